# Optimizing an MI355X kernel written in HIP

```python
import jax, jax.numpy as jnp
from jax import lax
import numpy as np

D_MODEL = 1024
BATCH = 16
SEQ = 2048
DEPTH = 4

GRID_W = 64
CTX_LEN = 256
Q_BLOCK = 128
ROPE_BASE = 10000.0
RMS_EPS = 1e-6
LN_EPS = 1e-5

MLA_HEADS = 8
MLA_Q_LORA = 384
MLA_KV_LORA = 256
MLA_NOPE = 64
MLA_ROPE = 32
MLA_V = 64
MLA_QK = MLA_NOPE + MLA_ROPE
MLA_SCALE = MLA_QK ** -0.5

HEAD_DIM = 64
GQA_HEADS = 8
GQA_KV_HEADS = 2
GQA_GROUP = GQA_HEADS // GQA_KV_HEADS
GQA_SCALE = HEAD_DIM ** -0.5

MIX_WIDTH = MLA_HEADS * MLA_V + GQA_HEADS * HEAD_DIM
IN_SPLITS = (MLA_Q_LORA,
             MLA_Q_LORA + MLA_KV_LORA,
             MLA_Q_LORA + MLA_KV_LORA + MLA_ROPE,
             MLA_Q_LORA + MLA_KV_LORA + MLA_ROPE + GQA_HEADS * HEAD_DIM,
             MLA_Q_LORA + MLA_KV_LORA + MLA_ROPE + (GQA_HEADS + GQA_KV_HEADS) * HEAD_DIM)
IN_COLS = MLA_Q_LORA + MLA_KV_LORA + MLA_ROPE + (GQA_HEADS + 2 * GQA_KV_HEADS) * HEAD_DIM

N_GROUPS = 4
EXPERTS_PER_GROUP = 8
N_EXPERTS = N_GROUPS * EXPERTS_PER_GROUP
TOP_K = 2
D_FF_EXPERT = 512
MOE_BLOCK = 128

ALPHA = (2.0 * DEPTH) ** 0.25
BETA = (8.0 * DEPTH) ** -0.25

kernel_name = "hybrid_mla_gqa_hmoe_diffusion_block"


def rms_norm(x, g):
    xf = x.astype(jnp.float32)
    y = xf * lax.rsqrt(jnp.mean(jnp.square(xf), axis=-1, keepdims=True) + RMS_EPS)
    return (y * g).astype(x.dtype)


def layer_norm(x, g, b):
    xf = x.astype(jnp.float32)
    mu = jnp.mean(xf, axis=-1, keepdims=True)
    var = jnp.mean(jnp.square(xf - mu), axis=-1, keepdims=True)
    return ((xf - mu) * lax.rsqrt(var + LN_EPS) * g + b).astype(x.dtype)


def modulate(x, shift, scale):
    return x * (1 + scale) + shift


def rope_1d(x, ang):
    d2 = ang.shape[-1]
    cos = jnp.cos(ang)[:, None, :]
    sin = jnp.sin(ang)[:, None, :]
    xf = x.astype(jnp.float32)
    x1, x2 = xf[..., :d2], xf[..., d2:]
    return jnp.concatenate([x1 * cos - x2 * sin, x2 * cos + x1 * sin], axis=-1).astype(x.dtype)


def rope_2d(x, row, col):
    half = x.shape[-1] // 2
    inv = ROPE_BASE ** (-(jnp.arange(0, half, 2, dtype=jnp.float32) / half))
    return jnp.concatenate([rope_1d(x[..., :half], row[:, None] * inv),
                            rope_1d(x[..., half:], col[:, None] * inv)], axis=-1)


def blocked_attention(q, k, v, scale):
    B, L, Hk, G, Dq = q.shape
    nb = L // Q_BLOCK
    qb = jnp.moveaxis(q.reshape(B, nb, Q_BLOCK, Hk, G, Dq), 1, 0)

    def one_block(qblk):
        s = jnp.einsum('bqhgd,bkhd->bhgqk', qblk, k, preferred_element_type=jnp.float32) * scale
        p = jax.nn.softmax(s, axis=-1)
        return jnp.einsum('bhgqk,bkhd->bqhgd', p.astype(v.dtype), v)

    o = lax.map(one_block, qb)
    return jnp.moveaxis(o, 0, 1).reshape(B, L, Hk * G * v.shape[-1])


def mixer_inputs(h, p_attn, row, col):
    w_in, g_q_a, w_q_b, g_kv_a, w_kv_b, g_gq, g_gk = p_attn
    B, L, _ = h.shape
    z = h @ w_in
    q_a, kv_a, k_rope, gq, gk, gv = jnp.split(z, IN_SPLITS, axis=-1)
    q = (rms_norm(q_a, g_q_a) @ w_q_b).reshape(B, L, MLA_HEADS, MLA_QK)
    q_nope, q_rope = q[..., :MLA_NOPE], q[..., MLA_NOPE:]
    kv = (rms_norm(kv_a, g_kv_a) @ w_kv_b).reshape(B, L, MLA_HEADS, MLA_NOPE + MLA_V)
    k_nope, v_mla = kv[..., :MLA_NOPE], kv[..., MLA_NOPE:]
    k_rope = k_rope.reshape(B, L, 1, MLA_ROPE)
    gq = rms_norm(gq.reshape(B, L, GQA_HEADS, HEAD_DIM), g_gq)
    gk = rms_norm(gk.reshape(B, L, GQA_KV_HEADS, HEAD_DIM), g_gk)
    gv = gv.reshape(B, L, GQA_KV_HEADS, HEAD_DIM)
    if row is not None:
        q_rope = rope_2d(q_rope, row, col)
        k_rope = rope_2d(k_rope, row, col)
        gq = rope_2d(gq, row, col)
        gk = rope_2d(gk, row, col)
    q_mla = jnp.concatenate([q_nope, q_rope], axis=-1)[:, :, :, None, :]
    k_mla = jnp.concatenate([k_nope, jnp.broadcast_to(k_rope, (B, L, MLA_HEADS, MLA_ROPE))], axis=-1)
    q_gqa = gq.reshape(B, L, GQA_KV_HEADS, GQA_GROUP, HEAD_DIM)
    return q_mla, k_mla, v_mla, q_gqa, gk, gv


def moe_ffn(h, w_grp, b_grp, w_exp, b_exp, w_gate, w_up, w_down):
    T, D = h.shape
    lg = (h @ w_grp + b_grp).astype(jnp.float32)
    pg = jax.nn.softmax(lg, axis=-1)
    g_star = jnp.argmax(lg, axis=-1)
    p_star = jnp.take_along_axis(pg, g_star[:, None], axis=-1)
    le = (h @ w_exp + b_exp).astype(jnp.float32).reshape(T, N_GROUPS, EXPERTS_PER_GROUP)
    le_g = jnp.take_along_axis(le, g_star[:, None, None], axis=1)[:, 0]
    top_v, top_i = lax.top_k(le_g, TOP_K)
    weights = (p_star * jax.nn.softmax(top_v, axis=-1)).astype(h.dtype)
    expert_id = g_star[:, None] * EXPERTS_PER_GROUP + top_i

    A = T * TOP_K
    flat_e = expert_id.reshape(A)
    order = jnp.argsort(flat_e)
    sorted_e = flat_e[order]
    counts = jnp.bincount(flat_e, length=N_EXPERTS)
    padded = (counts + MOE_BLOCK - 1) // MOE_BLOCK * MOE_BLOCK
    pad_end = jnp.cumsum(padded)
    pad_start = pad_end - padded
    start = jnp.cumsum(counts) - counts
    dest_sorted = pad_start[sorted_e] + jnp.arange(A) - start[sorted_e]
    n_blocks = -(-A // MOE_BLOCK) + N_EXPERTS
    slot_tok = jnp.zeros((n_blocks * MOE_BLOCK,), jnp.int32).at[dest_sorted].set(order // TOP_K)
    block_e = jnp.minimum(jnp.searchsorted(pad_end, jnp.arange(n_blocks) * MOE_BLOCK, side='right'),
                          N_EXPERTS - 1)
    xb = h[slot_tok].reshape(n_blocks, MOE_BLOCK, D)

    def expert_block(args):
        xblk, e = args
        return (jax.nn.silu(xblk @ w_gate[e]) * (xblk @ w_up[e])) @ w_down[e]

    yb = lax.map(expert_block, (xb, block_e)).reshape(n_blocks * MOE_BLOCK, D)
    dest = jnp.zeros((A,), jnp.int32).at[order].set(dest_sorted)
    y = yb[dest].reshape(T, TOP_K, D)
    return jnp.einsum('tk,tkd->td', weights, y)


def setup_inputs(seed: int = 0) -> dict:
    key = jax.random.key(seed)
    ks = jax.random.split(key, 26)
    f32 = jnp.float32
    L, D = DEPTH, D_MODEL

    def nrm(k, shape, scale):
        return jax.random.normal(k, shape, f32) * scale

    return {
        "x": nrm(ks[0], (BATCH, SEQ, D), 1.0),
        "c": nrm(ks[1], (BATCH, D), 1.0),
        "ctx": nrm(ks[2], (BATCH, CTX_LEN, D), 1.0),
        "c_ctx": nrm(ks[3], (D,), 1.0),
        "w_ada": nrm(ks[4], (L, D, 6 * D), D ** -0.5),
        "b_ada": nrm(ks[5], (L, 6 * D), 0.02),
        "w_in": nrm(ks[6], (L, D, IN_COLS), D ** -0.5),
        "g_q_a": 1.0 + nrm(ks[7], (L, MLA_Q_LORA), 0.02),
        "w_q_b": nrm(ks[8], (L, MLA_Q_LORA, MLA_HEADS * MLA_QK), MLA_Q_LORA ** -0.5),
        "g_kv_a": 1.0 + nrm(ks[9], (L, MLA_KV_LORA), 0.02),
        "w_kv_b": nrm(ks[10], (L, MLA_KV_LORA, MLA_HEADS * (MLA_NOPE + MLA_V)), MLA_KV_LORA ** -0.5),
        "g_gqa_q": 1.0 + nrm(ks[11], (L, HEAD_DIM), 0.02),
        "g_gqa_k": 1.0 + nrm(ks[12], (L, HEAD_DIM), 0.02),
        "w_o": nrm(ks[13], (L, MIX_WIDTH, D), MIX_WIDTH ** -0.5 * BETA),
        "ln1_g": 1.0 + nrm(ks[14], (L, D), 0.02),
        "ln1_b": nrm(ks[15], (L, D), 0.02),
        "w_router_grp": nrm(ks[16], (L, D, N_GROUPS), D ** -0.5),
        "b_router_grp": nrm(ks[17], (L, N_GROUPS), 0.01),
        "w_router_exp": nrm(ks[18], (L, D, N_EXPERTS), D ** -0.5),
        "b_router_exp": nrm(ks[19], (L, N_EXPERTS), 0.01),
        "w_gate": nrm(ks[20], (L, N_EXPERTS, D, D_FF_EXPERT), D ** -0.5),
        "w_up": nrm(ks[21], (L, N_EXPERTS, D, D_FF_EXPERT), D ** -0.5),
        "w_down": nrm(ks[22], (L, N_EXPERTS, D_FF_EXPERT, D), D_FF_EXPERT ** -0.5 * BETA),
        "ln2_g": 1.0 + nrm(ks[23], (L, D), 0.02),
        "ln2_b": nrm(ks[24], (L, D), 0.02),
    }


def reference(x, c, ctx, c_ctx, w_ada, b_ada, w_in, g_q_a, w_q_b, g_kv_a, w_kv_b, g_gqa_q, g_gqa_k,
              w_o, ln1_g, ln1_b, w_router_grp, b_router_grp, w_router_exp, b_router_exp,
              w_gate, w_up, w_down, ln2_g, ln2_b):
    B, S, D = x.shape
    C = ctx.shape[1]
    rows = S // GRID_W
    row = jnp.repeat(jnp.arange(rows, dtype=jnp.float32), GRID_W)
    col = jnp.tile(jnp.arange(GRID_W, dtype=jnp.float32), rows)
    silu_c = jax.nn.silu(c)
    silu_cc = jax.nn.silu(c_ctx)
    xc = ctx
    for l in range(DEPTH):
        last = l == DEPTH - 1
        sh_a, sc_a, ga, sh_f, sc_f, gf = jnp.split((silu_c @ w_ada[l] + b_ada[l])[:, None, :], 6, axis=-1)
        csh_a, csc_a, cga, csh_f, csc_f, cgf = jnp.split(silu_cc @ w_ada[l] + b_ada[l], 6, axis=-1)
        p_attn = (w_in[l], g_q_a[l], w_q_b[l], g_kv_a[l], w_kv_b[l], g_gqa_q[l], g_gqa_k[l])

        qm, km, vm, qg, kg, vg = mixer_inputs(modulate(x, sh_a, sc_a), p_attn, row, col)
        qmc, kmc, vmc, qgc, kgc, vgc = mixer_inputs(modulate(xc, csh_a, csc_a), p_attn, None, None)
        o = jnp.concatenate([
            blocked_attention(qm, jnp.concatenate([kmc, km], axis=1),
                              jnp.concatenate([vmc, vm], axis=1), MLA_SCALE),
            blocked_attention(qg, jnp.concatenate([kgc, kg], axis=1),
                              jnp.concatenate([vgc, vg], axis=1), GQA_SCALE)], axis=-1)
        x = layer_norm(ALPHA * x + ga * (o @ w_o[l]), ln1_g[l], ln1_b[l])
        if not last:
            oc = jnp.concatenate([blocked_attention(qmc, kmc, vmc, MLA_SCALE),
                                  blocked_attention(qgc, kgc, vgc, GQA_SCALE)], axis=-1)
            xc = layer_norm(ALPHA * xc + cga * (oc @ w_o[l]), ln1_g[l], ln1_b[l])

        p_moe = (w_router_grp[l], b_router_grp[l], w_router_exp[l], b_router_exp[l],
                 w_gate[l], w_up[l], w_down[l])
        h = modulate(x, sh_f, sc_f).reshape(B * S, D)
        if last:
            y = moe_ffn(h, *p_moe).reshape(B, S, D)
        else:
            hc = modulate(xc, csh_f, csc_f).reshape(B * C, D)
            y_all = moe_ffn(jnp.concatenate([h, hc], axis=0), *p_moe)
            y = y_all[:B * S].reshape(B, S, D)
            xc = layer_norm(ALPHA * xc + cgf * y_all[B * S:].reshape(B, C, D), ln2_g[l], ln2_b[l])
        x = layer_norm(ALPHA * x + gf * y, ln2_g[l], ln2_b[l])
    return x
```

```cpp
#include <hip/hip_runtime.h>
#include <cstdint>
#include <cstdio>

#ifndef REP_ATTN
#define REP_ATTN 1
#endif
#ifndef REP_GEMM
#define REP_GEMM 1
#endif
#ifndef REP_PRO
#define REP_PRO 1
#endif
#ifndef REP_THIN
#define REP_THIN 1
#endif
#ifndef REP_P2
#define REP_P2 1
#endif
#ifndef REP_P7
#define REP_P7 1
#endif
#ifndef REP_P6
#define REP_P6 1
#endif
#ifndef REP_P10
#define REP_P10 0
#endif
#ifndef FILL_P1
#define FILL_P1 3
#endif
#ifndef FILL_P5
#define FILL_P5 3
#endif
#ifndef USE_MFMA_GEMM
#define USE_MFMA_GEMM 1
#endif
#ifndef USE_MFMA_ATTN
#define USE_MFMA_ATTN 1
#endif

#define GAS __attribute__((address_space(1)))
#define LAS __attribute__((address_space(3)))
typedef unsigned short bf16_t;
typedef float f32x4 __attribute__((ext_vector_type(4)));
typedef float f32x2 __attribute__((ext_vector_type(2)));
typedef unsigned u32x4 __attribute__((ext_vector_type(4)));
typedef unsigned u32x2 __attribute__((ext_vector_type(2)));
typedef short bf16x8 __attribute__((ext_vector_type(8)));

constexpr int D = 1024, NB = 16, SEQ = 2048, CTX = 256, NL = 4;
constexpr int TL = NB * SEQ, TC = NB * CTX, MT = TL + TC;
constexpr int KPB = CTX + SEQ;
constexpr int ZW = 1536;
constexpr int QW = 768, KVW = 1024;
constexpr int NEXP = 32, FF = 512;
constexpr int XS_ROWS = 81920;
constexpr float ALPHA = 1.6817928305074290f;
constexpr float LOG2E = 1.4426950408889634f;
constexpr float QSCALE_M = 0.10206207261596575f * LOG2E;
constexpr float QSCALE_G = 0.125f * LOG2E;
constexpr float RMS_EPS = 1e-6f, LN_EPS = 1e-5f;
constexpr int NWAVES = 8, NTHREADS = 512, GRID = 256;

constexpr size_t al256(size_t x) { return (x + 255) & ~(size_t)255; }
constexpr size_t WS_CTL = 0, CTL_BYTES = 65536;
constexpr size_t WS_BLKCNT = WS_CTL + CTL_BYTES;
constexpr size_t WS_MOETAB = WS_BLKCNT + (size_t)NL * 256 * 32 * 4;
constexpr size_t WS_MOD = WS_MOETAB + (size_t)NL * 128 * 4;
constexpr size_t WS_MODP = WS_MOD + (size_t)NL * 17 * 6144 * 4;
constexpr size_t WS_TAB64 = WS_MODP + (size_t)4 * NL * 17 * 6144 * 4;
constexpr size_t WS_TAB32 = WS_TAB64 + 64 * 16 * 8;
constexpr size_t WS_RSTDQ = WS_TAB32 + 64 * 8 * 8;
constexpr size_t WS_RSTDKV = WS_RSTDQ + (size_t)MT * 4;
constexpr size_t WS_TOKE = WS_RSTDKV + (size_t)MT * 4;
constexpr size_t WS_TOKR = WS_TOKE + (size_t)MT * 8;
constexpr size_t WS_TOKP = WS_TOKR + (size_t)MT * 8;
constexpr size_t WS_TOKW = WS_TOKP + (size_t)MT * 8;
constexpr size_t WS_WIN = al256(WS_TOKW + (size_t)MT * 8);
constexpr size_t WS_WQ = WS_WIN + (size_t)NL * ZW * D * 2;
constexpr size_t WS_WKV = WS_WQ + (size_t)NL * QW * 384 * 2;
constexpr size_t WS_WO = WS_WKV + (size_t)NL * KVW * 256 * 2;
constexpr size_t WS_WGU = WS_WO + (size_t)NL * D * D * 2;
constexpr size_t WS_WD = WS_WGU + (size_t)NL * NEXP * 1024 * D * 2;
constexpr size_t WS_XC = WS_WD + (size_t)NL * NEXP * D * FF * 2;
constexpr size_t WS_H = WS_XC + (size_t)TC * D * 4;
constexpr size_t WS_B = WS_H + (size_t)MT * D * 2;
constexpr size_t WS_Z = WS_B;
constexpr size_t WS_QM = WS_Z + (size_t)MT * ZW * 2;
constexpr size_t WS_KM = WS_QM + (size_t)MT * QW * 2;
constexpr size_t WS_VM = WS_KM + (size_t)MT * QW * 2;
constexpr size_t WS_QG = WS_VM + (size_t)MT * 512 * 2;
constexpr size_t WS_KG = WS_QG + (size_t)MT * 512 * 2;
constexpr size_t WS_VG = WS_KG + (size_t)MT * 128 * 2;
constexpr size_t WS_O = WS_VG + (size_t)MT * 128 * 2;
constexpr size_t WS_BEND = WS_O + (size_t)MT * D * 2;
constexpr size_t WS_U = WS_B;
constexpr size_t WS_XS = WS_B;
constexpr size_t WS_ACT = WS_XS + (size_t)XS_ROWS * D * 2;
constexpr size_t WS_HLO = WS_BEND;
constexpr size_t WS_WR = WS_HLO + (size_t)MT * D * 2;
constexpr size_t WS_POSTOK = WS_WR + (size_t)NL * 2 * 48 * D * 2;
constexpr size_t WS_END = WS_POSTOK + (size_t)XS_ROWS * 4;
static_assert(WS_U + (size_t)MT * D * 4 <= WS_KM, "U must fit in Z+QM");
static_assert(WS_ACT + (size_t)XS_ROWS * FF * 2 <= WS_BEND, "MoE buffers must fit in region B");
static_assert(WS_END < (size_t)1100 * 1000 * 1000, "workspace map too large");

constexpr int LDS_BYTES = 163840;
constexpr int BIG_BYTES = 147456;
constexpr int MISC_OFF = BIG_BYTES;
constexpr int MISC_BAR = MISC_OFF;
constexpr int MISC_CNT = MISC_OFF + 64;
constexpr int MISC_POFF = MISC_OFF + 256;
constexpr int MISC_TOT = MISC_OFF + 512;
constexpr int MISC_BASE = MISC_OFF + 768;
constexpr int MISC_PA = MISC_OFF + 1024;
constexpr int MISC_PB = MISC_OFF + 1024 + 2048;
constexpr int MISC_LG = MISC_OFF + 8192;

#define LDS_WAIT() asm volatile("s_waitcnt lgkmcnt(0)" ::: "memory")
__device__ __forceinline__ unsigned f2bf(float f) { unsigned u = __builtin_bit_cast(unsigned, f); return (u + 0x7fffu + ((u >> 16) & 1u)) >> 16; }
__device__ __forceinline__ unsigned pk2(float lo, float hi) { return f2bf(lo) | (f2bf(hi) << 16); }
__device__ __forceinline__ float bflo(unsigned w) { return __builtin_bit_cast(float, w << 16); }
__device__ __forceinline__ float bfhi(unsigned w) { return __builtin_bit_cast(float, w & 0xffff0000u); }
__device__ __forceinline__ float wave_sum(float v) {
#pragma unroll
    for (int o = 1; o < 64; o <<= 1) v += __shfl_xor(v, o);
    return v;
}
__device__ __forceinline__ int krow_of(int r) { return r < TL ? (r >> 11) * KPB + CTX + (r & 2047) : ((r - TL) >> 8) * KPB + ((r - TL) & 255); }
__device__ __forceinline__ int bb_of(int r) { return r < TL ? (r >> 11) : 16; }

#define XB_TMO      128
#define XB_XCNT(j)  (256  + 64 * (j))
#define XB_XSUB(j)  (1280 + 64 * (j))
#define XB_XGEN(j)  (2304 + 64 * (j))
#define XB_TOP      3328
#define XB_TOPGEN   3392
#define XCD_BAR_WORDS 3456
#define XB_SPIN_CAP (1u << 18)
__device__ __forceinline__ unsigned xb_ld(unsigned* p)              { return __hip_atomic_load(p, __ATOMIC_RELAXED, __HIP_MEMORY_SCOPE_AGENT); }
__device__ __forceinline__ unsigned xb_add(unsigned* p, unsigned v) { return __hip_atomic_fetch_add(p, v, __ATOMIC_RELAXED, __HIP_MEMORY_SCOPE_AGENT); }
__device__ __forceinline__ unsigned xb_xcc_id() { return (unsigned)__builtin_amdgcn_s_getreg((3 << 11) | 20) & 0xFu; }
#define XB_SPIN(cond, bar) do { unsigned _sp = 0; while (cond) { __builtin_amdgcn_s_sleep(1); \
    if ((++_sp & 255u) == 0u) { if (xb_ld(&(bar)[XB_TMO])) break; if (_sp > XB_SPIN_CAP) { atomicAdd(&(bar)[XB_TMO], 1u); break; } } } } while (0)
struct XcdBarrier { unsigned* bar; unsigned x; volatile LAS unsigned* st; };
__device__ __forceinline__ XcdBarrier xcd_barrier_post(unsigned* bar, volatile LAS unsigned* st, const bool leader) {
    XcdBarrier b; b.bar = bar; b.x = xb_xcc_id(); b.st = st;
    if (leader) (void)xb_add(&bar[XB_XCNT(b.x)], 1u);
    return b;
}
__device__ __forceinline__ void xcd_barrier_complete(unsigned* bar, unsigned x, unsigned& nloc, unsigned& nx) {
    const unsigned G = gridDim.x * gridDim.y * gridDim.z;
    unsigned sum, cnt, mine, sp = 0u;
    for (;;) {
        sum = 0u; cnt = 0u; mine = 0u;
#pragma unroll
        for (unsigned j = 0; j < 16; ++j) { const unsigned c = xb_ld(&bar[XB_XCNT(j)]); sum += c; cnt += (c > 0u) ? 1u : 0u; mine = (j == x) ? c : mine; }
        if (sum == G) break;
        __builtin_amdgcn_s_sleep(1);
        if ((++sp & 255u) == 0u) { if (xb_ld(&bar[XB_TMO])) break; if (sp > XB_SPIN_CAP) { atomicAdd(&bar[XB_TMO], 1u); break; } }
    }
    nloc = mine > 0u ? mine : 1u; nx = cnt > 0u ? cnt : 1u;
}
__device__ __forceinline__ void xcd_barrier(const XcdBarrier& b, const bool leader) {
    asm volatile("s_waitcnt vmcnt(0)" ::: "memory");
    __syncthreads();
    if (leader) {
        unsigned* bar = b.bar;
        __builtin_amdgcn_s_waitcnt(0);
        unsigned nloc = b.st[0], nx = b.st[1];
        if (nloc == 0u) { xcd_barrier_complete(bar, b.x, nloc, nx); b.st[0] = nloc; b.st[1] = nx; }
        const unsigned old = xb_add(&bar[XB_XSUB(b.x)], 1u);
        const unsigned gen = old / nloc;
        if (old + 1u == (gen + 1u) * nloc) {
            __builtin_amdgcn_fence(__ATOMIC_RELEASE, "agent");
            asm volatile("s_waitcnt vmcnt(0)" ::: "memory");
            const unsigned og = xb_add(&bar[XB_TOP], 1u);
            const unsigned tg = og / nx;
            if (og + 1u == (tg + 1u) * nx) xb_add(&bar[XB_TOPGEN], 1u);
            else XB_SPIN(xb_ld(&bar[XB_TOPGEN]) == tg, bar);
            __builtin_amdgcn_fence(__ATOMIC_ACQUIRE, "agent");
            xb_add(&bar[XB_XGEN(b.x)], 1u);
            asm volatile("s_waitcnt vmcnt(0)" ::: "memory");
        } else {
            XB_SPIN(xb_ld(&bar[XB_XGEN(b.x)]) == gen, bar);
            __builtin_amdgcn_fence(__ATOMIC_ACQUIRE, "agent");
            asm volatile("s_waitcnt vmcnt(0)" ::: "memory");
        }
    }
    __syncthreads();
}

struct Args {
    const float* x; const float* c; const float* ctx; const float* c_ctx; const float* w_ada; const float* b_ada; const float* w_in;
    const float* g_q_a; const float* w_q_b; const float* g_kv_a; const float* w_kv_b; const float* g_gq; const float* g_gk; const float* w_o;
    const float* ln1_g; const float* ln1_b; const float* w_rg; const float* b_rg; const float* w_re; const float* b_re;
    const float* w_gate; const float* w_up; const float* w_down; const float* ln2_g; const float* ln2_b;
    float* out; unsigned char* ws;
};

typedef const __attribute__((address_space(4))) Args* KP;
__device__ __forceinline__ Args ldargs(KP p) {
#if defined(__HIP_DEVICE_COMPILE__)
    asm volatile("" : "+s"(p)); return *p;
#else
    return Args{};
#endif
}

struct Ctx {
    LAS unsigned char* lds;
    int tid, lane, wave, vcu, bk;
};

struct Unit { int pm, pn; };
constexpr int BM = 256, NXCD = 8, WGM = 8;
struct StaticOrder {
    int nM, nN, nwg, G, c;
    __device__ void init(int M, int N, int G_, int c_) { nM = M / BM; nN = N / BM; nwg = nM * nN; G = G_; c = c_; }
    __device__ bool next(int i, Unit& u) const {
        const long L = (long)i * G + c; if (L >= nwg) return false;
        int wgid = (int)L; { const int q = nwg / NXCD, r = nwg % NXCD, xcd = wgid % NXCD, off = wgid / NXCD; wgid = (xcd < r ? xcd * (q + 1) : r * (q + 1) + (xcd - r) * q) + off; }
        const int nig = WGM * nN, gid = wgid / nig, fm = gid * WGM, gsz = (nM - fm) < WGM ? (nM - fm) : WGM;
        u.pm = fm + ((wgid % nig) % gsz); u.pn = (wgid % nig) / gsz; return true;
    }
    __device__ __forceinline__ void a_ready(const Unit&) const {}
    __device__ __forceinline__ void done(const Unit&) const {}
};
struct GroupedOrder {
    const volatile LAS int* poff; int nunits, G, c;
    __device__ void init(const volatile LAS int* poff_, int G_, int c_) { poff = poff_; nunits = (poff_[32] >> 8) * 4; G = G_; c = c_; }
    __device__ bool next(int i, Unit& u) const {
        const int L = i * G + c; if (L >= nunits) return false;
        const int rt = L >> 2, r0 = rt << 8; int e = 0;
#pragma unroll
        for (int j = 1; j < 32; ++j) e += (poff[j] <= r0) ? 1 : 0;
        u.pm = rt; u.pn = e * 4 + (L & 3); return true;
    }
    __device__ __forceinline__ void a_ready(const Unit&) const {}
    __device__ __forceinline__ void done(const Unit&) const {}
};

__device__ __forceinline__ void st_bf4(bf16_t* p, f32x4 v) { u32x2 w; w.x = pk2(v[0], v[1]); w.y = pk2(v[2], v[3]); *(u32x2*)p = w; }
struct EpiZ {
    bf16_t* Z;
    __device__ __forceinline__ void tile32(int row, int col, int fq, f32x4 v0, f32x4 v1) const {
        bf16_t* p = Z + (size_t)row * ZW + col + 4 * fq; st_bf4(p, v0); st_bf4(p + 16, v1);
    }
};
struct EpiQ {
    bf16_t* Qm; const float* rstd; const f32x2* tab32;
    __device__ __forceinline__ void tile32(int row, int col, int fq, f32x4 v0, f32x4 v1) const {
        const int h = col / 96, gi = (col - h * 96) >> 5;
        const float rs = rstd[row] * QSCALE_M;
        v0 = v0 * rs; v1 = v1 * rs;
        bf16_t* base = Qm + (size_t)row * QW + h * 96;
        if (gi < 2) { bf16_t* p = base + gi * 32 + 4 * fq; st_bf4(p, v0); st_bf4(p + 16, v1); }
        else {
            const int part = fq >> 1, f0 = (4 * fq) & 7;
            f32x4 o1 = v0, o2 = v1;
            if (row < TL) {
                const int s = row & 2047, pos = part ? (s & 63) : (s >> 6);
#pragma unroll
                for (int j = 0; j < 4; ++j) { const f32x2 cs = tab32[pos * 8 + f0 + j]; o1[j] = v0[j] * cs.x - v1[j] * cs.y; o2[j] = v1[j] * cs.x + v0[j] * cs.y; }
            }
            bf16_t* p = base + 64 + part * 16 + f0; st_bf4(p, o1); st_bf4(p + 8, o2);
        }
    }
};
struct EpiKV {
    bf16_t* Km; bf16_t* Vm; const float* rstd;
    __device__ __forceinline__ void tile32(int row, int col, int fq, f32x4 v0, f32x4 v1) const {
        const int h = col >> 7, w = col & 127; const float rs = rstd[row]; const int kr = krow_of(row);
        v0 = v0 * rs; v1 = v1 * rs;
        bf16_t* p = (w < 64) ? (Km + (size_t)kr * QW + h * 96 + w + 4 * fq) : (Vm + (size_t)kr * 512 + h * 64 + (w - 64) + 4 * fq);
        st_bf4(p, v0); st_bf4(p + 16, v1);
    }
};
struct EpiU {
    float* U; const float* xl; const float* xc; const float* mod_l;
    int gate;
    __device__ __forceinline__ void tile32(int row, int col, int fq, f32x4 v0, f32x4 v1) const {
        const float* xr = (row < TL) ? (xl + (size_t)row * D) : (xc + (size_t)(row - TL) * D);
        const float* g = mod_l + (size_t)(bb_of(row) * 6 + gate) * D;
        const int c0 = col + 4 * fq;
        const f32x4 x0 = *(const f32x4*)(xr + c0), x1 = *(const f32x4*)(xr + c0 + 16), g0 = *(const f32x4*)(g + c0), g1 = *(const f32x4*)(g + c0 + 16);
        float* u = U + (size_t)row * D + c0;
        *(f32x4*)u = x0 * ALPHA + g0 * v0; *(f32x4*)(u + 16) = x1 * ALPHA + g1 * v1;
    }
};
__device__ __forceinline__ float silu_f(float x) { return x * __builtin_amdgcn_rcpf(1.0f + __builtin_amdgcn_exp2f(-x * LOG2E)); }
struct EpiAct {
    bf16_t* Act;
    __device__ __forceinline__ void tile32(int row, int col, int fq, f32x4 v0, f32x4 v1) const {
        const int f0 = ((col & 1023) >> 1) + 4 * fq; f32x4 a;
#pragma unroll
        for (int j = 0; j < 4; ++j) a[j] = silu_f(v0[j]) * v1[j];
        st_bf4(Act + (size_t)row * FF + f0, a);
    }
};
struct EpiYo {
    bf16_t* Y;
    __device__ __forceinline__ void tile32(int row, int col, int fq, f32x4 v0, f32x4 v1) const {
        bf16_t* p = Y + (size_t)row * D + col + 4 * fq; st_bf4(p, v0); st_bf4(p + 16, v1);
    }
};
struct EpiY {
    bf16_t* Y;
    __device__ __forceinline__ void tile32(int row, int col, int fq, f32x4 v0, f32x4 v1) const {
        bf16_t* p = Y + (size_t)row * D + (col & 1023) + 4 * fq; st_bf4(p, v0); st_bf4(p + 16, v1);
    }
};

struct Gemm { const bf16_t* A; int lda; const bf16_t* Bt; int K; };
__device__ __forceinline__ float dot8(u32x4 a, u32x4 b, float acc) {
#pragma unroll
    for (int i = 0; i < 4; ++i) { acc += bflo(a[i]) * bflo(b[i]); acc += bfhi(a[i]) * bfhi(b[i]); }
    return acc;
}
template <class Sched, class Epi>
__device__ __forceinline__ void gemm_naive(const Ctx& F, const Gemm g, const Sched& S, const Epi& E) {
    Unit u;
    for (int i = 0; S.next(i, u); ++i) {
        for (int task = F.tid; task < 8192; task += NTHREADS) {
            const int lane = task & 63, fr = lane & 15, fq = lane >> 4, rest = task >> 6, rg = rest & 15, cg = rest >> 4;
            const int row = u.pm * 256 + rg * 16 + fr, col = u.pn * 256 + cg * 32;
            const bf16_t* ap = g.A + (size_t)row * g.lda;
            const bf16_t* bp0 = g.Bt + (size_t)(col + 4 * fq) * g.K;
            const bf16_t* bp1 = bp0 + (size_t)16 * g.K;
            f32x4 v0 = {0.f, 0.f, 0.f, 0.f}, v1 = {0.f, 0.f, 0.f, 0.f};
            for (int k = 0; k < g.K; k += 8) {
                const u32x4 a = *(const u32x4*)(ap + k);
#pragma unroll
                for (int j = 0; j < 4; ++j) {
                    v0[j] = dot8(a, *(const u32x4*)(bp0 + (size_t)j * g.K + k), v0[j]);
                    v1[j] = dot8(a, *(const u32x4*)(bp1 + (size_t)j * g.K + k), v1[j]);
                }
            }
            E.tile32(row, col, fq, v0, v1);
        }
    }
}
constexpr int BK = 64, HALF = 128, HTB = HALF * BK * 2, STAGE_BYTES = 8 * HTB;
__device__ __forceinline__ int lds_byte(int r, int c) { const int st = (r >> 4) * 2 + (c >> 5), rr = r & 15, cc = c & 31, ob = rr * 64 + cc * 2; return st * 1024 + (ob ^ (((ob >> 9) & 1) << 5)); }
__device__ __forceinline__ void stage_rc(int b, int& R, int& C) { const int st = b / 1024, sb = b % 1024, swz = sb ^ (((sb >> 9) & 1) << 5); R = (st >> 1) * 16 + swz / 64; C = (st & 1) * 32 + (swz % 64) / 2; }
template <class Epi, class Sched, bool ALIGN_EPI = true, bool SP2 = true, bool GATHER = false>
__device__ __forceinline__ void gemm_mfma(LAS unsigned char* lds, const int tid_in, const Gemm g, const Sched& S, const Epi& E, const LAS int* gtab = nullptr) {
    int tid = tid_in; asm volatile("" : "+v"(tid));
    const int wid = __builtin_amdgcn_readfirstlane(tid >> 6), lane = tid & 63, wr = wid >> 2, wc = wid & 3, fr = lane & 15, fq = lane >> 4;
    const int K = g.K, nt = K / BK;
    unsigned voffB[2]; int RA[2], CA[2];
#pragma unroll
    for (int i = 0; i < 2; ++i) { int R, C; stage_rc(tid * 16 + i * 8192, R, C); const int Rb = R;
        RA[i] = R; CA[i] = C; voffB[i] = (unsigned)(Rb * K + C) * 2u; }
    const size_t kstep = (size_t)(BK * 2);
    const size_t hstepA = (size_t)HALF * g.lda * 2, hstepB = (size_t)HALF * K * 2;
    const size_t tstepA = GATHER ? 0 : 2 * hstepA, tstepB = 2 * hstepB;
    unsigned vc0[2], vc1[2], vn0[2], vn1[2];
#define PG8_GOFF(dst0, dst1, ui_) do { _Pragma("unroll") for (int i_ = 0; i_ < 2; ++i_) { \
        if constexpr (GATHER) { dst0[i_] = (unsigned)gtab[(ui_) * 256 + RA[i_]] * (unsigned)(g.lda * 2) + (unsigned)CA[i_] * 2u; dst1[i_] = (unsigned)gtab[(ui_) * 256 + HALF + RA[i_]] * (unsigned)(g.lda * 2) + (unsigned)CA[i_] * 2u; } \
        else { dst0[i_] = (unsigned)(RA[i_] * g.lda + CA[i_]) * 2u; dst1[i_] = dst0[i_] + (unsigned)hstepA; } } } while (0)
    const unsigned ldsw = (unsigned)wid * 1024u;
    const int aoff = lds_byte(wr * 64 + fr, fq * 8), boff = lds_byte(wc * 32 + fr, fq * 8);
#define PG8_SA(b, h) (((b) * 2 + (h)) * HTB)
#define PG8_SB(b, h) ((4 + (b) * 2 + (h)) * HTB)
#define PG8_STAGE(bufoff, gbase, voff) do { _Pragma("unroll") for (int _i = 0; _i < 2; ++_i) \
        __builtin_amdgcn_global_load_lds((const unsigned*)((const char*)(gbase) + (voff)[_i]), (LAS unsigned*)(lds + (bufoff) + ldsw + _i * 8192), 16, 0, 0); } while (0)
#define PG8_LDA(dst, b, h) do { _Pragma("unroll") for (int m = 0; m < 4; ++m) _Pragma("unroll") for (int k = 0; k < 2; ++k) dst[m][k] = *(const LAS bf16x8*)(lds + PG8_SA(b, h) + aoff + m * 2048 + k * 1024); } while (0)
#define PG8_LDB(dst, b, h) do { _Pragma("unroll") for (int n = 0; n < 2; ++n) _Pragma("unroll") for (int k = 0; k < 2; ++k) dst[n][k] = *(const LAS bf16x8*)(lds + PG8_SB(b, h) + boff + n * 2048 + k * 1024); } while (0)
#define PG8_MMA(ai, bj, At, Bt) do { __builtin_amdgcn_s_setprio(1); _Pragma("unroll") for (int m = 0; m < 4; ++m) _Pragma("unroll") for (int n = 0; n < 2; ++n) _Pragma("unroll") for (int k = 0; k < 2; ++k) \
        acc[ai][bj][m][n] = __builtin_amdgcn_mfma_f32_16x16x32_bf16(Bt[n][k], At[m][k], acc[ai][bj][m][n], 0, 0, 0); __builtin_amdgcn_s_setprio(0); } while (0)
#define PG8_WAIT_V(n) asm volatile("s_waitcnt vmcnt(" #n ")" ::: "memory")
#define PG8_WAIT_L(n) asm volatile("s_waitcnt lgkmcnt(" #n ")" ::: "memory")
#define PG8_BAR __builtin_amdgcn_s_barrier()
#define PG8_SCHED __builtin_amdgcn_sched_barrier(0)
    Unit cur, nxt; int ui = 0;
    if (!S.next(0, cur)) return;
    PG8_GOFF(vc0, vc1, 0);
#pragma unroll
    for (int i = 0; i < 2; ++i) { vn0[i] = vc0[i]; vn1[i] = vc1[i]; }
    f32x4 acc[2][2][4][2];
#pragma unroll
    for (int a = 0; a < 2; ++a)
#pragma unroll
        for (int b = 0; b < 2; ++b)
#pragma unroll
            for (int m = 0; m < 4; ++m)
#pragma unroll
                for (int n = 0; n < 2; ++n) acc[a][b][m][n] = (f32x4){0.f, 0.f, 0.f, 0.f};
    bf16x8 At[4][2], B0[2][2], B1[2][2];
    const char* cA = (const char*)g.A + (size_t)cur.pm * tstepA; const char* cB = (const char*)g.Bt + (size_t)cur.pn * tstepB;
    S.a_ready(cur);
    if constexpr (SP2) {
        PG8_STAGE(PG8_SB(0, 0), cB, voffB); PG8_STAGE(PG8_SB(0, 1), cB + hstepB, voffB); PG8_STAGE(PG8_SA(0, 0), cA, vc0); PG8_STAGE(PG8_SA(0, 1), cA, vc1);
        if (wr == 1) PG8_BAR;
        PG8_WAIT_V(2); PG8_BAR;
        PG8_STAGE(PG8_SB(1, 0), cB + kstep, voffB); PG8_STAGE(PG8_SA(1, 0), cA + kstep, vc0); PG8_STAGE(PG8_SB(1, 1), cB + hstepB + kstep, voffB);
        PG8_WAIT_V(6); PG8_BAR;
    } else {
        PG8_STAGE(PG8_SB(0, 0), cB, voffB); PG8_STAGE(PG8_SA(0, 0), cA, vc0); PG8_STAGE(PG8_SB(0, 1), cB + hstepB, voffB); PG8_STAGE(PG8_SA(0, 1), cA, vc1);
        if (wr == 1) PG8_BAR;
        PG8_WAIT_V(4); PG8_BAR;
        PG8_STAGE(PG8_SB(1, 0), cB + kstep, voffB); PG8_STAGE(PG8_SA(1, 0), cA + kstep, vc0); PG8_STAGE(PG8_SB(1, 1), cB + hstepB + kstep, voffB);
        PG8_WAIT_V(6); PG8_BAR;
    }
    for (;;) {
        const bool has_next = S.next(ui + 1, nxt);
        if constexpr (GATHER) { if (has_next) { PG8_GOFF(vn0, vn1, ui + 1); } else {
#pragma unroll
            for (int i = 0; i < 2; ++i) { vn0[i] = vc0[i]; vn1[i] = vc1[i]; } } }
        const char* nA = has_next ? (const char*)g.A + (size_t)nxt.pm * tstepA : cA; const char* nB = has_next ? (const char*)g.Bt + (size_t)nxt.pn * tstepB : cB;
        for (int t = 0; t < nt; t += 2) {
            const bool last = (t == nt - 2);
            const char* a1 = cA + (size_t)(t + 1) * kstep;
            const char* a2 = last ? nA : cA + (size_t)(t + 2) * kstep; const char* b2 = last ? nB : cB + (size_t)(t + 2) * kstep;
            const char* a3 = a2 + kstep; const char* b3 = b2 + kstep;
            unsigned s0[2], s1[2];
#pragma unroll
            for (int i = 0; i < 2; ++i) { if constexpr (GATHER) { s0[i] = last ? vn0[i] : vc0[i]; s1[i] = last ? vn1[i] : vc1[i]; } else { s0[i] = vc0[i]; s1[i] = vc1[i]; } }
            if (last && has_next) S.a_ready(nxt);
            if constexpr (SP2) {
            PG8_LDB(B0, 0, 0); PG8_LDB(B1, 0, 1); PG8_SCHED; PG8_LDA(At, 0, 0); PG8_STAGE(PG8_SA(1, 1), a1, vc1);
            PG8_WAIT_V(8); PG8_WAIT_L(0); PG8_BAR; PG8_MMA(0, 0, At, B0); PG8_MMA(0, 1, At, B1); PG8_BAR; PG8_SCHED;
            PG8_LDA(At, 0, 1); PG8_STAGE(PG8_SB(0, 0), b2, voffB); PG8_STAGE(PG8_SB(0, 1), b2 + hstepB, voffB); PG8_STAGE(PG8_SA(0, 0), a2, s0);
            PG8_WAIT_V(8); PG8_WAIT_L(0); PG8_BAR; PG8_MMA(1, 0, At, B0); PG8_MMA(1, 1, At, B1); PG8_BAR; PG8_SCHED;
            PG8_LDB(B0, 1, 0); PG8_LDB(B1, 1, 1); PG8_SCHED; PG8_LDA(At, 1, 0); PG8_STAGE(PG8_SA(0, 1), a2, s1);
            PG8_WAIT_V(8); PG8_WAIT_L(0); PG8_BAR; PG8_MMA(0, 0, At, B0); PG8_MMA(0, 1, At, B1); PG8_BAR; PG8_SCHED;
            PG8_LDA(At, 1, 1); PG8_STAGE(PG8_SB(1, 0), b3, voffB); PG8_STAGE(PG8_SB(1, 1), b3 + hstepB, voffB); PG8_STAGE(PG8_SA(1, 0), a3, s0);
            PG8_WAIT_V(8); PG8_WAIT_L(0); PG8_BAR; PG8_MMA(1, 0, At, B0); PG8_MMA(1, 1, At, B1); PG8_BAR; PG8_SCHED;
            } else {
            PG8_LDB(B0, 0, 0); PG8_SCHED; PG8_LDA(At, 0, 0); PG8_STAGE(PG8_SA(1, 1), a1, vc1);
            PG8_WAIT_L(8); PG8_BAR; PG8_WAIT_L(0); PG8_MMA(0, 0, At, B0); PG8_BAR; PG8_SCHED;
            PG8_LDB(B1, 0, 1); PG8_STAGE(PG8_SB(0, 0), b2, voffB);
            PG8_BAR; PG8_WAIT_L(0); PG8_MMA(0, 1, At, B1); PG8_BAR;
            PG8_LDA(At, 0, 1); PG8_STAGE(PG8_SA(0, 0), a2, s0);
            PG8_BAR; PG8_WAIT_L(0); PG8_MMA(1, 0, At, B0); PG8_BAR; PG8_SCHED;
            PG8_STAGE(PG8_SB(0, 1), b2 + hstepB, voffB);
            PG8_WAIT_V(6); PG8_BAR; PG8_MMA(1, 1, At, B1); PG8_BAR;
            PG8_LDB(B0, 1, 0); PG8_SCHED; PG8_LDA(At, 1, 0); PG8_STAGE(PG8_SA(0, 1), a2, s1);
            PG8_WAIT_L(8); PG8_BAR; PG8_WAIT_L(0); PG8_MMA(0, 0, At, B0); PG8_BAR; PG8_SCHED;
            PG8_LDB(B1, 1, 1); PG8_STAGE(PG8_SB(1, 0), b3, voffB);
            PG8_BAR; PG8_WAIT_L(0); PG8_MMA(0, 1, At, B1); PG8_BAR;
            PG8_LDA(At, 1, 1); PG8_STAGE(PG8_SA(1, 0), a3, s0);
            PG8_BAR; PG8_WAIT_L(0); PG8_MMA(1, 0, At, B0); PG8_BAR; PG8_SCHED;
            PG8_STAGE(PG8_SB(1, 1), b3 + hstepB, voffB);
            PG8_WAIT_V(6); PG8_BAR; PG8_MMA(1, 1, At, B1); PG8_BAR;
            }
        }
        if constexpr (ALIGN_EPI) { if (wr == 0) PG8_BAR; }
        {
            int ln_e; asm volatile("v_mbcnt_lo_u32_b32 %0, -1, 0\n\tv_mbcnt_hi_u32_b32 %0, -1, %0" : "=v"(ln_e));
            const int fr_e = ln_e & 15, fq_e = ln_e >> 4;
#pragma unroll
            for (int ai = 0; ai < 2; ++ai)
#pragma unroll
                for (int m = 0; m < 4; ++m) {
#pragma unroll
                    for (int bj = 0; bj < 2; ++bj)
                        E.tile32(cur.pm * BM + ai * HALF + wr * 64 + m * 16 + fr_e, cur.pn * BM + bj * HALF + wc * 32, fq_e, acc[ai][bj][m][0], acc[ai][bj][m][1]);
                    asm volatile("" ::: "memory");
                }
            S.done(cur);
        }
        if (!has_next) break;
#pragma unroll
        for (int a = 0; a < 2; ++a)
#pragma unroll
            for (int b = 0; b < 2; ++b)
#pragma unroll
                for (int m = 0; m < 4; ++m)
#pragma unroll
                    for (int n = 0; n < 2; ++n) acc[a][b][m][n] = (f32x4){0.f, 0.f, 0.f, 0.f};
        cur = nxt; cA = nA; cB = nB; ++ui;
        if constexpr (GATHER) {
#pragma unroll
            for (int i = 0; i < 2; ++i) { vc0[i] = vn0[i]; vc1[i] = vn1[i]; } }
        if constexpr (ALIGN_EPI) { if (wr == 1) PG8_BAR; }
    }
    PG8_WAIT_V(0);
    if constexpr (!ALIGN_EPI) { if (wr == 0) PG8_BAR; }
    PG8_BAR;
#undef PG8_GOFF
#undef PG8_SA
#undef PG8_SB
#undef PG8_STAGE
#undef PG8_LDA
#undef PG8_LDB
#undef PG8_MMA
#undef PG8_WAIT_V
#undef PG8_WAIT_L
#undef PG8_BAR
#undef PG8_SCHED
}

#ifndef REP_GEMM_MASK
#define REP_GEMM_MASK 0
#endif
template <int ID, class Sched, class Epi>
__device__ __forceinline__ void gemm_phase_gather(const Ctx& F, const Gemm g, const Sched& S, const Epi& E, const LAS int* gtab) {
    gemm_mfma<Epi, Sched, true, true, true>(F.lds, F.tid, g, S, E, gtab);
    if constexpr ((REP_GEMM_MASK >> ID) & 1) gemm_mfma<Epi, Sched, true, true, true>(F.lds, F.tid, g, S, E, gtab);
}
template <int ID, class Sched, class Epi>
__device__ __forceinline__ void gemm_phase(const Ctx& F, const Gemm g, const Sched& S, const Epi& E) {
#if USE_MFMA_GEMM
    gemm_mfma<Epi, Sched, true, true>(F.lds, F.tid, g, S, E);
    if constexpr ((REP_GEMM_MASK >> ID) & 1) gemm_mfma<Epi, Sched, true, true>(F.lds, F.tid, g, S, E);
#else
    gemm_naive(F, g, S, E);
#endif
}

template <class ColPtr>
__device__ __forceinline__ void tconv_tile(const ColPtr& cp, int ldw, const float* scale, bf16_t* WT, int K, int k0, int p0, LAS float* scr, int lane) {
    const int pc = (lane & 15) * 4, kq = lane >> 4;
    const float* src = cp(p0 + pc);
#pragma unroll 4
    for (int i = 0; i < 16; ++i) {
        const int kk = 4 * i + kq;
        f32x4 v = {0.f, 0.f, 0.f, 0.f};
        if (src) { v = *(const f32x4*)(src + (size_t)(k0 + kk) * ldw); if (scale) v = v * scale[k0 + kk]; }
        LAS float* d = scr + kk * 65 + pc; d[0] = v[0]; d[1] = v[1]; d[2] = v[2]; d[3] = v[3];
    }
    LDS_WAIT();
    const int c = lane & 7;
#pragma unroll
    for (int j = 0; j < 8; ++j) {
        const int n = (lane >> 3) + 8 * j; const LAS float* s = scr + (8 * c) * 65 + n;
        u32x4 o; o.x = pk2(s[0], s[65]); o.y = pk2(s[2 * 65], s[3 * 65]); o.z = pk2(s[4 * 65], s[5 * 65]); o.w = pk2(s[6 * 65], s[7 * 65]);
        *(u32x4*)(WT + (size_t)(p0 + n) * K + k0 + 8 * c) = o;
    }
    LDS_WAIT();
}
struct CpPlain { const float* W; int ncols; __device__ __forceinline__ const float* operator()(int p) const { return p < ncols ? W + p : nullptr; } };
struct CpQ {
    const float* W;
    __device__ __forceinline__ const float* operator()(int p) const {
        const int h = p / 96, pp = p - h * 96; int lc = pp;
        if (pp >= 64) { const int rp = pp - 64, i = rp & 15; lc = 64 + (i >> 3) * 16 + (i & 7) + ((rp >> 4) ? 8 : 0); }
        return W + h * 96 + lc;
    }
};
struct CpGU {
    const float* Wg; const float* Wu;
    __device__ __forceinline__ const float* operator()(int p) const { const int g32 = p >> 5, w = p & 31; return (w < 16) ? (Wg + g32 * 16 + w) : (Wu + g32 * 16 + (w - 16)); }
};

constexpr int CONV_ITEMS = NEXP * 256 + NEXP * 128, CONV_CH = 4, CONV_CTR0 = 8192;
struct ConvSrc { const float* p; size_t ld; bf16_t* dst; int K; };
__device__ __forceinline__ ConvSrc conv_decode(const Args& a, int l, int idx, int lane) {
    const int pc = (lane & 15) * 4, kq = lane >> 4; ConvSrc r;
    if (idx < NEXP * 256) { const int e = idx >> 8, q = idx & 255, k0 = (q >> 4) * 64, p = (q & 15) * 64 + pc, g32 = p >> 5, w = p & 31; const size_t le = (size_t)l * NEXP + e;
        r.p = ((w < 16) ? (a.w_gate + le * D * FF + g32 * 16 + w) : (a.w_up + le * D * FF + g32 * 16 + (w - 16))) + (size_t)(k0 + kq) * FF; r.ld = FF;
        r.dst = (bf16_t*)(a.ws + WS_WGU) + le * 1024 * D + (size_t)((q & 15) * 64) * D + k0; r.K = D; }
    else { const int i2 = idx - NEXP * 256, e = i2 >> 7, q = i2 & 127, k0 = (q >> 4) * 64, p0 = (q & 15) * 64; const size_t le = (size_t)l * NEXP + e;
        r.p = a.w_down + le * FF * D + (size_t)(k0 + kq) * D + p0 + pc; r.ld = D;
        r.dst = (bf16_t*)(a.ws + WS_WD) + le * D * FF + (size_t)p0 * FF + k0; r.K = FF; }
    return r;
}
__device__ __forceinline__ void conv_load(const ConvSrc& c, f32x4 (&v)[16]) {
#pragma unroll
    for (int i = 0; i < 16; ++i) v[i] = *(const f32x4*)(c.p + (size_t)(4 * i) * c.ld);
}
__device__ __forceinline__ void conv_store(const ConvSrc& c, const f32x4 (&v)[16], LAS float* scr, int lane) {
    const int pc = (lane & 15) * 4, kq = lane >> 4;
#pragma unroll
    for (int i = 0; i < 16; ++i) { LAS float* d = scr + (4 * i + kq) * 65 + pc; d[0] = v[i][0]; d[1] = v[i][1]; d[2] = v[i][2]; d[3] = v[i][3]; }
    LDS_WAIT();
    const int cc = lane & 7;
#pragma unroll
    for (int j = 0; j < 8; ++j) {
        const int n = (lane >> 3) + 8 * j; const LAS float* sp = scr + (8 * cc) * 65 + n;
        u32x4 o; o.x = pk2(sp[0], sp[65]); o.y = pk2(sp[2 * 65], sp[3 * 65]); o.z = pk2(sp[4 * 65], sp[5 * 65]); o.w = pk2(sp[6 * 65], sp[7 * 65]);
        *(u32x4*)(c.dst + (size_t)n * c.K + 8 * cc) = o;
    }
    LDS_WAIT();
}
__device__ __forceinline__ void conv_experts(const Ctx& F, const Args& a, int l, int grabs) {
    unsigned* ctr = (unsigned*)(a.ws + WS_CTL) + CONV_CTR0 + 64 * l;
    LAS float* scr = (LAS float*)(F.lds + F.wave * 18432);
    for (int g = 0; grabs < 0 || g < grabs; ++g) {
        unsigned b0 = 0; if (F.lane == 0) b0 = __hip_atomic_fetch_add(ctr, (unsigned)CONV_CH, __ATOMIC_RELAXED, __HIP_MEMORY_SCOPE_AGENT);
        const int base = __builtin_amdgcn_readfirstlane((int)b0);
        if (base >= CONV_ITEMS) break;
        f32x4 va[16], vb[16];
        ConvSrc c0 = conv_decode(a, l, base, F.lane), c1 = conv_decode(a, l, base + 1, F.lane), c2 = conv_decode(a, l, base + 2, F.lane), c3 = conv_decode(a, l, base + 3, F.lane);
        conv_load(c0, va); conv_load(c1, vb); conv_store(c0, va, scr, F.lane);
        conv_load(c2, va); conv_store(c1, vb, scr, F.lane);
        conv_load(c3, vb); conv_store(c2, va, scr, F.lane);
        conv_store(c3, vb, scr, F.lane);
    }
}

__device__ __forceinline__ void conv_filler(const Ctx& F, KP kp, int l, int grabs) {
    const Args a = ldargs(kp);
    int q = l;
    if (l == 0 || (int)__hip_atomic_load((unsigned*)(a.ws + WS_CTL) + CONV_CTR0 + 64 * l, __ATOMIC_RELAXED, __HIP_MEMORY_SCOPE_AGENT) >= CONV_ITEMS) q = l + 1;
    if (q < NL) conv_experts(F, a, q, grabs);
}
__device__ __forceinline__ void prologue1(const Ctx& F, KP kp) {
    const Args a = ldargs(kp);
    unsigned char* ws = a.ws;
    {
        LAS float* sl = (LAS float*)F.lds;
        float* modp = (float*)(ws + WS_MODP);
        for (int it = F.bk; it < NL * 12 * 4; it += GRID) {
            const int kc = it & 3, nc = (it >> 2) % 12, l = it / 48;
            __syncthreads();
            for (int idx = F.tid; idx < 17 * 256; idx += NTHREADS) {
                const int bb = idx >> 8, k = idx & 255; const float v = (bb < 16) ? a.c[bb * D + kc * 256 + k] : a.c_ctx[kc * 256 + k];
                sl[idx] = v / (1.0f + __expf(-v));
            }
            __syncthreads();
            const int n = nc * 512 + F.tid;
            const float* w = a.w_ada + ((size_t)l * D + kc * 256) * 6144 + n;
            float acc[17];
#pragma unroll
            for (int bb = 0; bb < 17; ++bb) acc[bb] = 0.f;
            for (int k = 0; k < 256; ++k) {
                const float wv = w[(size_t)k * 6144];
#pragma unroll
                for (int bb = 0; bb < 17; ++bb) acc[bb] += sl[bb * 256 + k] * wv;
            }
#pragma unroll
            for (int bb = 0; bb < 17; ++bb) modp[((size_t)(kc * NL + l) * 17 + bb) * 6144 + n] = acc[bb];
        }
        __syncthreads();
    }
    {
        f32x2* t64 = (f32x2*)(ws + WS_TAB64); f32x2* t32 = (f32x2*)(ws + WS_TAB32);
        const int gt = F.bk * NTHREADS + F.tid;
        if (gt < 64 * 16) { const int pos = gt >> 4, f = gt & 15; const float inv = powf(10000.0f, -((float)(2 * f) / 32.0f)); const float ang = (float)pos * inv; t64[gt] = (f32x2){cosf(ang), sinf(ang)}; }
        else if (gt < 64 * 16 + 64 * 8) { const int g2 = gt - 64 * 16, pos = g2 >> 3, f = g2 & 7; const float inv = powf(10000.0f, -((float)(2 * f) / 16.0f)); const float ang = (float)pos * inv; t32[g2] = (f32x2){cosf(ang), sinf(ang)}; }
    }
    {
        bf16_t* wr = (bf16_t*)(ws + WS_WR);
        for (int i = F.bk * NTHREADS + F.tid; i < NL * 48 * D; i += GRID * NTHREADS) {
            const int c = i & 1023, j = (i >> 10) % 48, l = i / (48 * D);
            float wv = 0.f;
            if (j < 4) wv = a.w_rg[((size_t)l * D + c) * 4 + j]; else if (j < 36) wv = a.w_re[((size_t)l * D + c) * 32 + (j - 4)];
            const unsigned h = f2bf(wv); const float rem = wv - __builtin_bit_cast(float, h << 16);
            wr[((size_t)(l * 2 + 0) * 48 + j) * D + c] = (bf16_t)h; wr[((size_t)(l * 2 + 1) * 48 + j) * D + c] = (bf16_t)f2bf(rem);
        }
    }
    {
        LAS float* scr = (LAS float*)(F.lds + F.wave * 18432);
        const int gw = F.vcu * NWAVES + F.wave, NGW = GRID * NWAVES;
        constexpr int I_IN = 16 * 24, I_Q = 6 * 12, I_KV = 4 * 16, I_O = 16 * 16, I_GU = 16 * 16, I_D = 8 * 16;
        constexpr int N_SMALL = NL * (I_IN + I_Q + I_KV + I_O), N_GU = NL * NEXP * I_GU, N_D = NL * NEXP * I_D;
        for (int it = gw; it < N_SMALL; it += NGW) {
            {
                const int l = it / (I_IN + I_Q + I_KV + I_O); int r = it % (I_IN + I_Q + I_KV + I_O);
                if (r < I_IN) { const int kt = r / 24, pt = r % 24; tconv_tile(CpPlain{a.w_in + (size_t)l * D * 1440, 1440}, 1440, nullptr, (bf16_t*)(ws + WS_WIN) + (size_t)l * ZW * D, D, kt * 64, pt * 64, scr, F.lane); continue; }
                r -= I_IN;
                if (r < I_Q) { const int kt = r / 12, pt = r % 12; tconv_tile(CpQ{a.w_q_b + (size_t)l * 384 * QW}, QW, a.g_q_a + l * 384, (bf16_t*)(ws + WS_WQ) + (size_t)l * QW * 384, 384, kt * 64, pt * 64, scr, F.lane); continue; }
                r -= I_Q;
                if (r < I_KV) { const int kt = r / 16, pt = r % 16; tconv_tile(CpPlain{a.w_kv_b + (size_t)l * 256 * KVW, KVW}, KVW, a.g_kv_a + l * 256, (bf16_t*)(ws + WS_WKV) + (size_t)l * KVW * 256, 256, kt * 64, pt * 64, scr, F.lane); continue; }
                r -= I_KV;
                { const int kt = r / 16, pt = r % 16; tconv_tile(CpPlain{a.w_o + (size_t)l * D * D, D}, D, nullptr, (bf16_t*)(ws + WS_WO) + (size_t)l * D * D, D, kt * 64, pt * 64, scr, F.lane); }
            }
        }
        conv_experts(F, a, 0, -1);
    }
}

__device__ __forceinline__ void prologue2(const Ctx& F, KP kp) {
    const Args a = ldargs(kp);
    const float* modp = (const float*)(a.ws + WS_MODP); float* mod = (float*)(a.ws + WS_MOD);
    constexpr int NE = NL * 17 * 6144 / 4;
    for (int i = F.bk * NTHREADS + F.tid; i < NE; i += GRID * NTHREADS) {
        const int e = i * 4, l = e / (17 * 6144), n = e % 6144;
        f32x4 s = *(const f32x4*)(a.b_ada + l * 6144 + n);
#pragma unroll
        for (int kc = 0; kc < 4; ++kc) s = s + *(const f32x4*)(modp + (size_t)kc * NL * 17 * 6144 + e);
        *(f32x4*)(mod + e) = s;
    }
}

__device__ __forceinline__ void row_load(const float* p, int lane, f32x4 (&v)[4]) {
#pragma unroll
    for (int j = 0; j < 4; ++j) v[j] = *(const f32x4*)(p + 4 * lane + 256 * j);
}
__device__ __forceinline__ void row_ln(f32x4 (&v)[4], const float* g, const float* b, int lane) {
    float s = 0.f;
#pragma unroll
    for (int j = 0; j < 4; ++j) s += (v[j][0] + v[j][1]) + (v[j][2] + v[j][3]);
    const float mean = wave_sum(s) * (1.0f / D); float q = 0.f;
#pragma unroll
    for (int j = 0; j < 4; ++j) { v[j] = v[j] - mean; q += (v[j][0] * v[j][0] + v[j][1] * v[j][1]) + (v[j][2] * v[j][2] + v[j][3] * v[j][3]); }
    const float rstd = 1.0f / sqrtf(wave_sum(q) * (1.0f / D) + LN_EPS);
#pragma unroll
    for (int j = 0; j < 4; ++j) { const f32x4 gg = *(const f32x4*)(g + 4 * lane + 256 * j), bv = *(const f32x4*)(b + 4 * lane + 256 * j); v[j] = v[j] * rstd * gg + bv; }
}
__device__ __forceinline__ void row_ln_reg(f32x4 (&v)[4], const f32x4 (&g)[4], const f32x4 (&b)[4]) {
    float s = 0.f;
#pragma unroll
    for (int j = 0; j < 4; ++j) s += (v[j][0] + v[j][1]) + (v[j][2] + v[j][3]);
    const float mean = wave_sum(s) * (1.0f / D); float q = 0.f;
#pragma unroll
    for (int j = 0; j < 4; ++j) { v[j] = v[j] - mean; q += (v[j][0] * v[j][0] + v[j][1] * v[j][1]) + (v[j][2] * v[j][2] + v[j][3] * v[j][3]); }
    const float rstd = 1.0f / sqrtf(wave_sum(q) * (1.0f / D) + LN_EPS);
#pragma unroll
    for (int j = 0; j < 4; ++j) v[j] = v[j] * rstd * g[j] + b[j];
}
__device__ __forceinline__ void row_store_mod_bf16(bf16_t* hrow, const f32x4 (&v)[4], const float* sh, const float* sc, int lane) {
#pragma unroll
    for (int j = 0; j < 4; ++j) {
        const f32x4 s1 = *(const f32x4*)(sc + 4 * lane + 256 * j), s0 = *(const f32x4*)(sh + 4 * lane + 256 * j);
        const f32x4 h = v[j] * (s1 + 1.0f) + s0;
        st_bf4(hrow + 4 * lane + 256 * j, h);
    }
}

__device__ __forceinline__ void prologue3(const Ctx& F, KP kp) {
    const Args a = ldargs(kp);
    const float* modp = (const float*)(a.ws + WS_MODP); bf16_t* H = (bf16_t*)(a.ws + WS_H);
    const int gw = F.vcu * NWAVES + F.wave, NGW = GRID * NWAVES;
    for (int r = gw; r < MT; r += NGW) {
        const float* xr = (r < TL) ? (a.x + (size_t)r * D) : (a.ctx + (size_t)(r - TL) * D);
        const int bb = bb_of(r);
        f32x4 v[4]; row_load(xr, F.lane, v);
#pragma unroll
        for (int j = 0; j < 4; ++j) {
            const int c = 4 * F.lane + 256 * j;
            f32x4 sh = *(const f32x4*)(a.b_ada + c), sc = *(const f32x4*)(a.b_ada + 1024 + c);
#pragma unroll
            for (int kc = 0; kc < 4; ++kc) { const float* mp = modp + ((size_t)(kc * NL + 0) * 17 + bb) * 6144; sh = sh + *(const f32x4*)(mp + c); sc = sc + *(const f32x4*)(mp + 1024 + c); }
            st_bf4(H + (size_t)r * D + c, v[j] * (sc + 1.0f) + sh);
        }
    }
}

__device__ __forceinline__ void phase_split(const Ctx& F, KP kp, int l) {
    const Args a = ldargs(kp);
    unsigned char* ws = a.ws;
    const bf16_t* Z = (const bf16_t*)(ws + WS_Z);
    float* rstdq = (float*)(ws + WS_RSTDQ); float* rstdkv = (float*)(ws + WS_RSTDKV);
    bf16_t* Km = (bf16_t*)(ws + WS_KM); bf16_t* Qg = (bf16_t*)(ws + WS_QG); bf16_t* Kg = (bf16_t*)(ws + WS_KG); bf16_t* Vg = (bf16_t*)(ws + WS_VG);
    LAS f32x2* t64 = (LAS f32x2*)(F.lds + 65536); LAS f32x2* t32 = (LAS f32x2*)(F.lds + 65536 + 8192);
    __syncthreads();
    for (int i = F.tid; i < 64 * 16; i += NTHREADS) t64[i] = ((const f32x2*)(ws + WS_TAB64))[i];
    if (F.tid < 64 * 8) t32[F.tid] = ((const f32x2*)(ws + WS_TAB32))[F.tid];
    __syncthreads();
    LAS float* zs = (LAS float*)(F.lds + F.wave * 8192);
    const int lane = F.lane, gw = F.vcu * NWAVES + F.wave, NGW = GRID * NWAVES;
    const float ggq = a.g_gq[l * 64 + lane], ggk = a.g_gk[l * 64 + lane];
    u32x4 zn[3];
#define P2_LOAD(rr) do { const u32x4* zr_ = (const u32x4*)(Z + (size_t)(rr) * ZW); _Pragma("unroll") for (int j = 0; j < 3; ++j) zn[j] = zr_[lane + 64 * j]; } while (0)
    if (gw < MT) P2_LOAD(gw);
    for (int r = gw; r < MT; r += NGW) {
#pragma unroll
        for (int j = 0; j < 3; ++j) {
            const int ch = lane + 64 * j; const u32x4 w = zn[j];
            LAS float* d = zs + ch * 8;
            *(LAS f32x4*)d = (f32x4){bflo(w.x), bfhi(w.x), bflo(w.y), bfhi(w.y)};
            *(LAS f32x4*)(d + 4) = (f32x4){bflo(w.z), bfhi(w.z), bflo(w.w), bfhi(w.w)};
        }
        if (r + NGW < MT) P2_LOAD(r + NGW);
        LDS_WAIT();
        const bool lat = r < TL; const int s = r & 2047, gr = s >> 6, gc = s & 63, kr = krow_of(r);
        float sq = 0.f, sk = 0.f;
#pragma unroll
        for (int i = 0; i < 6; ++i) { const float v = zs[lane + 64 * i]; sq += v * v; }
#pragma unroll
        for (int i = 0; i < 4; ++i) { const float v = zs[384 + lane + 64 * i]; sk += v * v; }
        sq = wave_sum(sq); sk = wave_sum(sk);
        if (lane == 0) { rstdq[r] = 1.0f / sqrtf(sq * (1.0f / 384.0f) + RMS_EPS); rstdkv[r] = 1.0f / sqrtf(sk * (1.0f / 256.0f) + RMS_EPS); }
        {
            const int d = lane & 31; const float v = zs[640 + d]; const float pv = __shfl_xor(v, 8);
            float o = v;
            if (lat) { const int part = d >> 4, f = d & 7, pos = part ? gc : gr; const f32x2 cs = t32[pos * 8 + f]; o = (d & 8) ? (v * cs.x + pv * cs.y) : (v * cs.x - pv * cs.y); }
            const unsigned short ob = (unsigned short)f2bf(o);
#pragma unroll
            for (int i = 0; i < 4; ++i) { const int h = (lane >> 5) + 2 * i; Km[(size_t)kr * QW + h * 96 + 64 + d] = ob; }
        }
#pragma unroll
        for (int h = 0; h < 8; ++h) {
            const float v = zs[672 + 64 * h + lane]; const float ss = wave_sum(v * v);
            const float y = v * (1.0f / sqrtf(ss * (1.0f / 64.0f) + RMS_EPS)) * ggq; const float py = __shfl_xor(y, 16);
            float o = y;
            if (lat) { const int part = lane >> 5, f = lane & 15, pos = part ? gc : gr; const f32x2 cs = t64[pos * 16 + f]; o = (lane & 16) ? (y * cs.x + py * cs.y) : (y * cs.x - py * cs.y); }
            Qg[(size_t)r * 512 + 64 * h + lane] = (unsigned short)f2bf(o * QSCALE_G);
        }
#pragma unroll
        for (int h = 0; h < 2; ++h) {
            const float v = zs[1184 + 64 * h + lane]; const float ss = wave_sum(v * v);
            const float y = v * (1.0f / sqrtf(ss * (1.0f / 64.0f) + RMS_EPS)) * ggk; const float py = __shfl_xor(y, 16);
            float o = y;
            if (lat) { const int part = lane >> 5, f = lane & 15, pos = part ? gc : gr; const f32x2 cs = t64[pos * 16 + f]; o = (lane & 16) ? (y * cs.x + py * cs.y) : (y * cs.x - py * cs.y); }
            Kg[(size_t)kr * 128 + 64 * h + lane] = (unsigned short)f2bf(o);
            Vg[(size_t)kr * 128 + 64 * h + lane] = (unsigned short)f2bf(zs[1312 + 64 * h + lane]);
        }
        LDS_WAIT();
    }
}

typedef float f32x4m __attribute__((ext_vector_type(4)));
__device__ __forceinline__ void phase_ln1_route(const Ctx& F, KP kp, int l, int ntok) {
    const Args a = ldargs(kp);
    unsigned char* ws = a.ws;
    const bf16_t* Yo = (const bf16_t*)(ws + WS_U); float* XC = (float*)(ws + WS_XC); bf16_t* H = (bf16_t*)(ws + WS_H); bf16_t* Hlo = (bf16_t*)(ws + WS_HLO);
    const float* xinl = (l == 0) ? a.x : a.out; const float* xinc = (l == 0) ? a.ctx : XC;
    const float* mod = (const float*)(ws + WS_MOD) + (size_t)l * 17 * 6144;
    int* toke = (int*)(ws + WS_TOKE); int* tokr = (int*)(ws + WS_TOKR); float* tokw = (float*)(ws + WS_TOKW);
    volatile LAS int* cntl = (volatile LAS int*)(F.lds + MISC_CNT);
    const int lane = F.lane;
    __syncthreads();
    if (F.tid < 32) cntl[F.tid] = 0;
    if (F.tid < 36) ((LAS float*)(F.lds + MISC_LG + 2048))[F.tid] = (F.tid < 4) ? a.b_rg[l * 4 + F.tid] : a.b_re[l * 32 + F.tid - 4];
    const int tpb = ntok / GRID;
    {
        f32x4 nx[4]; u32x2 ny[4]; int i = F.wave;
        f32x4 LG[4], LB[4], GA[4], SH[4], SC[4]; int bbc = -1;
#pragma unroll
        for (int j = 0; j < 4; ++j) { LG[j] = *(const f32x4*)(a.ln1_g + l * D + 4 * lane + 256 * j); LB[j] = *(const f32x4*)(a.ln1_b + l * D + 4 * lane + 256 * j); }
#define P6_LOAD(tt) do { const int t_ = (tt); const float* xp_ = (t_ < TL) ? (xinl + (size_t)t_ * D) : (xinc + (size_t)(t_ - TL) * D); row_load(xp_, lane, nx); \
        _Pragma("unroll") for (int j = 0; j < 4; ++j) ny[j] = *(const u32x2*)(Yo + (size_t)t_ * D + 4 * lane + 256 * j); } while (0)
        if (i < tpb) P6_LOAD(F.bk * tpb + i);
        for (; i < tpb; i += NWAVES) {
            const int t = F.bk * tpb + i, bb = bb_of(t);
            if (bb != bbc) {
                bbc = bb;
#pragma unroll
                for (int j = 0; j < 4; ++j) { const int c = 4 * lane + 256 * j; GA[j] = *(const f32x4*)(mod + (size_t)(bb * 6 + 2) * D + c);
                    SH[j] = *(const f32x4*)(mod + (size_t)(bb * 6 + 3) * D + c); SC[j] = *(const f32x4*)(mod + (size_t)(bb * 6 + 4) * D + c); }
            }
            f32x4 v[4];
#pragma unroll
            for (int j = 0; j < 4; ++j) { const f32x4 y = {bflo(ny[j].x), bfhi(ny[j].x), bflo(ny[j].y), bfhi(ny[j].y)}; v[j] = nx[j] * ALPHA + GA[j] * y; }
            if (i + NWAVES < tpb) P6_LOAD(t + NWAVES);
            row_ln_reg(v, LG, LB);
            float* xr = (t < TL) ? (a.out + (size_t)t * D) : (XC + (size_t)(t - TL) * D);
#pragma unroll
            for (int j = 0; j < 4; ++j) *(f32x4*)(xr + 4 * lane + 256 * j) = v[j];
#pragma unroll
            for (int j = 0; j < 4; ++j) {
                const f32x4 h = v[j] * (SC[j] + 1.0f) + SH[j];
                unsigned hb[4]; f32x4 r;
#pragma unroll
                for (int e = 0; e < 4; ++e) { hb[e] = f2bf(h[e]); r[e] = h[e] - __builtin_bit_cast(float, hb[e] << 16); }
                u32x2 wh; wh.x = hb[0] | (hb[1] << 16); wh.y = hb[2] | (hb[3] << 16);
                *(u32x2*)(H + (size_t)t * D + 4 * lane + 256 * j) = wh;
                st_bf4(Hlo + (size_t)t * D + 4 * lane + 256 * j, r);
            }
        }
    }
#undef P6_LOAD
    asm volatile("s_waitcnt vmcnt(0)" ::: "memory");
    __syncthreads();
    {
        const bf16_t* wrh = (const bf16_t*)(ws + WS_WR) + (size_t)(l * 2) * 48 * D; const bf16_t* wrl = wrh + (size_t)48 * D;
        LAS float* lg = (LAS float*)(F.lds + F.wave * 4096);
        const LAS float* bias = (const LAS float*)(F.lds + MISC_LG + 2048);
        const int fr = lane & 15, fq = lane >> 4;
        for (int g = F.wave; g < tpb / 16; g += NWAVES) {
            const int t0 = F.bk * tpb + g * 16;
            const bf16_t* hh = H + (size_t)(t0 + fr) * D + 8 * fq; const bf16_t* hl = Hlo + (size_t)(t0 + fr) * D + 8 * fq;
            f32x4m acc0 = {0.f, 0.f, 0.f, 0.f}, acc1 = acc0, acc2 = acc0;
#pragma unroll 2
            for (int ks = 0; ks < 32; ++ks) {
                const bf16x8 bh = *(const bf16x8*)(hh + 32 * ks), bl = *(const bf16x8*)(hl + 32 * ks);
                const bf16_t* wp = wrh + (size_t)fr * D + 32 * ks + 8 * fq; const bf16_t* wq = wrl + (size_t)fr * D + 32 * ks + 8 * fq;
                const bf16x8 a0h = *(const bf16x8*)(wp), a1h = *(const bf16x8*)(wp + 16 * D), a2h = *(const bf16x8*)(wp + 32 * D);
                const bf16x8 a0l = *(const bf16x8*)(wq), a1l = *(const bf16x8*)(wq + 16 * D), a2l = *(const bf16x8*)(wq + 32 * D);
                acc0 = __builtin_amdgcn_mfma_f32_16x16x32_bf16(a0h, bh, acc0, 0, 0, 0); acc1 = __builtin_amdgcn_mfma_f32_16x16x32_bf16(a1h, bh, acc1, 0, 0, 0); acc2 = __builtin_amdgcn_mfma_f32_16x16x32_bf16(a2h, bh, acc2, 0, 0, 0);
                acc0 = __builtin_amdgcn_mfma_f32_16x16x32_bf16(a0h, bl, acc0, 0, 0, 0); acc1 = __builtin_amdgcn_mfma_f32_16x16x32_bf16(a1h, bl, acc1, 0, 0, 0); acc2 = __builtin_amdgcn_mfma_f32_16x16x32_bf16(a2h, bl, acc2, 0, 0, 0);
                acc0 = __builtin_amdgcn_mfma_f32_16x16x32_bf16(a0l, bh, acc0, 0, 0, 0); acc1 = __builtin_amdgcn_mfma_f32_16x16x32_bf16(a1l, bh, acc1, 0, 0, 0); acc2 = __builtin_amdgcn_mfma_f32_16x16x32_bf16(a2l, bh, acc2, 0, 0, 0);
            }
#pragma unroll
            for (int r = 0; r < 4; ++r) { lg[fr * 48 + 4 * fq + r] = acc0[r]; lg[fr * 48 + 16 + 4 * fq + r] = acc1[r]; lg[fr * 48 + 32 + 4 * fq + r] = acc2[r]; }
            LDS_WAIT();
            if (lane < 16) {
                const int t = t0 + lane; const LAS float* q = lg + lane * 48;
                float l4[4];
#pragma unroll
                for (int o = 0; o < 4; ++o) l4[o] = q[o] + bias[o];
                int gs = 0; float gm = l4[0];
#pragma unroll
                for (int o = 1; o < 4; ++o) if (l4[o] > gm) { gm = l4[o]; gs = o; }
                float den = 0.f;
#pragma unroll
                for (int o = 0; o < 4; ++o) den += expf(l4[o] - gm);
                const float pstar = 1.0f / den;
                float le[8];
#pragma unroll
                for (int o = 0; o < 8; ++o) le[o] = q[4 + gs * 8 + o] + bias[4 + gs * 8 + o];
                int i1 = 0; float v1 = le[0];
#pragma unroll
                for (int o = 1; o < 8; ++o) if (le[o] > v1) { v1 = le[o]; i1 = o; }
                int i2 = -1; float v2 = -3.0e38f;
#pragma unroll
                for (int o = 0; o < 8; ++o) if (o != i1 && le[o] > v2) { v2 = le[o]; i2 = o; }
                const float ex = expf(v2 - v1), w1 = pstar / (1.0f + ex), w2 = pstar * ex / (1.0f + ex);
                const int e1 = gs * 8 + i1, e2 = gs * 8 + i2;
                const int r1 = __hip_atomic_fetch_add((LAS int*)(F.lds + MISC_CNT) + e1, 1, __ATOMIC_RELAXED, __HIP_MEMORY_SCOPE_WORKGROUP);
                const int r2 = __hip_atomic_fetch_add((LAS int*)(F.lds + MISC_CNT) + e2, 1, __ATOMIC_RELAXED, __HIP_MEMORY_SCOPE_WORKGROUP);
                toke[2 * t] = e1; toke[2 * t + 1] = e2; tokr[2 * t] = r1; tokr[2 * t + 1] = r2; tokw[2 * t] = w1; tokw[2 * t + 1] = w2;
            }
            LDS_WAIT();
        }
    }
    __syncthreads();
    if (F.tid < 32) ((int*)(ws + WS_BLKCNT))[((size_t)l * 256 + F.bk) * 32 + F.tid] = cntl[F.tid];
}

__device__ __forceinline__ void moe_tables(const Ctx& F, KP kp, int l, bool publish) {
    const Args a = ldargs(kp);
    const int* blkcnt = (const int*)(a.ws + WS_BLKCNT) + (size_t)l * 256 * 32;
    volatile LAS int* pa = (volatile LAS int*)(F.lds + MISC_PA); volatile LAS int* pb = (volatile LAS int*)(F.lds + MISC_PB);
    volatile LAS int* tot = (volatile LAS int*)(F.lds + MISC_TOT); volatile LAS int* base = (volatile LAS int*)(F.lds + MISC_BASE); volatile LAS int* poff = (volatile LAS int*)(F.lds + MISC_POFF);
    __syncthreads();
    {
        const int e = F.tid & 31, part = F.tid >> 5; int sa = 0, sb = 0;
        for (int j = 0; j < 16; ++j) { const int b2 = part * 16 + j; const int c = blkcnt[b2 * 32 + e]; sa += c; sb += (b2 < F.bk) ? c : 0; }
        pa[part * 32 + e] = sa; pb[part * 32 + e] = sb;
    }
    __syncthreads();
    if (F.tid < 32) { int sa = 0, sb = 0; for (int p = 0; p < 16; ++p) { sa += pa[p * 32 + F.tid]; sb += pb[p * 32 + F.tid]; } tot[F.tid] = sa; base[F.tid] = sb; }
    __syncthreads();
    if (F.tid == 0) { int o = 0; for (int e = 0; e < 32; ++e) { poff[e] = o; o += (tot[e] + 255) & ~255; } poff[32] = o; }
    __syncthreads();
    if (publish && F.bk == 0 && F.tid < 33) ((int*)(a.ws + WS_MOETAB))[l * 128 + F.tid] = poff[F.tid];
}

__device__ __forceinline__ void phase_dispatch(const Ctx& F, KP kp, int l, int ntok) {
    const Args a = ldargs(kp);
    unsigned char* ws = a.ws;
    if (l > 0) conv_experts(F, a, l, -1);
    moe_tables(F, kp, l, true);
    volatile LAS int* base = (volatile LAS int*)(F.lds + MISC_BASE); volatile LAS int* poff = (volatile LAS int*)(F.lds + MISC_POFF); volatile LAS int* tot = (volatile LAS int*)(F.lds + MISC_TOT);
    const int* toke = (const int*)(ws + WS_TOKE); const int* tokr = (const int*)(ws + WS_TOKR); int* tokp = (int*)(ws + WS_TOKP); int* postok = (int*)(ws + WS_POSTOK);
    const int tpb = ntok / GRID;
    if (F.tid < tpb) {
        const int t = F.bk * tpb + F.tid;
        const int2 e = *(const int2*)(toke + 2 * t), r = *(const int2*)(tokr + 2 * t);
        const int p1 = poff[e.x] + base[e.x] + r.x, p2 = poff[e.y] + base[e.y] + r.y;
        *(int2*)(tokp + 2 * t) = (int2){p1, p2};
        postok[p1] = t; postok[p2] = t;
    }
    { const int idx = F.bk * NTHREADS + F.tid;
      if (idx < poff[32]) { int e = 0;
#pragma unroll
          for (int j = 1; j < 32; ++j) e += (poff[j] <= idx) ? 1 : 0;
          if (idx >= poff[e] + tot[e]) postok[idx] = 0; } }
}

__device__ __forceinline__ void phase_ln2(const Ctx& F, KP kp, int l, int ntok, bool dry = false) {
    const Args a = ldargs(kp);
    unsigned char* ws = a.ws;
    const bf16_t* Ys = (const bf16_t*)(ws + WS_XS); float* XC = (float*)(ws + WS_XC); bf16_t* H = (bf16_t*)(ws + WS_H);
    const float* mod = (const float*)(ws + WS_MOD) + (size_t)l * 17 * 6144;
    const float* modn = (const float*)(ws + WS_MOD) + (size_t)(l + 1 < NL ? l + 1 : l) * 17 * 6144;
    const int* tokp = (const int*)(ws + WS_TOKP); const float* tokw = (const float*)(ws + WS_TOKW);
    const int gw = F.vcu * NWAVES + F.wave, NGW = GRID * NWAVES, lane = F.lane;
    const int per = ntok / NGW, t0 = gw * per, t1 = t0 + per;
    f32x4 LG[4], LB[4], GF[4], SH[4], SC[4];
#pragma unroll
    for (int j = 0; j < 4; ++j) { LG[j] = *(const f32x4*)(a.ln2_g + l * D + 4 * lane + 256 * j); LB[j] = *(const f32x4*)(a.ln2_b + l * D + 4 * lane + 256 * j); }
    int bbc = -1;
    int2 pn = {0, 0}; float2 wn = {0.f, 0.f};
    f32x4 xn[4]; u32x2 yan[4], ybn[4];
#define P10_REC(tt) do { pn = *(const int2*)(tokp + 2 * (tt)); wn = *(const float2*)(tokw + 2 * (tt)); } while (0)
#define P10_ROWS(tt, p_) do { const int t_ = (tt); const float* xp_ = (t_ < TL) ? (a.out + (size_t)t_ * D) : (XC + (size_t)(t_ - TL) * D); row_load(xp_, lane, xn); \
        _Pragma("unroll") for (int j = 0; j < 4; ++j) { yan[j] = *(const u32x2*)(Ys + (size_t)(p_).x * D + 4 * lane + 256 * j); ybn[j] = *(const u32x2*)(Ys + (size_t)(p_).y * D + 4 * lane + 256 * j); } } while (0)
    float2 wc = {0.f, 0.f};
    P10_REC(t0); wc = wn; P10_ROWS(t0, pn); if (t0 + 1 < t1) P10_REC(t0 + 1);
    for (int t = t0; t < t1; ++t) {
        const int bb = bb_of(t);
        if (bb != bbc) {
            bbc = bb;
#pragma unroll
            for (int j = 0; j < 4; ++j) { const int c = 4 * lane + 256 * j; GF[j] = *(const f32x4*)(mod + (size_t)(bb * 6 + 5) * D + c);
                SH[j] = *(const f32x4*)(modn + (size_t)(bb * 6 + 0) * D + c); SC[j] = *(const f32x4*)(modn + (size_t)(bb * 6 + 1) * D + c); }
        }
        f32x4 v[4]; u32x2 ya[4], yb[4];
#pragma unroll
        for (int j = 0; j < 4; ++j) { v[j] = xn[j]; ya[j] = yan[j]; yb[j] = ybn[j]; }
        const float w1 = wc.x, w2 = wc.y;
        if (t + 1 < t1) { wc = wn; P10_ROWS(t + 1, pn); if (t + 2 < t1) P10_REC(t + 2); }
        float* xr = (t < TL) ? (a.out + (size_t)t * D) : (XC + (size_t)(t - TL) * D);
#pragma unroll
        for (int j = 0; j < 4; ++j) {
            const f32x4 y = (f32x4){bflo(ya[j].x), bfhi(ya[j].x), bflo(ya[j].y), bfhi(ya[j].y)} * w1 + (f32x4){bflo(yb[j].x), bfhi(yb[j].x), bflo(yb[j].y), bfhi(yb[j].y)} * w2;
            v[j] = v[j] * ALPHA + GF[j] * y;
        }
        row_ln_reg(v, LG, LB);
        float* xw = dry ? ((float*)(ws + WS_HLO) + (size_t)(t & 16383) * D) : xr;
#pragma unroll
        for (int j = 0; j < 4; ++j) *(f32x4*)(xw + 4 * lane + 256 * j) = v[j];
        if (l + 1 < NL) { bf16_t* hrow = dry ? ((bf16_t*)(ws + WS_O) + (size_t)t * D) : H + (size_t)t * D;
#pragma unroll
            for (int j = 0; j < 4; ++j) st_bf4(hrow + 4 * lane + 256 * j, v[j] * (SC[j] + 1.0f) + SH[j]); }
    }
#undef P10_REC
#undef P10_ROWS
}

template <int QD>
__device__ __forceinline__ void attn_naive_task(const bf16_t* qp, const bf16_t* kp, int kstride, const bf16_t* vp, int vstride, int nkeys, bf16_t* op) {
    u32x4 qv[QD / 8];
#pragma unroll
    for (int i = 0; i < QD / 8; ++i) qv[i] = *(const u32x4*)(qp + 8 * i);
#pragma unroll 1
    for (int half = 0; half < 2; ++half) {
        float o[32];
#pragma unroll
        for (int i = 0; i < 32; ++i) o[i] = 0.f;
        float m = -1.0e30f, lsum = 0.f;
#pragma unroll 1
        for (int j = 0; j < nkeys; ++j) {
            const u32x4* kr = (const u32x4*)(kp + (size_t)j * kstride);
            float s = 0.f;
#pragma unroll
            for (int i = 0; i < QD / 8; ++i) s = dot8(qv[i], kr[i], s);
            if (s > m) { const float al = __builtin_amdgcn_exp2f(m - s); lsum *= al;
#pragma unroll
                for (int i = 0; i < 32; ++i) o[i] *= al;
                m = s; }
            const float p = __builtin_amdgcn_exp2f(s - m); lsum += p;
            const u32x4* vr = (const u32x4*)(vp + (size_t)j * vstride + 32 * half);
#pragma unroll
            for (int i = 0; i < 4; ++i) { const u32x4 w = vr[i];
                o[8 * i + 0] += p * bflo(w.x); o[8 * i + 1] += p * bfhi(w.x); o[8 * i + 2] += p * bflo(w.y); o[8 * i + 3] += p * bfhi(w.y); o[8 * i + 4] += p * bflo(w.z); o[8 * i + 5] += p * bfhi(w.z); o[8 * i + 6] += p * bflo(w.w); o[8 * i + 7] += p * bfhi(w.w); }
        }
        const float rl = 1.0f / lsum;
#pragma unroll
        for (int i = 0; i < 4; ++i) { u32x4 w; w.x = pk2(o[8 * i] * rl, o[8 * i + 1] * rl); w.y = pk2(o[8 * i + 2] * rl, o[8 * i + 3] * rl); w.z = pk2(o[8 * i + 4] * rl, o[8 * i + 5] * rl); w.w = pk2(o[8 * i + 6] * rl, o[8 * i + 7] * rl); *(u32x4*)(op + 32 * half + 8 * i) = w; }
    }
}
__device__ __forceinline__ void phase_attn_naive(const Ctx& F, KP kp, bool last) {
    const Args a = ldargs(kp);
    unsigned char* ws = a.ws;
    const bf16_t* Qm = (const bf16_t*)(ws + WS_QM); const bf16_t* Km = (const bf16_t*)(ws + WS_KM); const bf16_t* Vm = (const bf16_t*)(ws + WS_VM);
    const bf16_t* Qg = (const bf16_t*)(ws + WS_QG); const bf16_t* Kg = (const bf16_t*)(ws + WS_KG); const bf16_t* Vg = (const bf16_t*)(ws + WS_VG);
    bf16_t* O = (bf16_t*)(ws + WS_O);
    const int gw = F.vcu * NWAVES + F.wave, NGW = GRID * NWAVES;
    const int ntask = 8192 + (last ? 0 : 1024);
    for (int T = gw; T < ntask; T += NGW) {
        int b, h16, r, nkeys;
        if (T < 8192) { const int qw = T & 31; h16 = (T >> 5) & 15; b = T >> 9; r = b * SEQ + 64 * qw + F.lane; nkeys = KPB; }
        else { const int T2 = T - 8192, qw = T2 & 3; h16 = (T2 >> 2) & 15; b = T2 >> 6; r = TL + b * CTX + 64 * qw + F.lane; nkeys = CTX; }
        bf16_t* op = O + (size_t)r * D + h16 * 64;
        if (h16 < 8) attn_naive_task<96>(Qm + (size_t)r * QW + h16 * 96, Km + (size_t)b * KPB * QW + h16 * 96, QW, Vm + (size_t)b * KPB * 512 + h16 * 64, 512, nkeys, op);
        else { const int hh = h16 - 8, kvh = hh >> 2; attn_naive_task<64>(Qg + (size_t)r * 512 + hh * 64, Kg + (size_t)b * KPB * 128 + kvh * 64, 128, Vg + (size_t)b * KPB * 128 + kvh * 64, 128, nkeys, op); }
    }
}

typedef float f32x16 __attribute__((ext_vector_type(16)));
typedef short s16x4 __attribute__((ext_vector_type(4)));
__device__ __forceinline__ s16x4 vtr(const LAS unsigned char* p) { return __builtin_bit_cast(s16x4, __builtin_amdgcn_ds_read_tr16_b64_v4i16((LAS s16x4*)p)); }
__device__ __forceinline__ unsigned cvtpk(float lo, float hi) { typedef __bf16 bf2 __attribute__((ext_vector_type(2))); f32x2 v = {lo, hi}; bf2 b = __builtin_convertvector(v, bf2); return __builtin_bit_cast(unsigned, b); }
constexpr float ATT_THR = 6.0f;
constexpr int ATT_KSLOT = 12288, ATT_VSLOT = 8192, ATT_NSLOT = 3, ATT_V0 = ATT_NSLOT * ATT_KSLOT;
__device__ __forceinline__ void att_glds16(const void* gsrc, unsigned lds_dst) { unsigned keep;
    asm volatile("s_mov_b32 %0, m0\n\ts_mov_b32 m0, %2\n\ts_nop 0\n\tglobal_load_lds_dwordx4 %1, off\n\ts_mov_b32 m0, %0" : "=&s"(keep) : "v"(gsrc), "s"(lds_dst) : "memory"); }
#define ATT_WAITBAR(N) asm volatile("s_waitcnt vmcnt(" #N ") lgkmcnt(0)\n\ts_barrier" ::: "memory")
template <int QD>
__device__ __forceinline__ void attn_unit(LAS unsigned char* lds, int tid, const bf16_t* Kb, int kstride, const bf16_t* Vb, int vstride, int ntiles, const bf16_t* qrow, bf16_t* orow) {
    constexpr int NC = QD / 8, NS = QD / 16;
    const int lane = tid & 63, r32 = lane & 31, hi = lane >> 5;
    const int w = __builtin_amdgcn_readfirstlane(tid >> 6);
    const bool three = (NC == 12) && (w < 4);
    const int vp = (NC == 12) ? (w < 4 ? w + 4 : w - 4) : w;
    const bf16_t* ksrcA = Kb + (size_t)lane * kstride + w * 8;
    const bf16_t* ksrcB = Kb + (size_t)lane * kstride + (w + 8) * 8;
    const bf16_t* vsrc = Vb + (size_t)(16 * (vp & 3) + (lane >> 2)) * vstride + (vp >> 2) * 32 + (lane & 3) * 8;
    const size_t kstep = (size_t)64 * kstride, vstep = (size_t)64 * vstride;
    const unsigned lds0 = (unsigned)(size_t)lds;
#define ATT_DMA(t_, slot_) do { \
        att_glds16(ksrcA + (size_t)(t_) * kstep, (unsigned)__builtin_amdgcn_readfirstlane((int)(lds0 + (slot_) * ATT_KSLOT + w * 1024))); \
        if (three) att_glds16(ksrcB + (size_t)(t_) * kstep, (unsigned)__builtin_amdgcn_readfirstlane((int)(lds0 + (slot_) * ATT_KSLOT + (w + 8) * 1024))); \
        att_glds16(vsrc + (size_t)(t_) * vstep, (unsigned)__builtin_amdgcn_readfirstlane((int)(lds0 + ATT_V0 + (slot_) * ATT_VSLOT + vp * 1024))); } while (0)
    ATT_DMA(0, 0);
    if (ntiles > 1) ATT_DMA(1, 1);
    bf16x8 qr[NS];
#pragma unroll
    for (int s = 0; s < NS; ++s) qr[s] = *(const bf16x8*)(qrow + 16 * s + 8 * hi);
    f32x16 o0, o1, negm;
#pragma unroll
    for (int r = 0; r < 16; ++r) { o0[r] = 0.f; o1[r] = 0.f; negm[r] = 0.f; }
    float lsum = 0.f;
    const int kread = hi * 1024 + r32 * 16;
    const int vread = ATT_V0 + ((lane >> 4) & 1) * 32 + (lane & 3) * 8 + (4 * hi + ((lane & 15) >> 2)) * 64;
    if (ntiles > 1) { if (three) ATT_WAITBAR(3); else ATT_WAITBAR(2); } else ATT_WAITBAR(0);
    int slot = 0;
    for (int t = 0; t < ntiles; ++t) {
        const bool issue = (t + 2 < ntiles);
        const int slot2 = (slot >= 1) ? slot - 1 : 2;
        if (issue) ATT_DMA(t + 2, slot2);
        f32x16 p0, p1;
        const LAS unsigned char* kb = lds + slot * ATT_KSLOT + kread;
#pragma unroll
        for (int s = 0; s < NS; ++s) {
            const bf16x8 a0 = *(const LAS bf16x8*)(kb + s * 2048), a1 = *(const LAS bf16x8*)(kb + s * 2048 + 512);
            if (s == 0) { p0 = __builtin_amdgcn_mfma_f32_32x32x16_bf16(a0, qr[0], negm, 0, 0, 0); p1 = __builtin_amdgcn_mfma_f32_32x32x16_bf16(a1, qr[0], negm, 0, 0, 0); }
            else { p0 = __builtin_amdgcn_mfma_f32_32x32x16_bf16(a0, qr[s], p0, 0, 0, 0); p1 = __builtin_amdgcn_mfma_f32_32x32x16_bf16(a1, qr[s], p1, 0, 0, 0); }
        }
        float mx = fmaxf(fmaxf(p0[0], p1[0]), p0[1]);
#pragma unroll
        for (int r = 1; r < 16; ++r) mx = (r == 1) ? fmaxf(mx, p1[1]) : fmaxf(fmaxf(mx, p0[r]), p1[r]);
        { auto rr = __builtin_amdgcn_permlane32_swap(__float_as_uint(mx), __float_as_uint(mx), false, false); mx = fmaxf(__uint_as_float(rr[0]), __uint_as_float(rr[1])); }
        const bool first = (t == 0);
        if (first || __any(mx > ATT_THR)) {
            const float dl = first ? mx : fmaxf(mx, 0.f);
#pragma unroll
            for (int r = 0; r < 16; ++r) { p0[r] -= dl; p1[r] -= dl; negm[r] -= dl; }
            if (!first) { const float f = __builtin_amdgcn_exp2f(-dl); lsum *= f;
#pragma unroll
                for (int r = 0; r < 16; ++r) { o0[r] *= f; o1[r] *= f; } }
        }
        float rs = 0.f;
#pragma unroll
        for (int r = 0; r < 16; ++r) { p0[r] = __builtin_amdgcn_exp2f(p0[r]); p1[r] = __builtin_amdgcn_exp2f(p1[r]); rs += p0[r] + p1[r]; }
        lsum += rs;
        u32x4 w0, w1, w2, w3;
        w0.x = cvtpk(p0[0], p0[1]); w0.y = cvtpk(p0[2], p0[3]); w0.z = cvtpk(p0[4], p0[5]); w0.w = cvtpk(p0[6], p0[7]);
        w1.x = cvtpk(p0[8], p0[9]); w1.y = cvtpk(p0[10], p0[11]); w1.z = cvtpk(p0[12], p0[13]); w1.w = cvtpk(p0[14], p0[15]);
        w2.x = cvtpk(p1[0], p1[1]); w2.y = cvtpk(p1[2], p1[3]); w2.z = cvtpk(p1[4], p1[5]); w2.w = cvtpk(p1[6], p1[7]);
        w3.x = cvtpk(p1[8], p1[9]); w3.y = cvtpk(p1[10], p1[11]); w3.z = cvtpk(p1[12], p1[13]); w3.w = cvtpk(p1[14], p1[15]);
        const bf16x8 pa0 = __builtin_bit_cast(bf16x8, w0), pa1 = __builtin_bit_cast(bf16x8, w1), pa2 = __builtin_bit_cast(bf16x8, w2), pa3 = __builtin_bit_cast(bf16x8, w3);
        const LAS unsigned char* vb = lds + slot * ATT_VSLOT + vread;
#define ATT_VF(d0, ks) ({ const s16x4 lo_ = vtr(vb + (d0) * 4096 + (ks) * 1024), hi_ = vtr(vb + (d0) * 4096 + (ks) * 1024 + 512); (bf16x8){lo_[0], lo_[1], lo_[2], lo_[3], hi_[0], hi_[1], hi_[2], hi_[3]}; })
        o0 = __builtin_amdgcn_mfma_f32_32x32x16_bf16(ATT_VF(0, 0), pa0, o0, 0, 0, 0);
        o1 = __builtin_amdgcn_mfma_f32_32x32x16_bf16(ATT_VF(1, 0), pa0, o1, 0, 0, 0);
        o0 = __builtin_amdgcn_mfma_f32_32x32x16_bf16(ATT_VF(0, 1), pa1, o0, 0, 0, 0);
        o1 = __builtin_amdgcn_mfma_f32_32x32x16_bf16(ATT_VF(1, 1), pa1, o1, 0, 0, 0);
        o0 = __builtin_amdgcn_mfma_f32_32x32x16_bf16(ATT_VF(0, 2), pa2, o0, 0, 0, 0);
        o1 = __builtin_amdgcn_mfma_f32_32x32x16_bf16(ATT_VF(1, 2), pa2, o1, 0, 0, 0);
        o0 = __builtin_amdgcn_mfma_f32_32x32x16_bf16(ATT_VF(0, 3), pa3, o0, 0, 0, 0);
        o1 = __builtin_amdgcn_mfma_f32_32x32x16_bf16(ATT_VF(1, 3), pa3, o1, 0, 0, 0);
#undef ATT_VF
        if (issue) { if (three) ATT_WAITBAR(3); else ATT_WAITBAR(2); } else ATT_WAITBAR(0);
        slot = (slot == 2) ? 0 : slot + 1;
    }
#undef ATT_DMA
    { auto rr = __builtin_amdgcn_permlane32_swap(__float_as_uint(lsum), __float_as_uint(lsum), false, false); lsum = __uint_as_float(rr[0]) + __uint_as_float(rr[1]); }
    const float rl = 1.0f / lsum;
#pragma unroll
    for (int g = 0; g < 4; ++g) {
        u32x2 a, b2;
        a.x = cvtpk(o0[4 * g] * rl, o0[4 * g + 1] * rl); a.y = cvtpk(o0[4 * g + 2] * rl, o0[4 * g + 3] * rl);
        b2.x = cvtpk(o1[4 * g] * rl, o1[4 * g + 1] * rl); b2.y = cvtpk(o1[4 * g + 2] * rl, o1[4 * g + 3] * rl);
        *(u32x2*)(orow + 8 * g + 4 * hi) = a; *(u32x2*)(orow + 32 + 8 * g + 4 * hi) = b2;
    }
}
__device__ __forceinline__ void phase_attn(const Ctx& F, KP kp, bool last) {
    const Args a = ldargs(kp);
    unsigned char* ws = a.ws;
    const bf16_t* Qm = (const bf16_t*)(ws + WS_QM); const bf16_t* Km = (const bf16_t*)(ws + WS_KM); const bf16_t* Vm = (const bf16_t*)(ws + WS_VM);
    const bf16_t* Qg = (const bf16_t*)(ws + WS_QG); const bf16_t* Kg = (const bf16_t*)(ws + WS_KG); const bf16_t* Vg = (const bf16_t*)(ws + WS_VG);
    bf16_t* O = (bf16_t*)(ws + WS_O);
    const int xcd = F.vcu >> 5, cix = F.vcu & 31, r32 = F.lane & 31, w = F.wave;
    const int nun = last ? 8 : 9;
    for (int i = 0; i < nun; ++i) {
        if (i < 8 && (i & 1) == 0) {
            const int pair = xcd * 16 + (i >> 1) * 4 + (cix >> 3), b = pair >> 3, h = pair & 7, qb = cix & 7;
            const int row = b * SEQ + qb * 256 + w * 32 + r32;
            attn_unit<96>(F.lds, F.tid, Km + (size_t)b * KPB * QW + h * 96, QW, Vm + (size_t)b * KPB * 512 + h * 64, 512, KPB / 64, Qm + (size_t)row * QW + h * 96, O + (size_t)row * D + h * 64);
        } else if (i < 8) {
            const int pair = xcd * 4 + (i >> 1), b = pair >> 1, kvh = pair & 1, hh = kvh * 4 + (w >> 1);
            const int row = b * SEQ + cix * 64 + (w & 1) * 32 + r32;
            attn_unit<64>(F.lds, F.tid, Kg + (size_t)b * KPB * 128 + kvh * 64, 128, Vg + (size_t)b * KPB * 128 + kvh * 64, 128, KPB / 64, Qg + (size_t)row * 512 + hh * 64, O + (size_t)row * D + 512 + hh * 64);
        } else if (F.vcu < 128) {
            const int b = F.vcu >> 3, h = F.vcu & 7, row = TL + b * CTX + w * 32 + r32;
            attn_unit<96>(F.lds, F.tid, Km + (size_t)b * KPB * QW + h * 96, QW, Vm + (size_t)b * KPB * 512 + h * 64, 512, CTX / 64, Qm + (size_t)row * QW + h * 96, O + (size_t)row * D + h * 64);
        } else {
            const int idx = F.vcu - 128, b = idx >> 3, kvh = (idx >> 2) & 1, qb = idx & 3, hh = kvh * 4 + (w >> 1);
            const int row = TL + b * CTX + qb * 64 + (w & 1) * 32 + r32;
            attn_unit<64>(F.lds, F.tid, Kg + (size_t)b * KPB * 128 + kvh * 64, 128, Vg + (size_t)b * KPB * 128 + kvh * 64, 128, CTX / 64, Qg + (size_t)row * 512 + hh * 64, O + (size_t)row * D + 512 + hh * 64);
        }
    }
}
__global__ void __launch_bounds__(NTHREADS, 2) fwd_kernel(Args a_unused) {
    extern __shared__ __attribute__((aligned(16))) unsigned char lds_raw[];
    const KP kp = (KP)__builtin_amdgcn_kernarg_segment_ptr();
    Ctx F;
    F.lds = (LAS unsigned char*)lds_raw;
    F.tid = threadIdx.x; F.lane = F.tid & 63; F.wave = __builtin_amdgcn_readfirstlane(F.tid >> 6);
    F.bk = blockIdx.x; F.vcu = (F.bk & 7) * (GRID / 8) + (F.bk >> 3);
    if (F.tid < 4) ((volatile LAS unsigned*)(F.lds + MISC_BAR))[F.tid] = 0u;
    __syncthreads();
    { const Args a = ldargs(kp); (void)xcd_barrier_post((unsigned*)(a.ws + WS_CTL), (volatile LAS unsigned*)(F.lds + MISC_BAR), F.tid == 0); }
#define FRESH() do { int ln_; asm volatile("v_mbcnt_lo_u32_b32 %0, -1, 0\n\tv_mbcnt_hi_u32_b32 %0, -1, %0" : "=v"(ln_)); F.lane = ln_; F.tid = F.wave * 64 + ln_; F.bk = blockIdx.x; F.vcu = (F.bk & 7) * (GRID / 8) + (F.bk >> 3); } while (0)
#define GRID_BAR() do { XcdBarrier b_; { const Args a_ = ldargs(kp); b_.bar = (unsigned*)(a_.ws + WS_CTL); } b_.x = xb_xcc_id(); b_.st = (volatile LAS unsigned*)(F.lds + MISC_BAR); xcd_barrier(b_, F.tid == 0); } while (0)

    for (int rep_ = 0; rep_ < REP_PRO; ++rep_) prologue1(F, kp);
    GRID_BAR(); FRESH();
    prologue2(F, kp);
    prologue3(F, kp);
    GRID_BAR(); FRESH();

    for (int l = 0; l < NL; ++l) {
        const bool last = (l == NL - 1);
        const int ntok = last ? TL : MT;
        { const Args a = ldargs(kp); unsigned char* ws = a.ws;
          Gemm g{(const bf16_t*)(ws + WS_H), D, (const bf16_t*)(ws + WS_WIN) + (size_t)l * ZW * D, D}; StaticOrder S; S.init(MT, ZW, GRID, F.bk); EpiZ E{(bf16_t*)(ws + WS_Z)}; gemm_phase<0>(F, g, S, E); }
        if (F.bk >= (MT / 256) * (ZW / 256) - 3 * GRID) conv_filler(F, kp, l, FILL_P1);
        GRID_BAR(); FRESH();
        for (int rep_ = 0; rep_ < REP_P2; ++rep_) phase_split(F, kp, l);
        GRID_BAR(); FRESH();
        { const Args a = ldargs(kp); unsigned char* ws = a.ws;
          Gemm g{(const bf16_t*)(ws + WS_Z), ZW, (const bf16_t*)(ws + WS_WQ) + (size_t)l * QW * 384, 384}; StaticOrder S; S.init(MT, QW, GRID, F.bk);
          EpiQ E{(bf16_t*)(ws + WS_QM), (const float*)(ws + WS_RSTDQ), (const f32x2*)(ws + WS_TAB32)}; gemm_phase<1>(F, g, S, E); }
        FRESH();
        { const Args a = ldargs(kp); unsigned char* ws = a.ws;
          Gemm g{(const bf16_t*)(ws + WS_Z) + 384, ZW, (const bf16_t*)(ws + WS_WKV) + (size_t)l * KVW * 256, 256}; StaticOrder S; S.init(MT, KVW, GRID, (F.bk + 80) & 255);
          EpiKV E{(bf16_t*)(ws + WS_KM), (bf16_t*)(ws + WS_VM), (const float*)(ws + WS_RSTDKV)}; gemm_phase<2>(F, g, S, E); }
        GRID_BAR(); FRESH();
#if USE_MFMA_ATTN
        for (int rep_ = 0; rep_ < REP_ATTN; ++rep_) phase_attn(F, kp, last);
#else
        phase_attn_naive(F, kp, last);
#endif
        GRID_BAR(); FRESH();
        { const Args a = ldargs(kp); unsigned char* ws = a.ws;
          Gemm g{(const bf16_t*)(ws + WS_O), D, (const bf16_t*)(ws + WS_WO) + (size_t)l * D * D, D}; StaticOrder S; S.init(ntok, D, GRID, F.bk);
          EpiYo E{(bf16_t*)(ws + WS_U)}; gemm_phase<3>(F, g, S, E); }
        if (!last && F.bk >= (MT / 256) * (D / 256) - 2 * GRID) conv_filler(F, kp, l, FILL_P5);
        GRID_BAR(); FRESH();
        for (int rep_ = 0; rep_ < REP_P6; ++rep_) phase_ln1_route(F, kp, l, ntok);
        GRID_BAR(); FRESH();
        for (int rep_ = 0; rep_ < REP_P7; ++rep_) phase_dispatch(F, kp, l, ntok);
        GRID_BAR(); FRESH();
        { const Args a = ldargs(kp); unsigned char* ws = a.ws;
          Gemm g{(const bf16_t*)(ws + WS_H), D, (const bf16_t*)(ws + WS_WGU) + (size_t)l * NEXP * 1024 * D, D}; GroupedOrder S; S.init((const volatile LAS int*)(F.lds + MISC_POFF), GRID, F.vcu);
          LAS int* gt = (LAS int*)(F.lds + STAGE_BYTES);
          { const int* postok = (const int*)(ws + WS_POSTOK); Unit u; for (int i = 0; i < 16 && S.next(i, u); ++i) if (F.tid < 256) gt[i * 256 + F.tid] = postok[u.pm * 256 + F.tid]; }
          __syncthreads();
          EpiAct E{(bf16_t*)(ws + WS_ACT)}; gemm_phase_gather<4>(F, g, S, E, gt); }
        GRID_BAR(); FRESH();
        { const Args a = ldargs(kp); unsigned char* ws = a.ws;
          Gemm g{(const bf16_t*)(ws + WS_ACT), FF, (const bf16_t*)(ws + WS_WD) + (size_t)l * NEXP * D * FF, FF}; GroupedOrder S; S.init((const volatile LAS int*)(F.lds + MISC_POFF), GRID, F.vcu);
          EpiY E{(bf16_t*)(ws + WS_XS)}; gemm_phase<5>(F, g, S, E); }
        GRID_BAR(); FRESH();
        for (int rep_ = 0; rep_ < REP_P10; ++rep_) phase_ln2(F, kp, l, ntok, true);
        phase_ln2(F, kp, l, ntok);
        GRID_BAR(); FRESH();
    }
}

extern "C" void kernel_launch(void* const* d_in, const int* in_sizes, int n_in, void* d_out, int out_size, void* d_ws, size_t ws_size, hipStream_t stream) {
    static int grid = 0;
    if (grid == 0) {
        if (n_in != 25 || out_size != TL * D || ws_size < WS_END) { fprintf(stderr, "kernel_launch: unexpected shapes (n_in %d out %d ws %zu need %zu)\n", n_in, out_size, ws_size, (size_t)WS_END); grid = -1; return; }
        int dev = 0, cus = 0, per_cu = 0;
        if (hipGetDevice(&dev) != hipSuccess || hipDeviceGetAttribute(&cus, hipDeviceAttributeMultiprocessorCount, dev) != hipSuccess) { grid = -1; return; }
        if (hipFuncSetAttribute((const void*)fwd_kernel, hipFuncAttributeMaxDynamicSharedMemorySize, LDS_BYTES) != hipSuccess) { fprintf(stderr, "kernel_launch: hipFuncSetAttribute failed\n"); grid = -1; return; }
        if (hipOccupancyMaxActiveBlocksPerMultiprocessor(&per_cu, (const void*)fwd_kernel, NTHREADS, LDS_BYTES) != hipSuccess || per_cu < 1) { fprintf(stderr, "kernel_launch: occupancy query says %d\n", per_cu); }
        (void)hipGetLastError();
        grid = (cus == 256) ? 256 : -1;
        if (grid < 0) { fprintf(stderr, "kernel_launch: need a 256-CU device, got %d\n", cus); return; }
    }
    if (grid < 0) return;
    if (hipMemsetAsync((char*)d_ws + WS_CTL, 0, CTL_BYTES, stream) != hipSuccess) return;
    Args a{};
    a.x = (const float*)d_in[0]; a.c = (const float*)d_in[1]; a.ctx = (const float*)d_in[2]; a.c_ctx = (const float*)d_in[3]; a.w_ada = (const float*)d_in[4]; a.b_ada = (const float*)d_in[5];
    a.w_in = (const float*)d_in[6]; a.g_q_a = (const float*)d_in[7]; a.w_q_b = (const float*)d_in[8]; a.g_kv_a = (const float*)d_in[9]; a.w_kv_b = (const float*)d_in[10];
    a.g_gq = (const float*)d_in[11]; a.g_gk = (const float*)d_in[12]; a.w_o = (const float*)d_in[13]; a.ln1_g = (const float*)d_in[14]; a.ln1_b = (const float*)d_in[15];
    a.w_rg = (const float*)d_in[16]; a.b_rg = (const float*)d_in[17]; a.w_re = (const float*)d_in[18]; a.b_re = (const float*)d_in[19];
    a.w_gate = (const float*)d_in[20]; a.w_up = (const float*)d_in[21]; a.w_down = (const float*)d_in[22]; a.ln2_g = (const float*)d_in[23]; a.ln2_b = (const float*)d_in[24];
    a.out = (float*)d_out; a.ws = (unsigned char*)d_ws;
    hipLaunchKernelGGL(fwd_kernel, dim3(grid), dim3(NTHREADS), LDS_BYTES, stream, a);
}
```

```cpp
#include <hip/hip_runtime.h>
#include <cstdint>
#include <cstdio>

#ifndef REP_ATTN
#define REP_ATTN 1
#endif
#ifndef REP_GEMM
#define REP_GEMM 1
#endif
#ifndef REP_PRO
#define REP_PRO 1
#endif
#ifndef REP_THIN
#define REP_THIN 1
#endif
#ifndef REP_P2
#define REP_P2 1
#endif
#ifndef REP_P7
#define REP_P7 1
#endif
#ifndef REP_P6
#define REP_P6 1
#endif
#ifndef REP_P10
#define REP_P10 0
#endif
#ifndef FILL_P1
#define FILL_P1 3
#endif
#ifndef FILL_P5
#define FILL_P5 3
#endif
#ifndef USE_MFMA_GEMM
#define USE_MFMA_GEMM 1
#endif
#ifndef USE_MFMA_ATTN
#define USE_MFMA_ATTN 1
#endif

#define GAS __attribute__((address_space(1)))
#define LAS __attribute__((address_space(3)))
typedef unsigned short bf16_t;
typedef float f32x4 __attribute__((ext_vector_type(4)));
typedef float f32x2 __attribute__((ext_vector_type(2)));
typedef unsigned u32x4 __attribute__((ext_vector_type(4)));
typedef unsigned u32x2 __attribute__((ext_vector_type(2)));
typedef short bf16x8 __attribute__((ext_vector_type(8)));

constexpr int D = 1024, NB = 16, SEQ = 2048, CTX = 256, NL = 4;
constexpr int TL = NB * SEQ, TC = NB * CTX, MT = TL + TC;
constexpr int KPB = CTX + SEQ;
constexpr int ZW = 1536;
constexpr int QW = 768, KVW = 1024;
constexpr int NEXP = 32, FF = 512;
constexpr int XS_ROWS = 81920;
constexpr float ALPHA = 1.6817928305074290f;
constexpr float LOG2E = 1.4426950408889634f;
constexpr float QSCALE_M = 0.10206207261596575f * LOG2E;
constexpr float QSCALE_G = 0.125f * LOG2E;
constexpr float RMS_EPS = 1e-6f, LN_EPS = 1e-5f;
constexpr int NWAVES = 8, NTHREADS = 512, GRID = 256;

constexpr size_t al256(size_t x) { return (x + 255) & ~(size_t)255; }
constexpr size_t WS_CTL = 0, CTL_BYTES = 65536;
constexpr size_t WS_BLKCNT = WS_CTL + CTL_BYTES;
constexpr size_t WS_MOETAB = WS_BLKCNT + (size_t)NL * 256 * 32 * 4;
constexpr size_t WS_MOD = WS_MOETAB + (size_t)NL * 128 * 4;
constexpr size_t WS_MODP = WS_MOD + (size_t)NL * 17 * 6144 * 4;
constexpr size_t WS_TAB64 = WS_MODP + (size_t)4 * NL * 17 * 6144 * 4;
constexpr size_t WS_TAB32 = WS_TAB64 + 64 * 16 * 8;
constexpr size_t WS_RSTDQ = WS_TAB32 + 64 * 8 * 8;
constexpr size_t WS_RSTDKV = WS_RSTDQ + (size_t)MT * 4;
constexpr size_t WS_TOKE = WS_RSTDKV + (size_t)MT * 4;
constexpr size_t WS_TOKR = WS_TOKE + (size_t)MT * 8;
constexpr size_t WS_TOKP = WS_TOKR + (size_t)MT * 8;
constexpr size_t WS_TOKW = WS_TOKP + (size_t)MT * 8;
constexpr size_t WS_WIN = al256(WS_TOKW + (size_t)MT * 8);
constexpr size_t WS_WQ = WS_WIN + (size_t)NL * ZW * D * 2;
constexpr size_t WS_WKV = WS_WQ + (size_t)NL * QW * 384 * 2;
constexpr size_t WS_WO = WS_WKV + (size_t)NL * KVW * 256 * 2;
constexpr size_t WS_WGU = WS_WO + (size_t)NL * D * D * 2;
constexpr size_t WS_WD = WS_WGU + (size_t)NL * NEXP * 1024 * D * 2;
constexpr size_t WS_XC = WS_WD + (size_t)NL * NEXP * D * FF * 2;
constexpr size_t WS_H = WS_XC + (size_t)TC * D * 4;
constexpr size_t WS_B = WS_H + (size_t)MT * D * 2;
constexpr size_t WS_Z = WS_B;
constexpr size_t WS_QM = WS_Z + (size_t)MT * ZW * 2;
constexpr size_t WS_KM = WS_QM + (size_t)MT * QW * 2;
constexpr size_t WS_VM = WS_KM + (size_t)MT * QW * 2;
constexpr size_t WS_QG = WS_VM + (size_t)MT * 512 * 2;
constexpr size_t WS_KG = WS_QG + (size_t)MT * 512 * 2;
constexpr size_t WS_VG = WS_KG + (size_t)MT * 128 * 2;
constexpr size_t WS_O = WS_VG + (size_t)MT * 128 * 2;
constexpr size_t WS_BEND = WS_O + (size_t)MT * D * 2;
constexpr size_t WS_U = WS_B;
constexpr size_t WS_XS = WS_B;
constexpr size_t WS_ACT = WS_XS + (size_t)XS_ROWS * D * 2;
constexpr size_t WS_HLO = WS_BEND;
constexpr size_t WS_WR = WS_HLO + (size_t)MT * D * 2;
constexpr size_t WS_POSTOK = WS_WR + (size_t)NL * 2 * 48 * D * 2;
constexpr size_t WS_END = WS_POSTOK + (size_t)XS_ROWS * 4;
static_assert(WS_U + (size_t)MT * D * 4 <= WS_KM, "U must fit in Z+QM");
static_assert(WS_ACT + (size_t)XS_ROWS * FF * 2 <= WS_BEND, "MoE buffers must fit in region B");
static_assert(WS_END < (size_t)1100 * 1000 * 1000, "workspace map too large");

constexpr int LDS_BYTES = 163840;
constexpr int BIG_BYTES = 147456;
constexpr int MISC_OFF = BIG_BYTES;
constexpr int MISC_BAR = MISC_OFF;
constexpr int MISC_CNT = MISC_OFF + 64;
constexpr int MISC_POFF = MISC_OFF + 256;
constexpr int MISC_TOT = MISC_OFF + 512;
constexpr int MISC_BASE = MISC_OFF + 768;
constexpr int MISC_PA = MISC_OFF + 1024;
constexpr int MISC_PB = MISC_OFF + 1024 + 2048;
constexpr int MISC_LG = MISC_OFF + 8192;

#define LDS_WAIT() asm volatile("s_waitcnt lgkmcnt(0)" ::: "memory")
__device__ __forceinline__ unsigned f2bf(float f) { unsigned u = __builtin_bit_cast(unsigned, f); return (u + 0x7fffu + ((u >> 16) & 1u)) >> 16; }
__device__ __forceinline__ unsigned pk2(float lo, float hi) { typedef __bf16 bf2_t __attribute__((ext_vector_type(2))); f32x2 v = {lo, hi}; bf2_t b = __builtin_convertvector(v, bf2_t); return __builtin_bit_cast(unsigned, b); }
__device__ __forceinline__ float bflo(unsigned w) { return __builtin_bit_cast(float, w << 16); }
__device__ __forceinline__ float bfhi(unsigned w) { return __builtin_bit_cast(float, w & 0xffff0000u); }
__device__ __forceinline__ float wave_sum(float v) {
#pragma unroll
    for (int o = 1; o < 64; o <<= 1) v += __shfl_xor(v, o);
    return v;
}
__device__ __forceinline__ int krow_of(int r) { return r < TL ? (r >> 11) * KPB + CTX + (r & 2047) : ((r - TL) >> 8) * KPB + ((r - TL) & 255); }
__device__ __forceinline__ int bb_of(int r) { return r < TL ? (r >> 11) : 16; }

#define XB_TMO      128
#define XB_XCNT(j)  (256  + 64 * (j))
#define XB_XSUB(j)  (1280 + 64 * (j))
#define XB_XGEN(j)  (2304 + 64 * (j))
#define XB_TOP      3328
#define XB_TOPGEN   3392
#define XCD_BAR_WORDS 3456
#define XB_SPIN_CAP (1u << 18)
__device__ __forceinline__ unsigned xb_ld(unsigned* p)              { return __hip_atomic_load(p, __ATOMIC_RELAXED, __HIP_MEMORY_SCOPE_AGENT); }
__device__ __forceinline__ unsigned xb_add(unsigned* p, unsigned v) { return __hip_atomic_fetch_add(p, v, __ATOMIC_RELAXED, __HIP_MEMORY_SCOPE_AGENT); }
__device__ __forceinline__ unsigned xb_xcc_id() { return (unsigned)__builtin_amdgcn_s_getreg((3 << 11) | 20) & 0xFu; }
#define XB_SPIN(cond, bar) do { unsigned _sp = 0; while (cond) { __builtin_amdgcn_s_sleep(1); \
    if ((++_sp & 255u) == 0u) { if (xb_ld(&(bar)[XB_TMO])) break; if (_sp > XB_SPIN_CAP) { atomicAdd(&(bar)[XB_TMO], 1u); break; } } } } while (0)
struct XcdBarrier { unsigned* bar; unsigned x; volatile LAS unsigned* st; };
__device__ __forceinline__ XcdBarrier xcd_barrier_post(unsigned* bar, volatile LAS unsigned* st, const bool leader) {
    XcdBarrier b; b.bar = bar; b.x = xb_xcc_id(); b.st = st;
    if (leader) (void)xb_add(&bar[XB_XCNT(b.x)], 1u);
    return b;
}
__device__ __forceinline__ void xcd_barrier_complete(unsigned* bar, unsigned x, unsigned& nloc, unsigned& nx) {
    const unsigned G = gridDim.x * gridDim.y * gridDim.z;
    unsigned sum, cnt, mine, sp = 0u;
    for (;;) {
        sum = 0u; cnt = 0u; mine = 0u;
#pragma unroll
        for (unsigned j = 0; j < 16; ++j) { const unsigned c = xb_ld(&bar[XB_XCNT(j)]); sum += c; cnt += (c > 0u) ? 1u : 0u; mine = (j == x) ? c : mine; }
        if (sum == G) break;
        __builtin_amdgcn_s_sleep(1);
        if ((++sp & 255u) == 0u) { if (xb_ld(&bar[XB_TMO])) break; if (sp > XB_SPIN_CAP) { atomicAdd(&bar[XB_TMO], 1u); break; } }
    }
    nloc = mine > 0u ? mine : 1u; nx = cnt > 0u ? cnt : 1u;
}
__device__ __forceinline__ void xcd_barrier(const XcdBarrier& b, const bool leader) {
    asm volatile("s_waitcnt vmcnt(0)" ::: "memory");
    __syncthreads();
    if (leader) {
        unsigned* bar = b.bar;
        __builtin_amdgcn_s_waitcnt(0);
        unsigned nloc = b.st[0], nx = b.st[1];
        if (nloc == 0u) { xcd_barrier_complete(bar, b.x, nloc, nx); b.st[0] = nloc; b.st[1] = nx; }
        const unsigned old = xb_add(&bar[XB_XSUB(b.x)], 1u);
        const unsigned gen = old / nloc;
        if (old + 1u == (gen + 1u) * nloc) {
            __builtin_amdgcn_fence(__ATOMIC_RELEASE, "agent");
            asm volatile("s_waitcnt vmcnt(0)" ::: "memory");
            const unsigned og = xb_add(&bar[XB_TOP], 1u);
            const unsigned tg = og / nx;
            if (og + 1u == (tg + 1u) * nx) xb_add(&bar[XB_TOPGEN], 1u);
            else XB_SPIN(xb_ld(&bar[XB_TOPGEN]) == tg, bar);
            __builtin_amdgcn_fence(__ATOMIC_ACQUIRE, "agent");
            xb_add(&bar[XB_XGEN(b.x)], 1u);
            asm volatile("s_waitcnt vmcnt(0)" ::: "memory");
        } else {
            XB_SPIN(xb_ld(&bar[XB_XGEN(b.x)]) == gen, bar);
            __builtin_amdgcn_fence(__ATOMIC_ACQUIRE, "agent");
            asm volatile("s_waitcnt vmcnt(0)" ::: "memory");
        }
    }
    __syncthreads();
}

struct Args {
    const float* x; const float* c; const float* ctx; const float* c_ctx; const float* w_ada; const float* b_ada; const float* w_in;
    const float* g_q_a; const float* w_q_b; const float* g_kv_a; const float* w_kv_b; const float* g_gq; const float* g_gk; const float* w_o;
    const float* ln1_g; const float* ln1_b; const float* w_rg; const float* b_rg; const float* w_re; const float* b_re;
    const float* w_gate; const float* w_up; const float* w_down; const float* ln2_g; const float* ln2_b;
    float* out; unsigned char* ws;
};

typedef const __attribute__((address_space(4))) Args* KP;
__device__ __forceinline__ Args ldargs(KP p) {
#if defined(__HIP_DEVICE_COMPILE__)
    asm volatile("" : "+s"(p)); return *p;
#else
    return Args{};
#endif
}

struct Ctx {
    LAS unsigned char* lds;
    int tid, lane, wave, vcu, bk;
};

struct Unit { int pm, pn; };
constexpr int BM = 256, NXCD = 8, WGM = 8;
struct StaticOrder {
    int nM, nN, nwg, G, c;
    __device__ void init(int M, int N, int G_, int c_) { nM = M / BM; nN = N / BM; nwg = nM * nN; G = G_; c = c_; }
    __device__ bool next(int i, Unit& u) const {
        const long L = (long)i * G + c; if (L >= nwg) return false;
        int wgid = (int)L; { const int q = nwg / NXCD, r = nwg % NXCD, xcd = wgid % NXCD, off = wgid / NXCD; wgid = (xcd < r ? xcd * (q + 1) : r * (q + 1) + (xcd - r) * q) + off; }
        const int nig = WGM * nN, gid = wgid / nig, fm = gid * WGM, gsz = (nM - fm) < WGM ? (nM - fm) : WGM;
        u.pm = fm + ((wgid % nig) % gsz); u.pn = (wgid % nig) / gsz; return true;
    }
    __device__ __forceinline__ void a_ready(const Unit&) const {}
    __device__ __forceinline__ void done(const Unit&) const {}
};
struct GroupedOrder {
    const volatile LAS int* poff; int nunits, G, c;
    __device__ void init(const volatile LAS int* poff_, int G_, int c_) { poff = poff_; nunits = (poff_[32] >> 8) * 4; G = G_; c = c_; }
    __device__ bool next(int i, Unit& u) const {
        const int L = i * G + c; if (L >= nunits) return false;
        const int rt = L >> 2, r0 = rt << 8; int e = 0;
#pragma unroll
        for (int j = 1; j < 32; ++j) e += (poff[j] <= r0) ? 1 : 0;
        u.pm = rt; u.pn = e * 4 + (L & 3); return true;
    }
    __device__ __forceinline__ void a_ready(const Unit&) const {}
    __device__ __forceinline__ void done(const Unit&) const {}
};

__device__ __forceinline__ void st_bf4(bf16_t* p, f32x4 v) { u32x2 w; w.x = pk2(v[0], v[1]); w.y = pk2(v[2], v[3]); *(u32x2*)p = w; }
struct EpiZ {
    bf16_t* Z;
    __device__ __forceinline__ void tile32(int row, int col, int fq, f32x4 v0, f32x4 v1) const {
        bf16_t* p = Z + (size_t)row * ZW + col + 4 * fq; st_bf4(p, v0); st_bf4(p + 16, v1);
    }
};
struct EpiQ {
    bf16_t* Qm; const float* rstd; const f32x2* tab32;
    __device__ __forceinline__ void tile32(int row, int col, int fq, f32x4 v0, f32x4 v1) const {
        const int h = col / 96, gi = (col - h * 96) >> 5;
        const float rs = rstd[row] * QSCALE_M;
        v0 = v0 * rs; v1 = v1 * rs;
        bf16_t* base = Qm + (size_t)row * QW + h * 96;
        if (gi < 2) { bf16_t* p = base + gi * 32 + 4 * fq; st_bf4(p, v0); st_bf4(p + 16, v1); }
        else {
            const int part = fq >> 1, f0 = (4 * fq) & 7;
            f32x4 o1 = v0, o2 = v1;
            if (row < TL) {
                const int s = row & 2047, pos = part ? (s & 63) : (s >> 6);
#pragma unroll
                for (int j = 0; j < 4; ++j) { const f32x2 cs = tab32[pos * 8 + f0 + j]; o1[j] = v0[j] * cs.x - v1[j] * cs.y; o2[j] = v1[j] * cs.x + v0[j] * cs.y; }
            }
            bf16_t* p = base + 64 + part * 16 + f0; st_bf4(p, o1); st_bf4(p + 8, o2);
        }
    }
};
struct EpiKV {
    bf16_t* Km; bf16_t* Vm; const float* rstd;
    __device__ __forceinline__ void tile32(int row, int col, int fq, f32x4 v0, f32x4 v1) const {
        const int h = col >> 7, w = col & 127; const float rs = rstd[row]; const int kr = krow_of(row);
        v0 = v0 * rs; v1 = v1 * rs;
        bf16_t* p = (w < 64) ? (Km + (size_t)kr * QW + h * 96 + w + 4 * fq) : (Vm + (size_t)kr * 512 + h * 64 + (w - 64) + 4 * fq);
        st_bf4(p, v0); st_bf4(p + 16, v1);
    }
};
struct EpiU {
    float* U; const float* xl; const float* xc; const float* mod_l;
    int gate;
    __device__ __forceinline__ void tile32(int row, int col, int fq, f32x4 v0, f32x4 v1) const {
        const float* xr = (row < TL) ? (xl + (size_t)row * D) : (xc + (size_t)(row - TL) * D);
        const float* g = mod_l + (size_t)(bb_of(row) * 6 + gate) * D;
        const int c0 = col + 4 * fq;
        const f32x4 x0 = *(const f32x4*)(xr + c0), x1 = *(const f32x4*)(xr + c0 + 16), g0 = *(const f32x4*)(g + c0), g1 = *(const f32x4*)(g + c0 + 16);
        float* u = U + (size_t)row * D + c0;
        *(f32x4*)u = x0 * ALPHA + g0 * v0; *(f32x4*)(u + 16) = x1 * ALPHA + g1 * v1;
    }
};
__device__ __forceinline__ float silu_f(float x) { return x * __builtin_amdgcn_rcpf(1.0f + __builtin_amdgcn_exp2f(-x * LOG2E)); }
struct EpiAct {
    bf16_t* Act;
    __device__ __forceinline__ void tile32(int row, int col, int fq, f32x4 v0, f32x4 v1) const {
        const int f0 = ((col & 1023) >> 1) + 4 * fq; f32x4 a;
#pragma unroll
        for (int j = 0; j < 4; ++j) a[j] = silu_f(v0[j]) * v1[j];
        st_bf4(Act + (size_t)row * FF + f0, a);
    }
};
struct EpiYo {
    bf16_t* Y;
    __device__ __forceinline__ void tile32(int row, int col, int fq, f32x4 v0, f32x4 v1) const {
        bf16_t* p = Y + (size_t)row * D + col + 4 * fq; st_bf4(p, v0); st_bf4(p + 16, v1);
    }
};
struct EpiY {
    bf16_t* Y;
    __device__ __forceinline__ void tile32(int row, int col, int fq, f32x4 v0, f32x4 v1) const {
        bf16_t* p = Y + (size_t)row * D + (col & 1023) + 4 * fq; st_bf4(p, v0); st_bf4(p + 16, v1);
    }
};

struct Gemm { const bf16_t* A; int lda; const bf16_t* Bt; int K; };
__device__ __forceinline__ float dot8(u32x4 a, u32x4 b, float acc) {
#pragma unroll
    for (int i = 0; i < 4; ++i) { acc += bflo(a[i]) * bflo(b[i]); acc += bfhi(a[i]) * bfhi(b[i]); }
    return acc;
}
template <class Sched, class Epi>
__device__ __forceinline__ void gemm_naive(const Ctx& F, const Gemm g, const Sched& S, const Epi& E) {
    Unit u;
    for (int i = 0; S.next(i, u); ++i) {
        for (int task = F.tid; task < 8192; task += NTHREADS) {
            const int lane = task & 63, fr = lane & 15, fq = lane >> 4, rest = task >> 6, rg = rest & 15, cg = rest >> 4;
            const int row = u.pm * 256 + rg * 16 + fr, col = u.pn * 256 + cg * 32;
            const bf16_t* ap = g.A + (size_t)row * g.lda;
            const bf16_t* bp0 = g.Bt + (size_t)(col + 4 * fq) * g.K;
            const bf16_t* bp1 = bp0 + (size_t)16 * g.K;
            f32x4 v0 = {0.f, 0.f, 0.f, 0.f}, v1 = {0.f, 0.f, 0.f, 0.f};
            for (int k = 0; k < g.K; k += 8) {
                const u32x4 a = *(const u32x4*)(ap + k);
#pragma unroll
                for (int j = 0; j < 4; ++j) {
                    v0[j] = dot8(a, *(const u32x4*)(bp0 + (size_t)j * g.K + k), v0[j]);
                    v1[j] = dot8(a, *(const u32x4*)(bp1 + (size_t)j * g.K + k), v1[j]);
                }
            }
            E.tile32(row, col, fq, v0, v1);
        }
    }
}
constexpr int BK = 64, HALF = 128, HTB = HALF * BK * 2, STAGE_BYTES = 8 * HTB;
__device__ __forceinline__ int lds_byte(int r, int c) { const int st = (r >> 4) * 2 + (c >> 5), rr = r & 15, cc = c & 31, ob = rr * 64 + cc * 2; return st * 1024 + (ob ^ (((ob >> 9) & 1) << 5)); }
__device__ __forceinline__ void stage_rc(int b, int& R, int& C) { const int st = b / 1024, sb = b % 1024, swz = sb ^ (((sb >> 9) & 1) << 5); R = (st >> 1) * 16 + swz / 64; C = (st & 1) * 32 + (swz % 64) / 2; }
template <class Epi, class Sched, bool ALIGN_EPI = true, bool SP2 = true, bool GATHER = false>
__device__ __forceinline__ void gemm_mfma(LAS unsigned char* lds, const int tid_in, const Gemm g, const Sched& S, const Epi& E, const LAS int* gtab = nullptr) {
    int tid = tid_in; asm volatile("" : "+v"(tid));
    const int wid = __builtin_amdgcn_readfirstlane(tid >> 6), lane = tid & 63, wr = wid >> 2, wc = wid & 3, fr = lane & 15, fq = lane >> 4;
    const int K = g.K, nt = K / BK;
    unsigned voffB[2]; int RA[2], CA[2];
#pragma unroll
    for (int i = 0; i < 2; ++i) { int R, C; stage_rc(tid * 16 + i * 8192, R, C); const int Rb = R;
        RA[i] = R; CA[i] = C; voffB[i] = (unsigned)(Rb * K + C) * 2u; }
    const size_t kstep = (size_t)(BK * 2);
    const size_t hstepA = (size_t)HALF * g.lda * 2, hstepB = (size_t)HALF * K * 2;
    const size_t tstepA = GATHER ? 0 : 2 * hstepA, tstepB = 2 * hstepB;
    unsigned vc0[2], vc1[2], vn0[2], vn1[2];
#define PG8_GOFF(dst0, dst1, ui_) do { _Pragma("unroll") for (int i_ = 0; i_ < 2; ++i_) { \
        if constexpr (GATHER) { dst0[i_] = (unsigned)gtab[(ui_) * 256 + RA[i_]] * (unsigned)(g.lda * 2) + (unsigned)CA[i_] * 2u; dst1[i_] = (unsigned)gtab[(ui_) * 256 + HALF + RA[i_]] * (unsigned)(g.lda * 2) + (unsigned)CA[i_] * 2u; } \
        else { dst0[i_] = (unsigned)(RA[i_] * g.lda + CA[i_]) * 2u; dst1[i_] = dst0[i_] + (unsigned)hstepA; } } } while (0)
    const unsigned ldsw = (unsigned)wid * 1024u;
    const int aoff = lds_byte(wr * 64 + fr, fq * 8), boff = lds_byte(wc * 32 + fr, fq * 8);
#define PG8_SA(b, h) (((b) * 2 + (h)) * HTB)
#define PG8_SB(b, h) ((4 + (b) * 2 + (h)) * HTB)
#define PG8_STAGE(bufoff, gbase, voff) do { _Pragma("unroll") for (int _i = 0; _i < 2; ++_i) \
        __builtin_amdgcn_global_load_lds((const unsigned*)((const char*)(gbase) + (voff)[_i]), (LAS unsigned*)(lds + (bufoff) + ldsw + _i * 8192), 16, 0, 0); } while (0)
#define PG8_LDA(dst, b, h) do { _Pragma("unroll") for (int m = 0; m < 4; ++m) _Pragma("unroll") for (int k = 0; k < 2; ++k) dst[m][k] = *(const LAS bf16x8*)(lds + PG8_SA(b, h) + aoff + m * 2048 + k * 1024); } while (0)
#define PG8_LDB(dst, b, h) do { _Pragma("unroll") for (int n = 0; n < 2; ++n) _Pragma("unroll") for (int k = 0; k < 2; ++k) dst[n][k] = *(const LAS bf16x8*)(lds + PG8_SB(b, h) + boff + n * 2048 + k * 1024); } while (0)
#define PG8_MMA(ai, bj, At, Bt) do { __builtin_amdgcn_s_setprio(1); _Pragma("unroll") for (int m = 0; m < 4; ++m) _Pragma("unroll") for (int n = 0; n < 2; ++n) _Pragma("unroll") for (int k = 0; k < 2; ++k) \
        acc[ai][bj][m][n] = __builtin_amdgcn_mfma_f32_16x16x32_bf16(Bt[n][k], At[m][k], acc[ai][bj][m][n], 0, 0, 0); __builtin_amdgcn_s_setprio(0); } while (0)
#define PG8_WAIT_V(n) asm volatile("s_waitcnt vmcnt(" #n ")" ::: "memory")
#define PG8_WAIT_L(n) asm volatile("s_waitcnt lgkmcnt(" #n ")" ::: "memory")
#define PG8_BAR __builtin_amdgcn_s_barrier()
#define PG8_SCHED __builtin_amdgcn_sched_barrier(0)
    Unit cur, nxt; int ui = 0;
    if (!S.next(0, cur)) return;
    PG8_GOFF(vc0, vc1, 0);
#pragma unroll
    for (int i = 0; i < 2; ++i) { vn0[i] = vc0[i]; vn1[i] = vc1[i]; }
    f32x4 acc[2][2][4][2];
#pragma unroll
    for (int a = 0; a < 2; ++a)
#pragma unroll
        for (int b = 0; b < 2; ++b)
#pragma unroll
            for (int m = 0; m < 4; ++m)
#pragma unroll
                for (int n = 0; n < 2; ++n) acc[a][b][m][n] = (f32x4){0.f, 0.f, 0.f, 0.f};
    bf16x8 At[4][2], B0[2][2], B1[2][2];
    const char* cA = (const char*)g.A + (size_t)cur.pm * tstepA; const char* cB = (const char*)g.Bt + (size_t)cur.pn * tstepB;
    S.a_ready(cur);
    if constexpr (SP2) {
        PG8_STAGE(PG8_SB(0, 0), cB, voffB); PG8_STAGE(PG8_SB(0, 1), cB + hstepB, voffB); PG8_STAGE(PG8_SA(0, 0), cA, vc0); PG8_STAGE(PG8_SA(0, 1), cA, vc1);
        if (wr == 1) PG8_BAR;
        PG8_WAIT_V(2); PG8_BAR;
        PG8_STAGE(PG8_SB(1, 0), cB + kstep, voffB); PG8_STAGE(PG8_SA(1, 0), cA + kstep, vc0); PG8_STAGE(PG8_SB(1, 1), cB + hstepB + kstep, voffB);
        PG8_WAIT_V(6); PG8_BAR;
    } else {
        PG8_STAGE(PG8_SB(0, 0), cB, voffB); PG8_STAGE(PG8_SA(0, 0), cA, vc0); PG8_STAGE(PG8_SB(0, 1), cB + hstepB, voffB); PG8_STAGE(PG8_SA(0, 1), cA, vc1);
        if (wr == 1) PG8_BAR;
        PG8_WAIT_V(4); PG8_BAR;
        PG8_STAGE(PG8_SB(1, 0), cB + kstep, voffB); PG8_STAGE(PG8_SA(1, 0), cA + kstep, vc0); PG8_STAGE(PG8_SB(1, 1), cB + hstepB + kstep, voffB);
        PG8_WAIT_V(6); PG8_BAR;
    }
    for (;;) {
        const bool has_next = S.next(ui + 1, nxt);
        if constexpr (GATHER) { if (has_next) { PG8_GOFF(vn0, vn1, ui + 1); } else {
#pragma unroll
            for (int i = 0; i < 2; ++i) { vn0[i] = vc0[i]; vn1[i] = vc1[i]; } } }
        const char* nA = has_next ? (const char*)g.A + (size_t)nxt.pm * tstepA : cA; const char* nB = has_next ? (const char*)g.Bt + (size_t)nxt.pn * tstepB : cB;
        for (int t = 0; t < nt; t += 2) {
            const bool last = (t == nt - 2);
            const char* a1 = cA + (size_t)(t + 1) * kstep;
            const char* a2 = last ? nA : cA + (size_t)(t + 2) * kstep; const char* b2 = last ? nB : cB + (size_t)(t + 2) * kstep;
            const char* a3 = a2 + kstep; const char* b3 = b2 + kstep;
            unsigned s0[2], s1[2];
#pragma unroll
            for (int i = 0; i < 2; ++i) { if constexpr (GATHER) { s0[i] = last ? vn0[i] : vc0[i]; s1[i] = last ? vn1[i] : vc1[i]; } else { s0[i] = vc0[i]; s1[i] = vc1[i]; } }
            if (last && has_next) S.a_ready(nxt);
            if constexpr (SP2) {
            PG8_LDB(B0, 0, 0); PG8_LDB(B1, 0, 1); PG8_SCHED; PG8_LDA(At, 0, 0); PG8_STAGE(PG8_SA(1, 1), a1, vc1);
            PG8_WAIT_V(8); PG8_WAIT_L(0); PG8_BAR; PG8_MMA(0, 0, At, B0); PG8_MMA(0, 1, At, B1); PG8_BAR; PG8_SCHED;
            PG8_LDA(At, 0, 1); PG8_STAGE(PG8_SB(0, 0), b2, voffB); PG8_STAGE(PG8_SB(0, 1), b2 + hstepB, voffB); PG8_STAGE(PG8_SA(0, 0), a2, s0);
            PG8_WAIT_V(8); PG8_WAIT_L(0); PG8_BAR; PG8_MMA(1, 0, At, B0); PG8_MMA(1, 1, At, B1); PG8_BAR; PG8_SCHED;
            PG8_LDB(B0, 1, 0); PG8_LDB(B1, 1, 1); PG8_SCHED; PG8_LDA(At, 1, 0); PG8_STAGE(PG8_SA(0, 1), a2, s1);
            PG8_WAIT_V(8); PG8_WAIT_L(0); PG8_BAR; PG8_MMA(0, 0, At, B0); PG8_MMA(0, 1, At, B1); PG8_BAR; PG8_SCHED;
            PG8_LDA(At, 1, 1); PG8_STAGE(PG8_SB(1, 0), b3, voffB); PG8_STAGE(PG8_SB(1, 1), b3 + hstepB, voffB); PG8_STAGE(PG8_SA(1, 0), a3, s0);
            PG8_WAIT_V(8); PG8_WAIT_L(0); PG8_BAR; PG8_MMA(1, 0, At, B0); PG8_MMA(1, 1, At, B1); PG8_BAR; PG8_SCHED;
            } else {
            PG8_LDB(B0, 0, 0); PG8_SCHED; PG8_LDA(At, 0, 0); PG8_STAGE(PG8_SA(1, 1), a1, vc1);
            PG8_WAIT_L(8); PG8_BAR; PG8_WAIT_L(0); PG8_MMA(0, 0, At, B0); PG8_BAR; PG8_SCHED;
            PG8_LDB(B1, 0, 1); PG8_STAGE(PG8_SB(0, 0), b2, voffB);
            PG8_BAR; PG8_WAIT_L(0); PG8_MMA(0, 1, At, B1); PG8_BAR;
            PG8_LDA(At, 0, 1); PG8_STAGE(PG8_SA(0, 0), a2, s0);
            PG8_BAR; PG8_WAIT_L(0); PG8_MMA(1, 0, At, B0); PG8_BAR; PG8_SCHED;
            PG8_STAGE(PG8_SB(0, 1), b2 + hstepB, voffB);
            PG8_WAIT_V(6); PG8_BAR; PG8_MMA(1, 1, At, B1); PG8_BAR;
            PG8_LDB(B0, 1, 0); PG8_SCHED; PG8_LDA(At, 1, 0); PG8_STAGE(PG8_SA(0, 1), a2, s1);
            PG8_WAIT_L(8); PG8_BAR; PG8_WAIT_L(0); PG8_MMA(0, 0, At, B0); PG8_BAR; PG8_SCHED;
            PG8_LDB(B1, 1, 1); PG8_STAGE(PG8_SB(1, 0), b3, voffB);
            PG8_BAR; PG8_WAIT_L(0); PG8_MMA(0, 1, At, B1); PG8_BAR;
            PG8_LDA(At, 1, 1); PG8_STAGE(PG8_SA(1, 0), a3, s0);
            PG8_BAR; PG8_WAIT_L(0); PG8_MMA(1, 0, At, B0); PG8_BAR; PG8_SCHED;
            PG8_STAGE(PG8_SB(1, 1), b3 + hstepB, voffB);
            PG8_WAIT_V(6); PG8_BAR; PG8_MMA(1, 1, At, B1); PG8_BAR;
            }
        }
        if constexpr (ALIGN_EPI) { if (wr == 0) PG8_BAR; }
        {
            int ln_e; asm volatile("v_mbcnt_lo_u32_b32 %0, -1, 0\n\tv_mbcnt_hi_u32_b32 %0, -1, %0" : "=v"(ln_e));
            const int fr_e = ln_e & 15, fq_e = ln_e >> 4;
#pragma unroll
            for (int ai = 0; ai < 2; ++ai)
#pragma unroll
                for (int m = 0; m < 4; ++m) {
#pragma unroll
                    for (int bj = 0; bj < 2; ++bj)
                        E.tile32(cur.pm * BM + ai * HALF + wr * 64 + m * 16 + fr_e, cur.pn * BM + bj * HALF + wc * 32, fq_e, acc[ai][bj][m][0], acc[ai][bj][m][1]);
                    asm volatile("" ::: "memory");
                }
            S.done(cur);
        }
        if (!has_next) break;
#pragma unroll
        for (int a = 0; a < 2; ++a)
#pragma unroll
            for (int b = 0; b < 2; ++b)
#pragma unroll
                for (int m = 0; m < 4; ++m)
#pragma unroll
                    for (int n = 0; n < 2; ++n) acc[a][b][m][n] = (f32x4){0.f, 0.f, 0.f, 0.f};
        cur = nxt; cA = nA; cB = nB; ++ui;
        if constexpr (GATHER) {
#pragma unroll
            for (int i = 0; i < 2; ++i) { vc0[i] = vn0[i]; vc1[i] = vn1[i]; } }
        if constexpr (ALIGN_EPI) { if (wr == 1) PG8_BAR; }
    }
    PG8_WAIT_V(0);
    if constexpr (!ALIGN_EPI) { if (wr == 0) PG8_BAR; }
    PG8_BAR;
#undef PG8_GOFF
#undef PG8_SA
#undef PG8_SB
#undef PG8_STAGE
#undef PG8_LDA
#undef PG8_LDB
#undef PG8_MMA
#undef PG8_WAIT_V
#undef PG8_WAIT_L
#undef PG8_BAR
#undef PG8_SCHED
}

#ifndef REP_GEMM_MASK
#define REP_GEMM_MASK 0
#endif
template <int ID, class Sched, class Epi>
__device__ __forceinline__ void gemm_phase_gather(const Ctx& F, const Gemm g, const Sched& S, const Epi& E, const LAS int* gtab) {
    gemm_mfma<Epi, Sched, true, true, true>(F.lds, F.tid, g, S, E, gtab);
    if constexpr ((REP_GEMM_MASK >> ID) & 1) gemm_mfma<Epi, Sched, true, true, true>(F.lds, F.tid, g, S, E, gtab);
}
template <int ID, class Sched, class Epi>
__device__ __forceinline__ void gemm_phase(const Ctx& F, const Gemm g, const Sched& S, const Epi& E) {
#if USE_MFMA_GEMM
    gemm_mfma<Epi, Sched, true, true>(F.lds, F.tid, g, S, E);
    if constexpr ((REP_GEMM_MASK >> ID) & 1) gemm_mfma<Epi, Sched, true, true>(F.lds, F.tid, g, S, E);
#else
    gemm_naive(F, g, S, E);
#endif
}

template <class ColPtr>
__device__ __forceinline__ void tconv_tile(const ColPtr& cp, int ldw, const float* scale, bf16_t* WT, int K, int k0, int p0, LAS float* scr, int lane) {
    const int pc = (lane & 15) * 4, kq = lane >> 4;
    const float* src = cp(p0 + pc);
#pragma unroll 4
    for (int i = 0; i < 16; ++i) {
        const int kk = 4 * i + kq;
        f32x4 v = {0.f, 0.f, 0.f, 0.f};
        if (src) { v = *(const f32x4*)(src + (size_t)(k0 + kk) * ldw); if (scale) v = v * scale[k0 + kk]; }
        LAS float* d = scr + kk * 65 + pc; d[0] = v[0]; d[1] = v[1]; d[2] = v[2]; d[3] = v[3];
    }
    LDS_WAIT();
    const int c = lane & 7;
#pragma unroll
    for (int j = 0; j < 8; ++j) {
        const int n = (lane >> 3) + 8 * j; const LAS float* s = scr + (8 * c) * 65 + n;
        u32x4 o; o.x = pk2(s[0], s[65]); o.y = pk2(s[2 * 65], s[3 * 65]); o.z = pk2(s[4 * 65], s[5 * 65]); o.w = pk2(s[6 * 65], s[7 * 65]);
        *(u32x4*)(WT + (size_t)(p0 + n) * K + k0 + 8 * c) = o;
    }
    LDS_WAIT();
}
struct CpPlain { const float* W; int ncols; __device__ __forceinline__ const float* operator()(int p) const { return p < ncols ? W + p : nullptr; } };
struct CpQ {
    const float* W;
    __device__ __forceinline__ const float* operator()(int p) const {
        const int h = p / 96, pp = p - h * 96; int lc = pp;
        if (pp >= 64) { const int rp = pp - 64, i = rp & 15; lc = 64 + (i >> 3) * 16 + (i & 7) + ((rp >> 4) ? 8 : 0); }
        return W + h * 96 + lc;
    }
};
struct CpGU {
    const float* Wg; const float* Wu;
    __device__ __forceinline__ const float* operator()(int p) const { const int g32 = p >> 5, w = p & 31; return (w < 16) ? (Wg + g32 * 16 + w) : (Wu + g32 * 16 + (w - 16)); }
};

constexpr int CONV_ITEMS = NEXP * 256 + NEXP * 128, CONV_CH = 4, CONV_CTR0 = 8192;
struct ConvSrc { const float* p; size_t ld; bf16_t* dst; int K; };
__device__ __forceinline__ ConvSrc conv_decode(const Args& a, int l, int idx, int lane) {
    const int pc = (lane & 15) * 4, kq = lane >> 4; ConvSrc r;
    if (idx < NEXP * 256) { const int e = idx >> 8, q = idx & 255, k0 = (q >> 4) * 64, p = (q & 15) * 64 + pc, g32 = p >> 5, w = p & 31; const size_t le = (size_t)l * NEXP + e;
        r.p = ((w < 16) ? (a.w_gate + le * D * FF + g32 * 16 + w) : (a.w_up + le * D * FF + g32 * 16 + (w - 16))) + (size_t)(k0 + kq) * FF; r.ld = FF;
        r.dst = (bf16_t*)(a.ws + WS_WGU) + le * 1024 * D + (size_t)((q & 15) * 64) * D + k0; r.K = D; }
    else { const int i2 = idx - NEXP * 256, e = i2 >> 7, q = i2 & 127, k0 = (q >> 4) * 64, p0 = (q & 15) * 64; const size_t le = (size_t)l * NEXP + e;
        r.p = a.w_down + le * FF * D + (size_t)(k0 + kq) * D + p0 + pc; r.ld = D;
        r.dst = (bf16_t*)(a.ws + WS_WD) + le * D * FF + (size_t)p0 * FF + k0; r.K = FF; }
    return r;
}
__device__ __forceinline__ void conv_load(const ConvSrc& c, f32x4 (&v)[16]) {
#pragma unroll
    for (int i = 0; i < 16; ++i) v[i] = *(const f32x4*)(c.p + (size_t)(4 * i) * c.ld);
}
__device__ __forceinline__ void conv_store(const ConvSrc& c, const f32x4 (&v)[16], LAS float* scr, int lane) {
    const int pc = (lane & 15) * 4, kq = lane >> 4;
#pragma unroll
    for (int i = 0; i < 16; ++i) { LAS float* d = scr + (4 * i + kq) * 65 + pc; d[0] = v[i][0]; d[1] = v[i][1]; d[2] = v[i][2]; d[3] = v[i][3]; }
    LDS_WAIT();
    const int cc = lane & 7;
#pragma unroll
    for (int j = 0; j < 8; ++j) {
        const int n = (lane >> 3) + 8 * j; const LAS float* sp = scr + (8 * cc) * 65 + n;
        u32x4 o; o.x = pk2(sp[0], sp[65]); o.y = pk2(sp[2 * 65], sp[3 * 65]); o.z = pk2(sp[4 * 65], sp[5 * 65]); o.w = pk2(sp[6 * 65], sp[7 * 65]);
        *(u32x4*)(c.dst + (size_t)n * c.K + 8 * cc) = o;
    }
    LDS_WAIT();
}
__device__ __forceinline__ void conv_experts(const Ctx& F, const Args& a, int l, int grabs) {
    unsigned* ctr = (unsigned*)(a.ws + WS_CTL) + CONV_CTR0 + 64 * l;
    LAS float* scr = (LAS float*)(F.lds + F.wave * 18432);
    for (int g = 0; grabs < 0 || g < grabs; ++g) {
        unsigned b0 = 0; if (F.lane == 0) b0 = __hip_atomic_fetch_add(ctr, (unsigned)CONV_CH, __ATOMIC_RELAXED, __HIP_MEMORY_SCOPE_AGENT);
        const int base = __builtin_amdgcn_readfirstlane((int)b0);
        if (base >= CONV_ITEMS) break;
        f32x4 va[16], vb[16];
        ConvSrc c0 = conv_decode(a, l, base, F.lane), c1 = conv_decode(a, l, base + 1, F.lane), c2 = conv_decode(a, l, base + 2, F.lane), c3 = conv_decode(a, l, base + 3, F.lane);
        conv_load(c0, va); conv_load(c1, vb); conv_store(c0, va, scr, F.lane);
        conv_load(c2, va); conv_store(c1, vb, scr, F.lane);
        conv_load(c3, vb); conv_store(c2, va, scr, F.lane);
        conv_store(c3, vb, scr, F.lane);
    }
}

__device__ __forceinline__ void conv_filler(const Ctx& F, KP kp, int l, int grabs) {
    const Args a = ldargs(kp);
    int q = l;
    if (l == 0 || (int)__hip_atomic_load((unsigned*)(a.ws + WS_CTL) + CONV_CTR0 + 64 * l, __ATOMIC_RELAXED, __HIP_MEMORY_SCOPE_AGENT) >= CONV_ITEMS) q = l + 1;
    if (q < NL) conv_experts(F, a, q, grabs);
}
__device__ __forceinline__ void prologue1(const Ctx& F, KP kp) {
    const Args a = ldargs(kp);
    unsigned char* ws = a.ws;
    {
        LAS float* sl = (LAS float*)F.lds;
        float* modp = (float*)(ws + WS_MODP);
        for (int it = F.bk; it < NL * 12 * 4; it += GRID) {
            const int kc = it & 3, nc = (it >> 2) % 12, l = it / 48;
            __syncthreads();
            for (int idx = F.tid; idx < 17 * 256; idx += NTHREADS) {
                const int bb = idx >> 8, k = idx & 255; const float v = (bb < 16) ? a.c[bb * D + kc * 256 + k] : a.c_ctx[kc * 256 + k];
                sl[idx] = v / (1.0f + __expf(-v));
            }
            __syncthreads();
            const int n = nc * 512 + F.tid;
            const float* w = a.w_ada + ((size_t)l * D + kc * 256) * 6144 + n;
            float acc[17];
#pragma unroll
            for (int bb = 0; bb < 17; ++bb) acc[bb] = 0.f;
            for (int k = 0; k < 256; ++k) {
                const float wv = w[(size_t)k * 6144];
#pragma unroll
                for (int bb = 0; bb < 17; ++bb) acc[bb] += sl[bb * 256 + k] * wv;
            }
#pragma unroll
            for (int bb = 0; bb < 17; ++bb) modp[((size_t)(kc * NL + l) * 17 + bb) * 6144 + n] = acc[bb];
        }
        __syncthreads();
    }
    {
        f32x2* t64 = (f32x2*)(ws + WS_TAB64); f32x2* t32 = (f32x2*)(ws + WS_TAB32);
        const int gt = F.bk * NTHREADS + F.tid;
        if (gt < 64 * 16) { const int pos = gt >> 4, f = gt & 15; const float inv = powf(10000.0f, -((float)(2 * f) / 32.0f)); const float ang = (float)pos * inv; t64[gt] = (f32x2){cosf(ang), sinf(ang)}; }
        else if (gt < 64 * 16 + 64 * 8) { const int g2 = gt - 64 * 16, pos = g2 >> 3, f = g2 & 7; const float inv = powf(10000.0f, -((float)(2 * f) / 16.0f)); const float ang = (float)pos * inv; t32[g2] = (f32x2){cosf(ang), sinf(ang)}; }
    }
    {
        bf16_t* wr = (bf16_t*)(ws + WS_WR);
        for (int i = F.bk * NTHREADS + F.tid; i < NL * 48 * D; i += GRID * NTHREADS) {
            const int c = i & 1023, j = (i >> 10) % 48, l = i / (48 * D);
            float wv = 0.f;
            if (j < 4) wv = a.w_rg[((size_t)l * D + c) * 4 + j]; else if (j < 36) wv = a.w_re[((size_t)l * D + c) * 32 + (j - 4)];
            const unsigned h = f2bf(wv); const float rem = wv - __builtin_bit_cast(float, h << 16);
            wr[((size_t)(l * 2 + 0) * 48 + j) * D + c] = (bf16_t)h; wr[((size_t)(l * 2 + 1) * 48 + j) * D + c] = (bf16_t)f2bf(rem);
        }
    }
    {
        LAS float* scr = (LAS float*)(F.lds + F.wave * 18432);
        const int gw = F.vcu * NWAVES + F.wave, NGW = GRID * NWAVES;
        constexpr int I_IN = 16 * 24, I_Q = 6 * 12, I_KV = 4 * 16, I_O = 16 * 16, I_GU = 16 * 16, I_D = 8 * 16;
        constexpr int N_SMALL = NL * (I_IN + I_Q + I_KV + I_O), N_GU = NL * NEXP * I_GU, N_D = NL * NEXP * I_D;
        for (int it = gw; it < N_SMALL; it += NGW) {
            {
                const int l = it / (I_IN + I_Q + I_KV + I_O); int r = it % (I_IN + I_Q + I_KV + I_O);
                if (r < I_IN) { const int kt = r / 24, pt = r % 24; tconv_tile(CpPlain{a.w_in + (size_t)l * D * 1440, 1440}, 1440, nullptr, (bf16_t*)(ws + WS_WIN) + (size_t)l * ZW * D, D, kt * 64, pt * 64, scr, F.lane); continue; }
                r -= I_IN;
                if (r < I_Q) { const int kt = r / 12, pt = r % 12; tconv_tile(CpQ{a.w_q_b + (size_t)l * 384 * QW}, QW, a.g_q_a + l * 384, (bf16_t*)(ws + WS_WQ) + (size_t)l * QW * 384, 384, kt * 64, pt * 64, scr, F.lane); continue; }
                r -= I_Q;
                if (r < I_KV) { const int kt = r / 16, pt = r % 16; tconv_tile(CpPlain{a.w_kv_b + (size_t)l * 256 * KVW, KVW}, KVW, a.g_kv_a + l * 256, (bf16_t*)(ws + WS_WKV) + (size_t)l * KVW * 256, 256, kt * 64, pt * 64, scr, F.lane); continue; }
                r -= I_KV;
                { const int kt = r / 16, pt = r % 16; tconv_tile(CpPlain{a.w_o + (size_t)l * D * D, D}, D, nullptr, (bf16_t*)(ws + WS_WO) + (size_t)l * D * D, D, kt * 64, pt * 64, scr, F.lane); }
            }
        }
        conv_experts(F, a, 0, -1);
    }
}

__device__ __forceinline__ void prologue2(const Ctx& F, KP kp) {
    const Args a = ldargs(kp);
    const float* modp = (const float*)(a.ws + WS_MODP); float* mod = (float*)(a.ws + WS_MOD);
    constexpr int NE = NL * 17 * 6144 / 4;
    for (int i = F.bk * NTHREADS + F.tid; i < NE; i += GRID * NTHREADS) {
        const int e = i * 4, l = e / (17 * 6144), n = e % 6144;
        f32x4 s = *(const f32x4*)(a.b_ada + l * 6144 + n);
#pragma unroll
        for (int kc = 0; kc < 4; ++kc) s = s + *(const f32x4*)(modp + (size_t)kc * NL * 17 * 6144 + e);
        *(f32x4*)(mod + e) = s;
    }
}

__device__ __forceinline__ void row_load(const float* p, int lane, f32x4 (&v)[4]) {
#pragma unroll
    for (int j = 0; j < 4; ++j) v[j] = *(const f32x4*)(p + 4 * lane + 256 * j);
}
__device__ __forceinline__ void row_ln(f32x4 (&v)[4], const float* g, const float* b, int lane) {
    float s = 0.f;
#pragma unroll
    for (int j = 0; j < 4; ++j) s += (v[j][0] + v[j][1]) + (v[j][2] + v[j][3]);
    const float mean = wave_sum(s) * (1.0f / D); float q = 0.f;
#pragma unroll
    for (int j = 0; j < 4; ++j) { v[j] = v[j] - mean; q += (v[j][0] * v[j][0] + v[j][1] * v[j][1]) + (v[j][2] * v[j][2] + v[j][3] * v[j][3]); }
    const float rstd = 1.0f / sqrtf(wave_sum(q) * (1.0f / D) + LN_EPS);
#pragma unroll
    for (int j = 0; j < 4; ++j) { const f32x4 gg = *(const f32x4*)(g + 4 * lane + 256 * j), bv = *(const f32x4*)(b + 4 * lane + 256 * j); v[j] = v[j] * rstd * gg + bv; }
}
__device__ __forceinline__ void row_ln_reg(f32x4 (&v)[4], const f32x4 (&g)[4], const f32x4 (&b)[4]) {
    float s = 0.f;
#pragma unroll
    for (int j = 0; j < 4; ++j) s += (v[j][0] + v[j][1]) + (v[j][2] + v[j][3]);
    const float mean = wave_sum(s) * (1.0f / D); float q = 0.f;
#pragma unroll
    for (int j = 0; j < 4; ++j) { v[j] = v[j] - mean; q += (v[j][0] * v[j][0] + v[j][1] * v[j][1]) + (v[j][2] * v[j][2] + v[j][3] * v[j][3]); }
    const float rstd = 1.0f / sqrtf(wave_sum(q) * (1.0f / D) + LN_EPS);
#pragma unroll
    for (int j = 0; j < 4; ++j) v[j] = v[j] * rstd * g[j] + b[j];
}
__device__ __forceinline__ void row_store_mod_bf16(bf16_t* hrow, const f32x4 (&v)[4], const float* sh, const float* sc, int lane) {
#pragma unroll
    for (int j = 0; j < 4; ++j) {
        const f32x4 s1 = *(const f32x4*)(sc + 4 * lane + 256 * j), s0 = *(const f32x4*)(sh + 4 * lane + 256 * j);
        const f32x4 h = v[j] * (s1 + 1.0f) + s0;
        st_bf4(hrow + 4 * lane + 256 * j, h);
    }
}

__device__ __forceinline__ void prologue3(const Ctx& F, KP kp) {
    const Args a = ldargs(kp);
    const float* modp = (const float*)(a.ws + WS_MODP); bf16_t* H = (bf16_t*)(a.ws + WS_H);
    const int gw = F.vcu * NWAVES + F.wave, NGW = GRID * NWAVES;
    for (int r = gw; r < MT; r += NGW) {
        const float* xr = (r < TL) ? (a.x + (size_t)r * D) : (a.ctx + (size_t)(r - TL) * D);
        const int bb = bb_of(r);
        f32x4 v[4]; row_load(xr, F.lane, v);
#pragma unroll
        for (int j = 0; j < 4; ++j) {
            const int c = 4 * F.lane + 256 * j;
            f32x4 sh = *(const f32x4*)(a.b_ada + c), sc = *(const f32x4*)(a.b_ada + 1024 + c);
#pragma unroll
            for (int kc = 0; kc < 4; ++kc) { const float* mp = modp + ((size_t)(kc * NL + 0) * 17 + bb) * 6144; sh = sh + *(const f32x4*)(mp + c); sc = sc + *(const f32x4*)(mp + 1024 + c); }
            st_bf4(H + (size_t)r * D + c, v[j] * (sc + 1.0f) + sh);
        }
    }
}

__device__ __forceinline__ void phase_split(const Ctx& F, KP kp, int l) {
    const Args a = ldargs(kp);
    unsigned char* ws = a.ws;
    const bf16_t* Z = (const bf16_t*)(ws + WS_Z);
    float* rstdq = (float*)(ws + WS_RSTDQ); float* rstdkv = (float*)(ws + WS_RSTDKV);
    bf16_t* Km = (bf16_t*)(ws + WS_KM); bf16_t* Qg = (bf16_t*)(ws + WS_QG); bf16_t* Kg = (bf16_t*)(ws + WS_KG); bf16_t* Vg = (bf16_t*)(ws + WS_VG);
    LAS f32x2* t64 = (LAS f32x2*)(F.lds + 65536); LAS f32x2* t32 = (LAS f32x2*)(F.lds + 65536 + 8192);
    __syncthreads();
    for (int i = F.tid; i < 64 * 16; i += NTHREADS) t64[i] = ((const f32x2*)(ws + WS_TAB64))[i];
    if (F.tid < 64 * 8) t32[F.tid] = ((const f32x2*)(ws + WS_TAB32))[F.tid];
    __syncthreads();
    LAS float* zs = (LAS float*)(F.lds + F.wave * 8192);
    const int lane = F.lane, gw = F.vcu * NWAVES + F.wave, NGW = GRID * NWAVES;
    const float ggq = a.g_gq[l * 64 + lane], ggk = a.g_gk[l * 64 + lane];
    u32x4 zn[3];
#define P2_LOAD(rr) do { const u32x4* zr_ = (const u32x4*)(Z + (size_t)(rr) * ZW); _Pragma("unroll") for (int j = 0; j < 3; ++j) zn[j] = zr_[lane + 64 * j]; } while (0)
    if (gw < MT) P2_LOAD(gw);
    for (int r = gw; r < MT; r += NGW) {
#pragma unroll
        for (int j = 0; j < 3; ++j) {
            const int ch = lane + 64 * j; const u32x4 w = zn[j];
            LAS float* d = zs + ch * 8;
            *(LAS f32x4*)d = (f32x4){bflo(w.x), bfhi(w.x), bflo(w.y), bfhi(w.y)};
            *(LAS f32x4*)(d + 4) = (f32x4){bflo(w.z), bfhi(w.z), bflo(w.w), bfhi(w.w)};
        }
        if (r + NGW < MT) P2_LOAD(r + NGW);
        LDS_WAIT();
        const bool lat = r < TL; const int s = r & 2047, gr = s >> 6, gc = s & 63, kr = krow_of(r);
        float sq = 0.f, sk = 0.f;
#pragma unroll
        for (int i = 0; i < 6; ++i) { const float v = zs[lane + 64 * i]; sq += v * v; }
#pragma unroll
        for (int i = 0; i < 4; ++i) { const float v = zs[384 + lane + 64 * i]; sk += v * v; }
        sq = wave_sum(sq); sk = wave_sum(sk);
        if (lane == 0) { rstdq[r] = 1.0f / sqrtf(sq * (1.0f / 384.0f) + RMS_EPS); rstdkv[r] = 1.0f / sqrtf(sk * (1.0f / 256.0f) + RMS_EPS); }
        {
            const int d = lane & 31; const float v = zs[640 + d]; const float pv = __shfl_xor(v, 8);
            float o = v;
            if (lat) { const int part = d >> 4, f = d & 7, pos = part ? gc : gr; const f32x2 cs = t32[pos * 8 + f]; o = (d & 8) ? (v * cs.x + pv * cs.y) : (v * cs.x - pv * cs.y); }
            const unsigned short ob = (unsigned short)f2bf(o);
#pragma unroll
            for (int i = 0; i < 4; ++i) { const int h = (lane >> 5) + 2 * i; Km[(size_t)kr * QW + h * 96 + 64 + d] = ob; }
        }
#pragma unroll
        for (int h = 0; h < 8; ++h) {
            const float v = zs[672 + 64 * h + lane]; const float ss = wave_sum(v * v);
            const float y = v * (1.0f / sqrtf(ss * (1.0f / 64.0f) + RMS_EPS)) * ggq; const float py = __shfl_xor(y, 16);
            float o = y;
            if (lat) { const int part = lane >> 5, f = lane & 15, pos = part ? gc : gr; const f32x2 cs = t64[pos * 16 + f]; o = (lane & 16) ? (y * cs.x + py * cs.y) : (y * cs.x - py * cs.y); }
            Qg[(size_t)r * 512 + 64 * h + lane] = (unsigned short)f2bf(o * QSCALE_G);
        }
#pragma unroll
        for (int h = 0; h < 2; ++h) {
            const float v = zs[1184 + 64 * h + lane]; const float ss = wave_sum(v * v);
            const float y = v * (1.0f / sqrtf(ss * (1.0f / 64.0f) + RMS_EPS)) * ggk; const float py = __shfl_xor(y, 16);
            float o = y;
            if (lat) { const int part = lane >> 5, f = lane & 15, pos = part ? gc : gr; const f32x2 cs = t64[pos * 16 + f]; o = (lane & 16) ? (y * cs.x + py * cs.y) : (y * cs.x - py * cs.y); }
            Kg[(size_t)kr * 128 + 64 * h + lane] = (unsigned short)f2bf(o);
            Vg[(size_t)kr * 128 + 64 * h + lane] = (unsigned short)f2bf(zs[1312 + 64 * h + lane]);
        }
        LDS_WAIT();
    }
}

typedef float f32x4m __attribute__((ext_vector_type(4)));
__device__ __forceinline__ void phase_ln1_route(const Ctx& F, KP kp, int l, int ntok) {
    const Args a = ldargs(kp);
    unsigned char* ws = a.ws;
    const bf16_t* Yo = (const bf16_t*)(ws + WS_U); float* XC = (float*)(ws + WS_XC); bf16_t* H = (bf16_t*)(ws + WS_H); bf16_t* Hlo = (bf16_t*)(ws + WS_HLO);
    const float* xinl = (l == 0) ? a.x : a.out; const float* xinc = (l == 0) ? a.ctx : XC;
    const float* mod = (const float*)(ws + WS_MOD) + (size_t)l * 17 * 6144;
    int* toke = (int*)(ws + WS_TOKE); int* tokr = (int*)(ws + WS_TOKR); float* tokw = (float*)(ws + WS_TOKW);
    volatile LAS int* cntl = (volatile LAS int*)(F.lds + MISC_CNT);
    const int lane = F.lane;
    __syncthreads();
    if (F.tid < 32) cntl[F.tid] = 0;
    if (F.tid < 36) ((LAS float*)(F.lds + MISC_LG + 2048))[F.tid] = (F.tid < 4) ? a.b_rg[l * 4 + F.tid] : a.b_re[l * 32 + F.tid - 4];
    const int tpb = ntok / GRID;
    {
        f32x4 nx[4]; u32x2 ny[4]; int i = F.wave;
        f32x4 LG[4], LB[4], GA[4], SH[4], SC[4]; int bbc = -1;
#pragma unroll
        for (int j = 0; j < 4; ++j) { LG[j] = *(const f32x4*)(a.ln1_g + l * D + 4 * lane + 256 * j); LB[j] = *(const f32x4*)(a.ln1_b + l * D + 4 * lane + 256 * j); }
#define P6_LOAD(tt) do { const int t_ = (tt); const float* xp_ = (t_ < TL) ? (xinl + (size_t)t_ * D) : (xinc + (size_t)(t_ - TL) * D); row_load(xp_, lane, nx); \
        _Pragma("unroll") for (int j = 0; j < 4; ++j) ny[j] = *(const u32x2*)(Yo + (size_t)t_ * D + 4 * lane + 256 * j); } while (0)
        if (i < tpb) P6_LOAD(F.bk * tpb + i);
        for (; i < tpb; i += NWAVES) {
            const int t = F.bk * tpb + i, bb = bb_of(t);
            if (bb != bbc) {
                bbc = bb;
#pragma unroll
                for (int j = 0; j < 4; ++j) { const int c = 4 * lane + 256 * j; GA[j] = *(const f32x4*)(mod + (size_t)(bb * 6 + 2) * D + c);
                    SH[j] = *(const f32x4*)(mod + (size_t)(bb * 6 + 3) * D + c); SC[j] = *(const f32x4*)(mod + (size_t)(bb * 6 + 4) * D + c); }
            }
            f32x4 v[4];
#pragma unroll
            for (int j = 0; j < 4; ++j) { const f32x4 y = {bflo(ny[j].x), bfhi(ny[j].x), bflo(ny[j].y), bfhi(ny[j].y)}; v[j] = nx[j] * ALPHA + GA[j] * y; }
            if (i + NWAVES < tpb) P6_LOAD(t + NWAVES);
            row_ln_reg(v, LG, LB);
            float* xr = (t < TL) ? (a.out + (size_t)t * D) : (XC + (size_t)(t - TL) * D);
#pragma unroll
            for (int j = 0; j < 4; ++j) *(f32x4*)(xr + 4 * lane + 256 * j) = v[j];
#pragma unroll
            for (int j = 0; j < 4; ++j) {
                const f32x4 h = v[j] * (SC[j] + 1.0f) + SH[j];
                u32x2 wh; wh.x = pk2(h[0], h[1]); wh.y = pk2(h[2], h[3]);
                const f32x4 r = {h[0] - bflo(wh.x), h[1] - bfhi(wh.x), h[2] - bflo(wh.y), h[3] - bfhi(wh.y)};
                *(u32x2*)(H + (size_t)t * D + 4 * lane + 256 * j) = wh;
                st_bf4(Hlo + (size_t)t * D + 4 * lane + 256 * j, r);
            }
        }
    }
#undef P6_LOAD
    asm volatile("s_waitcnt vmcnt(0)" ::: "memory");
    __syncthreads();
    {
        const bf16_t* wrh = (const bf16_t*)(ws + WS_WR) + (size_t)(l * 2) * 48 * D; const bf16_t* wrl = wrh + (size_t)48 * D;
        LAS float* lg = (LAS float*)(F.lds + F.wave * 4096);
        const LAS float* bias = (const LAS float*)(F.lds + MISC_LG + 2048);
        const int fr = lane & 15, fq = lane >> 4;
        for (int g = F.wave; g < tpb / 16; g += NWAVES) {
            const int t0 = F.bk * tpb + g * 16;
            const bf16_t* hh = H + (size_t)(t0 + fr) * D + 8 * fq; const bf16_t* hl = Hlo + (size_t)(t0 + fr) * D + 8 * fq;
            f32x4m acc0 = {0.f, 0.f, 0.f, 0.f}, acc1 = acc0, acc2 = acc0;
#pragma unroll 2
            for (int ks = 0; ks < 32; ++ks) {
                const bf16x8 bh = *(const bf16x8*)(hh + 32 * ks), bl = *(const bf16x8*)(hl + 32 * ks);
                const bf16_t* wp = wrh + (size_t)fr * D + 32 * ks + 8 * fq; const bf16_t* wq = wrl + (size_t)fr * D + 32 * ks + 8 * fq;
                const bf16x8 a0h = *(const bf16x8*)(wp), a1h = *(const bf16x8*)(wp + 16 * D), a2h = *(const bf16x8*)(wp + 32 * D);
                const bf16x8 a0l = *(const bf16x8*)(wq), a1l = *(const bf16x8*)(wq + 16 * D), a2l = *(const bf16x8*)(wq + 32 * D);
                acc0 = __builtin_amdgcn_mfma_f32_16x16x32_bf16(a0h, bh, acc0, 0, 0, 0); acc1 = __builtin_amdgcn_mfma_f32_16x16x32_bf16(a1h, bh, acc1, 0, 0, 0); acc2 = __builtin_amdgcn_mfma_f32_16x16x32_bf16(a2h, bh, acc2, 0, 0, 0);
                acc0 = __builtin_amdgcn_mfma_f32_16x16x32_bf16(a0h, bl, acc0, 0, 0, 0); acc1 = __builtin_amdgcn_mfma_f32_16x16x32_bf16(a1h, bl, acc1, 0, 0, 0); acc2 = __builtin_amdgcn_mfma_f32_16x16x32_bf16(a2h, bl, acc2, 0, 0, 0);
                acc0 = __builtin_amdgcn_mfma_f32_16x16x32_bf16(a0l, bh, acc0, 0, 0, 0); acc1 = __builtin_amdgcn_mfma_f32_16x16x32_bf16(a1l, bh, acc1, 0, 0, 0); acc2 = __builtin_amdgcn_mfma_f32_16x16x32_bf16(a2l, bh, acc2, 0, 0, 0);
            }
#pragma unroll
            for (int r = 0; r < 4; ++r) { lg[fr * 48 + 4 * fq + r] = acc0[r]; lg[fr * 48 + 16 + 4 * fq + r] = acc1[r]; lg[fr * 48 + 32 + 4 * fq + r] = acc2[r]; }
            LDS_WAIT();
            if (lane < 16) {
                const int t = t0 + lane; const LAS float* q = lg + lane * 48;
                float l4[4];
#pragma unroll
                for (int o = 0; o < 4; ++o) l4[o] = q[o] + bias[o];
                int gs = 0; float gm = l4[0];
#pragma unroll
                for (int o = 1; o < 4; ++o) if (l4[o] > gm) { gm = l4[o]; gs = o; }
                float den = 0.f;
#pragma unroll
                for (int o = 0; o < 4; ++o) den += expf(l4[o] - gm);
                const float pstar = 1.0f / den;
                float le[8];
#pragma unroll
                for (int o = 0; o < 8; ++o) le[o] = q[4 + gs * 8 + o] + bias[4 + gs * 8 + o];
                int i1 = 0; float v1 = le[0];
#pragma unroll
                for (int o = 1; o < 8; ++o) if (le[o] > v1) { v1 = le[o]; i1 = o; }
                int i2 = -1; float v2 = -3.0e38f;
#pragma unroll
                for (int o = 0; o < 8; ++o) if (o != i1 && le[o] > v2) { v2 = le[o]; i2 = o; }
                const float ex = expf(v2 - v1), w1 = pstar / (1.0f + ex), w2 = pstar * ex / (1.0f + ex);
                const int e1 = gs * 8 + i1, e2 = gs * 8 + i2;
                const int r1 = __hip_atomic_fetch_add((LAS int*)(F.lds + MISC_CNT) + e1, 1, __ATOMIC_RELAXED, __HIP_MEMORY_SCOPE_WORKGROUP);
                const int r2 = __hip_atomic_fetch_add((LAS int*)(F.lds + MISC_CNT) + e2, 1, __ATOMIC_RELAXED, __HIP_MEMORY_SCOPE_WORKGROUP);
                toke[2 * t] = e1; toke[2 * t + 1] = e2; tokr[2 * t] = r1; tokr[2 * t + 1] = r2; tokw[2 * t] = w1; tokw[2 * t + 1] = w2;
            }
            LDS_WAIT();
        }
    }
    __syncthreads();
    if (F.tid < 32) ((int*)(ws + WS_BLKCNT))[((size_t)l * 256 + F.bk) * 32 + F.tid] = cntl[F.tid];
}

__device__ __forceinline__ void moe_tables(const Ctx& F, KP kp, int l, bool publish) {
    const Args a = ldargs(kp);
    const int* blkcnt = (const int*)(a.ws + WS_BLKCNT) + (size_t)l * 256 * 32;
    volatile LAS int* pa = (volatile LAS int*)(F.lds + MISC_PA); volatile LAS int* pb = (volatile LAS int*)(F.lds + MISC_PB);
    volatile LAS int* tot = (volatile LAS int*)(F.lds + MISC_TOT); volatile LAS int* base = (volatile LAS int*)(F.lds + MISC_BASE); volatile LAS int* poff = (volatile LAS int*)(F.lds + MISC_POFF);
    __syncthreads();
    {
        const int e = F.tid & 31, part = F.tid >> 5; int sa = 0, sb = 0;
        for (int j = 0; j < 16; ++j) { const int b2 = part * 16 + j; const int c = blkcnt[b2 * 32 + e]; sa += c; sb += (b2 < F.bk) ? c : 0; }
        pa[part * 32 + e] = sa; pb[part * 32 + e] = sb;
    }
    __syncthreads();
    if (F.tid < 32) { int sa = 0, sb = 0; for (int p = 0; p < 16; ++p) { sa += pa[p * 32 + F.tid]; sb += pb[p * 32 + F.tid]; } tot[F.tid] = sa; base[F.tid] = sb; }
    __syncthreads();
    if (F.tid == 0) { int o = 0; for (int e = 0; e < 32; ++e) { poff[e] = o; o += (tot[e] + 255) & ~255; } poff[32] = o; }
    __syncthreads();
    if (publish && F.bk == 0 && F.tid < 33) ((int*)(a.ws + WS_MOETAB))[l * 128 + F.tid] = poff[F.tid];
}

__device__ __forceinline__ void phase_dispatch(const Ctx& F, KP kp, int l, int ntok) {
    const Args a = ldargs(kp);
    unsigned char* ws = a.ws;
    if (l > 0) conv_experts(F, a, l, -1);
    moe_tables(F, kp, l, true);
    volatile LAS int* base = (volatile LAS int*)(F.lds + MISC_BASE); volatile LAS int* poff = (volatile LAS int*)(F.lds + MISC_POFF); volatile LAS int* tot = (volatile LAS int*)(F.lds + MISC_TOT);
    const int* toke = (const int*)(ws + WS_TOKE); const int* tokr = (const int*)(ws + WS_TOKR); int* tokp = (int*)(ws + WS_TOKP); int* postok = (int*)(ws + WS_POSTOK);
    const int tpb = ntok / GRID;
    if (F.tid < tpb) {
        const int t = F.bk * tpb + F.tid;
        const int2 e = *(const int2*)(toke + 2 * t), r = *(const int2*)(tokr + 2 * t);
        const int p1 = poff[e.x] + base[e.x] + r.x, p2 = poff[e.y] + base[e.y] + r.y;
        *(int2*)(tokp + 2 * t) = (int2){p1, p2};
        postok[p1] = t; postok[p2] = t;
    }
    { const int idx = F.bk * NTHREADS + F.tid;
      if (idx < poff[32]) { int e = 0;
#pragma unroll
          for (int j = 1; j < 32; ++j) e += (poff[j] <= idx) ? 1 : 0;
          if (idx >= poff[e] + tot[e]) postok[idx] = 0; } }
}

__device__ __forceinline__ void phase_ln2(const Ctx& F, KP kp, int l, int ntok, bool dry = false) {
    const Args a = ldargs(kp);
    unsigned char* ws = a.ws;
    const bf16_t* Ys = (const bf16_t*)(ws + WS_XS); float* XC = (float*)(ws + WS_XC); bf16_t* H = (bf16_t*)(ws + WS_H);
    const float* mod = (const float*)(ws + WS_MOD) + (size_t)l * 17 * 6144;
    const float* modn = (const float*)(ws + WS_MOD) + (size_t)(l + 1 < NL ? l + 1 : l) * 17 * 6144;
    const int* tokp = (const int*)(ws + WS_TOKP); const float* tokw = (const float*)(ws + WS_TOKW);
    const int gw = F.vcu * NWAVES + F.wave, NGW = GRID * NWAVES, lane = F.lane;
    const int per = ntok / NGW, t0 = gw * per, t1 = t0 + per;
    f32x4 LG[4], LB[4], GF[4], SH[4], SC[4];
#pragma unroll
    for (int j = 0; j < 4; ++j) { LG[j] = *(const f32x4*)(a.ln2_g + l * D + 4 * lane + 256 * j); LB[j] = *(const f32x4*)(a.ln2_b + l * D + 4 * lane + 256 * j); }
    int bbc = -1;
    int2 pn = {0, 0}; float2 wn = {0.f, 0.f};
    f32x4 xn[4]; u32x2 yan[4], ybn[4];
#define P10_REC(tt) do { pn = *(const int2*)(tokp + 2 * (tt)); wn = *(const float2*)(tokw + 2 * (tt)); } while (0)
#define P10_ROWS(tt, p_) do { const int t_ = (tt); const float* xp_ = (t_ < TL) ? (a.out + (size_t)t_ * D) : (XC + (size_t)(t_ - TL) * D); row_load(xp_, lane, xn); \
        _Pragma("unroll") for (int j = 0; j < 4; ++j) { yan[j] = *(const u32x2*)(Ys + (size_t)(p_).x * D + 4 * lane + 256 * j); ybn[j] = *(const u32x2*)(Ys + (size_t)(p_).y * D + 4 * lane + 256 * j); } } while (0)
    float2 wc = {0.f, 0.f};
    P10_REC(t0); wc = wn; P10_ROWS(t0, pn); if (t0 + 1 < t1) P10_REC(t0 + 1);
    for (int t = t0; t < t1; ++t) {
        const int bb = bb_of(t);
        if (bb != bbc) {
            bbc = bb;
#pragma unroll
            for (int j = 0; j < 4; ++j) { const int c = 4 * lane + 256 * j; GF[j] = *(const f32x4*)(mod + (size_t)(bb * 6 + 5) * D + c);
                SH[j] = *(const f32x4*)(modn + (size_t)(bb * 6 + 0) * D + c); SC[j] = *(const f32x4*)(modn + (size_t)(bb * 6 + 1) * D + c); }
        }
        f32x4 v[4]; u32x2 ya[4], yb[4];
#pragma unroll
        for (int j = 0; j < 4; ++j) { v[j] = xn[j]; ya[j] = yan[j]; yb[j] = ybn[j]; }
        const float w1 = wc.x, w2 = wc.y;
        if (t + 1 < t1) { wc = wn; P10_ROWS(t + 1, pn); if (t + 2 < t1) P10_REC(t + 2); }
        float* xr = (t < TL) ? (a.out + (size_t)t * D) : (XC + (size_t)(t - TL) * D);
#pragma unroll
        for (int j = 0; j < 4; ++j) {
            const f32x4 y = (f32x4){bflo(ya[j].x), bfhi(ya[j].x), bflo(ya[j].y), bfhi(ya[j].y)} * w1 + (f32x4){bflo(yb[j].x), bfhi(yb[j].x), bflo(yb[j].y), bfhi(yb[j].y)} * w2;
            v[j] = v[j] * ALPHA + GF[j] * y;
        }
        row_ln_reg(v, LG, LB);
        float* xw = dry ? ((float*)(ws + WS_HLO) + (size_t)(t & 16383) * D) : xr;
#pragma unroll
        for (int j = 0; j < 4; ++j) *(f32x4*)(xw + 4 * lane + 256 * j) = v[j];
        if (l + 1 < NL) { bf16_t* hrow = dry ? ((bf16_t*)(ws + WS_O) + (size_t)t * D) : H + (size_t)t * D;
#pragma unroll
            for (int j = 0; j < 4; ++j) st_bf4(hrow + 4 * lane + 256 * j, v[j] * (SC[j] + 1.0f) + SH[j]); }
    }
#undef P10_REC
#undef P10_ROWS
}

template <int QD>
__device__ __forceinline__ void attn_naive_task(const bf16_t* qp, const bf16_t* kp, int kstride, const bf16_t* vp, int vstride, int nkeys, bf16_t* op) {
    u32x4 qv[QD / 8];
#pragma unroll
    for (int i = 0; i < QD / 8; ++i) qv[i] = *(const u32x4*)(qp + 8 * i);
#pragma unroll 1
    for (int half = 0; half < 2; ++half) {
        float o[32];
#pragma unroll
        for (int i = 0; i < 32; ++i) o[i] = 0.f;
        float m = -1.0e30f, lsum = 0.f;
#pragma unroll 1
        for (int j = 0; j < nkeys; ++j) {
            const u32x4* kr = (const u32x4*)(kp + (size_t)j * kstride);
            float s = 0.f;
#pragma unroll
            for (int i = 0; i < QD / 8; ++i) s = dot8(qv[i], kr[i], s);
            if (s > m) { const float al = __builtin_amdgcn_exp2f(m - s); lsum *= al;
#pragma unroll
                for (int i = 0; i < 32; ++i) o[i] *= al;
                m = s; }
            const float p = __builtin_amdgcn_exp2f(s - m); lsum += p;
            const u32x4* vr = (const u32x4*)(vp + (size_t)j * vstride + 32 * half);
#pragma unroll
            for (int i = 0; i < 4; ++i) { const u32x4 w = vr[i];
                o[8 * i + 0] += p * bflo(w.x); o[8 * i + 1] += p * bfhi(w.x); o[8 * i + 2] += p * bflo(w.y); o[8 * i + 3] += p * bfhi(w.y); o[8 * i + 4] += p * bflo(w.z); o[8 * i + 5] += p * bfhi(w.z); o[8 * i + 6] += p * bflo(w.w); o[8 * i + 7] += p * bfhi(w.w); }
        }
        const float rl = 1.0f / lsum;
#pragma unroll
        for (int i = 0; i < 4; ++i) { u32x4 w; w.x = pk2(o[8 * i] * rl, o[8 * i + 1] * rl); w.y = pk2(o[8 * i + 2] * rl, o[8 * i + 3] * rl); w.z = pk2(o[8 * i + 4] * rl, o[8 * i + 5] * rl); w.w = pk2(o[8 * i + 6] * rl, o[8 * i + 7] * rl); *(u32x4*)(op + 32 * half + 8 * i) = w; }
    }
}
__device__ __forceinline__ void phase_attn_naive(const Ctx& F, KP kp, bool last) {
    const Args a = ldargs(kp);
    unsigned char* ws = a.ws;
    const bf16_t* Qm = (const bf16_t*)(ws + WS_QM); const bf16_t* Km = (const bf16_t*)(ws + WS_KM); const bf16_t* Vm = (const bf16_t*)(ws + WS_VM);
    const bf16_t* Qg = (const bf16_t*)(ws + WS_QG); const bf16_t* Kg = (const bf16_t*)(ws + WS_KG); const bf16_t* Vg = (const bf16_t*)(ws + WS_VG);
    bf16_t* O = (bf16_t*)(ws + WS_O);
    const int gw = F.vcu * NWAVES + F.wave, NGW = GRID * NWAVES;
    const int ntask = 8192 + (last ? 0 : 1024);
    for (int T = gw; T < ntask; T += NGW) {
        int b, h16, r, nkeys;
        if (T < 8192) { const int qw = T & 31; h16 = (T >> 5) & 15; b = T >> 9; r = b * SEQ + 64 * qw + F.lane; nkeys = KPB; }
        else { const int T2 = T - 8192, qw = T2 & 3; h16 = (T2 >> 2) & 15; b = T2 >> 6; r = TL + b * CTX + 64 * qw + F.lane; nkeys = CTX; }
        bf16_t* op = O + (size_t)r * D + h16 * 64;
        if (h16 < 8) attn_naive_task<96>(Qm + (size_t)r * QW + h16 * 96, Km + (size_t)b * KPB * QW + h16 * 96, QW, Vm + (size_t)b * KPB * 512 + h16 * 64, 512, nkeys, op);
        else { const int hh = h16 - 8, kvh = hh >> 2; attn_naive_task<64>(Qg + (size_t)r * 512 + hh * 64, Kg + (size_t)b * KPB * 128 + kvh * 64, 128, Vg + (size_t)b * KPB * 128 + kvh * 64, 128, nkeys, op); }
    }
}

typedef float f32x16 __attribute__((ext_vector_type(16)));
typedef short s16x4 __attribute__((ext_vector_type(4)));
__device__ __forceinline__ s16x4 vtr(const LAS unsigned char* p) { return __builtin_bit_cast(s16x4, __builtin_amdgcn_ds_read_tr16_b64_v4i16((LAS s16x4*)p)); }
__device__ __forceinline__ unsigned cvtpk(float lo, float hi) { typedef __bf16 bf2 __attribute__((ext_vector_type(2))); f32x2 v = {lo, hi}; bf2 b = __builtin_convertvector(v, bf2); return __builtin_bit_cast(unsigned, b); }
constexpr float ATT_THR = 6.0f;
constexpr int ATT_KSLOT = 12288, ATT_VSLOT = 8192, ATT_NKS = 3, ATT_NVS = 4, ATT_V0 = ATT_NKS * ATT_KSLOT;
__device__ __forceinline__ void att_glds16(const void* gsrc, unsigned lds_dst) { unsigned keep;
    asm volatile("s_mov_b32 %0, m0\n\ts_mov_b32 m0, %2\n\ts_nop 0\n\tglobal_load_lds_dwordx4 %1, off\n\ts_mov_b32 m0, %0" : "=&s"(keep) : "v"(gsrc), "s"(lds_dst) : "memory"); }
#define ATT_WAITBAR(N) asm volatile("s_waitcnt vmcnt(" #N ") lgkmcnt(0)\n\ts_barrier" ::: "memory")
template <int QD>
__device__ __forceinline__ void attn_unit(LAS unsigned char* lds, int tid, const bf16_t* Kb, int kstride, const bf16_t* Vb, int vstride, int ntiles, const bf16_t* qrow, bf16_t* orow) {
    constexpr int NC = QD / 8, NS = QD / 16;
    const int lane = tid & 63, r32 = lane & 31, hi = lane >> 5;
    const int w = __builtin_amdgcn_readfirstlane(tid >> 6);
    const bool three = (NC == 12) && (w < 4);
    const int vp = (NC == 12) ? (w < 4 ? w + 4 : w - 4) : w;
    const bf16_t* ksrcA = Kb + (size_t)lane * kstride + w * 8;
    const bf16_t* ksrcB = Kb + (size_t)lane * kstride + (w + 8) * 8;
    const bf16_t* vsrc = Vb + (size_t)(16 * (vp & 3) + (lane >> 2)) * vstride + (vp >> 2) * 32 + (lane & 3) * 8;
    const size_t kstep = (size_t)64 * kstride, vstep = (size_t)64 * vstride;
    const unsigned lds0 = (unsigned)(size_t)lds;
#define ATT_DMA(t_, ks_, vs_) do { \
        att_glds16(ksrcA + (size_t)(t_) * kstep, (unsigned)__builtin_amdgcn_readfirstlane((int)(lds0 + (ks_) * ATT_KSLOT + w * 1024))); \
        if (three) att_glds16(ksrcB + (size_t)(t_) * kstep, (unsigned)__builtin_amdgcn_readfirstlane((int)(lds0 + (ks_) * ATT_KSLOT + (w + 8) * 1024))); \
        att_glds16(vsrc + (size_t)(t_) * vstep, (unsigned)__builtin_amdgcn_readfirstlane((int)(lds0 + ATT_V0 + (vs_) * ATT_VSLOT + vp * 1024))); } while (0)
    ATT_DMA(0, 0, 0);
    if (ntiles > 1) ATT_DMA(1, 1, 1);
    bf16x8 qr[NS];
#pragma unroll
    for (int s = 0; s < NS; ++s) qr[s] = *(const bf16x8*)(qrow + 16 * s + 8 * hi);
    f32x16 o0, o1, negm, p0, p1;
#pragma unroll
    for (int r = 0; r < 16; ++r) { o0[r] = 0.f; o1[r] = 0.f; negm[r] = 0.f; p0[r] = 0.f; p1[r] = 0.f; }
    float lsum = 0.f;
    const int kread = hi * 1024 + r32 * 16;
    const int vread = ATT_V0 + ((lane >> 4) & 1) * 32 + (lane & 3) * 8 + (4 * hi + ((lane & 15) >> 2)) * 64;
#define ATT_QK(ks_) do { const LAS unsigned char* kb_ = lds + (ks_) * ATT_KSLOT + kread; \
        _Pragma("unroll") for (int s = 0; s < NS; ++s) { \
            const bf16x8 a0 = *(const LAS bf16x8*)(kb_ + s * 2048), a1 = *(const LAS bf16x8*)(kb_ + s * 2048 + 512); \
            if (s == 0) { p0 = __builtin_amdgcn_mfma_f32_32x32x16_bf16(a0, qr[0], negm, 0, 0, 0); p1 = __builtin_amdgcn_mfma_f32_32x32x16_bf16(a1, qr[0], negm, 0, 0, 0); } \
            else { p0 = __builtin_amdgcn_mfma_f32_32x32x16_bf16(a0, qr[s], p0, 0, 0, 0); p1 = __builtin_amdgcn_mfma_f32_32x32x16_bf16(a1, qr[s], p1, 0, 0, 0); } } } while (0)
#define ATT_SOFT_PV(first_, vs_) do { \
        float mx = fmaxf(fmaxf(p0[0], p1[0]), p0[1]); \
        _Pragma("unroll") for (int r = 1; r < 16; ++r) mx = (r == 1) ? fmaxf(mx, p1[1]) : fmaxf(fmaxf(mx, p0[r]), p1[r]); \
        { auto rr = __builtin_amdgcn_permlane32_swap(__float_as_uint(mx), __float_as_uint(mx), false, false); mx = fmaxf(__uint_as_float(rr[0]), __uint_as_float(rr[1])); } \
        if ((first_) || __any(mx > ATT_THR)) { \
            const float dl = (first_) ? mx : fmaxf(mx, 0.f); \
            _Pragma("unroll") for (int r = 0; r < 16; ++r) { p0[r] -= dl; p1[r] -= dl; negm[r] -= dl; } \
            if (!(first_)) { const float f = __builtin_amdgcn_exp2f(-dl); lsum *= f; \
                _Pragma("unroll") for (int r = 0; r < 16; ++r) { o0[r] *= f; o1[r] *= f; } } \
        } \
        float rs = 0.f; \
        _Pragma("unroll") for (int r = 0; r < 16; ++r) { p0[r] = __builtin_amdgcn_exp2f(p0[r]); p1[r] = __builtin_amdgcn_exp2f(p1[r]); rs += p0[r] + p1[r]; } \
        lsum += rs; \
        u32x4 w0, w1, w2, w3; \
        w0.x = cvtpk(p0[0], p0[1]); w0.y = cvtpk(p0[2], p0[3]); w0.z = cvtpk(p0[4], p0[5]); w0.w = cvtpk(p0[6], p0[7]); \
        w1.x = cvtpk(p0[8], p0[9]); w1.y = cvtpk(p0[10], p0[11]); w1.z = cvtpk(p0[12], p0[13]); w1.w = cvtpk(p0[14], p0[15]); \
        w2.x = cvtpk(p1[0], p1[1]); w2.y = cvtpk(p1[2], p1[3]); w2.z = cvtpk(p1[4], p1[5]); w2.w = cvtpk(p1[6], p1[7]); \
        w3.x = cvtpk(p1[8], p1[9]); w3.y = cvtpk(p1[10], p1[11]); w3.z = cvtpk(p1[12], p1[13]); w3.w = cvtpk(p1[14], p1[15]); \
        const bf16x8 pa0 = __builtin_bit_cast(bf16x8, w0), pa1 = __builtin_bit_cast(bf16x8, w1), pa2 = __builtin_bit_cast(bf16x8, w2), pa3 = __builtin_bit_cast(bf16x8, w3); \
        const LAS unsigned char* vb_ = lds + (vs_) * ATT_VSLOT + vread; \
        o0 = __builtin_amdgcn_mfma_f32_32x32x16_bf16(ATT_VF(0, 0), pa0, o0, 0, 0, 0); \
        o1 = __builtin_amdgcn_mfma_f32_32x32x16_bf16(ATT_VF(1, 0), pa0, o1, 0, 0, 0); \
        o0 = __builtin_amdgcn_mfma_f32_32x32x16_bf16(ATT_VF(0, 1), pa1, o0, 0, 0, 0); \
        o1 = __builtin_amdgcn_mfma_f32_32x32x16_bf16(ATT_VF(1, 1), pa1, o1, 0, 0, 0); \
        o0 = __builtin_amdgcn_mfma_f32_32x32x16_bf16(ATT_VF(0, 2), pa2, o0, 0, 0, 0); \
        o1 = __builtin_amdgcn_mfma_f32_32x32x16_bf16(ATT_VF(1, 2), pa2, o1, 0, 0, 0); \
        o0 = __builtin_amdgcn_mfma_f32_32x32x16_bf16(ATT_VF(0, 3), pa3, o0, 0, 0, 0); \
        o1 = __builtin_amdgcn_mfma_f32_32x32x16_bf16(ATT_VF(1, 3), pa3, o1, 0, 0, 0); } while (0)
#define ATT_VF(d0, ks) ({ const s16x4 lo_ = vtr(vb_ + (d0) * 4096 + (ks) * 1024), hi_ = vtr(vb_ + (d0) * 4096 + (ks) * 1024 + 512); (bf16x8){lo_[0], lo_[1], lo_[2], lo_[3], hi_[0], hi_[1], hi_[2], hi_[3]}; })
#define ATT_ENDSTEP() do { if (issue) { if (three) ATT_WAITBAR(3); else ATT_WAITBAR(2); } else ATT_WAITBAR(0); \
        ks = (ks == ATT_NKS - 1) ? 0 : ks + 1; vs = (vs + 1) & (ATT_NVS - 1); } while (0)
    if (ntiles > 1) { if (three) ATT_WAITBAR(3); else ATT_WAITBAR(2); } else ATT_WAITBAR(0);
    int ks = 0, vs = 0;
    if (w < 4) {
        for (int t = 0; t < ntiles; ++t) {
            const bool issue = (t + 2 < ntiles);
            if (issue) ATT_DMA(t + 2, (ks >= 1) ? ks - 1 : ATT_NKS - 1, (vs + 2) & (ATT_NVS - 1));
            ATT_QK(ks);
            ATT_SOFT_PV(t == 0, vs);
            ATT_ENDSTEP();
        }
    } else {
        for (int t = 0; t < ntiles; ++t) {
            const bool issue = (t + 2 < ntiles);
            if (issue) ATT_DMA(t + 2, (ks >= 1) ? ks - 1 : ATT_NKS - 1, (vs + 2) & (ATT_NVS - 1));
            if (t > 0) ATT_SOFT_PV(t == 1, (vs + ATT_NVS - 1) & (ATT_NVS - 1));
            ATT_QK(ks);
            ATT_ENDSTEP();
        }
        ATT_SOFT_PV(ntiles == 1, (vs + ATT_NVS - 1) & (ATT_NVS - 1));
    }
#undef ATT_DMA
#undef ATT_QK
#undef ATT_SOFT_PV
#undef ATT_VF
#undef ATT_ENDSTEP
    { auto rr = __builtin_amdgcn_permlane32_swap(__float_as_uint(lsum), __float_as_uint(lsum), false, false); lsum = __uint_as_float(rr[0]) + __uint_as_float(rr[1]); }
    const float rl = 1.0f / lsum;
#pragma unroll
    for (int g = 0; g < 4; ++g) {
        u32x2 a, b2;
        a.x = cvtpk(o0[4 * g] * rl, o0[4 * g + 1] * rl); a.y = cvtpk(o0[4 * g + 2] * rl, o0[4 * g + 3] * rl);
        b2.x = cvtpk(o1[4 * g] * rl, o1[4 * g + 1] * rl); b2.y = cvtpk(o1[4 * g + 2] * rl, o1[4 * g + 3] * rl);
        *(u32x2*)(orow + 8 * g + 4 * hi) = a; *(u32x2*)(orow + 32 + 8 * g + 4 * hi) = b2;
    }
    asm volatile("s_waitcnt lgkmcnt(0)\n\ts_barrier" ::: "memory");
}
__device__ __forceinline__ void phase_attn(const Ctx& F, KP kp, bool last) {
    const Args a = ldargs(kp);
    unsigned char* ws = a.ws;
    const bf16_t* Qm = (const bf16_t*)(ws + WS_QM); const bf16_t* Km = (const bf16_t*)(ws + WS_KM); const bf16_t* Vm = (const bf16_t*)(ws + WS_VM);
    const bf16_t* Qg = (const bf16_t*)(ws + WS_QG); const bf16_t* Kg = (const bf16_t*)(ws + WS_KG); const bf16_t* Vg = (const bf16_t*)(ws + WS_VG);
    bf16_t* O = (bf16_t*)(ws + WS_O);
    const int xcd = F.vcu >> 5, cix = F.vcu & 31, r32 = F.lane & 31, w = F.wave;
    const int nun = last ? 8 : 9;
    for (int i = 0; i < nun; ++i) {
        if (i < 8 && (i & 1) == 0) {
            const int pair = xcd * 16 + (i >> 1) * 4 + (cix >> 3), b = pair >> 3, h = pair & 7, qb = cix & 7;
            const int row = b * SEQ + qb * 256 + w * 32 + r32;
            attn_unit<96>(F.lds, F.tid, Km + (size_t)b * KPB * QW + h * 96, QW, Vm + (size_t)b * KPB * 512 + h * 64, 512, KPB / 64, Qm + (size_t)row * QW + h * 96, O + (size_t)row * D + h * 64);
        } else if (i < 8) {
            const int pair = xcd * 4 + (i >> 1), b = pair >> 1, kvh = pair & 1, hh = kvh * 4 + (w >> 1);
            const int row = b * SEQ + cix * 64 + (w & 1) * 32 + r32;
            attn_unit<64>(F.lds, F.tid, Kg + (size_t)b * KPB * 128 + kvh * 64, 128, Vg + (size_t)b * KPB * 128 + kvh * 64, 128, KPB / 64, Qg + (size_t)row * 512 + hh * 64, O + (size_t)row * D + 512 + hh * 64);
        } else if (F.vcu < 128) {
            const int b = F.vcu >> 3, h = F.vcu & 7, row = TL + b * CTX + w * 32 + r32;
            attn_unit<96>(F.lds, F.tid, Km + (size_t)b * KPB * QW + h * 96, QW, Vm + (size_t)b * KPB * 512 + h * 64, 512, CTX / 64, Qm + (size_t)row * QW + h * 96, O + (size_t)row * D + h * 64);
        } else {
            const int idx = F.vcu - 128, b = idx >> 3, kvh = (idx >> 2) & 1, qb = idx & 3, hh = kvh * 4 + (w >> 1);
            const int row = TL + b * CTX + qb * 64 + (w & 1) * 32 + r32;
            attn_unit<64>(F.lds, F.tid, Kg + (size_t)b * KPB * 128 + kvh * 64, 128, Vg + (size_t)b * KPB * 128 + kvh * 64, 128, CTX / 64, Qg + (size_t)row * 512 + hh * 64, O + (size_t)row * D + 512 + hh * 64);
        }
    }
}
__global__ void __launch_bounds__(NTHREADS, 2) fwd_kernel(Args a_unused) {
    extern __shared__ __attribute__((aligned(16))) unsigned char lds_raw[];
    const KP kp = (KP)__builtin_amdgcn_kernarg_segment_ptr();
    Ctx F;
    F.lds = (LAS unsigned char*)lds_raw;
    F.tid = threadIdx.x; F.lane = F.tid & 63; F.wave = __builtin_amdgcn_readfirstlane(F.tid >> 6);
    F.bk = blockIdx.x; F.vcu = (F.bk & 7) * (GRID / 8) + (F.bk >> 3);
    if (F.tid < 4) ((volatile LAS unsigned*)(F.lds + MISC_BAR))[F.tid] = 0u;
    __syncthreads();
    { const Args a = ldargs(kp); (void)xcd_barrier_post((unsigned*)(a.ws + WS_CTL), (volatile LAS unsigned*)(F.lds + MISC_BAR), F.tid == 0); }
#define FRESH() do { int ln_; asm volatile("v_mbcnt_lo_u32_b32 %0, -1, 0\n\tv_mbcnt_hi_u32_b32 %0, -1, %0" : "=v"(ln_)); F.lane = ln_; F.tid = F.wave * 64 + ln_; F.bk = blockIdx.x; F.vcu = (F.bk & 7) * (GRID / 8) + (F.bk >> 3); } while (0)
#define GRID_BAR() do { XcdBarrier b_; { const Args a_ = ldargs(kp); b_.bar = (unsigned*)(a_.ws + WS_CTL); } b_.x = xb_xcc_id(); b_.st = (volatile LAS unsigned*)(F.lds + MISC_BAR); xcd_barrier(b_, F.tid == 0); } while (0)

    for (int rep_ = 0; rep_ < REP_PRO; ++rep_) prologue1(F, kp);
    GRID_BAR(); FRESH();
    prologue2(F, kp);
    prologue3(F, kp);
    GRID_BAR(); FRESH();

    for (int l = 0; l < NL; ++l) {
        const bool last = (l == NL - 1);
        const int ntok = last ? TL : MT;
        { const Args a = ldargs(kp); unsigned char* ws = a.ws;
          Gemm g{(const bf16_t*)(ws + WS_H), D, (const bf16_t*)(ws + WS_WIN) + (size_t)l * ZW * D, D}; StaticOrder S; S.init(MT, ZW, GRID, F.bk); EpiZ E{(bf16_t*)(ws + WS_Z)}; gemm_phase<0>(F, g, S, E); }
        if (F.bk >= (MT / 256) * (ZW / 256) - 3 * GRID) conv_filler(F, kp, l, FILL_P1);
        GRID_BAR(); FRESH();
        for (int rep_ = 0; rep_ < REP_P2; ++rep_) phase_split(F, kp, l);
        GRID_BAR(); FRESH();
        { const Args a = ldargs(kp); unsigned char* ws = a.ws;
          Gemm g{(const bf16_t*)(ws + WS_Z), ZW, (const bf16_t*)(ws + WS_WQ) + (size_t)l * QW * 384, 384}; StaticOrder S; S.init(MT, QW, GRID, F.bk);
          EpiQ E{(bf16_t*)(ws + WS_QM), (const float*)(ws + WS_RSTDQ), (const f32x2*)(ws + WS_TAB32)}; gemm_phase<1>(F, g, S, E); }
        FRESH();
        { const Args a = ldargs(kp); unsigned char* ws = a.ws;
          Gemm g{(const bf16_t*)(ws + WS_Z) + 384, ZW, (const bf16_t*)(ws + WS_WKV) + (size_t)l * KVW * 256, 256}; StaticOrder S; S.init(MT, KVW, GRID, (F.bk + 80) & 255);
          EpiKV E{(bf16_t*)(ws + WS_KM), (bf16_t*)(ws + WS_VM), (const float*)(ws + WS_RSTDKV)}; gemm_phase<2>(F, g, S, E); }
        GRID_BAR(); FRESH();
#if USE_MFMA_ATTN
        for (int rep_ = 0; rep_ < REP_ATTN; ++rep_) phase_attn(F, kp, last);
#else
        phase_attn_naive(F, kp, last);
#endif
        GRID_BAR(); FRESH();
        { const Args a = ldargs(kp); unsigned char* ws = a.ws;
          Gemm g{(const bf16_t*)(ws + WS_O), D, (const bf16_t*)(ws + WS_WO) + (size_t)l * D * D, D}; StaticOrder S; S.init(ntok, D, GRID, F.bk);
          EpiYo E{(bf16_t*)(ws + WS_U)}; gemm_phase<3>(F, g, S, E); }
        if (!last && F.bk >= (MT / 256) * (D / 256) - 2 * GRID) conv_filler(F, kp, l, FILL_P5);
        GRID_BAR(); FRESH();
        for (int rep_ = 0; rep_ < REP_P6; ++rep_) phase_ln1_route(F, kp, l, ntok);
        GRID_BAR(); FRESH();
        for (int rep_ = 0; rep_ < REP_P7; ++rep_) phase_dispatch(F, kp, l, ntok);
        GRID_BAR(); FRESH();
        { const Args a = ldargs(kp); unsigned char* ws = a.ws;
          Gemm g{(const bf16_t*)(ws + WS_H), D, (const bf16_t*)(ws + WS_WGU) + (size_t)l * NEXP * 1024 * D, D}; GroupedOrder S; S.init((const volatile LAS int*)(F.lds + MISC_POFF), GRID, F.vcu);
          LAS int* gt = (LAS int*)(F.lds + STAGE_BYTES);
          { const int* postok = (const int*)(ws + WS_POSTOK); Unit u; for (int i = 0; i < 16 && S.next(i, u); ++i) if (F.tid < 256) gt[i * 256 + F.tid] = postok[u.pm * 256 + F.tid]; }
          __syncthreads();
          EpiAct E{(bf16_t*)(ws + WS_ACT)}; gemm_phase_gather<4>(F, g, S, E, gt); }
        GRID_BAR(); FRESH();
        { const Args a = ldargs(kp); unsigned char* ws = a.ws;
          Gemm g{(const bf16_t*)(ws + WS_ACT), FF, (const bf16_t*)(ws + WS_WD) + (size_t)l * NEXP * D * FF, FF}; GroupedOrder S; S.init((const volatile LAS int*)(F.lds + MISC_POFF), GRID, F.vcu);
          EpiY E{(bf16_t*)(ws + WS_XS)}; gemm_phase<5>(F, g, S, E); }
        GRID_BAR(); FRESH();
        for (int rep_ = 0; rep_ < REP_P10; ++rep_) phase_ln2(F, kp, l, ntok, true);
        phase_ln2(F, kp, l, ntok);
        GRID_BAR(); FRESH();
    }
}

extern "C" void kernel_launch(void* const* d_in, const int* in_sizes, int n_in, void* d_out, int out_size, void* d_ws, size_t ws_size, hipStream_t stream) {
    static int grid = 0;
    if (grid == 0) {
        if (n_in != 25 || out_size != TL * D || ws_size < WS_END) { fprintf(stderr, "kernel_launch: unexpected shapes (n_in %d out %d ws %zu need %zu)\n", n_in, out_size, ws_size, (size_t)WS_END); grid = -1; return; }
        int dev = 0, cus = 0, per_cu = 0;
        if (hipGetDevice(&dev) != hipSuccess || hipDeviceGetAttribute(&cus, hipDeviceAttributeMultiprocessorCount, dev) != hipSuccess) { grid = -1; return; }
        if (hipFuncSetAttribute((const void*)fwd_kernel, hipFuncAttributeMaxDynamicSharedMemorySize, LDS_BYTES) != hipSuccess) { fprintf(stderr, "kernel_launch: hipFuncSetAttribute failed\n"); grid = -1; return; }
        if (hipOccupancyMaxActiveBlocksPerMultiprocessor(&per_cu, (const void*)fwd_kernel, NTHREADS, LDS_BYTES) != hipSuccess || per_cu < 1) { fprintf(stderr, "kernel_launch: occupancy query says %d\n", per_cu); }
        (void)hipGetLastError();
        grid = (cus == 256) ? 256 : -1;
        if (grid < 0) { fprintf(stderr, "kernel_launch: need a 256-CU device, got %d\n", cus); return; }
    }
    if (grid < 0) return;
    if (hipMemsetAsync((char*)d_ws + WS_CTL, 0, CTL_BYTES, stream) != hipSuccess) return;
    Args a{};
    a.x = (const float*)d_in[0]; a.c = (const float*)d_in[1]; a.ctx = (const float*)d_in[2]; a.c_ctx = (const float*)d_in[3]; a.w_ada = (const float*)d_in[4]; a.b_ada = (const float*)d_in[5];
    a.w_in = (const float*)d_in[6]; a.g_q_a = (const float*)d_in[7]; a.w_q_b = (const float*)d_in[8]; a.g_kv_a = (const float*)d_in[9]; a.w_kv_b = (const float*)d_in[10];
    a.g_gq = (const float*)d_in[11]; a.g_gk = (const float*)d_in[12]; a.w_o = (const float*)d_in[13]; a.ln1_g = (const float*)d_in[14]; a.ln1_b = (const float*)d_in[15];
    a.w_rg = (const float*)d_in[16]; a.b_rg = (const float*)d_in[17]; a.w_re = (const float*)d_in[18]; a.b_re = (const float*)d_in[19];
    a.w_gate = (const float*)d_in[20]; a.w_up = (const float*)d_in[21]; a.w_down = (const float*)d_in[22]; a.ln2_g = (const float*)d_in[23]; a.ln2_b = (const float*)d_in[24];
    a.out = (float*)d_out; a.ws = (unsigned char*)d_ws;
    hipLaunchKernelGGL(fwd_kernel, dim3(grid), dim3(NTHREADS), LDS_BYTES, stream, a);
}
```

```cpp
#include <hip/hip_runtime.h>
#include <cstdint>
#include <cstdio>

#ifndef REP_ATTN
#define REP_ATTN 1
#endif
#ifndef REP_GEMM
#define REP_GEMM 1
#endif
#ifndef REP_PRO
#define REP_PRO 1
#endif
#ifndef REP_THIN
#define REP_THIN 1
#endif
#ifndef REP_P2
#define REP_P2 1
#endif
#ifndef REP_P7
#define REP_P7 1
#endif
#ifndef REP_P6
#define REP_P6 1
#endif
#ifndef REP_P10
#define REP_P10 0
#endif
#ifndef FILL_P1
#define FILL_P1 3
#endif
#ifndef FILL_P5
#define FILL_P5 3
#endif
#ifndef USE_MFMA_GEMM
#define USE_MFMA_GEMM 1
#endif
#ifndef USE_MFMA_ATTN
#define USE_MFMA_ATTN 1
#endif

#define GAS __attribute__((address_space(1)))
#define LAS __attribute__((address_space(3)))
typedef unsigned short bf16_t;
typedef float f32x4 __attribute__((ext_vector_type(4)));
typedef float f32x2 __attribute__((ext_vector_type(2)));
typedef unsigned u32x4 __attribute__((ext_vector_type(4)));
typedef unsigned u32x2 __attribute__((ext_vector_type(2)));
typedef short bf16x8 __attribute__((ext_vector_type(8)));

constexpr int D = 1024, NB = 16, SEQ = 2048, CTX = 256, NL = 4;
constexpr int TL = NB * SEQ, TC = NB * CTX, MT = TL + TC;
constexpr int KPB = CTX + SEQ;
constexpr int ZW = 1536;
constexpr int QW = 768, KVW = 1024;
constexpr int NEXP = 32, FF = 512;
constexpr int XS_ROWS = 81920;
constexpr float ALPHA = 1.6817928305074290f;
constexpr float LOG2E = 1.4426950408889634f;
constexpr float QSCALE_M = 0.10206207261596575f * LOG2E;
constexpr float QSCALE_G = 0.125f * LOG2E;
constexpr float RMS_EPS = 1e-6f, LN_EPS = 1e-5f;
constexpr int NWAVES = 8, NTHREADS = 512, GRID = 256;

constexpr size_t al256(size_t x) { return (x + 255) & ~(size_t)255; }
constexpr size_t WS_CTL = 0, CTL_BYTES = 65536;
constexpr size_t WS_BLKCNT = WS_CTL + CTL_BYTES;
constexpr size_t WS_MOETAB = WS_BLKCNT + (size_t)NL * 256 * 32 * 4;
constexpr size_t WS_MOD = WS_MOETAB + (size_t)NL * 128 * 4;
constexpr size_t WS_MODP = WS_MOD + (size_t)NL * 17 * 6144 * 4;
constexpr size_t WS_TAB64 = WS_MODP + (size_t)4 * NL * 17 * 6144 * 4;
constexpr size_t WS_TAB32 = WS_TAB64 + 64 * 16 * 8;
constexpr size_t WS_RSTDQ = WS_TAB32 + 64 * 8 * 8;
constexpr size_t WS_RSTDKV = WS_RSTDQ + (size_t)MT * 4;
constexpr size_t WS_TOKE = WS_RSTDKV + (size_t)MT * 4;
constexpr size_t WS_TOKR = WS_TOKE + (size_t)MT * 8;
constexpr size_t WS_TOKP = WS_TOKR + (size_t)MT * 8;
constexpr size_t WS_TOKW = WS_TOKP + (size_t)MT * 8;
constexpr size_t WS_WIN = al256(WS_TOKW + (size_t)MT * 8);
constexpr size_t WS_WQ = WS_WIN + (size_t)NL * ZW * D * 2;
constexpr size_t WS_WKV = WS_WQ + (size_t)NL * QW * 384 * 2;
constexpr size_t WS_WO = WS_WKV + (size_t)NL * KVW * 256 * 2;
constexpr size_t WS_WGU = WS_WO + (size_t)NL * D * D * 2;
constexpr size_t WS_WD = WS_WGU + (size_t)NL * NEXP * 1024 * D * 2;
constexpr size_t WS_XC = WS_WD + (size_t)NL * NEXP * D * FF * 2;
constexpr size_t WS_H = WS_XC + (size_t)TC * D * 4;
constexpr size_t WS_B = WS_H + (size_t)MT * D * 2;
constexpr size_t WS_Z = WS_B;
constexpr size_t WS_QM = WS_Z + (size_t)MT * ZW * 2;
constexpr size_t WS_KM = WS_QM + (size_t)MT * QW * 2;
constexpr size_t WS_VM = WS_KM + (size_t)MT * QW * 2;
constexpr size_t WS_QG = WS_VM + (size_t)MT * 512 * 2;
constexpr size_t WS_KG = WS_QG + (size_t)MT * 512 * 2;
constexpr size_t WS_VG = WS_KG + (size_t)MT * 128 * 2;
constexpr size_t WS_O = WS_VG + (size_t)MT * 128 * 2;
constexpr size_t WS_BEND = WS_O + (size_t)MT * D * 2;
constexpr size_t WS_U = WS_B;
constexpr size_t WS_XS = WS_B;
constexpr size_t WS_ACT = WS_XS + (size_t)XS_ROWS * D * 2;
constexpr size_t WS_HLO = WS_BEND;
constexpr size_t WS_WR = WS_HLO + (size_t)MT * D * 2;
constexpr size_t WS_POSTOK = WS_WR + (size_t)NL * 2 * 48 * D * 2;
constexpr size_t WS_XB = al256(WS_POSTOK + (size_t)XS_ROWS * 4);
constexpr size_t WS_END = WS_XB + (size_t)MT * D * 2;
static_assert(WS_U + (size_t)MT * D * 4 <= WS_KM, "U must fit in Z+QM");
static_assert(WS_ACT + (size_t)XS_ROWS * FF * 2 <= WS_BEND, "MoE buffers must fit in region B");
static_assert(WS_END < (size_t)1100 * 1000 * 1000, "workspace map too large");

constexpr int LDS_BYTES = 163840;
constexpr int BIG_BYTES = 147456;
constexpr int MISC_OFF = BIG_BYTES;
constexpr int MISC_BAR = MISC_OFF;
constexpr int MISC_CNT = MISC_OFF + 64;
constexpr int MISC_POFF = MISC_OFF + 256;
constexpr int MISC_TOT = MISC_OFF + 512;
constexpr int MISC_BASE = MISC_OFF + 768;
constexpr int MISC_PA = MISC_OFF + 1024;
constexpr int MISC_PB = MISC_OFF + 1024 + 2048;
constexpr int MISC_LG = MISC_OFF + 8192;

#define LDS_WAIT() asm volatile("s_waitcnt lgkmcnt(0)" ::: "memory")
__device__ __forceinline__ unsigned f2bf(float f) { unsigned u = __builtin_bit_cast(unsigned, f); return (u + 0x7fffu + ((u >> 16) & 1u)) >> 16; }
__device__ __forceinline__ unsigned pk2(float lo, float hi) { typedef __bf16 bf2_t __attribute__((ext_vector_type(2))); f32x2 v = {lo, hi}; bf2_t b = __builtin_convertvector(v, bf2_t); return __builtin_bit_cast(unsigned, b); }
__device__ __forceinline__ float bflo(unsigned w) { return __builtin_bit_cast(float, w << 16); }
__device__ __forceinline__ float bfhi(unsigned w) { return __builtin_bit_cast(float, w & 0xffff0000u); }
__device__ __forceinline__ float wave_sum(float v) {
#pragma unroll
    for (int o = 1; o < 64; o <<= 1) v += __shfl_xor(v, o);
    return v;
}
__device__ __forceinline__ int krow_of(int r) { return r < TL ? (r >> 11) * KPB + CTX + (r & 2047) : ((r - TL) >> 8) * KPB + ((r - TL) & 255); }
__device__ __forceinline__ int bb_of(int r) { return r < TL ? (r >> 11) : 16; }

#define XB_TMO      128
#define XB_XCNT(j)  (256  + 64 * (j))
#define XB_XSUB(j)  (1280 + 64 * (j))
#define XB_XGEN(j)  (2304 + 64 * (j))
#define XB_TOP      3328
#define XB_TOPGEN   3392
#define XCD_BAR_WORDS 3456
#define XB_SPIN_CAP (1u << 18)
__device__ __forceinline__ unsigned xb_ld(unsigned* p)              { return __hip_atomic_load(p, __ATOMIC_RELAXED, __HIP_MEMORY_SCOPE_AGENT); }
__device__ __forceinline__ unsigned xb_add(unsigned* p, unsigned v) { return __hip_atomic_fetch_add(p, v, __ATOMIC_RELAXED, __HIP_MEMORY_SCOPE_AGENT); }
__device__ __forceinline__ unsigned xb_xcc_id() { return (unsigned)__builtin_amdgcn_s_getreg((3 << 11) | 20) & 0xFu; }
#define XB_SPIN(cond, bar) do { unsigned _sp = 0; while (cond) { __builtin_amdgcn_s_sleep(1); \
    if ((++_sp & 255u) == 0u) { if (xb_ld(&(bar)[XB_TMO])) break; if (_sp > XB_SPIN_CAP) { atomicAdd(&(bar)[XB_TMO], 1u); break; } } } } while (0)
struct XcdBarrier { unsigned* bar; unsigned x; volatile LAS unsigned* st; };
__device__ __forceinline__ XcdBarrier xcd_barrier_post(unsigned* bar, volatile LAS unsigned* st, const bool leader) {
    XcdBarrier b; b.bar = bar; b.x = xb_xcc_id(); b.st = st;
    if (leader) (void)xb_add(&bar[XB_XCNT(b.x)], 1u);
    return b;
}
__device__ __forceinline__ void xcd_barrier_complete(unsigned* bar, unsigned x, unsigned& nloc, unsigned& nx) {
    const unsigned G = gridDim.x * gridDim.y * gridDim.z;
    unsigned sum, cnt, mine, sp = 0u;
    for (;;) {
        sum = 0u; cnt = 0u; mine = 0u;
#pragma unroll
        for (unsigned j = 0; j < 16; ++j) { const unsigned c = xb_ld(&bar[XB_XCNT(j)]); sum += c; cnt += (c > 0u) ? 1u : 0u; mine = (j == x) ? c : mine; }
        if (sum == G) break;
        __builtin_amdgcn_s_sleep(1);
        if ((++sp & 255u) == 0u) { if (xb_ld(&bar[XB_TMO])) break; if (sp > XB_SPIN_CAP) { atomicAdd(&bar[XB_TMO], 1u); break; } }
    }
    nloc = mine > 0u ? mine : 1u; nx = cnt > 0u ? cnt : 1u;
}
__device__ __forceinline__ void xcd_barrier(const XcdBarrier& b, const bool leader) {
    asm volatile("s_waitcnt vmcnt(0)" ::: "memory");
    __syncthreads();
    if (leader) {
        unsigned* bar = b.bar;
        __builtin_amdgcn_s_waitcnt(0);
        unsigned nloc = b.st[0], nx = b.st[1];
        if (nloc == 0u) { xcd_barrier_complete(bar, b.x, nloc, nx); b.st[0] = nloc; b.st[1] = nx; }
        const unsigned old = xb_add(&bar[XB_XSUB(b.x)], 1u);
        const unsigned gen = old / nloc;
        if (old + 1u == (gen + 1u) * nloc) {
            __builtin_amdgcn_fence(__ATOMIC_RELEASE, "agent");
            asm volatile("s_waitcnt vmcnt(0)" ::: "memory");
            const unsigned og = xb_add(&bar[XB_TOP], 1u);
            const unsigned tg = og / nx;
            if (og + 1u == (tg + 1u) * nx) xb_add(&bar[XB_TOPGEN], 1u);
            else XB_SPIN(xb_ld(&bar[XB_TOPGEN]) == tg, bar);
            __builtin_amdgcn_fence(__ATOMIC_ACQUIRE, "agent");
            xb_add(&bar[XB_XGEN(b.x)], 1u);
            asm volatile("s_waitcnt vmcnt(0)" ::: "memory");
        } else {
            XB_SPIN(xb_ld(&bar[XB_XGEN(b.x)]) == gen, bar);
            __builtin_amdgcn_fence(__ATOMIC_ACQUIRE, "agent");
            asm volatile("s_waitcnt vmcnt(0)" ::: "memory");
        }
    }
    __syncthreads();
}

struct Args {
    const float* x; const float* c; const float* ctx; const float* c_ctx; const float* w_ada; const float* b_ada; const float* w_in;
    const float* g_q_a; const float* w_q_b; const float* g_kv_a; const float* w_kv_b; const float* g_gq; const float* g_gk; const float* w_o;
    const float* ln1_g; const float* ln1_b; const float* w_rg; const float* b_rg; const float* w_re; const float* b_re;
    const float* w_gate; const float* w_up; const float* w_down; const float* ln2_g; const float* ln2_b;
    float* out; unsigned char* ws;
};

typedef const __attribute__((address_space(4))) Args* KP;
__device__ __forceinline__ Args ldargs(KP p) {
#if defined(__HIP_DEVICE_COMPILE__)
    asm volatile("" : "+s"(p)); return *p;
#else
    return Args{};
#endif
}

struct Ctx {
    LAS unsigned char* lds;
    int tid, lane, wave, vcu, bk;
};

struct Unit { int pm, pn; };
constexpr int BM = 256, NXCD = 8, WGM = 8;
struct StaticOrder {
    int nM, nN, nwg, G, c;
    __device__ void init(int M, int N, int G_, int c_) { nM = M / BM; nN = N / BM; nwg = nM * nN; G = G_; c = c_; }
    __device__ bool next(int i, Unit& u) const {
        const long L = (long)i * G + c; if (L >= nwg) return false;
        int wgid = (int)L; { const int q = nwg / NXCD, r = nwg % NXCD, xcd = wgid % NXCD, off = wgid / NXCD; wgid = (xcd < r ? xcd * (q + 1) : r * (q + 1) + (xcd - r) * q) + off; }
        const int nig = WGM * nN, gid = wgid / nig, fm = gid * WGM, gsz = (nM - fm) < WGM ? (nM - fm) : WGM;
        u.pm = fm + ((wgid % nig) % gsz); u.pn = (wgid % nig) / gsz; return true;
    }
    __device__ __forceinline__ void a_ready(const Unit&) const {}
    __device__ __forceinline__ void done(const Unit&) const {}
};
struct GroupedOrder {
    const volatile LAS int* poff; int nunits, G, c;
    __device__ void init(const volatile LAS int* poff_, int G_, int c_) { poff = poff_; nunits = (poff_[32] >> 8) * 4; G = G_; c = c_; }
    __device__ bool next(int i, Unit& u) const {
        const int L = i * G + c; if (L >= nunits) return false;
        const int rt = L >> 2, r0 = rt << 8; int e = 0;
#pragma unroll
        for (int j = 1; j < 32; ++j) e += (poff[j] <= r0) ? 1 : 0;
        u.pm = rt; u.pn = e * 4 + (L & 3); return true;
    }
    __device__ __forceinline__ void a_ready(const Unit&) const {}
    __device__ __forceinline__ void done(const Unit&) const {}
};

__device__ __forceinline__ void st_bf4(bf16_t* p, f32x4 v) { u32x2 w; w.x = pk2(v[0], v[1]); w.y = pk2(v[2], v[3]); *(u32x2*)p = w; }
struct EpiZ {
    bf16_t* Z;
    __device__ __forceinline__ void tile32(int row, int col, int fq, f32x4 v0, f32x4 v1) const {
        bf16_t* p = Z + (size_t)row * ZW + col + 4 * fq; st_bf4(p, v0); st_bf4(p + 16, v1);
    }
};
struct EpiQ {
    bf16_t* Qm; const float* rstd; const f32x2* tab32;
    __device__ __forceinline__ void tile32(int row, int col, int fq, f32x4 v0, f32x4 v1) const {
        const int h = col / 96, gi = (col - h * 96) >> 5;
        const float rs = rstd[row] * QSCALE_M;
        v0 = v0 * rs; v1 = v1 * rs;
        bf16_t* base = Qm + (size_t)row * QW + h * 96;
        if (gi < 2) { bf16_t* p = base + gi * 32 + 4 * fq; st_bf4(p, v0); st_bf4(p + 16, v1); }
        else {
            const int part = fq >> 1, f0 = (4 * fq) & 7;
            f32x4 o1 = v0, o2 = v1;
            if (row < TL) {
                const int s = row & 2047, pos = part ? (s & 63) : (s >> 6);
#pragma unroll
                for (int j = 0; j < 4; ++j) { const f32x2 cs = tab32[pos * 8 + f0 + j]; o1[j] = v0[j] * cs.x - v1[j] * cs.y; o2[j] = v1[j] * cs.x + v0[j] * cs.y; }
            }
            bf16_t* p = base + 64 + part * 16 + f0; st_bf4(p, o1); st_bf4(p + 8, o2);
        }
    }
};
struct EpiKV {
    bf16_t* Km; bf16_t* Vm; const float* rstd;
    __device__ __forceinline__ void tile32(int row, int col, int fq, f32x4 v0, f32x4 v1) const {
        const int h = col >> 7, w = col & 127; const float rs = rstd[row]; const int kr = krow_of(row);
        v0 = v0 * rs; v1 = v1 * rs;
        bf16_t* p = (w < 64) ? (Km + (size_t)kr * QW + h * 96 + w + 4 * fq) : (Vm + (size_t)kr * 512 + h * 64 + (w - 64) + 4 * fq);
        st_bf4(p, v0); st_bf4(p + 16, v1);
    }
};
struct EpiU {
    float* U; const float* xl; const float* xc; const float* mod_l;
    int gate;
    __device__ __forceinline__ void tile32(int row, int col, int fq, f32x4 v0, f32x4 v1) const {
        const float* xr = (row < TL) ? (xl + (size_t)row * D) : (xc + (size_t)(row - TL) * D);
        const float* g = mod_l + (size_t)(bb_of(row) * 6 + gate) * D;
        const int c0 = col + 4 * fq;
        const f32x4 x0 = *(const f32x4*)(xr + c0), x1 = *(const f32x4*)(xr + c0 + 16), g0 = *(const f32x4*)(g + c0), g1 = *(const f32x4*)(g + c0 + 16);
        float* u = U + (size_t)row * D + c0;
        *(f32x4*)u = x0 * ALPHA + g0 * v0; *(f32x4*)(u + 16) = x1 * ALPHA + g1 * v1;
    }
};
__device__ __forceinline__ float silu_f(float x) { return x * __builtin_amdgcn_rcpf(1.0f + __builtin_amdgcn_exp2f(-x * LOG2E)); }
struct EpiAct {
    bf16_t* Act;
    __device__ __forceinline__ void tile32(int row, int col, int fq, f32x4 v0, f32x4 v1) const {
        const int f0 = ((col & 1023) >> 1) + 4 * fq; f32x4 a;
#pragma unroll
        for (int j = 0; j < 4; ++j) a[j] = silu_f(v0[j]) * v1[j];
        st_bf4(Act + (size_t)row * FF + f0, a);
    }
};
struct EpiYo {
    bf16_t* Y;
    __device__ __forceinline__ void tile32(int row, int col, int fq, f32x4 v0, f32x4 v1) const {
        bf16_t* p = Y + (size_t)row * D + col + 4 * fq; st_bf4(p, v0); st_bf4(p + 16, v1);
    }
};
struct EpiY {
    bf16_t* Y;
    __device__ __forceinline__ void tile32(int row, int col, int fq, f32x4 v0, f32x4 v1) const {
        bf16_t* p = Y + (size_t)row * D + (col & 1023) + 4 * fq; st_bf4(p, v0); st_bf4(p + 16, v1);
    }
};

struct Gemm { const bf16_t* A; int lda; const bf16_t* Bt; int K; };
__device__ __forceinline__ float dot8(u32x4 a, u32x4 b, float acc) {
#pragma unroll
    for (int i = 0; i < 4; ++i) { acc += bflo(a[i]) * bflo(b[i]); acc += bfhi(a[i]) * bfhi(b[i]); }
    return acc;
}
template <class Sched, class Epi>
__device__ __forceinline__ void gemm_naive(const Ctx& F, const Gemm g, const Sched& S, const Epi& E) {
    Unit u;
    for (int i = 0; S.next(i, u); ++i) {
        for (int task = F.tid; task < 8192; task += NTHREADS) {
            const int lane = task & 63, fr = lane & 15, fq = lane >> 4, rest = task >> 6, rg = rest & 15, cg = rest >> 4;
            const int row = u.pm * 256 + rg * 16 + fr, col = u.pn * 256 + cg * 32;
            const bf16_t* ap = g.A + (size_t)row * g.lda;
            const bf16_t* bp0 = g.Bt + (size_t)(col + 4 * fq) * g.K;
            const bf16_t* bp1 = bp0 + (size_t)16 * g.K;
            f32x4 v0 = {0.f, 0.f, 0.f, 0.f}, v1 = {0.f, 0.f, 0.f, 0.f};
            for (int k = 0; k < g.K; k += 8) {
                const u32x4 a = *(const u32x4*)(ap + k);
#pragma unroll
                for (int j = 0; j < 4; ++j) {
                    v0[j] = dot8(a, *(const u32x4*)(bp0 + (size_t)j * g.K + k), v0[j]);
                    v1[j] = dot8(a, *(const u32x4*)(bp1 + (size_t)j * g.K + k), v1[j]);
                }
            }
            E.tile32(row, col, fq, v0, v1);
        }
    }
}
constexpr int BK = 64, HALF = 128, HTB = HALF * BK * 2, STAGE_BYTES = 8 * HTB;
__device__ __forceinline__ int lds_byte(int r, int c) { const int st = (r >> 4) * 2 + (c >> 5), rr = r & 15, cc = c & 31, ob = rr * 64 + cc * 2; return st * 1024 + (ob ^ (((ob >> 9) & 1) << 5)); }
__device__ __forceinline__ void stage_rc(int b, int& R, int& C) { const int st = b / 1024, sb = b % 1024, swz = sb ^ (((sb >> 9) & 1) << 5); R = (st >> 1) * 16 + swz / 64; C = (st & 1) * 32 + (swz % 64) / 2; }
template <class Epi, class Sched, bool ALIGN_EPI = true, bool SP2 = true, bool GATHER = false>
__device__ __forceinline__ void gemm_mfma(LAS unsigned char* lds, const int tid_in, const Gemm g, const Sched& S, const Epi& E, const LAS int* gtab = nullptr) {
    int tid = tid_in; asm volatile("" : "+v"(tid));
    const int wid = __builtin_amdgcn_readfirstlane(tid >> 6), lane = tid & 63, wr = wid >> 2, wc = wid & 3, fr = lane & 15, fq = lane >> 4;
    const int K = g.K, nt = K / BK;
    unsigned voffB[2]; int RA[2], CA[2];
#pragma unroll
    for (int i = 0; i < 2; ++i) { int R, C; stage_rc(tid * 16 + i * 8192, R, C); const int Rb = R;
        RA[i] = R; CA[i] = C; voffB[i] = (unsigned)(Rb * K + C) * 2u; }
    const size_t kstep = (size_t)(BK * 2);
    const size_t hstepA = (size_t)HALF * g.lda * 2, hstepB = (size_t)HALF * K * 2;
    const size_t tstepA = GATHER ? 0 : 2 * hstepA, tstepB = 2 * hstepB;
    unsigned vc0[2], vc1[2], vn0[2], vn1[2];
#define PG8_GOFF(dst0, dst1, ui_) do { _Pragma("unroll") for (int i_ = 0; i_ < 2; ++i_) { \
        if constexpr (GATHER) { dst0[i_] = (unsigned)gtab[(ui_) * 256 + RA[i_]] * (unsigned)(g.lda * 2) + (unsigned)CA[i_] * 2u; dst1[i_] = (unsigned)gtab[(ui_) * 256 + HALF + RA[i_]] * (unsigned)(g.lda * 2) + (unsigned)CA[i_] * 2u; } \
        else { dst0[i_] = (unsigned)(RA[i_] * g.lda + CA[i_]) * 2u; dst1[i_] = dst0[i_] + (unsigned)hstepA; } } } while (0)
    const unsigned ldsw = (unsigned)wid * 1024u;
    const int aoff = lds_byte(wr * 64 + fr, fq * 8), boff = lds_byte(wc * 32 + fr, fq * 8);
#define PG8_SA(b, h) (((b) * 2 + (h)) * HTB)
#define PG8_SB(b, h) ((4 + (b) * 2 + (h)) * HTB)
#define PG8_STAGE(bufoff, gbase, voff) do { _Pragma("unroll") for (int _i = 0; _i < 2; ++_i) \
        __builtin_amdgcn_global_load_lds((const unsigned*)((const char*)(gbase) + (voff)[_i]), (LAS unsigned*)(lds + (bufoff) + ldsw + _i * 8192), 16, 0, 0); } while (0)
#define PG8_LDA(dst, b, h) do { _Pragma("unroll") for (int m = 0; m < 4; ++m) _Pragma("unroll") for (int k = 0; k < 2; ++k) dst[m][k] = *(const LAS bf16x8*)(lds + PG8_SA(b, h) + aoff + m * 2048 + k * 1024); } while (0)
#define PG8_LDB(dst, b, h) do { _Pragma("unroll") for (int n = 0; n < 2; ++n) _Pragma("unroll") for (int k = 0; k < 2; ++k) dst[n][k] = *(const LAS bf16x8*)(lds + PG8_SB(b, h) + boff + n * 2048 + k * 1024); } while (0)
#define PG8_MMA(ai, bj, At, Bt) do { __builtin_amdgcn_s_setprio(1); _Pragma("unroll") for (int m = 0; m < 4; ++m) _Pragma("unroll") for (int n = 0; n < 2; ++n) _Pragma("unroll") for (int k = 0; k < 2; ++k) \
        acc[ai][bj][m][n] = __builtin_amdgcn_mfma_f32_16x16x32_bf16(Bt[n][k], At[m][k], acc[ai][bj][m][n], 0, 0, 0); __builtin_amdgcn_s_setprio(0); } while (0)
#define PG8_WAIT_V(n) asm volatile("s_waitcnt vmcnt(" #n ")" ::: "memory")
#define PG8_WAIT_L(n) asm volatile("s_waitcnt lgkmcnt(" #n ")" ::: "memory")
#define PG8_BAR __builtin_amdgcn_s_barrier()
#define PG8_SCHED __builtin_amdgcn_sched_barrier(0)
    Unit cur, nxt; int ui = 0;
    if (!S.next(0, cur)) return;
    PG8_GOFF(vc0, vc1, 0);
#pragma unroll
    for (int i = 0; i < 2; ++i) { vn0[i] = vc0[i]; vn1[i] = vc1[i]; }
    f32x4 acc[2][2][4][2];
#pragma unroll
    for (int a = 0; a < 2; ++a)
#pragma unroll
        for (int b = 0; b < 2; ++b)
#pragma unroll
            for (int m = 0; m < 4; ++m)
#pragma unroll
                for (int n = 0; n < 2; ++n) acc[a][b][m][n] = (f32x4){0.f, 0.f, 0.f, 0.f};
    bf16x8 At[4][2], B0[2][2], B1[2][2];
    const char* cA = (const char*)g.A + (size_t)cur.pm * tstepA; const char* cB = (const char*)g.Bt + (size_t)cur.pn * tstepB;
    S.a_ready(cur);
    if constexpr (SP2) {
        PG8_STAGE(PG8_SB(0, 0), cB, voffB); PG8_STAGE(PG8_SB(0, 1), cB + hstepB, voffB); PG8_STAGE(PG8_SA(0, 0), cA, vc0); PG8_STAGE(PG8_SA(0, 1), cA, vc1);
        if (wr == 1) PG8_BAR;
        PG8_WAIT_V(2); PG8_BAR;
        PG8_STAGE(PG8_SB(1, 0), cB + kstep, voffB); PG8_STAGE(PG8_SA(1, 0), cA + kstep, vc0); PG8_STAGE(PG8_SB(1, 1), cB + hstepB + kstep, voffB);
        PG8_WAIT_V(6); PG8_BAR;
    } else {
        PG8_STAGE(PG8_SB(0, 0), cB, voffB); PG8_STAGE(PG8_SA(0, 0), cA, vc0); PG8_STAGE(PG8_SB(0, 1), cB + hstepB, voffB); PG8_STAGE(PG8_SA(0, 1), cA, vc1);
        if (wr == 1) PG8_BAR;
        PG8_WAIT_V(4); PG8_BAR;
        PG8_STAGE(PG8_SB(1, 0), cB + kstep, voffB); PG8_STAGE(PG8_SA(1, 0), cA + kstep, vc0); PG8_STAGE(PG8_SB(1, 1), cB + hstepB + kstep, voffB);
        PG8_WAIT_V(6); PG8_BAR;
    }
    for (;;) {
        const bool has_next = S.next(ui + 1, nxt);
        if constexpr (GATHER) { if (has_next) { PG8_GOFF(vn0, vn1, ui + 1); } else {
#pragma unroll
            for (int i = 0; i < 2; ++i) { vn0[i] = vc0[i]; vn1[i] = vc1[i]; } } }
        const char* nA = has_next ? (const char*)g.A + (size_t)nxt.pm * tstepA : cA; const char* nB = has_next ? (const char*)g.Bt + (size_t)nxt.pn * tstepB : cB;
        for (int t = 0; t < nt; t += 2) {
            const bool last = (t == nt - 2);
            const char* a1 = cA + (size_t)(t + 1) * kstep;
            const char* a2 = last ? nA : cA + (size_t)(t + 2) * kstep; const char* b2 = last ? nB : cB + (size_t)(t + 2) * kstep;
            const char* a3 = a2 + kstep; const char* b3 = b2 + kstep;
            unsigned s0[2], s1[2];
#pragma unroll
            for (int i = 0; i < 2; ++i) { if constexpr (GATHER) { s0[i] = last ? vn0[i] : vc0[i]; s1[i] = last ? vn1[i] : vc1[i]; } else { s0[i] = vc0[i]; s1[i] = vc1[i]; } }
            if (last && has_next) S.a_ready(nxt);
            if constexpr (SP2) {
            PG8_LDB(B0, 0, 0); PG8_LDB(B1, 0, 1); PG8_SCHED; PG8_LDA(At, 0, 0); PG8_STAGE(PG8_SA(1, 1), a1, vc1);
            PG8_WAIT_V(8); PG8_WAIT_L(0); PG8_BAR; PG8_MMA(0, 0, At, B0); PG8_MMA(0, 1, At, B1); PG8_BAR; PG8_SCHED;
            PG8_LDA(At, 0, 1); PG8_STAGE(PG8_SB(0, 0), b2, voffB); PG8_STAGE(PG8_SB(0, 1), b2 + hstepB, voffB); PG8_STAGE(PG8_SA(0, 0), a2, s0);
            PG8_WAIT_V(8); PG8_WAIT_L(0); PG8_BAR; PG8_MMA(1, 0, At, B0); PG8_MMA(1, 1, At, B1); PG8_BAR; PG8_SCHED;
            PG8_LDB(B0, 1, 0); PG8_LDB(B1, 1, 1); PG8_SCHED; PG8_LDA(At, 1, 0); PG8_STAGE(PG8_SA(0, 1), a2, s1);
            PG8_WAIT_V(8); PG8_WAIT_L(0); PG8_BAR; PG8_MMA(0, 0, At, B0); PG8_MMA(0, 1, At, B1); PG8_BAR; PG8_SCHED;
            PG8_LDA(At, 1, 1); PG8_STAGE(PG8_SB(1, 0), b3, voffB); PG8_STAGE(PG8_SB(1, 1), b3 + hstepB, voffB); PG8_STAGE(PG8_SA(1, 0), a3, s0);
            PG8_WAIT_V(8); PG8_WAIT_L(0); PG8_BAR; PG8_MMA(1, 0, At, B0); PG8_MMA(1, 1, At, B1); PG8_BAR; PG8_SCHED;
            } else {
            PG8_LDB(B0, 0, 0); PG8_SCHED; PG8_LDA(At, 0, 0); PG8_STAGE(PG8_SA(1, 1), a1, vc1);
            PG8_WAIT_L(8); PG8_BAR; PG8_WAIT_L(0); PG8_MMA(0, 0, At, B0); PG8_BAR; PG8_SCHED;
            PG8_LDB(B1, 0, 1); PG8_STAGE(PG8_SB(0, 0), b2, voffB);
            PG8_BAR; PG8_WAIT_L(0); PG8_MMA(0, 1, At, B1); PG8_BAR;
            PG8_LDA(At, 0, 1); PG8_STAGE(PG8_SA(0, 0), a2, s0);
            PG8_BAR; PG8_WAIT_L(0); PG8_MMA(1, 0, At, B0); PG8_BAR; PG8_SCHED;
            PG8_STAGE(PG8_SB(0, 1), b2 + hstepB, voffB);
            PG8_WAIT_V(6); PG8_BAR; PG8_MMA(1, 1, At, B1); PG8_BAR;
            PG8_LDB(B0, 1, 0); PG8_SCHED; PG8_LDA(At, 1, 0); PG8_STAGE(PG8_SA(0, 1), a2, s1);
            PG8_WAIT_L(8); PG8_BAR; PG8_WAIT_L(0); PG8_MMA(0, 0, At, B0); PG8_BAR; PG8_SCHED;
            PG8_LDB(B1, 1, 1); PG8_STAGE(PG8_SB(1, 0), b3, voffB);
            PG8_BAR; PG8_WAIT_L(0); PG8_MMA(0, 1, At, B1); PG8_BAR;
            PG8_LDA(At, 1, 1); PG8_STAGE(PG8_SA(1, 0), a3, s0);
            PG8_BAR; PG8_WAIT_L(0); PG8_MMA(1, 0, At, B0); PG8_BAR; PG8_SCHED;
            PG8_STAGE(PG8_SB(1, 1), b3 + hstepB, voffB);
            PG8_WAIT_V(6); PG8_BAR; PG8_MMA(1, 1, At, B1); PG8_BAR;
            }
        }
        if constexpr (ALIGN_EPI) { if (wr == 0) PG8_BAR; }
        {
            int ln_e; asm volatile("v_mbcnt_lo_u32_b32 %0, -1, 0\n\tv_mbcnt_hi_u32_b32 %0, -1, %0" : "=v"(ln_e));
            const int fr_e = ln_e & 15, fq_e = ln_e >> 4;
#pragma unroll
            for (int ai = 0; ai < 2; ++ai)
#pragma unroll
                for (int m = 0; m < 4; ++m) {
#pragma unroll
                    for (int bj = 0; bj < 2; ++bj)
                        E.tile32(cur.pm * BM + ai * HALF + wr * 64 + m * 16 + fr_e, cur.pn * BM + bj * HALF + wc * 32, fq_e, acc[ai][bj][m][0], acc[ai][bj][m][1]);
                    asm volatile("" ::: "memory");
                }
            S.done(cur);
        }
        if (!has_next) break;
#pragma unroll
        for (int a = 0; a < 2; ++a)
#pragma unroll
            for (int b = 0; b < 2; ++b)
#pragma unroll
                for (int m = 0; m < 4; ++m)
#pragma unroll
                    for (int n = 0; n < 2; ++n) acc[a][b][m][n] = (f32x4){0.f, 0.f, 0.f, 0.f};
        cur = nxt; cA = nA; cB = nB; ++ui;
        if constexpr (GATHER) {
#pragma unroll
            for (int i = 0; i < 2; ++i) { vc0[i] = vn0[i]; vc1[i] = vn1[i]; } }
        if constexpr (ALIGN_EPI) { if (wr == 1) PG8_BAR; }
    }
    PG8_WAIT_V(0);
    if constexpr (!ALIGN_EPI) { if (wr == 0) PG8_BAR; }
    PG8_BAR;
#undef PG8_GOFF
#undef PG8_SA
#undef PG8_SB
#undef PG8_STAGE
#undef PG8_LDA
#undef PG8_LDB
#undef PG8_MMA
#undef PG8_WAIT_V
#undef PG8_WAIT_L
#undef PG8_BAR
#undef PG8_SCHED
}

#ifndef REP_GEMM_MASK
#define REP_GEMM_MASK 0
#endif
template <int ID, class Sched, class Epi>
__device__ __forceinline__ void gemm_phase_gather(const Ctx& F, const Gemm g, const Sched& S, const Epi& E, const LAS int* gtab) {
    gemm_mfma<Epi, Sched, true, true, true>(F.lds, F.tid, g, S, E, gtab);
    if constexpr ((REP_GEMM_MASK >> ID) & 1) gemm_mfma<Epi, Sched, true, true, true>(F.lds, F.tid, g, S, E, gtab);
}
template <int ID, class Sched, class Epi>
__device__ __forceinline__ void gemm_phase(const Ctx& F, const Gemm g, const Sched& S, const Epi& E) {
#if USE_MFMA_GEMM
    gemm_mfma<Epi, Sched, true, true>(F.lds, F.tid, g, S, E);
    if constexpr ((REP_GEMM_MASK >> ID) & 1) gemm_mfma<Epi, Sched, true, true>(F.lds, F.tid, g, S, E);
#else
    gemm_naive(F, g, S, E);
#endif
}

template <class ColPtr>
__device__ __forceinline__ void tconv_tile(const ColPtr& cp, int ldw, const float* scale, bf16_t* WT, int K, int k0, int p0, LAS float* scr, int lane) {
    const int pc = (lane & 15) * 4, kq = lane >> 4;
    const float* src = cp(p0 + pc);
#pragma unroll 4
    for (int i = 0; i < 16; ++i) {
        const int kk = 4 * i + kq;
        f32x4 v = {0.f, 0.f, 0.f, 0.f};
        if (src) { v = *(const f32x4*)(src + (size_t)(k0 + kk) * ldw); if (scale) v = v * scale[k0 + kk]; }
        LAS float* d = scr + kk * 65 + pc; d[0] = v[0]; d[1] = v[1]; d[2] = v[2]; d[3] = v[3];
    }
    LDS_WAIT();
    const int c = lane & 7;
#pragma unroll
    for (int j = 0; j < 8; ++j) {
        const int n = (lane >> 3) + 8 * j; const LAS float* s = scr + (8 * c) * 65 + n;
        u32x4 o; o.x = pk2(s[0], s[65]); o.y = pk2(s[2 * 65], s[3 * 65]); o.z = pk2(s[4 * 65], s[5 * 65]); o.w = pk2(s[6 * 65], s[7 * 65]);
        *(u32x4*)(WT + (size_t)(p0 + n) * K + k0 + 8 * c) = o;
    }
    LDS_WAIT();
}
struct CpPlain { const float* W; int ncols; __device__ __forceinline__ const float* operator()(int p) const { return p < ncols ? W + p : nullptr; } };
struct CpQ {
    const float* W;
    __device__ __forceinline__ const float* operator()(int p) const {
        const int h = p / 96, pp = p - h * 96; int lc = pp;
        if (pp >= 64) { const int rp = pp - 64, i = rp & 15; lc = 64 + (i >> 3) * 16 + (i & 7) + ((rp >> 4) ? 8 : 0); }
        return W + h * 96 + lc;
    }
};
struct CpGU {
    const float* Wg; const float* Wu;
    __device__ __forceinline__ const float* operator()(int p) const { const int g32 = p >> 5, w = p & 31; return (w < 16) ? (Wg + g32 * 16 + w) : (Wu + g32 * 16 + (w - 16)); }
};

constexpr int CONV_ITEMS = NEXP * 256 + NEXP * 128, CONV_CH = 4, CONV_CTR0 = 8192;
struct ConvSrc { const float* p; size_t ld; bf16_t* dst; int K; };
__device__ __forceinline__ ConvSrc conv_decode(const Args& a, int l, int idx, int lane) {
    const int pc = (lane & 15) * 4, kq = lane >> 4; ConvSrc r;
    if (idx < NEXP * 256) { const int e = idx >> 8, q = idx & 255, k0 = (q >> 4) * 64, p = (q & 15) * 64 + pc, g32 = p >> 5, w = p & 31; const size_t le = (size_t)l * NEXP + e;
        r.p = ((w < 16) ? (a.w_gate + le * D * FF + g32 * 16 + w) : (a.w_up + le * D * FF + g32 * 16 + (w - 16))) + (size_t)(k0 + kq) * FF; r.ld = FF;
        r.dst = (bf16_t*)(a.ws + WS_WGU) + le * 1024 * D + (size_t)((q & 15) * 64) * D + k0; r.K = D; }
    else { const int i2 = idx - NEXP * 256, e = i2 >> 7, q = i2 & 127, k0 = (q >> 4) * 64, p0 = (q & 15) * 64; const size_t le = (size_t)l * NEXP + e;
        r.p = a.w_down + le * FF * D + (size_t)(k0 + kq) * D + p0 + pc; r.ld = D;
        r.dst = (bf16_t*)(a.ws + WS_WD) + le * D * FF + (size_t)p0 * FF + k0; r.K = FF; }
    return r;
}
__device__ __forceinline__ void conv_load(const ConvSrc& c, f32x4 (&v)[16]) {
#pragma unroll
    for (int i = 0; i < 16; ++i) v[i] = *(const f32x4*)(c.p + (size_t)(4 * i) * c.ld);
}
__device__ __forceinline__ void conv_store(const ConvSrc& c, const f32x4 (&v)[16], LAS float* scr, int lane) {
    const int pc = (lane & 15) * 4, kq = lane >> 4;
#pragma unroll
    for (int i = 0; i < 16; ++i) { LAS float* d = scr + (4 * i + kq) * 65 + pc; d[0] = v[i][0]; d[1] = v[i][1]; d[2] = v[i][2]; d[3] = v[i][3]; }
    LDS_WAIT();
    const int cc = lane & 7;
#pragma unroll
    for (int j = 0; j < 8; ++j) {
        const int n = (lane >> 3) + 8 * j; const LAS float* sp = scr + (8 * cc) * 65 + n;
        u32x4 o; o.x = pk2(sp[0], sp[65]); o.y = pk2(sp[2 * 65], sp[3 * 65]); o.z = pk2(sp[4 * 65], sp[5 * 65]); o.w = pk2(sp[6 * 65], sp[7 * 65]);
        *(u32x4*)(c.dst + (size_t)n * c.K + 8 * cc) = o;
    }
    LDS_WAIT();
}
__device__ __forceinline__ void conv_experts(const Ctx& F, const Args& a, int l, int grabs) {
    unsigned* ctr = (unsigned*)(a.ws + WS_CTL) + CONV_CTR0 + 64 * l;
    LAS float* scr = (LAS float*)(F.lds + F.wave * 18432);
    for (int g = 0; grabs < 0 || g < grabs; ++g) {
        unsigned b0 = 0; if (F.lane == 0) b0 = __hip_atomic_fetch_add(ctr, (unsigned)CONV_CH, __ATOMIC_RELAXED, __HIP_MEMORY_SCOPE_AGENT);
        const int base = __builtin_amdgcn_readfirstlane((int)b0);
        if (base >= CONV_ITEMS) break;
        f32x4 va[16], vb[16];
        ConvSrc c0 = conv_decode(a, l, base, F.lane), c1 = conv_decode(a, l, base + 1, F.lane), c2 = conv_decode(a, l, base + 2, F.lane), c3 = conv_decode(a, l, base + 3, F.lane);
        conv_load(c0, va); conv_load(c1, vb); conv_store(c0, va, scr, F.lane);
        conv_load(c2, va); conv_store(c1, vb, scr, F.lane);
        conv_load(c3, vb); conv_store(c2, va, scr, F.lane);
        conv_store(c3, vb, scr, F.lane);
    }
}

__device__ __forceinline__ void conv_filler(const Ctx& F, KP kp, int l, int grabs) {
    const Args a = ldargs(kp);
    int q = l;
    if (l == 0 || (int)__hip_atomic_load((unsigned*)(a.ws + WS_CTL) + CONV_CTR0 + 64 * l, __ATOMIC_RELAXED, __HIP_MEMORY_SCOPE_AGENT) >= CONV_ITEMS) q = l + 1;
    if (q < NL) conv_experts(F, a, q, grabs);
}
__device__ __forceinline__ void prologue1(const Ctx& F, KP kp) {
    const Args a = ldargs(kp);
    unsigned char* ws = a.ws;
    {
        LAS float* sl = (LAS float*)F.lds;
        float* modp = (float*)(ws + WS_MODP);
        for (int it = F.bk; it < NL * 12 * 4; it += GRID) {
            const int kc = it & 3, nc = (it >> 2) % 12, l = it / 48;
            __syncthreads();
            for (int idx = F.tid; idx < 17 * 256; idx += NTHREADS) {
                const int bb = idx >> 8, k = idx & 255; const float v = (bb < 16) ? a.c[bb * D + kc * 256 + k] : a.c_ctx[kc * 256 + k];
                sl[idx] = v / (1.0f + __expf(-v));
            }
            __syncthreads();
            const int n = nc * 512 + F.tid;
            const float* w = a.w_ada + ((size_t)l * D + kc * 256) * 6144 + n;
            float acc[17];
#pragma unroll
            for (int bb = 0; bb < 17; ++bb) acc[bb] = 0.f;
            for (int k = 0; k < 256; ++k) {
                const float wv = w[(size_t)k * 6144];
#pragma unroll
                for (int bb = 0; bb < 17; ++bb) acc[bb] += sl[bb * 256 + k] * wv;
            }
#pragma unroll
            for (int bb = 0; bb < 17; ++bb) modp[((size_t)(kc * NL + l) * 17 + bb) * 6144 + n] = acc[bb];
        }
        __syncthreads();
    }
    {
        f32x2* t64 = (f32x2*)(ws + WS_TAB64); f32x2* t32 = (f32x2*)(ws + WS_TAB32);
        const int gt = F.bk * NTHREADS + F.tid;
        if (gt < 64 * 16) { const int pos = gt >> 4, f = gt & 15; const float inv = powf(10000.0f, -((float)(2 * f) / 32.0f)); const float ang = (float)pos * inv; t64[gt] = (f32x2){cosf(ang), sinf(ang)}; }
        else if (gt < 64 * 16 + 64 * 8) { const int g2 = gt - 64 * 16, pos = g2 >> 3, f = g2 & 7; const float inv = powf(10000.0f, -((float)(2 * f) / 16.0f)); const float ang = (float)pos * inv; t32[g2] = (f32x2){cosf(ang), sinf(ang)}; }
    }
    {
        bf16_t* wr = (bf16_t*)(ws + WS_WR);
        for (int i = F.bk * NTHREADS + F.tid; i < NL * 48 * D; i += GRID * NTHREADS) {
            const int c = i & 1023, j = (i >> 10) % 48, l = i / (48 * D);
            float wv = 0.f;
            if (j < 4) wv = a.w_rg[((size_t)l * D + c) * 4 + j]; else if (j < 36) wv = a.w_re[((size_t)l * D + c) * 32 + (j - 4)];
            const unsigned h = f2bf(wv); const float rem = wv - __builtin_bit_cast(float, h << 16);
            wr[((size_t)(l * 2 + 0) * 48 + j) * D + c] = (bf16_t)h; wr[((size_t)(l * 2 + 1) * 48 + j) * D + c] = (bf16_t)f2bf(rem);
        }
    }
    {
        LAS float* scr = (LAS float*)(F.lds + F.wave * 18432);
        const int gw = F.vcu * NWAVES + F.wave, NGW = GRID * NWAVES;
        constexpr int I_IN = 16 * 24, I_Q = 6 * 12, I_KV = 4 * 16, I_O = 16 * 16, I_GU = 16 * 16, I_D = 8 * 16;
        constexpr int N_SMALL = NL * (I_IN + I_Q + I_KV + I_O), N_GU = NL * NEXP * I_GU, N_D = NL * NEXP * I_D;
        for (int it = gw; it < N_SMALL; it += NGW) {
            {
                const int l = it / (I_IN + I_Q + I_KV + I_O); int r = it % (I_IN + I_Q + I_KV + I_O);
                if (r < I_IN) { const int kt = r / 24, pt = r % 24; tconv_tile(CpPlain{a.w_in + (size_t)l * D * 1440, 1440}, 1440, nullptr, (bf16_t*)(ws + WS_WIN) + (size_t)l * ZW * D, D, kt * 64, pt * 64, scr, F.lane); continue; }
                r -= I_IN;
                if (r < I_Q) { const int kt = r / 12, pt = r % 12; tconv_tile(CpQ{a.w_q_b + (size_t)l * 384 * QW}, QW, a.g_q_a + l * 384, (bf16_t*)(ws + WS_WQ) + (size_t)l * QW * 384, 384, kt * 64, pt * 64, scr, F.lane); continue; }
                r -= I_Q;
                if (r < I_KV) { const int kt = r / 16, pt = r % 16; tconv_tile(CpPlain{a.w_kv_b + (size_t)l * 256 * KVW, KVW}, KVW, a.g_kv_a + l * 256, (bf16_t*)(ws + WS_WKV) + (size_t)l * KVW * 256, 256, kt * 64, pt * 64, scr, F.lane); continue; }
                r -= I_KV;
                { const int kt = r / 16, pt = r % 16; tconv_tile(CpPlain{a.w_o + (size_t)l * D * D, D}, D, nullptr, (bf16_t*)(ws + WS_WO) + (size_t)l * D * D, D, kt * 64, pt * 64, scr, F.lane); }
            }
        }
        conv_experts(F, a, 0, -1);
    }
}

__device__ __forceinline__ void prologue2(const Ctx& F, KP kp) {
    const Args a = ldargs(kp);
    const float* modp = (const float*)(a.ws + WS_MODP); float* mod = (float*)(a.ws + WS_MOD);
    constexpr int NE = NL * 17 * 6144 / 4;
    for (int i = F.bk * NTHREADS + F.tid; i < NE; i += GRID * NTHREADS) {
        const int e = i * 4, l = e / (17 * 6144), n = e % 6144;
        f32x4 s = *(const f32x4*)(a.b_ada + l * 6144 + n);
#pragma unroll
        for (int kc = 0; kc < 4; ++kc) s = s + *(const f32x4*)(modp + (size_t)kc * NL * 17 * 6144 + e);
        *(f32x4*)(mod + e) = s;
    }
}

__device__ __forceinline__ void row_load(const float* p, int lane, f32x4 (&v)[4]) {
#pragma unroll
    for (int j = 0; j < 4; ++j) v[j] = *(const f32x4*)(p + 4 * lane + 256 * j);
}
__device__ __forceinline__ void row_ln(f32x4 (&v)[4], const float* g, const float* b, int lane) {
    float s = 0.f;
#pragma unroll
    for (int j = 0; j < 4; ++j) s += (v[j][0] + v[j][1]) + (v[j][2] + v[j][3]);
    const float mean = wave_sum(s) * (1.0f / D); float q = 0.f;
#pragma unroll
    for (int j = 0; j < 4; ++j) { v[j] = v[j] - mean; q += (v[j][0] * v[j][0] + v[j][1] * v[j][1]) + (v[j][2] * v[j][2] + v[j][3] * v[j][3]); }
    const float rstd = 1.0f / sqrtf(wave_sum(q) * (1.0f / D) + LN_EPS);
#pragma unroll
    for (int j = 0; j < 4; ++j) { const f32x4 gg = *(const f32x4*)(g + 4 * lane + 256 * j), bv = *(const f32x4*)(b + 4 * lane + 256 * j); v[j] = v[j] * rstd * gg + bv; }
}
__device__ __forceinline__ void row_ln_reg(f32x4 (&v)[4], const f32x4 (&g)[4], const f32x4 (&b)[4]) {
    float s = 0.f;
#pragma unroll
    for (int j = 0; j < 4; ++j) s += (v[j][0] + v[j][1]) + (v[j][2] + v[j][3]);
    const float mean = wave_sum(s) * (1.0f / D); float q = 0.f;
#pragma unroll
    for (int j = 0; j < 4; ++j) { v[j] = v[j] - mean; q += (v[j][0] * v[j][0] + v[j][1] * v[j][1]) + (v[j][2] * v[j][2] + v[j][3] * v[j][3]); }
    const float rstd = 1.0f / sqrtf(wave_sum(q) * (1.0f / D) + LN_EPS);
#pragma unroll
    for (int j = 0; j < 4; ++j) v[j] = v[j] * rstd * g[j] + b[j];
}
__device__ __forceinline__ void row_store_mod_bf16(bf16_t* hrow, const f32x4 (&v)[4], const float* sh, const float* sc, int lane) {
#pragma unroll
    for (int j = 0; j < 4; ++j) {
        const f32x4 s1 = *(const f32x4*)(sc + 4 * lane + 256 * j), s0 = *(const f32x4*)(sh + 4 * lane + 256 * j);
        const f32x4 h = v[j] * (s1 + 1.0f) + s0;
        st_bf4(hrow + 4 * lane + 256 * j, h);
    }
}

__device__ __forceinline__ void prologue3(const Ctx& F, KP kp) {
    const Args a = ldargs(kp);
    const float* modp = (const float*)(a.ws + WS_MODP); bf16_t* H = (bf16_t*)(a.ws + WS_H);
    const int gw = F.vcu * NWAVES + F.wave, NGW = GRID * NWAVES;
    for (int r = gw; r < MT; r += NGW) {
        const float* xr = (r < TL) ? (a.x + (size_t)r * D) : (a.ctx + (size_t)(r - TL) * D);
        const int bb = bb_of(r);
        f32x4 v[4]; row_load(xr, F.lane, v);
#pragma unroll
        for (int j = 0; j < 4; ++j) {
            const int c = 4 * F.lane + 256 * j;
            f32x4 sh = *(const f32x4*)(a.b_ada + c), sc = *(const f32x4*)(a.b_ada + 1024 + c);
#pragma unroll
            for (int kc = 0; kc < 4; ++kc) { const float* mp = modp + ((size_t)(kc * NL + 0) * 17 + bb) * 6144; sh = sh + *(const f32x4*)(mp + c); sc = sc + *(const f32x4*)(mp + 1024 + c); }
            st_bf4(H + (size_t)r * D + c, v[j] * (sc + 1.0f) + sh);
        }
    }
}

__device__ __forceinline__ void phase_split(const Ctx& F, KP kp, int l) {
    const Args a = ldargs(kp);
    unsigned char* ws = a.ws;
    const bf16_t* Z = (const bf16_t*)(ws + WS_Z);
    float* rstdq = (float*)(ws + WS_RSTDQ); float* rstdkv = (float*)(ws + WS_RSTDKV);
    bf16_t* Km = (bf16_t*)(ws + WS_KM); bf16_t* Qg = (bf16_t*)(ws + WS_QG); bf16_t* Kg = (bf16_t*)(ws + WS_KG); bf16_t* Vg = (bf16_t*)(ws + WS_VG);
    LAS f32x2* t64 = (LAS f32x2*)(F.lds + 65536); LAS f32x2* t32 = (LAS f32x2*)(F.lds + 65536 + 8192);
    __syncthreads();
    for (int i = F.tid; i < 64 * 16; i += NTHREADS) t64[i] = ((const f32x2*)(ws + WS_TAB64))[i];
    if (F.tid < 64 * 8) t32[F.tid] = ((const f32x2*)(ws + WS_TAB32))[F.tid];
    __syncthreads();
    LAS float* zs = (LAS float*)(F.lds + F.wave * 8192);
    const int lane = F.lane, gw = F.vcu * NWAVES + F.wave, NGW = GRID * NWAVES;
    const float ggq = a.g_gq[l * 64 + lane], ggk = a.g_gk[l * 64 + lane];
    u32x4 zn[3];
#define P2_LOAD(rr) do { const u32x4* zr_ = (const u32x4*)(Z + (size_t)(rr) * ZW); _Pragma("unroll") for (int j = 0; j < 3; ++j) zn[j] = zr_[lane + 64 * j]; } while (0)
    if (gw < MT) P2_LOAD(gw);
    for (int r = gw; r < MT; r += NGW) {
#pragma unroll
        for (int j = 0; j < 3; ++j) {
            const int ch = lane + 64 * j; const u32x4 w = zn[j];
            LAS float* d = zs + ch * 8;
            *(LAS f32x4*)d = (f32x4){bflo(w.x), bfhi(w.x), bflo(w.y), bfhi(w.y)};
            *(LAS f32x4*)(d + 4) = (f32x4){bflo(w.z), bfhi(w.z), bflo(w.w), bfhi(w.w)};
        }
        if (r + NGW < MT) P2_LOAD(r + NGW);
        LDS_WAIT();
        const bool lat = r < TL; const int s = r & 2047, gr = s >> 6, gc = s & 63, kr = krow_of(r);
        float sq = 0.f, sk = 0.f;
#pragma unroll
        for (int i = 0; i < 6; ++i) { const float v = zs[lane + 64 * i]; sq += v * v; }
#pragma unroll
        for (int i = 0; i < 4; ++i) { const float v = zs[384 + lane + 64 * i]; sk += v * v; }
        sq = wave_sum(sq); sk = wave_sum(sk);
        if (lane == 0) { rstdq[r] = 1.0f / sqrtf(sq * (1.0f / 384.0f) + RMS_EPS); rstdkv[r] = 1.0f / sqrtf(sk * (1.0f / 256.0f) + RMS_EPS); }
        {
            const int d = lane & 31; const float v = zs[640 + d]; const float pv = __shfl_xor(v, 8);
            float o = v;
            if (lat) { const int part = d >> 4, f = d & 7, pos = part ? gc : gr; const f32x2 cs = t32[pos * 8 + f]; o = (d & 8) ? (v * cs.x + pv * cs.y) : (v * cs.x - pv * cs.y); }
            const unsigned short ob = (unsigned short)f2bf(o);
#pragma unroll
            for (int i = 0; i < 4; ++i) { const int h = (lane >> 5) + 2 * i; Km[(size_t)kr * QW + h * 96 + 64 + d] = ob; }
        }
#pragma unroll
        for (int h = 0; h < 8; ++h) {
            const float v = zs[672 + 64 * h + lane]; const float ss = wave_sum(v * v);
            const float y = v * (1.0f / sqrtf(ss * (1.0f / 64.0f) + RMS_EPS)) * ggq; const float py = __shfl_xor(y, 16);
            float o = y;
            if (lat) { const int part = lane >> 5, f = lane & 15, pos = part ? gc : gr; const f32x2 cs = t64[pos * 16 + f]; o = (lane & 16) ? (y * cs.x + py * cs.y) : (y * cs.x - py * cs.y); }
            Qg[(size_t)r * 512 + 64 * h + lane] = (unsigned short)f2bf(o * QSCALE_G);
        }
#pragma unroll
        for (int h = 0; h < 2; ++h) {
            const float v = zs[1184 + 64 * h + lane]; const float ss = wave_sum(v * v);
            const float y = v * (1.0f / sqrtf(ss * (1.0f / 64.0f) + RMS_EPS)) * ggk; const float py = __shfl_xor(y, 16);
            float o = y;
            if (lat) { const int part = lane >> 5, f = lane & 15, pos = part ? gc : gr; const f32x2 cs = t64[pos * 16 + f]; o = (lane & 16) ? (y * cs.x + py * cs.y) : (y * cs.x - py * cs.y); }
            Kg[(size_t)kr * 128 + 64 * h + lane] = (unsigned short)f2bf(o);
            Vg[(size_t)kr * 128 + 64 * h + lane] = (unsigned short)f2bf(zs[1312 + 64 * h + lane]);
        }
        LDS_WAIT();
    }
}

typedef float f32x4m __attribute__((ext_vector_type(4)));
template <bool XF32>
__device__ __forceinline__ void phase_ln1_route(const Ctx& F, KP kp, int l, int ntok) {
    const Args a = ldargs(kp);
    unsigned char* ws = a.ws;
    const bf16_t* Yo = (const bf16_t*)(ws + WS_U); float* XC = (float*)(ws + WS_XC); bf16_t* H = (bf16_t*)(ws + WS_H); bf16_t* Hlo = (bf16_t*)(ws + WS_HLO);
    bf16_t* XB = (bf16_t*)(ws + WS_XB); constexpr bool xf32 = XF32;
    const float* mod = (const float*)(ws + WS_MOD) + (size_t)l * 17 * 6144;
    int* toke = (int*)(ws + WS_TOKE); int* tokr = (int*)(ws + WS_TOKR); float* tokw = (float*)(ws + WS_TOKW);
    volatile LAS int* cntl = (volatile LAS int*)(F.lds + MISC_CNT);
    const int lane = F.lane;
    __syncthreads();
    if (F.tid < 32) cntl[F.tid] = 0;
    if (F.tid < 36) ((LAS float*)(F.lds + MISC_LG + 2048))[F.tid] = (F.tid < 4) ? a.b_rg[l * 4 + F.tid] : a.b_re[l * 32 + F.tid - 4];
    const int tpb = ntok / GRID;
    {
        f32x4 nx[4]; u32x2 ny[4]; int i = F.wave;
        f32x4 LG[4], LB[4], GA[4], SH[4], SC[4]; int bbc = -1;
#pragma unroll
        for (int j = 0; j < 4; ++j) { LG[j] = *(const f32x4*)(a.ln1_g + l * D + 4 * lane + 256 * j); LB[j] = *(const f32x4*)(a.ln1_b + l * D + 4 * lane + 256 * j); }
        u32x2 nb[4];
#define P6_LOAD(tt) do { const int t_ = (tt); \
        if (xf32) { const float* xp_ = (t_ < TL) ? (a.x + (size_t)t_ * D) : (a.ctx + (size_t)(t_ - TL) * D); row_load(xp_, lane, nx); } \
        else { _Pragma("unroll") for (int j = 0; j < 4; ++j) nb[j] = *(const u32x2*)(XB + (size_t)t_ * D + 4 * lane + 256 * j); } \
        _Pragma("unroll") for (int j = 0; j < 4; ++j) ny[j] = *(const u32x2*)(Yo + (size_t)t_ * D + 4 * lane + 256 * j); } while (0)
        if (i < tpb) P6_LOAD(F.bk * tpb + i);
        for (; i < tpb; i += NWAVES) {
            const int t = F.bk * tpb + i, bb = bb_of(t);
            if (bb != bbc) {
                bbc = bb;
#pragma unroll
                for (int j = 0; j < 4; ++j) { const int c = 4 * lane + 256 * j; GA[j] = *(const f32x4*)(mod + (size_t)(bb * 6 + 2) * D + c);
                    SH[j] = *(const f32x4*)(mod + (size_t)(bb * 6 + 3) * D + c); SC[j] = *(const f32x4*)(mod + (size_t)(bb * 6 + 4) * D + c); }
            }
            f32x4 v[4];
#pragma unroll
            for (int j = 0; j < 4; ++j) { const f32x4 y = {bflo(ny[j].x), bfhi(ny[j].x), bflo(ny[j].y), bfhi(ny[j].y)};
                const f32x4 xv = xf32 ? nx[j] : (f32x4){bflo(nb[j].x), bfhi(nb[j].x), bflo(nb[j].y), bfhi(nb[j].y)}; v[j] = xv * ALPHA + GA[j] * y; }
            if (i + NWAVES < tpb) P6_LOAD(t + NWAVES);
            row_ln_reg(v, LG, LB);
#pragma unroll
            for (int j = 0; j < 4; ++j) st_bf4(XB + (size_t)t * D + 4 * lane + 256 * j, v[j]);
#pragma unroll
            for (int j = 0; j < 4; ++j) {
                const f32x4 h = v[j] * (SC[j] + 1.0f) + SH[j];
                u32x2 wh; wh.x = pk2(h[0], h[1]); wh.y = pk2(h[2], h[3]);
                const f32x4 r = {h[0] - bflo(wh.x), h[1] - bfhi(wh.x), h[2] - bflo(wh.y), h[3] - bfhi(wh.y)};
                *(u32x2*)(H + (size_t)t * D + 4 * lane + 256 * j) = wh;
                st_bf4(Hlo + (size_t)t * D + 4 * lane + 256 * j, r);
            }
        }
    }
#undef P6_LOAD
    asm volatile("s_waitcnt vmcnt(0)" ::: "memory");
    __syncthreads();
    {
        const bf16_t* wrh = (const bf16_t*)(ws + WS_WR) + (size_t)(l * 2) * 48 * D; const bf16_t* wrl = wrh + (size_t)48 * D;
        LAS float* lg = (LAS float*)(F.lds + F.wave * 4096);
        const LAS float* bias = (const LAS float*)(F.lds + MISC_LG + 2048);
        const int fr = lane & 15, fq = lane >> 4;
        for (int g = F.wave; g < tpb / 16; g += NWAVES) {
            const int t0 = F.bk * tpb + g * 16;
            const bf16_t* hh = H + (size_t)(t0 + fr) * D + 8 * fq; const bf16_t* hl = Hlo + (size_t)(t0 + fr) * D + 8 * fq;
            f32x4m acc0 = {0.f, 0.f, 0.f, 0.f}, acc1 = acc0, acc2 = acc0;
#pragma unroll 2
            for (int ks = 0; ks < 32; ++ks) {
                const bf16x8 bh = *(const bf16x8*)(hh + 32 * ks), bl = *(const bf16x8*)(hl + 32 * ks);
                const bf16_t* wp = wrh + (size_t)fr * D + 32 * ks + 8 * fq; const bf16_t* wq = wrl + (size_t)fr * D + 32 * ks + 8 * fq;
                const bf16x8 a0h = *(const bf16x8*)(wp), a1h = *(const bf16x8*)(wp + 16 * D), a2h = *(const bf16x8*)(wp + 32 * D);
                const bf16x8 a0l = *(const bf16x8*)(wq), a1l = *(const bf16x8*)(wq + 16 * D), a2l = *(const bf16x8*)(wq + 32 * D);
                acc0 = __builtin_amdgcn_mfma_f32_16x16x32_bf16(a0h, bh, acc0, 0, 0, 0); acc1 = __builtin_amdgcn_mfma_f32_16x16x32_bf16(a1h, bh, acc1, 0, 0, 0); acc2 = __builtin_amdgcn_mfma_f32_16x16x32_bf16(a2h, bh, acc2, 0, 0, 0);
                acc0 = __builtin_amdgcn_mfma_f32_16x16x32_bf16(a0h, bl, acc0, 0, 0, 0); acc1 = __builtin_amdgcn_mfma_f32_16x16x32_bf16(a1h, bl, acc1, 0, 0, 0); acc2 = __builtin_amdgcn_mfma_f32_16x16x32_bf16(a2h, bl, acc2, 0, 0, 0);
                acc0 = __builtin_amdgcn_mfma_f32_16x16x32_bf16(a0l, bh, acc0, 0, 0, 0); acc1 = __builtin_amdgcn_mfma_f32_16x16x32_bf16(a1l, bh, acc1, 0, 0, 0); acc2 = __builtin_amdgcn_mfma_f32_16x16x32_bf16(a2l, bh, acc2, 0, 0, 0);
            }
#pragma unroll
            for (int r = 0; r < 4; ++r) { lg[fr * 48 + 4 * fq + r] = acc0[r]; lg[fr * 48 + 16 + 4 * fq + r] = acc1[r]; lg[fr * 48 + 32 + 4 * fq + r] = acc2[r]; }
            LDS_WAIT();
            if (lane < 16) {
                const int t = t0 + lane; const LAS float* q = lg + lane * 48;
                float l4[4];
#pragma unroll
                for (int o = 0; o < 4; ++o) l4[o] = q[o] + bias[o];
                int gs = 0; float gm = l4[0];
#pragma unroll
                for (int o = 1; o < 4; ++o) if (l4[o] > gm) { gm = l4[o]; gs = o; }
                float den = 0.f;
#pragma unroll
                for (int o = 0; o < 4; ++o) den += expf(l4[o] - gm);
                const float pstar = 1.0f / den;
                float le[8];
#pragma unroll
                for (int o = 0; o < 8; ++o) le[o] = q[4 + gs * 8 + o] + bias[4 + gs * 8 + o];
                int i1 = 0; float v1 = le[0];
#pragma unroll
                for (int o = 1; o < 8; ++o) if (le[o] > v1) { v1 = le[o]; i1 = o; }
                int i2 = -1; float v2 = -3.0e38f;
#pragma unroll
                for (int o = 0; o < 8; ++o) if (o != i1 && le[o] > v2) { v2 = le[o]; i2 = o; }
                const float ex = expf(v2 - v1), w1 = pstar / (1.0f + ex), w2 = pstar * ex / (1.0f + ex);
                const int e1 = gs * 8 + i1, e2 = gs * 8 + i2;
                const int r1 = __hip_atomic_fetch_add((LAS int*)(F.lds + MISC_CNT) + e1, 1, __ATOMIC_RELAXED, __HIP_MEMORY_SCOPE_WORKGROUP);
                const int r2 = __hip_atomic_fetch_add((LAS int*)(F.lds + MISC_CNT) + e2, 1, __ATOMIC_RELAXED, __HIP_MEMORY_SCOPE_WORKGROUP);
                toke[2 * t] = e1; toke[2 * t + 1] = e2; tokr[2 * t] = r1; tokr[2 * t + 1] = r2; tokw[2 * t] = w1; tokw[2 * t + 1] = w2;
            }
            LDS_WAIT();
        }
    }
    __syncthreads();
    if (F.tid < 32) ((int*)(ws + WS_BLKCNT))[((size_t)l * 256 + F.bk) * 32 + F.tid] = cntl[F.tid];
}

__device__ __forceinline__ void moe_tables(const Ctx& F, KP kp, int l, bool publish) {
    const Args a = ldargs(kp);
    const int* blkcnt = (const int*)(a.ws + WS_BLKCNT) + (size_t)l * 256 * 32;
    volatile LAS int* pa = (volatile LAS int*)(F.lds + MISC_PA); volatile LAS int* pb = (volatile LAS int*)(F.lds + MISC_PB);
    volatile LAS int* tot = (volatile LAS int*)(F.lds + MISC_TOT); volatile LAS int* base = (volatile LAS int*)(F.lds + MISC_BASE); volatile LAS int* poff = (volatile LAS int*)(F.lds + MISC_POFF);
    __syncthreads();
    {
        const int e = F.tid & 31, part = F.tid >> 5; int sa = 0, sb = 0;
        for (int j = 0; j < 16; ++j) { const int b2 = part * 16 + j; const int c = blkcnt[b2 * 32 + e]; sa += c; sb += (b2 < F.bk) ? c : 0; }
        pa[part * 32 + e] = sa; pb[part * 32 + e] = sb;
    }
    __syncthreads();
    if (F.tid < 32) { int sa = 0, sb = 0; for (int p = 0; p < 16; ++p) { sa += pa[p * 32 + F.tid]; sb += pb[p * 32 + F.tid]; } tot[F.tid] = sa; base[F.tid] = sb; }
    __syncthreads();
    if (F.tid == 0) { int o = 0; for (int e = 0; e < 32; ++e) { poff[e] = o; o += (tot[e] + 255) & ~255; } poff[32] = o; }
    __syncthreads();
    if (publish && F.bk == 0 && F.tid < 33) ((int*)(a.ws + WS_MOETAB))[l * 128 + F.tid] = poff[F.tid];
}

__device__ __forceinline__ void phase_dispatch(const Ctx& F, KP kp, int l, int ntok) {
    const Args a = ldargs(kp);
    unsigned char* ws = a.ws;
    if (l > 0) conv_experts(F, a, l, -1);
    moe_tables(F, kp, l, true);
    volatile LAS int* base = (volatile LAS int*)(F.lds + MISC_BASE); volatile LAS int* poff = (volatile LAS int*)(F.lds + MISC_POFF); volatile LAS int* tot = (volatile LAS int*)(F.lds + MISC_TOT);
    const int* toke = (const int*)(ws + WS_TOKE); const int* tokr = (const int*)(ws + WS_TOKR); int* tokp = (int*)(ws + WS_TOKP); int* postok = (int*)(ws + WS_POSTOK);
    const int tpb = ntok / GRID;
    if (F.tid < tpb) {
        const int t = F.bk * tpb + F.tid;
        const int2 e = *(const int2*)(toke + 2 * t), r = *(const int2*)(tokr + 2 * t);
        const int p1 = poff[e.x] + base[e.x] + r.x, p2 = poff[e.y] + base[e.y] + r.y;
        *(int2*)(tokp + 2 * t) = (int2){p1, p2};
        postok[p1] = t; postok[p2] = t;
    }
    { const int idx = F.bk * NTHREADS + F.tid;
      if (idx < poff[32]) { int e = 0;
#pragma unroll
          for (int j = 1; j < 32; ++j) e += (poff[j] <= idx) ? 1 : 0;
          if (idx >= poff[e] + tot[e]) postok[idx] = 0; } }
}

__device__ __forceinline__ void phase_ln2(const Ctx& F, KP kp, int l, int ntok, bool dry = false) {
    const Args a = ldargs(kp);
    unsigned char* ws = a.ws;
    const bf16_t* Ys = (const bf16_t*)(ws + WS_XS); float* XC = (float*)(ws + WS_XC); bf16_t* H = (bf16_t*)(ws + WS_H);
    const float* mod = (const float*)(ws + WS_MOD) + (size_t)l * 17 * 6144;
    const float* modn = (const float*)(ws + WS_MOD) + (size_t)(l + 1 < NL ? l + 1 : l) * 17 * 6144;
    const int* tokp = (const int*)(ws + WS_TOKP); const float* tokw = (const float*)(ws + WS_TOKW);
    const int gw = F.vcu * NWAVES + F.wave, NGW = GRID * NWAVES, lane = F.lane;
    const int per = ntok / NGW, t0 = gw * per, t1 = t0 + per;
    f32x4 LG[4], LB[4], GF[4], SH[4], SC[4];
#pragma unroll
    for (int j = 0; j < 4; ++j) { LG[j] = *(const f32x4*)(a.ln2_g + l * D + 4 * lane + 256 * j); LB[j] = *(const f32x4*)(a.ln2_b + l * D + 4 * lane + 256 * j); }
    int bbc = -1;
    int2 pn = {0, 0}; float2 wn = {0.f, 0.f};
    u32x2 xn[4], yan[4], ybn[4]; bf16_t* XB = (bf16_t*)(ws + WS_XB);
#define P10_REC(tt) do { pn = *(const int2*)(tokp + 2 * (tt)); wn = *(const float2*)(tokw + 2 * (tt)); } while (0)
#define P10_ROWS(tt, p_) do { const int t_ = (tt); _Pragma("unroll") for (int j = 0; j < 4; ++j) xn[j] = *(const u32x2*)(XB + (size_t)t_ * D + 4 * lane + 256 * j); \
        _Pragma("unroll") for (int j = 0; j < 4; ++j) { yan[j] = *(const u32x2*)(Ys + (size_t)(p_).x * D + 4 * lane + 256 * j); ybn[j] = *(const u32x2*)(Ys + (size_t)(p_).y * D + 4 * lane + 256 * j); } } while (0)
    float2 wc = {0.f, 0.f};
    P10_REC(t0); wc = wn; P10_ROWS(t0, pn); if (t0 + 1 < t1) P10_REC(t0 + 1);
    for (int t = t0; t < t1; ++t) {
        const int bb = bb_of(t);
        if (bb != bbc) {
            bbc = bb;
#pragma unroll
            for (int j = 0; j < 4; ++j) { const int c = 4 * lane + 256 * j; GF[j] = *(const f32x4*)(mod + (size_t)(bb * 6 + 5) * D + c);
                SH[j] = *(const f32x4*)(modn + (size_t)(bb * 6 + 0) * D + c); SC[j] = *(const f32x4*)(modn + (size_t)(bb * 6 + 1) * D + c); }
        }
        f32x4 v[4]; u32x2 ya[4], yb[4];
#pragma unroll
        for (int j = 0; j < 4; ++j) { v[j] = (f32x4){bflo(xn[j].x), bfhi(xn[j].x), bflo(xn[j].y), bfhi(xn[j].y)}; ya[j] = yan[j]; yb[j] = ybn[j]; }
        const float w1 = wc.x, w2 = wc.y;
        if (t + 1 < t1) { wc = wn; P10_ROWS(t + 1, pn); if (t + 2 < t1) P10_REC(t + 2); }
#pragma unroll
        for (int j = 0; j < 4; ++j) {
            const f32x4 y = (f32x4){bflo(ya[j].x), bfhi(ya[j].x), bflo(ya[j].y), bfhi(ya[j].y)} * w1 + (f32x4){bflo(yb[j].x), bfhi(yb[j].x), bflo(yb[j].y), bfhi(yb[j].y)} * w2;
            v[j] = v[j] * ALPHA + GF[j] * y;
        }
        row_ln_reg(v, LG, LB);
        if (l + 1 < NL) {
#pragma unroll
            for (int j = 0; j < 4; ++j) st_bf4(XB + (size_t)t * D + 4 * lane + 256 * j, v[j]);
        } else {
#pragma unroll
            for (int j = 0; j < 4; ++j) *(f32x4*)(a.out + (size_t)t * D + 4 * lane + 256 * j) = v[j];
        }
        if (l + 1 < NL) { bf16_t* hrow = H + (size_t)t * D;
#pragma unroll
            for (int j = 0; j < 4; ++j) st_bf4(hrow + 4 * lane + 256 * j, v[j] * (SC[j] + 1.0f) + SH[j]); }
    }
#undef P10_REC
#undef P10_ROWS
}

template <int QD>
__device__ __forceinline__ void attn_naive_task(const bf16_t* qp, const bf16_t* kp, int kstride, const bf16_t* vp, int vstride, int nkeys, bf16_t* op) {
    u32x4 qv[QD / 8];
#pragma unroll
    for (int i = 0; i < QD / 8; ++i) qv[i] = *(const u32x4*)(qp + 8 * i);
#pragma unroll 1
    for (int half = 0; half < 2; ++half) {
        float o[32];
#pragma unroll
        for (int i = 0; i < 32; ++i) o[i] = 0.f;
        float m = -1.0e30f, lsum = 0.f;
#pragma unroll 1
        for (int j = 0; j < nkeys; ++j) {
            const u32x4* kr = (const u32x4*)(kp + (size_t)j * kstride);
            float s = 0.f;
#pragma unroll
            for (int i = 0; i < QD / 8; ++i) s = dot8(qv[i], kr[i], s);
            if (s > m) { const float al = __builtin_amdgcn_exp2f(m - s); lsum *= al;
#pragma unroll
                for (int i = 0; i < 32; ++i) o[i] *= al;
                m = s; }
            const float p = __builtin_amdgcn_exp2f(s - m); lsum += p;
            const u32x4* vr = (const u32x4*)(vp + (size_t)j * vstride + 32 * half);
#pragma unroll
            for (int i = 0; i < 4; ++i) { const u32x4 w = vr[i];
                o[8 * i + 0] += p * bflo(w.x); o[8 * i + 1] += p * bfhi(w.x); o[8 * i + 2] += p * bflo(w.y); o[8 * i + 3] += p * bfhi(w.y); o[8 * i + 4] += p * bflo(w.z); o[8 * i + 5] += p * bfhi(w.z); o[8 * i + 6] += p * bflo(w.w); o[8 * i + 7] += p * bfhi(w.w); }
        }
        const float rl = 1.0f / lsum;
#pragma unroll
        for (int i = 0; i < 4; ++i) { u32x4 w; w.x = pk2(o[8 * i] * rl, o[8 * i + 1] * rl); w.y = pk2(o[8 * i + 2] * rl, o[8 * i + 3] * rl); w.z = pk2(o[8 * i + 4] * rl, o[8 * i + 5] * rl); w.w = pk2(o[8 * i + 6] * rl, o[8 * i + 7] * rl); *(u32x4*)(op + 32 * half + 8 * i) = w; }
    }
}
__device__ __forceinline__ void phase_attn_naive(const Ctx& F, KP kp, bool last) {
    const Args a = ldargs(kp);
    unsigned char* ws = a.ws;
    const bf16_t* Qm = (const bf16_t*)(ws + WS_QM); const bf16_t* Km = (const bf16_t*)(ws + WS_KM); const bf16_t* Vm = (const bf16_t*)(ws + WS_VM);
    const bf16_t* Qg = (const bf16_t*)(ws + WS_QG); const bf16_t* Kg = (const bf16_t*)(ws + WS_KG); const bf16_t* Vg = (const bf16_t*)(ws + WS_VG);
    bf16_t* O = (bf16_t*)(ws + WS_O);
    const int gw = F.vcu * NWAVES + F.wave, NGW = GRID * NWAVES;
    const int ntask = 8192 + (last ? 0 : 1024);
    for (int T = gw; T < ntask; T += NGW) {
        int b, h16, r, nkeys;
        if (T < 8192) { const int qw = T & 31; h16 = (T >> 5) & 15; b = T >> 9; r = b * SEQ + 64 * qw + F.lane; nkeys = KPB; }
        else { const int T2 = T - 8192, qw = T2 & 3; h16 = (T2 >> 2) & 15; b = T2 >> 6; r = TL + b * CTX + 64 * qw + F.lane; nkeys = CTX; }
        bf16_t* op = O + (size_t)r * D + h16 * 64;
        if (h16 < 8) attn_naive_task<96>(Qm + (size_t)r * QW + h16 * 96, Km + (size_t)b * KPB * QW + h16 * 96, QW, Vm + (size_t)b * KPB * 512 + h16 * 64, 512, nkeys, op);
        else { const int hh = h16 - 8, kvh = hh >> 2; attn_naive_task<64>(Qg + (size_t)r * 512 + hh * 64, Kg + (size_t)b * KPB * 128 + kvh * 64, 128, Vg + (size_t)b * KPB * 128 + kvh * 64, 128, nkeys, op); }
    }
}

typedef float f32x16 __attribute__((ext_vector_type(16)));
typedef short s16x4 __attribute__((ext_vector_type(4)));
__device__ __forceinline__ s16x4 vtr(const LAS unsigned char* p) { return __builtin_bit_cast(s16x4, __builtin_amdgcn_ds_read_tr16_b64_v4i16((LAS s16x4*)p)); }
__device__ __forceinline__ unsigned cvtpk(float lo, float hi) { typedef __bf16 bf2 __attribute__((ext_vector_type(2))); f32x2 v = {lo, hi}; bf2 b = __builtin_convertvector(v, bf2); return __builtin_bit_cast(unsigned, b); }
constexpr float ATT_THR = 6.0f;
constexpr int ATT_KSLOT = 12288, ATT_VSLOT = 8192, ATT_NKS = 3, ATT_NVS = 4, ATT_V0 = ATT_NKS * ATT_KSLOT;
__device__ __forceinline__ void att_glds16(const void* gsrc, unsigned lds_dst) { unsigned keep;
    asm volatile("s_mov_b32 %0, m0\n\ts_mov_b32 m0, %2\n\ts_nop 0\n\tglobal_load_lds_dwordx4 %1, off\n\ts_mov_b32 m0, %0" : "=&s"(keep) : "v"(gsrc), "s"(lds_dst) : "memory"); }
#define ATT_WAITBAR(N) asm volatile("s_waitcnt vmcnt(" #N ") lgkmcnt(0)\n\ts_barrier" ::: "memory")
template <int QD>
__device__ __forceinline__ void attn_unit(LAS unsigned char* lds, int tid, const bf16_t* Kb, int kstride, const bf16_t* Vb, int vstride, int ntiles, const bf16_t* qrow, bf16_t* orow) {
    constexpr int NC = QD / 8, NS = QD / 16;
    const int lane = tid & 63, r32 = lane & 31, hi = lane >> 5;
    const int w = __builtin_amdgcn_readfirstlane(tid >> 6);
    const bool three = (NC == 12) && (w < 4);
    const int vp = (NC == 12) ? (w < 4 ? w + 4 : w - 4) : w;
    const bf16_t* ksrcA = Kb + (size_t)lane * kstride + w * 8;
    const bf16_t* ksrcB = Kb + (size_t)lane * kstride + (w + 8) * 8;
    const bf16_t* vsrc = Vb + (size_t)(16 * (vp & 3) + (lane >> 2)) * vstride + (vp >> 2) * 32 + (lane & 3) * 8;
    const size_t kstep = (size_t)64 * kstride, vstep = (size_t)64 * vstride;
    const unsigned lds0 = (unsigned)(size_t)lds;
#define ATT_DMA(t_, ks_, vs_) do { \
        att_glds16(ksrcA + (size_t)(t_) * kstep, (unsigned)__builtin_amdgcn_readfirstlane((int)(lds0 + (ks_) * ATT_KSLOT + w * 1024))); \
        if (three) att_glds16(ksrcB + (size_t)(t_) * kstep, (unsigned)__builtin_amdgcn_readfirstlane((int)(lds0 + (ks_) * ATT_KSLOT + (w + 8) * 1024))); \
        att_glds16(vsrc + (size_t)(t_) * vstep, (unsigned)__builtin_amdgcn_readfirstlane((int)(lds0 + ATT_V0 + (vs_) * ATT_VSLOT + vp * 1024))); } while (0)
    ATT_DMA(0, 0, 0);
    if (ntiles > 1) ATT_DMA(1, 1, 1);
    bf16x8 qr[NS];
#pragma unroll
    for (int s = 0; s < NS; ++s) qr[s] = *(const bf16x8*)(qrow + 16 * s + 8 * hi);
    f32x16 o0, o1, negm, p0, p1;
#pragma unroll
    for (int r = 0; r < 16; ++r) { o0[r] = 0.f; o1[r] = 0.f; negm[r] = 0.f; p0[r] = 0.f; p1[r] = 0.f; }
    float lsum = 0.f;
    const int kread = hi * 1024 + r32 * 16;
    const int vread = ATT_V0 + ((lane >> 4) & 1) * 32 + (lane & 3) * 8 + (4 * hi + ((lane & 15) >> 2)) * 64;
#define ATT_QK(ks_) do { const LAS unsigned char* kb_ = lds + (ks_) * ATT_KSLOT + kread; \
        _Pragma("unroll") for (int s = 0; s < NS; ++s) { \
            const bf16x8 a0 = *(const LAS bf16x8*)(kb_ + s * 2048), a1 = *(const LAS bf16x8*)(kb_ + s * 2048 + 512); \
            if (s == 0) { p0 = __builtin_amdgcn_mfma_f32_32x32x16_bf16(a0, qr[0], negm, 0, 0, 0); p1 = __builtin_amdgcn_mfma_f32_32x32x16_bf16(a1, qr[0], negm, 0, 0, 0); } \
            else { p0 = __builtin_amdgcn_mfma_f32_32x32x16_bf16(a0, qr[s], p0, 0, 0, 0); p1 = __builtin_amdgcn_mfma_f32_32x32x16_bf16(a1, qr[s], p1, 0, 0, 0); } } } while (0)
#define ATT_SOFT_PV(first_, vs_) do { \
        float mx = fmaxf(fmaxf(p0[0], p1[0]), p0[1]); \
        _Pragma("unroll") for (int r = 1; r < 16; ++r) mx = (r == 1) ? fmaxf(mx, p1[1]) : fmaxf(fmaxf(mx, p0[r]), p1[r]); \
        { auto rr = __builtin_amdgcn_permlane32_swap(__float_as_uint(mx), __float_as_uint(mx), false, false); mx = fmaxf(__uint_as_float(rr[0]), __uint_as_float(rr[1])); } \
        if ((first_) || __any(mx > ATT_THR)) { \
            const float dl = (first_) ? mx : fmaxf(mx, 0.f); \
            _Pragma("unroll") for (int r = 0; r < 16; ++r) { p0[r] -= dl; p1[r] -= dl; negm[r] -= dl; } \
            if (!(first_)) { const float f = __builtin_amdgcn_exp2f(-dl); lsum *= f; \
                _Pragma("unroll") for (int r = 0; r < 16; ++r) { o0[r] *= f; o1[r] *= f; } } \
        } \
        float rs = 0.f; \
        _Pragma("unroll") for (int r = 0; r < 16; ++r) { p0[r] = __builtin_amdgcn_exp2f(p0[r]); p1[r] = __builtin_amdgcn_exp2f(p1[r]); rs += p0[r] + p1[r]; } \
        lsum += rs; \
        u32x4 w0, w1, w2, w3; \
        w0.x = cvtpk(p0[0], p0[1]); w0.y = cvtpk(p0[2], p0[3]); w0.z = cvtpk(p0[4], p0[5]); w0.w = cvtpk(p0[6], p0[7]); \
        w1.x = cvtpk(p0[8], p0[9]); w1.y = cvtpk(p0[10], p0[11]); w1.z = cvtpk(p0[12], p0[13]); w1.w = cvtpk(p0[14], p0[15]); \
        w2.x = cvtpk(p1[0], p1[1]); w2.y = cvtpk(p1[2], p1[3]); w2.z = cvtpk(p1[4], p1[5]); w2.w = cvtpk(p1[6], p1[7]); \
        w3.x = cvtpk(p1[8], p1[9]); w3.y = cvtpk(p1[10], p1[11]); w3.z = cvtpk(p1[12], p1[13]); w3.w = cvtpk(p1[14], p1[15]); \
        const bf16x8 pa0 = __builtin_bit_cast(bf16x8, w0), pa1 = __builtin_bit_cast(bf16x8, w1), pa2 = __builtin_bit_cast(bf16x8, w2), pa3 = __builtin_bit_cast(bf16x8, w3); \
        const LAS unsigned char* vb_ = lds + (vs_) * ATT_VSLOT + vread; \
        o0 = __builtin_amdgcn_mfma_f32_32x32x16_bf16(ATT_VF(0, 0), pa0, o0, 0, 0, 0); \
        o1 = __builtin_amdgcn_mfma_f32_32x32x16_bf16(ATT_VF(1, 0), pa0, o1, 0, 0, 0); \
        o0 = __builtin_amdgcn_mfma_f32_32x32x16_bf16(ATT_VF(0, 1), pa1, o0, 0, 0, 0); \
        o1 = __builtin_amdgcn_mfma_f32_32x32x16_bf16(ATT_VF(1, 1), pa1, o1, 0, 0, 0); \
        o0 = __builtin_amdgcn_mfma_f32_32x32x16_bf16(ATT_VF(0, 2), pa2, o0, 0, 0, 0); \
        o1 = __builtin_amdgcn_mfma_f32_32x32x16_bf16(ATT_VF(1, 2), pa2, o1, 0, 0, 0); \
        o0 = __builtin_amdgcn_mfma_f32_32x32x16_bf16(ATT_VF(0, 3), pa3, o0, 0, 0, 0); \
        o1 = __builtin_amdgcn_mfma_f32_32x32x16_bf16(ATT_VF(1, 3), pa3, o1, 0, 0, 0); } while (0)
#define ATT_VF(d0, ks) ({ const s16x4 lo_ = vtr(vb_ + (d0) * 4096 + (ks) * 1024), hi_ = vtr(vb_ + (d0) * 4096 + (ks) * 1024 + 512); (bf16x8){lo_[0], lo_[1], lo_[2], lo_[3], hi_[0], hi_[1], hi_[2], hi_[3]}; })
#define ATT_ENDSTEP() do { if (issue) { if (three) ATT_WAITBAR(3); else ATT_WAITBAR(2); } else ATT_WAITBAR(0); \
        ks = (ks == ATT_NKS - 1) ? 0 : ks + 1; vs = (vs + 1) & (ATT_NVS - 1); } while (0)
    if (ntiles > 1) { if (three) ATT_WAITBAR(3); else ATT_WAITBAR(2); } else ATT_WAITBAR(0);
    int ks = 0, vs = 0;
    if (w < 4) {
        for (int t = 0; t < ntiles; ++t) {
            const bool issue = (t + 2 < ntiles);
            if (issue) ATT_DMA(t + 2, (ks >= 1) ? ks - 1 : ATT_NKS - 1, (vs + 2) & (ATT_NVS - 1));
            ATT_QK(ks);
            ATT_SOFT_PV(t == 0, vs);
            ATT_ENDSTEP();
        }
    } else {
        for (int t = 0; t < ntiles; ++t) {
            const bool issue = (t + 2 < ntiles);
            if (issue) ATT_DMA(t + 2, (ks >= 1) ? ks - 1 : ATT_NKS - 1, (vs + 2) & (ATT_NVS - 1));
            if (t > 0) ATT_SOFT_PV(t == 1, (vs + ATT_NVS - 1) & (ATT_NVS - 1));
            ATT_QK(ks);
            ATT_ENDSTEP();
        }
        ATT_SOFT_PV(ntiles == 1, (vs + ATT_NVS - 1) & (ATT_NVS - 1));
    }
#undef ATT_DMA
#undef ATT_QK
#undef ATT_SOFT_PV
#undef ATT_VF
#undef ATT_ENDSTEP
    { auto rr = __builtin_amdgcn_permlane32_swap(__float_as_uint(lsum), __float_as_uint(lsum), false, false); lsum = __uint_as_float(rr[0]) + __uint_as_float(rr[1]); }
    const float rl = 1.0f / lsum;
#pragma unroll
    for (int g = 0; g < 4; ++g) {
        u32x2 a, b2;
        a.x = cvtpk(o0[4 * g] * rl, o0[4 * g + 1] * rl); a.y = cvtpk(o0[4 * g + 2] * rl, o0[4 * g + 3] * rl);
        b2.x = cvtpk(o1[4 * g] * rl, o1[4 * g + 1] * rl); b2.y = cvtpk(o1[4 * g + 2] * rl, o1[4 * g + 3] * rl);
        *(u32x2*)(orow + 8 * g + 4 * hi) = a; *(u32x2*)(orow + 32 + 8 * g + 4 * hi) = b2;
    }
    asm volatile("s_waitcnt lgkmcnt(0)\n\ts_barrier" ::: "memory");
}
__device__ __forceinline__ void phase_attn(const Ctx& F, KP kp, bool last) {
    const Args a = ldargs(kp);
    unsigned char* ws = a.ws;
    const bf16_t* Qm = (const bf16_t*)(ws + WS_QM); const bf16_t* Km = (const bf16_t*)(ws + WS_KM); const bf16_t* Vm = (const bf16_t*)(ws + WS_VM);
    const bf16_t* Qg = (const bf16_t*)(ws + WS_QG); const bf16_t* Kg = (const bf16_t*)(ws + WS_KG); const bf16_t* Vg = (const bf16_t*)(ws + WS_VG);
    bf16_t* O = (bf16_t*)(ws + WS_O);
    const int xcd = F.vcu >> 5, cix = F.vcu & 31, r32 = F.lane & 31, w = F.wave;
    const int nun = last ? 8 : 9;
    for (int i = 0; i < nun; ++i) {
        if (i < 8 && (i & 1) == 0) {
            const int pair = xcd * 16 + (i >> 1) * 4 + (cix >> 3), b = pair >> 3, h = pair & 7, qb = cix & 7;
            const int row = b * SEQ + qb * 256 + w * 32 + r32;
            attn_unit<96>(F.lds, F.tid, Km + (size_t)b * KPB * QW + h * 96, QW, Vm + (size_t)b * KPB * 512 + h * 64, 512, KPB / 64, Qm + (size_t)row * QW + h * 96, O + (size_t)row * D + h * 64);
        } else if (i < 8) {
            const int pair = xcd * 4 + (i >> 1), b = pair >> 1, kvh = pair & 1, hh = kvh * 4 + (w >> 1);
            const int row = b * SEQ + cix * 64 + (w & 1) * 32 + r32;
            attn_unit<64>(F.lds, F.tid, Kg + (size_t)b * KPB * 128 + kvh * 64, 128, Vg + (size_t)b * KPB * 128 + kvh * 64, 128, KPB / 64, Qg + (size_t)row * 512 + hh * 64, O + (size_t)row * D + 512 + hh * 64);
        } else if (F.vcu < 128) {
            const int b = F.vcu >> 3, h = F.vcu & 7, row = TL + b * CTX + w * 32 + r32;
            attn_unit<96>(F.lds, F.tid, Km + (size_t)b * KPB * QW + h * 96, QW, Vm + (size_t)b * KPB * 512 + h * 64, 512, CTX / 64, Qm + (size_t)row * QW + h * 96, O + (size_t)row * D + h * 64);
        } else {
            const int idx = F.vcu - 128, b = idx >> 3, kvh = (idx >> 2) & 1, qb = idx & 3, hh = kvh * 4 + (w >> 1);
            const int row = TL + b * CTX + qb * 64 + (w & 1) * 32 + r32;
            attn_unit<64>(F.lds, F.tid, Kg + (size_t)b * KPB * 128 + kvh * 64, 128, Vg + (size_t)b * KPB * 128 + kvh * 64, 128, CTX / 64, Qg + (size_t)row * 512 + hh * 64, O + (size_t)row * D + 512 + hh * 64);
        }
    }
}
__global__ void __launch_bounds__(NTHREADS, 2) fwd_kernel(Args a_unused) {
    extern __shared__ __attribute__((aligned(16))) unsigned char lds_raw[];
    const KP kp = (KP)__builtin_amdgcn_kernarg_segment_ptr();
    Ctx F;
    F.lds = (LAS unsigned char*)lds_raw;
    F.tid = threadIdx.x; F.lane = F.tid & 63; F.wave = __builtin_amdgcn_readfirstlane(F.tid >> 6);
    F.bk = blockIdx.x; F.vcu = (F.bk & 7) * (GRID / 8) + (F.bk >> 3);
    if (F.tid < 4) ((volatile LAS unsigned*)(F.lds + MISC_BAR))[F.tid] = 0u;
    __syncthreads();
    { const Args a = ldargs(kp); (void)xcd_barrier_post((unsigned*)(a.ws + WS_CTL), (volatile LAS unsigned*)(F.lds + MISC_BAR), F.tid == 0); }
#define FRESH() do { int ln_; asm volatile("v_mbcnt_lo_u32_b32 %0, -1, 0\n\tv_mbcnt_hi_u32_b32 %0, -1, %0" : "=v"(ln_)); F.lane = ln_; F.tid = F.wave * 64 + ln_; F.bk = blockIdx.x; F.vcu = (F.bk & 7) * (GRID / 8) + (F.bk >> 3); } while (0)
#define GRID_BAR() do { XcdBarrier b_; { const Args a_ = ldargs(kp); b_.bar = (unsigned*)(a_.ws + WS_CTL); } b_.x = xb_xcc_id(); b_.st = (volatile LAS unsigned*)(F.lds + MISC_BAR); xcd_barrier(b_, F.tid == 0); } while (0)

    for (int rep_ = 0; rep_ < REP_PRO; ++rep_) prologue1(F, kp);
    GRID_BAR(); FRESH();
    prologue2(F, kp);
    prologue3(F, kp);
    GRID_BAR(); FRESH();

    for (int l = 0; l < NL; ++l) {
        const bool last = (l == NL - 1);
        const int ntok = last ? TL : MT;
        { const Args a = ldargs(kp); unsigned char* ws = a.ws;
          Gemm g{(const bf16_t*)(ws + WS_H), D, (const bf16_t*)(ws + WS_WIN) + (size_t)l * ZW * D, D}; StaticOrder S; S.init(MT, ZW, GRID, F.bk); EpiZ E{(bf16_t*)(ws + WS_Z)}; gemm_phase<0>(F, g, S, E); }
        if (F.bk >= (MT / 256) * (ZW / 256) - 3 * GRID) conv_filler(F, kp, l, FILL_P1);
        GRID_BAR(); FRESH();
        for (int rep_ = 0; rep_ < REP_P2; ++rep_) phase_split(F, kp, l);
        GRID_BAR(); FRESH();
        { const Args a = ldargs(kp); unsigned char* ws = a.ws;
          Gemm g{(const bf16_t*)(ws + WS_Z), ZW, (const bf16_t*)(ws + WS_WQ) + (size_t)l * QW * 384, 384}; StaticOrder S; S.init(MT, QW, GRID, F.bk);
          EpiQ E{(bf16_t*)(ws + WS_QM), (const float*)(ws + WS_RSTDQ), (const f32x2*)(ws + WS_TAB32)}; gemm_phase<1>(F, g, S, E); }
        FRESH();
        { const Args a = ldargs(kp); unsigned char* ws = a.ws;
          Gemm g{(const bf16_t*)(ws + WS_Z) + 384, ZW, (const bf16_t*)(ws + WS_WKV) + (size_t)l * KVW * 256, 256}; StaticOrder S; S.init(MT, KVW, GRID, (F.bk + 80) & 255);
          EpiKV E{(bf16_t*)(ws + WS_KM), (bf16_t*)(ws + WS_VM), (const float*)(ws + WS_RSTDKV)}; gemm_phase<2>(F, g, S, E); }
        GRID_BAR(); FRESH();
#if USE_MFMA_ATTN
        for (int rep_ = 0; rep_ < REP_ATTN; ++rep_) phase_attn(F, kp, last);
#else
        phase_attn_naive(F, kp, last);
#endif
        GRID_BAR(); FRESH();
        { const Args a = ldargs(kp); unsigned char* ws = a.ws;
          Gemm g{(const bf16_t*)(ws + WS_O), D, (const bf16_t*)(ws + WS_WO) + (size_t)l * D * D, D}; StaticOrder S; S.init(ntok, D, GRID, F.bk);
          EpiYo E{(bf16_t*)(ws + WS_U)}; gemm_phase<3>(F, g, S, E); }
        if (!last && F.bk >= (MT / 256) * (D / 256) - 2 * GRID) conv_filler(F, kp, l, FILL_P5);
        GRID_BAR(); FRESH();
        if (l == 0) phase_ln1_route<true>(F, kp, l, ntok); else phase_ln1_route<false>(F, kp, l, ntok);
        GRID_BAR(); FRESH();
        for (int rep_ = 0; rep_ < REP_P7; ++rep_) phase_dispatch(F, kp, l, ntok);
        GRID_BAR(); FRESH();
        { const Args a = ldargs(kp); unsigned char* ws = a.ws;
          Gemm g{(const bf16_t*)(ws + WS_H), D, (const bf16_t*)(ws + WS_WGU) + (size_t)l * NEXP * 1024 * D, D}; GroupedOrder S; S.init((const volatile LAS int*)(F.lds + MISC_POFF), GRID, F.vcu);
          LAS int* gt = (LAS int*)(F.lds + STAGE_BYTES);
          { const int* postok = (const int*)(ws + WS_POSTOK); Unit u; for (int i = 0; i < 16 && S.next(i, u); ++i) if (F.tid < 256) gt[i * 256 + F.tid] = postok[u.pm * 256 + F.tid]; }
          __syncthreads();
          EpiAct E{(bf16_t*)(ws + WS_ACT)}; gemm_phase_gather<4>(F, g, S, E, gt); }
        GRID_BAR(); FRESH();
        { const Args a = ldargs(kp); unsigned char* ws = a.ws;
          Gemm g{(const bf16_t*)(ws + WS_ACT), FF, (const bf16_t*)(ws + WS_WD) + (size_t)l * NEXP * D * FF, FF}; GroupedOrder S; S.init((const volatile LAS int*)(F.lds + MISC_POFF), GRID, F.vcu);
          EpiY E{(bf16_t*)(ws + WS_XS)}; gemm_phase<5>(F, g, S, E); }
        GRID_BAR(); FRESH();
        phase_ln2(F, kp, l, ntok);
        GRID_BAR(); FRESH();
    }
}

extern "C" void kernel_launch(void* const* d_in, const int* in_sizes, int n_in, void* d_out, int out_size, void* d_ws, size_t ws_size, hipStream_t stream) {
    static int grid = 0;
    if (grid == 0) {
        if (n_in != 25 || out_size != TL * D || ws_size < WS_END) { fprintf(stderr, "kernel_launch: unexpected shapes (n_in %d out %d ws %zu need %zu)\n", n_in, out_size, ws_size, (size_t)WS_END); grid = -1; return; }
        int dev = 0, cus = 0, per_cu = 0;
        if (hipGetDevice(&dev) != hipSuccess || hipDeviceGetAttribute(&cus, hipDeviceAttributeMultiprocessorCount, dev) != hipSuccess) { grid = -1; return; }
        if (hipFuncSetAttribute((const void*)fwd_kernel, hipFuncAttributeMaxDynamicSharedMemorySize, LDS_BYTES) != hipSuccess) { fprintf(stderr, "kernel_launch: hipFuncSetAttribute failed\n"); grid = -1; return; }
        if (hipOccupancyMaxActiveBlocksPerMultiprocessor(&per_cu, (const void*)fwd_kernel, NTHREADS, LDS_BYTES) != hipSuccess || per_cu < 1) { fprintf(stderr, "kernel_launch: occupancy query says %d\n", per_cu); }
        (void)hipGetLastError();
        grid = (cus == 256) ? 256 : -1;
        if (grid < 0) { fprintf(stderr, "kernel_launch: need a 256-CU device, got %d\n", cus); return; }
    }
    if (grid < 0) return;
    if (hipMemsetAsync((char*)d_ws + WS_CTL, 0, CTL_BYTES, stream) != hipSuccess) return;
    Args a{};
    a.x = (const float*)d_in[0]; a.c = (const float*)d_in[1]; a.ctx = (const float*)d_in[2]; a.c_ctx = (const float*)d_in[3]; a.w_ada = (const float*)d_in[4]; a.b_ada = (const float*)d_in[5];
    a.w_in = (const float*)d_in[6]; a.g_q_a = (const float*)d_in[7]; a.w_q_b = (const float*)d_in[8]; a.g_kv_a = (const float*)d_in[9]; a.w_kv_b = (const float*)d_in[10];
    a.g_gq = (const float*)d_in[11]; a.g_gk = (const float*)d_in[12]; a.w_o = (const float*)d_in[13]; a.ln1_g = (const float*)d_in[14]; a.ln1_b = (const float*)d_in[15];
    a.w_rg = (const float*)d_in[16]; a.b_rg = (const float*)d_in[17]; a.w_re = (const float*)d_in[18]; a.b_re = (const float*)d_in[19];
    a.w_gate = (const float*)d_in[20]; a.w_up = (const float*)d_in[21]; a.w_down = (const float*)d_in[22]; a.ln2_g = (const float*)d_in[23]; a.ln2_b = (const float*)d_in[24];
    a.out = (float*)d_out; a.ws = (unsigned char*)d_ws;
    hipLaunchKernelGGL(fwd_kernel, dim3(grid), dim3(NTHREADS), LDS_BYTES, stream, a);
}
```

```cpp
#include <hip/hip_runtime.h>
#include <cstdint>
#include <cstdio>

#ifndef REP_ATTN
#define REP_ATTN 1
#endif
#ifndef REP_GEMM
#define REP_GEMM 1
#endif
#ifndef REP_PRO
#define REP_PRO 1
#endif
#ifndef REP_THIN
#define REP_THIN 1
#endif
#ifndef REP_P2
#define REP_P2 1
#endif
#ifndef REP_P7
#define REP_P7 1
#endif
#ifndef REP_P6
#define REP_P6 1
#endif
#ifndef REP_P10
#define REP_P10 0
#endif
#ifndef FILL_P1
#define FILL_P1 3
#endif
#ifndef FILL_P5
#define FILL_P5 3
#endif
#ifndef USE_MFMA_GEMM
#define USE_MFMA_GEMM 1
#endif
#ifndef USE_MFMA_ATTN
#define USE_MFMA_ATTN 1
#endif

#define GAS __attribute__((address_space(1)))
#define LAS __attribute__((address_space(3)))
typedef unsigned short bf16_t;
typedef float f32x4 __attribute__((ext_vector_type(4)));
typedef float f32x2 __attribute__((ext_vector_type(2)));
typedef unsigned u32x4 __attribute__((ext_vector_type(4)));
typedef unsigned u32x2 __attribute__((ext_vector_type(2)));
typedef short bf16x8 __attribute__((ext_vector_type(8)));

constexpr int D = 1024, NB = 16, SEQ = 2048, CTX = 256, NL = 4;
constexpr int TL = NB * SEQ, TC = NB * CTX, MT = TL + TC;
constexpr int KPB = CTX + SEQ;
constexpr int ZW = 1536;
constexpr int QW = 768, KVW = 1024;
constexpr int NEXP = 32, FF = 512;
constexpr int XS_ROWS = 81920;
constexpr float ALPHA = 1.6817928305074290f;
constexpr float LOG2E = 1.4426950408889634f;
constexpr float QSCALE_M = 0.10206207261596575f * LOG2E;
constexpr float QSCALE_G = 0.125f * LOG2E;
constexpr float RMS_EPS = 1e-6f, LN_EPS = 1e-5f;
constexpr int NWAVES = 8, NTHREADS = 512, GRID = 256;

constexpr size_t al256(size_t x) { return (x + 255) & ~(size_t)255; }
constexpr size_t WS_CTL = 0, CTL_BYTES = 65536;
constexpr size_t WS_BLKCNT = WS_CTL + CTL_BYTES;
constexpr size_t WS_MOETAB = WS_BLKCNT + (size_t)NL * 256 * 32 * 4;
constexpr size_t WS_MOD = WS_MOETAB + (size_t)NL * 128 * 4;
constexpr size_t WS_MODP = WS_MOD + (size_t)NL * 17 * 6144 * 4;
constexpr size_t WS_TAB64 = WS_MODP + (size_t)4 * NL * 17 * 6144 * 4;
constexpr size_t WS_TAB32 = WS_TAB64 + 64 * 16 * 8;
constexpr size_t WS_RSTDQ = WS_TAB32 + 64 * 8 * 8;
constexpr size_t WS_RSTDKV = WS_RSTDQ + (size_t)MT * 4;
constexpr size_t WS_TOKE = WS_RSTDKV + (size_t)MT * 4;
constexpr size_t WS_TOKR = WS_TOKE + (size_t)MT * 8;
constexpr size_t WS_TOKP = WS_TOKR + (size_t)MT * 8;
constexpr size_t WS_TOKW = WS_TOKP + (size_t)MT * 8;
constexpr size_t WS_WIN = al256(WS_TOKW + (size_t)MT * 8);
constexpr size_t WS_WQ = WS_WIN + (size_t)NL * ZW * D * 2;
constexpr size_t WS_WKV = WS_WQ + (size_t)NL * QW * 384 * 2;
constexpr size_t WS_WO = WS_WKV + (size_t)NL * KVW * 256 * 2;
constexpr size_t WS_WGU = WS_WO + (size_t)NL * D * D * 2;
constexpr size_t WS_WD = WS_WGU + (size_t)NL * NEXP * 1024 * D * 2;
constexpr size_t WS_XC = WS_WD + (size_t)NL * NEXP * D * FF * 2;
constexpr size_t WS_H = WS_XC + (size_t)TC * D * 4;
constexpr size_t WS_B = WS_H + (size_t)MT * D * 2;
constexpr size_t WS_Z = WS_B;
constexpr size_t WS_QM = WS_Z + (size_t)MT * ZW * 2;
constexpr size_t WS_KM = WS_QM + (size_t)MT * QW * 2;
constexpr size_t WS_VM = WS_KM + (size_t)MT * QW * 2;
constexpr size_t WS_QG = WS_VM + (size_t)MT * 512 * 2;
constexpr size_t WS_KG = WS_QG + (size_t)MT * 512 * 2;
constexpr size_t WS_VG = WS_KG + (size_t)MT * 128 * 2;
constexpr size_t WS_O = WS_VG + (size_t)MT * 128 * 2;
constexpr size_t WS_BEND = WS_O + (size_t)MT * D * 2;
constexpr size_t WS_U = WS_B;
constexpr size_t WS_XS = WS_B;
constexpr size_t WS_ACT = WS_XS + (size_t)XS_ROWS * D * 2;
constexpr size_t WS_HLO = WS_BEND;
constexpr size_t WS_WR = WS_HLO + (size_t)MT * D * 2;
constexpr size_t WS_POSTOK = WS_WR + (size_t)NL * 2 * 48 * D * 2;
constexpr size_t WS_XB = al256(WS_POSTOK + (size_t)XS_ROWS * 4);
constexpr size_t WS_END = WS_XB + (size_t)MT * D * 2;
static_assert(WS_U + (size_t)MT * D * 4 <= WS_KM, "U must fit in Z+QM");
static_assert(WS_ACT + (size_t)XS_ROWS * FF * 2 <= WS_BEND, "MoE buffers must fit in region B");
static_assert(WS_END < (size_t)1100 * 1000 * 1000, "workspace map too large");

constexpr int LDS_BYTES = 163840;
constexpr int BIG_BYTES = 147456;
constexpr int MISC_OFF = BIG_BYTES;
constexpr int MISC_BAR = MISC_OFF;
constexpr int MISC_CNT = MISC_OFF + 64;
constexpr int MISC_POFF = MISC_OFF + 256;
constexpr int MISC_TOT = MISC_OFF + 512;
constexpr int MISC_BASE = MISC_OFF + 768;
constexpr int MISC_PA = MISC_OFF + 1024;
constexpr int MISC_PB = MISC_OFF + 1024 + 2048;
constexpr int MISC_LG = MISC_OFF + 8192;

#define LDS_WAIT() asm volatile("s_waitcnt lgkmcnt(0)" ::: "memory")
__device__ __forceinline__ unsigned f2bf(float f) { unsigned u = __builtin_bit_cast(unsigned, f); return (u + 0x7fffu + ((u >> 16) & 1u)) >> 16; }
__device__ __forceinline__ unsigned pk2(float lo, float hi) { typedef __bf16 bf2_t __attribute__((ext_vector_type(2))); f32x2 v = {lo, hi}; bf2_t b = __builtin_convertvector(v, bf2_t); return __builtin_bit_cast(unsigned, b); }
__device__ __forceinline__ float bflo(unsigned w) { return __builtin_bit_cast(float, w << 16); }
__device__ __forceinline__ float bfhi(unsigned w) { return __builtin_bit_cast(float, w & 0xffff0000u); }
template <int K> __device__ __forceinline__ float lane_xor(float v) { return __int_as_float(__builtin_amdgcn_ds_swizzle(__float_as_int(v), (K << 10) | 0x1f)); }
__device__ __forceinline__ float wave_sum(float v) {
    v += lane_xor<1>(v); v += lane_xor<2>(v); v += lane_xor<4>(v); v += lane_xor<8>(v); v += lane_xor<16>(v);
    { auto rr = __builtin_amdgcn_permlane32_swap(__float_as_uint(v), __float_as_uint(v), false, false); v = __uint_as_float(rr[0]) + __uint_as_float(rr[1]); }
    return v;
}
__device__ __forceinline__ int krow_of(int r) { return r < TL ? (r >> 11) * KPB + CTX + (r & 2047) : ((r - TL) >> 8) * KPB + ((r - TL) & 255); }
__device__ __forceinline__ int bb_of(int r) { return r < TL ? (r >> 11) : 16; }

#define XB_TMO      128
#define XB_XCNT(j)  (256  + 64 * (j))
#define XB_XSUB(j)  (1280 + 64 * (j))
#define XB_XGEN(j)  (2304 + 64 * (j))
#define XB_TOP      3328
#define XB_TOPGEN   3392
#define XCD_BAR_WORDS 3456
#define XB_SPIN_CAP (1u << 18)
__device__ __forceinline__ unsigned xb_ld(unsigned* p)              { return __hip_atomic_load(p, __ATOMIC_RELAXED, __HIP_MEMORY_SCOPE_AGENT); }
__device__ __forceinline__ unsigned xb_add(unsigned* p, unsigned v) { return __hip_atomic_fetch_add(p, v, __ATOMIC_RELAXED, __HIP_MEMORY_SCOPE_AGENT); }
__device__ __forceinline__ unsigned xb_xcc_id() { return (unsigned)__builtin_amdgcn_s_getreg((3 << 11) | 20) & 0xFu; }
#define XB_SPIN(cond, bar) do { unsigned _sp = 0; while (cond) { __builtin_amdgcn_s_sleep(1); \
    if ((++_sp & 255u) == 0u) { if (xb_ld(&(bar)[XB_TMO])) break; if (_sp > XB_SPIN_CAP) { atomicAdd(&(bar)[XB_TMO], 1u); break; } } } } while (0)
struct XcdBarrier { unsigned* bar; unsigned x; volatile LAS unsigned* st; };
__device__ __forceinline__ XcdBarrier xcd_barrier_post(unsigned* bar, volatile LAS unsigned* st, const bool leader) {
    XcdBarrier b; b.bar = bar; b.x = xb_xcc_id(); b.st = st;
    if (leader) (void)xb_add(&bar[XB_XCNT(b.x)], 1u);
    return b;
}
__device__ __forceinline__ void xcd_barrier_complete(unsigned* bar, unsigned x, unsigned& nloc, unsigned& nx) {
    const unsigned G = gridDim.x * gridDim.y * gridDim.z;
    unsigned sum, cnt, mine, sp = 0u;
    for (;;) {
        sum = 0u; cnt = 0u; mine = 0u;
#pragma unroll
        for (unsigned j = 0; j < 16; ++j) { const unsigned c = xb_ld(&bar[XB_XCNT(j)]); sum += c; cnt += (c > 0u) ? 1u : 0u; mine = (j == x) ? c : mine; }
        if (sum == G) break;
        __builtin_amdgcn_s_sleep(1);
        if ((++sp & 255u) == 0u) { if (xb_ld(&bar[XB_TMO])) break; if (sp > XB_SPIN_CAP) { atomicAdd(&bar[XB_TMO], 1u); break; } }
    }
    nloc = mine > 0u ? mine : 1u; nx = cnt > 0u ? cnt : 1u;
}
__device__ __forceinline__ void xcd_barrier(const XcdBarrier& b, const bool leader) {
    asm volatile("s_waitcnt vmcnt(0)" ::: "memory");
    __syncthreads();
    if (leader) {
        unsigned* bar = b.bar;
        __builtin_amdgcn_s_waitcnt(0);
        unsigned nloc = b.st[0], nx = b.st[1];
        if (nloc == 0u) { xcd_barrier_complete(bar, b.x, nloc, nx); b.st[0] = nloc; b.st[1] = nx; }
        const unsigned old = xb_add(&bar[XB_XSUB(b.x)], 1u);
        const unsigned gen = old / nloc;
        if (old + 1u == (gen + 1u) * nloc) {
            __builtin_amdgcn_fence(__ATOMIC_RELEASE, "agent");
            asm volatile("s_waitcnt vmcnt(0)" ::: "memory");
            const unsigned og = xb_add(&bar[XB_TOP], 1u);
            const unsigned tg = og / nx;
            if (og + 1u == (tg + 1u) * nx) xb_add(&bar[XB_TOPGEN], 1u);
            else XB_SPIN(xb_ld(&bar[XB_TOPGEN]) == tg, bar);
            __builtin_amdgcn_fence(__ATOMIC_ACQUIRE, "agent");
            xb_add(&bar[XB_XGEN(b.x)], 1u);
            asm volatile("s_waitcnt vmcnt(0)" ::: "memory");
        } else {
            XB_SPIN(xb_ld(&bar[XB_XGEN(b.x)]) == gen, bar);
            __builtin_amdgcn_fence(__ATOMIC_ACQUIRE, "agent");
            asm volatile("s_waitcnt vmcnt(0)" ::: "memory");
        }
    }
    __syncthreads();
}

struct Args {
    const float* x; const float* c; const float* ctx; const float* c_ctx; const float* w_ada; const float* b_ada; const float* w_in;
    const float* g_q_a; const float* w_q_b; const float* g_kv_a; const float* w_kv_b; const float* g_gq; const float* g_gk; const float* w_o;
    const float* ln1_g; const float* ln1_b; const float* w_rg; const float* b_rg; const float* w_re; const float* b_re;
    const float* w_gate; const float* w_up; const float* w_down; const float* ln2_g; const float* ln2_b;
    float* out; unsigned char* ws;
};

typedef const __attribute__((address_space(4))) Args* KP;
__device__ __forceinline__ Args ldargs(KP p) {
#if defined(__HIP_DEVICE_COMPILE__)
    asm volatile("" : "+s"(p)); return *p;
#else
    return Args{};
#endif
}

struct Ctx {
    LAS unsigned char* lds;
    int tid, lane, wave, vcu, bk;
};

struct Unit { int pm, pn; };
constexpr int BM = 256, NXCD = 8, WGM = 8;
struct StaticOrder {
    int nM, nN, nwg, G, c;
    __device__ void init(int M, int N, int G_, int c_) { nM = M / BM; nN = N / BM; nwg = nM * nN; G = G_; c = c_; }
    __device__ bool next(int i, Unit& u) const {
        const long L = (long)i * G + c; if (L >= nwg) return false;
        int wgid = (int)L; { const int q = nwg / NXCD, r = nwg % NXCD, xcd = wgid % NXCD, off = wgid / NXCD; wgid = (xcd < r ? xcd * (q + 1) : r * (q + 1) + (xcd - r) * q) + off; }
        const int nig = WGM * nN, gid = wgid / nig, fm = gid * WGM, gsz = (nM - fm) < WGM ? (nM - fm) : WGM;
        u.pm = fm + ((wgid % nig) % gsz); u.pn = (wgid % nig) / gsz; return true;
    }
    __device__ __forceinline__ void a_ready(const Unit&) const {}
    __device__ __forceinline__ void done(const Unit&) const {}
};
struct GroupedOrder {
    const volatile LAS int* poff; int nunits, G, c;
    __device__ void init(const volatile LAS int* poff_, int G_, int c_) { poff = poff_; nunits = (poff_[32] >> 8) * 4; G = G_; c = c_; }
    __device__ bool next(int i, Unit& u) const {
        const int L = i * G + c; if (L >= nunits) return false;
        const int rt = L >> 2, r0 = rt << 8; int e = 0;
#pragma unroll
        for (int j = 1; j < 32; ++j) e += (poff[j] <= r0) ? 1 : 0;
        u.pm = rt; u.pn = e * 4 + (L & 3); return true;
    }
    __device__ __forceinline__ void a_ready(const Unit&) const {}
    __device__ __forceinline__ void done(const Unit&) const {}
};

__device__ __forceinline__ void st_bf4(bf16_t* p, f32x4 v) { u32x2 w; w.x = pk2(v[0], v[1]); w.y = pk2(v[2], v[3]); *(u32x2*)p = w; }
struct EpiZ {
    bf16_t* Z;
    __device__ __forceinline__ void tile32(int row, int col, int fq, f32x4 v0, f32x4 v1) const {
        bf16_t* p = Z + (size_t)row * ZW + col + 4 * fq; st_bf4(p, v0); st_bf4(p + 16, v1);
    }
};
struct EpiQ {
    bf16_t* Qm; const float* rstd; const f32x2* tab32;
    __device__ __forceinline__ void tile32(int row, int col, int fq, f32x4 v0, f32x4 v1) const {
        const int h = col / 96, gi = (col - h * 96) >> 5;
        const float rs = rstd[row] * QSCALE_M;
        v0 = v0 * rs; v1 = v1 * rs;
        bf16_t* base = Qm + (size_t)row * QW + h * 96;
        if (gi < 2) { bf16_t* p = base + gi * 32 + 4 * fq; st_bf4(p, v0); st_bf4(p + 16, v1); }
        else {
            const int part = fq >> 1, f0 = (4 * fq) & 7;
            f32x4 o1 = v0, o2 = v1;
            if (row < TL) {
                const int s = row & 2047, pos = part ? (s & 63) : (s >> 6);
#pragma unroll
                for (int j = 0; j < 4; ++j) { const f32x2 cs = tab32[pos * 8 + f0 + j]; o1[j] = v0[j] * cs.x - v1[j] * cs.y; o2[j] = v1[j] * cs.x + v0[j] * cs.y; }
            }
            bf16_t* p = base + 64 + part * 16 + f0; st_bf4(p, o1); st_bf4(p + 8, o2);
        }
    }
};
struct EpiKV {
    bf16_t* Km; bf16_t* Vm; const float* rstd;
    __device__ __forceinline__ void tile32(int row, int col, int fq, f32x4 v0, f32x4 v1) const {
        const int h = col >> 7, w = col & 127; const float rs = rstd[row]; const int kr = krow_of(row);
        v0 = v0 * rs; v1 = v1 * rs;
        bf16_t* p = (w < 64) ? (Km + (size_t)kr * QW + h * 96 + w + 4 * fq) : (Vm + (size_t)kr * 512 + h * 64 + (w - 64) + 4 * fq);
        st_bf4(p, v0); st_bf4(p + 16, v1);
    }
};
struct EpiU {
    float* U; const float* xl; const float* xc; const float* mod_l;
    int gate;
    __device__ __forceinline__ void tile32(int row, int col, int fq, f32x4 v0, f32x4 v1) const {
        const float* xr = (row < TL) ? (xl + (size_t)row * D) : (xc + (size_t)(row - TL) * D);
        const float* g = mod_l + (size_t)(bb_of(row) * 6 + gate) * D;
        const int c0 = col + 4 * fq;
        const f32x4 x0 = *(const f32x4*)(xr + c0), x1 = *(const f32x4*)(xr + c0 + 16), g0 = *(const f32x4*)(g + c0), g1 = *(const f32x4*)(g + c0 + 16);
        float* u = U + (size_t)row * D + c0;
        *(f32x4*)u = x0 * ALPHA + g0 * v0; *(f32x4*)(u + 16) = x1 * ALPHA + g1 * v1;
    }
};
__device__ __forceinline__ float silu_f(float x) { return x * __builtin_amdgcn_rcpf(1.0f + __builtin_amdgcn_exp2f(-x * LOG2E)); }
struct EpiAct {
    bf16_t* Act;
    __device__ __forceinline__ void tile32(int row, int col, int fq, f32x4 v0, f32x4 v1) const {
        const int f0 = ((col & 1023) >> 1) + 4 * fq; f32x4 a;
#pragma unroll
        for (int j = 0; j < 4; ++j) a[j] = silu_f(v0[j]) * v1[j];
        st_bf4(Act + (size_t)row * FF + f0, a);
    }
};
struct EpiYo {
    bf16_t* Y;
    __device__ __forceinline__ void tile32(int row, int col, int fq, f32x4 v0, f32x4 v1) const {
        bf16_t* p = Y + (size_t)row * D + col + 4 * fq; st_bf4(p, v0); st_bf4(p + 16, v1);
    }
};
struct EpiY {
    bf16_t* Y;
    __device__ __forceinline__ void tile32(int row, int col, int fq, f32x4 v0, f32x4 v1) const {
        bf16_t* p = Y + (size_t)row * D + (col & 1023) + 4 * fq; st_bf4(p, v0); st_bf4(p + 16, v1);
    }
};

struct Gemm { const bf16_t* A; int lda; const bf16_t* Bt; int K; };
__device__ __forceinline__ float dot8(u32x4 a, u32x4 b, float acc) {
#pragma unroll
    for (int i = 0; i < 4; ++i) { acc += bflo(a[i]) * bflo(b[i]); acc += bfhi(a[i]) * bfhi(b[i]); }
    return acc;
}
template <class Sched, class Epi>
__device__ __forceinline__ void gemm_naive(const Ctx& F, const Gemm g, const Sched& S, const Epi& E) {
    Unit u;
    for (int i = 0; S.next(i, u); ++i) {
        for (int task = F.tid; task < 8192; task += NTHREADS) {
            const int lane = task & 63, fr = lane & 15, fq = lane >> 4, rest = task >> 6, rg = rest & 15, cg = rest >> 4;
            const int row = u.pm * 256 + rg * 16 + fr, col = u.pn * 256 + cg * 32;
            const bf16_t* ap = g.A + (size_t)row * g.lda;
            const bf16_t* bp0 = g.Bt + (size_t)(col + 4 * fq) * g.K;
            const bf16_t* bp1 = bp0 + (size_t)16 * g.K;
            f32x4 v0 = {0.f, 0.f, 0.f, 0.f}, v1 = {0.f, 0.f, 0.f, 0.f};
            for (int k = 0; k < g.K; k += 8) {
                const u32x4 a = *(const u32x4*)(ap + k);
#pragma unroll
                for (int j = 0; j < 4; ++j) {
                    v0[j] = dot8(a, *(const u32x4*)(bp0 + (size_t)j * g.K + k), v0[j]);
                    v1[j] = dot8(a, *(const u32x4*)(bp1 + (size_t)j * g.K + k), v1[j]);
                }
            }
            E.tile32(row, col, fq, v0, v1);
        }
    }
}
constexpr int BK = 64, HALF = 128, HTB = HALF * BK * 2, STAGE_BYTES = 8 * HTB;
__device__ __forceinline__ int lds_byte(int r, int c) { const int st = (r >> 4) * 2 + (c >> 5), rr = r & 15, cc = c & 31, ob = rr * 64 + cc * 2; return st * 1024 + (ob ^ (((ob >> 9) & 1) << 5)); }
__device__ __forceinline__ void stage_rc(int b, int& R, int& C) { const int st = b / 1024, sb = b % 1024, swz = sb ^ (((sb >> 9) & 1) << 5); R = (st >> 1) * 16 + swz / 64; C = (st & 1) * 32 + (swz % 64) / 2; }
template <class Epi, class Sched, bool ALIGN_EPI = true, bool SP2 = true, bool GATHER = false>
__device__ __forceinline__ void gemm_mfma(LAS unsigned char* lds, const int tid_in, const Gemm g, const Sched& S, const Epi& E, const LAS int* gtab = nullptr) {
    int tid = tid_in; asm volatile("" : "+v"(tid));
    const int wid = __builtin_amdgcn_readfirstlane(tid >> 6), lane = tid & 63, wr = wid >> 2, wc = wid & 3, fr = lane & 15, fq = lane >> 4;
    const int K = g.K, nt = K / BK;
    unsigned voffB[2]; int RA[2], CA[2];
#pragma unroll
    for (int i = 0; i < 2; ++i) { int R, C; stage_rc(tid * 16 + i * 8192, R, C); const int Rb = R;
        RA[i] = R; CA[i] = C; voffB[i] = (unsigned)(Rb * K + C) * 2u; }
    const size_t kstep = (size_t)(BK * 2);
    const size_t hstepA = (size_t)HALF * g.lda * 2, hstepB = (size_t)HALF * K * 2;
    const size_t tstepA = GATHER ? 0 : 2 * hstepA, tstepB = 2 * hstepB;
    unsigned vc0[2], vc1[2], vn0[2], vn1[2];
#define PG8_GOFF(dst0, dst1, ui_) do { _Pragma("unroll") for (int i_ = 0; i_ < 2; ++i_) { \
        if constexpr (GATHER) { dst0[i_] = (unsigned)gtab[(ui_) * 256 + RA[i_]] * (unsigned)(g.lda * 2) + (unsigned)CA[i_] * 2u; dst1[i_] = (unsigned)gtab[(ui_) * 256 + HALF + RA[i_]] * (unsigned)(g.lda * 2) + (unsigned)CA[i_] * 2u; } \
        else { dst0[i_] = (unsigned)(RA[i_] * g.lda + CA[i_]) * 2u; dst1[i_] = dst0[i_] + (unsigned)hstepA; } } } while (0)
    const unsigned ldsw = (unsigned)wid * 1024u;
    const int aoff = lds_byte(wr * 64 + fr, fq * 8), boff = lds_byte(wc * 32 + fr, fq * 8);
#define PG8_SA(b, h) (((b) * 2 + (h)) * HTB)
#define PG8_SB(b, h) ((4 + (b) * 2 + (h)) * HTB)
#define PG8_STAGE(bufoff, gbase, voff) do { _Pragma("unroll") for (int _i = 0; _i < 2; ++_i) \
        __builtin_amdgcn_global_load_lds((const unsigned*)((const char*)(gbase) + (voff)[_i]), (LAS unsigned*)(lds + (bufoff) + ldsw + _i * 8192), 16, 0, 0); } while (0)
#define PG8_LDA(dst, b, h) do { _Pragma("unroll") for (int m = 0; m < 4; ++m) _Pragma("unroll") for (int k = 0; k < 2; ++k) dst[m][k] = *(const LAS bf16x8*)(lds + PG8_SA(b, h) + aoff + m * 2048 + k * 1024); } while (0)
#define PG8_LDB(dst, b, h) do { _Pragma("unroll") for (int n = 0; n < 2; ++n) _Pragma("unroll") for (int k = 0; k < 2; ++k) dst[n][k] = *(const LAS bf16x8*)(lds + PG8_SB(b, h) + boff + n * 2048 + k * 1024); } while (0)
#define PG8_MMA(ai, bj, At, Bt) do { __builtin_amdgcn_s_setprio(1); _Pragma("unroll") for (int m = 0; m < 4; ++m) _Pragma("unroll") for (int n = 0; n < 2; ++n) _Pragma("unroll") for (int k = 0; k < 2; ++k) \
        acc[ai][bj][m][n] = __builtin_amdgcn_mfma_f32_16x16x32_bf16(Bt[n][k], At[m][k], acc[ai][bj][m][n], 0, 0, 0); __builtin_amdgcn_s_setprio(0); } while (0)
#define PG8_WAIT_V(n) asm volatile("s_waitcnt vmcnt(" #n ")" ::: "memory")
#define PG8_WAIT_L(n) asm volatile("s_waitcnt lgkmcnt(" #n ")" ::: "memory")
#define PG8_BAR __builtin_amdgcn_s_barrier()
#define PG8_SCHED __builtin_amdgcn_sched_barrier(0)
    Unit cur, nxt; int ui = 0;
    if (!S.next(0, cur)) return;
    PG8_GOFF(vc0, vc1, 0);
#pragma unroll
    for (int i = 0; i < 2; ++i) { vn0[i] = vc0[i]; vn1[i] = vc1[i]; }
    f32x4 acc[2][2][4][2];
#pragma unroll
    for (int a = 0; a < 2; ++a)
#pragma unroll
        for (int b = 0; b < 2; ++b)
#pragma unroll
            for (int m = 0; m < 4; ++m)
#pragma unroll
                for (int n = 0; n < 2; ++n) acc[a][b][m][n] = (f32x4){0.f, 0.f, 0.f, 0.f};
    bf16x8 At[4][2], B0[2][2], B1[2][2];
    const char* cA = (const char*)g.A + (size_t)cur.pm * tstepA; const char* cB = (const char*)g.Bt + (size_t)cur.pn * tstepB;
    S.a_ready(cur);
    if constexpr (SP2) {
        PG8_STAGE(PG8_SB(0, 0), cB, voffB); PG8_STAGE(PG8_SB(0, 1), cB + hstepB, voffB); PG8_STAGE(PG8_SA(0, 0), cA, vc0); PG8_STAGE(PG8_SA(0, 1), cA, vc1);
        if (wr == 1) PG8_BAR;
        PG8_WAIT_V(2); PG8_BAR;
        PG8_STAGE(PG8_SB(1, 0), cB + kstep, voffB); PG8_STAGE(PG8_SA(1, 0), cA + kstep, vc0); PG8_STAGE(PG8_SB(1, 1), cB + hstepB + kstep, voffB);
        PG8_WAIT_V(6); PG8_BAR;
    } else {
        PG8_STAGE(PG8_SB(0, 0), cB, voffB); PG8_STAGE(PG8_SA(0, 0), cA, vc0); PG8_STAGE(PG8_SB(0, 1), cB + hstepB, voffB); PG8_STAGE(PG8_SA(0, 1), cA, vc1);
        if (wr == 1) PG8_BAR;
        PG8_WAIT_V(4); PG8_BAR;
        PG8_STAGE(PG8_SB(1, 0), cB + kstep, voffB); PG8_STAGE(PG8_SA(1, 0), cA + kstep, vc0); PG8_STAGE(PG8_SB(1, 1), cB + hstepB + kstep, voffB);
        PG8_WAIT_V(6); PG8_BAR;
    }
    for (;;) {
        const bool has_next = S.next(ui + 1, nxt);
        if constexpr (GATHER) { if (has_next) { PG8_GOFF(vn0, vn1, ui + 1); } else {
#pragma unroll
            for (int i = 0; i < 2; ++i) { vn0[i] = vc0[i]; vn1[i] = vc1[i]; } } }
        const char* nA = has_next ? (const char*)g.A + (size_t)nxt.pm * tstepA : cA; const char* nB = has_next ? (const char*)g.Bt + (size_t)nxt.pn * tstepB : cB;
        for (int t = 0; t < nt; t += 2) {
            const bool last = (t == nt - 2);
            const char* a1 = cA + (size_t)(t + 1) * kstep;
            const char* a2 = last ? nA : cA + (size_t)(t + 2) * kstep; const char* b2 = last ? nB : cB + (size_t)(t + 2) * kstep;
            const char* a3 = a2 + kstep; const char* b3 = b2 + kstep;
            unsigned s0[2], s1[2];
#pragma unroll
            for (int i = 0; i < 2; ++i) { if constexpr (GATHER) { s0[i] = last ? vn0[i] : vc0[i]; s1[i] = last ? vn1[i] : vc1[i]; } else { s0[i] = vc0[i]; s1[i] = vc1[i]; } }
            if (last && has_next) S.a_ready(nxt);
            if constexpr (SP2) {
            PG8_LDB(B0, 0, 0); PG8_LDB(B1, 0, 1); PG8_SCHED; PG8_LDA(At, 0, 0); PG8_STAGE(PG8_SA(1, 1), a1, vc1);
            PG8_WAIT_V(8); PG8_WAIT_L(0); PG8_BAR; PG8_MMA(0, 0, At, B0); PG8_MMA(0, 1, At, B1); PG8_BAR; PG8_SCHED;
            PG8_LDA(At, 0, 1); PG8_STAGE(PG8_SB(0, 0), b2, voffB); PG8_STAGE(PG8_SB(0, 1), b2 + hstepB, voffB); PG8_STAGE(PG8_SA(0, 0), a2, s0);
            PG8_WAIT_V(8); PG8_WAIT_L(0); PG8_BAR; PG8_MMA(1, 0, At, B0); PG8_MMA(1, 1, At, B1); PG8_BAR; PG8_SCHED;
            PG8_LDB(B0, 1, 0); PG8_LDB(B1, 1, 1); PG8_SCHED; PG8_LDA(At, 1, 0); PG8_STAGE(PG8_SA(0, 1), a2, s1);
            PG8_WAIT_V(8); PG8_WAIT_L(0); PG8_BAR; PG8_MMA(0, 0, At, B0); PG8_MMA(0, 1, At, B1); PG8_BAR; PG8_SCHED;
            PG8_LDA(At, 1, 1); PG8_STAGE(PG8_SB(1, 0), b3, voffB); PG8_STAGE(PG8_SB(1, 1), b3 + hstepB, voffB); PG8_STAGE(PG8_SA(1, 0), a3, s0);
            PG8_WAIT_V(8); PG8_WAIT_L(0); PG8_BAR; PG8_MMA(1, 0, At, B0); PG8_MMA(1, 1, At, B1); PG8_BAR; PG8_SCHED;
            } else {
            PG8_LDB(B0, 0, 0); PG8_SCHED; PG8_LDA(At, 0, 0); PG8_STAGE(PG8_SA(1, 1), a1, vc1);
            PG8_WAIT_L(8); PG8_BAR; PG8_WAIT_L(0); PG8_MMA(0, 0, At, B0); PG8_BAR; PG8_SCHED;
            PG8_LDB(B1, 0, 1); PG8_STAGE(PG8_SB(0, 0), b2, voffB);
            PG8_BAR; PG8_WAIT_L(0); PG8_MMA(0, 1, At, B1); PG8_BAR;
            PG8_LDA(At, 0, 1); PG8_STAGE(PG8_SA(0, 0), a2, s0);
            PG8_BAR; PG8_WAIT_L(0); PG8_MMA(1, 0, At, B0); PG8_BAR; PG8_SCHED;
            PG8_STAGE(PG8_SB(0, 1), b2 + hstepB, voffB);
            PG8_WAIT_V(6); PG8_BAR; PG8_MMA(1, 1, At, B1); PG8_BAR;
            PG8_LDB(B0, 1, 0); PG8_SCHED; PG8_LDA(At, 1, 0); PG8_STAGE(PG8_SA(0, 1), a2, s1);
            PG8_WAIT_L(8); PG8_BAR; PG8_WAIT_L(0); PG8_MMA(0, 0, At, B0); PG8_BAR; PG8_SCHED;
            PG8_LDB(B1, 1, 1); PG8_STAGE(PG8_SB(1, 0), b3, voffB);
            PG8_BAR; PG8_WAIT_L(0); PG8_MMA(0, 1, At, B1); PG8_BAR;
            PG8_LDA(At, 1, 1); PG8_STAGE(PG8_SA(1, 0), a3, s0);
            PG8_BAR; PG8_WAIT_L(0); PG8_MMA(1, 0, At, B0); PG8_BAR; PG8_SCHED;
            PG8_STAGE(PG8_SB(1, 1), b3 + hstepB, voffB);
            PG8_WAIT_V(6); PG8_BAR; PG8_MMA(1, 1, At, B1); PG8_BAR;
            }
        }
        if constexpr (ALIGN_EPI) { if (wr == 0) PG8_BAR; }
        {
            int ln_e; asm volatile("v_mbcnt_lo_u32_b32 %0, -1, 0\n\tv_mbcnt_hi_u32_b32 %0, -1, %0" : "=v"(ln_e));
            const int fr_e = ln_e & 15, fq_e = ln_e >> 4;
#pragma unroll
            for (int ai = 0; ai < 2; ++ai)
#pragma unroll
                for (int m = 0; m < 4; ++m) {
#pragma unroll
                    for (int bj = 0; bj < 2; ++bj)
                        E.tile32(cur.pm * BM + ai * HALF + wr * 64 + m * 16 + fr_e, cur.pn * BM + bj * HALF + wc * 32, fq_e, acc[ai][bj][m][0], acc[ai][bj][m][1]);
                    asm volatile("" ::: "memory");
                }
            S.done(cur);
        }
        if (!has_next) break;
#pragma unroll
        for (int a = 0; a < 2; ++a)
#pragma unroll
            for (int b = 0; b < 2; ++b)
#pragma unroll
                for (int m = 0; m < 4; ++m)
#pragma unroll
                    for (int n = 0; n < 2; ++n) acc[a][b][m][n] = (f32x4){0.f, 0.f, 0.f, 0.f};
        cur = nxt; cA = nA; cB = nB; ++ui;
        if constexpr (GATHER) {
#pragma unroll
            for (int i = 0; i < 2; ++i) { vc0[i] = vn0[i]; vc1[i] = vn1[i]; } }
        if constexpr (ALIGN_EPI) { if (wr == 1) PG8_BAR; }
    }
    PG8_WAIT_V(0);
    if constexpr (!ALIGN_EPI) { if (wr == 0) PG8_BAR; }
    PG8_BAR;
#undef PG8_GOFF
#undef PG8_SA
#undef PG8_SB
#undef PG8_STAGE
#undef PG8_LDA
#undef PG8_LDB
#undef PG8_MMA
#undef PG8_WAIT_V
#undef PG8_WAIT_L
#undef PG8_BAR
#undef PG8_SCHED
}

#ifndef REP_GEMM_MASK
#define REP_GEMM_MASK 0
#endif
template <int ID, class Sched, class Epi>
__device__ __forceinline__ void gemm_phase_gather(const Ctx& F, const Gemm g, const Sched& S, const Epi& E, const LAS int* gtab) {
    gemm_mfma<Epi, Sched, true, true, true>(F.lds, F.tid, g, S, E, gtab);
    if constexpr ((REP_GEMM_MASK >> ID) & 1) gemm_mfma<Epi, Sched, true, true, true>(F.lds, F.tid, g, S, E, gtab);
}
template <int ID, class Sched, class Epi>
__device__ __forceinline__ void gemm_phase(const Ctx& F, const Gemm g, const Sched& S, const Epi& E) {
#if USE_MFMA_GEMM
    gemm_mfma<Epi, Sched, true, true>(F.lds, F.tid, g, S, E);
    if constexpr ((REP_GEMM_MASK >> ID) & 1) gemm_mfma<Epi, Sched, true, true>(F.lds, F.tid, g, S, E);
#else
    gemm_naive(F, g, S, E);
#endif
}

template <class ColPtr>
__device__ __forceinline__ void tconv_tile(const ColPtr& cp, int ldw, const float* scale, bf16_t* WT, int K, int k0, int p0, LAS float* scr, int lane) {
    const int pc = (lane & 15) * 4, kq = lane >> 4;
    const float* src = cp(p0 + pc);
#pragma unroll 4
    for (int i = 0; i < 16; ++i) {
        const int kk = 4 * i + kq;
        f32x4 v = {0.f, 0.f, 0.f, 0.f};
        if (src) { v = *(const f32x4*)(src + (size_t)(k0 + kk) * ldw); if (scale) v = v * scale[k0 + kk]; }
        LAS float* d = scr + kk * 65 + pc; d[0] = v[0]; d[1] = v[1]; d[2] = v[2]; d[3] = v[3];
    }
    LDS_WAIT();
    const int c = lane & 7;
#pragma unroll
    for (int j = 0; j < 8; ++j) {
        const int n = (lane >> 3) + 8 * j; const LAS float* s = scr + (8 * c) * 65 + n;
        u32x4 o; o.x = pk2(s[0], s[65]); o.y = pk2(s[2 * 65], s[3 * 65]); o.z = pk2(s[4 * 65], s[5 * 65]); o.w = pk2(s[6 * 65], s[7 * 65]);
        *(u32x4*)(WT + (size_t)(p0 + n) * K + k0 + 8 * c) = o;
    }
    LDS_WAIT();
}
struct CpPlain { const float* W; int ncols; __device__ __forceinline__ const float* operator()(int p) const { return p < ncols ? W + p : nullptr; } };
struct CpQ {
    const float* W;
    __device__ __forceinline__ const float* operator()(int p) const {
        const int h = p / 96, pp = p - h * 96; int lc = pp;
        if (pp >= 64) { const int rp = pp - 64, i = rp & 15; lc = 64 + (i >> 3) * 16 + (i & 7) + ((rp >> 4) ? 8 : 0); }
        return W + h * 96 + lc;
    }
};
struct CpGU {
    const float* Wg; const float* Wu;
    __device__ __forceinline__ const float* operator()(int p) const { const int g32 = p >> 5, w = p & 31; return (w < 16) ? (Wg + g32 * 16 + w) : (Wu + g32 * 16 + (w - 16)); }
};

constexpr int CONV_ITEMS = NEXP * 256 + NEXP * 128, CONV_CH = 4, CONV_CTR0 = 8192;
struct ConvSrc { const float* p; size_t ld; bf16_t* dst; int K; };
__device__ __forceinline__ ConvSrc conv_decode(const Args& a, int l, int idx, int lane) {
    const int pc = (lane & 15) * 4, kq = lane >> 4; ConvSrc r;
    if (idx < NEXP * 256) { const int e = idx >> 8, q = idx & 255, k0 = (q >> 4) * 64, p = (q & 15) * 64 + pc, g32 = p >> 5, w = p & 31; const size_t le = (size_t)l * NEXP + e;
        r.p = ((w < 16) ? (a.w_gate + le * D * FF + g32 * 16 + w) : (a.w_up + le * D * FF + g32 * 16 + (w - 16))) + (size_t)(k0 + kq) * FF; r.ld = FF;
        r.dst = (bf16_t*)(a.ws + WS_WGU) + le * 1024 * D + (size_t)((q & 15) * 64) * D + k0; r.K = D; }
    else { const int i2 = idx - NEXP * 256, e = i2 >> 7, q = i2 & 127, k0 = (q >> 4) * 64, p0 = (q & 15) * 64; const size_t le = (size_t)l * NEXP + e;
        r.p = a.w_down + le * FF * D + (size_t)(k0 + kq) * D + p0 + pc; r.ld = D;
        r.dst = (bf16_t*)(a.ws + WS_WD) + le * D * FF + (size_t)p0 * FF + k0; r.K = FF; }
    return r;
}
__device__ __forceinline__ void conv_load(const ConvSrc& c, f32x4 (&v)[16]) {
#pragma unroll
    for (int i = 0; i < 16; ++i) v[i] = *(const f32x4*)(c.p + (size_t)(4 * i) * c.ld);
}
__device__ __forceinline__ void conv_store(const ConvSrc& c, const f32x4 (&v)[16], LAS float* scr, int lane) {
    const int pc = (lane & 15) * 4, kq = lane >> 4;
#pragma unroll
    for (int i = 0; i < 16; ++i) { LAS float* d = scr + (4 * i + kq) * 65 + pc; d[0] = v[i][0]; d[1] = v[i][1]; d[2] = v[i][2]; d[3] = v[i][3]; }
    LDS_WAIT();
    const int cc = lane & 7;
#pragma unroll
    for (int j = 0; j < 8; ++j) {
        const int n = (lane >> 3) + 8 * j; const LAS float* sp = scr + (8 * cc) * 65 + n;
        u32x4 o; o.x = pk2(sp[0], sp[65]); o.y = pk2(sp[2 * 65], sp[3 * 65]); o.z = pk2(sp[4 * 65], sp[5 * 65]); o.w = pk2(sp[6 * 65], sp[7 * 65]);
        *(u32x4*)(c.dst + (size_t)n * c.K + 8 * cc) = o;
    }
    LDS_WAIT();
}
__device__ __forceinline__ void conv_experts(const Ctx& F, const Args& a, int l, int grabs) {
    unsigned* ctr = (unsigned*)(a.ws + WS_CTL) + CONV_CTR0 + 64 * l;
    LAS float* scr = (LAS float*)(F.lds + F.wave * 18432);
    for (int g = 0; grabs < 0 || g < grabs; ++g) {
        unsigned b0 = 0; if (F.lane == 0) b0 = __hip_atomic_fetch_add(ctr, (unsigned)CONV_CH, __ATOMIC_RELAXED, __HIP_MEMORY_SCOPE_AGENT);
        const int base = __builtin_amdgcn_readfirstlane((int)b0);
        if (base >= CONV_ITEMS) break;
        f32x4 va[16], vb[16];
        ConvSrc c0 = conv_decode(a, l, base, F.lane), c1 = conv_decode(a, l, base + 1, F.lane), c2 = conv_decode(a, l, base + 2, F.lane), c3 = conv_decode(a, l, base + 3, F.lane);
        conv_load(c0, va); conv_load(c1, vb); conv_store(c0, va, scr, F.lane);
        conv_load(c2, va); conv_store(c1, vb, scr, F.lane);
        conv_load(c3, vb); conv_store(c2, va, scr, F.lane);
        conv_store(c3, vb, scr, F.lane);
    }
}

__device__ __forceinline__ void conv_filler(const Ctx& F, KP kp, int l, int grabs) {
    const Args a = ldargs(kp);
    int q = l;
    if (l == 0 || (int)__hip_atomic_load((unsigned*)(a.ws + WS_CTL) + CONV_CTR0 + 64 * l, __ATOMIC_RELAXED, __HIP_MEMORY_SCOPE_AGENT) >= CONV_ITEMS) q = l + 1;
    if (q < NL) conv_experts(F, a, q, grabs);
}
__device__ __forceinline__ void prologue1(const Ctx& F, KP kp) {
    const Args a = ldargs(kp);
    unsigned char* ws = a.ws;
    {
        LAS float* sl = (LAS float*)F.lds;
        float* modp = (float*)(ws + WS_MODP);
        for (int it = F.bk; it < NL * 12 * 4; it += GRID) {
            const int kc = it & 3, nc = (it >> 2) % 12, l = it / 48;
            __syncthreads();
            for (int idx = F.tid; idx < 17 * 256; idx += NTHREADS) {
                const int bb = idx >> 8, k = idx & 255; const float v = (bb < 16) ? a.c[bb * D + kc * 256 + k] : a.c_ctx[kc * 256 + k];
                sl[idx] = v / (1.0f + __expf(-v));
            }
            __syncthreads();
            const int n = nc * 512 + F.tid;
            const float* w = a.w_ada + ((size_t)l * D + kc * 256) * 6144 + n;
            float acc[17];
#pragma unroll
            for (int bb = 0; bb < 17; ++bb) acc[bb] = 0.f;
            for (int k = 0; k < 256; ++k) {
                const float wv = w[(size_t)k * 6144];
#pragma unroll
                for (int bb = 0; bb < 17; ++bb) acc[bb] += sl[bb * 256 + k] * wv;
            }
#pragma unroll
            for (int bb = 0; bb < 17; ++bb) modp[((size_t)(kc * NL + l) * 17 + bb) * 6144 + n] = acc[bb];
        }
        __syncthreads();
    }
    {
        f32x2* t64 = (f32x2*)(ws + WS_TAB64); f32x2* t32 = (f32x2*)(ws + WS_TAB32);
        const int gt = F.bk * NTHREADS + F.tid;
        if (gt < 64 * 16) { const int pos = gt >> 4, f = gt & 15; const float inv = powf(10000.0f, -((float)(2 * f) / 32.0f)); const float ang = (float)pos * inv; t64[gt] = (f32x2){cosf(ang), sinf(ang)}; }
        else if (gt < 64 * 16 + 64 * 8) { const int g2 = gt - 64 * 16, pos = g2 >> 3, f = g2 & 7; const float inv = powf(10000.0f, -((float)(2 * f) / 16.0f)); const float ang = (float)pos * inv; t32[g2] = (f32x2){cosf(ang), sinf(ang)}; }
    }
    {
        bf16_t* wr = (bf16_t*)(ws + WS_WR);
        for (int i = F.bk * NTHREADS + F.tid; i < NL * 48 * D; i += GRID * NTHREADS) {
            const int c = i & 1023, j = (i >> 10) % 48, l = i / (48 * D);
            float wv = 0.f;
            if (j < 4) wv = a.w_rg[((size_t)l * D + c) * 4 + j]; else if (j < 36) wv = a.w_re[((size_t)l * D + c) * 32 + (j - 4)];
            const unsigned h = f2bf(wv); const float rem = wv - __builtin_bit_cast(float, h << 16);
            wr[((size_t)(l * 2 + 0) * 48 + j) * D + c] = (bf16_t)h; wr[((size_t)(l * 2 + 1) * 48 + j) * D + c] = (bf16_t)f2bf(rem);
        }
    }
    {
        LAS float* scr = (LAS float*)(F.lds + F.wave * 18432);
        const int gw = F.vcu * NWAVES + F.wave, NGW = GRID * NWAVES;
        constexpr int I_IN = 16 * 24, I_Q = 6 * 12, I_KV = 4 * 16, I_O = 16 * 16, I_GU = 16 * 16, I_D = 8 * 16;
        constexpr int N_SMALL = NL * (I_IN + I_Q + I_KV + I_O), N_GU = NL * NEXP * I_GU, N_D = NL * NEXP * I_D;
        for (int it = gw; it < N_SMALL; it += NGW) {
            {
                const int l = it / (I_IN + I_Q + I_KV + I_O); int r = it % (I_IN + I_Q + I_KV + I_O);
                if (r < I_IN) { const int kt = r / 24, pt = r % 24; tconv_tile(CpPlain{a.w_in + (size_t)l * D * 1440, 1440}, 1440, nullptr, (bf16_t*)(ws + WS_WIN) + (size_t)l * ZW * D, D, kt * 64, pt * 64, scr, F.lane); continue; }
                r -= I_IN;
                if (r < I_Q) { const int kt = r / 12, pt = r % 12; tconv_tile(CpQ{a.w_q_b + (size_t)l * 384 * QW}, QW, a.g_q_a + l * 384, (bf16_t*)(ws + WS_WQ) + (size_t)l * QW * 384, 384, kt * 64, pt * 64, scr, F.lane); continue; }
                r -= I_Q;
                if (r < I_KV) { const int kt = r / 16, pt = r % 16; tconv_tile(CpPlain{a.w_kv_b + (size_t)l * 256 * KVW, KVW}, KVW, a.g_kv_a + l * 256, (bf16_t*)(ws + WS_WKV) + (size_t)l * KVW * 256, 256, kt * 64, pt * 64, scr, F.lane); continue; }
                r -= I_KV;
                { const int kt = r / 16, pt = r % 16; tconv_tile(CpPlain{a.w_o + (size_t)l * D * D, D}, D, nullptr, (bf16_t*)(ws + WS_WO) + (size_t)l * D * D, D, kt * 64, pt * 64, scr, F.lane); }
            }
        }
        conv_experts(F, a, 0, -1);
    }
}

__device__ __forceinline__ void prologue2(const Ctx& F, KP kp) {
    const Args a = ldargs(kp);
    const float* modp = (const float*)(a.ws + WS_MODP); float* mod = (float*)(a.ws + WS_MOD);
    constexpr int NE = NL * 17 * 6144 / 4;
    for (int i = F.bk * NTHREADS + F.tid; i < NE; i += GRID * NTHREADS) {
        const int e = i * 4, l = e / (17 * 6144), n = e % 6144;
        f32x4 s = *(const f32x4*)(a.b_ada + l * 6144 + n);
#pragma unroll
        for (int kc = 0; kc < 4; ++kc) s = s + *(const f32x4*)(modp + (size_t)kc * NL * 17 * 6144 + e);
        *(f32x4*)(mod + e) = s;
    }
}

__device__ __forceinline__ void row_load(const float* p, int lane, f32x4 (&v)[4]) {
#pragma unroll
    for (int j = 0; j < 4; ++j) v[j] = *(const f32x4*)(p + 4 * lane + 256 * j);
}
__device__ __forceinline__ void row_ln(f32x4 (&v)[4], const float* g, const float* b, int lane) {
    float s = 0.f;
#pragma unroll
    for (int j = 0; j < 4; ++j) s += (v[j][0] + v[j][1]) + (v[j][2] + v[j][3]);
    const float mean = wave_sum(s) * (1.0f / D); float q = 0.f;
#pragma unroll
    for (int j = 0; j < 4; ++j) { v[j] = v[j] - mean; q += (v[j][0] * v[j][0] + v[j][1] * v[j][1]) + (v[j][2] * v[j][2] + v[j][3] * v[j][3]); }
    const float rstd = 1.0f / sqrtf(wave_sum(q) * (1.0f / D) + LN_EPS);
#pragma unroll
    for (int j = 0; j < 4; ++j) { const f32x4 gg = *(const f32x4*)(g + 4 * lane + 256 * j), bv = *(const f32x4*)(b + 4 * lane + 256 * j); v[j] = v[j] * rstd * gg + bv; }
}
__device__ __forceinline__ void row_ln_reg(f32x4 (&v)[4], const f32x4 (&g)[4], const f32x4 (&b)[4]) {
    float s = 0.f;
#pragma unroll
    for (int j = 0; j < 4; ++j) s += (v[j][0] + v[j][1]) + (v[j][2] + v[j][3]);
    const float mean = wave_sum(s) * (1.0f / D); float q = 0.f;
#pragma unroll
    for (int j = 0; j < 4; ++j) { v[j] = v[j] - mean; q += (v[j][0] * v[j][0] + v[j][1] * v[j][1]) + (v[j][2] * v[j][2] + v[j][3] * v[j][3]); }
    const float rstd = 1.0f / sqrtf(wave_sum(q) * (1.0f / D) + LN_EPS);
#pragma unroll
    for (int j = 0; j < 4; ++j) v[j] = v[j] * rstd * g[j] + b[j];
}
__device__ __forceinline__ void row_store_mod_bf16(bf16_t* hrow, const f32x4 (&v)[4], const float* sh, const float* sc, int lane) {
#pragma unroll
    for (int j = 0; j < 4; ++j) {
        const f32x4 s1 = *(const f32x4*)(sc + 4 * lane + 256 * j), s0 = *(const f32x4*)(sh + 4 * lane + 256 * j);
        const f32x4 h = v[j] * (s1 + 1.0f) + s0;
        st_bf4(hrow + 4 * lane + 256 * j, h);
    }
}

__device__ __forceinline__ void prologue3(const Ctx& F, KP kp) {
    const Args a = ldargs(kp);
    const float* modp = (const float*)(a.ws + WS_MODP); bf16_t* H = (bf16_t*)(a.ws + WS_H);
    const int gw = F.vcu * NWAVES + F.wave, NGW = GRID * NWAVES;
    for (int r = gw; r < MT; r += NGW) {
        const float* xr = (r < TL) ? (a.x + (size_t)r * D) : (a.ctx + (size_t)(r - TL) * D);
        const int bb = bb_of(r);
        f32x4 v[4]; row_load(xr, F.lane, v);
#pragma unroll
        for (int j = 0; j < 4; ++j) {
            const int c = 4 * F.lane + 256 * j;
            f32x4 sh = *(const f32x4*)(a.b_ada + c), sc = *(const f32x4*)(a.b_ada + 1024 + c);
#pragma unroll
            for (int kc = 0; kc < 4; ++kc) { const float* mp = modp + ((size_t)(kc * NL + 0) * 17 + bb) * 6144; sh = sh + *(const f32x4*)(mp + c); sc = sc + *(const f32x4*)(mp + 1024 + c); }
            st_bf4(H + (size_t)r * D + c, v[j] * (sc + 1.0f) + sh);
        }
    }
}

__device__ __forceinline__ void phase_split(const Ctx& F, KP kp, int l) {
    const Args a = ldargs(kp);
    unsigned char* ws = a.ws;
    const bf16_t* Z = (const bf16_t*)(ws + WS_Z);
    float* rstdq = (float*)(ws + WS_RSTDQ); float* rstdkv = (float*)(ws + WS_RSTDKV);
    bf16_t* Km = (bf16_t*)(ws + WS_KM); bf16_t* Qg = (bf16_t*)(ws + WS_QG); bf16_t* Kg = (bf16_t*)(ws + WS_KG); bf16_t* Vg = (bf16_t*)(ws + WS_VG);
    LAS f32x2* t64 = (LAS f32x2*)(F.lds + 65536); LAS f32x2* t32 = (LAS f32x2*)(F.lds + 65536 + 8192);
    __syncthreads();
    for (int i = F.tid; i < 64 * 16; i += NTHREADS) t64[i] = ((const f32x2*)(ws + WS_TAB64))[i];
    if (F.tid < 64 * 8) t32[F.tid] = ((const f32x2*)(ws + WS_TAB32))[F.tid];
    __syncthreads();
    LAS float* zs = (LAS float*)(F.lds + F.wave * 8192);
    const int lane = F.lane, gw = F.vcu * NWAVES + F.wave, NGW = GRID * NWAVES;
    const float ggq = a.g_gq[l * 64 + lane], ggk = a.g_gk[l * 64 + lane];
    u32x4 zn[3];
#define P2_LOAD(rr) do { const u32x4* zr_ = (const u32x4*)(Z + (size_t)(rr) * ZW); _Pragma("unroll") for (int j = 0; j < 3; ++j) zn[j] = zr_[lane + 64 * j]; } while (0)
    if (gw < MT) P2_LOAD(gw);
    for (int r = gw; r < MT; r += NGW) {
#pragma unroll
        for (int j = 0; j < 3; ++j) {
            const int ch = lane + 64 * j; const u32x4 w = zn[j];
            LAS float* d = zs + ch * 8;
            *(LAS f32x4*)d = (f32x4){bflo(w.x), bfhi(w.x), bflo(w.y), bfhi(w.y)};
            *(LAS f32x4*)(d + 4) = (f32x4){bflo(w.z), bfhi(w.z), bflo(w.w), bfhi(w.w)};
        }
        if (r + NGW < MT) P2_LOAD(r + NGW);
        LDS_WAIT();
        const bool lat = r < TL; const int s = r & 2047, gr = s >> 6, gc = s & 63, kr = krow_of(r);
        float sq = 0.f, sk = 0.f;
#pragma unroll
        for (int i = 0; i < 6; ++i) { const float v = zs[lane + 64 * i]; sq += v * v; }
#pragma unroll
        for (int i = 0; i < 4; ++i) { const float v = zs[384 + lane + 64 * i]; sk += v * v; }
        sq = wave_sum(sq); sk = wave_sum(sk);
        if (lane == 0) { rstdq[r] = 1.0f / sqrtf(sq * (1.0f / 384.0f) + RMS_EPS); rstdkv[r] = 1.0f / sqrtf(sk * (1.0f / 256.0f) + RMS_EPS); }
        {
            const int d = lane & 31; const float v = zs[640 + d]; const float pv = lane_xor<8>(v);
            float o = v;
            if (lat) { const int part = d >> 4, f = d & 7, pos = part ? gc : gr; const f32x2 cs = t32[pos * 8 + f]; o = (d & 8) ? (v * cs.x + pv * cs.y) : (v * cs.x - pv * cs.y); }
            const unsigned short ob = (unsigned short)f2bf(o);
#pragma unroll
            for (int i = 0; i < 4; ++i) { const int h = (lane >> 5) + 2 * i; Km[(size_t)kr * QW + h * 96 + 64 + d] = ob; }
        }
#pragma unroll
        for (int h = 0; h < 8; ++h) {
            const float v = zs[672 + 64 * h + lane]; const float ss = wave_sum(v * v);
            const float y = v * (1.0f / sqrtf(ss * (1.0f / 64.0f) + RMS_EPS)) * ggq; const float py = lane_xor<16>(y);
            float o = y;
            if (lat) { const int part = lane >> 5, f = lane & 15, pos = part ? gc : gr; const f32x2 cs = t64[pos * 16 + f]; o = (lane & 16) ? (y * cs.x + py * cs.y) : (y * cs.x - py * cs.y); }
            Qg[(size_t)r * 512 + 64 * h + lane] = (unsigned short)f2bf(o * QSCALE_G);
        }
#pragma unroll
        for (int h = 0; h < 2; ++h) {
            const float v = zs[1184 + 64 * h + lane]; const float ss = wave_sum(v * v);
            const float y = v * (1.0f / sqrtf(ss * (1.0f / 64.0f) + RMS_EPS)) * ggk; const float py = lane_xor<16>(y);
            float o = y;
            if (lat) { const int part = lane >> 5, f = lane & 15, pos = part ? gc : gr; const f32x2 cs = t64[pos * 16 + f]; o = (lane & 16) ? (y * cs.x + py * cs.y) : (y * cs.x - py * cs.y); }
            Kg[(size_t)kr * 128 + 64 * h + lane] = (unsigned short)f2bf(o);
            Vg[(size_t)kr * 128 + 64 * h + lane] = (unsigned short)f2bf(zs[1312 + 64 * h + lane]);
        }
        LDS_WAIT();
    }
}

typedef float f32x4m __attribute__((ext_vector_type(4)));
template <bool XF32>
__device__ __forceinline__ void phase_ln1_route(const Ctx& F, KP kp, int l, int ntok) {
    const Args a = ldargs(kp);
    unsigned char* ws = a.ws;
    const bf16_t* Yo = (const bf16_t*)(ws + WS_U); float* XC = (float*)(ws + WS_XC); bf16_t* H = (bf16_t*)(ws + WS_H);
    bf16_t* XB = (bf16_t*)(ws + WS_XB); constexpr bool xf32 = XF32;
    const float* mod = (const float*)(ws + WS_MOD) + (size_t)l * 17 * 6144;
    int* toke = (int*)(ws + WS_TOKE); int* tokr = (int*)(ws + WS_TOKR); float* tokw = (float*)(ws + WS_TOKW);
    volatile LAS int* cntl = (volatile LAS int*)(F.lds + MISC_CNT);
    const int lane = F.lane;
    __syncthreads();
    if (F.tid < 32) cntl[F.tid] = 0;
    if (F.tid < 36) ((LAS float*)(F.lds + MISC_LG + 2048))[F.tid] = (F.tid < 4) ? a.b_rg[l * 4 + F.tid] : a.b_re[l * 32 + F.tid - 4];
    const int tpb = ntok / GRID;
    {
        f32x4 nx[4]; u32x2 ny[4]; int i = F.wave;
        f32x4 LG[4], LB[4], GA[4], SH[4], SC[4]; int bbc = -1;
#pragma unroll
        for (int j = 0; j < 4; ++j) { LG[j] = *(const f32x4*)(a.ln1_g + l * D + 4 * lane + 256 * j); LB[j] = *(const f32x4*)(a.ln1_b + l * D + 4 * lane + 256 * j); }
        u32x2 nb[4];
#define P6_LOAD(tt) do { const int t_ = (tt); \
        if (xf32) { const float* xp_ = (t_ < TL) ? (a.x + (size_t)t_ * D) : (a.ctx + (size_t)(t_ - TL) * D); row_load(xp_, lane, nx); } \
        else { _Pragma("unroll") for (int j = 0; j < 4; ++j) nb[j] = *(const u32x2*)(XB + (size_t)t_ * D + 4 * lane + 256 * j); } \
        _Pragma("unroll") for (int j = 0; j < 4; ++j) ny[j] = *(const u32x2*)(Yo + (size_t)t_ * D + 4 * lane + 256 * j); } while (0)
        if (i < tpb) P6_LOAD(F.bk * tpb + i);
        for (; i < tpb; i += NWAVES) {
            const int t = F.bk * tpb + i, bb = bb_of(t);
            if (bb != bbc) {
                bbc = bb;
#pragma unroll
                for (int j = 0; j < 4; ++j) { const int c = 4 * lane + 256 * j; GA[j] = *(const f32x4*)(mod + (size_t)(bb * 6 + 2) * D + c);
                    SH[j] = *(const f32x4*)(mod + (size_t)(bb * 6 + 3) * D + c); SC[j] = *(const f32x4*)(mod + (size_t)(bb * 6 + 4) * D + c); }
            }
            f32x4 v[4];
#pragma unroll
            for (int j = 0; j < 4; ++j) { const f32x4 y = {bflo(ny[j].x), bfhi(ny[j].x), bflo(ny[j].y), bfhi(ny[j].y)};
                const f32x4 xv = xf32 ? nx[j] : (f32x4){bflo(nb[j].x), bfhi(nb[j].x), bflo(nb[j].y), bfhi(nb[j].y)}; v[j] = xv * ALPHA + GA[j] * y; }
            if (i + NWAVES < tpb) P6_LOAD(t + NWAVES);
            row_ln_reg(v, LG, LB);
#pragma unroll
            for (int j = 0; j < 4; ++j) st_bf4(XB + (size_t)t * D + 4 * lane + 256 * j, v[j]);
#pragma unroll
            for (int j = 0; j < 4; ++j) {
                const f32x4 h = v[j] * (SC[j] + 1.0f) + SH[j];
                st_bf4(H + (size_t)t * D + 4 * lane + 256 * j, h);
            }
        }
    }
#undef P6_LOAD
    asm volatile("s_waitcnt vmcnt(0)" ::: "memory");
    __syncthreads();
    {
        const bf16_t* wrh = (const bf16_t*)(ws + WS_WR) + (size_t)(l * 2) * 48 * D; const bf16_t* wrl = wrh + (size_t)48 * D;
        LAS float* lg = (LAS float*)(F.lds + F.wave * 4096);
        const LAS float* bias = (const LAS float*)(F.lds + MISC_LG + 2048);
        const int fr = lane & 15, fq = lane >> 4;
        for (int g = F.wave; g < tpb / 16; g += NWAVES) {
            const int t0 = F.bk * tpb + g * 16;
            const bf16_t* hh = H + (size_t)(t0 + fr) * D + 8 * fq;
            f32x4m acc0 = {0.f, 0.f, 0.f, 0.f}, acc1 = acc0, acc2 = acc0;
#pragma unroll 2
            for (int ks = 0; ks < 32; ++ks) {
                const bf16x8 bh = *(const bf16x8*)(hh + 32 * ks);
                const bf16_t* wp = wrh + (size_t)fr * D + 32 * ks + 8 * fq; const bf16_t* wq = wrl + (size_t)fr * D + 32 * ks + 8 * fq;
                const bf16x8 a0h = *(const bf16x8*)(wp), a1h = *(const bf16x8*)(wp + 16 * D), a2h = *(const bf16x8*)(wp + 32 * D);
                const bf16x8 a0l = *(const bf16x8*)(wq), a1l = *(const bf16x8*)(wq + 16 * D), a2l = *(const bf16x8*)(wq + 32 * D);
                acc0 = __builtin_amdgcn_mfma_f32_16x16x32_bf16(a0h, bh, acc0, 0, 0, 0); acc1 = __builtin_amdgcn_mfma_f32_16x16x32_bf16(a1h, bh, acc1, 0, 0, 0); acc2 = __builtin_amdgcn_mfma_f32_16x16x32_bf16(a2h, bh, acc2, 0, 0, 0);
                acc0 = __builtin_amdgcn_mfma_f32_16x16x32_bf16(a0l, bh, acc0, 0, 0, 0); acc1 = __builtin_amdgcn_mfma_f32_16x16x32_bf16(a1l, bh, acc1, 0, 0, 0); acc2 = __builtin_amdgcn_mfma_f32_16x16x32_bf16(a2l, bh, acc2, 0, 0, 0);
            }
#pragma unroll
            for (int r = 0; r < 4; ++r) { lg[fr * 48 + 4 * fq + r] = acc0[r]; lg[fr * 48 + 16 + 4 * fq + r] = acc1[r]; lg[fr * 48 + 32 + 4 * fq + r] = acc2[r]; }
            LDS_WAIT();
            if (lane < 16) {
                const int t = t0 + lane; const LAS float* q = lg + lane * 48;
                float l4[4];
#pragma unroll
                for (int o = 0; o < 4; ++o) l4[o] = q[o] + bias[o];
                int gs = 0; float gm = l4[0];
#pragma unroll
                for (int o = 1; o < 4; ++o) if (l4[o] > gm) { gm = l4[o]; gs = o; }
                float den = 0.f;
#pragma unroll
                for (int o = 0; o < 4; ++o) den += expf(l4[o] - gm);
                const float pstar = 1.0f / den;
                float le[8];
#pragma unroll
                for (int o = 0; o < 8; ++o) le[o] = q[4 + gs * 8 + o] + bias[4 + gs * 8 + o];
                int i1 = 0; float v1 = le[0];
#pragma unroll
                for (int o = 1; o < 8; ++o) if (le[o] > v1) { v1 = le[o]; i1 = o; }
                int i2 = -1; float v2 = -3.0e38f;
#pragma unroll
                for (int o = 0; o < 8; ++o) if (o != i1 && le[o] > v2) { v2 = le[o]; i2 = o; }
                const float ex = expf(v2 - v1), w1 = pstar / (1.0f + ex), w2 = pstar * ex / (1.0f + ex);
                const int e1 = gs * 8 + i1, e2 = gs * 8 + i2;
                const int r1 = __hip_atomic_fetch_add((LAS int*)(F.lds + MISC_CNT) + e1, 1, __ATOMIC_RELAXED, __HIP_MEMORY_SCOPE_WORKGROUP);
                const int r2 = __hip_atomic_fetch_add((LAS int*)(F.lds + MISC_CNT) + e2, 1, __ATOMIC_RELAXED, __HIP_MEMORY_SCOPE_WORKGROUP);
                toke[2 * t] = e1; toke[2 * t + 1] = e2; tokr[2 * t] = r1; tokr[2 * t + 1] = r2; tokw[2 * t] = w1; tokw[2 * t + 1] = w2;
            }
            LDS_WAIT();
        }
    }
    __syncthreads();
    if (F.tid < 32) ((int*)(ws + WS_BLKCNT))[((size_t)l * 256 + F.bk) * 32 + F.tid] = cntl[F.tid];
}

__device__ __forceinline__ void moe_tables(const Ctx& F, KP kp, int l, bool publish) {
    const Args a = ldargs(kp);
    const int* blkcnt = (const int*)(a.ws + WS_BLKCNT) + (size_t)l * 256 * 32;
    volatile LAS int* pa = (volatile LAS int*)(F.lds + MISC_PA); volatile LAS int* pb = (volatile LAS int*)(F.lds + MISC_PB);
    volatile LAS int* tot = (volatile LAS int*)(F.lds + MISC_TOT); volatile LAS int* base = (volatile LAS int*)(F.lds + MISC_BASE); volatile LAS int* poff = (volatile LAS int*)(F.lds + MISC_POFF);
    __syncthreads();
    {
        const int e = F.tid & 31, part = F.tid >> 5; int sa = 0, sb = 0;
        for (int j = 0; j < 16; ++j) { const int b2 = part * 16 + j; const int c = blkcnt[b2 * 32 + e]; sa += c; sb += (b2 < F.bk) ? c : 0; }
        pa[part * 32 + e] = sa; pb[part * 32 + e] = sb;
    }
    __syncthreads();
    if (F.tid < 32) { int sa = 0, sb = 0; for (int p = 0; p < 16; ++p) { sa += pa[p * 32 + F.tid]; sb += pb[p * 32 + F.tid]; } tot[F.tid] = sa; base[F.tid] = sb; }
    __syncthreads();
    if (F.tid == 0) { int o = 0; for (int e = 0; e < 32; ++e) { poff[e] = o; o += (tot[e] + 255) & ~255; } poff[32] = o; }
    __syncthreads();
    if (publish && F.bk == 0 && F.tid < 33) ((int*)(a.ws + WS_MOETAB))[l * 128 + F.tid] = poff[F.tid];
}

__device__ __forceinline__ void phase_dispatch(const Ctx& F, KP kp, int l, int ntok) {
    const Args a = ldargs(kp);
    unsigned char* ws = a.ws;
    if (l > 0) conv_experts(F, a, l, -1);
    moe_tables(F, kp, l, true);
    volatile LAS int* base = (volatile LAS int*)(F.lds + MISC_BASE); volatile LAS int* poff = (volatile LAS int*)(F.lds + MISC_POFF); volatile LAS int* tot = (volatile LAS int*)(F.lds + MISC_TOT);
    const int* toke = (const int*)(ws + WS_TOKE); const int* tokr = (const int*)(ws + WS_TOKR); int* tokp = (int*)(ws + WS_TOKP); int* postok = (int*)(ws + WS_POSTOK);
    const int tpb = ntok / GRID;
    if (F.tid < tpb) {
        const int t = F.bk * tpb + F.tid;
        const int2 e = *(const int2*)(toke + 2 * t), r = *(const int2*)(tokr + 2 * t);
        const int p1 = poff[e.x] + base[e.x] + r.x, p2 = poff[e.y] + base[e.y] + r.y;
        *(int2*)(tokp + 2 * t) = (int2){p1, p2};
        postok[p1] = t; postok[p2] = t;
    }
    { const int idx = F.bk * NTHREADS + F.tid;
      if (idx < poff[32]) { int e = 0;
#pragma unroll
          for (int j = 1; j < 32; ++j) e += (poff[j] <= idx) ? 1 : 0;
          if (idx >= poff[e] + tot[e]) postok[idx] = 0; } }
}

__device__ __forceinline__ void phase_ln2(const Ctx& F, KP kp, int l, int ntok, bool dry = false) {
    const Args a = ldargs(kp);
    unsigned char* ws = a.ws;
    const bf16_t* Ys = (const bf16_t*)(ws + WS_XS); float* XC = (float*)(ws + WS_XC); bf16_t* H = (bf16_t*)(ws + WS_H);
    const float* mod = (const float*)(ws + WS_MOD) + (size_t)l * 17 * 6144;
    const float* modn = (const float*)(ws + WS_MOD) + (size_t)(l + 1 < NL ? l + 1 : l) * 17 * 6144;
    const int* tokp = (const int*)(ws + WS_TOKP); const float* tokw = (const float*)(ws + WS_TOKW);
    const int gw = F.vcu * NWAVES + F.wave, NGW = GRID * NWAVES, lane = F.lane;
    const int per = ntok / NGW, t0 = gw * per, t1 = t0 + per;
    f32x4 LG[4], LB[4], GF[4], SH[4], SC[4];
#pragma unroll
    for (int j = 0; j < 4; ++j) { LG[j] = *(const f32x4*)(a.ln2_g + l * D + 4 * lane + 256 * j); LB[j] = *(const f32x4*)(a.ln2_b + l * D + 4 * lane + 256 * j); }
    int bbc = -1;
    int2 pn = {0, 0}; float2 wn = {0.f, 0.f};
    u32x2 xn[4], yan[4], ybn[4]; bf16_t* XB = (bf16_t*)(ws + WS_XB);
#define P10_REC(tt) do { pn = *(const int2*)(tokp + 2 * (tt)); wn = *(const float2*)(tokw + 2 * (tt)); } while (0)
#define P10_ROWS(tt, p_) do { const int t_ = (tt); _Pragma("unroll") for (int j = 0; j < 4; ++j) xn[j] = *(const u32x2*)(XB + (size_t)t_ * D + 4 * lane + 256 * j); \
        _Pragma("unroll") for (int j = 0; j < 4; ++j) { yan[j] = *(const u32x2*)(Ys + (size_t)(p_).x * D + 4 * lane + 256 * j); ybn[j] = *(const u32x2*)(Ys + (size_t)(p_).y * D + 4 * lane + 256 * j); } } while (0)
    float2 wc = {0.f, 0.f};
    P10_REC(t0); wc = wn; P10_ROWS(t0, pn); if (t0 + 1 < t1) P10_REC(t0 + 1);
    for (int t = t0; t < t1; ++t) {
        const int bb = bb_of(t);
        if (bb != bbc) {
            bbc = bb;
#pragma unroll
            for (int j = 0; j < 4; ++j) { const int c = 4 * lane + 256 * j; GF[j] = *(const f32x4*)(mod + (size_t)(bb * 6 + 5) * D + c);
                SH[j] = *(const f32x4*)(modn + (size_t)(bb * 6 + 0) * D + c); SC[j] = *(const f32x4*)(modn + (size_t)(bb * 6 + 1) * D + c); }
        }
        f32x4 v[4]; u32x2 ya[4], yb[4];
#pragma unroll
        for (int j = 0; j < 4; ++j) { v[j] = (f32x4){bflo(xn[j].x), bfhi(xn[j].x), bflo(xn[j].y), bfhi(xn[j].y)}; ya[j] = yan[j]; yb[j] = ybn[j]; }
        const float w1 = wc.x, w2 = wc.y;
        if (t + 1 < t1) { wc = wn; P10_ROWS(t + 1, pn); if (t + 2 < t1) P10_REC(t + 2); }
#pragma unroll
        for (int j = 0; j < 4; ++j) {
            const f32x4 y = (f32x4){bflo(ya[j].x), bfhi(ya[j].x), bflo(ya[j].y), bfhi(ya[j].y)} * w1 + (f32x4){bflo(yb[j].x), bfhi(yb[j].x), bflo(yb[j].y), bfhi(yb[j].y)} * w2;
            v[j] = v[j] * ALPHA + GF[j] * y;
        }
        row_ln_reg(v, LG, LB);
        if (l + 1 < NL) {
#pragma unroll
            for (int j = 0; j < 4; ++j) st_bf4(XB + (size_t)t * D + 4 * lane + 256 * j, v[j]);
        } else {
#pragma unroll
            for (int j = 0; j < 4; ++j) *(f32x4*)(a.out + (size_t)t * D + 4 * lane + 256 * j) = v[j];
        }
        if (l + 1 < NL) { bf16_t* hrow = H + (size_t)t * D;
#pragma unroll
            for (int j = 0; j < 4; ++j) st_bf4(hrow + 4 * lane + 256 * j, v[j] * (SC[j] + 1.0f) + SH[j]); }
    }
#undef P10_REC
#undef P10_ROWS
}

template <int QD>
__device__ __forceinline__ void attn_naive_task(const bf16_t* qp, const bf16_t* kp, int kstride, const bf16_t* vp, int vstride, int nkeys, bf16_t* op) {
    u32x4 qv[QD / 8];
#pragma unroll
    for (int i = 0; i < QD / 8; ++i) qv[i] = *(const u32x4*)(qp + 8 * i);
#pragma unroll 1
    for (int half = 0; half < 2; ++half) {
        float o[32];
#pragma unroll
        for (int i = 0; i < 32; ++i) o[i] = 0.f;
        float m = -1.0e30f, lsum = 0.f;
#pragma unroll 1
        for (int j = 0; j < nkeys; ++j) {
            const u32x4* kr = (const u32x4*)(kp + (size_t)j * kstride);
            float s = 0.f;
#pragma unroll
            for (int i = 0; i < QD / 8; ++i) s = dot8(qv[i], kr[i], s);
            if (s > m) { const float al = __builtin_amdgcn_exp2f(m - s); lsum *= al;
#pragma unroll
                for (int i = 0; i < 32; ++i) o[i] *= al;
                m = s; }
            const float p = __builtin_amdgcn_exp2f(s - m); lsum += p;
            const u32x4* vr = (const u32x4*)(vp + (size_t)j * vstride + 32 * half);
#pragma unroll
            for (int i = 0; i < 4; ++i) { const u32x4 w = vr[i];
                o[8 * i + 0] += p * bflo(w.x); o[8 * i + 1] += p * bfhi(w.x); o[8 * i + 2] += p * bflo(w.y); o[8 * i + 3] += p * bfhi(w.y); o[8 * i + 4] += p * bflo(w.z); o[8 * i + 5] += p * bfhi(w.z); o[8 * i + 6] += p * bflo(w.w); o[8 * i + 7] += p * bfhi(w.w); }
        }
        const float rl = 1.0f / lsum;
#pragma unroll
        for (int i = 0; i < 4; ++i) { u32x4 w; w.x = pk2(o[8 * i] * rl, o[8 * i + 1] * rl); w.y = pk2(o[8 * i + 2] * rl, o[8 * i + 3] * rl); w.z = pk2(o[8 * i + 4] * rl, o[8 * i + 5] * rl); w.w = pk2(o[8 * i + 6] * rl, o[8 * i + 7] * rl); *(u32x4*)(op + 32 * half + 8 * i) = w; }
    }
}
__device__ __forceinline__ void phase_attn_naive(const Ctx& F, KP kp, bool last) {
    const Args a = ldargs(kp);
    unsigned char* ws = a.ws;
    const bf16_t* Qm = (const bf16_t*)(ws + WS_QM); const bf16_t* Km = (const bf16_t*)(ws + WS_KM); const bf16_t* Vm = (const bf16_t*)(ws + WS_VM);
    const bf16_t* Qg = (const bf16_t*)(ws + WS_QG); const bf16_t* Kg = (const bf16_t*)(ws + WS_KG); const bf16_t* Vg = (const bf16_t*)(ws + WS_VG);
    bf16_t* O = (bf16_t*)(ws + WS_O);
    const int gw = F.vcu * NWAVES + F.wave, NGW = GRID * NWAVES;
    const int ntask = 8192 + (last ? 0 : 1024);
    for (int T = gw; T < ntask; T += NGW) {
        int b, h16, r, nkeys;
        if (T < 8192) { const int qw = T & 31; h16 = (T >> 5) & 15; b = T >> 9; r = b * SEQ + 64 * qw + F.lane; nkeys = KPB; }
        else { const int T2 = T - 8192, qw = T2 & 3; h16 = (T2 >> 2) & 15; b = T2 >> 6; r = TL + b * CTX + 64 * qw + F.lane; nkeys = CTX; }
        bf16_t* op = O + (size_t)r * D + h16 * 64;
        if (h16 < 8) attn_naive_task<96>(Qm + (size_t)r * QW + h16 * 96, Km + (size_t)b * KPB * QW + h16 * 96, QW, Vm + (size_t)b * KPB * 512 + h16 * 64, 512, nkeys, op);
        else { const int hh = h16 - 8, kvh = hh >> 2; attn_naive_task<64>(Qg + (size_t)r * 512 + hh * 64, Kg + (size_t)b * KPB * 128 + kvh * 64, 128, Vg + (size_t)b * KPB * 128 + kvh * 64, 128, nkeys, op); }
    }
}

typedef float f32x16 __attribute__((ext_vector_type(16)));
typedef short s16x4 __attribute__((ext_vector_type(4)));
__device__ __forceinline__ s16x4 vtr(const LAS unsigned char* p) { return __builtin_bit_cast(s16x4, __builtin_amdgcn_ds_read_tr16_b64_v4i16((LAS s16x4*)p)); }
__device__ __forceinline__ unsigned cvtpk(float lo, float hi) { typedef __bf16 bf2 __attribute__((ext_vector_type(2))); f32x2 v = {lo, hi}; bf2 b = __builtin_convertvector(v, bf2); return __builtin_bit_cast(unsigned, b); }
constexpr float ATT_THR = 6.0f;
constexpr int ATT_KSLOT = 12288, ATT_VSLOT = 8192, ATT_NKS = 3, ATT_NVS = 4, ATT_V0 = ATT_NKS * ATT_KSLOT;
__device__ __forceinline__ void att_glds16(const void* gsrc, unsigned lds_dst) { unsigned keep;
    asm volatile("s_mov_b32 %0, m0\n\ts_mov_b32 m0, %2\n\ts_nop 0\n\tglobal_load_lds_dwordx4 %1, off\n\ts_mov_b32 m0, %0" : "=&s"(keep) : "v"(gsrc), "s"(lds_dst) : "memory"); }
#define ATT_WAITBAR(N) asm volatile("s_waitcnt vmcnt(" #N ") lgkmcnt(0)\n\ts_barrier" ::: "memory")
template <int QD>
__device__ __forceinline__ void attn_unit(LAS unsigned char* lds, int tid, const bf16_t* Kb, int kstride, const bf16_t* Vb, int vstride, int ntiles, const bf16_t* qrow, bf16_t* orow) {
    constexpr int NC = QD / 8, NS = QD / 16;
    const int lane = tid & 63, r32 = lane & 31, hi = lane >> 5;
    const int w = __builtin_amdgcn_readfirstlane(tid >> 6);
    const bool three = (NC == 12) && (w < 4);
    const int vp = (NC == 12) ? (w < 4 ? w + 4 : w - 4) : w;
    const bf16_t* ksrcA = Kb + (size_t)lane * kstride + w * 8;
    const bf16_t* ksrcB = Kb + (size_t)lane * kstride + (w + 8) * 8;
    const bf16_t* vsrc = Vb + (size_t)(16 * (vp & 3) + (lane >> 2)) * vstride + (vp >> 2) * 32 + (lane & 3) * 8;
    const size_t kstep = (size_t)64 * kstride, vstep = (size_t)64 * vstride;
    const unsigned lds0 = (unsigned)(size_t)lds;
#define ATT_DMA(t_, ks_, vs_) do { \
        att_glds16(ksrcA + (size_t)(t_) * kstep, (unsigned)__builtin_amdgcn_readfirstlane((int)(lds0 + (ks_) * ATT_KSLOT + w * 1024))); \
        if (three) att_glds16(ksrcB + (size_t)(t_) * kstep, (unsigned)__builtin_amdgcn_readfirstlane((int)(lds0 + (ks_) * ATT_KSLOT + (w + 8) * 1024))); \
        att_glds16(vsrc + (size_t)(t_) * vstep, (unsigned)__builtin_amdgcn_readfirstlane((int)(lds0 + ATT_V0 + (vs_) * ATT_VSLOT + vp * 1024))); } while (0)
    ATT_DMA(0, 0, 0);
    if (ntiles > 1) ATT_DMA(1, 1, 1);
    bf16x8 qr[NS];
#pragma unroll
    for (int s = 0; s < NS; ++s) qr[s] = *(const bf16x8*)(qrow + 16 * s + 8 * hi);
    f32x16 o0, o1, negm, p0, p1;
#pragma unroll
    for (int r = 0; r < 16; ++r) { o0[r] = 0.f; o1[r] = 0.f; negm[r] = 0.f; p0[r] = 0.f; p1[r] = 0.f; }
    float lsum = 0.f;
    const int kread = hi * 1024 + r32 * 16;
    const int vread = ATT_V0 + ((lane >> 4) & 1) * 32 + (lane & 3) * 8 + (4 * hi + ((lane & 15) >> 2)) * 64;
#define ATT_QK(ks_) do { const LAS unsigned char* kb_ = lds + (ks_) * ATT_KSLOT + kread; \
        _Pragma("unroll") for (int s = 0; s < NS; ++s) { \
            const bf16x8 a0 = *(const LAS bf16x8*)(kb_ + s * 2048), a1 = *(const LAS bf16x8*)(kb_ + s * 2048 + 512); \
            if (s == 0) { p0 = __builtin_amdgcn_mfma_f32_32x32x16_bf16(a0, qr[0], negm, 0, 0, 0); p1 = __builtin_amdgcn_mfma_f32_32x32x16_bf16(a1, qr[0], negm, 0, 0, 0); } \
            else { p0 = __builtin_amdgcn_mfma_f32_32x32x16_bf16(a0, qr[s], p0, 0, 0, 0); p1 = __builtin_amdgcn_mfma_f32_32x32x16_bf16(a1, qr[s], p1, 0, 0, 0); } } } while (0)
#define ATT_SOFT_PV(first_, vs_) do { \
        float mx = fmaxf(fmaxf(p0[0], p1[0]), p0[1]); \
        _Pragma("unroll") for (int r = 1; r < 16; ++r) mx = (r == 1) ? fmaxf(mx, p1[1]) : fmaxf(fmaxf(mx, p0[r]), p1[r]); \
        { auto rr = __builtin_amdgcn_permlane32_swap(__float_as_uint(mx), __float_as_uint(mx), false, false); mx = fmaxf(__uint_as_float(rr[0]), __uint_as_float(rr[1])); } \
        if ((first_) || __any(mx > ATT_THR)) { \
            const float dl = (first_) ? mx : fmaxf(mx, 0.f); \
            _Pragma("unroll") for (int r = 0; r < 16; ++r) { p0[r] -= dl; p1[r] -= dl; negm[r] -= dl; } \
            if (!(first_)) { const float f = __builtin_amdgcn_exp2f(-dl); lsum *= f; \
                _Pragma("unroll") for (int r = 0; r < 16; ++r) { o0[r] *= f; o1[r] *= f; } } \
        } \
        float rs = 0.f; \
        _Pragma("unroll") for (int r = 0; r < 16; ++r) { p0[r] = __builtin_amdgcn_exp2f(p0[r]); p1[r] = __builtin_amdgcn_exp2f(p1[r]); rs += p0[r] + p1[r]; } \
        lsum += rs; \
        u32x4 w0, w1, w2, w3; \
        w0.x = cvtpk(p0[0], p0[1]); w0.y = cvtpk(p0[2], p0[3]); w0.z = cvtpk(p0[4], p0[5]); w0.w = cvtpk(p0[6], p0[7]); \
        w1.x = cvtpk(p0[8], p0[9]); w1.y = cvtpk(p0[10], p0[11]); w1.z = cvtpk(p0[12], p0[13]); w1.w = cvtpk(p0[14], p0[15]); \
        w2.x = cvtpk(p1[0], p1[1]); w2.y = cvtpk(p1[2], p1[3]); w2.z = cvtpk(p1[4], p1[5]); w2.w = cvtpk(p1[6], p1[7]); \
        w3.x = cvtpk(p1[8], p1[9]); w3.y = cvtpk(p1[10], p1[11]); w3.z = cvtpk(p1[12], p1[13]); w3.w = cvtpk(p1[14], p1[15]); \
        const bf16x8 pa0 = __builtin_bit_cast(bf16x8, w0), pa1 = __builtin_bit_cast(bf16x8, w1), pa2 = __builtin_bit_cast(bf16x8, w2), pa3 = __builtin_bit_cast(bf16x8, w3); \
        const LAS unsigned char* vb_ = lds + (vs_) * ATT_VSLOT + vread; \
        o0 = __builtin_amdgcn_mfma_f32_32x32x16_bf16(ATT_VF(0, 0), pa0, o0, 0, 0, 0); \
        o1 = __builtin_amdgcn_mfma_f32_32x32x16_bf16(ATT_VF(1, 0), pa0, o1, 0, 0, 0); \
        o0 = __builtin_amdgcn_mfma_f32_32x32x16_bf16(ATT_VF(0, 1), pa1, o0, 0, 0, 0); \
        o1 = __builtin_amdgcn_mfma_f32_32x32x16_bf16(ATT_VF(1, 1), pa1, o1, 0, 0, 0); \
        o0 = __builtin_amdgcn_mfma_f32_32x32x16_bf16(ATT_VF(0, 2), pa2, o0, 0, 0, 0); \
        o1 = __builtin_amdgcn_mfma_f32_32x32x16_bf16(ATT_VF(1, 2), pa2, o1, 0, 0, 0); \
        o0 = __builtin_amdgcn_mfma_f32_32x32x16_bf16(ATT_VF(0, 3), pa3, o0, 0, 0, 0); \
        o1 = __builtin_amdgcn_mfma_f32_32x32x16_bf16(ATT_VF(1, 3), pa3, o1, 0, 0, 0); } while (0)
#define ATT_VF(d0, ks) ({ const s16x4 lo_ = vtr(vb_ + (d0) * 4096 + (ks) * 1024), hi_ = vtr(vb_ + (d0) * 4096 + (ks) * 1024 + 512); (bf16x8){lo_[0], lo_[1], lo_[2], lo_[3], hi_[0], hi_[1], hi_[2], hi_[3]}; })
#define ATT_ENDSTEP() do { if (issue) { if (three) ATT_WAITBAR(3); else ATT_WAITBAR(2); } else ATT_WAITBAR(0); \
        ks = (ks == ATT_NKS - 1) ? 0 : ks + 1; vs = (vs + 1) & (ATT_NVS - 1); } while (0)
    if (ntiles > 1) { if (three) ATT_WAITBAR(3); else ATT_WAITBAR(2); } else ATT_WAITBAR(0);
    int ks = 0, vs = 0;
    if (w < 4) {
        for (int t = 0; t < ntiles; ++t) {
            const bool issue = (t + 2 < ntiles);
            if (issue) ATT_DMA(t + 2, (ks >= 1) ? ks - 1 : ATT_NKS - 1, (vs + 2) & (ATT_NVS - 1));
            ATT_QK(ks);
            ATT_SOFT_PV(t == 0, vs);
            ATT_ENDSTEP();
        }
    } else {
        for (int t = 0; t < ntiles; ++t) {
            const bool issue = (t + 2 < ntiles);
            if (issue) ATT_DMA(t + 2, (ks >= 1) ? ks - 1 : ATT_NKS - 1, (vs + 2) & (ATT_NVS - 1));
            if (t > 0) ATT_SOFT_PV(t == 1, (vs + ATT_NVS - 1) & (ATT_NVS - 1));
            ATT_QK(ks);
            ATT_ENDSTEP();
        }
        ATT_SOFT_PV(ntiles == 1, (vs + ATT_NVS - 1) & (ATT_NVS - 1));
    }
#undef ATT_DMA
#undef ATT_QK
#undef ATT_SOFT_PV
#undef ATT_VF
#undef ATT_ENDSTEP
    { auto rr = __builtin_amdgcn_permlane32_swap(__float_as_uint(lsum), __float_as_uint(lsum), false, false); lsum = __uint_as_float(rr[0]) + __uint_as_float(rr[1]); }
    const float rl = 1.0f / lsum;
#pragma unroll
    for (int g = 0; g < 4; ++g) {
        u32x2 a, b2;
        a.x = cvtpk(o0[4 * g] * rl, o0[4 * g + 1] * rl); a.y = cvtpk(o0[4 * g + 2] * rl, o0[4 * g + 3] * rl);
        b2.x = cvtpk(o1[4 * g] * rl, o1[4 * g + 1] * rl); b2.y = cvtpk(o1[4 * g + 2] * rl, o1[4 * g + 3] * rl);
        *(u32x2*)(orow + 8 * g + 4 * hi) = a; *(u32x2*)(orow + 32 + 8 * g + 4 * hi) = b2;
    }
    asm volatile("s_waitcnt lgkmcnt(0)\n\ts_barrier" ::: "memory");
}
__device__ __forceinline__ void phase_attn(const Ctx& F, KP kp, bool last) {
    const Args a = ldargs(kp);
    unsigned char* ws = a.ws;
    const bf16_t* Qm = (const bf16_t*)(ws + WS_QM); const bf16_t* Km = (const bf16_t*)(ws + WS_KM); const bf16_t* Vm = (const bf16_t*)(ws + WS_VM);
    const bf16_t* Qg = (const bf16_t*)(ws + WS_QG); const bf16_t* Kg = (const bf16_t*)(ws + WS_KG); const bf16_t* Vg = (const bf16_t*)(ws + WS_VG);
    bf16_t* O = (bf16_t*)(ws + WS_O);
    const int xcd = F.vcu >> 5, cix = F.vcu & 31, r32 = F.lane & 31, w = F.wave;
    const int nun = last ? 8 : 9;
    for (int i = 0; i < nun; ++i) {
        if (i < 8 && (i & 1) == 0) {
            const int pair = xcd * 16 + (i >> 1) * 4 + (cix >> 3), b = pair >> 3, h = pair & 7, qb = cix & 7;
            const int row = b * SEQ + qb * 256 + w * 32 + r32;
            attn_unit<96>(F.lds, F.tid, Km + (size_t)b * KPB * QW + h * 96, QW, Vm + (size_t)b * KPB * 512 + h * 64, 512, KPB / 64, Qm + (size_t)row * QW + h * 96, O + (size_t)row * D + h * 64);
        } else if (i < 8) {
            const int pair = xcd * 4 + (i >> 1), b = pair >> 1, kvh = pair & 1, hh = kvh * 4 + (w >> 1);
            const int row = b * SEQ + cix * 64 + (w & 1) * 32 + r32;
            attn_unit<64>(F.lds, F.tid, Kg + (size_t)b * KPB * 128 + kvh * 64, 128, Vg + (size_t)b * KPB * 128 + kvh * 64, 128, KPB / 64, Qg + (size_t)row * 512 + hh * 64, O + (size_t)row * D + 512 + hh * 64);
        } else if (F.vcu < 128) {
            const int b = F.vcu >> 3, h = F.vcu & 7, row = TL + b * CTX + w * 32 + r32;
            attn_unit<96>(F.lds, F.tid, Km + (size_t)b * KPB * QW + h * 96, QW, Vm + (size_t)b * KPB * 512 + h * 64, 512, CTX / 64, Qm + (size_t)row * QW + h * 96, O + (size_t)row * D + h * 64);
        } else {
            const int idx = F.vcu - 128, b = idx >> 3, kvh = (idx >> 2) & 1, qb = idx & 3, hh = kvh * 4 + (w >> 1);
            const int row = TL + b * CTX + qb * 64 + (w & 1) * 32 + r32;
            attn_unit<64>(F.lds, F.tid, Kg + (size_t)b * KPB * 128 + kvh * 64, 128, Vg + (size_t)b * KPB * 128 + kvh * 64, 128, CTX / 64, Qg + (size_t)row * 512 + hh * 64, O + (size_t)row * D + 512 + hh * 64);
        }
    }
}
__global__ void __launch_bounds__(NTHREADS, 2) fwd_kernel(Args a_unused) {
    extern __shared__ __attribute__((aligned(16))) unsigned char lds_raw[];
    const KP kp = (KP)__builtin_amdgcn_kernarg_segment_ptr();
    Ctx F;
    F.lds = (LAS unsigned char*)lds_raw;
    F.tid = threadIdx.x; F.lane = F.tid & 63; F.wave = __builtin_amdgcn_readfirstlane(F.tid >> 6);
    F.bk = blockIdx.x; F.vcu = (F.bk & 7) * (GRID / 8) + (F.bk >> 3);
    if (F.tid < 4) ((volatile LAS unsigned*)(F.lds + MISC_BAR))[F.tid] = 0u;
    __syncthreads();
    { const Args a = ldargs(kp); (void)xcd_barrier_post((unsigned*)(a.ws + WS_CTL), (volatile LAS unsigned*)(F.lds + MISC_BAR), F.tid == 0); }
#define FRESH() do { int ln_; asm volatile("v_mbcnt_lo_u32_b32 %0, -1, 0\n\tv_mbcnt_hi_u32_b32 %0, -1, %0" : "=v"(ln_)); F.lane = ln_; F.tid = F.wave * 64 + ln_; F.bk = blockIdx.x; F.vcu = (F.bk & 7) * (GRID / 8) + (F.bk >> 3); } while (0)
#define GRID_BAR() do { XcdBarrier b_; { const Args a_ = ldargs(kp); b_.bar = (unsigned*)(a_.ws + WS_CTL); } b_.x = xb_xcc_id(); b_.st = (volatile LAS unsigned*)(F.lds + MISC_BAR); xcd_barrier(b_, F.tid == 0); } while (0)

    for (int rep_ = 0; rep_ < REP_PRO; ++rep_) prologue1(F, kp);
    GRID_BAR(); FRESH();
    prologue2(F, kp);
    prologue3(F, kp);
    GRID_BAR(); FRESH();

    for (int l = 0; l < NL; ++l) {
        const bool last = (l == NL - 1);
        const int ntok = last ? TL : MT;
        { const Args a = ldargs(kp); unsigned char* ws = a.ws;
          Gemm g{(const bf16_t*)(ws + WS_H), D, (const bf16_t*)(ws + WS_WIN) + (size_t)l * ZW * D, D}; StaticOrder S; S.init(MT, ZW, GRID, F.bk); EpiZ E{(bf16_t*)(ws + WS_Z)}; gemm_phase<0>(F, g, S, E); }
        if (F.bk >= (MT / 256) * (ZW / 256) - 3 * GRID) conv_filler(F, kp, l, FILL_P1);
        GRID_BAR(); FRESH();
        for (int rep_ = 0; rep_ < REP_P2; ++rep_) phase_split(F, kp, l);
        GRID_BAR(); FRESH();
        { const Args a = ldargs(kp); unsigned char* ws = a.ws;
          Gemm g{(const bf16_t*)(ws + WS_Z), ZW, (const bf16_t*)(ws + WS_WQ) + (size_t)l * QW * 384, 384}; StaticOrder S; S.init(MT, QW, GRID, F.bk);
          EpiQ E{(bf16_t*)(ws + WS_QM), (const float*)(ws + WS_RSTDQ), (const f32x2*)(ws + WS_TAB32)}; gemm_phase<1>(F, g, S, E); }
        FRESH();
        { const Args a = ldargs(kp); unsigned char* ws = a.ws;
          Gemm g{(const bf16_t*)(ws + WS_Z) + 384, ZW, (const bf16_t*)(ws + WS_WKV) + (size_t)l * KVW * 256, 256}; StaticOrder S; S.init(MT, KVW, GRID, (F.bk + 80) & 255);
          EpiKV E{(bf16_t*)(ws + WS_KM), (bf16_t*)(ws + WS_VM), (const float*)(ws + WS_RSTDKV)}; gemm_phase<2>(F, g, S, E); }
        GRID_BAR(); FRESH();
#if USE_MFMA_ATTN
        for (int rep_ = 0; rep_ < REP_ATTN; ++rep_) phase_attn(F, kp, last);
#else
        phase_attn_naive(F, kp, last);
#endif
        GRID_BAR(); FRESH();
        { const Args a = ldargs(kp); unsigned char* ws = a.ws;
          Gemm g{(const bf16_t*)(ws + WS_O), D, (const bf16_t*)(ws + WS_WO) + (size_t)l * D * D, D}; StaticOrder S; S.init(ntok, D, GRID, F.bk);
          EpiYo E{(bf16_t*)(ws + WS_U)}; gemm_phase<3>(F, g, S, E); }
        if (!last && F.bk >= (MT / 256) * (D / 256) - 2 * GRID) conv_filler(F, kp, l, FILL_P5);
        GRID_BAR(); FRESH();
        if (l == 0) phase_ln1_route<true>(F, kp, l, ntok); else phase_ln1_route<false>(F, kp, l, ntok);
        GRID_BAR(); FRESH();
        for (int rep_ = 0; rep_ < REP_P7; ++rep_) phase_dispatch(F, kp, l, ntok);
        GRID_BAR(); FRESH();
        { const Args a = ldargs(kp); unsigned char* ws = a.ws;
          Gemm g{(const bf16_t*)(ws + WS_H), D, (const bf16_t*)(ws + WS_WGU) + (size_t)l * NEXP * 1024 * D, D}; GroupedOrder S; S.init((const volatile LAS int*)(F.lds + MISC_POFF), GRID, F.vcu);
          LAS int* gt = (LAS int*)(F.lds + STAGE_BYTES);
          { const int* postok = (const int*)(ws + WS_POSTOK); Unit u; for (int i = 0; i < 16 && S.next(i, u); ++i) if (F.tid < 256) gt[i * 256 + F.tid] = postok[u.pm * 256 + F.tid]; }
          __syncthreads();
          EpiAct E{(bf16_t*)(ws + WS_ACT)}; gemm_phase_gather<4>(F, g, S, E, gt); }
        GRID_BAR(); FRESH();
        { const Args a = ldargs(kp); unsigned char* ws = a.ws;
          Gemm g{(const bf16_t*)(ws + WS_ACT), FF, (const bf16_t*)(ws + WS_WD) + (size_t)l * NEXP * D * FF, FF}; GroupedOrder S; S.init((const volatile LAS int*)(F.lds + MISC_POFF), GRID, F.vcu);
          EpiY E{(bf16_t*)(ws + WS_XS)}; gemm_phase<5>(F, g, S, E); }
        GRID_BAR(); FRESH();
        phase_ln2(F, kp, l, ntok);
        GRID_BAR(); FRESH();
    }
}

extern "C" void kernel_launch(void* const* d_in, const int* in_sizes, int n_in, void* d_out, int out_size, void* d_ws, size_t ws_size, hipStream_t stream) {
    static int grid = 0;
    if (grid == 0) {
        if (n_in != 25 || out_size != TL * D || ws_size < WS_END) { fprintf(stderr, "kernel_launch: unexpected shapes (n_in %d out %d ws %zu need %zu)\n", n_in, out_size, ws_size, (size_t)WS_END); grid = -1; return; }
        int dev = 0, cus = 0, per_cu = 0;
        if (hipGetDevice(&dev) != hipSuccess || hipDeviceGetAttribute(&cus, hipDeviceAttributeMultiprocessorCount, dev) != hipSuccess) { grid = -1; return; }
        if (hipFuncSetAttribute((const void*)fwd_kernel, hipFuncAttributeMaxDynamicSharedMemorySize, LDS_BYTES) != hipSuccess) { fprintf(stderr, "kernel_launch: hipFuncSetAttribute failed\n"); grid = -1; return; }
        if (hipOccupancyMaxActiveBlocksPerMultiprocessor(&per_cu, (const void*)fwd_kernel, NTHREADS, LDS_BYTES) != hipSuccess || per_cu < 1) { fprintf(stderr, "kernel_launch: occupancy query says %d\n", per_cu); }
        (void)hipGetLastError();
        grid = (cus == 256) ? 256 : -1;
        if (grid < 0) { fprintf(stderr, "kernel_launch: need a 256-CU device, got %d\n", cus); return; }
    }
    if (grid < 0) return;
    if (hipMemsetAsync((char*)d_ws + WS_CTL, 0, CTL_BYTES, stream) != hipSuccess) return;
    Args a{};
    a.x = (const float*)d_in[0]; a.c = (const float*)d_in[1]; a.ctx = (const float*)d_in[2]; a.c_ctx = (const float*)d_in[3]; a.w_ada = (const float*)d_in[4]; a.b_ada = (const float*)d_in[5];
    a.w_in = (const float*)d_in[6]; a.g_q_a = (const float*)d_in[7]; a.w_q_b = (const float*)d_in[8]; a.g_kv_a = (const float*)d_in[9]; a.w_kv_b = (const float*)d_in[10];
    a.g_gq = (const float*)d_in[11]; a.g_gk = (const float*)d_in[12]; a.w_o = (const float*)d_in[13]; a.ln1_g = (const float*)d_in[14]; a.ln1_b = (const float*)d_in[15];
    a.w_rg = (const float*)d_in[16]; a.b_rg = (const float*)d_in[17]; a.w_re = (const float*)d_in[18]; a.b_re = (const float*)d_in[19];
    a.w_gate = (const float*)d_in[20]; a.w_up = (const float*)d_in[21]; a.w_down = (const float*)d_in[22]; a.ln2_g = (const float*)d_in[23]; a.ln2_b = (const float*)d_in[24];
    a.out = (float*)d_out; a.ws = (unsigned char*)d_ws;
    hipLaunchKernelGGL(fwd_kernel, dim3(grid), dim3(NTHREADS), LDS_BYTES, stream, a);
}
```

```cpp
#include <hip/hip_runtime.h>
#include <cstdint>
#include <cstdio>

#ifndef REP_ATTN
#define REP_ATTN 1
#endif
#ifndef REP_GEMM
#define REP_GEMM 1
#endif
#ifndef REP_PRO
#define REP_PRO 1
#endif
#ifndef REP_THIN
#define REP_THIN 1
#endif
#ifndef REP_P2
#define REP_P2 1
#endif
#ifndef REP_P7
#define REP_P7 1
#endif
#ifndef REP_P6
#define REP_P6 1
#endif
#ifndef REP_P10
#define REP_P10 0
#endif
#ifndef FILL_P1
#define FILL_P1 3
#endif
#ifndef FILL_P5
#define FILL_P5 3
#endif
#ifndef USE_MFMA_GEMM
#define USE_MFMA_GEMM 1
#endif
#ifndef USE_MFMA_ATTN
#define USE_MFMA_ATTN 1
#endif

#define GAS __attribute__((address_space(1)))
#define LAS __attribute__((address_space(3)))
typedef unsigned short bf16_t;
typedef float f32x4 __attribute__((ext_vector_type(4)));
typedef float f32x2 __attribute__((ext_vector_type(2)));
typedef unsigned u32x4 __attribute__((ext_vector_type(4)));
typedef unsigned u32x2 __attribute__((ext_vector_type(2)));
typedef short bf16x8 __attribute__((ext_vector_type(8)));

constexpr int D = 1024, NB = 16, SEQ = 2048, CTX = 256, NL = 4;
constexpr int TL = NB * SEQ, TC = NB * CTX, MT = TL + TC;
constexpr int KPB = CTX + SEQ;
constexpr int ZW = 1536;
constexpr int QW = 768, KVW = 1024;
constexpr int NEXP = 32, FF = 512;
constexpr int XS_ROWS = 81920;
constexpr float ALPHA = 1.6817928305074290f;
constexpr float LOG2E = 1.4426950408889634f;
constexpr float QSCALE_M = 0.10206207261596575f * LOG2E;
constexpr float QSCALE_G = 0.125f * LOG2E;
constexpr float RMS_EPS = 1e-6f, LN_EPS = 1e-5f;
constexpr int NWAVES = 8, NTHREADS = 512, GRID = 256;

constexpr size_t al256(size_t x) { return (x + 255) & ~(size_t)255; }
constexpr size_t WS_CTL = 0, CTL_BYTES = 65536;
constexpr size_t WS_BLKCNT = WS_CTL + CTL_BYTES;
constexpr size_t WS_MOETAB = WS_BLKCNT + (size_t)NL * 256 * 32 * 4;
constexpr size_t WS_MOD = WS_MOETAB + (size_t)NL * 128 * 4;
constexpr size_t WS_MODP = WS_MOD + (size_t)NL * 17 * 6144 * 4;
constexpr size_t WS_TAB64 = WS_MODP + (size_t)4 * NL * 17 * 6144 * 4;
constexpr size_t WS_TAB32 = WS_TAB64 + 64 * 16 * 8;
constexpr size_t WS_RSTDQ = WS_TAB32 + 64 * 8 * 8;
constexpr size_t WS_RSTDKV = WS_RSTDQ + (size_t)MT * 4;
constexpr size_t WS_TOKE = WS_RSTDKV + (size_t)MT * 4;
constexpr size_t WS_TOKR = WS_TOKE + (size_t)MT * 8;
constexpr size_t WS_TOKP = WS_TOKR + (size_t)MT * 8;
constexpr size_t WS_TOKW = WS_TOKP + (size_t)MT * 8;
constexpr size_t WS_WIN = al256(WS_TOKW + (size_t)MT * 8);
constexpr size_t WS_WQ = WS_WIN + (size_t)NL * ZW * D * 2;
constexpr size_t WS_WKV = WS_WQ + (size_t)NL * QW * 384 * 2;
constexpr size_t WS_WO = WS_WKV + (size_t)NL * KVW * 256 * 2;
constexpr size_t WS_WGU = WS_WO + (size_t)NL * D * D * 2;
constexpr size_t WS_WD = WS_WGU + (size_t)NL * NEXP * 1024 * D * 2;
constexpr size_t WS_XC = WS_WD + (size_t)NL * NEXP * D * FF * 2;
constexpr size_t WS_H = WS_XC + (size_t)TC * D * 4;
constexpr size_t WS_B = WS_H + (size_t)MT * D * 2;
constexpr size_t WS_Z = WS_B;
constexpr size_t WS_QM = WS_Z + (size_t)MT * ZW * 2;
constexpr size_t WS_KM = WS_QM + (size_t)MT * QW * 2;
constexpr size_t WS_VM = WS_KM + (size_t)MT * QW * 2;
constexpr size_t WS_QG = WS_VM + (size_t)MT * 512 * 2;
constexpr size_t WS_KG = WS_QG + (size_t)MT * 512 * 2;
constexpr size_t WS_VG = WS_KG + (size_t)MT * 128 * 2;
constexpr size_t WS_O = WS_VG + (size_t)MT * 128 * 2;
constexpr size_t WS_BEND = WS_O + (size_t)MT * D * 2;
constexpr size_t WS_U = WS_B;
constexpr size_t WS_XS = WS_B;
constexpr size_t WS_ACT = WS_XS + (size_t)XS_ROWS * D * 2;
constexpr size_t WS_HLO = WS_BEND;
constexpr size_t WS_WR = WS_HLO + (size_t)MT * D * 2;
constexpr size_t WS_POSTOK = WS_WR + (size_t)NL * 2 * 48 * D * 2;
constexpr size_t WS_XB = al256(WS_POSTOK + (size_t)XS_ROWS * 4);
constexpr size_t WS_END = WS_XB + (size_t)MT * D * 2;
static_assert(WS_U + (size_t)MT * D * 4 <= WS_KM, "U must fit in Z+QM");
static_assert(WS_ACT + (size_t)XS_ROWS * FF * 2 <= WS_BEND, "MoE buffers must fit in region B");
static_assert(WS_END < (size_t)1100 * 1000 * 1000, "workspace map too large");

constexpr int LDS_BYTES = 163840;
constexpr int BIG_BYTES = 147456;
constexpr int MISC_OFF = BIG_BYTES;
constexpr int MISC_BAR = MISC_OFF;
constexpr int MISC_CNT = MISC_OFF + 64;
constexpr int MISC_POFF = MISC_OFF + 256;
constexpr int MISC_TOT = MISC_OFF + 512;
constexpr int MISC_BASE = MISC_OFF + 768;
constexpr int MISC_PA = MISC_OFF + 1024;
constexpr int MISC_PB = MISC_OFF + 1024 + 2048;
constexpr int MISC_LG = MISC_OFF + 8192;

#define LDS_WAIT() asm volatile("s_waitcnt lgkmcnt(0)" ::: "memory")
__device__ __forceinline__ unsigned f2bf(float f) { unsigned u = __builtin_bit_cast(unsigned, f); return (u + 0x7fffu + ((u >> 16) & 1u)) >> 16; }
__device__ __forceinline__ unsigned pk2(float lo, float hi) { typedef __bf16 bf2_t __attribute__((ext_vector_type(2))); f32x2 v = {lo, hi}; bf2_t b = __builtin_convertvector(v, bf2_t); return __builtin_bit_cast(unsigned, b); }
__device__ __forceinline__ float bflo(unsigned w) { return __builtin_bit_cast(float, w << 16); }
__device__ __forceinline__ float bfhi(unsigned w) { return __builtin_bit_cast(float, w & 0xffff0000u); }
template <int K> __device__ __forceinline__ float lane_xor(float v) { return __int_as_float(__builtin_amdgcn_ds_swizzle(__float_as_int(v), (K << 10) | 0x1f)); }
__device__ __forceinline__ float wave_sum(float v) {
    v += lane_xor<1>(v); v += lane_xor<2>(v); v += lane_xor<4>(v); v += lane_xor<8>(v); v += lane_xor<16>(v);
    { auto rr = __builtin_amdgcn_permlane32_swap(__float_as_uint(v), __float_as_uint(v), false, false); v = __uint_as_float(rr[0]) + __uint_as_float(rr[1]); }
    return v;
}
__device__ __forceinline__ int krow_of(int r) { return r < TL ? (r >> 11) * KPB + CTX + (r & 2047) : ((r - TL) >> 8) * KPB + ((r - TL) & 255); }
__device__ __forceinline__ int bb_of(int r) { return r < TL ? (r >> 11) : 16; }

#define XB_TMO      128
#define XB_XCNT(j)  (256  + 64 * (j))
#define XB_XSUB(j)  (1280 + 64 * (j))
#define XB_XGEN(j)  (2304 + 64 * (j))
#define XB_TOP      3328
#define XB_TOPGEN   3392
#define XCD_BAR_WORDS 3456
#define XB_SPIN_CAP (1u << 18)
__device__ __forceinline__ unsigned xb_ld(unsigned* p)              { return __hip_atomic_load(p, __ATOMIC_RELAXED, __HIP_MEMORY_SCOPE_AGENT); }
__device__ __forceinline__ unsigned xb_add(unsigned* p, unsigned v) { return __hip_atomic_fetch_add(p, v, __ATOMIC_RELAXED, __HIP_MEMORY_SCOPE_AGENT); }
__device__ __forceinline__ unsigned xb_xcc_id() { return (unsigned)__builtin_amdgcn_s_getreg((3 << 11) | 20) & 0xFu; }
#define XB_SPIN(cond, bar) do { unsigned _sp = 0; while (cond) { __builtin_amdgcn_s_sleep(1); \
    if ((++_sp & 255u) == 0u) { if (xb_ld(&(bar)[XB_TMO])) break; if (_sp > XB_SPIN_CAP) { atomicAdd(&(bar)[XB_TMO], 1u); break; } } } } while (0)
struct XcdBarrier { unsigned* bar; unsigned x; volatile LAS unsigned* st; };
__device__ __forceinline__ XcdBarrier xcd_barrier_post(unsigned* bar, volatile LAS unsigned* st, const bool leader) {
    XcdBarrier b; b.bar = bar; b.x = xb_xcc_id(); b.st = st;
    if (leader) (void)xb_add(&bar[XB_XCNT(b.x)], 1u);
    return b;
}
__device__ __forceinline__ void xcd_barrier_complete(unsigned* bar, unsigned x, unsigned& nloc, unsigned& nx) {
    const unsigned G = gridDim.x * gridDim.y * gridDim.z;
    unsigned sum, cnt, mine, sp = 0u;
    for (;;) {
        sum = 0u; cnt = 0u; mine = 0u;
#pragma unroll
        for (unsigned j = 0; j < 16; ++j) { const unsigned c = xb_ld(&bar[XB_XCNT(j)]); sum += c; cnt += (c > 0u) ? 1u : 0u; mine = (j == x) ? c : mine; }
        if (sum == G) break;
        __builtin_amdgcn_s_sleep(1);
        if ((++sp & 255u) == 0u) { if (xb_ld(&bar[XB_TMO])) break; if (sp > XB_SPIN_CAP) { atomicAdd(&bar[XB_TMO], 1u); break; } }
    }
    nloc = mine > 0u ? mine : 1u; nx = cnt > 0u ? cnt : 1u;
}
__device__ __forceinline__ void xcd_barrier(const XcdBarrier& b, const bool leader) {
    asm volatile("s_waitcnt vmcnt(0)" ::: "memory");
    __syncthreads();
    if (leader) {
        unsigned* bar = b.bar;
        __builtin_amdgcn_s_waitcnt(0);
        unsigned nloc = b.st[0], nx = b.st[1];
        if (nloc == 0u) { xcd_barrier_complete(bar, b.x, nloc, nx); b.st[0] = nloc; b.st[1] = nx; }
        const unsigned old = xb_add(&bar[XB_XSUB(b.x)], 1u);
        const unsigned gen = old / nloc;
        if (old + 1u == (gen + 1u) * nloc) {
            __builtin_amdgcn_fence(__ATOMIC_RELEASE, "agent");
            asm volatile("s_waitcnt vmcnt(0)" ::: "memory");
            const unsigned og = xb_add(&bar[XB_TOP], 1u);
            const unsigned tg = og / nx;
            if (og + 1u == (tg + 1u) * nx) xb_add(&bar[XB_TOPGEN], 1u);
            else XB_SPIN(xb_ld(&bar[XB_TOPGEN]) == tg, bar);
            __builtin_amdgcn_fence(__ATOMIC_ACQUIRE, "agent");
            xb_add(&bar[XB_XGEN(b.x)], 1u);
            asm volatile("s_waitcnt vmcnt(0)" ::: "memory");
        } else {
            XB_SPIN(xb_ld(&bar[XB_XGEN(b.x)]) == gen, bar);
            __builtin_amdgcn_fence(__ATOMIC_ACQUIRE, "agent");
            asm volatile("s_waitcnt vmcnt(0)" ::: "memory");
        }
    }
    __syncthreads();
}

struct Args {
    const float* x; const float* c; const float* ctx; const float* c_ctx; const float* w_ada; const float* b_ada; const float* w_in;
    const float* g_q_a; const float* w_q_b; const float* g_kv_a; const float* w_kv_b; const float* g_gq; const float* g_gk; const float* w_o;
    const float* ln1_g; const float* ln1_b; const float* w_rg; const float* b_rg; const float* w_re; const float* b_re;
    const float* w_gate; const float* w_up; const float* w_down; const float* ln2_g; const float* ln2_b;
    float* out; unsigned char* ws;
};

typedef const __attribute__((address_space(4))) Args* KP;
__device__ __forceinline__ Args ldargs(KP p) {
#if defined(__HIP_DEVICE_COMPILE__)
    asm volatile("" : "+s"(p)); return *p;
#else
    return Args{};
#endif
}

struct Ctx {
    LAS unsigned char* lds;
    int tid, lane, wave, vcu, bk;
};

struct Unit { int pm, pn; };
constexpr int BM = 256, NXCD = 8, WGM = 8;
struct StaticOrder {
    int nM, nN, nwg, G, c;
    __device__ void init(int M, int N, int G_, int c_) { nM = M / BM; nN = N / BM; nwg = nM * nN; G = G_; c = c_; }
    __device__ bool next(int i, Unit& u) const {
        const long L = (long)i * G + c; if (L >= nwg) return false;
        int wgid = (int)L; { const int q = nwg / NXCD, r = nwg % NXCD, xcd = wgid % NXCD, off = wgid / NXCD; wgid = (xcd < r ? xcd * (q + 1) : r * (q + 1) + (xcd - r) * q) + off; }
        const int nig = WGM * nN, gid = wgid / nig, fm = gid * WGM, gsz = (nM - fm) < WGM ? (nM - fm) : WGM;
        u.pm = fm + ((wgid % nig) % gsz); u.pn = (wgid % nig) / gsz; return true;
    }
    __device__ __forceinline__ void a_ready(const Unit&) const {}
    __device__ __forceinline__ void done(const Unit&) const {}
};
struct GroupedOrder {
    const volatile LAS int* poff; int nunits, G, c;
    __device__ void init(const volatile LAS int* poff_, int G_, int c_) { poff = poff_; nunits = (poff_[32] >> 8) * 4; G = G_; c = c_; }
    __device__ bool next(int i, Unit& u) const {
        const int L = i * G + c; if (L >= nunits) return false;
        const int rt = L >> 2, r0 = rt << 8; int e = 0;
#pragma unroll
        for (int j = 1; j < 32; ++j) e += (poff[j] <= r0) ? 1 : 0;
        u.pm = rt; u.pn = e * 4 + (L & 3); return true;
    }
    __device__ __forceinline__ void a_ready(const Unit&) const {}
    __device__ __forceinline__ void done(const Unit&) const {}
};

__device__ __forceinline__ void st_bf4(bf16_t* p, f32x4 v) { u32x2 w; w.x = pk2(v[0], v[1]); w.y = pk2(v[2], v[3]); *(u32x2*)p = w; }
__device__ __forceinline__ void st_bf8(bf16_t* p, f32x4 a, f32x4 b) { u32x4 w; w.x = pk2(a[0], a[1]); w.y = pk2(a[2], a[3]); w.z = pk2(b[0], b[1]); w.w = pk2(b[2], b[3]); *(u32x4*)p = w; }
struct EpiZ {
    static constexpr bool PERM = true;
    bf16_t* Z;
    __device__ __forceinline__ void tile32(int row, int col, int fq, f32x4 v0, f32x4 v1) const { st_bf8(Z + (size_t)row * ZW + col + 8 * fq, v0, v1); }
};
struct EpiQ {
    static constexpr bool PERM = true;
    bf16_t* Qm; const float* rstd; const f32x2* tab32;
    __device__ __forceinline__ void tile32(int row, int col, int fq, f32x4 v0, f32x4 v1) const {
        const int h = col / 96, gi = (col - h * 96) >> 5;
        const float rs = rstd[row] * QSCALE_M;
        v0 = v0 * rs; v1 = v1 * rs;
        bf16_t* base = Qm + (size_t)row * QW + h * 96;
        if (gi < 2) { st_bf8(base + gi * 32 + 8 * fq, v0, v1); }
        else {
            const int part = fq >> 1, f0 = (4 * fq) & 7;
            f32x4 o1 = v0, o2 = v1;
            if (row < TL) {
                const int s = row & 2047, pos = part ? (s & 63) : (s >> 6);
#pragma unroll
                for (int j = 0; j < 4; ++j) { const f32x2 cs = tab32[pos * 8 + f0 + j]; o1[j] = v0[j] * cs.x - v1[j] * cs.y; o2[j] = v1[j] * cs.x + v0[j] * cs.y; }
            }
            bf16_t* p = base + 64 + part * 16 + f0; st_bf4(p, o1); st_bf4(p + 8, o2);
        }
    }
};
struct EpiKV {
    static constexpr bool PERM = true;
    bf16_t* Km; bf16_t* Vm; const float* rstd;
    __device__ __forceinline__ void tile32(int row, int col, int fq, f32x4 v0, f32x4 v1) const {
        const int h = col >> 7, w = col & 127; const float rs = rstd[row]; const int kr = krow_of(row);
        bf16_t* p = (w < 64) ? (Km + (size_t)kr * QW + h * 96 + w + 8 * fq) : (Vm + (size_t)kr * 512 + h * 64 + (w - 64) + 8 * fq);
        st_bf8(p, v0 * rs, v1 * rs);
    }
};
struct EpiU {
    static constexpr bool PERM = false;
    float* U; const float* xl; const float* xc; const float* mod_l;
    int gate;
    __device__ __forceinline__ void tile32(int row, int col, int fq, f32x4 v0, f32x4 v1) const {
        const float* xr = (row < TL) ? (xl + (size_t)row * D) : (xc + (size_t)(row - TL) * D);
        const float* g = mod_l + (size_t)(bb_of(row) * 6 + gate) * D;
        const int c0 = col + 4 * fq;
        const f32x4 x0 = *(const f32x4*)(xr + c0), x1 = *(const f32x4*)(xr + c0 + 16), g0 = *(const f32x4*)(g + c0), g1 = *(const f32x4*)(g + c0 + 16);
        float* u = U + (size_t)row * D + c0;
        *(f32x4*)u = x0 * ALPHA + g0 * v0; *(f32x4*)(u + 16) = x1 * ALPHA + g1 * v1;
    }
};
__device__ __forceinline__ float silu_f(float x) { return x * __builtin_amdgcn_rcpf(1.0f + __builtin_amdgcn_exp2f(-x * LOG2E)); }
struct EpiAct {
    static constexpr bool PERM = false;
    bf16_t* Act;
    __device__ __forceinline__ void tile32(int row, int col, int fq, f32x4 v0, f32x4 v1) const {
        const int f0 = ((col & 1023) >> 1) + 4 * fq; f32x4 a;
#pragma unroll
        for (int j = 0; j < 4; ++j) a[j] = silu_f(v0[j]) * v1[j];
        st_bf4(Act + (size_t)row * FF + f0, a);
    }
};
struct EpiYo {
    static constexpr bool PERM = true;
    bf16_t* Y;
    __device__ __forceinline__ void tile32(int row, int col, int fq, f32x4 v0, f32x4 v1) const { st_bf8(Y + (size_t)row * D + col + 8 * fq, v0, v1); }
};
struct EpiY {
    static constexpr bool PERM = true;
    bf16_t* Y;
    __device__ __forceinline__ void tile32(int row, int col, int fq, f32x4 v0, f32x4 v1) const { st_bf8(Y + (size_t)row * D + (col & 1023) + 8 * fq, v0, v1); }
};

struct Gemm { const bf16_t* A; int lda; const bf16_t* Bt; int K; };
__device__ __forceinline__ float dot8(u32x4 a, u32x4 b, float acc) {
#pragma unroll
    for (int i = 0; i < 4; ++i) { acc += bflo(a[i]) * bflo(b[i]); acc += bfhi(a[i]) * bfhi(b[i]); }
    return acc;
}
template <class Sched, class Epi>
__device__ __forceinline__ void gemm_naive(const Ctx& F, const Gemm g, const Sched& S, const Epi& E) {
    Unit u;
    for (int i = 0; S.next(i, u); ++i) {
        for (int task = F.tid; task < 8192; task += NTHREADS) {
            const int lane = task & 63, fr = lane & 15, fq = lane >> 4, rest = task >> 6, rg = rest & 15, cg = rest >> 4;
            const int row = u.pm * 256 + rg * 16 + fr, col = u.pn * 256 + cg * 32;
            const bf16_t* ap = g.A + (size_t)row * g.lda;
            const bf16_t* bp0 = g.Bt + (size_t)(col + 4 * fq) * g.K;
            const bf16_t* bp1 = bp0 + (size_t)16 * g.K;
            f32x4 v0 = {0.f, 0.f, 0.f, 0.f}, v1 = {0.f, 0.f, 0.f, 0.f};
            for (int k = 0; k < g.K; k += 8) {
                const u32x4 a = *(const u32x4*)(ap + k);
#pragma unroll
                for (int j = 0; j < 4; ++j) {
                    v0[j] = dot8(a, *(const u32x4*)(bp0 + (size_t)j * g.K + k), v0[j]);
                    v1[j] = dot8(a, *(const u32x4*)(bp1 + (size_t)j * g.K + k), v1[j]);
                }
            }
            E.tile32(row, col, fq, v0, v1);
        }
    }
}
constexpr int BK = 64, HALF = 128, HTB = HALF * BK * 2, STAGE_BYTES = 8 * HTB;
__device__ __forceinline__ int lds_byte(int r, int c) { const int st = (r >> 4) * 2 + (c >> 5), rr = r & 15, cc = c & 31, ob = rr * 64 + cc * 2; return st * 1024 + (ob ^ (((ob >> 9) & 1) << 5)); }
__device__ __forceinline__ int perm32(int rho) { const int n = rho >> 4, i = rho & 15; return 8 * (i >> 2) + 4 * n + (i & 3); }
__device__ __forceinline__ void stage_rc(int b, int& R, int& C) { const int st = b / 1024, sb = b % 1024, swz = sb ^ (((sb >> 9) & 1) << 5); R = (st >> 1) * 16 + swz / 64; C = (st & 1) * 32 + (swz % 64) / 2; }
template <class Epi, class Sched, bool ALIGN_EPI = true, bool SP2 = true, bool GATHER = false>
__device__ __forceinline__ void gemm_mfma(LAS unsigned char* lds, const int tid_in, const Gemm g, const Sched& S, const Epi& E, const LAS int* gtab = nullptr) {
    int tid = tid_in; asm volatile("" : "+v"(tid));
    const int wid = __builtin_amdgcn_readfirstlane(tid >> 6), lane = tid & 63, wr = wid >> 2, wc = wid & 3, fr = lane & 15, fq = lane >> 4;
    const int K = g.K, nt = K / BK;
    unsigned voffB[2]; int RA[2], CA[2];
#pragma unroll
    for (int i = 0; i < 2; ++i) { int R, C; stage_rc(tid * 16 + i * 8192, R, C); const int Rb = Epi::PERM ? ((R & ~31) + perm32(R & 31)) : R;
        RA[i] = R; CA[i] = C; voffB[i] = (unsigned)(Rb * K + C) * 2u; }
    const size_t kstep = (size_t)(BK * 2);
    const size_t hstepA = (size_t)HALF * g.lda * 2, hstepB = (size_t)HALF * K * 2;
    const size_t tstepA = GATHER ? 0 : 2 * hstepA, tstepB = 2 * hstepB;
    unsigned vc0[2], vc1[2], vn0[2], vn1[2];
#define PG8_GOFF(dst0, dst1, ui_) do { _Pragma("unroll") for (int i_ = 0; i_ < 2; ++i_) { \
        if constexpr (GATHER) { dst0[i_] = (unsigned)gtab[(ui_) * 256 + RA[i_]] * (unsigned)(g.lda * 2) + (unsigned)CA[i_] * 2u; dst1[i_] = (unsigned)gtab[(ui_) * 256 + HALF + RA[i_]] * (unsigned)(g.lda * 2) + (unsigned)CA[i_] * 2u; } \
        else { dst0[i_] = (unsigned)(RA[i_] * g.lda + CA[i_]) * 2u; dst1[i_] = dst0[i_] + (unsigned)hstepA; } } } while (0)
    const unsigned ldsw = (unsigned)wid * 1024u;
    const int aoff = lds_byte(wr * 64 + fr, fq * 8), boff = lds_byte(wc * 32 + fr, fq * 8);
#define PG8_SA(b, h) (((b) * 2 + (h)) * HTB)
#define PG8_SB(b, h) ((4 + (b) * 2 + (h)) * HTB)
#define PG8_STAGE(bufoff, gbase, voff) do { _Pragma("unroll") for (int _i = 0; _i < 2; ++_i) \
        __builtin_amdgcn_global_load_lds((const unsigned*)((const char*)(gbase) + (voff)[_i]), (LAS unsigned*)(lds + (bufoff) + ldsw + _i * 8192), 16, 0, 0); } while (0)
#define PG8_LDA(dst, b, h) do { _Pragma("unroll") for (int m = 0; m < 4; ++m) _Pragma("unroll") for (int k = 0; k < 2; ++k) dst[m][k] = *(const LAS bf16x8*)(lds + PG8_SA(b, h) + aoff + m * 2048 + k * 1024); } while (0)
#define PG8_LDB(dst, b, h) do { _Pragma("unroll") for (int n = 0; n < 2; ++n) _Pragma("unroll") for (int k = 0; k < 2; ++k) dst[n][k] = *(const LAS bf16x8*)(lds + PG8_SB(b, h) + boff + n * 2048 + k * 1024); } while (0)
#define PG8_MMA(ai, bj, At, Bt) do { __builtin_amdgcn_s_setprio(1); _Pragma("unroll") for (int m = 0; m < 4; ++m) _Pragma("unroll") for (int n = 0; n < 2; ++n) _Pragma("unroll") for (int k = 0; k < 2; ++k) \
        acc[ai][bj][m][n] = __builtin_amdgcn_mfma_f32_16x16x32_bf16(Bt[n][k], At[m][k], acc[ai][bj][m][n], 0, 0, 0); __builtin_amdgcn_s_setprio(0); } while (0)
#define PG8_WAIT_V(n) asm volatile("s_waitcnt vmcnt(" #n ")" ::: "memory")
#define PG8_WAIT_L(n) asm volatile("s_waitcnt lgkmcnt(" #n ")" ::: "memory")
#define PG8_BAR __builtin_amdgcn_s_barrier()
#define PG8_SCHED __builtin_amdgcn_sched_barrier(0)
    Unit cur, nxt; int ui = 0;
    if (!S.next(0, cur)) return;
    PG8_GOFF(vc0, vc1, 0);
#pragma unroll
    for (int i = 0; i < 2; ++i) { vn0[i] = vc0[i]; vn1[i] = vc1[i]; }
    f32x4 acc[2][2][4][2];
#pragma unroll
    for (int a = 0; a < 2; ++a)
#pragma unroll
        for (int b = 0; b < 2; ++b)
#pragma unroll
            for (int m = 0; m < 4; ++m)
#pragma unroll
                for (int n = 0; n < 2; ++n) acc[a][b][m][n] = (f32x4){0.f, 0.f, 0.f, 0.f};
    bf16x8 At[4][2], B0[2][2], B1[2][2];
    const char* cA = (const char*)g.A + (size_t)cur.pm * tstepA; const char* cB = (const char*)g.Bt + (size_t)cur.pn * tstepB;
    S.a_ready(cur);
    if constexpr (SP2) {
        PG8_STAGE(PG8_SB(0, 0), cB, voffB); PG8_STAGE(PG8_SB(0, 1), cB + hstepB, voffB); PG8_STAGE(PG8_SA(0, 0), cA, vc0); PG8_STAGE(PG8_SA(0, 1), cA, vc1);
        if (wr == 1) PG8_BAR;
        PG8_WAIT_V(2); PG8_BAR;
        PG8_STAGE(PG8_SB(1, 0), cB + kstep, voffB); PG8_STAGE(PG8_SA(1, 0), cA + kstep, vc0); PG8_STAGE(PG8_SB(1, 1), cB + hstepB + kstep, voffB);
        PG8_WAIT_V(6); PG8_BAR;
    } else {
        PG8_STAGE(PG8_SB(0, 0), cB, voffB); PG8_STAGE(PG8_SA(0, 0), cA, vc0); PG8_STAGE(PG8_SB(0, 1), cB + hstepB, voffB); PG8_STAGE(PG8_SA(0, 1), cA, vc1);
        if (wr == 1) PG8_BAR;
        PG8_WAIT_V(4); PG8_BAR;
        PG8_STAGE(PG8_SB(1, 0), cB + kstep, voffB); PG8_STAGE(PG8_SA(1, 0), cA + kstep, vc0); PG8_STAGE(PG8_SB(1, 1), cB + hstepB + kstep, voffB);
        PG8_WAIT_V(6); PG8_BAR;
    }
    for (;;) {
        const bool has_next = S.next(ui + 1, nxt);
        if constexpr (GATHER) { if (has_next) { PG8_GOFF(vn0, vn1, ui + 1); } else {
#pragma unroll
            for (int i = 0; i < 2; ++i) { vn0[i] = vc0[i]; vn1[i] = vc1[i]; } } }
        const char* nA = has_next ? (const char*)g.A + (size_t)nxt.pm * tstepA : cA; const char* nB = has_next ? (const char*)g.Bt + (size_t)nxt.pn * tstepB : cB;
        for (int t = 0; t < nt; t += 2) {
            const bool last = (t == nt - 2);
            const char* a1 = cA + (size_t)(t + 1) * kstep;
            const char* a2 = last ? nA : cA + (size_t)(t + 2) * kstep; const char* b2 = last ? nB : cB + (size_t)(t + 2) * kstep;
            const char* a3 = a2 + kstep; const char* b3 = b2 + kstep;
            unsigned s0[2], s1[2];
#pragma unroll
            for (int i = 0; i < 2; ++i) { if constexpr (GATHER) { s0[i] = last ? vn0[i] : vc0[i]; s1[i] = last ? vn1[i] : vc1[i]; } else { s0[i] = vc0[i]; s1[i] = vc1[i]; } }
            if (last && has_next) S.a_ready(nxt);
            if constexpr (SP2) {
            PG8_LDB(B0, 0, 0); PG8_LDB(B1, 0, 1); PG8_SCHED; PG8_LDA(At, 0, 0); PG8_STAGE(PG8_SA(1, 1), a1, vc1);
            PG8_WAIT_V(8); PG8_WAIT_L(0); PG8_BAR; PG8_MMA(0, 0, At, B0); PG8_MMA(0, 1, At, B1); PG8_BAR; PG8_SCHED;
            PG8_LDA(At, 0, 1); PG8_STAGE(PG8_SB(0, 0), b2, voffB); PG8_STAGE(PG8_SB(0, 1), b2 + hstepB, voffB); PG8_STAGE(PG8_SA(0, 0), a2, s0);
            PG8_WAIT_V(8); PG8_WAIT_L(0); PG8_BAR; PG8_MMA(1, 0, At, B0); PG8_MMA(1, 1, At, B1); PG8_BAR; PG8_SCHED;
            PG8_LDB(B0, 1, 0); PG8_LDB(B1, 1, 1); PG8_SCHED; PG8_LDA(At, 1, 0); PG8_STAGE(PG8_SA(0, 1), a2, s1);
            PG8_WAIT_V(8); PG8_WAIT_L(0); PG8_BAR; PG8_MMA(0, 0, At, B0); PG8_MMA(0, 1, At, B1); PG8_BAR; PG8_SCHED;
            PG8_LDA(At, 1, 1); PG8_STAGE(PG8_SB(1, 0), b3, voffB); PG8_STAGE(PG8_SB(1, 1), b3 + hstepB, voffB); PG8_STAGE(PG8_SA(1, 0), a3, s0);
            PG8_WAIT_V(8); PG8_WAIT_L(0); PG8_BAR; PG8_MMA(1, 0, At, B0); PG8_MMA(1, 1, At, B1); PG8_BAR; PG8_SCHED;
            } else {
            PG8_LDB(B0, 0, 0); PG8_SCHED; PG8_LDA(At, 0, 0); PG8_STAGE(PG8_SA(1, 1), a1, vc1);
            PG8_WAIT_L(8); PG8_BAR; PG8_WAIT_L(0); PG8_MMA(0, 0, At, B0); PG8_BAR; PG8_SCHED;
            PG8_LDB(B1, 0, 1); PG8_STAGE(PG8_SB(0, 0), b2, voffB);
            PG8_BAR; PG8_WAIT_L(0); PG8_MMA(0, 1, At, B1); PG8_BAR;
            PG8_LDA(At, 0, 1); PG8_STAGE(PG8_SA(0, 0), a2, s0);
            PG8_BAR; PG8_WAIT_L(0); PG8_MMA(1, 0, At, B0); PG8_BAR; PG8_SCHED;
            PG8_STAGE(PG8_SB(0, 1), b2 + hstepB, voffB);
            PG8_WAIT_V(6); PG8_BAR; PG8_MMA(1, 1, At, B1); PG8_BAR;
            PG8_LDB(B0, 1, 0); PG8_SCHED; PG8_LDA(At, 1, 0); PG8_STAGE(PG8_SA(0, 1), a2, s1);
            PG8_WAIT_L(8); PG8_BAR; PG8_WAIT_L(0); PG8_MMA(0, 0, At, B0); PG8_BAR; PG8_SCHED;
            PG8_LDB(B1, 1, 1); PG8_STAGE(PG8_SB(1, 0), b3, voffB);
            PG8_BAR; PG8_WAIT_L(0); PG8_MMA(0, 1, At, B1); PG8_BAR;
            PG8_LDA(At, 1, 1); PG8_STAGE(PG8_SA(1, 0), a3, s0);
            PG8_BAR; PG8_WAIT_L(0); PG8_MMA(1, 0, At, B0); PG8_BAR; PG8_SCHED;
            PG8_STAGE(PG8_SB(1, 1), b3 + hstepB, voffB);
            PG8_WAIT_V(6); PG8_BAR; PG8_MMA(1, 1, At, B1); PG8_BAR;
            }
        }
        if constexpr (ALIGN_EPI) { if (wr == 0) PG8_BAR; }
        {
            int ln_e; asm volatile("v_mbcnt_lo_u32_b32 %0, -1, 0\n\tv_mbcnt_hi_u32_b32 %0, -1, %0" : "=v"(ln_e));
            const int fr_e = ln_e & 15, fq_e = ln_e >> 4;
#pragma unroll
            for (int ai = 0; ai < 2; ++ai)
#pragma unroll
                for (int m = 0; m < 4; ++m) {
#pragma unroll
                    for (int bj = 0; bj < 2; ++bj)
                        E.tile32(cur.pm * BM + ai * HALF + wr * 64 + m * 16 + fr_e, cur.pn * BM + bj * HALF + wc * 32, fq_e, acc[ai][bj][m][0], acc[ai][bj][m][1]);
                    asm volatile("" ::: "memory");
                }
            S.done(cur);
        }
        if (!has_next) break;
#pragma unroll
        for (int a = 0; a < 2; ++a)
#pragma unroll
            for (int b = 0; b < 2; ++b)
#pragma unroll
                for (int m = 0; m < 4; ++m)
#pragma unroll
                    for (int n = 0; n < 2; ++n) acc[a][b][m][n] = (f32x4){0.f, 0.f, 0.f, 0.f};
        cur = nxt; cA = nA; cB = nB; ++ui;
        if constexpr (GATHER) {
#pragma unroll
            for (int i = 0; i < 2; ++i) { vc0[i] = vn0[i]; vc1[i] = vn1[i]; } }
        if constexpr (ALIGN_EPI) { if (wr == 1) PG8_BAR; }
    }
    PG8_WAIT_V(0);
    if constexpr (!ALIGN_EPI) { if (wr == 0) PG8_BAR; }
    PG8_BAR;
#undef PG8_GOFF
#undef PG8_SA
#undef PG8_SB
#undef PG8_STAGE
#undef PG8_LDA
#undef PG8_LDB
#undef PG8_MMA
#undef PG8_WAIT_V
#undef PG8_WAIT_L
#undef PG8_BAR
#undef PG8_SCHED
}

#ifndef REP_GEMM_MASK
#define REP_GEMM_MASK 0
#endif
template <int ID, class Sched, class Epi>
__device__ __forceinline__ void gemm_phase_gather(const Ctx& F, const Gemm g, const Sched& S, const Epi& E, const LAS int* gtab) {
    gemm_mfma<Epi, Sched, true, true, true>(F.lds, F.tid, g, S, E, gtab);
    if constexpr ((REP_GEMM_MASK >> ID) & 1) gemm_mfma<Epi, Sched, true, true, true>(F.lds, F.tid, g, S, E, gtab);
}
template <int ID, class Sched, class Epi>
__device__ __forceinline__ void gemm_phase(const Ctx& F, const Gemm g, const Sched& S, const Epi& E) {
#if USE_MFMA_GEMM
    gemm_mfma<Epi, Sched, true, true>(F.lds, F.tid, g, S, E);
    if constexpr ((REP_GEMM_MASK >> ID) & 1) gemm_mfma<Epi, Sched, true, true>(F.lds, F.tid, g, S, E);
#else
    gemm_naive(F, g, S, E);
#endif
}

template <class ColPtr>
__device__ __forceinline__ void tconv_tile(const ColPtr& cp, int ldw, const float* scale, bf16_t* WT, int K, int k0, int p0, LAS float* scr, int lane) {
    const int pc = (lane & 15) * 4, kq = lane >> 4;
    const float* src = cp(p0 + pc);
#pragma unroll 4
    for (int i = 0; i < 16; ++i) {
        const int kk = 4 * i + kq;
        f32x4 v = {0.f, 0.f, 0.f, 0.f};
        if (src) { v = *(const f32x4*)(src + (size_t)(k0 + kk) * ldw); if (scale) v = v * scale[k0 + kk]; }
        LAS float* d = scr + kk * 65 + pc; d[0] = v[0]; d[1] = v[1]; d[2] = v[2]; d[3] = v[3];
    }
    LDS_WAIT();
    const int c = lane & 7;
#pragma unroll
    for (int j = 0; j < 8; ++j) {
        const int n = (lane >> 3) + 8 * j; const LAS float* s = scr + (8 * c) * 65 + n;
        u32x4 o; o.x = pk2(s[0], s[65]); o.y = pk2(s[2 * 65], s[3 * 65]); o.z = pk2(s[4 * 65], s[5 * 65]); o.w = pk2(s[6 * 65], s[7 * 65]);
        *(u32x4*)(WT + (size_t)(p0 + n) * K + k0 + 8 * c) = o;
    }
    LDS_WAIT();
}
struct CpPlain { const float* W; int ncols; __device__ __forceinline__ const float* operator()(int p) const { return p < ncols ? W + p : nullptr; } };
struct CpQ {
    const float* W;
    __device__ __forceinline__ const float* operator()(int p) const {
        const int h = p / 96, pp = p - h * 96; int lc = pp;
        if (pp >= 64) { const int rp = pp - 64, q = rp >> 3, r = rp & 7, i = 4 * q + (r & 3); lc = 64 + (i >> 3) * 16 + (i & 7) + ((r >> 2) ? 8 : 0); }
        return W + h * 96 + lc;
    }
};
struct CpGU {
    const float* Wg; const float* Wu;
    __device__ __forceinline__ const float* operator()(int p) const { const int g32 = p >> 5, w = p & 31; return (w < 16) ? (Wg + g32 * 16 + w) : (Wu + g32 * 16 + (w - 16)); }
};

constexpr int CONV_ITEMS = NEXP * 256 + NEXP * 128, CONV_CH = 4, CONV_CTR0 = 8192;
struct ConvSrc { const float* p; size_t ld; bf16_t* dst; int K; };
__device__ __forceinline__ ConvSrc conv_decode(const Args& a, int l, int idx, int lane) {
    const int pc = (lane & 15) * 4, kq = lane >> 4; ConvSrc r;
    if (idx < NEXP * 256) { const int e = idx >> 8, q = idx & 255, k0 = (q >> 4) * 64, p = (q & 15) * 64 + pc, g32 = p >> 5, w = p & 31; const size_t le = (size_t)l * NEXP + e;
        r.p = ((w < 16) ? (a.w_gate + le * D * FF + g32 * 16 + w) : (a.w_up + le * D * FF + g32 * 16 + (w - 16))) + (size_t)(k0 + kq) * FF; r.ld = FF;
        r.dst = (bf16_t*)(a.ws + WS_WGU) + le * 1024 * D + (size_t)((q & 15) * 64) * D + k0; r.K = D; }
    else { const int i2 = idx - NEXP * 256, e = i2 >> 7, q = i2 & 127, k0 = (q >> 4) * 64, p0 = (q & 15) * 64; const size_t le = (size_t)l * NEXP + e;
        r.p = a.w_down + le * FF * D + (size_t)(k0 + kq) * D + p0 + pc; r.ld = D;
        r.dst = (bf16_t*)(a.ws + WS_WD) + le * D * FF + (size_t)p0 * FF + k0; r.K = FF; }
    return r;
}
__device__ __forceinline__ void conv_load(const ConvSrc& c, f32x4 (&v)[16]) {
#pragma unroll
    for (int i = 0; i < 16; ++i) v[i] = *(const f32x4*)(c.p + (size_t)(4 * i) * c.ld);
}
__device__ __forceinline__ void conv_store(const ConvSrc& c, const f32x4 (&v)[16], LAS float* scr, int lane) {
    const int pc = (lane & 15) * 4, kq = lane >> 4;
#pragma unroll
    for (int i = 0; i < 16; ++i) { LAS float* d = scr + (4 * i + kq) * 65 + pc; d[0] = v[i][0]; d[1] = v[i][1]; d[2] = v[i][2]; d[3] = v[i][3]; }
    LDS_WAIT();
    const int cc = lane & 7;
#pragma unroll
    for (int j = 0; j < 8; ++j) {
        const int n = (lane >> 3) + 8 * j; const LAS float* sp = scr + (8 * cc) * 65 + n;
        u32x4 o; o.x = pk2(sp[0], sp[65]); o.y = pk2(sp[2 * 65], sp[3 * 65]); o.z = pk2(sp[4 * 65], sp[5 * 65]); o.w = pk2(sp[6 * 65], sp[7 * 65]);
        *(u32x4*)(c.dst + (size_t)n * c.K + 8 * cc) = o;
    }
    LDS_WAIT();
}
__device__ __forceinline__ void conv_experts(const Ctx& F, const Args& a, int l, int grabs) {
    unsigned* ctr = (unsigned*)(a.ws + WS_CTL) + CONV_CTR0 + 64 * l;
    LAS float* scr = (LAS float*)(F.lds + F.wave * 18432);
    for (int g = 0; grabs < 0 || g < grabs; ++g) {
        unsigned b0 = 0; if (F.lane == 0) b0 = __hip_atomic_fetch_add(ctr, (unsigned)CONV_CH, __ATOMIC_RELAXED, __HIP_MEMORY_SCOPE_AGENT);
        const int base = __builtin_amdgcn_readfirstlane((int)b0);
        if (base >= CONV_ITEMS) break;
        f32x4 va[16], vb[16];
        ConvSrc c0 = conv_decode(a, l, base, F.lane), c1 = conv_decode(a, l, base + 1, F.lane), c2 = conv_decode(a, l, base + 2, F.lane), c3 = conv_decode(a, l, base + 3, F.lane);
        conv_load(c0, va); conv_load(c1, vb); conv_store(c0, va, scr, F.lane);
        conv_load(c2, va); conv_store(c1, vb, scr, F.lane);
        conv_load(c3, vb); conv_store(c2, va, scr, F.lane);
        conv_store(c3, vb, scr, F.lane);
    }
}

__device__ __forceinline__ void conv_filler(const Ctx& F, KP kp, int l, int grabs) {
    const Args a = ldargs(kp);
    int q = l;
    if (l == 0 || (int)__hip_atomic_load((unsigned*)(a.ws + WS_CTL) + CONV_CTR0 + 64 * l, __ATOMIC_RELAXED, __HIP_MEMORY_SCOPE_AGENT) >= CONV_ITEMS) q = l + 1;
    if (q < NL) conv_experts(F, a, q, grabs);
}
__device__ __forceinline__ void prologue1(const Ctx& F, KP kp) {
    const Args a = ldargs(kp);
    unsigned char* ws = a.ws;
    {
        LAS float* sl = (LAS float*)F.lds;
        float* modp = (float*)(ws + WS_MODP);
        for (int it = F.bk; it < NL * 12 * 4; it += GRID) {
            const int kc = it & 3, nc = (it >> 2) % 12, l = it / 48;
            __syncthreads();
            for (int idx = F.tid; idx < 17 * 256; idx += NTHREADS) {
                const int bb = idx >> 8, k = idx & 255; const float v = (bb < 16) ? a.c[bb * D + kc * 256 + k] : a.c_ctx[kc * 256 + k];
                sl[idx] = v / (1.0f + __expf(-v));
            }
            __syncthreads();
            const int n = nc * 512 + F.tid;
            const float* w = a.w_ada + ((size_t)l * D + kc * 256) * 6144 + n;
            float acc[17];
#pragma unroll
            for (int bb = 0; bb < 17; ++bb) acc[bb] = 0.f;
            for (int k = 0; k < 256; ++k) {
                const float wv = w[(size_t)k * 6144];
#pragma unroll
                for (int bb = 0; bb < 17; ++bb) acc[bb] += sl[bb * 256 + k] * wv;
            }
#pragma unroll
            for (int bb = 0; bb < 17; ++bb) modp[((size_t)(kc * NL + l) * 17 + bb) * 6144 + n] = acc[bb];
        }
        __syncthreads();
    }
    {
        f32x2* t64 = (f32x2*)(ws + WS_TAB64); f32x2* t32 = (f32x2*)(ws + WS_TAB32);
        const int gt = F.bk * NTHREADS + F.tid;
        if (gt < 64 * 16) { const int pos = gt >> 4, f = gt & 15; const float inv = powf(10000.0f, -((float)(2 * f) / 32.0f)); const float ang = (float)pos * inv; t64[gt] = (f32x2){cosf(ang), sinf(ang)}; }
        else if (gt < 64 * 16 + 64 * 8) { const int g2 = gt - 64 * 16, pos = g2 >> 3, f = g2 & 7; const float inv = powf(10000.0f, -((float)(2 * f) / 16.0f)); const float ang = (float)pos * inv; t32[g2] = (f32x2){cosf(ang), sinf(ang)}; }
    }
    {
        bf16_t* wr = (bf16_t*)(ws + WS_WR);
        for (int i = F.bk * NTHREADS + F.tid; i < NL * 48 * D; i += GRID * NTHREADS) {
            const int c = i & 1023, j = (i >> 10) % 48, l = i / (48 * D);
            float wv = 0.f;
            if (j < 4) wv = a.w_rg[((size_t)l * D + c) * 4 + j]; else if (j < 36) wv = a.w_re[((size_t)l * D + c) * 32 + (j - 4)];
            const unsigned h = f2bf(wv); const float rem = wv - __builtin_bit_cast(float, h << 16);
            wr[((size_t)(l * 2 + 0) * 48 + j) * D + c] = (bf16_t)h; wr[((size_t)(l * 2 + 1) * 48 + j) * D + c] = (bf16_t)f2bf(rem);
        }
    }
    {
        LAS float* scr = (LAS float*)(F.lds + F.wave * 18432);
        const int gw = F.vcu * NWAVES + F.wave, NGW = GRID * NWAVES;
        constexpr int I_IN = 16 * 24, I_Q = 6 * 12, I_KV = 4 * 16, I_O = 16 * 16, I_GU = 16 * 16, I_D = 8 * 16;
        constexpr int N_SMALL = NL * (I_IN + I_Q + I_KV + I_O), N_GU = NL * NEXP * I_GU, N_D = NL * NEXP * I_D;
        for (int it = gw; it < N_SMALL; it += NGW) {
            {
                const int l = it / (I_IN + I_Q + I_KV + I_O); int r = it % (I_IN + I_Q + I_KV + I_O);
                if (r < I_IN) { const int kt = r / 24, pt = r % 24; tconv_tile(CpPlain{a.w_in + (size_t)l * D * 1440, 1440}, 1440, nullptr, (bf16_t*)(ws + WS_WIN) + (size_t)l * ZW * D, D, kt * 64, pt * 64, scr, F.lane); continue; }
                r -= I_IN;
                if (r < I_Q) { const int kt = r / 12, pt = r % 12; tconv_tile(CpQ{a.w_q_b + (size_t)l * 384 * QW}, QW, a.g_q_a + l * 384, (bf16_t*)(ws + WS_WQ) + (size_t)l * QW * 384, 384, kt * 64, pt * 64, scr, F.lane); continue; }
                r -= I_Q;
                if (r < I_KV) { const int kt = r / 16, pt = r % 16; tconv_tile(CpPlain{a.w_kv_b + (size_t)l * 256 * KVW, KVW}, KVW, a.g_kv_a + l * 256, (bf16_t*)(ws + WS_WKV) + (size_t)l * KVW * 256, 256, kt * 64, pt * 64, scr, F.lane); continue; }
                r -= I_KV;
                { const int kt = r / 16, pt = r % 16; tconv_tile(CpPlain{a.w_o + (size_t)l * D * D, D}, D, nullptr, (bf16_t*)(ws + WS_WO) + (size_t)l * D * D, D, kt * 64, pt * 64, scr, F.lane); }
            }
        }
        conv_experts(F, a, 0, -1);
    }
}

__device__ __forceinline__ void prologue2(const Ctx& F, KP kp) {
    const Args a = ldargs(kp);
    const float* modp = (const float*)(a.ws + WS_MODP); float* mod = (float*)(a.ws + WS_MOD);
    constexpr int NE = NL * 17 * 6144 / 4;
    for (int i = F.bk * NTHREADS + F.tid; i < NE; i += GRID * NTHREADS) {
        const int e = i * 4, l = e / (17 * 6144), n = e % 6144;
        f32x4 s = *(const f32x4*)(a.b_ada + l * 6144 + n);
#pragma unroll
        for (int kc = 0; kc < 4; ++kc) s = s + *(const f32x4*)(modp + (size_t)kc * NL * 17 * 6144 + e);
        *(f32x4*)(mod + e) = s;
    }
}

__device__ __forceinline__ void row_load(const float* p, int lane, f32x4 (&v)[4]) {
#pragma unroll
    for (int j = 0; j < 4; ++j) v[j] = *(const f32x4*)(p + 4 * lane + 256 * j);
}
__device__ __forceinline__ void row_ln(f32x4 (&v)[4], const float* g, const float* b, int lane) {
    float s = 0.f;
#pragma unroll
    for (int j = 0; j < 4; ++j) s += (v[j][0] + v[j][1]) + (v[j][2] + v[j][3]);
    const float mean = wave_sum(s) * (1.0f / D); float q = 0.f;
#pragma unroll
    for (int j = 0; j < 4; ++j) { v[j] = v[j] - mean; q += (v[j][0] * v[j][0] + v[j][1] * v[j][1]) + (v[j][2] * v[j][2] + v[j][3] * v[j][3]); }
    const float rstd = 1.0f / sqrtf(wave_sum(q) * (1.0f / D) + LN_EPS);
#pragma unroll
    for (int j = 0; j < 4; ++j) { const f32x4 gg = *(const f32x4*)(g + 4 * lane + 256 * j), bv = *(const f32x4*)(b + 4 * lane + 256 * j); v[j] = v[j] * rstd * gg + bv; }
}
__device__ __forceinline__ void row_ln_reg(f32x4 (&v)[4], const f32x4 (&g)[4], const f32x4 (&b)[4]) {
    float s = 0.f;
#pragma unroll
    for (int j = 0; j < 4; ++j) s += (v[j][0] + v[j][1]) + (v[j][2] + v[j][3]);
    const float mean = wave_sum(s) * (1.0f / D); float q = 0.f;
#pragma unroll
    for (int j = 0; j < 4; ++j) { v[j] = v[j] - mean; q += (v[j][0] * v[j][0] + v[j][1] * v[j][1]) + (v[j][2] * v[j][2] + v[j][3] * v[j][3]); }
    const float rstd = 1.0f / sqrtf(wave_sum(q) * (1.0f / D) + LN_EPS);
#pragma unroll
    for (int j = 0; j < 4; ++j) v[j] = v[j] * rstd * g[j] + b[j];
}
__device__ __forceinline__ void row_store_mod_bf16(bf16_t* hrow, const f32x4 (&v)[4], const float* sh, const float* sc, int lane) {
#pragma unroll
    for (int j = 0; j < 4; ++j) {
        const f32x4 s1 = *(const f32x4*)(sc + 4 * lane + 256 * j), s0 = *(const f32x4*)(sh + 4 * lane + 256 * j);
        const f32x4 h = v[j] * (s1 + 1.0f) + s0;
        st_bf4(hrow + 4 * lane + 256 * j, h);
    }
}

__device__ __forceinline__ void prologue3(const Ctx& F, KP kp) {
    const Args a = ldargs(kp);
    const float* modp = (const float*)(a.ws + WS_MODP); bf16_t* H = (bf16_t*)(a.ws + WS_H);
    const int gw = F.vcu * NWAVES + F.wave, NGW = GRID * NWAVES;
    for (int r = gw; r < MT; r += NGW) {
        const float* xr = (r < TL) ? (a.x + (size_t)r * D) : (a.ctx + (size_t)(r - TL) * D);
        const int bb = bb_of(r);
        f32x4 v[4]; row_load(xr, F.lane, v);
#pragma unroll
        for (int j = 0; j < 4; ++j) {
            const int c = 4 * F.lane + 256 * j;
            f32x4 sh = *(const f32x4*)(a.b_ada + c), sc = *(const f32x4*)(a.b_ada + 1024 + c);
#pragma unroll
            for (int kc = 0; kc < 4; ++kc) { const float* mp = modp + ((size_t)(kc * NL + 0) * 17 + bb) * 6144; sh = sh + *(const f32x4*)(mp + c); sc = sc + *(const f32x4*)(mp + 1024 + c); }
            st_bf4(H + (size_t)r * D + c, v[j] * (sc + 1.0f) + sh);
        }
    }
}

__device__ __forceinline__ void phase_split(const Ctx& F, KP kp, int l) {
    const Args a = ldargs(kp);
    unsigned char* ws = a.ws;
    const bf16_t* Z = (const bf16_t*)(ws + WS_Z);
    float* rstdq = (float*)(ws + WS_RSTDQ); float* rstdkv = (float*)(ws + WS_RSTDKV);
    bf16_t* Km = (bf16_t*)(ws + WS_KM); bf16_t* Qg = (bf16_t*)(ws + WS_QG); bf16_t* Kg = (bf16_t*)(ws + WS_KG); bf16_t* Vg = (bf16_t*)(ws + WS_VG);
    LAS f32x2* t64 = (LAS f32x2*)(F.lds + 65536); LAS f32x2* t32 = (LAS f32x2*)(F.lds + 65536 + 8192);
    __syncthreads();
    for (int i = F.tid; i < 64 * 16; i += NTHREADS) t64[i] = ((const f32x2*)(ws + WS_TAB64))[i];
    if (F.tid < 64 * 8) t32[F.tid] = ((const f32x2*)(ws + WS_TAB32))[F.tid];
    __syncthreads();
    LAS float* zs = (LAS float*)(F.lds + F.wave * 8192);
    const int lane = F.lane, gw = F.vcu * NWAVES + F.wave, NGW = GRID * NWAVES;
    const float ggq = a.g_gq[l * 64 + lane], ggk = a.g_gk[l * 64 + lane];
    u32x4 zn[3];
#define P2_LOAD(rr) do { const u32x4* zr_ = (const u32x4*)(Z + (size_t)(rr) * ZW); _Pragma("unroll") for (int j = 0; j < 3; ++j) zn[j] = zr_[lane + 64 * j]; } while (0)
    if (gw < MT) P2_LOAD(gw);
    for (int r = gw; r < MT; r += NGW) {
#pragma unroll
        for (int j = 0; j < 3; ++j) {
            const int ch = lane + 64 * j; const u32x4 w = zn[j];
            LAS float* d = zs + ch * 8;
            *(LAS f32x4*)d = (f32x4){bflo(w.x), bfhi(w.x), bflo(w.y), bfhi(w.y)};
            *(LAS f32x4*)(d + 4) = (f32x4){bflo(w.z), bfhi(w.z), bflo(w.w), bfhi(w.w)};
        }
        if (r + NGW < MT) P2_LOAD(r + NGW);
        LDS_WAIT();
        const bool lat = r < TL; const int s = r & 2047, gr = s >> 6, gc = s & 63, kr = krow_of(r);
        float sq = 0.f, sk = 0.f;
#pragma unroll
        for (int i = 0; i < 6; ++i) { const float v = zs[lane + 64 * i]; sq += v * v; }
#pragma unroll
        for (int i = 0; i < 4; ++i) { const float v = zs[384 + lane + 64 * i]; sk += v * v; }
        sq = wave_sum(sq); sk = wave_sum(sk);
        if (lane == 0) { rstdq[r] = 1.0f / sqrtf(sq * (1.0f / 384.0f) + RMS_EPS); rstdkv[r] = 1.0f / sqrtf(sk * (1.0f / 256.0f) + RMS_EPS); }
        {
            const int d = lane & 31; const float v = zs[640 + d]; const float pv = lane_xor<8>(v);
            float o = v;
            if (lat) { const int part = d >> 4, f = d & 7, pos = part ? gc : gr; const f32x2 cs = t32[pos * 8 + f]; o = (d & 8) ? (v * cs.x + pv * cs.y) : (v * cs.x - pv * cs.y); }
            const unsigned short ob = (unsigned short)f2bf(o);
#pragma unroll
            for (int i = 0; i < 4; ++i) { const int h = (lane >> 5) + 2 * i; Km[(size_t)kr * QW + h * 96 + 64 + d] = ob; }
        }
#pragma unroll
        for (int h = 0; h < 8; ++h) {
            const float v = zs[672 + 64 * h + lane]; const float ss = wave_sum(v * v);
            const float y = v * (1.0f / sqrtf(ss * (1.0f / 64.0f) + RMS_EPS)) * ggq; const float py = lane_xor<16>(y);
            float o = y;
            if (lat) { const int part = lane >> 5, f = lane & 15, pos = part ? gc : gr; const f32x2 cs = t64[pos * 16 + f]; o = (lane & 16) ? (y * cs.x + py * cs.y) : (y * cs.x - py * cs.y); }
            Qg[(size_t)r * 512 + 64 * h + lane] = (unsigned short)f2bf(o * QSCALE_G);
        }
#pragma unroll
        for (int h = 0; h < 2; ++h) {
            const float v = zs[1184 + 64 * h + lane]; const float ss = wave_sum(v * v);
            const float y = v * (1.0f / sqrtf(ss * (1.0f / 64.0f) + RMS_EPS)) * ggk; const float py = lane_xor<16>(y);
            float o = y;
            if (lat) { const int part = lane >> 5, f = lane & 15, pos = part ? gc : gr; const f32x2 cs = t64[pos * 16 + f]; o = (lane & 16) ? (y * cs.x + py * cs.y) : (y * cs.x - py * cs.y); }
            Kg[(size_t)kr * 128 + 64 * h + lane] = (unsigned short)f2bf(o);
            Vg[(size_t)kr * 128 + 64 * h + lane] = (unsigned short)f2bf(zs[1312 + 64 * h + lane]);
        }
        LDS_WAIT();
    }
}

typedef float f32x4m __attribute__((ext_vector_type(4)));
template <bool XF32>
__device__ __forceinline__ void phase_ln1_route(const Ctx& F, KP kp, int l, int ntok) {
    const Args a = ldargs(kp);
    unsigned char* ws = a.ws;
    const bf16_t* Yo = (const bf16_t*)(ws + WS_U); float* XC = (float*)(ws + WS_XC); bf16_t* H = (bf16_t*)(ws + WS_H);
    bf16_t* XB = (bf16_t*)(ws + WS_XB); constexpr bool xf32 = XF32;
    const float* mod = (const float*)(ws + WS_MOD) + (size_t)l * 17 * 6144;
    int* toke = (int*)(ws + WS_TOKE); int* tokr = (int*)(ws + WS_TOKR); float* tokw = (float*)(ws + WS_TOKW);
    volatile LAS int* cntl = (volatile LAS int*)(F.lds + MISC_CNT);
    const int lane = F.lane;
    __syncthreads();
    if (F.tid < 32) cntl[F.tid] = 0;
    if (F.tid < 36) ((LAS float*)(F.lds + MISC_LG + 2048))[F.tid] = (F.tid < 4) ? a.b_rg[l * 4 + F.tid] : a.b_re[l * 32 + F.tid - 4];
    const int tpb = ntok / GRID;
    {
        f32x4 nx[4]; u32x2 ny[4]; int i = F.wave;
        f32x4 LG[4], LB[4], GA[4], SH[4], SC[4]; int bbc = -1;
#pragma unroll
        for (int j = 0; j < 4; ++j) { LG[j] = *(const f32x4*)(a.ln1_g + l * D + 4 * lane + 256 * j); LB[j] = *(const f32x4*)(a.ln1_b + l * D + 4 * lane + 256 * j); }
        u32x2 nb[4];
#define P6_LOAD(tt) do { const int t_ = (tt); \
        if (xf32) { const float* xp_ = (t_ < TL) ? (a.x + (size_t)t_ * D) : (a.ctx + (size_t)(t_ - TL) * D); row_load(xp_, lane, nx); } \
        else { _Pragma("unroll") for (int j = 0; j < 4; ++j) nb[j] = *(const u32x2*)(XB + (size_t)t_ * D + 4 * lane + 256 * j); } \
        _Pragma("unroll") for (int j = 0; j < 4; ++j) ny[j] = *(const u32x2*)(Yo + (size_t)t_ * D + 4 * lane + 256 * j); } while (0)
        if (i < tpb) P6_LOAD(F.bk * tpb + i);
        for (; i < tpb; i += NWAVES) {
            const int t = F.bk * tpb + i, bb = bb_of(t);
            if (bb != bbc) {
                bbc = bb;
#pragma unroll
                for (int j = 0; j < 4; ++j) { const int c = 4 * lane + 256 * j; GA[j] = *(const f32x4*)(mod + (size_t)(bb * 6 + 2) * D + c);
                    SH[j] = *(const f32x4*)(mod + (size_t)(bb * 6 + 3) * D + c); SC[j] = *(const f32x4*)(mod + (size_t)(bb * 6 + 4) * D + c); }
            }
            f32x4 v[4];
#pragma unroll
            for (int j = 0; j < 4; ++j) { const f32x4 y = {bflo(ny[j].x), bfhi(ny[j].x), bflo(ny[j].y), bfhi(ny[j].y)};
                const f32x4 xv = xf32 ? nx[j] : (f32x4){bflo(nb[j].x), bfhi(nb[j].x), bflo(nb[j].y), bfhi(nb[j].y)}; v[j] = xv * ALPHA + GA[j] * y; }
            if (i + NWAVES < tpb) P6_LOAD(t + NWAVES);
            row_ln_reg(v, LG, LB);
#pragma unroll
            for (int j = 0; j < 4; ++j) st_bf4(XB + (size_t)t * D + 4 * lane + 256 * j, v[j]);
#pragma unroll
            for (int j = 0; j < 4; ++j) {
                const f32x4 h = v[j] * (SC[j] + 1.0f) + SH[j];
                st_bf4(H + (size_t)t * D + 4 * lane + 256 * j, h);
            }
        }
    }
#undef P6_LOAD
    asm volatile("s_waitcnt vmcnt(0)" ::: "memory");
    __syncthreads();
    {
        const bf16_t* wrh = (const bf16_t*)(ws + WS_WR) + (size_t)(l * 2) * 48 * D; const bf16_t* wrl = wrh + (size_t)48 * D;
        LAS float* lg = (LAS float*)(F.lds + F.wave * 4096);
        const LAS float* bias = (const LAS float*)(F.lds + MISC_LG + 2048);
        const int fr = lane & 15, fq = lane >> 4;
        for (int g = F.wave; g < tpb / 16; g += NWAVES) {
            const int t0 = F.bk * tpb + g * 16;
            const bf16_t* hh = H + (size_t)(t0 + fr) * D + 8 * fq;
            f32x4m acc0 = {0.f, 0.f, 0.f, 0.f}, acc1 = acc0, acc2 = acc0;
#pragma unroll 2
            for (int ks = 0; ks < 32; ++ks) {
                const bf16x8 bh = *(const bf16x8*)(hh + 32 * ks);
                const bf16_t* wp = wrh + (size_t)fr * D + 32 * ks + 8 * fq; const bf16_t* wq = wrl + (size_t)fr * D + 32 * ks + 8 * fq;
                const bf16x8 a0h = *(const bf16x8*)(wp), a1h = *(const bf16x8*)(wp + 16 * D), a2h = *(const bf16x8*)(wp + 32 * D);
                const bf16x8 a0l = *(const bf16x8*)(wq), a1l = *(const bf16x8*)(wq + 16 * D), a2l = *(const bf16x8*)(wq + 32 * D);
                acc0 = __builtin_amdgcn_mfma_f32_16x16x32_bf16(a0h, bh, acc0, 0, 0, 0); acc1 = __builtin_amdgcn_mfma_f32_16x16x32_bf16(a1h, bh, acc1, 0, 0, 0); acc2 = __builtin_amdgcn_mfma_f32_16x16x32_bf16(a2h, bh, acc2, 0, 0, 0);
                acc0 = __builtin_amdgcn_mfma_f32_16x16x32_bf16(a0l, bh, acc0, 0, 0, 0); acc1 = __builtin_amdgcn_mfma_f32_16x16x32_bf16(a1l, bh, acc1, 0, 0, 0); acc2 = __builtin_amdgcn_mfma_f32_16x16x32_bf16(a2l, bh, acc2, 0, 0, 0);
            }
#pragma unroll
            for (int r = 0; r < 4; ++r) { lg[fr * 48 + 4 * fq + r] = acc0[r]; lg[fr * 48 + 16 + 4 * fq + r] = acc1[r]; lg[fr * 48 + 32 + 4 * fq + r] = acc2[r]; }
            LDS_WAIT();
            if (lane < 16) {
                const int t = t0 + lane; const LAS float* q = lg + lane * 48;
                float l4[4];
#pragma unroll
                for (int o = 0; o < 4; ++o) l4[o] = q[o] + bias[o];
                int gs = 0; float gm = l4[0];
#pragma unroll
                for (int o = 1; o < 4; ++o) if (l4[o] > gm) { gm = l4[o]; gs = o; }
                float den = 0.f;
#pragma unroll
                for (int o = 0; o < 4; ++o) den += expf(l4[o] - gm);
                const float pstar = 1.0f / den;
                float le[8];
#pragma unroll
                for (int o = 0; o < 8; ++o) le[o] = q[4 + gs * 8 + o] + bias[4 + gs * 8 + o];
                int i1 = 0; float v1 = le[0];
#pragma unroll
                for (int o = 1; o < 8; ++o) if (le[o] > v1) { v1 = le[o]; i1 = o; }
                int i2 = -1; float v2 = -3.0e38f;
#pragma unroll
                for (int o = 0; o < 8; ++o) if (o != i1 && le[o] > v2) { v2 = le[o]; i2 = o; }
                const float ex = expf(v2 - v1), w1 = pstar / (1.0f + ex), w2 = pstar * ex / (1.0f + ex);
                const int e1 = gs * 8 + i1, e2 = gs * 8 + i2;
                const int r1 = __hip_atomic_fetch_add((LAS int*)(F.lds + MISC_CNT) + e1, 1, __ATOMIC_RELAXED, __HIP_MEMORY_SCOPE_WORKGROUP);
                const int r2 = __hip_atomic_fetch_add((LAS int*)(F.lds + MISC_CNT) + e2, 1, __ATOMIC_RELAXED, __HIP_MEMORY_SCOPE_WORKGROUP);
                toke[2 * t] = e1; toke[2 * t + 1] = e2; tokr[2 * t] = r1; tokr[2 * t + 1] = r2; tokw[2 * t] = w1; tokw[2 * t + 1] = w2;
            }
            LDS_WAIT();
        }
    }
    __syncthreads();
    if (F.tid < 32) ((int*)(ws + WS_BLKCNT))[((size_t)l * 256 + F.bk) * 32 + F.tid] = cntl[F.tid];
}

__device__ __forceinline__ void moe_tables(const Ctx& F, KP kp, int l, bool publish) {
    const Args a = ldargs(kp);
    const int* blkcnt = (const int*)(a.ws + WS_BLKCNT) + (size_t)l * 256 * 32;
    volatile LAS int* pa = (volatile LAS int*)(F.lds + MISC_PA); volatile LAS int* pb = (volatile LAS int*)(F.lds + MISC_PB);
    volatile LAS int* tot = (volatile LAS int*)(F.lds + MISC_TOT); volatile LAS int* base = (volatile LAS int*)(F.lds + MISC_BASE); volatile LAS int* poff = (volatile LAS int*)(F.lds + MISC_POFF);
    __syncthreads();
    {
        const int e = F.tid & 31, part = F.tid >> 5; int sa = 0, sb = 0;
        for (int j = 0; j < 16; ++j) { const int b2 = part * 16 + j; const int c = blkcnt[b2 * 32 + e]; sa += c; sb += (b2 < F.bk) ? c : 0; }
        pa[part * 32 + e] = sa; pb[part * 32 + e] = sb;
    }
    __syncthreads();
    if (F.tid < 32) { int sa = 0, sb = 0; for (int p = 0; p < 16; ++p) { sa += pa[p * 32 + F.tid]; sb += pb[p * 32 + F.tid]; } tot[F.tid] = sa; base[F.tid] = sb; }
    __syncthreads();
    if (F.tid == 0) { int o = 0; for (int e = 0; e < 32; ++e) { poff[e] = o; o += (tot[e] + 255) & ~255; } poff[32] = o; }
    __syncthreads();
    if (publish && F.bk == 0 && F.tid < 33) ((int*)(a.ws + WS_MOETAB))[l * 128 + F.tid] = poff[F.tid];
}

__device__ __forceinline__ void phase_dispatch(const Ctx& F, KP kp, int l, int ntok) {
    const Args a = ldargs(kp);
    unsigned char* ws = a.ws;
    if (l > 0) conv_experts(F, a, l, -1);
    moe_tables(F, kp, l, true);
    volatile LAS int* base = (volatile LAS int*)(F.lds + MISC_BASE); volatile LAS int* poff = (volatile LAS int*)(F.lds + MISC_POFF); volatile LAS int* tot = (volatile LAS int*)(F.lds + MISC_TOT);
    const int* toke = (const int*)(ws + WS_TOKE); const int* tokr = (const int*)(ws + WS_TOKR); int* tokp = (int*)(ws + WS_TOKP); int* postok = (int*)(ws + WS_POSTOK);
    const int tpb = ntok / GRID;
    if (F.tid < tpb) {
        const int t = F.bk * tpb + F.tid;
        const int2 e = *(const int2*)(toke + 2 * t), r = *(const int2*)(tokr + 2 * t);
        const int p1 = poff[e.x] + base[e.x] + r.x, p2 = poff[e.y] + base[e.y] + r.y;
        *(int2*)(tokp + 2 * t) = (int2){p1, p2};
        postok[p1] = t; postok[p2] = t;
    }
    { const int idx = F.bk * NTHREADS + F.tid;
      if (idx < poff[32]) { int e = 0;
#pragma unroll
          for (int j = 1; j < 32; ++j) e += (poff[j] <= idx) ? 1 : 0;
          if (idx >= poff[e] + tot[e]) postok[idx] = 0; } }
}

__device__ __forceinline__ void phase_ln2(const Ctx& F, KP kp, int l, int ntok, bool dry = false) {
    const Args a = ldargs(kp);
    unsigned char* ws = a.ws;
    const bf16_t* Ys = (const bf16_t*)(ws + WS_XS); float* XC = (float*)(ws + WS_XC); bf16_t* H = (bf16_t*)(ws + WS_H);
    const float* mod = (const float*)(ws + WS_MOD) + (size_t)l * 17 * 6144;
    const float* modn = (const float*)(ws + WS_MOD) + (size_t)(l + 1 < NL ? l + 1 : l) * 17 * 6144;
    const int* tokp = (const int*)(ws + WS_TOKP); const float* tokw = (const float*)(ws + WS_TOKW);
    const int gw = F.vcu * NWAVES + F.wave, NGW = GRID * NWAVES, lane = F.lane;
    const int per = ntok / NGW, t0 = gw * per, t1 = t0 + per;
    f32x4 LG[4], LB[4], GF[4], SH[4], SC[4];
#pragma unroll
    for (int j = 0; j < 4; ++j) { LG[j] = *(const f32x4*)(a.ln2_g + l * D + 4 * lane + 256 * j); LB[j] = *(const f32x4*)(a.ln2_b + l * D + 4 * lane + 256 * j); }
    int bbc = -1;
    int2 pn = {0, 0}; float2 wn = {0.f, 0.f};
    u32x2 xn[4], yan[4], ybn[4]; bf16_t* XB = (bf16_t*)(ws + WS_XB);
#define P10_REC(tt) do { pn = *(const int2*)(tokp + 2 * (tt)); wn = *(const float2*)(tokw + 2 * (tt)); } while (0)
#define P10_ROWS(tt, p_) do { const int t_ = (tt); _Pragma("unroll") for (int j = 0; j < 4; ++j) xn[j] = *(const u32x2*)(XB + (size_t)t_ * D + 4 * lane + 256 * j); \
        _Pragma("unroll") for (int j = 0; j < 4; ++j) { yan[j] = *(const u32x2*)(Ys + (size_t)(p_).x * D + 4 * lane + 256 * j); ybn[j] = *(const u32x2*)(Ys + (size_t)(p_).y * D + 4 * lane + 256 * j); } } while (0)
    float2 wc = {0.f, 0.f};
    P10_REC(t0); wc = wn; P10_ROWS(t0, pn); if (t0 + 1 < t1) P10_REC(t0 + 1);
    for (int t = t0; t < t1; ++t) {
        const int bb = bb_of(t);
        if (bb != bbc) {
            bbc = bb;
#pragma unroll
            for (int j = 0; j < 4; ++j) { const int c = 4 * lane + 256 * j; GF[j] = *(const f32x4*)(mod + (size_t)(bb * 6 + 5) * D + c);
                SH[j] = *(const f32x4*)(modn + (size_t)(bb * 6 + 0) * D + c); SC[j] = *(const f32x4*)(modn + (size_t)(bb * 6 + 1) * D + c); }
        }
        f32x4 v[4]; u32x2 ya[4], yb[4];
#pragma unroll
        for (int j = 0; j < 4; ++j) { v[j] = (f32x4){bflo(xn[j].x), bfhi(xn[j].x), bflo(xn[j].y), bfhi(xn[j].y)}; ya[j] = yan[j]; yb[j] = ybn[j]; }
        const float w1 = wc.x, w2 = wc.y;
        if (t + 1 < t1) { wc = wn; P10_ROWS(t + 1, pn); if (t + 2 < t1) P10_REC(t + 2); }
#pragma unroll
        for (int j = 0; j < 4; ++j) {
            const f32x4 y = (f32x4){bflo(ya[j].x), bfhi(ya[j].x), bflo(ya[j].y), bfhi(ya[j].y)} * w1 + (f32x4){bflo(yb[j].x), bfhi(yb[j].x), bflo(yb[j].y), bfhi(yb[j].y)} * w2;
            v[j] = v[j] * ALPHA + GF[j] * y;
        }
        row_ln_reg(v, LG, LB);
        if (l + 1 < NL) {
#pragma unroll
            for (int j = 0; j < 4; ++j) st_bf4(XB + (size_t)t * D + 4 * lane + 256 * j, v[j]);
        } else {
#pragma unroll
            for (int j = 0; j < 4; ++j) *(f32x4*)(a.out + (size_t)t * D + 4 * lane + 256 * j) = v[j];
        }
        if (l + 1 < NL) { bf16_t* hrow = H + (size_t)t * D;
#pragma unroll
            for (int j = 0; j < 4; ++j) st_bf4(hrow + 4 * lane + 256 * j, v[j] * (SC[j] + 1.0f) + SH[j]); }
    }
#undef P10_REC
#undef P10_ROWS
}

template <int QD>
__device__ __forceinline__ void attn_naive_task(const bf16_t* qp, const bf16_t* kp, int kstride, const bf16_t* vp, int vstride, int nkeys, bf16_t* op) {
    u32x4 qv[QD / 8];
#pragma unroll
    for (int i = 0; i < QD / 8; ++i) qv[i] = *(const u32x4*)(qp + 8 * i);
#pragma unroll 1
    for (int half = 0; half < 2; ++half) {
        float o[32];
#pragma unroll
        for (int i = 0; i < 32; ++i) o[i] = 0.f;
        float m = -1.0e30f, lsum = 0.f;
#pragma unroll 1
        for (int j = 0; j < nkeys; ++j) {
            const u32x4* kr = (const u32x4*)(kp + (size_t)j * kstride);
            float s = 0.f;
#pragma unroll
            for (int i = 0; i < QD / 8; ++i) s = dot8(qv[i], kr[i], s);
            if (s > m) { const float al = __builtin_amdgcn_exp2f(m - s); lsum *= al;
#pragma unroll
                for (int i = 0; i < 32; ++i) o[i] *= al;
                m = s; }
            const float p = __builtin_amdgcn_exp2f(s - m); lsum += p;
            const u32x4* vr = (const u32x4*)(vp + (size_t)j * vstride + 32 * half);
#pragma unroll
            for (int i = 0; i < 4; ++i) { const u32x4 w = vr[i];
                o[8 * i + 0] += p * bflo(w.x); o[8 * i + 1] += p * bfhi(w.x); o[8 * i + 2] += p * bflo(w.y); o[8 * i + 3] += p * bfhi(w.y); o[8 * i + 4] += p * bflo(w.z); o[8 * i + 5] += p * bfhi(w.z); o[8 * i + 6] += p * bflo(w.w); o[8 * i + 7] += p * bfhi(w.w); }
        }
        const float rl = 1.0f / lsum;
#pragma unroll
        for (int i = 0; i < 4; ++i) { u32x4 w; w.x = pk2(o[8 * i] * rl, o[8 * i + 1] * rl); w.y = pk2(o[8 * i + 2] * rl, o[8 * i + 3] * rl); w.z = pk2(o[8 * i + 4] * rl, o[8 * i + 5] * rl); w.w = pk2(o[8 * i + 6] * rl, o[8 * i + 7] * rl); *(u32x4*)(op + 32 * half + 8 * i) = w; }
    }
}
__device__ __forceinline__ void phase_attn_naive(const Ctx& F, KP kp, bool last) {
    const Args a = ldargs(kp);
    unsigned char* ws = a.ws;
    const bf16_t* Qm = (const bf16_t*)(ws + WS_QM); const bf16_t* Km = (const bf16_t*)(ws + WS_KM); const bf16_t* Vm = (const bf16_t*)(ws + WS_VM);
    const bf16_t* Qg = (const bf16_t*)(ws + WS_QG); const bf16_t* Kg = (const bf16_t*)(ws + WS_KG); const bf16_t* Vg = (const bf16_t*)(ws + WS_VG);
    bf16_t* O = (bf16_t*)(ws + WS_O);
    const int gw = F.vcu * NWAVES + F.wave, NGW = GRID * NWAVES;
    const int ntask = 8192 + (last ? 0 : 1024);
    for (int T = gw; T < ntask; T += NGW) {
        int b, h16, r, nkeys;
        if (T < 8192) { const int qw = T & 31; h16 = (T >> 5) & 15; b = T >> 9; r = b * SEQ + 64 * qw + F.lane; nkeys = KPB; }
        else { const int T2 = T - 8192, qw = T2 & 3; h16 = (T2 >> 2) & 15; b = T2 >> 6; r = TL + b * CTX + 64 * qw + F.lane; nkeys = CTX; }
        bf16_t* op = O + (size_t)r * D + h16 * 64;
        if (h16 < 8) attn_naive_task<96>(Qm + (size_t)r * QW + h16 * 96, Km + (size_t)b * KPB * QW + h16 * 96, QW, Vm + (size_t)b * KPB * 512 + h16 * 64, 512, nkeys, op);
        else { const int hh = h16 - 8, kvh = hh >> 2; attn_naive_task<64>(Qg + (size_t)r * 512 + hh * 64, Kg + (size_t)b * KPB * 128 + kvh * 64, 128, Vg + (size_t)b * KPB * 128 + kvh * 64, 128, nkeys, op); }
    }
}

typedef float f32x16 __attribute__((ext_vector_type(16)));
typedef short s16x4 __attribute__((ext_vector_type(4)));
__device__ __forceinline__ s16x4 vtr(const LAS unsigned char* p) { return __builtin_bit_cast(s16x4, __builtin_amdgcn_ds_read_tr16_b64_v4i16((LAS s16x4*)p)); }
__device__ __forceinline__ unsigned cvtpk(float lo, float hi) { typedef __bf16 bf2 __attribute__((ext_vector_type(2))); f32x2 v = {lo, hi}; bf2 b = __builtin_convertvector(v, bf2); return __builtin_bit_cast(unsigned, b); }
constexpr float ATT_THR = 6.0f;
constexpr int ATT_KSLOT = 12288, ATT_VSLOT = 8192, ATT_NKS = 3, ATT_NVS = 4, ATT_V0 = ATT_NKS * ATT_KSLOT;
__device__ __forceinline__ void att_glds16(const void* gsrc, unsigned lds_dst) { unsigned keep;
    asm volatile("s_mov_b32 %0, m0\n\ts_mov_b32 m0, %2\n\ts_nop 0\n\tglobal_load_lds_dwordx4 %1, off\n\ts_mov_b32 m0, %0" : "=&s"(keep) : "v"(gsrc), "s"(lds_dst) : "memory"); }
#define ATT_WAITBAR(N) asm volatile("s_waitcnt vmcnt(" #N ") lgkmcnt(0)\n\ts_barrier" ::: "memory")
template <int QD>
__device__ __forceinline__ void attn_unit(LAS unsigned char* lds, int tid, const bf16_t* Kb, int kstride, const bf16_t* Vb, int vstride, int ntiles, const bf16_t* qrow, bf16_t* orow) {
    constexpr int NC = QD / 8, NS = QD / 16;
    const int lane = tid & 63, r32 = lane & 31, hi = lane >> 5;
    const int w = __builtin_amdgcn_readfirstlane(tid >> 6);
    const bool three = (NC == 12) && (w < 4);
    const int vp = (NC == 12) ? (w < 4 ? w + 4 : w - 4) : w;
    const bf16_t* ksrcA = Kb + (size_t)lane * kstride + w * 8;
    const bf16_t* ksrcB = Kb + (size_t)lane * kstride + (w + 8) * 8;
    const bf16_t* vsrc = Vb + (size_t)(16 * (vp & 3) + (lane >> 2)) * vstride + (vp >> 2) * 32 + (lane & 3) * 8;
    const size_t kstep = (size_t)64 * kstride, vstep = (size_t)64 * vstride;
    const unsigned lds0 = (unsigned)(size_t)lds;
#define ATT_DMA(t_, ks_, vs_) do { \
        att_glds16(ksrcA + (size_t)(t_) * kstep, (unsigned)__builtin_amdgcn_readfirstlane((int)(lds0 + (ks_) * ATT_KSLOT + w * 1024))); \
        if (three) att_glds16(ksrcB + (size_t)(t_) * kstep, (unsigned)__builtin_amdgcn_readfirstlane((int)(lds0 + (ks_) * ATT_KSLOT + (w + 8) * 1024))); \
        att_glds16(vsrc + (size_t)(t_) * vstep, (unsigned)__builtin_amdgcn_readfirstlane((int)(lds0 + ATT_V0 + (vs_) * ATT_VSLOT + vp * 1024))); } while (0)
    ATT_DMA(0, 0, 0);
    if (ntiles > 1) ATT_DMA(1, 1, 1);
    bf16x8 qr[NS];
#pragma unroll
    for (int s = 0; s < NS; ++s) qr[s] = *(const bf16x8*)(qrow + 16 * s + 8 * hi);
    f32x16 o0, o1, negm, p0, p1;
#pragma unroll
    for (int r = 0; r < 16; ++r) { o0[r] = 0.f; o1[r] = 0.f; negm[r] = 0.f; p0[r] = 0.f; p1[r] = 0.f; }
    float lsum = 0.f;
    const int kread = hi * 1024 + r32 * 16;
    const int vread = ATT_V0 + ((lane >> 4) & 1) * 32 + (lane & 3) * 8 + (4 * hi + ((lane & 15) >> 2)) * 64;
#define ATT_QK(ks_) do { const LAS unsigned char* kb_ = lds + (ks_) * ATT_KSLOT + kread; \
        _Pragma("unroll") for (int s = 0; s < NS; ++s) { \
            const bf16x8 a0 = *(const LAS bf16x8*)(kb_ + s * 2048), a1 = *(const LAS bf16x8*)(kb_ + s * 2048 + 512); \
            if (s == 0) { p0 = __builtin_amdgcn_mfma_f32_32x32x16_bf16(a0, qr[0], negm, 0, 0, 0); p1 = __builtin_amdgcn_mfma_f32_32x32x16_bf16(a1, qr[0], negm, 0, 0, 0); } \
            else { p0 = __builtin_amdgcn_mfma_f32_32x32x16_bf16(a0, qr[s], p0, 0, 0, 0); p1 = __builtin_amdgcn_mfma_f32_32x32x16_bf16(a1, qr[s], p1, 0, 0, 0); } } } while (0)
#define ATT_SOFT_PV(first_, vs_) do { \
        float mx = fmaxf(fmaxf(p0[0], p1[0]), p0[1]); \
        _Pragma("unroll") for (int r = 1; r < 16; ++r) mx = (r == 1) ? fmaxf(mx, p1[1]) : fmaxf(fmaxf(mx, p0[r]), p1[r]); \
        { auto rr = __builtin_amdgcn_permlane32_swap(__float_as_uint(mx), __float_as_uint(mx), false, false); mx = fmaxf(__uint_as_float(rr[0]), __uint_as_float(rr[1])); } \
        if ((first_) || __any(mx > ATT_THR)) { \
            const float dl = (first_) ? mx : fmaxf(mx, 0.f); \
            _Pragma("unroll") for (int r = 0; r < 16; ++r) { p0[r] -= dl; p1[r] -= dl; negm[r] -= dl; } \
            if (!(first_)) { const float f = __builtin_amdgcn_exp2f(-dl); lsum *= f; \
                _Pragma("unroll") for (int r = 0; r < 16; ++r) { o0[r] *= f; o1[r] *= f; } } \
        } \
        float rs = 0.f; \
        _Pragma("unroll") for (int r = 0; r < 16; ++r) { p0[r] = __builtin_amdgcn_exp2f(p0[r]); p1[r] = __builtin_amdgcn_exp2f(p1[r]); rs += p0[r] + p1[r]; } \
        lsum += rs; \
        u32x4 w0, w1, w2, w3; \
        w0.x = cvtpk(p0[0], p0[1]); w0.y = cvtpk(p0[2], p0[3]); w0.z = cvtpk(p0[4], p0[5]); w0.w = cvtpk(p0[6], p0[7]); \
        w1.x = cvtpk(p0[8], p0[9]); w1.y = cvtpk(p0[10], p0[11]); w1.z = cvtpk(p0[12], p0[13]); w1.w = cvtpk(p0[14], p0[15]); \
        w2.x = cvtpk(p1[0], p1[1]); w2.y = cvtpk(p1[2], p1[3]); w2.z = cvtpk(p1[4], p1[5]); w2.w = cvtpk(p1[6], p1[7]); \
        w3.x = cvtpk(p1[8], p1[9]); w3.y = cvtpk(p1[10], p1[11]); w3.z = cvtpk(p1[12], p1[13]); w3.w = cvtpk(p1[14], p1[15]); \
        const bf16x8 pa0 = __builtin_bit_cast(bf16x8, w0), pa1 = __builtin_bit_cast(bf16x8, w1), pa2 = __builtin_bit_cast(bf16x8, w2), pa3 = __builtin_bit_cast(bf16x8, w3); \
        const LAS unsigned char* vb_ = lds + (vs_) * ATT_VSLOT + vread; \
        o0 = __builtin_amdgcn_mfma_f32_32x32x16_bf16(ATT_VF(0, 0), pa0, o0, 0, 0, 0); \
        o1 = __builtin_amdgcn_mfma_f32_32x32x16_bf16(ATT_VF(1, 0), pa0, o1, 0, 0, 0); \
        o0 = __builtin_amdgcn_mfma_f32_32x32x16_bf16(ATT_VF(0, 1), pa1, o0, 0, 0, 0); \
        o1 = __builtin_amdgcn_mfma_f32_32x32x16_bf16(ATT_VF(1, 1), pa1, o1, 0, 0, 0); \
        o0 = __builtin_amdgcn_mfma_f32_32x32x16_bf16(ATT_VF(0, 2), pa2, o0, 0, 0, 0); \
        o1 = __builtin_amdgcn_mfma_f32_32x32x16_bf16(ATT_VF(1, 2), pa2, o1, 0, 0, 0); \
        o0 = __builtin_amdgcn_mfma_f32_32x32x16_bf16(ATT_VF(0, 3), pa3, o0, 0, 0, 0); \
        o1 = __builtin_amdgcn_mfma_f32_32x32x16_bf16(ATT_VF(1, 3), pa3, o1, 0, 0, 0); } while (0)
#define ATT_VF(d0, ks) ({ const s16x4 lo_ = vtr(vb_ + (d0) * 4096 + (ks) * 1024), hi_ = vtr(vb_ + (d0) * 4096 + (ks) * 1024 + 512); (bf16x8){lo_[0], lo_[1], lo_[2], lo_[3], hi_[0], hi_[1], hi_[2], hi_[3]}; })
#define ATT_ENDSTEP() do { if (issue) { if (three) ATT_WAITBAR(3); else ATT_WAITBAR(2); } else ATT_WAITBAR(0); \
        ks = (ks == ATT_NKS - 1) ? 0 : ks + 1; vs = (vs + 1) & (ATT_NVS - 1); } while (0)
    if (ntiles > 1) { if (three) ATT_WAITBAR(3); else ATT_WAITBAR(2); } else ATT_WAITBAR(0);
    int ks = 0, vs = 0;
    if (w < 4) {
        for (int t = 0; t < ntiles; ++t) {
            const bool issue = (t + 2 < ntiles);
            if (issue) ATT_DMA(t + 2, (ks >= 1) ? ks - 1 : ATT_NKS - 1, (vs + 2) & (ATT_NVS - 1));
            ATT_QK(ks);
            ATT_SOFT_PV(t == 0, vs);
            ATT_ENDSTEP();
        }
    } else {
        for (int t = 0; t < ntiles; ++t) {
            const bool issue = (t + 2 < ntiles);
            if (issue) ATT_DMA(t + 2, (ks >= 1) ? ks - 1 : ATT_NKS - 1, (vs + 2) & (ATT_NVS - 1));
            if (t > 0) ATT_SOFT_PV(t == 1, (vs + ATT_NVS - 1) & (ATT_NVS - 1));
            ATT_QK(ks);
            ATT_ENDSTEP();
        }
        ATT_SOFT_PV(ntiles == 1, (vs + ATT_NVS - 1) & (ATT_NVS - 1));
    }
#undef ATT_DMA
#undef ATT_QK
#undef ATT_SOFT_PV
#undef ATT_VF
#undef ATT_ENDSTEP
    { auto rr = __builtin_amdgcn_permlane32_swap(__float_as_uint(lsum), __float_as_uint(lsum), false, false); lsum = __uint_as_float(rr[0]) + __uint_as_float(rr[1]); }
    const float rl = 1.0f / lsum;
#pragma unroll
    for (int g = 0; g < 4; ++g) {
        u32x2 a, b2;
        a.x = cvtpk(o0[4 * g] * rl, o0[4 * g + 1] * rl); a.y = cvtpk(o0[4 * g + 2] * rl, o0[4 * g + 3] * rl);
        b2.x = cvtpk(o1[4 * g] * rl, o1[4 * g + 1] * rl); b2.y = cvtpk(o1[4 * g + 2] * rl, o1[4 * g + 3] * rl);
        *(u32x2*)(orow + 8 * g + 4 * hi) = a; *(u32x2*)(orow + 32 + 8 * g + 4 * hi) = b2;
    }
    asm volatile("s_waitcnt lgkmcnt(0)\n\ts_barrier" ::: "memory");
}
__device__ __forceinline__ void phase_attn(const Ctx& F, KP kp, bool last) {
    const Args a = ldargs(kp);
    unsigned char* ws = a.ws;
    const bf16_t* Qm = (const bf16_t*)(ws + WS_QM); const bf16_t* Km = (const bf16_t*)(ws + WS_KM); const bf16_t* Vm = (const bf16_t*)(ws + WS_VM);
    const bf16_t* Qg = (const bf16_t*)(ws + WS_QG); const bf16_t* Kg = (const bf16_t*)(ws + WS_KG); const bf16_t* Vg = (const bf16_t*)(ws + WS_VG);
    bf16_t* O = (bf16_t*)(ws + WS_O);
    const int xcd = F.vcu >> 5, cix = F.vcu & 31, r32 = F.lane & 31, w = F.wave;
    const int nun = last ? 8 : 9;
    for (int i = 0; i < nun; ++i) {
        if (i < 8 && (i & 1) == 0) {
            const int pair = xcd * 16 + (i >> 1) * 4 + (cix >> 3), b = pair >> 3, h = pair & 7, qb = cix & 7;
            const int row = b * SEQ + qb * 256 + w * 32 + r32;
            attn_unit<96>(F.lds, F.tid, Km + (size_t)b * KPB * QW + h * 96, QW, Vm + (size_t)b * KPB * 512 + h * 64, 512, KPB / 64, Qm + (size_t)row * QW + h * 96, O + (size_t)row * D + h * 64);
        } else if (i < 8) {
            const int pair = xcd * 4 + (i >> 1), b = pair >> 1, kvh = pair & 1, hh = kvh * 4 + (w >> 1);
            const int row = b * SEQ + cix * 64 + (w & 1) * 32 + r32;
            attn_unit<64>(F.lds, F.tid, Kg + (size_t)b * KPB * 128 + kvh * 64, 128, Vg + (size_t)b * KPB * 128 + kvh * 64, 128, KPB / 64, Qg + (size_t)row * 512 + hh * 64, O + (size_t)row * D + 512 + hh * 64);
        } else if (F.vcu < 128) {
            const int b = F.vcu >> 3, h = F.vcu & 7, row = TL + b * CTX + w * 32 + r32;
            attn_unit<96>(F.lds, F.tid, Km + (size_t)b * KPB * QW + h * 96, QW, Vm + (size_t)b * KPB * 512 + h * 64, 512, CTX / 64, Qm + (size_t)row * QW + h * 96, O + (size_t)row * D + h * 64);
        } else {
            const int idx = F.vcu - 128, b = idx >> 3, kvh = (idx >> 2) & 1, qb = idx & 3, hh = kvh * 4 + (w >> 1);
            const int row = TL + b * CTX + qb * 64 + (w & 1) * 32 + r32;
            attn_unit<64>(F.lds, F.tid, Kg + (size_t)b * KPB * 128 + kvh * 64, 128, Vg + (size_t)b * KPB * 128 + kvh * 64, 128, CTX / 64, Qg + (size_t)row * 512 + hh * 64, O + (size_t)row * D + 512 + hh * 64);
        }
    }
}
__global__ void __launch_bounds__(NTHREADS, 2) fwd_kernel(Args a_unused) {
    extern __shared__ __attribute__((aligned(16))) unsigned char lds_raw[];
    const KP kp = (KP)__builtin_amdgcn_kernarg_segment_ptr();
    Ctx F;
    F.lds = (LAS unsigned char*)lds_raw;
    F.tid = threadIdx.x; F.lane = F.tid & 63; F.wave = __builtin_amdgcn_readfirstlane(F.tid >> 6);
    F.bk = blockIdx.x; F.vcu = (F.bk & 7) * (GRID / 8) + (F.bk >> 3);
    if (F.tid < 4) ((volatile LAS unsigned*)(F.lds + MISC_BAR))[F.tid] = 0u;
    __syncthreads();
    { const Args a = ldargs(kp); (void)xcd_barrier_post((unsigned*)(a.ws + WS_CTL), (volatile LAS unsigned*)(F.lds + MISC_BAR), F.tid == 0); }
#define FRESH() do { int ln_; asm volatile("v_mbcnt_lo_u32_b32 %0, -1, 0\n\tv_mbcnt_hi_u32_b32 %0, -1, %0" : "=v"(ln_)); F.lane = ln_; F.tid = F.wave * 64 + ln_; F.bk = blockIdx.x; F.vcu = (F.bk & 7) * (GRID / 8) + (F.bk >> 3); } while (0)
#define GRID_BAR() do { XcdBarrier b_; { const Args a_ = ldargs(kp); b_.bar = (unsigned*)(a_.ws + WS_CTL); } b_.x = xb_xcc_id(); b_.st = (volatile LAS unsigned*)(F.lds + MISC_BAR); xcd_barrier(b_, F.tid == 0); } while (0)

    for (int rep_ = 0; rep_ < REP_PRO; ++rep_) prologue1(F, kp);
    GRID_BAR(); FRESH();
    prologue2(F, kp);
    prologue3(F, kp);
    GRID_BAR(); FRESH();

    for (int l = 0; l < NL; ++l) {
        const bool last = (l == NL - 1);
        const int ntok = last ? TL : MT;
        { const Args a = ldargs(kp); unsigned char* ws = a.ws;
          Gemm g{(const bf16_t*)(ws + WS_H), D, (const bf16_t*)(ws + WS_WIN) + (size_t)l * ZW * D, D}; StaticOrder S; S.init(MT, ZW, GRID, F.bk); EpiZ E{(bf16_t*)(ws + WS_Z)}; gemm_phase<0>(F, g, S, E); }
        if (F.bk >= (MT / 256) * (ZW / 256) - 3 * GRID) conv_filler(F, kp, l, FILL_P1);
        GRID_BAR(); FRESH();
        for (int rep_ = 0; rep_ < REP_P2; ++rep_) phase_split(F, kp, l);
        GRID_BAR(); FRESH();
        { const Args a = ldargs(kp); unsigned char* ws = a.ws;
          Gemm g{(const bf16_t*)(ws + WS_Z), ZW, (const bf16_t*)(ws + WS_WQ) + (size_t)l * QW * 384, 384}; StaticOrder S; S.init(MT, QW, GRID, F.bk);
          EpiQ E{(bf16_t*)(ws + WS_QM), (const float*)(ws + WS_RSTDQ), (const f32x2*)(ws + WS_TAB32)}; gemm_phase<1>(F, g, S, E); }
        FRESH();
        { const Args a = ldargs(kp); unsigned char* ws = a.ws;
          Gemm g{(const bf16_t*)(ws + WS_Z) + 384, ZW, (const bf16_t*)(ws + WS_WKV) + (size_t)l * KVW * 256, 256}; StaticOrder S; S.init(MT, KVW, GRID, (F.bk + 80) & 255);
          EpiKV E{(bf16_t*)(ws + WS_KM), (bf16_t*)(ws + WS_VM), (const float*)(ws + WS_RSTDKV)}; gemm_phase<2>(F, g, S, E); }
        GRID_BAR(); FRESH();
#if USE_MFMA_ATTN
        for (int rep_ = 0; rep_ < REP_ATTN; ++rep_) phase_attn(F, kp, last);
#else
        phase_attn_naive(F, kp, last);
#endif
        GRID_BAR(); FRESH();
        { const Args a = ldargs(kp); unsigned char* ws = a.ws;
          Gemm g{(const bf16_t*)(ws + WS_O), D, (const bf16_t*)(ws + WS_WO) + (size_t)l * D * D, D}; StaticOrder S; S.init(ntok, D, GRID, F.bk);
          EpiYo E{(bf16_t*)(ws + WS_U)}; gemm_phase<3>(F, g, S, E); }
        if (!last && F.bk >= (MT / 256) * (D / 256) - 2 * GRID) conv_filler(F, kp, l, FILL_P5);
        GRID_BAR(); FRESH();
        if (l == 0) phase_ln1_route<true>(F, kp, l, ntok); else phase_ln1_route<false>(F, kp, l, ntok);
        GRID_BAR(); FRESH();
        for (int rep_ = 0; rep_ < REP_P7; ++rep_) phase_dispatch(F, kp, l, ntok);
        GRID_BAR(); FRESH();
        { const Args a = ldargs(kp); unsigned char* ws = a.ws;
          Gemm g{(const bf16_t*)(ws + WS_H), D, (const bf16_t*)(ws + WS_WGU) + (size_t)l * NEXP * 1024 * D, D}; GroupedOrder S; S.init((const volatile LAS int*)(F.lds + MISC_POFF), GRID, F.vcu);
          LAS int* gt = (LAS int*)(F.lds + STAGE_BYTES);
          { const int* postok = (const int*)(ws + WS_POSTOK); Unit u; for (int i = 0; i < 16 && S.next(i, u); ++i) if (F.tid < 256) gt[i * 256 + F.tid] = postok[u.pm * 256 + F.tid]; }
          __syncthreads();
          EpiAct E{(bf16_t*)(ws + WS_ACT)}; gemm_phase_gather<4>(F, g, S, E, gt); }
        GRID_BAR(); FRESH();
        { const Args a = ldargs(kp); unsigned char* ws = a.ws;
          Gemm g{(const bf16_t*)(ws + WS_ACT), FF, (const bf16_t*)(ws + WS_WD) + (size_t)l * NEXP * D * FF, FF}; GroupedOrder S; S.init((const volatile LAS int*)(F.lds + MISC_POFF), GRID, F.vcu);
          EpiY E{(bf16_t*)(ws + WS_XS)}; gemm_phase<5>(F, g, S, E); }
        GRID_BAR(); FRESH();
        phase_ln2(F, kp, l, ntok);
        GRID_BAR(); FRESH();
    }
}

extern "C" void kernel_launch(void* const* d_in, const int* in_sizes, int n_in, void* d_out, int out_size, void* d_ws, size_t ws_size, hipStream_t stream) {
    static int grid = 0;
    if (grid == 0) {
        if (n_in != 25 || out_size != TL * D || ws_size < WS_END) { fprintf(stderr, "kernel_launch: unexpected shapes (n_in %d out %d ws %zu need %zu)\n", n_in, out_size, ws_size, (size_t)WS_END); grid = -1; return; }
        int dev = 0, cus = 0, per_cu = 0;
        if (hipGetDevice(&dev) != hipSuccess || hipDeviceGetAttribute(&cus, hipDeviceAttributeMultiprocessorCount, dev) != hipSuccess) { grid = -1; return; }
        if (hipFuncSetAttribute((const void*)fwd_kernel, hipFuncAttributeMaxDynamicSharedMemorySize, LDS_BYTES) != hipSuccess) { fprintf(stderr, "kernel_launch: hipFuncSetAttribute failed\n"); grid = -1; return; }
        if (hipOccupancyMaxActiveBlocksPerMultiprocessor(&per_cu, (const void*)fwd_kernel, NTHREADS, LDS_BYTES) != hipSuccess || per_cu < 1) { fprintf(stderr, "kernel_launch: occupancy query says %d\n", per_cu); }
        (void)hipGetLastError();
        grid = (cus == 256) ? 256 : -1;
        if (grid < 0) { fprintf(stderr, "kernel_launch: need a 256-CU device, got %d\n", cus); return; }
    }
    if (grid < 0) return;
    if (hipMemsetAsync((char*)d_ws + WS_CTL, 0, CTL_BYTES, stream) != hipSuccess) return;
    Args a{};
    a.x = (const float*)d_in[0]; a.c = (const float*)d_in[1]; a.ctx = (const float*)d_in[2]; a.c_ctx = (const float*)d_in[3]; a.w_ada = (const float*)d_in[4]; a.b_ada = (const float*)d_in[5];
    a.w_in = (const float*)d_in[6]; a.g_q_a = (const float*)d_in[7]; a.w_q_b = (const float*)d_in[8]; a.g_kv_a = (const float*)d_in[9]; a.w_kv_b = (const float*)d_in[10];
    a.g_gq = (const float*)d_in[11]; a.g_gk = (const float*)d_in[12]; a.w_o = (const float*)d_in[13]; a.ln1_g = (const float*)d_in[14]; a.ln1_b = (const float*)d_in[15];
    a.w_rg = (const float*)d_in[16]; a.b_rg = (const float*)d_in[17]; a.w_re = (const float*)d_in[18]; a.b_re = (const float*)d_in[19];
    a.w_gate = (const float*)d_in[20]; a.w_up = (const float*)d_in[21]; a.w_down = (const float*)d_in[22]; a.ln2_g = (const float*)d_in[23]; a.ln2_b = (const float*)d_in[24];
    a.out = (float*)d_out; a.ws = (unsigned char*)d_ws;
    hipLaunchKernelGGL(fwd_kernel, dim3(grid), dim3(NTHREADS), LDS_BYTES, stream, a);
}
```

```cpp
#include <hip/hip_runtime.h>
#include <cstdint>
#include <cstdio>

#ifndef REP_ATTN
#define REP_ATTN 1
#endif
#ifndef REP_GEMM
#define REP_GEMM 1
#endif
#ifndef REP_PRO
#define REP_PRO 1
#endif
#ifndef REP_THIN
#define REP_THIN 1
#endif
#ifndef REP_P2
#define REP_P2 1
#endif
#ifndef REP_P7
#define REP_P7 1
#endif
#ifndef REP_P6
#define REP_P6 1
#endif
#ifndef REP_P10
#define REP_P10 0
#endif
#ifndef FILL_P1
#define FILL_P1 3
#endif
#ifndef FILL_P5
#define FILL_P5 3
#endif
#ifndef USE_MFMA_GEMM
#define USE_MFMA_GEMM 1
#endif
#ifndef USE_MFMA_ATTN
#define USE_MFMA_ATTN 1
#endif

#define GAS __attribute__((address_space(1)))
#define LAS __attribute__((address_space(3)))
typedef unsigned short bf16_t;
typedef float f32x4 __attribute__((ext_vector_type(4)));
typedef float f32x2 __attribute__((ext_vector_type(2)));
typedef unsigned u32x4 __attribute__((ext_vector_type(4)));
typedef unsigned u32x2 __attribute__((ext_vector_type(2)));
typedef short bf16x8 __attribute__((ext_vector_type(8)));

constexpr int D = 1024, NB = 16, SEQ = 2048, CTX = 256, NL = 4;
constexpr int TL = NB * SEQ, TC = NB * CTX, MT = TL + TC;
constexpr int KPB = CTX + SEQ;
constexpr int ZW = 1536;
constexpr int QW = 768, KVW = 1024;
constexpr int NEXP = 32, FF = 512;
constexpr int XS_ROWS = 81920;
constexpr float ALPHA = 1.6817928305074290f;
constexpr float LOG2E = 1.4426950408889634f;
constexpr float QSCALE_M = 0.10206207261596575f * LOG2E;
constexpr float QSCALE_G = 0.125f * LOG2E;
constexpr float RMS_EPS = 1e-6f, LN_EPS = 1e-5f;
constexpr int NWAVES = 8, NTHREADS = 512, GRID = 256;

constexpr size_t al256(size_t x) { return (x + 255) & ~(size_t)255; }
constexpr size_t WS_CTL = 0, CTL_BYTES = 65536;
constexpr size_t WS_BLKCNT = WS_CTL + CTL_BYTES;
constexpr size_t WS_MOETAB = WS_BLKCNT + (size_t)NL * 256 * 32 * 4;
constexpr size_t WS_MOD = WS_MOETAB + (size_t)NL * 128 * 4;
constexpr size_t WS_MODP = WS_MOD + (size_t)NL * 17 * 6144 * 4;
constexpr size_t WS_TAB64 = WS_MODP + (size_t)4 * NL * 17 * 6144 * 4;
constexpr size_t WS_TAB32 = WS_TAB64 + 64 * 16 * 8;
constexpr size_t WS_RSTDQ = WS_TAB32 + 64 * 8 * 8;
constexpr size_t WS_RSTDKV = WS_RSTDQ + (size_t)MT * 4;
constexpr size_t WS_TOKE = WS_RSTDKV + (size_t)MT * 4;
constexpr size_t WS_TOKR = WS_TOKE + (size_t)MT * 8;
constexpr size_t WS_TOKP = WS_TOKR + (size_t)MT * 8;
constexpr size_t WS_TOKW = WS_TOKP + (size_t)MT * 8;
constexpr size_t WS_WIN = al256(WS_TOKW + (size_t)MT * 8);
constexpr size_t WS_WQ = WS_WIN + (size_t)NL * ZW * D * 2;
constexpr size_t WS_WKV = WS_WQ + (size_t)NL * QW * 384 * 2;
constexpr size_t WS_WO = WS_WKV + (size_t)NL * KVW * 256 * 2;
constexpr size_t WS_WGU = WS_WO + (size_t)NL * D * D * 2;
constexpr size_t WS_WD = WS_WGU + (size_t)NL * NEXP * 1024 * D * 2;
constexpr size_t WS_XC = WS_WD + (size_t)NL * NEXP * D * FF * 2;
constexpr size_t WS_H = WS_XC + (size_t)TC * D * 4;
constexpr size_t WS_B = WS_H + (size_t)MT * D * 2;
constexpr size_t WS_Z = WS_B;
constexpr size_t WS_QM = WS_Z + (size_t)MT * ZW * 2;
constexpr size_t WS_KM = WS_QM + (size_t)MT * QW * 2;
constexpr size_t WS_VM = WS_KM + (size_t)MT * QW * 2;
constexpr size_t WS_QG = WS_VM + (size_t)MT * 512 * 2;
constexpr size_t WS_KG = WS_QG + (size_t)MT * 512 * 2;
constexpr size_t WS_VG = WS_KG + (size_t)MT * 128 * 2;
constexpr size_t WS_O = WS_VG + (size_t)MT * 128 * 2;
constexpr size_t WS_BEND = WS_O + (size_t)MT * D * 2;
constexpr size_t WS_U = WS_B;
constexpr size_t WS_XS = WS_B;
constexpr size_t WS_ACT = WS_XS + (size_t)XS_ROWS * D * 2;
constexpr size_t WS_HLO = WS_BEND;
constexpr size_t WS_WR = WS_HLO + (size_t)MT * D * 2;
constexpr size_t WS_POSTOK = WS_WR + (size_t)NL * 2 * 48 * D * 2;
constexpr size_t WS_XB = al256(WS_POSTOK + (size_t)XS_ROWS * 4);
constexpr size_t WS_END = WS_XB + (size_t)MT * D * 2;
static_assert(WS_U + (size_t)MT * D * 4 <= WS_KM, "U must fit in Z+QM");
static_assert(WS_ACT + (size_t)XS_ROWS * FF * 2 <= WS_BEND, "MoE buffers must fit in region B");
static_assert(WS_END < (size_t)1100 * 1000 * 1000, "workspace map too large");

constexpr int LDS_BYTES = 163840;
constexpr int BIG_BYTES = 147456;
constexpr int MISC_OFF = BIG_BYTES;
constexpr int MISC_BAR = MISC_OFF;
constexpr int MISC_CNT = MISC_OFF + 64;
constexpr int MISC_POFF = MISC_OFF + 256;
constexpr int MISC_TOT = MISC_OFF + 512;
constexpr int MISC_BASE = MISC_OFF + 768;
constexpr int MISC_PA = MISC_OFF + 1024;
constexpr int MISC_PB = MISC_OFF + 1024 + 2048;
constexpr int MISC_LG = MISC_OFF + 8192;

#define LDS_WAIT() asm volatile("s_waitcnt lgkmcnt(0)" ::: "memory")
__device__ __forceinline__ unsigned f2bf(float f) { unsigned u = __builtin_bit_cast(unsigned, f); return (u + 0x7fffu + ((u >> 16) & 1u)) >> 16; }
__device__ __forceinline__ unsigned pk2(float lo, float hi) { typedef __bf16 bf2_t __attribute__((ext_vector_type(2))); f32x2 v = {lo, hi}; bf2_t b = __builtin_convertvector(v, bf2_t); return __builtin_bit_cast(unsigned, b); }
__device__ __forceinline__ float bflo(unsigned w) { return __builtin_bit_cast(float, w << 16); }
__device__ __forceinline__ float bfhi(unsigned w) { return __builtin_bit_cast(float, w & 0xffff0000u); }
template <int K> __device__ __forceinline__ float lane_xor(float v) { return __int_as_float(__builtin_amdgcn_ds_swizzle(__float_as_int(v), (K << 10) | 0x1f)); }
__device__ __forceinline__ float wave_sum(float v) {
    v += lane_xor<1>(v); v += lane_xor<2>(v); v += lane_xor<4>(v); v += lane_xor<8>(v); v += lane_xor<16>(v);
    { auto rr = __builtin_amdgcn_permlane32_swap(__float_as_uint(v), __float_as_uint(v), false, false); v = __uint_as_float(rr[0]) + __uint_as_float(rr[1]); }
    return v;
}
__device__ __forceinline__ int krow_of(int r) { return r < TL ? (r >> 11) * KPB + CTX + (r & 2047) : ((r - TL) >> 8) * KPB + ((r - TL) & 255); }
__device__ __forceinline__ int bb_of(int r) { return r < TL ? (r >> 11) : 16; }

#define XB_TMO      128
#define XB_XCNT(j)  (256  + 64 * (j))
#define XB_XSUB(j)  (1280 + 64 * (j))
#define XB_XGEN(j)  (2304 + 64 * (j))
#define XB_TOP      3328
#define XB_TOPGEN   3392
#define XCD_BAR_WORDS 3456
#define XB_SPIN_CAP (1u << 18)
__device__ __forceinline__ unsigned xb_ld(unsigned* p)              { return __hip_atomic_load(p, __ATOMIC_RELAXED, __HIP_MEMORY_SCOPE_AGENT); }
__device__ __forceinline__ unsigned xb_add(unsigned* p, unsigned v) { return __hip_atomic_fetch_add(p, v, __ATOMIC_RELAXED, __HIP_MEMORY_SCOPE_AGENT); }
__device__ __forceinline__ unsigned xb_xcc_id() { return (unsigned)__builtin_amdgcn_s_getreg((3 << 11) | 20) & 0xFu; }
#define XB_SPIN(cond, bar) do { unsigned _sp = 0; while (cond) { __builtin_amdgcn_s_sleep(1); \
    if ((++_sp & 255u) == 0u) { if (xb_ld(&(bar)[XB_TMO])) break; if (_sp > XB_SPIN_CAP) { atomicAdd(&(bar)[XB_TMO], 1u); break; } } } } while (0)
struct XcdBarrier { unsigned* bar; unsigned x; volatile LAS unsigned* st; };
__device__ __forceinline__ XcdBarrier xcd_barrier_post(unsigned* bar, volatile LAS unsigned* st, const bool leader) {
    XcdBarrier b; b.bar = bar; b.x = xb_xcc_id(); b.st = st;
    if (leader) (void)xb_add(&bar[XB_XCNT(b.x)], 1u);
    return b;
}
__device__ __forceinline__ void xcd_barrier_complete(unsigned* bar, unsigned x, unsigned& nloc, unsigned& nx) {
    const unsigned G = gridDim.x * gridDim.y * gridDim.z;
    unsigned sum, cnt, mine, sp = 0u;
    for (;;) {
        sum = 0u; cnt = 0u; mine = 0u;
#pragma unroll
        for (unsigned j = 0; j < 16; ++j) { const unsigned c = xb_ld(&bar[XB_XCNT(j)]); sum += c; cnt += (c > 0u) ? 1u : 0u; mine = (j == x) ? c : mine; }
        if (sum == G) break;
        __builtin_amdgcn_s_sleep(1);
        if ((++sp & 255u) == 0u) { if (xb_ld(&bar[XB_TMO])) break; if (sp > XB_SPIN_CAP) { atomicAdd(&bar[XB_TMO], 1u); break; } }
    }
    nloc = mine > 0u ? mine : 1u; nx = cnt > 0u ? cnt : 1u;
}
__device__ __forceinline__ void xcd_barrier(const XcdBarrier& b, const bool leader) {
    asm volatile("s_waitcnt vmcnt(0)" ::: "memory");
    __syncthreads();
    if (leader) {
        unsigned* bar = b.bar;
        __builtin_amdgcn_s_waitcnt(0);
        unsigned nloc = b.st[0], nx = b.st[1];
        if (nloc == 0u) { xcd_barrier_complete(bar, b.x, nloc, nx); b.st[0] = nloc; b.st[1] = nx; }
        const unsigned old = xb_add(&bar[XB_XSUB(b.x)], 1u);
        const unsigned gen = old / nloc;
        if (old + 1u == (gen + 1u) * nloc) {
            __builtin_amdgcn_fence(__ATOMIC_RELEASE, "agent");
            asm volatile("s_waitcnt vmcnt(0)" ::: "memory");
            const unsigned og = xb_add(&bar[XB_TOP], 1u);
            const unsigned tg = og / nx;
            if (og + 1u == (tg + 1u) * nx) xb_add(&bar[XB_TOPGEN], 1u);
            else XB_SPIN(xb_ld(&bar[XB_TOPGEN]) == tg, bar);
            __builtin_amdgcn_fence(__ATOMIC_ACQUIRE, "agent");
            xb_add(&bar[XB_XGEN(b.x)], 1u);
            asm volatile("s_waitcnt vmcnt(0)" ::: "memory");
        } else {
            XB_SPIN(xb_ld(&bar[XB_XGEN(b.x)]) == gen, bar);
            __builtin_amdgcn_fence(__ATOMIC_ACQUIRE, "agent");
            asm volatile("s_waitcnt vmcnt(0)" ::: "memory");
        }
    }
    __syncthreads();
}

struct Args {
    const float* x; const float* c; const float* ctx; const float* c_ctx; const float* w_ada; const float* b_ada; const float* w_in;
    const float* g_q_a; const float* w_q_b; const float* g_kv_a; const float* w_kv_b; const float* g_gq; const float* g_gk; const float* w_o;
    const float* ln1_g; const float* ln1_b; const float* w_rg; const float* b_rg; const float* w_re; const float* b_re;
    const float* w_gate; const float* w_up; const float* w_down; const float* ln2_g; const float* ln2_b;
    float* out; unsigned char* ws;
};

typedef const __attribute__((address_space(4))) Args* KP;
__device__ __forceinline__ Args ldargs(KP p) {
#if defined(__HIP_DEVICE_COMPILE__)
    asm volatile("" : "+s"(p)); return *p;
#else
    return Args{};
#endif
}

struct Ctx {
    LAS unsigned char* lds;
    int tid, lane, wave, vcu, bk;
};

struct Unit { int pm, pn; };
constexpr int BM = 256, NXCD = 8, WGM = 8;
struct StaticOrder {
    int nM, nN, nwg, G, c;
    __device__ void init(int M, int N, int G_, int c_) { nM = M / BM; nN = N / BM; nwg = nM * nN; G = G_; c = c_; }
    __device__ bool next(int i, Unit& u) const {
        const long L = (long)i * G + c; if (L >= nwg) return false;
        int wgid = (int)L; { const int q = nwg / NXCD, r = nwg % NXCD, xcd = wgid % NXCD, off = wgid / NXCD; wgid = (xcd < r ? xcd * (q + 1) : r * (q + 1) + (xcd - r) * q) + off; }
        const int nig = WGM * nN, gid = wgid / nig, fm = gid * WGM, gsz = (nM - fm) < WGM ? (nM - fm) : WGM;
        u.pm = fm + ((wgid % nig) % gsz); u.pn = (wgid % nig) / gsz; return true;
    }
    __device__ __forceinline__ void a_ready(const Unit&) const {}
    __device__ __forceinline__ void done(const Unit&) const {}
};
struct GroupedOrder {
    const volatile LAS int* poff; int nunits, G, c;
    __device__ void init(const volatile LAS int* poff_, int G_, int c_) { poff = poff_; nunits = (poff_[32] >> 8) * 4; G = G_; c = c_; }
    __device__ bool next(int i, Unit& u) const {
        const int L = i * G + c; if (L >= nunits) return false;
        const int rt = L >> 2, r0 = rt << 8; int e = 0;
#pragma unroll
        for (int j = 1; j < 32; ++j) e += (poff[j] <= r0) ? 1 : 0;
        u.pm = rt; u.pn = e * 4 + (L & 3); return true;
    }
    __device__ __forceinline__ void a_ready(const Unit&) const {}
    __device__ __forceinline__ void done(const Unit&) const {}
};

__device__ __forceinline__ void st_bf4(bf16_t* p, f32x4 v) { u32x2 w; w.x = pk2(v[0], v[1]); w.y = pk2(v[2], v[3]); *(u32x2*)p = w; }
__device__ __forceinline__ void st_bf8(bf16_t* p, f32x4 a, f32x4 b) { u32x4 w; w.x = pk2(a[0], a[1]); w.y = pk2(a[2], a[3]); w.z = pk2(b[0], b[1]); w.w = pk2(b[2], b[3]); *(u32x4*)p = w; }
struct EpiZ {
    static constexpr bool PERM = true;
    bf16_t* Z;
    __device__ __forceinline__ void tile32(int row, int col, int fq, f32x4 v0, f32x4 v1) const { st_bf8(Z + (size_t)row * ZW + col + 8 * fq, v0, v1); }
};
struct EpiQ {
    static constexpr bool PERM = true;
    bf16_t* Qm; const float* rstd; const f32x2* tab32;
    __device__ __forceinline__ void tile32(int row, int col, int fq, f32x4 v0, f32x4 v1) const {
        const int h = col / 96, gi = (col - h * 96) >> 5;
        const float rs = rstd[row] * QSCALE_M;
        v0 = v0 * rs; v1 = v1 * rs;
        bf16_t* base = Qm + (size_t)row * QW + h * 96;
        if (gi < 2) { st_bf8(base + gi * 32 + 8 * fq, v0, v1); }
        else {
            const int part = fq >> 1, f0 = (4 * fq) & 7;
            f32x4 o1 = v0, o2 = v1;
            if (row < TL) {
                const int s = row & 2047, pos = part ? (s & 63) : (s >> 6);
#pragma unroll
                for (int j = 0; j < 4; ++j) { const f32x2 cs = tab32[pos * 8 + f0 + j]; o1[j] = v0[j] * cs.x - v1[j] * cs.y; o2[j] = v1[j] * cs.x + v0[j] * cs.y; }
            }
            bf16_t* p = base + 64 + part * 16 + f0; st_bf4(p, o1); st_bf4(p + 8, o2);
        }
    }
};
struct EpiKV {
    static constexpr bool PERM = true;
    bf16_t* Km; bf16_t* Vm; const float* rstd;
    __device__ __forceinline__ void tile32(int row, int col, int fq, f32x4 v0, f32x4 v1) const {
        const int h = col >> 7, w = col & 127; const float rs = rstd[row]; const int kr = krow_of(row);
        bf16_t* p = (w < 64) ? (Km + (size_t)kr * QW + h * 96 + w + 8 * fq) : (Vm + (size_t)kr * 512 + h * 64 + (w - 64) + 8 * fq);
        st_bf8(p, v0 * rs, v1 * rs);
    }
};
struct EpiU {
    static constexpr bool PERM = false;
    float* U; const float* xl; const float* xc; const float* mod_l;
    int gate;
    __device__ __forceinline__ void tile32(int row, int col, int fq, f32x4 v0, f32x4 v1) const {
        const float* xr = (row < TL) ? (xl + (size_t)row * D) : (xc + (size_t)(row - TL) * D);
        const float* g = mod_l + (size_t)(bb_of(row) * 6 + gate) * D;
        const int c0 = col + 4 * fq;
        const f32x4 x0 = *(const f32x4*)(xr + c0), x1 = *(const f32x4*)(xr + c0 + 16), g0 = *(const f32x4*)(g + c0), g1 = *(const f32x4*)(g + c0 + 16);
        float* u = U + (size_t)row * D + c0;
        *(f32x4*)u = x0 * ALPHA + g0 * v0; *(f32x4*)(u + 16) = x1 * ALPHA + g1 * v1;
    }
};
__device__ __forceinline__ float silu_f(float x) { return x * __builtin_amdgcn_rcpf(1.0f + __builtin_amdgcn_exp2f(-x * LOG2E)); }
struct EpiAct {
    static constexpr bool PERM = false;
    bf16_t* Act;
    __device__ __forceinline__ void tile32(int row, int col, int fq, f32x4 v0, f32x4 v1) const {
        const int f0 = ((col & 1023) >> 1) + 4 * fq; f32x4 a;
#pragma unroll
        for (int j = 0; j < 4; ++j) a[j] = silu_f(v0[j]) * v1[j];
        st_bf4(Act + (size_t)row * FF + f0, a);
    }
};
struct EpiYo {
    static constexpr bool PERM = true;
    bf16_t* Y;
    __device__ __forceinline__ void tile32(int row, int col, int fq, f32x4 v0, f32x4 v1) const { st_bf8(Y + (size_t)row * D + col + 8 * fq, v0, v1); }
};
struct EpiY {
    static constexpr bool PERM = true;
    bf16_t* Y;
    __device__ __forceinline__ void tile32(int row, int col, int fq, f32x4 v0, f32x4 v1) const { st_bf8(Y + (size_t)row * D + (col & 1023) + 8 * fq, v0, v1); }
};

struct Gemm { const bf16_t* A; int lda; const bf16_t* Bt; int K; };
__device__ __forceinline__ float dot8(u32x4 a, u32x4 b, float acc) {
#pragma unroll
    for (int i = 0; i < 4; ++i) { acc += bflo(a[i]) * bflo(b[i]); acc += bfhi(a[i]) * bfhi(b[i]); }
    return acc;
}
template <class Sched, class Epi>
__device__ __forceinline__ void gemm_naive(const Ctx& F, const Gemm g, const Sched& S, const Epi& E) {
    Unit u;
    for (int i = 0; S.next(i, u); ++i) {
        for (int task = F.tid; task < 8192; task += NTHREADS) {
            const int lane = task & 63, fr = lane & 15, fq = lane >> 4, rest = task >> 6, rg = rest & 15, cg = rest >> 4;
            const int row = u.pm * 256 + rg * 16 + fr, col = u.pn * 256 + cg * 32;
            const bf16_t* ap = g.A + (size_t)row * g.lda;
            const bf16_t* bp0 = g.Bt + (size_t)(col + 4 * fq) * g.K;
            const bf16_t* bp1 = bp0 + (size_t)16 * g.K;
            f32x4 v0 = {0.f, 0.f, 0.f, 0.f}, v1 = {0.f, 0.f, 0.f, 0.f};
            for (int k = 0; k < g.K; k += 8) {
                const u32x4 a = *(const u32x4*)(ap + k);
#pragma unroll
                for (int j = 0; j < 4; ++j) {
                    v0[j] = dot8(a, *(const u32x4*)(bp0 + (size_t)j * g.K + k), v0[j]);
                    v1[j] = dot8(a, *(const u32x4*)(bp1 + (size_t)j * g.K + k), v1[j]);
                }
            }
            E.tile32(row, col, fq, v0, v1);
        }
    }
}
constexpr int BK = 64, HALF = 128, HTB = HALF * BK * 2, STAGE_BYTES = 8 * HTB;
__device__ __forceinline__ int lds_byte(int r, int c) { const int st = (r >> 4) * 2 + (c >> 5), rr = r & 15, cc = c & 31, ob = rr * 64 + cc * 2; return st * 1024 + (ob ^ (((ob >> 9) & 1) << 5)); }
__device__ __forceinline__ int perm32(int rho) { const int n = rho >> 4, i = rho & 15; return 8 * (i >> 2) + 4 * n + (i & 3); }
__device__ __forceinline__ void stage_rc(int b, int& R, int& C) { const int st = b / 1024, sb = b % 1024, swz = sb ^ (((sb >> 9) & 1) << 5); R = (st >> 1) * 16 + swz / 64; C = (st & 1) * 32 + (swz % 64) / 2; }
template <class Epi, class Sched, bool ALIGN_EPI = true, bool SP2 = true, bool GATHER = false>
__device__ __forceinline__ void gemm_mfma(LAS unsigned char* lds, const int tid_in, const Gemm g, const Sched& S, const Epi& E, const LAS int* gtab = nullptr) {
    int tid = tid_in; asm volatile("" : "+v"(tid));
    const int wid = __builtin_amdgcn_readfirstlane(tid >> 6), lane = tid & 63, wr = wid >> 2, wc = wid & 3, fr = lane & 15, fq = lane >> 4;
    const int K = g.K, nt = K / BK;
    unsigned voffB[2]; int RA[2], CA[2];
#pragma unroll
    for (int i = 0; i < 2; ++i) { int R, C; stage_rc(tid * 16 + i * 8192, R, C); const int Rb = Epi::PERM ? ((R & ~31) + perm32(R & 31)) : R;
        RA[i] = R; CA[i] = C; voffB[i] = (unsigned)(Rb * K + C) * 2u; }
    const size_t kstep = (size_t)(BK * 2);
    const size_t hstepA = (size_t)HALF * g.lda * 2, hstepB = (size_t)HALF * K * 2;
    const size_t tstepA = GATHER ? 0 : 2 * hstepA, tstepB = 2 * hstepB;
    unsigned vc0[2], vc1[2], vn0[2], vn1[2];
#define PG8_GOFF(dst0, dst1, ui_) do { _Pragma("unroll") for (int i_ = 0; i_ < 2; ++i_) { \
        if constexpr (GATHER) { dst0[i_] = (unsigned)gtab[(ui_) * 256 + RA[i_]] * (unsigned)(g.lda * 2) + (unsigned)CA[i_] * 2u; dst1[i_] = (unsigned)gtab[(ui_) * 256 + HALF + RA[i_]] * (unsigned)(g.lda * 2) + (unsigned)CA[i_] * 2u; } \
        else { dst0[i_] = (unsigned)(RA[i_] * g.lda + CA[i_]) * 2u; dst1[i_] = dst0[i_] + (unsigned)hstepA; } } } while (0)
    const unsigned ldsw = (unsigned)wid * 1024u;
    const int aoff = lds_byte(wr * 64 + fr, fq * 8), boff = lds_byte(wc * 32 + fr, fq * 8);
#define PG8_SA(b, h) (((b) * 2 + (h)) * HTB)
#define PG8_SB(b, h) ((4 + (b) * 2 + (h)) * HTB)
#define PG8_STAGE(bufoff, gbase, voff) do { _Pragma("unroll") for (int _i = 0; _i < 2; ++_i) \
        __builtin_amdgcn_global_load_lds((const unsigned*)((const char*)(gbase) + (voff)[_i]), (LAS unsigned*)(lds + (bufoff) + ldsw + _i * 8192), 16, 0, 0); } while (0)
#define PG8_LDA(dst, b, h) do { _Pragma("unroll") for (int m = 0; m < 4; ++m) _Pragma("unroll") for (int k = 0; k < 2; ++k) dst[m][k] = *(const LAS bf16x8*)(lds + PG8_SA(b, h) + aoff + m * 2048 + k * 1024); } while (0)
#define PG8_LDB(dst, b, h) do { _Pragma("unroll") for (int n = 0; n < 2; ++n) _Pragma("unroll") for (int k = 0; k < 2; ++k) dst[n][k] = *(const LAS bf16x8*)(lds + PG8_SB(b, h) + boff + n * 2048 + k * 1024); } while (0)
#define PG8_MMA(ai, bj, At, Bt) do { __builtin_amdgcn_s_setprio(1); _Pragma("unroll") for (int m = 0; m < 4; ++m) _Pragma("unroll") for (int n = 0; n < 2; ++n) _Pragma("unroll") for (int k = 0; k < 2; ++k) \
        acc[ai][bj][m][n] = __builtin_amdgcn_mfma_f32_16x16x32_bf16(Bt[n][k], At[m][k], acc[ai][bj][m][n], 0, 0, 0); __builtin_amdgcn_s_setprio(0); } while (0)
#define PG8_WAIT_V(n) asm volatile("s_waitcnt vmcnt(" #n ")" ::: "memory")
#define PG8_WAIT_L(n) asm volatile("s_waitcnt lgkmcnt(" #n ")" ::: "memory")
#define PG8_BAR __builtin_amdgcn_s_barrier()
#define PG8_SCHED __builtin_amdgcn_sched_barrier(0)
    Unit cur, nxt; int ui = 0;
    if (!S.next(0, cur)) return;
    PG8_GOFF(vc0, vc1, 0);
#pragma unroll
    for (int i = 0; i < 2; ++i) { vn0[i] = vc0[i]; vn1[i] = vc1[i]; }
    f32x4 acc[2][2][4][2];
#pragma unroll
    for (int a = 0; a < 2; ++a)
#pragma unroll
        for (int b = 0; b < 2; ++b)
#pragma unroll
            for (int m = 0; m < 4; ++m)
#pragma unroll
                for (int n = 0; n < 2; ++n) acc[a][b][m][n] = (f32x4){0.f, 0.f, 0.f, 0.f};
    bf16x8 At[4][2], B0[2][2], B1[2][2];
    const char* cA = (const char*)g.A + (size_t)cur.pm * tstepA; const char* cB = (const char*)g.Bt + (size_t)cur.pn * tstepB;
    S.a_ready(cur);
    if constexpr (SP2) {
        PG8_STAGE(PG8_SB(0, 0), cB, voffB); PG8_STAGE(PG8_SB(0, 1), cB + hstepB, voffB); PG8_STAGE(PG8_SA(0, 0), cA, vc0); PG8_STAGE(PG8_SA(0, 1), cA, vc1);
        if (wr == 1) PG8_BAR;
        PG8_WAIT_V(2); PG8_BAR;
        PG8_STAGE(PG8_SB(1, 0), cB + kstep, voffB); PG8_STAGE(PG8_SA(1, 0), cA + kstep, vc0); PG8_STAGE(PG8_SB(1, 1), cB + hstepB + kstep, voffB);
        PG8_WAIT_V(6); PG8_BAR;
    } else {
        PG8_STAGE(PG8_SB(0, 0), cB, voffB); PG8_STAGE(PG8_SA(0, 0), cA, vc0); PG8_STAGE(PG8_SB(0, 1), cB + hstepB, voffB); PG8_STAGE(PG8_SA(0, 1), cA, vc1);
        if (wr == 1) PG8_BAR;
        PG8_WAIT_V(4); PG8_BAR;
        PG8_STAGE(PG8_SB(1, 0), cB + kstep, voffB); PG8_STAGE(PG8_SA(1, 0), cA + kstep, vc0); PG8_STAGE(PG8_SB(1, 1), cB + hstepB + kstep, voffB);
        PG8_WAIT_V(6); PG8_BAR;
    }
    for (;;) {
        const bool has_next = S.next(ui + 1, nxt);
        if constexpr (GATHER) { if (has_next) { PG8_GOFF(vn0, vn1, ui + 1); } else {
#pragma unroll
            for (int i = 0; i < 2; ++i) { vn0[i] = vc0[i]; vn1[i] = vc1[i]; } } }
        const char* nA = has_next ? (const char*)g.A + (size_t)nxt.pm * tstepA : cA; const char* nB = has_next ? (const char*)g.Bt + (size_t)nxt.pn * tstepB : cB;
        for (int t = 0; t < nt; t += 2) {
            const bool last = (t == nt - 2);
            const char* a1 = cA + (size_t)(t + 1) * kstep;
            const char* a2 = last ? nA : cA + (size_t)(t + 2) * kstep; const char* b2 = last ? nB : cB + (size_t)(t + 2) * kstep;
            const char* a3 = a2 + kstep; const char* b3 = b2 + kstep;
            unsigned s0[2], s1[2];
#pragma unroll
            for (int i = 0; i < 2; ++i) { if constexpr (GATHER) { s0[i] = last ? vn0[i] : vc0[i]; s1[i] = last ? vn1[i] : vc1[i]; } else { s0[i] = vc0[i]; s1[i] = vc1[i]; } }
            if (last && has_next) S.a_ready(nxt);
            if constexpr (SP2) {
            PG8_LDB(B0, 0, 0); PG8_LDB(B1, 0, 1); PG8_SCHED; PG8_LDA(At, 0, 0); PG8_STAGE(PG8_SA(1, 1), a1, vc1);
            PG8_WAIT_V(8); PG8_WAIT_L(0); PG8_BAR; PG8_MMA(0, 0, At, B0); PG8_MMA(0, 1, At, B1); PG8_BAR; PG8_SCHED;
            PG8_LDA(At, 0, 1); PG8_STAGE(PG8_SB(0, 0), b2, voffB); PG8_STAGE(PG8_SB(0, 1), b2 + hstepB, voffB); PG8_STAGE(PG8_SA(0, 0), a2, s0);
            PG8_WAIT_V(8); PG8_WAIT_L(0); PG8_BAR; PG8_MMA(1, 0, At, B0); PG8_MMA(1, 1, At, B1); PG8_BAR; PG8_SCHED;
            PG8_LDB(B0, 1, 0); PG8_LDB(B1, 1, 1); PG8_SCHED; PG8_LDA(At, 1, 0); PG8_STAGE(PG8_SA(0, 1), a2, s1);
            PG8_WAIT_V(8); PG8_WAIT_L(0); PG8_BAR; PG8_MMA(0, 0, At, B0); PG8_MMA(0, 1, At, B1); PG8_BAR; PG8_SCHED;
            PG8_LDA(At, 1, 1); PG8_STAGE(PG8_SB(1, 0), b3, voffB); PG8_STAGE(PG8_SB(1, 1), b3 + hstepB, voffB); PG8_STAGE(PG8_SA(1, 0), a3, s0);
            PG8_WAIT_V(8); PG8_WAIT_L(0); PG8_BAR; PG8_MMA(1, 0, At, B0); PG8_MMA(1, 1, At, B1); PG8_BAR; PG8_SCHED;
            } else {
            PG8_LDB(B0, 0, 0); PG8_SCHED; PG8_LDA(At, 0, 0); PG8_STAGE(PG8_SA(1, 1), a1, vc1);
            PG8_WAIT_L(8); PG8_BAR; PG8_WAIT_L(0); PG8_MMA(0, 0, At, B0); PG8_BAR; PG8_SCHED;
            PG8_LDB(B1, 0, 1); PG8_STAGE(PG8_SB(0, 0), b2, voffB);
            PG8_BAR; PG8_WAIT_L(0); PG8_MMA(0, 1, At, B1); PG8_BAR;
            PG8_LDA(At, 0, 1); PG8_STAGE(PG8_SA(0, 0), a2, s0);
            PG8_BAR; PG8_WAIT_L(0); PG8_MMA(1, 0, At, B0); PG8_BAR; PG8_SCHED;
            PG8_STAGE(PG8_SB(0, 1), b2 + hstepB, voffB);
            PG8_WAIT_V(6); PG8_BAR; PG8_MMA(1, 1, At, B1); PG8_BAR;
            PG8_LDB(B0, 1, 0); PG8_SCHED; PG8_LDA(At, 1, 0); PG8_STAGE(PG8_SA(0, 1), a2, s1);
            PG8_WAIT_L(8); PG8_BAR; PG8_WAIT_L(0); PG8_MMA(0, 0, At, B0); PG8_BAR; PG8_SCHED;
            PG8_LDB(B1, 1, 1); PG8_STAGE(PG8_SB(1, 0), b3, voffB);
            PG8_BAR; PG8_WAIT_L(0); PG8_MMA(0, 1, At, B1); PG8_BAR;
            PG8_LDA(At, 1, 1); PG8_STAGE(PG8_SA(1, 0), a3, s0);
            PG8_BAR; PG8_WAIT_L(0); PG8_MMA(1, 0, At, B0); PG8_BAR; PG8_SCHED;
            PG8_STAGE(PG8_SB(1, 1), b3 + hstepB, voffB);
            PG8_WAIT_V(6); PG8_BAR; PG8_MMA(1, 1, At, B1); PG8_BAR;
            }
        }
        if constexpr (ALIGN_EPI) { if (wr == 0) PG8_BAR; }
        {
            int ln_e; asm volatile("v_mbcnt_lo_u32_b32 %0, -1, 0\n\tv_mbcnt_hi_u32_b32 %0, -1, %0" : "=v"(ln_e));
            const int fr_e = ln_e & 15, fq_e = ln_e >> 4;
#pragma unroll
            for (int ai = 0; ai < 2; ++ai)
#pragma unroll
                for (int m = 0; m < 4; ++m) {
#pragma unroll
                    for (int bj = 0; bj < 2; ++bj)
                        E.tile32(cur.pm * BM + ai * HALF + wr * 64 + m * 16 + fr_e, cur.pn * BM + bj * HALF + wc * 32, fq_e, acc[ai][bj][m][0], acc[ai][bj][m][1]);
                    asm volatile("" ::: "memory");
                }
            S.done(cur);
        }
        if (!has_next) break;
#pragma unroll
        for (int a = 0; a < 2; ++a)
#pragma unroll
            for (int b = 0; b < 2; ++b)
#pragma unroll
                for (int m = 0; m < 4; ++m)
#pragma unroll
                    for (int n = 0; n < 2; ++n) acc[a][b][m][n] = (f32x4){0.f, 0.f, 0.f, 0.f};
        cur = nxt; cA = nA; cB = nB; ++ui;
        if constexpr (GATHER) {
#pragma unroll
            for (int i = 0; i < 2; ++i) { vc0[i] = vn0[i]; vc1[i] = vn1[i]; } }
        if constexpr (ALIGN_EPI) { if (wr == 1) PG8_BAR; }
    }
    PG8_WAIT_V(0);
    if constexpr (!ALIGN_EPI) { if (wr == 0) PG8_BAR; }
    PG8_BAR;
#undef PG8_GOFF
#undef PG8_SA
#undef PG8_SB
#undef PG8_STAGE
#undef PG8_LDA
#undef PG8_LDB
#undef PG8_MMA
#undef PG8_WAIT_V
#undef PG8_WAIT_L
#undef PG8_BAR
#undef PG8_SCHED
}

#ifndef REP_GEMM_MASK
#define REP_GEMM_MASK 0
#endif
template <int ID, class Sched, class Epi>
__device__ __forceinline__ void gemm_phase_gather(const Ctx& F, const Gemm g, const Sched& S, const Epi& E, const LAS int* gtab) {
    gemm_mfma<Epi, Sched, true, true, true>(F.lds, F.tid, g, S, E, gtab);
    if constexpr ((REP_GEMM_MASK >> ID) & 1) gemm_mfma<Epi, Sched, true, true, true>(F.lds, F.tid, g, S, E, gtab);
}
template <int ID, class Sched, class Epi>
__device__ __forceinline__ void gemm_phase(const Ctx& F, const Gemm g, const Sched& S, const Epi& E) {
#if USE_MFMA_GEMM
    gemm_mfma<Epi, Sched, true, true>(F.lds, F.tid, g, S, E);
    if constexpr ((REP_GEMM_MASK >> ID) & 1) gemm_mfma<Epi, Sched, true, true>(F.lds, F.tid, g, S, E);
#else
    gemm_naive(F, g, S, E);
#endif
}

template <class ColPtr>
__device__ __forceinline__ void tconv_tile(const ColPtr& cp, int ldw, const float* scale, bf16_t* WT, int K, int k0, int p0, LAS float* scr, int lane) {
    const int pc = (lane & 15) * 4, kq = lane >> 4;
    const float* src = cp(p0 + pc);
#pragma unroll 4
    for (int i = 0; i < 16; ++i) {
        const int kk = 4 * i + kq;
        f32x4 v = {0.f, 0.f, 0.f, 0.f};
        if (src) { v = *(const f32x4*)(src + (size_t)(k0 + kk) * ldw); if (scale) v = v * scale[k0 + kk]; }
        LAS float* d = scr + kk * 65 + pc; d[0] = v[0]; d[1] = v[1]; d[2] = v[2]; d[3] = v[3];
    }
    LDS_WAIT();
    const int c = lane & 7;
#pragma unroll
    for (int j = 0; j < 8; ++j) {
        const int n = (lane >> 3) + 8 * j; const LAS float* s = scr + (8 * c) * 65 + n;
        u32x4 o; o.x = pk2(s[0], s[65]); o.y = pk2(s[2 * 65], s[3 * 65]); o.z = pk2(s[4 * 65], s[5 * 65]); o.w = pk2(s[6 * 65], s[7 * 65]);
        *(u32x4*)(WT + (size_t)(p0 + n) * K + k0 + 8 * c) = o;
    }
    LDS_WAIT();
}
struct CpPlain { const float* W; int ncols; __device__ __forceinline__ const float* operator()(int p) const { return p < ncols ? W + p : nullptr; } };
struct CpQ {
    const float* W;
    __device__ __forceinline__ const float* operator()(int p) const {
        const int h = p / 96, pp = p - h * 96; int lc = pp;
        if (pp >= 64) { const int rp = pp - 64, q = rp >> 3, r = rp & 7, i = 4 * q + (r & 3); lc = 64 + (i >> 3) * 16 + (i & 7) + ((r >> 2) ? 8 : 0); }
        return W + h * 96 + lc;
    }
};
struct CpGU {
    const float* Wg; const float* Wu;
    __device__ __forceinline__ const float* operator()(int p) const { const int g32 = p >> 5, w = p & 31; return (w < 16) ? (Wg + g32 * 16 + w) : (Wu + g32 * 16 + (w - 16)); }
};

constexpr int CONV_ITEMS = NEXP * 256 + NEXP * 128, CONV_CH = 4, CONV_CTR0 = 8192;
struct ConvSrc { const float* p; size_t ld; bf16_t* dst; int K; };
__device__ __forceinline__ ConvSrc conv_decode(const Args& a, int l, int idx, int lane) {
    const int pc = (lane & 15) * 4, kq = lane >> 4; ConvSrc r;
    if (idx < NEXP * 256) { const int e = idx >> 8, q = idx & 255, k0 = (q >> 4) * 64, p = (q & 15) * 64 + pc, g32 = p >> 5, w = p & 31; const size_t le = (size_t)l * NEXP + e;
        r.p = ((w < 16) ? (a.w_gate + le * D * FF + g32 * 16 + w) : (a.w_up + le * D * FF + g32 * 16 + (w - 16))) + (size_t)(k0 + kq) * FF; r.ld = FF;
        r.dst = (bf16_t*)(a.ws + WS_WGU) + le * 1024 * D + (size_t)((q & 15) * 64) * D + k0; r.K = D; }
    else { const int i2 = idx - NEXP * 256, e = i2 >> 7, q = i2 & 127, k0 = (q >> 4) * 64, p0 = (q & 15) * 64; const size_t le = (size_t)l * NEXP + e;
        r.p = a.w_down + le * FF * D + (size_t)(k0 + kq) * D + p0 + pc; r.ld = D;
        r.dst = (bf16_t*)(a.ws + WS_WD) + le * D * FF + (size_t)p0 * FF + k0; r.K = FF; }
    return r;
}
__device__ __forceinline__ void conv_load(const ConvSrc& c, f32x4 (&v)[16]) {
#pragma unroll
    for (int i = 0; i < 16; ++i) v[i] = *(const f32x4*)(c.p + (size_t)(4 * i) * c.ld);
}
__device__ __forceinline__ void conv_store(const ConvSrc& c, const f32x4 (&v)[16], LAS float* scr, int lane) {
    const int pc = (lane & 15) * 4, kq = lane >> 4;
#pragma unroll
    for (int i = 0; i < 16; ++i) { LAS float* d = scr + (4 * i + kq) * 65 + pc; d[0] = v[i][0]; d[1] = v[i][1]; d[2] = v[i][2]; d[3] = v[i][3]; }
    LDS_WAIT();
    const int cc = lane & 7;
#pragma unroll
    for (int j = 0; j < 8; ++j) {
        const int n = (lane >> 3) + 8 * j; const LAS float* sp = scr + (8 * cc) * 65 + n;
        u32x4 o; o.x = pk2(sp[0], sp[65]); o.y = pk2(sp[2 * 65], sp[3 * 65]); o.z = pk2(sp[4 * 65], sp[5 * 65]); o.w = pk2(sp[6 * 65], sp[7 * 65]);
        *(u32x4*)(c.dst + (size_t)n * c.K + 8 * cc) = o;
    }
    LDS_WAIT();
}
__device__ __forceinline__ void conv_experts(const Ctx& F, const Args& a, int l, int grabs) {
    unsigned* ctr = (unsigned*)(a.ws + WS_CTL) + CONV_CTR0 + 64 * l;
    LAS float* scr = (LAS float*)(F.lds + F.wave * 18432);
    for (int g = 0; grabs < 0 || g < grabs; ++g) {
        unsigned b0 = 0; if (F.lane == 0) b0 = __hip_atomic_fetch_add(ctr, (unsigned)CONV_CH, __ATOMIC_RELAXED, __HIP_MEMORY_SCOPE_AGENT);
        const int base = __builtin_amdgcn_readfirstlane((int)b0);
        if (base >= CONV_ITEMS) break;
        f32x4 va[16], vb[16];
        ConvSrc c0 = conv_decode(a, l, base, F.lane), c1 = conv_decode(a, l, base + 1, F.lane), c2 = conv_decode(a, l, base + 2, F.lane), c3 = conv_decode(a, l, base + 3, F.lane);
        conv_load(c0, va); conv_load(c1, vb); conv_store(c0, va, scr, F.lane);
        conv_load(c2, va); conv_store(c1, vb, scr, F.lane);
        conv_load(c3, vb); conv_store(c2, va, scr, F.lane);
        conv_store(c3, vb, scr, F.lane);
    }
}

__device__ __forceinline__ void conv_filler(const Ctx& F, KP kp, int l, int grabs) {
    const Args a = ldargs(kp);
    int q = l;
    if (l == 0 || (int)__hip_atomic_load((unsigned*)(a.ws + WS_CTL) + CONV_CTR0 + 64 * l, __ATOMIC_RELAXED, __HIP_MEMORY_SCOPE_AGENT) >= CONV_ITEMS) q = l + 1;
    if (q < NL) conv_experts(F, a, q, grabs);
}
__device__ __forceinline__ void prologue1(const Ctx& F, KP kp) {
    const Args a = ldargs(kp);
    unsigned char* ws = a.ws;
    {
        LAS float* sl = (LAS float*)F.lds;
        float* modp = (float*)(ws + WS_MODP);
        for (int it = F.bk; it < NL * 12 * 4; it += GRID) {
            const int kc = it & 3, nc = (it >> 2) % 12, l = it / 48;
            __syncthreads();
            for (int idx = F.tid; idx < 17 * 256; idx += NTHREADS) {
                const int bb = idx >> 8, k = idx & 255; const float v = (bb < 16) ? a.c[bb * D + kc * 256 + k] : a.c_ctx[kc * 256 + k];
                sl[idx] = v / (1.0f + __expf(-v));
            }
            __syncthreads();
            const int n = nc * 512 + F.tid;
            const float* w = a.w_ada + ((size_t)l * D + kc * 256) * 6144 + n;
            float acc[17];
#pragma unroll
            for (int bb = 0; bb < 17; ++bb) acc[bb] = 0.f;
            for (int k = 0; k < 256; ++k) {
                const float wv = w[(size_t)k * 6144];
#pragma unroll
                for (int bb = 0; bb < 17; ++bb) acc[bb] += sl[bb * 256 + k] * wv;
            }
#pragma unroll
            for (int bb = 0; bb < 17; ++bb) modp[((size_t)(kc * NL + l) * 17 + bb) * 6144 + n] = acc[bb];
        }
        __syncthreads();
    }
    {
        f32x2* t64 = (f32x2*)(ws + WS_TAB64); f32x2* t32 = (f32x2*)(ws + WS_TAB32);
        const int gt = F.bk * NTHREADS + F.tid;
        if (gt < 64 * 16) { const int pos = gt >> 4, f = gt & 15; const float inv = powf(10000.0f, -((float)(2 * f) / 32.0f)); const float ang = (float)pos * inv; t64[gt] = (f32x2){cosf(ang), sinf(ang)}; }
        else if (gt < 64 * 16 + 64 * 8) { const int g2 = gt - 64 * 16, pos = g2 >> 3, f = g2 & 7; const float inv = powf(10000.0f, -((float)(2 * f) / 16.0f)); const float ang = (float)pos * inv; t32[g2] = (f32x2){cosf(ang), sinf(ang)}; }
    }
    {
        bf16_t* wr = (bf16_t*)(ws + WS_WR);
        for (int i = F.bk * NTHREADS + F.tid; i < NL * 48 * D; i += GRID * NTHREADS) {
            const int c = i & 1023, j = (i >> 10) % 48, l = i / (48 * D);
            float wv = 0.f;
            if (j < 4) wv = a.w_rg[((size_t)l * D + c) * 4 + j]; else if (j < 36) wv = a.w_re[((size_t)l * D + c) * 32 + (j - 4)];
            const unsigned h = f2bf(wv); const float rem = wv - __builtin_bit_cast(float, h << 16);
            wr[((size_t)(l * 2 + 0) * 48 + j) * D + c] = (bf16_t)h; wr[((size_t)(l * 2 + 1) * 48 + j) * D + c] = (bf16_t)f2bf(rem);
        }
    }
    {
        LAS float* scr = (LAS float*)(F.lds + F.wave * 18432);
        const int gw = F.vcu * NWAVES + F.wave, NGW = GRID * NWAVES;
        constexpr int I_IN = 16 * 24, I_Q = 6 * 12, I_KV = 4 * 16, I_O = 16 * 16, I_GU = 16 * 16, I_D = 8 * 16;
        constexpr int N_SMALL = NL * (I_IN + I_Q + I_KV + I_O), N_GU = NL * NEXP * I_GU, N_D = NL * NEXP * I_D;
        for (int it = gw; it < N_SMALL; it += NGW) {
            {
                const int l = it / (I_IN + I_Q + I_KV + I_O); int r = it % (I_IN + I_Q + I_KV + I_O);
                if (r < I_IN) { const int kt = r / 24, pt = r % 24; tconv_tile(CpPlain{a.w_in + (size_t)l * D * 1440, 1440}, 1440, nullptr, (bf16_t*)(ws + WS_WIN) + (size_t)l * ZW * D, D, kt * 64, pt * 64, scr, F.lane); continue; }
                r -= I_IN;
                if (r < I_Q) { const int kt = r / 12, pt = r % 12; tconv_tile(CpQ{a.w_q_b + (size_t)l * 384 * QW}, QW, a.g_q_a + l * 384, (bf16_t*)(ws + WS_WQ) + (size_t)l * QW * 384, 384, kt * 64, pt * 64, scr, F.lane); continue; }
                r -= I_Q;
                if (r < I_KV) { const int kt = r / 16, pt = r % 16; tconv_tile(CpPlain{a.w_kv_b + (size_t)l * 256 * KVW, KVW}, KVW, a.g_kv_a + l * 256, (bf16_t*)(ws + WS_WKV) + (size_t)l * KVW * 256, 256, kt * 64, pt * 64, scr, F.lane); continue; }
                r -= I_KV;
                { const int kt = r / 16, pt = r % 16; tconv_tile(CpPlain{a.w_o + (size_t)l * D * D, D}, D, nullptr, (bf16_t*)(ws + WS_WO) + (size_t)l * D * D, D, kt * 64, pt * 64, scr, F.lane); }
            }
        }
        conv_experts(F, a, 0, -1);
    }
}

__device__ __forceinline__ void prologue2(const Ctx& F, KP kp) {
    const Args a = ldargs(kp);
    const float* modp = (const float*)(a.ws + WS_MODP); float* mod = (float*)(a.ws + WS_MOD);
    constexpr int NE = NL * 17 * 6144 / 4;
    for (int i = F.bk * NTHREADS + F.tid; i < NE; i += GRID * NTHREADS) {
        const int e = i * 4, l = e / (17 * 6144), n = e % 6144;
        f32x4 s = *(const f32x4*)(a.b_ada + l * 6144 + n);
#pragma unroll
        for (int kc = 0; kc < 4; ++kc) s = s + *(const f32x4*)(modp + (size_t)kc * NL * 17 * 6144 + e);
        *(f32x4*)(mod + e) = s;
    }
}

__device__ __forceinline__ void row_load(const float* p, int lane, f32x4 (&v)[4]) {
#pragma unroll
    for (int j = 0; j < 4; ++j) v[j] = *(const f32x4*)(p + 4 * lane + 256 * j);
}
__device__ __forceinline__ void row_ln(f32x4 (&v)[4], const float* g, const float* b, int lane) {
    float s = 0.f;
#pragma unroll
    for (int j = 0; j < 4; ++j) s += (v[j][0] + v[j][1]) + (v[j][2] + v[j][3]);
    const float mean = wave_sum(s) * (1.0f / D); float q = 0.f;
#pragma unroll
    for (int j = 0; j < 4; ++j) { v[j] = v[j] - mean; q += (v[j][0] * v[j][0] + v[j][1] * v[j][1]) + (v[j][2] * v[j][2] + v[j][3] * v[j][3]); }
    const float rstd = 1.0f / sqrtf(wave_sum(q) * (1.0f / D) + LN_EPS);
#pragma unroll
    for (int j = 0; j < 4; ++j) { const f32x4 gg = *(const f32x4*)(g + 4 * lane + 256 * j), bv = *(const f32x4*)(b + 4 * lane + 256 * j); v[j] = v[j] * rstd * gg + bv; }
}
__device__ __forceinline__ void row_ln_reg(f32x4 (&v)[4], const f32x4 (&g)[4], const f32x4 (&b)[4]) {
    float s = 0.f;
#pragma unroll
    for (int j = 0; j < 4; ++j) s += (v[j][0] + v[j][1]) + (v[j][2] + v[j][3]);
    const float mean = wave_sum(s) * (1.0f / D); float q = 0.f;
#pragma unroll
    for (int j = 0; j < 4; ++j) { v[j] = v[j] - mean; q += (v[j][0] * v[j][0] + v[j][1] * v[j][1]) + (v[j][2] * v[j][2] + v[j][3] * v[j][3]); }
    const float rstd = 1.0f / sqrtf(wave_sum(q) * (1.0f / D) + LN_EPS);
#pragma unroll
    for (int j = 0; j < 4; ++j) v[j] = v[j] * rstd * g[j] + b[j];
}
__device__ __forceinline__ void row_store_mod_bf16(bf16_t* hrow, const f32x4 (&v)[4], const float* sh, const float* sc, int lane) {
#pragma unroll
    for (int j = 0; j < 4; ++j) {
        const f32x4 s1 = *(const f32x4*)(sc + 4 * lane + 256 * j), s0 = *(const f32x4*)(sh + 4 * lane + 256 * j);
        const f32x4 h = v[j] * (s1 + 1.0f) + s0;
        st_bf4(hrow + 4 * lane + 256 * j, h);
    }
}

__device__ __forceinline__ void prologue3(const Ctx& F, KP kp) {
    const Args a = ldargs(kp);
    const float* modp = (const float*)(a.ws + WS_MODP); bf16_t* H = (bf16_t*)(a.ws + WS_H);
    const int gw = F.vcu * NWAVES + F.wave, NGW = GRID * NWAVES;
    for (int r = gw; r < MT; r += NGW) {
        const float* xr = (r < TL) ? (a.x + (size_t)r * D) : (a.ctx + (size_t)(r - TL) * D);
        const int bb = bb_of(r);
        f32x4 v[4]; row_load(xr, F.lane, v);
#pragma unroll
        for (int j = 0; j < 4; ++j) {
            const int c = 4 * F.lane + 256 * j;
            f32x4 sh = *(const f32x4*)(a.b_ada + c), sc = *(const f32x4*)(a.b_ada + 1024 + c);
#pragma unroll
            for (int kc = 0; kc < 4; ++kc) { const float* mp = modp + ((size_t)(kc * NL + 0) * 17 + bb) * 6144; sh = sh + *(const f32x4*)(mp + c); sc = sc + *(const f32x4*)(mp + 1024 + c); }
            st_bf4(H + (size_t)r * D + c, v[j] * (sc + 1.0f) + sh);
        }
    }
}

__device__ __forceinline__ void unpack8(const u32x4 w, float (&v)[8]) { v[0] = bflo(w.x); v[1] = bfhi(w.x); v[2] = bflo(w.y); v[3] = bfhi(w.y); v[4] = bflo(w.z); v[5] = bfhi(w.z); v[6] = bflo(w.w); v[7] = bfhi(w.w); }
__device__ __forceinline__ u32x4 pack8(const float (&v)[8]) { u32x4 w; w.x = pk2(v[0], v[1]); w.y = pk2(v[2], v[3]); w.z = pk2(v[4], v[5]); w.w = pk2(v[6], v[7]); return w; }
__device__ __forceinline__ u32x4 head64_norm_rope(const u32x4 raw, const float (&g)[8], const LAS f32x2* t64, bool lat, int gr, int gc, int w8, float scale) {
    float v[8]; unpack8(raw, v);
    float ss = 0.f;
#pragma unroll
    for (int e = 0; e < 8; ++e) ss += v[e] * v[e];
    ss += lane_xor<1>(ss); ss += lane_xor<2>(ss); ss += lane_xor<4>(ss);
    const float rn = 1.0f / sqrtf(ss * (1.0f / 64.0f) + RMS_EPS);
    float y[8], p[8], o[8];
#pragma unroll
    for (int e = 0; e < 8; ++e) { y[e] = v[e] * rn * g[e]; p[e] = lane_xor<2>(y[e]); o[e] = y[e]; }
    if (lat) {
        const int pos = (w8 >> 2) ? gc : gr; const LAS f32x2* cs = t64 + pos * 16 + 8 * (w8 & 1); const bool x2 = (w8 & 2) != 0;
#pragma unroll
        for (int e = 0; e < 8; ++e) { const f32x2 c = cs[e]; o[e] = x2 ? (y[e] * c.x + p[e] * c.y) : (y[e] * c.x - p[e] * c.y); }
    }
#pragma unroll
    for (int e = 0; e < 8; ++e) o[e] *= scale;
    return pack8(o);
}
__device__ __forceinline__ void phase_split(const Ctx& F, KP kp, int l) {
    const Args a = ldargs(kp);
    unsigned char* ws = a.ws;
    const bf16_t* Z = (const bf16_t*)(ws + WS_Z);
    float* rstdq = (float*)(ws + WS_RSTDQ); float* rstdkv = (float*)(ws + WS_RSTDKV);
    bf16_t* Km = (bf16_t*)(ws + WS_KM); bf16_t* Qg = (bf16_t*)(ws + WS_QG); bf16_t* Kg = (bf16_t*)(ws + WS_KG); bf16_t* Vg = (bf16_t*)(ws + WS_VG);
    LAS f32x2* t64 = (LAS f32x2*)(F.lds + 65536); LAS f32x2* t32 = (LAS f32x2*)(F.lds + 65536 + 8192);
    __syncthreads();
    for (int i = F.tid; i < 64 * 16; i += NTHREADS) t64[i] = ((const f32x2*)(ws + WS_TAB64))[i];
    if (F.tid < 64 * 8) t32[F.tid] = ((const f32x2*)(ws + WS_TAB32))[F.tid];
    __syncthreads();
    const int lane = F.lane, gw = F.vcu * NWAVES + F.wave, NGW = GRID * NWAVES, w8 = lane & 7;
    float ggq[8], ggk[8];
#pragma unroll
    for (int e = 0; e < 8; ++e) { ggq[e] = a.g_gq[l * 64 + 8 * w8 + e]; ggk[e] = a.g_gk[l * 64 + 8 * w8 + e]; }
    const int offA2 = 8 * (64 + (lane & 15)), offB = 672 + 8 * lane;
    const int offC = (lane < 4) ? (640 + 8 * lane) : (lane >= 8 && lane < 24) ? (1184 + 8 * (lane - 8)) : (lane >= 24 && lane < 40) ? (1312 + 8 * (lane - 24)) : 0;
    u32x4 nA1, nA2, nB, nC;
#define P2_LOAD(rr) do { const bf16_t* zr_ = Z + (size_t)(rr) * ZW; nA1 = *(const u32x4*)(zr_ + 8 * lane); nA2 = *(const u32x4*)(zr_ + offA2); nB = *(const u32x4*)(zr_ + offB); nC = *(const u32x4*)(zr_ + offC); } while (0)
    if (gw < MT) P2_LOAD(gw);
    for (int r = gw; r < MT; r += NGW) {
        const u32x4 A1 = nA1, A2 = nA2, B = nB, C = nC;
        if (r + NGW < MT) P2_LOAD(r + NGW);
        const bool lat = r < TL; const int s = r & 2047, gr = s >> 6, gc = s & 63, kr = krow_of(r);
        { float v[8]; unpack8(A1, v); float s1 = 0.f;
#pragma unroll
          for (int e = 0; e < 8; ++e) s1 += v[e] * v[e];
          unpack8(A2, v); float s2 = 0.f;
#pragma unroll
          for (int e = 0; e < 8; ++e) s2 += v[e] * v[e];
          const float sq = wave_sum(lane < 48 ? s1 : 0.f), sk = wave_sum((lane >= 48 ? s1 : 0.f) + (lane < 16 ? s2 : 0.f));
          if (lane == 0) { rstdq[r] = 1.0f / sqrtf(sq * (1.0f / 384.0f) + RMS_EPS); rstdkv[r] = 1.0f / sqrtf(sk * (1.0f / 256.0f) + RMS_EPS); } }
        { const u32x4 o = head64_norm_rope(B, ggq, t64, lat, gr, gc, w8, QSCALE_G); *(u32x4*)(Qg + (size_t)r * 512 + 8 * lane) = o; }
        { const u32x4 o = head64_norm_rope(C, ggk, t64, lat, gr, gc, w8, 1.0f); if (lane >= 8 && lane < 24) *(u32x4*)(Kg + (size_t)kr * 128 + 8 * (lane - 8)) = o; }
        if (lane >= 24 && lane < 40) *(u32x4*)(Vg + (size_t)kr * 128 + 8 * (lane - 24)) = C;
        { float v[8], p[8], o[8]; unpack8(C, v);
#pragma unroll
          for (int e = 0; e < 8; ++e) { p[e] = lane_xor<1>(v[e]); o[e] = v[e]; }
          if (lat) { const int pos = ((lane >> 1) & 1) ? gc : gr; const LAS f32x2* cs = t32 + pos * 8; const bool x2 = (lane & 1) != 0;
#pragma unroll
              for (int e = 0; e < 8; ++e) { const f32x2 c = cs[e]; o[e] = x2 ? (v[e] * c.x + p[e] * c.y) : (v[e] * c.x - p[e] * c.y); } }
          const u32x4 ow = pack8(o);
          if (lane < 4) {
#pragma unroll
              for (int h = 0; h < 8; ++h) *(u32x4*)(Km + (size_t)kr * QW + h * 96 + 64 + 8 * lane) = ow; } }
    }
#undef P2_LOAD
}

typedef float f32x4m __attribute__((ext_vector_type(4)));
template <bool XF32>
__device__ __forceinline__ void phase_ln1_route(const Ctx& F, KP kp, int l, int ntok) {
    const Args a = ldargs(kp);
    unsigned char* ws = a.ws;
    const bf16_t* Yo = (const bf16_t*)(ws + WS_U); float* XC = (float*)(ws + WS_XC); bf16_t* H = (bf16_t*)(ws + WS_H);
    bf16_t* XB = (bf16_t*)(ws + WS_XB); constexpr bool xf32 = XF32;
    const float* mod = (const float*)(ws + WS_MOD) + (size_t)l * 17 * 6144;
    int* toke = (int*)(ws + WS_TOKE); int* tokr = (int*)(ws + WS_TOKR); float* tokw = (float*)(ws + WS_TOKW);
    volatile LAS int* cntl = (volatile LAS int*)(F.lds + MISC_CNT);
    const int lane = F.lane;
    __syncthreads();
    if (F.tid < 32) cntl[F.tid] = 0;
    if (F.tid < 36) ((LAS float*)(F.lds + MISC_LG + 2048))[F.tid] = (F.tid < 4) ? a.b_rg[l * 4 + F.tid] : a.b_re[l * 32 + F.tid - 4];
    const int tpb = ntok / GRID;
    {
        f32x4 nx[4]; u32x2 ny[4]; int i = F.wave;
        f32x4 LG[4], LB[4], GA[4], SH[4], SC[4]; int bbc = -1;
#pragma unroll
        for (int j = 0; j < 4; ++j) { LG[j] = *(const f32x4*)(a.ln1_g + l * D + 4 * lane + 256 * j); LB[j] = *(const f32x4*)(a.ln1_b + l * D + 4 * lane + 256 * j); }
        u32x2 nb[4];
#define P6_LOAD(tt) do { const int t_ = (tt); \
        if (xf32) { const float* xp_ = (t_ < TL) ? (a.x + (size_t)t_ * D) : (a.ctx + (size_t)(t_ - TL) * D); row_load(xp_, lane, nx); } \
        else { _Pragma("unroll") for (int j = 0; j < 4; ++j) nb[j] = *(const u32x2*)(XB + (size_t)t_ * D + 4 * lane + 256 * j); } \
        _Pragma("unroll") for (int j = 0; j < 4; ++j) ny[j] = *(const u32x2*)(Yo + (size_t)t_ * D + 4 * lane + 256 * j); } while (0)
        if (i < tpb) P6_LOAD(F.bk * tpb + i);
        for (; i < tpb; i += NWAVES) {
            const int t = F.bk * tpb + i, bb = bb_of(t);
            if (bb != bbc) {
                bbc = bb;
#pragma unroll
                for (int j = 0; j < 4; ++j) { const int c = 4 * lane + 256 * j; GA[j] = *(const f32x4*)(mod + (size_t)(bb * 6 + 2) * D + c);
                    SH[j] = *(const f32x4*)(mod + (size_t)(bb * 6 + 3) * D + c); SC[j] = *(const f32x4*)(mod + (size_t)(bb * 6 + 4) * D + c); }
            }
            f32x4 v[4];
#pragma unroll
            for (int j = 0; j < 4; ++j) { const f32x4 y = {bflo(ny[j].x), bfhi(ny[j].x), bflo(ny[j].y), bfhi(ny[j].y)};
                const f32x4 xv = xf32 ? nx[j] : (f32x4){bflo(nb[j].x), bfhi(nb[j].x), bflo(nb[j].y), bfhi(nb[j].y)}; v[j] = xv * ALPHA + GA[j] * y; }
            if (i + NWAVES < tpb) P6_LOAD(t + NWAVES);
            row_ln_reg(v, LG, LB);
#pragma unroll
            for (int j = 0; j < 4; ++j) st_bf4(XB + (size_t)t * D + 4 * lane + 256 * j, v[j]);
#pragma unroll
            for (int j = 0; j < 4; ++j) {
                const f32x4 h = v[j] * (SC[j] + 1.0f) + SH[j];
                st_bf4(H + (size_t)t * D + 4 * lane + 256 * j, h);
            }
        }
    }
#undef P6_LOAD
    asm volatile("s_waitcnt vmcnt(0)" ::: "memory");
    __syncthreads();
    {
        const bf16_t* wrh = (const bf16_t*)(ws + WS_WR) + (size_t)(l * 2) * 48 * D; const bf16_t* wrl = wrh + (size_t)48 * D;
        LAS float* lg = (LAS float*)(F.lds + F.wave * 4096);
        const LAS float* bias = (const LAS float*)(F.lds + MISC_LG + 2048);
        const int fr = lane & 15, fq = lane >> 4;
        for (int g = F.wave; g < tpb / 16; g += NWAVES) {
            const int t0 = F.bk * tpb + g * 16;
            const bf16_t* hh = H + (size_t)(t0 + fr) * D + 8 * fq;
            f32x4m acc0 = {0.f, 0.f, 0.f, 0.f}, acc1 = acc0, acc2 = acc0;
#pragma unroll 2
            for (int ks = 0; ks < 32; ++ks) {
                const bf16x8 bh = *(const bf16x8*)(hh + 32 * ks);
                const bf16_t* wp = wrh + (size_t)fr * D + 32 * ks + 8 * fq; const bf16_t* wq = wrl + (size_t)fr * D + 32 * ks + 8 * fq;
                const bf16x8 a0h = *(const bf16x8*)(wp), a1h = *(const bf16x8*)(wp + 16 * D), a2h = *(const bf16x8*)(wp + 32 * D);
                const bf16x8 a0l = *(const bf16x8*)(wq), a1l = *(const bf16x8*)(wq + 16 * D), a2l = *(const bf16x8*)(wq + 32 * D);
                acc0 = __builtin_amdgcn_mfma_f32_16x16x32_bf16(a0h, bh, acc0, 0, 0, 0); acc1 = __builtin_amdgcn_mfma_f32_16x16x32_bf16(a1h, bh, acc1, 0, 0, 0); acc2 = __builtin_amdgcn_mfma_f32_16x16x32_bf16(a2h, bh, acc2, 0, 0, 0);
                acc0 = __builtin_amdgcn_mfma_f32_16x16x32_bf16(a0l, bh, acc0, 0, 0, 0); acc1 = __builtin_amdgcn_mfma_f32_16x16x32_bf16(a1l, bh, acc1, 0, 0, 0); acc2 = __builtin_amdgcn_mfma_f32_16x16x32_bf16(a2l, bh, acc2, 0, 0, 0);
            }
#pragma unroll
            for (int r = 0; r < 4; ++r) { lg[fr * 48 + 4 * fq + r] = acc0[r]; lg[fr * 48 + 16 + 4 * fq + r] = acc1[r]; lg[fr * 48 + 32 + 4 * fq + r] = acc2[r]; }
            LDS_WAIT();
            if (lane < 16) {
                const int t = t0 + lane; const LAS float* q = lg + lane * 48;
                float l4[4];
#pragma unroll
                for (int o = 0; o < 4; ++o) l4[o] = q[o] + bias[o];
                int gs = 0; float gm = l4[0];
#pragma unroll
                for (int o = 1; o < 4; ++o) if (l4[o] > gm) { gm = l4[o]; gs = o; }
                float den = 0.f;
#pragma unroll
                for (int o = 0; o < 4; ++o) den += expf(l4[o] - gm);
                const float pstar = 1.0f / den;
                float le[8];
#pragma unroll
                for (int o = 0; o < 8; ++o) le[o] = q[4 + gs * 8 + o] + bias[4 + gs * 8 + o];
                int i1 = 0; float v1 = le[0];
#pragma unroll
                for (int o = 1; o < 8; ++o) if (le[o] > v1) { v1 = le[o]; i1 = o; }
                int i2 = -1; float v2 = -3.0e38f;
#pragma unroll
                for (int o = 0; o < 8; ++o) if (o != i1 && le[o] > v2) { v2 = le[o]; i2 = o; }
                const float ex = expf(v2 - v1), w1 = pstar / (1.0f + ex), w2 = pstar * ex / (1.0f + ex);
                const int e1 = gs * 8 + i1, e2 = gs * 8 + i2;
                const int r1 = __hip_atomic_fetch_add((LAS int*)(F.lds + MISC_CNT) + e1, 1, __ATOMIC_RELAXED, __HIP_MEMORY_SCOPE_WORKGROUP);
                const int r2 = __hip_atomic_fetch_add((LAS int*)(F.lds + MISC_CNT) + e2, 1, __ATOMIC_RELAXED, __HIP_MEMORY_SCOPE_WORKGROUP);
                toke[2 * t] = e1; toke[2 * t + 1] = e2; tokr[2 * t] = r1; tokr[2 * t + 1] = r2; tokw[2 * t] = w1; tokw[2 * t + 1] = w2;
            }
            LDS_WAIT();
        }
    }
    __syncthreads();
    if (F.tid < 32) ((int*)(ws + WS_BLKCNT))[((size_t)l * 256 + F.bk) * 32 + F.tid] = cntl[F.tid];
}

__device__ __forceinline__ void moe_tables(const Ctx& F, KP kp, int l, bool publish) {
    const Args a = ldargs(kp);
    const int* blkcnt = (const int*)(a.ws + WS_BLKCNT) + (size_t)l * 256 * 32;
    volatile LAS int* pa = (volatile LAS int*)(F.lds + MISC_PA); volatile LAS int* pb = (volatile LAS int*)(F.lds + MISC_PB);
    volatile LAS int* tot = (volatile LAS int*)(F.lds + MISC_TOT); volatile LAS int* base = (volatile LAS int*)(F.lds + MISC_BASE); volatile LAS int* poff = (volatile LAS int*)(F.lds + MISC_POFF);
    __syncthreads();
    {
        const int e = F.tid & 31, part = F.tid >> 5; int sa = 0, sb = 0;
        for (int j = 0; j < 16; ++j) { const int b2 = part * 16 + j; const int c = blkcnt[b2 * 32 + e]; sa += c; sb += (b2 < F.bk) ? c : 0; }
        pa[part * 32 + e] = sa; pb[part * 32 + e] = sb;
    }
    __syncthreads();
    if (F.tid < 32) { int sa = 0, sb = 0; for (int p = 0; p < 16; ++p) { sa += pa[p * 32 + F.tid]; sb += pb[p * 32 + F.tid]; } tot[F.tid] = sa; base[F.tid] = sb; }
    __syncthreads();
    if (F.tid == 0) { int o = 0; for (int e = 0; e < 32; ++e) { poff[e] = o; o += (tot[e] + 255) & ~255; } poff[32] = o; }
    __syncthreads();
    if (publish && F.bk == 0 && F.tid < 33) ((int*)(a.ws + WS_MOETAB))[l * 128 + F.tid] = poff[F.tid];
}

__device__ __forceinline__ void phase_dispatch(const Ctx& F, KP kp, int l, int ntok) {
    const Args a = ldargs(kp);
    unsigned char* ws = a.ws;
    if (l > 0) conv_experts(F, a, l, -1);
    moe_tables(F, kp, l, true);
    volatile LAS int* base = (volatile LAS int*)(F.lds + MISC_BASE); volatile LAS int* poff = (volatile LAS int*)(F.lds + MISC_POFF); volatile LAS int* tot = (volatile LAS int*)(F.lds + MISC_TOT);
    const int* toke = (const int*)(ws + WS_TOKE); const int* tokr = (const int*)(ws + WS_TOKR); int* tokp = (int*)(ws + WS_TOKP); int* postok = (int*)(ws + WS_POSTOK);
    const int tpb = ntok / GRID;
    if (F.tid < tpb) {
        const int t = F.bk * tpb + F.tid;
        const int2 e = *(const int2*)(toke + 2 * t), r = *(const int2*)(tokr + 2 * t);
        const int p1 = poff[e.x] + base[e.x] + r.x, p2 = poff[e.y] + base[e.y] + r.y;
        *(int2*)(tokp + 2 * t) = (int2){p1, p2};
        postok[p1] = t; postok[p2] = t;
    }
    { const int idx = F.bk * NTHREADS + F.tid;
      if (idx < poff[32]) { int e = 0;
#pragma unroll
          for (int j = 1; j < 32; ++j) e += (poff[j] <= idx) ? 1 : 0;
          if (idx >= poff[e] + tot[e]) postok[idx] = 0; } }
}

__device__ __forceinline__ void phase_ln2(const Ctx& F, KP kp, int l, int ntok, bool dry = false) {
    const Args a = ldargs(kp);
    unsigned char* ws = a.ws;
    const bf16_t* Ys = (const bf16_t*)(ws + WS_XS); float* XC = (float*)(ws + WS_XC); bf16_t* H = (bf16_t*)(ws + WS_H);
    const float* mod = (const float*)(ws + WS_MOD) + (size_t)l * 17 * 6144;
    const float* modn = (const float*)(ws + WS_MOD) + (size_t)(l + 1 < NL ? l + 1 : l) * 17 * 6144;
    const int* tokp = (const int*)(ws + WS_TOKP); const float* tokw = (const float*)(ws + WS_TOKW);
    const int gw = F.vcu * NWAVES + F.wave, NGW = GRID * NWAVES, lane = F.lane;
    const int per = ntok / NGW, t0 = gw * per, t1 = t0 + per;
    f32x4 LG[4], LB[4], GF[4], SH[4], SC[4];
#pragma unroll
    for (int j = 0; j < 4; ++j) { LG[j] = *(const f32x4*)(a.ln2_g + l * D + 4 * lane + 256 * j); LB[j] = *(const f32x4*)(a.ln2_b + l * D + 4 * lane + 256 * j); }
    int bbc = -1;
    int2 pn = {0, 0}; float2 wn = {0.f, 0.f};
    u32x2 xn[4], yan[4], ybn[4]; bf16_t* XB = (bf16_t*)(ws + WS_XB);
#define P10_REC(tt) do { pn = *(const int2*)(tokp + 2 * (tt)); wn = *(const float2*)(tokw + 2 * (tt)); } while (0)
#define P10_ROWS(tt, p_) do { const int t_ = (tt); _Pragma("unroll") for (int j = 0; j < 4; ++j) xn[j] = *(const u32x2*)(XB + (size_t)t_ * D + 4 * lane + 256 * j); \
        _Pragma("unroll") for (int j = 0; j < 4; ++j) { yan[j] = *(const u32x2*)(Ys + (size_t)(p_).x * D + 4 * lane + 256 * j); ybn[j] = *(const u32x2*)(Ys + (size_t)(p_).y * D + 4 * lane + 256 * j); } } while (0)
    float2 wc = {0.f, 0.f};
    P10_REC(t0); wc = wn; P10_ROWS(t0, pn); if (t0 + 1 < t1) P10_REC(t0 + 1);
    for (int t = t0; t < t1; ++t) {
        const int bb = bb_of(t);
        if (bb != bbc) {
            bbc = bb;
#pragma unroll
            for (int j = 0; j < 4; ++j) { const int c = 4 * lane + 256 * j; GF[j] = *(const f32x4*)(mod + (size_t)(bb * 6 + 5) * D + c);
                SH[j] = *(const f32x4*)(modn + (size_t)(bb * 6 + 0) * D + c); SC[j] = *(const f32x4*)(modn + (size_t)(bb * 6 + 1) * D + c); }
        }
        f32x4 v[4]; u32x2 ya[4], yb[4];
#pragma unroll
        for (int j = 0; j < 4; ++j) { v[j] = (f32x4){bflo(xn[j].x), bfhi(xn[j].x), bflo(xn[j].y), bfhi(xn[j].y)}; ya[j] = yan[j]; yb[j] = ybn[j]; }
        const float w1 = wc.x, w2 = wc.y;
        if (t + 1 < t1) { wc = wn; P10_ROWS(t + 1, pn); if (t + 2 < t1) P10_REC(t + 2); }
#pragma unroll
        for (int j = 0; j < 4; ++j) {
            const f32x4 y = (f32x4){bflo(ya[j].x), bfhi(ya[j].x), bflo(ya[j].y), bfhi(ya[j].y)} * w1 + (f32x4){bflo(yb[j].x), bfhi(yb[j].x), bflo(yb[j].y), bfhi(yb[j].y)} * w2;
            v[j] = v[j] * ALPHA + GF[j] * y;
        }
        row_ln_reg(v, LG, LB);
        if (l + 1 < NL) {
#pragma unroll
            for (int j = 0; j < 4; ++j) st_bf4(XB + (size_t)t * D + 4 * lane + 256 * j, v[j]);
        } else {
#pragma unroll
            for (int j = 0; j < 4; ++j) *(f32x4*)(a.out + (size_t)t * D + 4 * lane + 256 * j) = v[j];
        }
        if (l + 1 < NL) { bf16_t* hrow = H + (size_t)t * D;
#pragma unroll
            for (int j = 0; j < 4; ++j) st_bf4(hrow + 4 * lane + 256 * j, v[j] * (SC[j] + 1.0f) + SH[j]); }
    }
#undef P10_REC
#undef P10_ROWS
}

template <int QD>
__device__ __forceinline__ void attn_naive_task(const bf16_t* qp, const bf16_t* kp, int kstride, const bf16_t* vp, int vstride, int nkeys, bf16_t* op) {
    u32x4 qv[QD / 8];
#pragma unroll
    for (int i = 0; i < QD / 8; ++i) qv[i] = *(const u32x4*)(qp + 8 * i);
#pragma unroll 1
    for (int half = 0; half < 2; ++half) {
        float o[32];
#pragma unroll
        for (int i = 0; i < 32; ++i) o[i] = 0.f;
        float m = -1.0e30f, lsum = 0.f;
#pragma unroll 1
        for (int j = 0; j < nkeys; ++j) {
            const u32x4* kr = (const u32x4*)(kp + (size_t)j * kstride);
            float s = 0.f;
#pragma unroll
            for (int i = 0; i < QD / 8; ++i) s = dot8(qv[i], kr[i], s);
            if (s > m) { const float al = __builtin_amdgcn_exp2f(m - s); lsum *= al;
#pragma unroll
                for (int i = 0; i < 32; ++i) o[i] *= al;
                m = s; }
            const float p = __builtin_amdgcn_exp2f(s - m); lsum += p;
            const u32x4* vr = (const u32x4*)(vp + (size_t)j * vstride + 32 * half);
#pragma unroll
            for (int i = 0; i < 4; ++i) { const u32x4 w = vr[i];
                o[8 * i + 0] += p * bflo(w.x); o[8 * i + 1] += p * bfhi(w.x); o[8 * i + 2] += p * bflo(w.y); o[8 * i + 3] += p * bfhi(w.y); o[8 * i + 4] += p * bflo(w.z); o[8 * i + 5] += p * bfhi(w.z); o[8 * i + 6] += p * bflo(w.w); o[8 * i + 7] += p * bfhi(w.w); }
        }
        const float rl = 1.0f / lsum;
#pragma unroll
        for (int i = 0; i < 4; ++i) { u32x4 w; w.x = pk2(o[8 * i] * rl, o[8 * i + 1] * rl); w.y = pk2(o[8 * i + 2] * rl, o[8 * i + 3] * rl); w.z = pk2(o[8 * i + 4] * rl, o[8 * i + 5] * rl); w.w = pk2(o[8 * i + 6] * rl, o[8 * i + 7] * rl); *(u32x4*)(op + 32 * half + 8 * i) = w; }
    }
}
__device__ __forceinline__ void phase_attn_naive(const Ctx& F, KP kp, bool last) {
    const Args a = ldargs(kp);
    unsigned char* ws = a.ws;
    const bf16_t* Qm = (const bf16_t*)(ws + WS_QM); const bf16_t* Km = (const bf16_t*)(ws + WS_KM); const bf16_t* Vm = (const bf16_t*)(ws + WS_VM);
    const bf16_t* Qg = (const bf16_t*)(ws + WS_QG); const bf16_t* Kg = (const bf16_t*)(ws + WS_KG); const bf16_t* Vg = (const bf16_t*)(ws + WS_VG);
    bf16_t* O = (bf16_t*)(ws + WS_O);
    const int gw = F.vcu * NWAVES + F.wave, NGW = GRID * NWAVES;
    const int ntask = 8192 + (last ? 0 : 1024);
    for (int T = gw; T < ntask; T += NGW) {
        int b, h16, r, nkeys;
        if (T < 8192) { const int qw = T & 31; h16 = (T >> 5) & 15; b = T >> 9; r = b * SEQ + 64 * qw + F.lane; nkeys = KPB; }
        else { const int T2 = T - 8192, qw = T2 & 3; h16 = (T2 >> 2) & 15; b = T2 >> 6; r = TL + b * CTX + 64 * qw + F.lane; nkeys = CTX; }
        bf16_t* op = O + (size_t)r * D + h16 * 64;
        if (h16 < 8) attn_naive_task<96>(Qm + (size_t)r * QW + h16 * 96, Km + (size_t)b * KPB * QW + h16 * 96, QW, Vm + (size_t)b * KPB * 512 + h16 * 64, 512, nkeys, op);
        else { const int hh = h16 - 8, kvh = hh >> 2; attn_naive_task<64>(Qg + (size_t)r * 512 + hh * 64, Kg + (size_t)b * KPB * 128 + kvh * 64, 128, Vg + (size_t)b * KPB * 128 + kvh * 64, 128, nkeys, op); }
    }
}

typedef float f32x16 __attribute__((ext_vector_type(16)));
typedef short s16x4 __attribute__((ext_vector_type(4)));
__device__ __forceinline__ s16x4 vtr(const LAS unsigned char* p) { return __builtin_bit_cast(s16x4, __builtin_amdgcn_ds_read_tr16_b64_v4i16((LAS s16x4*)p)); }
__device__ __forceinline__ unsigned cvtpk(float lo, float hi) { typedef __bf16 bf2 __attribute__((ext_vector_type(2))); f32x2 v = {lo, hi}; bf2 b = __builtin_convertvector(v, bf2); return __builtin_bit_cast(unsigned, b); }
constexpr float ATT_THR = 6.0f;
constexpr int ATT_KSLOT = 12288, ATT_VSLOT = 8192, ATT_NKS = 3, ATT_NVS = 4, ATT_V0 = ATT_NKS * ATT_KSLOT;
__device__ __forceinline__ void att_glds16(const void* gsrc, unsigned lds_dst) { unsigned keep;
    asm volatile("s_mov_b32 %0, m0\n\ts_mov_b32 m0, %2\n\ts_nop 0\n\tglobal_load_lds_dwordx4 %1, off\n\ts_mov_b32 m0, %0" : "=&s"(keep) : "v"(gsrc), "s"(lds_dst) : "memory"); }
#define ATT_WAITBAR(N) asm volatile("s_waitcnt vmcnt(" #N ") lgkmcnt(0)\n\ts_barrier" ::: "memory")
template <int QD>
__device__ __forceinline__ void attn_unit(LAS unsigned char* lds, int tid, const bf16_t* Kb, int kstride, const bf16_t* Vb, int vstride, int ntiles, const bf16_t* qrow, bf16_t* orow) {
    constexpr int NC = QD / 8, NS = QD / 16;
    const int lane = tid & 63, r32 = lane & 31, hi = lane >> 5;
    const int w = __builtin_amdgcn_readfirstlane(tid >> 6);
    const bool three = (NC == 12) && (w < 4);
    const int vp = (NC == 12) ? (w < 4 ? w + 4 : w - 4) : w;
    const bf16_t* ksrcA = Kb + (size_t)lane * kstride + w * 8;
    const bf16_t* ksrcB = Kb + (size_t)lane * kstride + (w + 8) * 8;
    const bf16_t* vsrc = Vb + (size_t)(16 * (vp & 3) + (lane >> 2)) * vstride + (vp >> 2) * 32 + (lane & 3) * 8;
    const size_t kstep = (size_t)64 * kstride, vstep = (size_t)64 * vstride;
    const unsigned lds0 = (unsigned)(size_t)lds;
#define ATT_DMA(t_, ks_, vs_) do { \
        att_glds16(ksrcA + (size_t)(t_) * kstep, (unsigned)__builtin_amdgcn_readfirstlane((int)(lds0 + (ks_) * ATT_KSLOT + w * 1024))); \
        if (three) att_glds16(ksrcB + (size_t)(t_) * kstep, (unsigned)__builtin_amdgcn_readfirstlane((int)(lds0 + (ks_) * ATT_KSLOT + (w + 8) * 1024))); \
        att_glds16(vsrc + (size_t)(t_) * vstep, (unsigned)__builtin_amdgcn_readfirstlane((int)(lds0 + ATT_V0 + (vs_) * ATT_VSLOT + vp * 1024))); } while (0)
    ATT_DMA(0, 0, 0);
    if (ntiles > 1) ATT_DMA(1, 1, 1);
    bf16x8 qr[NS];
#pragma unroll
    for (int s = 0; s < NS; ++s) qr[s] = *(const bf16x8*)(qrow + 16 * s + 8 * hi);
    f32x16 o0, o1, negm, p0, p1;
#pragma unroll
    for (int r = 0; r < 16; ++r) { o0[r] = 0.f; o1[r] = 0.f; negm[r] = 0.f; p0[r] = 0.f; p1[r] = 0.f; }
    float lsum = 0.f;
    const int kread = hi * 1024 + r32 * 16;
    const int vread = ATT_V0 + ((lane >> 4) & 1) * 32 + (lane & 3) * 8 + (4 * hi + ((lane & 15) >> 2)) * 64;
#define ATT_QK(ks_) do { const LAS unsigned char* kb_ = lds + (ks_) * ATT_KSLOT + kread; \
        _Pragma("unroll") for (int s = 0; s < NS; ++s) { \
            const bf16x8 a0 = *(const LAS bf16x8*)(kb_ + s * 2048), a1 = *(const LAS bf16x8*)(kb_ + s * 2048 + 512); \
            if (s == 0) { p0 = __builtin_amdgcn_mfma_f32_32x32x16_bf16(a0, qr[0], negm, 0, 0, 0); p1 = __builtin_amdgcn_mfma_f32_32x32x16_bf16(a1, qr[0], negm, 0, 0, 0); } \
            else { p0 = __builtin_amdgcn_mfma_f32_32x32x16_bf16(a0, qr[s], p0, 0, 0, 0); p1 = __builtin_amdgcn_mfma_f32_32x32x16_bf16(a1, qr[s], p1, 0, 0, 0); } } } while (0)
#define ATT_SOFT_PV(first_, vs_) do { \
        float mx = fmaxf(fmaxf(p0[0], p1[0]), p0[1]); \
        _Pragma("unroll") for (int r = 1; r < 16; ++r) mx = (r == 1) ? fmaxf(mx, p1[1]) : fmaxf(fmaxf(mx, p0[r]), p1[r]); \
        { auto rr = __builtin_amdgcn_permlane32_swap(__float_as_uint(mx), __float_as_uint(mx), false, false); mx = fmaxf(__uint_as_float(rr[0]), __uint_as_float(rr[1])); } \
        if ((first_) || __any(mx > ATT_THR)) { \
            const float dl = (first_) ? mx : fmaxf(mx, 0.f); \
            _Pragma("unroll") for (int r = 0; r < 16; ++r) { p0[r] -= dl; p1[r] -= dl; negm[r] -= dl; } \
            if (!(first_)) { const float f = __builtin_amdgcn_exp2f(-dl); lsum *= f; \
                _Pragma("unroll") for (int r = 0; r < 16; ++r) { o0[r] *= f; o1[r] *= f; } } \
        } \
        float rs = 0.f; \
        _Pragma("unroll") for (int r = 0; r < 16; ++r) { p0[r] = __builtin_amdgcn_exp2f(p0[r]); p1[r] = __builtin_amdgcn_exp2f(p1[r]); rs += p0[r] + p1[r]; } \
        lsum += rs; \
        u32x4 w0, w1, w2, w3; \
        w0.x = cvtpk(p0[0], p0[1]); w0.y = cvtpk(p0[2], p0[3]); w0.z = cvtpk(p0[4], p0[5]); w0.w = cvtpk(p0[6], p0[7]); \
        w1.x = cvtpk(p0[8], p0[9]); w1.y = cvtpk(p0[10], p0[11]); w1.z = cvtpk(p0[12], p0[13]); w1.w = cvtpk(p0[14], p0[15]); \
        w2.x = cvtpk(p1[0], p1[1]); w2.y = cvtpk(p1[2], p1[3]); w2.z = cvtpk(p1[4], p1[5]); w2.w = cvtpk(p1[6], p1[7]); \
        w3.x = cvtpk(p1[8], p1[9]); w3.y = cvtpk(p1[10], p1[11]); w3.z = cvtpk(p1[12], p1[13]); w3.w = cvtpk(p1[14], p1[15]); \
        const bf16x8 pa0 = __builtin_bit_cast(bf16x8, w0), pa1 = __builtin_bit_cast(bf16x8, w1), pa2 = __builtin_bit_cast(bf16x8, w2), pa3 = __builtin_bit_cast(bf16x8, w3); \
        const LAS unsigned char* vb_ = lds + (vs_) * ATT_VSLOT + vread; \
        o0 = __builtin_amdgcn_mfma_f32_32x32x16_bf16(ATT_VF(0, 0), pa0, o0, 0, 0, 0); \
        o1 = __builtin_amdgcn_mfma_f32_32x32x16_bf16(ATT_VF(1, 0), pa0, o1, 0, 0, 0); \
        o0 = __builtin_amdgcn_mfma_f32_32x32x16_bf16(ATT_VF(0, 1), pa1, o0, 0, 0, 0); \
        o1 = __builtin_amdgcn_mfma_f32_32x32x16_bf16(ATT_VF(1, 1), pa1, o1, 0, 0, 0); \
        o0 = __builtin_amdgcn_mfma_f32_32x32x16_bf16(ATT_VF(0, 2), pa2, o0, 0, 0, 0); \
        o1 = __builtin_amdgcn_mfma_f32_32x32x16_bf16(ATT_VF(1, 2), pa2, o1, 0, 0, 0); \
        o0 = __builtin_amdgcn_mfma_f32_32x32x16_bf16(ATT_VF(0, 3), pa3, o0, 0, 0, 0); \
        o1 = __builtin_amdgcn_mfma_f32_32x32x16_bf16(ATT_VF(1, 3), pa3, o1, 0, 0, 0); } while (0)
#define ATT_VF(d0, ks) ({ const s16x4 lo_ = vtr(vb_ + (d0) * 4096 + (ks) * 1024), hi_ = vtr(vb_ + (d0) * 4096 + (ks) * 1024 + 512); (bf16x8){lo_[0], lo_[1], lo_[2], lo_[3], hi_[0], hi_[1], hi_[2], hi_[3]}; })
#define ATT_ENDSTEP() do { if (issue) { if (three) ATT_WAITBAR(3); else ATT_WAITBAR(2); } else ATT_WAITBAR(0); \
        ks = (ks == ATT_NKS - 1) ? 0 : ks + 1; vs = (vs + 1) & (ATT_NVS - 1); } while (0)
    if (ntiles > 1) { if (three) ATT_WAITBAR(3); else ATT_WAITBAR(2); } else ATT_WAITBAR(0);
    int ks = 0, vs = 0;
    if (w < 4) {
        for (int t = 0; t < ntiles; ++t) {
            const bool issue = (t + 2 < ntiles);
            if (issue) ATT_DMA(t + 2, (ks >= 1) ? ks - 1 : ATT_NKS - 1, (vs + 2) & (ATT_NVS - 1));
            ATT_QK(ks);
            ATT_SOFT_PV(t == 0, vs);
            ATT_ENDSTEP();
        }
    } else {
        for (int t = 0; t < ntiles; ++t) {
            const bool issue = (t + 2 < ntiles);
            if (issue) ATT_DMA(t + 2, (ks >= 1) ? ks - 1 : ATT_NKS - 1, (vs + 2) & (ATT_NVS - 1));
            if (t > 0) ATT_SOFT_PV(t == 1, (vs + ATT_NVS - 1) & (ATT_NVS - 1));
            ATT_QK(ks);
            ATT_ENDSTEP();
        }
        ATT_SOFT_PV(ntiles == 1, (vs + ATT_NVS - 1) & (ATT_NVS - 1));
    }
#undef ATT_DMA
#undef ATT_QK
#undef ATT_SOFT_PV
#undef ATT_VF
#undef ATT_ENDSTEP
    { auto rr = __builtin_amdgcn_permlane32_swap(__float_as_uint(lsum), __float_as_uint(lsum), false, false); lsum = __uint_as_float(rr[0]) + __uint_as_float(rr[1]); }
    const float rl = 1.0f / lsum;
#pragma unroll
    for (int g = 0; g < 4; ++g) {
        u32x2 a, b2;
        a.x = cvtpk(o0[4 * g] * rl, o0[4 * g + 1] * rl); a.y = cvtpk(o0[4 * g + 2] * rl, o0[4 * g + 3] * rl);
        b2.x = cvtpk(o1[4 * g] * rl, o1[4 * g + 1] * rl); b2.y = cvtpk(o1[4 * g + 2] * rl, o1[4 * g + 3] * rl);
        *(u32x2*)(orow + 8 * g + 4 * hi) = a; *(u32x2*)(orow + 32 + 8 * g + 4 * hi) = b2;
    }
    asm volatile("s_waitcnt lgkmcnt(0)\n\ts_barrier" ::: "memory");
}
__device__ __forceinline__ void phase_attn(const Ctx& F, KP kp, bool last) {
    const Args a = ldargs(kp);
    unsigned char* ws = a.ws;
    const bf16_t* Qm = (const bf16_t*)(ws + WS_QM); const bf16_t* Km = (const bf16_t*)(ws + WS_KM); const bf16_t* Vm = (const bf16_t*)(ws + WS_VM);
    const bf16_t* Qg = (const bf16_t*)(ws + WS_QG); const bf16_t* Kg = (const bf16_t*)(ws + WS_KG); const bf16_t* Vg = (const bf16_t*)(ws + WS_VG);
    bf16_t* O = (bf16_t*)(ws + WS_O);
    const int xcd = F.vcu >> 5, cix = F.vcu & 31, r32 = F.lane & 31, w = F.wave;
    const int nun = last ? 8 : 9;
    for (int i = 0; i < nun; ++i) {
        if (i < 8 && (i & 1) == 0) {
            const int pair = xcd * 16 + (i >> 1) * 4 + (cix >> 3), b = pair >> 3, h = pair & 7, qb = cix & 7;
            const int row = b * SEQ + qb * 256 + w * 32 + r32;
            attn_unit<96>(F.lds, F.tid, Km + (size_t)b * KPB * QW + h * 96, QW, Vm + (size_t)b * KPB * 512 + h * 64, 512, KPB / 64, Qm + (size_t)row * QW + h * 96, O + (size_t)row * D + h * 64);
        } else if (i < 8) {
            const int pair = xcd * 4 + (i >> 1), b = pair >> 1, kvh = pair & 1, hh = kvh * 4 + (w >> 1);
            const int row = b * SEQ + cix * 64 + (w & 1) * 32 + r32;
            attn_unit<64>(F.lds, F.tid, Kg + (size_t)b * KPB * 128 + kvh * 64, 128, Vg + (size_t)b * KPB * 128 + kvh * 64, 128, KPB / 64, Qg + (size_t)row * 512 + hh * 64, O + (size_t)row * D + 512 + hh * 64);
        } else if (F.vcu < 128) {
            const int b = F.vcu >> 3, h = F.vcu & 7, row = TL + b * CTX + w * 32 + r32;
            attn_unit<96>(F.lds, F.tid, Km + (size_t)b * KPB * QW + h * 96, QW, Vm + (size_t)b * KPB * 512 + h * 64, 512, CTX / 64, Qm + (size_t)row * QW + h * 96, O + (size_t)row * D + h * 64);
        } else {
            const int idx = F.vcu - 128, b = idx >> 3, kvh = (idx >> 2) & 1, qb = idx & 3, hh = kvh * 4 + (w >> 1);
            const int row = TL + b * CTX + qb * 64 + (w & 1) * 32 + r32;
            attn_unit<64>(F.lds, F.tid, Kg + (size_t)b * KPB * 128 + kvh * 64, 128, Vg + (size_t)b * KPB * 128 + kvh * 64, 128, CTX / 64, Qg + (size_t)row * 512 + hh * 64, O + (size_t)row * D + 512 + hh * 64);
        }
    }
}
__global__ void __launch_bounds__(NTHREADS, 2) fwd_kernel(Args a_unused) {
    extern __shared__ __attribute__((aligned(16))) unsigned char lds_raw[];
    const KP kp = (KP)__builtin_amdgcn_kernarg_segment_ptr();
    Ctx F;
    F.lds = (LAS unsigned char*)lds_raw;
    F.tid = threadIdx.x; F.lane = F.tid & 63; F.wave = __builtin_amdgcn_readfirstlane(F.tid >> 6);
    F.bk = blockIdx.x; F.vcu = (F.bk & 7) * (GRID / 8) + (F.bk >> 3);
    if (F.tid < 4) ((volatile LAS unsigned*)(F.lds + MISC_BAR))[F.tid] = 0u;
    __syncthreads();
    { const Args a = ldargs(kp); (void)xcd_barrier_post((unsigned*)(a.ws + WS_CTL), (volatile LAS unsigned*)(F.lds + MISC_BAR), F.tid == 0); }
#define FRESH() do { int ln_; asm volatile("v_mbcnt_lo_u32_b32 %0, -1, 0\n\tv_mbcnt_hi_u32_b32 %0, -1, %0" : "=v"(ln_)); F.lane = ln_; F.tid = F.wave * 64 + ln_; F.bk = blockIdx.x; F.vcu = (F.bk & 7) * (GRID / 8) + (F.bk >> 3); } while (0)
#define GRID_BAR() do { XcdBarrier b_; { const Args a_ = ldargs(kp); b_.bar = (unsigned*)(a_.ws + WS_CTL); } b_.x = xb_xcc_id(); b_.st = (volatile LAS unsigned*)(F.lds + MISC_BAR); xcd_barrier(b_, F.tid == 0); } while (0)

    for (int rep_ = 0; rep_ < REP_PRO; ++rep_) prologue1(F, kp);
    GRID_BAR(); FRESH();
    prologue2(F, kp);
    prologue3(F, kp);
    GRID_BAR(); FRESH();

    for (int l = 0; l < NL; ++l) {
        const bool last = (l == NL - 1);
        const int ntok = last ? TL : MT;
        { const Args a = ldargs(kp); unsigned char* ws = a.ws;
          Gemm g{(const bf16_t*)(ws + WS_H), D, (const bf16_t*)(ws + WS_WIN) + (size_t)l * ZW * D, D}; StaticOrder S; S.init(MT, ZW, GRID, F.bk); EpiZ E{(bf16_t*)(ws + WS_Z)}; gemm_phase<0>(F, g, S, E); }
        if (F.bk >= (MT / 256) * (ZW / 256) - 3 * GRID) conv_filler(F, kp, l, FILL_P1);
        GRID_BAR(); FRESH();
        for (int rep_ = 0; rep_ < REP_P2; ++rep_) phase_split(F, kp, l);
        GRID_BAR(); FRESH();
        { const Args a = ldargs(kp); unsigned char* ws = a.ws;
          Gemm g{(const bf16_t*)(ws + WS_Z), ZW, (const bf16_t*)(ws + WS_WQ) + (size_t)l * QW * 384, 384}; StaticOrder S; S.init(MT, QW, GRID, F.bk);
          EpiQ E{(bf16_t*)(ws + WS_QM), (const float*)(ws + WS_RSTDQ), (const f32x2*)(ws + WS_TAB32)}; gemm_phase<1>(F, g, S, E); }
        FRESH();
        { const Args a = ldargs(kp); unsigned char* ws = a.ws;
          Gemm g{(const bf16_t*)(ws + WS_Z) + 384, ZW, (const bf16_t*)(ws + WS_WKV) + (size_t)l * KVW * 256, 256}; StaticOrder S; S.init(MT, KVW, GRID, (F.bk + 80) & 255);
          EpiKV E{(bf16_t*)(ws + WS_KM), (bf16_t*)(ws + WS_VM), (const float*)(ws + WS_RSTDKV)}; gemm_phase<2>(F, g, S, E); }
        GRID_BAR(); FRESH();
#if USE_MFMA_ATTN
        for (int rep_ = 0; rep_ < REP_ATTN; ++rep_) phase_attn(F, kp, last);
#else
        phase_attn_naive(F, kp, last);
#endif
        GRID_BAR(); FRESH();
        { const Args a = ldargs(kp); unsigned char* ws = a.ws;
          Gemm g{(const bf16_t*)(ws + WS_O), D, (const bf16_t*)(ws + WS_WO) + (size_t)l * D * D, D}; StaticOrder S; S.init(ntok, D, GRID, F.bk);
          EpiYo E{(bf16_t*)(ws + WS_U)}; gemm_phase<3>(F, g, S, E); }
        if (!last && F.bk >= (MT / 256) * (D / 256) - 2 * GRID) conv_filler(F, kp, l, FILL_P5);
        GRID_BAR(); FRESH();
        if (l == 0) phase_ln1_route<true>(F, kp, l, ntok); else phase_ln1_route<false>(F, kp, l, ntok);
        GRID_BAR(); FRESH();
        for (int rep_ = 0; rep_ < REP_P7; ++rep_) phase_dispatch(F, kp, l, ntok);
        GRID_BAR(); FRESH();
        { const Args a = ldargs(kp); unsigned char* ws = a.ws;
          Gemm g{(const bf16_t*)(ws + WS_H), D, (const bf16_t*)(ws + WS_WGU) + (size_t)l * NEXP * 1024 * D, D}; GroupedOrder S; S.init((const volatile LAS int*)(F.lds + MISC_POFF), GRID, F.vcu);
          LAS int* gt = (LAS int*)(F.lds + STAGE_BYTES);
          { const int* postok = (const int*)(ws + WS_POSTOK); Unit u; for (int i = 0; i < 16 && S.next(i, u); ++i) if (F.tid < 256) gt[i * 256 + F.tid] = postok[u.pm * 256 + F.tid]; }
          __syncthreads();
          EpiAct E{(bf16_t*)(ws + WS_ACT)}; gemm_phase_gather<4>(F, g, S, E, gt); }
        GRID_BAR(); FRESH();
        { const Args a = ldargs(kp); unsigned char* ws = a.ws;
          Gemm g{(const bf16_t*)(ws + WS_ACT), FF, (const bf16_t*)(ws + WS_WD) + (size_t)l * NEXP * D * FF, FF}; GroupedOrder S; S.init((const volatile LAS int*)(F.lds + MISC_POFF), GRID, F.vcu);
          EpiY E{(bf16_t*)(ws + WS_XS)}; gemm_phase<5>(F, g, S, E); }
        GRID_BAR(); FRESH();
        phase_ln2(F, kp, l, ntok);
        GRID_BAR(); FRESH();
    }
}

extern "C" void kernel_launch(void* const* d_in, const int* in_sizes, int n_in, void* d_out, int out_size, void* d_ws, size_t ws_size, hipStream_t stream) {
    static int grid = 0;
    if (grid == 0) {
        if (n_in != 25 || out_size != TL * D || ws_size < WS_END) { fprintf(stderr, "kernel_launch: unexpected shapes (n_in %d out %d ws %zu need %zu)\n", n_in, out_size, ws_size, (size_t)WS_END); grid = -1; return; }
        int dev = 0, cus = 0, per_cu = 0;
        if (hipGetDevice(&dev) != hipSuccess || hipDeviceGetAttribute(&cus, hipDeviceAttributeMultiprocessorCount, dev) != hipSuccess) { grid = -1; return; }
        if (hipFuncSetAttribute((const void*)fwd_kernel, hipFuncAttributeMaxDynamicSharedMemorySize, LDS_BYTES) != hipSuccess) { fprintf(stderr, "kernel_launch: hipFuncSetAttribute failed\n"); grid = -1; return; }
        if (hipOccupancyMaxActiveBlocksPerMultiprocessor(&per_cu, (const void*)fwd_kernel, NTHREADS, LDS_BYTES) != hipSuccess || per_cu < 1) { fprintf(stderr, "kernel_launch: occupancy query says %d\n", per_cu); }
        (void)hipGetLastError();
        grid = (cus == 256) ? 256 : -1;
        if (grid < 0) { fprintf(stderr, "kernel_launch: need a 256-CU device, got %d\n", cus); return; }
    }
    if (grid < 0) return;
    if (hipMemsetAsync((char*)d_ws + WS_CTL, 0, CTL_BYTES, stream) != hipSuccess) return;
    Args a{};
    a.x = (const float*)d_in[0]; a.c = (const float*)d_in[1]; a.ctx = (const float*)d_in[2]; a.c_ctx = (const float*)d_in[3]; a.w_ada = (const float*)d_in[4]; a.b_ada = (const float*)d_in[5];
    a.w_in = (const float*)d_in[6]; a.g_q_a = (const float*)d_in[7]; a.w_q_b = (const float*)d_in[8]; a.g_kv_a = (const float*)d_in[9]; a.w_kv_b = (const float*)d_in[10];
    a.g_gq = (const float*)d_in[11]; a.g_gk = (const float*)d_in[12]; a.w_o = (const float*)d_in[13]; a.ln1_g = (const float*)d_in[14]; a.ln1_b = (const float*)d_in[15];
    a.w_rg = (const float*)d_in[16]; a.b_rg = (const float*)d_in[17]; a.w_re = (const float*)d_in[18]; a.b_re = (const float*)d_in[19];
    a.w_gate = (const float*)d_in[20]; a.w_up = (const float*)d_in[21]; a.w_down = (const float*)d_in[22]; a.ln2_g = (const float*)d_in[23]; a.ln2_b = (const float*)d_in[24];
    a.out = (float*)d_out; a.ws = (unsigned char*)d_ws;
    hipLaunchKernelGGL(fwd_kernel, dim3(grid), dim3(NTHREADS), LDS_BYTES, stream, a);
}
```

```cpp
#include <hip/hip_runtime.h>
#include <cstdint>
#include <cstdio>

#ifndef REP_ATTN
#define REP_ATTN 1
#endif
#ifndef REP_GEMM
#define REP_GEMM 1
#endif
#ifndef REP_PRO
#define REP_PRO 1
#endif
#ifndef REP_THIN
#define REP_THIN 1
#endif
#ifndef REP_P2
#define REP_P2 1
#endif
#ifndef REP_P7
#define REP_P7 1
#endif
#ifndef REP_P6
#define REP_P6 1
#endif
#ifndef REP_P10
#define REP_P10 0
#endif
#ifndef FILL_P1
#define FILL_P1 3
#endif
#ifndef FILL_P5
#define FILL_P5 3
#endif
#ifndef FUSE_SPLIT
#define FUSE_SPLIT 1
#endif
#ifndef USE_MFMA_GEMM
#define USE_MFMA_GEMM 1
#endif
#ifndef USE_MFMA_ATTN
#define USE_MFMA_ATTN 1
#endif

#define GAS __attribute__((address_space(1)))
#define LAS __attribute__((address_space(3)))
typedef unsigned short bf16_t;
typedef float f32x4 __attribute__((ext_vector_type(4)));
typedef float f32x2 __attribute__((ext_vector_type(2)));
typedef unsigned u32x4 __attribute__((ext_vector_type(4)));
typedef unsigned u32x2 __attribute__((ext_vector_type(2)));
typedef short bf16x8 __attribute__((ext_vector_type(8)));

constexpr int D = 1024, NB = 16, SEQ = 2048, CTX = 256, NL = 4;
constexpr int TL = NB * SEQ, TC = NB * CTX, MT = TL + TC;
constexpr int KPB = CTX + SEQ;
constexpr int ZW = 1536;
constexpr int QW = 768, KVW = 1024;
constexpr int NEXP = 32, FF = 512;
constexpr int XS_ROWS = 81920;
constexpr float ALPHA = 1.6817928305074290f;
constexpr float LOG2E = 1.4426950408889634f;
constexpr float QSCALE_M = 0.10206207261596575f * LOG2E;
constexpr float QSCALE_G = 0.125f * LOG2E;
constexpr float RMS_EPS = 1e-6f, LN_EPS = 1e-5f;
constexpr int NWAVES = 8, NTHREADS = 512, GRID = 256;

constexpr size_t al256(size_t x) { return (x + 255) & ~(size_t)255; }
constexpr size_t WS_CTL = 0, CTL_BYTES = 65536;
constexpr size_t WS_BLKCNT = WS_CTL + CTL_BYTES;
constexpr size_t WS_MOETAB = WS_BLKCNT + (size_t)NL * 256 * 32 * 4;
constexpr size_t WS_MOD = WS_MOETAB + (size_t)NL * 128 * 4;
constexpr size_t WS_MODP = WS_MOD + (size_t)NL * 17 * 6144 * 4;
constexpr size_t WS_TAB64 = WS_MODP + (size_t)4 * NL * 17 * 6144 * 4;
constexpr size_t WS_TAB32 = WS_TAB64 + 64 * 16 * 8;
constexpr size_t WS_RSTDQ = WS_TAB32 + 64 * 8 * 8;
constexpr size_t WS_RSTDKV = WS_RSTDQ + (size_t)MT * 4;
constexpr size_t WS_TOKE = WS_RSTDKV + (size_t)MT * 4;
constexpr size_t WS_TOKR = WS_TOKE + (size_t)MT * 8;
constexpr size_t WS_TOKP = WS_TOKR + (size_t)MT * 8;
constexpr size_t WS_TOKW = WS_TOKP + (size_t)MT * 8;
constexpr size_t WS_WIN = al256(WS_TOKW + (size_t)MT * 8);
constexpr size_t WS_WQ = WS_WIN + (size_t)NL * ZW * D * 2;
constexpr size_t WS_WKV = WS_WQ + (size_t)NL * QW * 384 * 2;
constexpr size_t WS_WO = WS_WKV + (size_t)NL * KVW * 256 * 2;
constexpr size_t WS_WGU = WS_WO + (size_t)NL * D * D * 2;
constexpr size_t WS_WD = WS_WGU + (size_t)NL * NEXP * 1024 * D * 2;
constexpr size_t WS_XC = WS_WD + (size_t)NL * NEXP * D * FF * 2;
constexpr size_t WS_H = WS_XC + (size_t)TC * D * 4;
constexpr size_t WS_B = WS_H + (size_t)MT * D * 2;
constexpr size_t WS_Z = WS_B;
constexpr size_t WS_QM = WS_Z + (size_t)MT * ZW * 2;
constexpr size_t WS_KM = WS_QM + (size_t)MT * QW * 2;
constexpr size_t WS_VM = WS_KM + (size_t)MT * QW * 2;
constexpr size_t WS_QG = WS_VM + (size_t)MT * 512 * 2;
constexpr size_t WS_KG = WS_QG + (size_t)MT * 512 * 2;
constexpr size_t WS_VG = WS_KG + (size_t)MT * 128 * 2;
constexpr size_t WS_O = WS_VG + (size_t)MT * 128 * 2;
constexpr size_t WS_BEND = WS_O + (size_t)MT * D * 2;
constexpr size_t WS_U = WS_B;
constexpr size_t WS_XS = WS_B;
constexpr size_t WS_ACT = WS_XS + (size_t)XS_ROWS * D * 2;
constexpr size_t WS_HLO = WS_BEND;
constexpr size_t WS_WR = WS_HLO + (size_t)MT * D * 2;
constexpr size_t WS_POSTOK = WS_WR + (size_t)NL * 2 * 48 * D * 2;
constexpr size_t WS_SSQP = al256(WS_POSTOK + (size_t)XS_ROWS * 4);
constexpr size_t WS_XB = al256(WS_SSQP + (size_t)MT * 20 * 4);
constexpr size_t WS_END = WS_XB + (size_t)MT * D * 2;
static_assert(WS_U + (size_t)MT * D * 4 <= WS_KM, "U must fit in Z+QM");
static_assert(WS_ACT + (size_t)XS_ROWS * FF * 2 <= WS_BEND, "MoE buffers must fit in region B");
static_assert(WS_END < (size_t)1100 * 1000 * 1000, "workspace map too large");

constexpr int LDS_BYTES = 163840;
constexpr int BIG_BYTES = 147456;
constexpr int MISC_OFF = BIG_BYTES;
constexpr int MISC_BAR = MISC_OFF;
constexpr int MISC_CNT = MISC_OFF + 64;
constexpr int MISC_POFF = MISC_OFF + 256;
constexpr int MISC_TOT = MISC_OFF + 512;
constexpr int MISC_BASE = MISC_OFF + 768;
constexpr int MISC_PA = MISC_OFF + 1024;
constexpr int MISC_PB = MISC_OFF + 1024 + 2048;
constexpr int MISC_LG = MISC_OFF + 8192;

#define LDS_WAIT() asm volatile("s_waitcnt lgkmcnt(0)" ::: "memory")
__device__ __forceinline__ unsigned f2bf(float f) { unsigned u = __builtin_bit_cast(unsigned, f); return (u + 0x7fffu + ((u >> 16) & 1u)) >> 16; }
__device__ __forceinline__ unsigned pk2(float lo, float hi) { typedef __bf16 bf2_t __attribute__((ext_vector_type(2))); f32x2 v = {lo, hi}; bf2_t b = __builtin_convertvector(v, bf2_t); return __builtin_bit_cast(unsigned, b); }
__device__ __forceinline__ float bflo(unsigned w) { return __builtin_bit_cast(float, w << 16); }
__device__ __forceinline__ float bfhi(unsigned w) { return __builtin_bit_cast(float, w & 0xffff0000u); }
template <int K> __device__ __forceinline__ float lane_xor(float v) { return __int_as_float(__builtin_amdgcn_ds_swizzle(__float_as_int(v), (K << 10) | 0x1f)); }
__device__ __forceinline__ float wave_sum(float v) {
    v += lane_xor<1>(v); v += lane_xor<2>(v); v += lane_xor<4>(v); v += lane_xor<8>(v); v += lane_xor<16>(v);
    { auto rr = __builtin_amdgcn_permlane32_swap(__float_as_uint(v), __float_as_uint(v), false, false); v = __uint_as_float(rr[0]) + __uint_as_float(rr[1]); }
    return v;
}
__device__ __forceinline__ int krow_of(int r) { return r < TL ? (r >> 11) * KPB + CTX + (r & 2047) : ((r - TL) >> 8) * KPB + ((r - TL) & 255); }
__device__ __forceinline__ int bb_of(int r) { return r < TL ? (r >> 11) : 16; }

#define XB_TMO      128
#define XB_XCNT(j)  (256  + 64 * (j))
#define XB_XSUB(j)  (1280 + 64 * (j))
#define XB_XGEN(j)  (2304 + 64 * (j))
#define XB_TOP      3328
#define XB_TOPGEN   3392
#define XCD_BAR_WORDS 3456
#define XB_SPIN_CAP (1u << 18)
__device__ __forceinline__ unsigned xb_ld(unsigned* p)              { return __hip_atomic_load(p, __ATOMIC_RELAXED, __HIP_MEMORY_SCOPE_AGENT); }
__device__ __forceinline__ unsigned xb_add(unsigned* p, unsigned v) { return __hip_atomic_fetch_add(p, v, __ATOMIC_RELAXED, __HIP_MEMORY_SCOPE_AGENT); }
__device__ __forceinline__ unsigned xb_xcc_id() { return (unsigned)__builtin_amdgcn_s_getreg((3 << 11) | 20) & 0xFu; }
#define XB_SPIN(cond, bar) do { unsigned _sp = 0; while (cond) { __builtin_amdgcn_s_sleep(1); \
    if ((++_sp & 255u) == 0u) { if (xb_ld(&(bar)[XB_TMO])) break; if (_sp > XB_SPIN_CAP) { atomicAdd(&(bar)[XB_TMO], 1u); break; } } } } while (0)
struct XcdBarrier { unsigned* bar; unsigned x; volatile LAS unsigned* st; };
__device__ __forceinline__ XcdBarrier xcd_barrier_post(unsigned* bar, volatile LAS unsigned* st, const bool leader) {
    XcdBarrier b; b.bar = bar; b.x = xb_xcc_id(); b.st = st;
    if (leader) (void)xb_add(&bar[XB_XCNT(b.x)], 1u);
    return b;
}
__device__ __forceinline__ void xcd_barrier_complete(unsigned* bar, unsigned x, unsigned& nloc, unsigned& nx) {
    const unsigned G = gridDim.x * gridDim.y * gridDim.z;
    unsigned sum, cnt, mine, sp = 0u;
    for (;;) {
        sum = 0u; cnt = 0u; mine = 0u;
#pragma unroll
        for (unsigned j = 0; j < 16; ++j) { const unsigned c = xb_ld(&bar[XB_XCNT(j)]); sum += c; cnt += (c > 0u) ? 1u : 0u; mine = (j == x) ? c : mine; }
        if (sum == G) break;
        __builtin_amdgcn_s_sleep(1);
        if ((++sp & 255u) == 0u) { if (xb_ld(&bar[XB_TMO])) break; if (sp > XB_SPIN_CAP) { atomicAdd(&bar[XB_TMO], 1u); break; } }
    }
    nloc = mine > 0u ? mine : 1u; nx = cnt > 0u ? cnt : 1u;
}
__device__ __forceinline__ void xcd_barrier(const XcdBarrier& b, const bool leader) {
    asm volatile("s_waitcnt vmcnt(0)" ::: "memory");
    __syncthreads();
    if (leader) {
        unsigned* bar = b.bar;
        __builtin_amdgcn_s_waitcnt(0);
        unsigned nloc = b.st[0], nx = b.st[1];
        if (nloc == 0u) { xcd_barrier_complete(bar, b.x, nloc, nx); b.st[0] = nloc; b.st[1] = nx; }
        const unsigned old = xb_add(&bar[XB_XSUB(b.x)], 1u);
        const unsigned gen = old / nloc;
        if (old + 1u == (gen + 1u) * nloc) {
            __builtin_amdgcn_fence(__ATOMIC_RELEASE, "agent");
            asm volatile("s_waitcnt vmcnt(0)" ::: "memory");
            const unsigned og = xb_add(&bar[XB_TOP], 1u);
            const unsigned tg = og / nx;
            if (og + 1u == (tg + 1u) * nx) xb_add(&bar[XB_TOPGEN], 1u);
            else XB_SPIN(xb_ld(&bar[XB_TOPGEN]) == tg, bar);
            __builtin_amdgcn_fence(__ATOMIC_ACQUIRE, "agent");
            xb_add(&bar[XB_XGEN(b.x)], 1u);
            asm volatile("s_waitcnt vmcnt(0)" ::: "memory");
        } else {
            XB_SPIN(xb_ld(&bar[XB_XGEN(b.x)]) == gen, bar);
            __builtin_amdgcn_fence(__ATOMIC_ACQUIRE, "agent");
            asm volatile("s_waitcnt vmcnt(0)" ::: "memory");
        }
    }
    __syncthreads();
}

struct Args {
    const float* x; const float* c; const float* ctx; const float* c_ctx; const float* w_ada; const float* b_ada; const float* w_in;
    const float* g_q_a; const float* w_q_b; const float* g_kv_a; const float* w_kv_b; const float* g_gq; const float* g_gk; const float* w_o;
    const float* ln1_g; const float* ln1_b; const float* w_rg; const float* b_rg; const float* w_re; const float* b_re;
    const float* w_gate; const float* w_up; const float* w_down; const float* ln2_g; const float* ln2_b;
    float* out; unsigned char* ws;
};

typedef const __attribute__((address_space(4))) Args* KP;
__device__ __forceinline__ Args ldargs(KP p) {
#if defined(__HIP_DEVICE_COMPILE__)
    asm volatile("" : "+s"(p)); return *p;
#else
    return Args{};
#endif
}

struct Ctx {
    LAS unsigned char* lds;
    int tid, lane, wave, vcu, bk;
};

struct Unit { int pm, pn; };
constexpr int BM = 256, NXCD = 8, WGM = 8;
struct StaticOrder {
    int nM, nN, nwg, G, c;
    __device__ __forceinline__ void init(int M, int N, int G_, int c_) { nM = M / BM; nN = N / BM; nwg = nM * nN; G = G_; c = c_; }
    __device__ __forceinline__ bool next(int i, Unit& u) const {
        const long L = (long)i * G + c; if (L >= nwg) return false;
        int wgid = (int)L; { const int q = nwg / NXCD, r = nwg % NXCD, xcd = wgid % NXCD, off = wgid / NXCD; wgid = (xcd < r ? xcd * (q + 1) : r * (q + 1) + (xcd - r) * q) + off; }
        const int nig = WGM * nN, gid = wgid / nig, fm = gid * WGM, gsz = (nM - fm) < WGM ? (nM - fm) : WGM;
        u.pm = fm + ((wgid % nig) % gsz); u.pn = (wgid % nig) / gsz; return true;
    }
    __device__ __forceinline__ void a_ready(const Unit&) const {}
    __device__ __forceinline__ void done(const Unit&) const {}
};
struct GroupedOrder {
    const volatile LAS int* poff; int nunits, G, c;
    __device__ __forceinline__ void init(const volatile LAS int* poff_, int G_, int c_) { poff = poff_; nunits = (poff_[32] >> 8) * 4; G = G_; c = c_; }
    __device__ __forceinline__ bool next(int i, Unit& u) const {
        const int L = i * G + c; if (L >= nunits) return false;
        const int rt = L >> 2, r0 = rt << 8; int e = 0;
#pragma unroll
        for (int j = 1; j < 32; ++j) e += (poff[j] <= r0) ? 1 : 0;
        u.pm = rt; u.pn = e * 4 + (L & 3); return true;
    }
    __device__ __forceinline__ void a_ready(const Unit&) const {}
    __device__ __forceinline__ void done(const Unit&) const {}
};

__device__ __forceinline__ void st_bf4(bf16_t* p, f32x4 v) { u32x2 w; w.x = pk2(v[0], v[1]); w.y = pk2(v[2], v[3]); *(u32x2*)p = w; }
__device__ __forceinline__ void st_bf8(bf16_t* p, f32x4 a, f32x4 b) { u32x4 w; w.x = pk2(a[0], a[1]); w.y = pk2(a[2], a[3]); w.z = pk2(b[0], b[1]); w.w = pk2(b[2], b[3]); *(u32x4*)p = w; }
struct EpiZ {
    static constexpr bool PERM = true;
    bf16_t* Z;
    __device__ __forceinline__ void tile32(int row, int col, int fq, f32x4 v0, f32x4 v1) const { st_bf8(Z + (size_t)row * ZW + col + 8 * fq, v0, v1); }
};
__device__ __forceinline__ float xor32(float v, bool lower) { auto rr = __builtin_amdgcn_permlane32_swap(__float_as_uint(v), __float_as_uint(v), false, false); return __uint_as_float(lower ? rr[1] : rr[0]); }
struct EpiIn {
    static constexpr bool PERM = true, PAIR = true;
    unsigned char* wsb; const float* ggq; const float* ggk;
    __device__ __forceinline__ float sum4(float s, int fq) const { s += lane_xor<16>(s); s += xor32(s, fq < 2); return s; }
    __device__ __forceinline__ void za(int row, int col, int fq, f32x4 v0, f32x4 v1) const {
        bf16_t* Z = (bf16_t*)(wsb + WS_Z); float* ssqp = (float*)(wsb + WS_SSQP); bf16_t* Km = (bf16_t*)(wsb + WS_KM); const f32x2* t32 = (const f32x2*)(wsb + WS_TAB32);
        if (col < 640) {
            st_bf8(Z + (size_t)row * ZW + col + 8 * fq, v0, v1);
            float s = (v0[0] * v0[0] + v0[1] * v0[1]) + (v0[2] * v0[2] + v0[3] * v0[3]) + (v1[0] * v1[0] + v1[1] * v1[1]) + (v1[2] * v1[2] + v1[3] * v1[3]);
            s = sum4(s, fq);
            if (fq == 0) ssqp[(size_t)row * 20 + (col >> 5)] = s;
        } else if (col == 640) {
            float v[8] = {v0[0], v0[1], v0[2], v0[3], v1[0], v1[1], v1[2], v1[3]}, o[8];
#pragma unroll
            for (int e = 0; e < 8; ++e) { const float p = lane_xor<16>(v[e]); o[e] = v[e];
                if (row < TL) { const int s2 = row & 2047, pos = (fq >> 1) ? (s2 & 63) : (s2 >> 6); const f32x2 c = t32[pos * 8 + e]; o[e] = (fq & 1) ? (v[e] * c.x + p * c.y) : (v[e] * c.x - p * c.y); } }
            u32x4 w; w.x = pk2(o[0], o[1]); w.y = pk2(o[2], o[3]); w.z = pk2(o[4], o[5]); w.w = pk2(o[6], o[7]);
            bf16_t* kp = Km + (size_t)krow_of(row) * QW + 64 + 8 * fq;
#pragma unroll
            for (int h = 0; h < 8; ++h) *(u32x4*)(kp + h * 96) = w;
        }
    }
    __device__ __forceinline__ void head(int row, int fq, f32x4 a0, f32x4 a1, f32x4 b0, f32x4 b1, const float* g, float scale, bf16_t* dst) const {
        const f32x2* t64 = (const f32x2*)(wsb + WS_TAB64);
        float lo[8] = {a0[0], a0[1], a0[2], a0[3], a1[0], a1[1], a1[2], a1[3]}, hi[8] = {b0[0], b0[1], b0[2], b0[3], b1[0], b1[1], b1[2], b1[3]};
        float ss = 0.f;
#pragma unroll
        for (int e = 0; e < 8; ++e) ss += lo[e] * lo[e] + hi[e] * hi[e];
        ss = sum4(ss, fq);
        const float rn = __builtin_amdgcn_rsqf(ss * (1.0f / 64.0f) + RMS_EPS) * scale;
        const bool lat = row < TL, lower = fq < 2; const int s2 = row & 2047, gr = s2 >> 6, gc = s2 & 63, f0 = 8 * (fq & 1);
        const f32x4* gp = (const f32x4*)(g + 8 * fq); const f32x4 g0 = gp[0], g1 = gp[1], g2 = gp[8], g3 = gp[9];
        const float gl[8] = {g0[0], g0[1], g0[2], g0[3], g1[0], g1[1], g1[2], g1[3]}, gh[8] = {g2[0], g2[1], g2[2], g2[3], g3[0], g3[1], g3[2], g3[3]};
        float ol[8], oh[8];
        if (lat) {
            const f32x4* tl = (const f32x4*)(t64 + gr * 16 + f0); const f32x4* th = (const f32x4*)(t64 + gc * 16 + f0);
            const f32x4 cl0 = tl[0], cl1 = tl[1], cl2 = tl[2], cl3 = tl[3], ch0 = th[0], ch1 = th[1], ch2 = th[2], ch3 = th[3];
            const float cL[8] = {cl0[0], cl0[2], cl1[0], cl1[2], cl2[0], cl2[2], cl3[0], cl3[2]}, sL[8] = {cl0[1], cl0[3], cl1[1], cl1[3], cl2[1], cl2[3], cl3[1], cl3[3]};
            const float cH[8] = {ch0[0], ch0[2], ch1[0], ch1[2], ch2[0], ch2[2], ch3[0], ch3[2]}, sH[8] = {ch0[1], ch0[3], ch1[1], ch1[3], ch2[1], ch2[3], ch3[1], ch3[3]};
#pragma unroll
            for (int e = 0; e < 8; ++e) {
                const float yl = lo[e] * rn * gl[e], yh = hi[e] * rn * gh[e];
                const float pl = xor32(yl, lower), ph = xor32(yh, lower);
                ol[e] = lower ? (yl * cL[e] - pl * sL[e]) : (yl * cL[e] + pl * sL[e]);
                oh[e] = lower ? (yh * cH[e] - ph * sH[e]) : (yh * cH[e] + ph * sH[e]);
            }
        } else {
#pragma unroll
            for (int e = 0; e < 8; ++e) { ol[e] = lo[e] * rn * gl[e]; oh[e] = hi[e] * rn * gh[e]; }
        }
        u32x4 w; w.x = pk2(ol[0], ol[1]); w.y = pk2(ol[2], ol[3]); w.z = pk2(ol[4], ol[5]); w.w = pk2(ol[6], ol[7]); *(u32x4*)(dst + 8 * fq) = w;
        w.x = pk2(oh[0], oh[1]); w.y = pk2(oh[2], oh[3]); w.z = pk2(oh[4], oh[5]); w.w = pk2(oh[6], oh[7]); *(u32x4*)(dst + 32 + 8 * fq) = w;
    }
    __device__ __forceinline__ void tile64(int row, int pn, int wc, int fq, f32x4 a0, f32x4 a1, f32x4 b0, f32x4 b1) const {
        if (pn < 3) { const int col = pn * 256 + wc * 32; za(row, col, fq, a0, a1); za(row, col + 128, fq, b0, b1); }
        else if (pn < 5) { const int h = 4 * (pn - 3) + wc; head(row, fq, a0, a1, b0, b1, ggq, QSCALE_G, (bf16_t*)(wsb + WS_QG) + (size_t)row * 512 + 64 * h); }
        else if (wc < 2) { head(row, fq, a0, a1, b0, b1, ggk, 1.0f, (bf16_t*)(wsb + WS_KG) + (size_t)krow_of(row) * 128 + 64 * wc); }
        else { bf16_t* vp = (bf16_t*)(wsb + WS_VG) + (size_t)krow_of(row) * 128 + 64 * (wc - 2); st_bf8(vp + 8 * fq, a0, a1); st_bf8(vp + 32 + 8 * fq, b0, b1); }
    }
};
struct EpiQ {
    static constexpr bool PERM = true;
    unsigned char* wsb;
    __device__ __forceinline__ void tile32(int row, int col, int fq, f32x4 v0, f32x4 v1) const {
        bf16_t* Qm = (bf16_t*)(wsb + WS_QM); const float* rstd = (const float*)(wsb + (FUSE_SPLIT ? WS_SSQP : WS_RSTDQ)); const f32x2* tab32 = (const f32x2*)(wsb + WS_TAB32);
        const int h = col / 96, gi = (col - h * 96) >> 5;
#if FUSE_SPLIT
        const f32x4* sp = (const f32x4*)(rstd + (size_t)row * 20); const f32x4 s0 = sp[0], s1 = sp[1], s2 = sp[2];
        const float rs = QSCALE_M / sqrtf(((s0[0] + s0[1]) + (s0[2] + s0[3]) + (s1[0] + s1[1]) + (s1[2] + s1[3]) + (s2[0] + s2[1]) + (s2[2] + s2[3])) * (1.0f / 384.0f) + RMS_EPS);
#else
        const float rs = rstd[row] * QSCALE_M;
#endif
        v0 = v0 * rs; v1 = v1 * rs;
        bf16_t* base = Qm + (size_t)row * QW + h * 96;
        if (gi < 2) { st_bf8(base + gi * 32 + 8 * fq, v0, v1); }
        else {
            const int part = fq >> 1, f0 = (4 * fq) & 7;
            f32x4 o1 = v0, o2 = v1;
            if (row < TL) {
                const int s = row & 2047, pos = part ? (s & 63) : (s >> 6);
#pragma unroll
                for (int j = 0; j < 4; ++j) { const f32x2 cs = tab32[pos * 8 + f0 + j]; o1[j] = v0[j] * cs.x - v1[j] * cs.y; o2[j] = v1[j] * cs.x + v0[j] * cs.y; }
            }
            bf16_t* p = base + 64 + part * 16 + f0; st_bf4(p, o1); st_bf4(p + 8, o2);
        }
    }
};
struct EpiKV {
    static constexpr bool PERM = true;
    unsigned char* wsb;
    __device__ __forceinline__ void tile32(int row, int col, int fq, f32x4 v0, f32x4 v1) const {
        bf16_t* Km = (bf16_t*)(wsb + WS_KM); bf16_t* Vm = (bf16_t*)(wsb + WS_VM); const float* rstd = (const float*)(wsb + (FUSE_SPLIT ? WS_SSQP : WS_RSTDKV));
        const int h = col >> 7, w = col & 127; const int kr = krow_of(row);
#if FUSE_SPLIT
        const f32x4* sp = (const f32x4*)(rstd + (size_t)row * 20 + 12); const f32x4 s0 = sp[0], s1 = sp[1];
        const float rs = 1.0f / sqrtf(((s0[0] + s0[1]) + (s0[2] + s0[3]) + (s1[0] + s1[1]) + (s1[2] + s1[3])) * (1.0f / 256.0f) + RMS_EPS);
#else
        const float rs = rstd[row];
#endif
        bf16_t* p = (w < 64) ? (Km + (size_t)kr * QW + h * 96 + w + 8 * fq) : (Vm + (size_t)kr * 512 + h * 64 + (w - 64) + 8 * fq);
        st_bf8(p, v0 * rs, v1 * rs);
    }
};
struct EpiU {
    static constexpr bool PERM = false;
    float* U; const float* xl; const float* xc; const float* mod_l;
    int gate;
    __device__ __forceinline__ void tile32(int row, int col, int fq, f32x4 v0, f32x4 v1) const {
        const float* xr = (row < TL) ? (xl + (size_t)row * D) : (xc + (size_t)(row - TL) * D);
        const float* g = mod_l + (size_t)(bb_of(row) * 6 + gate) * D;
        const int c0 = col + 4 * fq;
        const f32x4 x0 = *(const f32x4*)(xr + c0), x1 = *(const f32x4*)(xr + c0 + 16), g0 = *(const f32x4*)(g + c0), g1 = *(const f32x4*)(g + c0 + 16);
        float* u = U + (size_t)row * D + c0;
        *(f32x4*)u = x0 * ALPHA + g0 * v0; *(f32x4*)(u + 16) = x1 * ALPHA + g1 * v1;
    }
};
__device__ __forceinline__ float silu_f(float x) { return x * __builtin_amdgcn_rcpf(1.0f + __builtin_amdgcn_exp2f(-x * LOG2E)); }
struct EpiAct {
    static constexpr bool PERM = false;
    bf16_t* Act;
    __device__ __forceinline__ void tile32(int row, int col, int fq, f32x4 v0, f32x4 v1) const {
        const int f0 = ((col & 1023) >> 1) + 4 * fq; f32x4 a;
#pragma unroll
        for (int j = 0; j < 4; ++j) a[j] = silu_f(v0[j]) * v1[j];
        st_bf4(Act + (size_t)row * FF + f0, a);
    }
};
struct EpiYo {
    static constexpr bool PERM = true;
    bf16_t* Y;
    __device__ __forceinline__ void tile32(int row, int col, int fq, f32x4 v0, f32x4 v1) const { st_bf8(Y + (size_t)row * D + col + 8 * fq, v0, v1); }
};
struct EpiY {
    static constexpr bool PERM = true;
    bf16_t* Y;
    __device__ __forceinline__ void tile32(int row, int col, int fq, f32x4 v0, f32x4 v1) const { st_bf8(Y + (size_t)row * D + (col & 1023) + 8 * fq, v0, v1); }
};

template <class E, class = void> struct epi_pair { static constexpr bool value = false; };
template <class E> struct epi_pair<E, decltype((void)E::PAIR)> { static constexpr bool value = E::PAIR; };
struct Gemm { const bf16_t* A; int lda; const bf16_t* Bt; int K; };
__device__ __forceinline__ float dot8(u32x4 a, u32x4 b, float acc) {
#pragma unroll
    for (int i = 0; i < 4; ++i) { acc += bflo(a[i]) * bflo(b[i]); acc += bfhi(a[i]) * bfhi(b[i]); }
    return acc;
}
template <class Sched, class Epi>
__device__ __forceinline__ void gemm_naive(const Ctx& F, const Gemm g, const Sched& S, const Epi& E) {
    Unit u;
    for (int i = 0; S.next(i, u); ++i) {
        for (int task = F.tid; task < 8192; task += NTHREADS) {
            const int lane = task & 63, fr = lane & 15, fq = lane >> 4, rest = task >> 6, rg = rest & 15, cg = rest >> 4;
            const int row = u.pm * 256 + rg * 16 + fr, col = u.pn * 256 + cg * 32;
            const bf16_t* ap = g.A + (size_t)row * g.lda;
            const bf16_t* bp0 = g.Bt + (size_t)(col + 4 * fq) * g.K;
            const bf16_t* bp1 = bp0 + (size_t)16 * g.K;
            f32x4 v0 = {0.f, 0.f, 0.f, 0.f}, v1 = {0.f, 0.f, 0.f, 0.f};
            for (int k = 0; k < g.K; k += 8) {
                const u32x4 a = *(const u32x4*)(ap + k);
#pragma unroll
                for (int j = 0; j < 4; ++j) {
                    v0[j] = dot8(a, *(const u32x4*)(bp0 + (size_t)j * g.K + k), v0[j]);
                    v1[j] = dot8(a, *(const u32x4*)(bp1 + (size_t)j * g.K + k), v1[j]);
                }
            }
            E.tile32(row, col, fq, v0, v1);
        }
    }
}
constexpr int BK = 64, HALF = 128, HTB = HALF * BK * 2, STAGE_BYTES = 8 * HTB;
__device__ __forceinline__ int lds_byte(int r, int c) { const int st = (r >> 4) * 2 + (c >> 5), rr = r & 15, cc = c & 31, ob = rr * 64 + cc * 2; return st * 1024 + (ob ^ (((ob >> 9) & 1) << 5)); }
__device__ __forceinline__ int perm32(int rho) { const int n = rho >> 4, i = rho & 15; return 8 * (i >> 2) + 4 * n + (i & 3); }
__device__ __forceinline__ void stage_rc(int b, int& R, int& C) { const int st = b / 1024, sb = b % 1024, swz = sb ^ (((sb >> 9) & 1) << 5); R = (st >> 1) * 16 + swz / 64; C = (st & 1) * 32 + (swz % 64) / 2; }
template <class Epi, class Sched, bool ALIGN_EPI = true, bool SP2 = true, bool GATHER = false>
__device__ __forceinline__ void gemm_mfma(LAS unsigned char* lds, const int tid_in, const Gemm g, const Sched& S, const Epi& E, const LAS int* gtab = nullptr) {
    int tid = tid_in; asm volatile("" : "+v"(tid));
    const int wid = __builtin_amdgcn_readfirstlane(tid >> 6), lane = tid & 63, wr = wid >> 2, wc = wid & 3, fr = lane & 15, fq = lane >> 4;
    const int K = g.K, nt = K / BK;
    unsigned voffB[2]; int RA[2], CA[2];
#pragma unroll
    for (int i = 0; i < 2; ++i) { int R, C; stage_rc(tid * 16 + i * 8192, R, C); const int Rb = Epi::PERM ? ((R & ~31) + perm32(R & 31)) : R;
        RA[i] = R; CA[i] = C; voffB[i] = (unsigned)(Rb * K + C) * 2u; }
    const size_t kstep = (size_t)(BK * 2);
    const size_t hstepA = (size_t)HALF * g.lda * 2, hstepB = (size_t)HALF * K * 2;
    const size_t tstepA = GATHER ? 0 : 2 * hstepA, tstepB = 2 * hstepB;
    unsigned vc0[2], vc1[2], vn0[2], vn1[2];
#define PG8_GOFF(dst0, dst1, ui_) do { _Pragma("unroll") for (int i_ = 0; i_ < 2; ++i_) { \
        if constexpr (GATHER) { dst0[i_] = (unsigned)gtab[(ui_) * 256 + RA[i_]] * (unsigned)(g.lda * 2) + (unsigned)CA[i_] * 2u; dst1[i_] = (unsigned)gtab[(ui_) * 256 + HALF + RA[i_]] * (unsigned)(g.lda * 2) + (unsigned)CA[i_] * 2u; } \
        else { dst0[i_] = (unsigned)(RA[i_] * g.lda + CA[i_]) * 2u; dst1[i_] = dst0[i_] + (unsigned)hstepA; } } } while (0)
    const unsigned ldsw = (unsigned)wid * 1024u;
    const int aoff = lds_byte(wr * 64 + fr, fq * 8), boff = lds_byte(wc * 32 + fr, fq * 8);
#define PG8_SA(b, h) (((b) * 2 + (h)) * HTB)
#define PG8_SB(b, h) ((4 + (b) * 2 + (h)) * HTB)
#define PG8_STAGE(bufoff, gbase, voff) do { _Pragma("unroll") for (int _i = 0; _i < 2; ++_i) \
        __builtin_amdgcn_global_load_lds((const unsigned*)((const char*)(gbase) + (voff)[_i]), (LAS unsigned*)(lds + (bufoff) + ldsw + _i * 8192), 16, 0, 0); } while (0)
#define PG8_LDA(dst, b, h) do { _Pragma("unroll") for (int m = 0; m < 4; ++m) _Pragma("unroll") for (int k = 0; k < 2; ++k) dst[m][k] = *(const LAS bf16x8*)(lds + PG8_SA(b, h) + aoff + m * 2048 + k * 1024); } while (0)
#define PG8_LDB(dst, b, h) do { _Pragma("unroll") for (int n = 0; n < 2; ++n) _Pragma("unroll") for (int k = 0; k < 2; ++k) dst[n][k] = *(const LAS bf16x8*)(lds + PG8_SB(b, h) + boff + n * 2048 + k * 1024); } while (0)
#define PG8_MMA(ai, bj, At, Bt) do { __builtin_amdgcn_s_setprio(1); _Pragma("unroll") for (int m = 0; m < 4; ++m) _Pragma("unroll") for (int n = 0; n < 2; ++n) _Pragma("unroll") for (int k = 0; k < 2; ++k) \
        acc[ai][bj][m][n] = __builtin_amdgcn_mfma_f32_16x16x32_bf16(Bt[n][k], At[m][k], acc[ai][bj][m][n], 0, 0, 0); __builtin_amdgcn_s_setprio(0); } while (0)
#define PG8_WAIT_V(n) asm volatile("s_waitcnt vmcnt(" #n ")" ::: "memory")
#define PG8_WAIT_L(n) asm volatile("s_waitcnt lgkmcnt(" #n ")" ::: "memory")
#define PG8_BAR __builtin_amdgcn_s_barrier()
#define PG8_SCHED __builtin_amdgcn_sched_barrier(0)
    Unit cur, nxt; int ui = 0;
    if (!S.next(0, cur)) return;
    PG8_GOFF(vc0, vc1, 0);
#pragma unroll
    for (int i = 0; i < 2; ++i) { vn0[i] = vc0[i]; vn1[i] = vc1[i]; }
    f32x4 acc[2][2][4][2];
#pragma unroll
    for (int a = 0; a < 2; ++a)
#pragma unroll
        for (int b = 0; b < 2; ++b)
#pragma unroll
            for (int m = 0; m < 4; ++m)
#pragma unroll
                for (int n = 0; n < 2; ++n) acc[a][b][m][n] = (f32x4){0.f, 0.f, 0.f, 0.f};
    bf16x8 At[4][2], B0[2][2], B1[2][2];
    const char* cA = (const char*)g.A + (size_t)cur.pm * tstepA; const char* cB = (const char*)g.Bt + (size_t)cur.pn * tstepB;
    S.a_ready(cur);
    if constexpr (SP2) {
        PG8_STAGE(PG8_SB(0, 0), cB, voffB); PG8_STAGE(PG8_SB(0, 1), cB + hstepB, voffB); PG8_STAGE(PG8_SA(0, 0), cA, vc0); PG8_STAGE(PG8_SA(0, 1), cA, vc1);
        if (wr == 1) PG8_BAR;
        PG8_WAIT_V(2); PG8_BAR;
        PG8_STAGE(PG8_SB(1, 0), cB + kstep, voffB); PG8_STAGE(PG8_SA(1, 0), cA + kstep, vc0); PG8_STAGE(PG8_SB(1, 1), cB + hstepB + kstep, voffB);
        PG8_WAIT_V(6); PG8_BAR;
    } else {
        PG8_STAGE(PG8_SB(0, 0), cB, voffB); PG8_STAGE(PG8_SA(0, 0), cA, vc0); PG8_STAGE(PG8_SB(0, 1), cB + hstepB, voffB); PG8_STAGE(PG8_SA(0, 1), cA, vc1);
        if (wr == 1) PG8_BAR;
        PG8_WAIT_V(4); PG8_BAR;
        PG8_STAGE(PG8_SB(1, 0), cB + kstep, voffB); PG8_STAGE(PG8_SA(1, 0), cA + kstep, vc0); PG8_STAGE(PG8_SB(1, 1), cB + hstepB + kstep, voffB);
        PG8_WAIT_V(6); PG8_BAR;
    }
    for (;;) {
        const bool has_next = S.next(ui + 1, nxt);
        if constexpr (GATHER) { if (has_next) { PG8_GOFF(vn0, vn1, ui + 1); } else {
#pragma unroll
            for (int i = 0; i < 2; ++i) { vn0[i] = vc0[i]; vn1[i] = vc1[i]; } } }
        const char* nA = has_next ? (const char*)g.A + (size_t)nxt.pm * tstepA : cA; const char* nB = has_next ? (const char*)g.Bt + (size_t)nxt.pn * tstepB : cB;
#pragma unroll 1
        for (int t = 0; t < nt; t += 2) {
            const bool last = (t == nt - 2);
            const char* a1 = cA + (size_t)(t + 1) * kstep;
            const char* a2 = last ? nA : cA + (size_t)(t + 2) * kstep; const char* b2 = last ? nB : cB + (size_t)(t + 2) * kstep;
            const char* a3 = a2 + kstep; const char* b3 = b2 + kstep;
            unsigned s0[2], s1[2];
#pragma unroll
            for (int i = 0; i < 2; ++i) { if constexpr (GATHER) { s0[i] = last ? vn0[i] : vc0[i]; s1[i] = last ? vn1[i] : vc1[i]; } else { s0[i] = vc0[i]; s1[i] = vc1[i]; } }
            if (last && has_next) S.a_ready(nxt);
            if constexpr (SP2) {
            PG8_LDB(B0, 0, 0); PG8_LDB(B1, 0, 1); PG8_SCHED; PG8_LDA(At, 0, 0); PG8_STAGE(PG8_SA(1, 1), a1, vc1);
            PG8_WAIT_V(8); PG8_WAIT_L(0); PG8_BAR; PG8_MMA(0, 0, At, B0); PG8_MMA(0, 1, At, B1); PG8_BAR; PG8_SCHED;
            PG8_LDA(At, 0, 1); PG8_STAGE(PG8_SB(0, 0), b2, voffB); PG8_STAGE(PG8_SB(0, 1), b2 + hstepB, voffB); PG8_STAGE(PG8_SA(0, 0), a2, s0);
            PG8_WAIT_V(8); PG8_WAIT_L(0); PG8_BAR; PG8_MMA(1, 0, At, B0); PG8_MMA(1, 1, At, B1); PG8_BAR; PG8_SCHED;
            PG8_LDB(B0, 1, 0); PG8_LDB(B1, 1, 1); PG8_SCHED; PG8_LDA(At, 1, 0); PG8_STAGE(PG8_SA(0, 1), a2, s1);
            PG8_WAIT_V(8); PG8_WAIT_L(0); PG8_BAR; PG8_MMA(0, 0, At, B0); PG8_MMA(0, 1, At, B1); PG8_BAR; PG8_SCHED;
            PG8_LDA(At, 1, 1); PG8_STAGE(PG8_SB(1, 0), b3, voffB); PG8_STAGE(PG8_SB(1, 1), b3 + hstepB, voffB); PG8_STAGE(PG8_SA(1, 0), a3, s0);
            PG8_WAIT_V(8); PG8_WAIT_L(0); PG8_BAR; PG8_MMA(1, 0, At, B0); PG8_MMA(1, 1, At, B1); PG8_BAR; PG8_SCHED;
            } else {
            PG8_LDB(B0, 0, 0); PG8_SCHED; PG8_LDA(At, 0, 0); PG8_STAGE(PG8_SA(1, 1), a1, vc1);
            PG8_WAIT_L(8); PG8_BAR; PG8_WAIT_L(0); PG8_MMA(0, 0, At, B0); PG8_BAR; PG8_SCHED;
            PG8_LDB(B1, 0, 1); PG8_STAGE(PG8_SB(0, 0), b2, voffB);
            PG8_BAR; PG8_WAIT_L(0); PG8_MMA(0, 1, At, B1); PG8_BAR;
            PG8_LDA(At, 0, 1); PG8_STAGE(PG8_SA(0, 0), a2, s0);
            PG8_BAR; PG8_WAIT_L(0); PG8_MMA(1, 0, At, B0); PG8_BAR; PG8_SCHED;
            PG8_STAGE(PG8_SB(0, 1), b2 + hstepB, voffB);
            PG8_WAIT_V(6); PG8_BAR; PG8_MMA(1, 1, At, B1); PG8_BAR;
            PG8_LDB(B0, 1, 0); PG8_SCHED; PG8_LDA(At, 1, 0); PG8_STAGE(PG8_SA(0, 1), a2, s1);
            PG8_WAIT_L(8); PG8_BAR; PG8_WAIT_L(0); PG8_MMA(0, 0, At, B0); PG8_BAR; PG8_SCHED;
            PG8_LDB(B1, 1, 1); PG8_STAGE(PG8_SB(1, 0), b3, voffB);
            PG8_BAR; PG8_WAIT_L(0); PG8_MMA(0, 1, At, B1); PG8_BAR;
            PG8_LDA(At, 1, 1); PG8_STAGE(PG8_SA(1, 0), a3, s0);
            PG8_BAR; PG8_WAIT_L(0); PG8_MMA(1, 0, At, B0); PG8_BAR; PG8_SCHED;
            PG8_STAGE(PG8_SB(1, 1), b3 + hstepB, voffB);
            PG8_WAIT_V(6); PG8_BAR; PG8_MMA(1, 1, At, B1); PG8_BAR;
            }
        }
        if constexpr (ALIGN_EPI) { if (wr == 0) PG8_BAR; }
        {
            int ln_e; asm volatile("v_mbcnt_lo_u32_b32 %0, -1, 0\n\tv_mbcnt_hi_u32_b32 %0, -1, %0" : "=v"(ln_e));
            const int fr_e = ln_e & 15, fq_e = ln_e >> 4;
            int pm_e = __builtin_amdgcn_readfirstlane(cur.pm), pn_e = __builtin_amdgcn_readfirstlane(cur.pn), wr_e = __builtin_amdgcn_readfirstlane(wr), wc_e = __builtin_amdgcn_readfirstlane(wc); asm volatile("" : "+s"(pm_e), "+s"(pn_e), "+s"(wr_e), "+s"(wc_e));
#pragma unroll
            for (int ai = 0; ai < 2; ++ai)
#pragma unroll
                for (int m = 0; m < 4; ++m) {
                    if constexpr (epi_pair<Epi>::value) E.tile64(pm_e * BM + ai * HALF + wr_e * 64 + m * 16 + fr_e, pn_e, wc_e, fq_e, acc[ai][0][m][0], acc[ai][0][m][1], acc[ai][1][m][0], acc[ai][1][m][1]);
                    else {
#pragma unroll
                    for (int bj = 0; bj < 2; ++bj)
                        E.tile32(pm_e * BM + ai * HALF + wr_e * 64 + m * 16 + fr_e, pn_e * BM + bj * HALF + wc_e * 32, fq_e, acc[ai][bj][m][0], acc[ai][bj][m][1]);
                    }
                    asm volatile("" ::: "memory");
                }
            S.done(cur);
        }
        if (!has_next) break;
#pragma unroll
        for (int a = 0; a < 2; ++a)
#pragma unroll
            for (int b = 0; b < 2; ++b)
#pragma unroll
                for (int m = 0; m < 4; ++m)
#pragma unroll
                    for (int n = 0; n < 2; ++n) acc[a][b][m][n] = (f32x4){0.f, 0.f, 0.f, 0.f};
        cur = nxt; cA = nA; cB = nB; ++ui;
        if constexpr (GATHER) {
#pragma unroll
            for (int i = 0; i < 2; ++i) { vc0[i] = vn0[i]; vc1[i] = vn1[i]; } }
        if constexpr (ALIGN_EPI) { if (wr == 1) PG8_BAR; }
    }
    PG8_WAIT_V(0);
    if constexpr (!ALIGN_EPI) { if (wr == 0) PG8_BAR; }
    PG8_BAR;
#undef PG8_GOFF
#undef PG8_SA
#undef PG8_SB
#undef PG8_STAGE
#undef PG8_LDA
#undef PG8_LDB
#undef PG8_MMA
#undef PG8_WAIT_V
#undef PG8_WAIT_L
#undef PG8_BAR
#undef PG8_SCHED
}

#ifndef REP_GEMM_MASK
#define REP_GEMM_MASK 0
#endif
template <int ID, class Sched, class Epi>
__device__ __forceinline__ void gemm_phase_gather(const Ctx& F, const Gemm g, const Sched& S, const Epi& E, const LAS int* gtab) {
    gemm_mfma<Epi, Sched, true, true, true>(F.lds, F.tid, g, S, E, gtab);
    if constexpr ((REP_GEMM_MASK >> ID) & 1) gemm_mfma<Epi, Sched, true, true, true>(F.lds, F.tid, g, S, E, gtab);
}
template <int ID, class Sched, class Epi>
__device__ __forceinline__ void gemm_phase(const Ctx& F, const Gemm g, const Sched& S, const Epi& E) {
#if USE_MFMA_GEMM
    gemm_mfma<Epi, Sched, true, true>(F.lds, F.tid, g, S, E);
    if constexpr ((REP_GEMM_MASK >> ID) & 1) gemm_mfma<Epi, Sched, true, true>(F.lds, F.tid, g, S, E);
#else
    gemm_naive(F, g, S, E);
#endif
}

template <class ColPtr>
__device__ __forceinline__ void tconv_tile(const ColPtr& cp, int ldw, const float* scale, bf16_t* WT, int K, int k0, int p0, LAS float* scr, int lane) {
    const int pc = (lane & 15) * 4, kq = lane >> 4;
    const float* src = cp(p0 + pc);
#pragma unroll 4
    for (int i = 0; i < 16; ++i) {
        const int kk = 4 * i + kq;
        f32x4 v = {0.f, 0.f, 0.f, 0.f};
        if (src) { v = *(const f32x4*)(src + (size_t)(k0 + kk) * ldw); if (scale) v = v * scale[k0 + kk]; }
        LAS float* d = scr + kk * 65 + pc; d[0] = v[0]; d[1] = v[1]; d[2] = v[2]; d[3] = v[3];
    }
    LDS_WAIT();
    const int c = lane & 7;
#pragma unroll
    for (int j = 0; j < 8; ++j) {
        const int n = (lane >> 3) + 8 * j; const LAS float* s = scr + (8 * c) * 65 + n;
        u32x4 o; o.x = pk2(s[0], s[65]); o.y = pk2(s[2 * 65], s[3 * 65]); o.z = pk2(s[4 * 65], s[5 * 65]); o.w = pk2(s[6 * 65], s[7 * 65]);
        *(u32x4*)(WT + (size_t)(p0 + n) * K + k0 + 8 * c) = o;
    }
    LDS_WAIT();
}
struct CpPlain { const float* W; int ncols; __device__ __forceinline__ const float* operator()(int p) const { return p < ncols ? W + p : nullptr; } };
struct CpIn {
    const float* W;
    __device__ __forceinline__ const float* operator()(int p) const {
        if (p < 672) return W + p;
        if (p < 768) return nullptr;
        const int w = p & 31;
        if (p < 1280) { const int q = p - 768, t = q >> 8, g = (q & 255) >> 5; return W + 672 + 64 * (4 * t + (g & 3)) + 32 * (g >> 2) + w; }
        const int g = (p - 1280) >> 5, half = g >> 2, slot = g & 3;
        return W + ((slot < 2) ? (1184 + 64 * slot) : (1312 + 64 * (slot - 2))) + 32 * half + w;
    }
};
#if FUSE_SPLIT
typedef CpIn CpInSel;
#else
struct CpInSel { const float* W; __device__ __forceinline__ const float* operator()(int p) const { return p < 1440 ? W + p : nullptr; } };
#endif
struct CpQ {
    const float* W;
    __device__ __forceinline__ const float* operator()(int p) const {
        const int h = p / 96, pp = p - h * 96; int lc = pp;
        if (pp >= 64) { const int rp = pp - 64, q = rp >> 3, r = rp & 7, i = 4 * q + (r & 3); lc = 64 + (i >> 3) * 16 + (i & 7) + ((r >> 2) ? 8 : 0); }
        return W + h * 96 + lc;
    }
};
struct CpGU {
    const float* Wg; const float* Wu;
    __device__ __forceinline__ const float* operator()(int p) const { const int g32 = p >> 5, w = p & 31; return (w < 16) ? (Wg + g32 * 16 + w) : (Wu + g32 * 16 + (w - 16)); }
};

constexpr int CONV_ITEMS = NEXP * 256 + NEXP * 128, CONV_CH = 4, CONV_CTR0 = 8192;
struct ConvSrc { const float* p; size_t ld; bf16_t* dst; int K; };
__device__ __forceinline__ ConvSrc conv_decode(const Args& a, int l, int idx, int lane) {
    const int pc = (lane & 15) * 4, kq = lane >> 4; ConvSrc r;
    if (idx < NEXP * 256) { const int e = idx >> 8, q = idx & 255, k0 = (q >> 4) * 64, p = (q & 15) * 64 + pc, g32 = p >> 5, w = p & 31; const size_t le = (size_t)l * NEXP + e;
        r.p = ((w < 16) ? (a.w_gate + le * D * FF + g32 * 16 + w) : (a.w_up + le * D * FF + g32 * 16 + (w - 16))) + (size_t)(k0 + kq) * FF; r.ld = FF;
        r.dst = (bf16_t*)(a.ws + WS_WGU) + le * 1024 * D + (size_t)((q & 15) * 64) * D + k0; r.K = D; }
    else { const int i2 = idx - NEXP * 256, e = i2 >> 7, q = i2 & 127, k0 = (q >> 4) * 64, p0 = (q & 15) * 64; const size_t le = (size_t)l * NEXP + e;
        r.p = a.w_down + le * FF * D + (size_t)(k0 + kq) * D + p0 + pc; r.ld = D;
        r.dst = (bf16_t*)(a.ws + WS_WD) + le * D * FF + (size_t)p0 * FF + k0; r.K = FF; }
    return r;
}
__device__ __forceinline__ void conv_load(const ConvSrc& c, f32x4 (&v)[16]) {
#pragma unroll
    for (int i = 0; i < 16; ++i) v[i] = *(const f32x4*)(c.p + (size_t)(4 * i) * c.ld);
}
__device__ __forceinline__ void conv_store(const ConvSrc& c, const f32x4 (&v)[16], LAS float* scr, int lane) {
    const int pc = (lane & 15) * 4, kq = lane >> 4;
#pragma unroll
    for (int i = 0; i < 16; ++i) { LAS float* d = scr + (4 * i + kq) * 65 + pc; d[0] = v[i][0]; d[1] = v[i][1]; d[2] = v[i][2]; d[3] = v[i][3]; }
    LDS_WAIT();
    const int cc = lane & 7;
#pragma unroll
    for (int j = 0; j < 8; ++j) {
        const int n = (lane >> 3) + 8 * j; const LAS float* sp = scr + (8 * cc) * 65 + n;
        u32x4 o; o.x = pk2(sp[0], sp[65]); o.y = pk2(sp[2 * 65], sp[3 * 65]); o.z = pk2(sp[4 * 65], sp[5 * 65]); o.w = pk2(sp[6 * 65], sp[7 * 65]);
        *(u32x4*)(c.dst + (size_t)n * c.K + 8 * cc) = o;
    }
    LDS_WAIT();
}
__device__ __forceinline__ void conv_experts(const Ctx& F, const Args& a, int l, int grabs) {
    unsigned* ctr = (unsigned*)(a.ws + WS_CTL) + CONV_CTR0 + 64 * l;
    LAS float* scr = (LAS float*)(F.lds + F.wave * 18432);
    for (int g = 0; grabs < 0 || g < grabs; ++g) {
        unsigned b0 = 0; if (F.lane == 0) b0 = __hip_atomic_fetch_add(ctr, (unsigned)CONV_CH, __ATOMIC_RELAXED, __HIP_MEMORY_SCOPE_AGENT);
        const int base = __builtin_amdgcn_readfirstlane((int)b0);
        if (base >= CONV_ITEMS) break;
        f32x4 va[16], vb[16];
        ConvSrc c0 = conv_decode(a, l, base, F.lane), c1 = conv_decode(a, l, base + 1, F.lane), c2 = conv_decode(a, l, base + 2, F.lane), c3 = conv_decode(a, l, base + 3, F.lane);
        conv_load(c0, va); conv_load(c1, vb); conv_store(c0, va, scr, F.lane);
        conv_load(c2, va); conv_store(c1, vb, scr, F.lane);
        conv_load(c3, vb); conv_store(c2, va, scr, F.lane);
        conv_store(c3, vb, scr, F.lane);
    }
}

__device__ __forceinline__ void conv_filler(const Ctx& F, KP kp, int l, int grabs) {
    const Args a = ldargs(kp);
    int q = l;
    if (l == 0 || (int)__hip_atomic_load((unsigned*)(a.ws + WS_CTL) + CONV_CTR0 + 64 * l, __ATOMIC_RELAXED, __HIP_MEMORY_SCOPE_AGENT) >= CONV_ITEMS) q = l + 1;
    if (q < NL) conv_experts(F, a, q, grabs);
}
__device__ __forceinline__ void prologue1(const Ctx& F, KP kp) {
    const Args a = ldargs(kp);
    unsigned char* ws = a.ws;
    {
        LAS float* sl = (LAS float*)F.lds;
        float* modp = (float*)(ws + WS_MODP);
        for (int it = F.bk; it < NL * 12 * 4; it += GRID) {
            const int kc = it & 3, nc = (it >> 2) % 12, l = it / 48;
            __syncthreads();
            for (int idx = F.tid; idx < 17 * 256; idx += NTHREADS) {
                const int bb = idx >> 8, k = idx & 255; const float v = (bb < 16) ? a.c[bb * D + kc * 256 + k] : a.c_ctx[kc * 256 + k];
                sl[idx] = v / (1.0f + __expf(-v));
            }
            __syncthreads();
            const int n = nc * 512 + F.tid;
            const float* w = a.w_ada + ((size_t)l * D + kc * 256) * 6144 + n;
            float acc[17];
#pragma unroll
            for (int bb = 0; bb < 17; ++bb) acc[bb] = 0.f;
            for (int k = 0; k < 256; ++k) {
                const float wv = w[(size_t)k * 6144];
#pragma unroll
                for (int bb = 0; bb < 17; ++bb) acc[bb] += sl[bb * 256 + k] * wv;
            }
#pragma unroll
            for (int bb = 0; bb < 17; ++bb) modp[((size_t)(kc * NL + l) * 17 + bb) * 6144 + n] = acc[bb];
        }
        __syncthreads();
    }
    {
        f32x2* t64 = (f32x2*)(ws + WS_TAB64); f32x2* t32 = (f32x2*)(ws + WS_TAB32);
        const int gt = F.bk * NTHREADS + F.tid;
        if (gt < 64 * 16) { const int pos = gt >> 4, f = gt & 15; const float inv = powf(10000.0f, -((float)(2 * f) / 32.0f)); const float ang = (float)pos * inv; t64[gt] = (f32x2){cosf(ang), sinf(ang)}; }
        else if (gt < 64 * 16 + 64 * 8) { const int g2 = gt - 64 * 16, pos = g2 >> 3, f = g2 & 7; const float inv = powf(10000.0f, -((float)(2 * f) / 16.0f)); const float ang = (float)pos * inv; t32[g2] = (f32x2){cosf(ang), sinf(ang)}; }
    }
    {
        bf16_t* wr = (bf16_t*)(ws + WS_WR);
        for (int i = F.bk * NTHREADS + F.tid; i < NL * 48 * D; i += GRID * NTHREADS) {
            const int c = i & 1023, j = (i >> 10) % 48, l = i / (48 * D);
            float wv = 0.f;
            if (j < 4) wv = a.w_rg[((size_t)l * D + c) * 4 + j]; else if (j < 36) wv = a.w_re[((size_t)l * D + c) * 32 + (j - 4)];
            const unsigned h = f2bf(wv); const float rem = wv - __builtin_bit_cast(float, h << 16);
            wr[((size_t)(l * 2 + 0) * 48 + j) * D + c] = (bf16_t)h; wr[((size_t)(l * 2 + 1) * 48 + j) * D + c] = (bf16_t)f2bf(rem);
        }
    }
    {
        LAS float* scr = (LAS float*)(F.lds + F.wave * 18432);
        const int gw = F.vcu * NWAVES + F.wave, NGW = GRID * NWAVES;
        constexpr int I_IN = 16 * 24, I_Q = 6 * 12, I_KV = 4 * 16, I_O = 16 * 16, I_GU = 16 * 16, I_D = 8 * 16;
        constexpr int N_SMALL = NL * (I_IN + I_Q + I_KV + I_O), N_GU = NL * NEXP * I_GU, N_D = NL * NEXP * I_D;
        for (int it = gw; it < N_SMALL; it += NGW) {
            {
                const int l = it / (I_IN + I_Q + I_KV + I_O); int r = it % (I_IN + I_Q + I_KV + I_O);
                if (r < I_IN) { const int kt = r / 24, pt = r % 24; tconv_tile(CpInSel{a.w_in + (size_t)l * D * 1440}, 1440, nullptr, (bf16_t*)(ws + WS_WIN) + (size_t)l * ZW * D, D, kt * 64, pt * 64, scr, F.lane); continue; }
                r -= I_IN;
                if (r < I_Q) { const int kt = r / 12, pt = r % 12; tconv_tile(CpQ{a.w_q_b + (size_t)l * 384 * QW}, QW, a.g_q_a + l * 384, (bf16_t*)(ws + WS_WQ) + (size_t)l * QW * 384, 384, kt * 64, pt * 64, scr, F.lane); continue; }
                r -= I_Q;
                if (r < I_KV) { const int kt = r / 16, pt = r % 16; tconv_tile(CpPlain{a.w_kv_b + (size_t)l * 256 * KVW, KVW}, KVW, a.g_kv_a + l * 256, (bf16_t*)(ws + WS_WKV) + (size_t)l * KVW * 256, 256, kt * 64, pt * 64, scr, F.lane); continue; }
                r -= I_KV;
                { const int kt = r / 16, pt = r % 16; tconv_tile(CpPlain{a.w_o + (size_t)l * D * D, D}, D, nullptr, (bf16_t*)(ws + WS_WO) + (size_t)l * D * D, D, kt * 64, pt * 64, scr, F.lane); }
            }
        }
        conv_experts(F, a, 0, -1);
    }
}

__device__ __forceinline__ void prologue2(const Ctx& F, KP kp) {
    const Args a = ldargs(kp);
    const float* modp = (const float*)(a.ws + WS_MODP); float* mod = (float*)(a.ws + WS_MOD);
    constexpr int NE = NL * 17 * 6144 / 4;
    for (int i = F.bk * NTHREADS + F.tid; i < NE; i += GRID * NTHREADS) {
        const int e = i * 4, l = e / (17 * 6144), n = e % 6144;
        f32x4 s = *(const f32x4*)(a.b_ada + l * 6144 + n);
#pragma unroll
        for (int kc = 0; kc < 4; ++kc) s = s + *(const f32x4*)(modp + (size_t)kc * NL * 17 * 6144 + e);
        *(f32x4*)(mod + e) = s;
    }
}

__device__ __forceinline__ void row_load(const float* p, int lane, f32x4 (&v)[4]) {
#pragma unroll
    for (int j = 0; j < 4; ++j) v[j] = *(const f32x4*)(p + 4 * lane + 256 * j);
}
__device__ __forceinline__ void row_ln(f32x4 (&v)[4], const float* g, const float* b, int lane) {
    float s = 0.f;
#pragma unroll
    for (int j = 0; j < 4; ++j) s += (v[j][0] + v[j][1]) + (v[j][2] + v[j][3]);
    const float mean = wave_sum(s) * (1.0f / D); float q = 0.f;
#pragma unroll
    for (int j = 0; j < 4; ++j) { v[j] = v[j] - mean; q += (v[j][0] * v[j][0] + v[j][1] * v[j][1]) + (v[j][2] * v[j][2] + v[j][3] * v[j][3]); }
    const float rstd = 1.0f / sqrtf(wave_sum(q) * (1.0f / D) + LN_EPS);
#pragma unroll
    for (int j = 0; j < 4; ++j) { const f32x4 gg = *(const f32x4*)(g + 4 * lane + 256 * j), bv = *(const f32x4*)(b + 4 * lane + 256 * j); v[j] = v[j] * rstd * gg + bv; }
}
__device__ __forceinline__ void row_ln_reg(f32x4 (&v)[4], const f32x4 (&g)[4], const f32x4 (&b)[4]) {
    float s = 0.f;
#pragma unroll
    for (int j = 0; j < 4; ++j) s += (v[j][0] + v[j][1]) + (v[j][2] + v[j][3]);
    const float mean = wave_sum(s) * (1.0f / D); float q = 0.f;
#pragma unroll
    for (int j = 0; j < 4; ++j) { v[j] = v[j] - mean; q += (v[j][0] * v[j][0] + v[j][1] * v[j][1]) + (v[j][2] * v[j][2] + v[j][3] * v[j][3]); }
    const float rstd = 1.0f / sqrtf(wave_sum(q) * (1.0f / D) + LN_EPS);
#pragma unroll
    for (int j = 0; j < 4; ++j) v[j] = v[j] * rstd * g[j] + b[j];
}
__device__ __forceinline__ void row_store_mod_bf16(bf16_t* hrow, const f32x4 (&v)[4], const float* sh, const float* sc, int lane) {
#pragma unroll
    for (int j = 0; j < 4; ++j) {
        const f32x4 s1 = *(const f32x4*)(sc + 4 * lane + 256 * j), s0 = *(const f32x4*)(sh + 4 * lane + 256 * j);
        const f32x4 h = v[j] * (s1 + 1.0f) + s0;
        st_bf4(hrow + 4 * lane + 256 * j, h);
    }
}

__device__ __forceinline__ void prologue3(const Ctx& F, KP kp) {
    const Args a = ldargs(kp);
    const float* modp = (const float*)(a.ws + WS_MODP); bf16_t* H = (bf16_t*)(a.ws + WS_H);
    const int gw = F.vcu * NWAVES + F.wave, NGW = GRID * NWAVES;
    for (int r = gw; r < MT; r += NGW) {
        const float* xr = (r < TL) ? (a.x + (size_t)r * D) : (a.ctx + (size_t)(r - TL) * D);
        const int bb = bb_of(r);
        f32x4 v[4]; row_load(xr, F.lane, v);
#pragma unroll
        for (int j = 0; j < 4; ++j) {
            const int c = 4 * F.lane + 256 * j;
            f32x4 sh = *(const f32x4*)(a.b_ada + c), sc = *(const f32x4*)(a.b_ada + 1024 + c);
#pragma unroll
            for (int kc = 0; kc < 4; ++kc) { const float* mp = modp + ((size_t)(kc * NL + 0) * 17 + bb) * 6144; sh = sh + *(const f32x4*)(mp + c); sc = sc + *(const f32x4*)(mp + 1024 + c); }
            st_bf4(H + (size_t)r * D + c, v[j] * (sc + 1.0f) + sh);
        }
    }
}

__device__ __forceinline__ void unpack8(const u32x4 w, float (&v)[8]) { v[0] = bflo(w.x); v[1] = bfhi(w.x); v[2] = bflo(w.y); v[3] = bfhi(w.y); v[4] = bflo(w.z); v[5] = bfhi(w.z); v[6] = bflo(w.w); v[7] = bfhi(w.w); }
__device__ __forceinline__ u32x4 pack8(const float (&v)[8]) { u32x4 w; w.x = pk2(v[0], v[1]); w.y = pk2(v[2], v[3]); w.z = pk2(v[4], v[5]); w.w = pk2(v[6], v[7]); return w; }
__device__ __forceinline__ u32x4 head64_norm_rope(const u32x4 raw, const float (&g)[8], const LAS f32x2* t64, bool lat, int gr, int gc, int w8, float scale) {
    float v[8]; unpack8(raw, v);
    float ss = 0.f;
#pragma unroll
    for (int e = 0; e < 8; ++e) ss += v[e] * v[e];
    ss += lane_xor<1>(ss); ss += lane_xor<2>(ss); ss += lane_xor<4>(ss);
    const float rn = 1.0f / sqrtf(ss * (1.0f / 64.0f) + RMS_EPS);
    float y[8], p[8], o[8];
#pragma unroll
    for (int e = 0; e < 8; ++e) { y[e] = v[e] * rn * g[e]; p[e] = lane_xor<2>(y[e]); o[e] = y[e]; }
    if (lat) {
        const int pos = (w8 >> 2) ? gc : gr; const LAS f32x2* cs = t64 + pos * 16 + 8 * (w8 & 1); const bool x2 = (w8 & 2) != 0;
#pragma unroll
        for (int e = 0; e < 8; ++e) { const f32x2 c = cs[e]; o[e] = x2 ? (y[e] * c.x + p[e] * c.y) : (y[e] * c.x - p[e] * c.y); }
    }
#pragma unroll
    for (int e = 0; e < 8; ++e) o[e] *= scale;
    return pack8(o);
}
__device__ __forceinline__ void phase_split(const Ctx& F, KP kp, int l) {
    const Args a = ldargs(kp);
    unsigned char* ws = a.ws;
    const bf16_t* Z = (const bf16_t*)(ws + WS_Z);
    float* rstdq = (float*)(ws + WS_RSTDQ); float* rstdkv = (float*)(ws + WS_RSTDKV);
    bf16_t* Km = (bf16_t*)(ws + WS_KM); bf16_t* Qg = (bf16_t*)(ws + WS_QG); bf16_t* Kg = (bf16_t*)(ws + WS_KG); bf16_t* Vg = (bf16_t*)(ws + WS_VG);
    LAS f32x2* t64 = (LAS f32x2*)(F.lds + 65536); LAS f32x2* t32 = (LAS f32x2*)(F.lds + 65536 + 8192);
    __syncthreads();
    for (int i = F.tid; i < 64 * 16; i += NTHREADS) t64[i] = ((const f32x2*)(ws + WS_TAB64))[i];
    if (F.tid < 64 * 8) t32[F.tid] = ((const f32x2*)(ws + WS_TAB32))[F.tid];
    __syncthreads();
    const int lane = F.lane, gw = F.vcu * NWAVES + F.wave, NGW = GRID * NWAVES, w8 = lane & 7;
    float ggq[8], ggk[8];
#pragma unroll
    for (int e = 0; e < 8; ++e) { ggq[e] = a.g_gq[l * 64 + 8 * w8 + e]; ggk[e] = a.g_gk[l * 64 + 8 * w8 + e]; }
    const int offA2 = 8 * (64 + (lane & 15)), offB = 672 + 8 * lane;
    const int offC = (lane < 4) ? (640 + 8 * lane) : (lane >= 8 && lane < 24) ? (1184 + 8 * (lane - 8)) : (lane >= 24 && lane < 40) ? (1312 + 8 * (lane - 24)) : 0;
    u32x4 nA1, nA2, nB, nC;
#define P2_LOAD(rr) do { const bf16_t* zr_ = Z + (size_t)(rr) * ZW; nA1 = *(const u32x4*)(zr_ + 8 * lane); nA2 = *(const u32x4*)(zr_ + offA2); nB = *(const u32x4*)(zr_ + offB); nC = *(const u32x4*)(zr_ + offC); } while (0)
    if (gw < MT) P2_LOAD(gw);
    for (int r = gw; r < MT; r += NGW) {
        const u32x4 A1 = nA1, A2 = nA2, B = nB, C = nC;
        if (r + NGW < MT) P2_LOAD(r + NGW);
        const bool lat = r < TL; const int s = r & 2047, gr = s >> 6, gc = s & 63, kr = krow_of(r);
        { float v[8]; unpack8(A1, v); float s1 = 0.f;
#pragma unroll
          for (int e = 0; e < 8; ++e) s1 += v[e] * v[e];
          unpack8(A2, v); float s2 = 0.f;
#pragma unroll
          for (int e = 0; e < 8; ++e) s2 += v[e] * v[e];
          const float sq = wave_sum(lane < 48 ? s1 : 0.f), sk = wave_sum((lane >= 48 ? s1 : 0.f) + (lane < 16 ? s2 : 0.f));
          if (lane == 0) { rstdq[r] = 1.0f / sqrtf(sq * (1.0f / 384.0f) + RMS_EPS); rstdkv[r] = 1.0f / sqrtf(sk * (1.0f / 256.0f) + RMS_EPS); } }
        { const u32x4 o = head64_norm_rope(B, ggq, t64, lat, gr, gc, w8, QSCALE_G); *(u32x4*)(Qg + (size_t)r * 512 + 8 * lane) = o; }
        { const u32x4 o = head64_norm_rope(C, ggk, t64, lat, gr, gc, w8, 1.0f); if (lane >= 8 && lane < 24) *(u32x4*)(Kg + (size_t)kr * 128 + 8 * (lane - 8)) = o; }
        if (lane >= 24 && lane < 40) *(u32x4*)(Vg + (size_t)kr * 128 + 8 * (lane - 24)) = C;
        { float v[8], p[8], o[8]; unpack8(C, v);
#pragma unroll
          for (int e = 0; e < 8; ++e) { p[e] = lane_xor<1>(v[e]); o[e] = v[e]; }
          if (lat) { const int pos = ((lane >> 1) & 1) ? gc : gr; const LAS f32x2* cs = t32 + pos * 8; const bool x2 = (lane & 1) != 0;
#pragma unroll
              for (int e = 0; e < 8; ++e) { const f32x2 c = cs[e]; o[e] = x2 ? (v[e] * c.x + p[e] * c.y) : (v[e] * c.x - p[e] * c.y); } }
          const u32x4 ow = pack8(o);
          if (lane < 4) {
#pragma unroll
              for (int h = 0; h < 8; ++h) *(u32x4*)(Km + (size_t)kr * QW + h * 96 + 64 + 8 * lane) = ow; } }
    }
#undef P2_LOAD
}

typedef float f32x4m __attribute__((ext_vector_type(4)));
template <bool XF32>
__device__ __forceinline__ void phase_ln1_route(const Ctx& F, KP kp, int l, int ntok) {
    const Args a = ldargs(kp);
    unsigned char* ws = a.ws;
    const bf16_t* Yo = (const bf16_t*)(ws + WS_U); float* XC = (float*)(ws + WS_XC); bf16_t* H = (bf16_t*)(ws + WS_H);
    bf16_t* XB = (bf16_t*)(ws + WS_XB); constexpr bool xf32 = XF32;
    const float* mod = (const float*)(ws + WS_MOD) + (size_t)l * 17 * 6144;
    int* toke = (int*)(ws + WS_TOKE); int* tokr = (int*)(ws + WS_TOKR); float* tokw = (float*)(ws + WS_TOKW);
    volatile LAS int* cntl = (volatile LAS int*)(F.lds + MISC_CNT);
    const int lane = F.lane;
    __syncthreads();
    if (F.tid < 32) cntl[F.tid] = 0;
    if (F.tid < 36) ((LAS float*)(F.lds + MISC_LG + 2048))[F.tid] = (F.tid < 4) ? a.b_rg[l * 4 + F.tid] : a.b_re[l * 32 + F.tid - 4];
    const int tpb = ntok / GRID;
    {
        f32x4 nx[4]; u32x2 ny[4]; int i = F.wave;
        f32x4 LG[4], LB[4], GA[4], SH[4], SC[4]; int bbc = -1;
#pragma unroll
        for (int j = 0; j < 4; ++j) { LG[j] = *(const f32x4*)(a.ln1_g + l * D + 4 * lane + 256 * j); LB[j] = *(const f32x4*)(a.ln1_b + l * D + 4 * lane + 256 * j); }
        u32x2 nb[4];
#define P6_LOAD(tt) do { const int t_ = (tt); \
        if (xf32) { const float* xp_ = (t_ < TL) ? (a.x + (size_t)t_ * D) : (a.ctx + (size_t)(t_ - TL) * D); row_load(xp_, lane, nx); } \
        else { _Pragma("unroll") for (int j = 0; j < 4; ++j) nb[j] = *(const u32x2*)(XB + (size_t)t_ * D + 4 * lane + 256 * j); } \
        _Pragma("unroll") for (int j = 0; j < 4; ++j) ny[j] = *(const u32x2*)(Yo + (size_t)t_ * D + 4 * lane + 256 * j); } while (0)
        if (i < tpb) P6_LOAD(F.bk * tpb + i);
        for (; i < tpb; i += NWAVES) {
            const int t = F.bk * tpb + i, bb = bb_of(t);
            if (bb != bbc) {
                bbc = bb;
#pragma unroll
                for (int j = 0; j < 4; ++j) { const int c = 4 * lane + 256 * j; GA[j] = *(const f32x4*)(mod + (size_t)(bb * 6 + 2) * D + c);
                    SH[j] = *(const f32x4*)(mod + (size_t)(bb * 6 + 3) * D + c); SC[j] = *(const f32x4*)(mod + (size_t)(bb * 6 + 4) * D + c); }
            }
            f32x4 v[4];
#pragma unroll
            for (int j = 0; j < 4; ++j) { const f32x4 y = {bflo(ny[j].x), bfhi(ny[j].x), bflo(ny[j].y), bfhi(ny[j].y)};
                const f32x4 xv = xf32 ? nx[j] : (f32x4){bflo(nb[j].x), bfhi(nb[j].x), bflo(nb[j].y), bfhi(nb[j].y)}; v[j] = xv * ALPHA + GA[j] * y; }
            if (i + NWAVES < tpb) P6_LOAD(t + NWAVES);
            row_ln_reg(v, LG, LB);
#pragma unroll
            for (int j = 0; j < 4; ++j) st_bf4(XB + (size_t)t * D + 4 * lane + 256 * j, v[j]);
#pragma unroll
            for (int j = 0; j < 4; ++j) {
                const f32x4 h = v[j] * (SC[j] + 1.0f) + SH[j];
                st_bf4(H + (size_t)t * D + 4 * lane + 256 * j, h);
            }
        }
    }
#undef P6_LOAD
    asm volatile("s_waitcnt vmcnt(0)" ::: "memory");
    __syncthreads();
    {
        const bf16_t* wrh = (const bf16_t*)(ws + WS_WR) + (size_t)(l * 2) * 48 * D; const bf16_t* wrl = wrh + (size_t)48 * D;
        LAS float* lg = (LAS float*)(F.lds + F.wave * 4096);
        const LAS float* bias = (const LAS float*)(F.lds + MISC_LG + 2048);
        const int fr = lane & 15, fq = lane >> 4;
        for (int g = F.wave; g < tpb / 16; g += NWAVES) {
            const int t0 = F.bk * tpb + g * 16;
            const bf16_t* hh = H + (size_t)(t0 + fr) * D + 8 * fq;
            f32x4m acc0 = {0.f, 0.f, 0.f, 0.f}, acc1 = acc0, acc2 = acc0;
#pragma unroll 2
            for (int ks = 0; ks < 32; ++ks) {
                const bf16x8 bh = *(const bf16x8*)(hh + 32 * ks);
                const bf16_t* wp = wrh + (size_t)fr * D + 32 * ks + 8 * fq; const bf16_t* wq = wrl + (size_t)fr * D + 32 * ks + 8 * fq;
                const bf16x8 a0h = *(const bf16x8*)(wp), a1h = *(const bf16x8*)(wp + 16 * D), a2h = *(const bf16x8*)(wp + 32 * D);
                const bf16x8 a0l = *(const bf16x8*)(wq), a1l = *(const bf16x8*)(wq + 16 * D), a2l = *(const bf16x8*)(wq + 32 * D);
                acc0 = __builtin_amdgcn_mfma_f32_16x16x32_bf16(a0h, bh, acc0, 0, 0, 0); acc1 = __builtin_amdgcn_mfma_f32_16x16x32_bf16(a1h, bh, acc1, 0, 0, 0); acc2 = __builtin_amdgcn_mfma_f32_16x16x32_bf16(a2h, bh, acc2, 0, 0, 0);
                acc0 = __builtin_amdgcn_mfma_f32_16x16x32_bf16(a0l, bh, acc0, 0, 0, 0); acc1 = __builtin_amdgcn_mfma_f32_16x16x32_bf16(a1l, bh, acc1, 0, 0, 0); acc2 = __builtin_amdgcn_mfma_f32_16x16x32_bf16(a2l, bh, acc2, 0, 0, 0);
            }
#pragma unroll
            for (int r = 0; r < 4; ++r) { lg[fr * 48 + 4 * fq + r] = acc0[r]; lg[fr * 48 + 16 + 4 * fq + r] = acc1[r]; lg[fr * 48 + 32 + 4 * fq + r] = acc2[r]; }
            LDS_WAIT();
            if (lane < 16) {
                const int t = t0 + lane; const LAS float* q = lg + lane * 48;
                float l4[4];
#pragma unroll
                for (int o = 0; o < 4; ++o) l4[o] = q[o] + bias[o];
                int gs = 0; float gm = l4[0];
#pragma unroll
                for (int o = 1; o < 4; ++o) if (l4[o] > gm) { gm = l4[o]; gs = o; }
                float den = 0.f;
#pragma unroll
                for (int o = 0; o < 4; ++o) den += expf(l4[o] - gm);
                const float pstar = 1.0f / den;
                float le[8];
#pragma unroll
                for (int o = 0; o < 8; ++o) le[o] = q[4 + gs * 8 + o] + bias[4 + gs * 8 + o];
                int i1 = 0; float v1 = le[0];
#pragma unroll
                for (int o = 1; o < 8; ++o) if (le[o] > v1) { v1 = le[o]; i1 = o; }
                int i2 = -1; float v2 = -3.0e38f;
#pragma unroll
                for (int o = 0; o < 8; ++o) if (o != i1 && le[o] > v2) { v2 = le[o]; i2 = o; }
                const float ex = expf(v2 - v1), w1 = pstar / (1.0f + ex), w2 = pstar * ex / (1.0f + ex);
                const int e1 = gs * 8 + i1, e2 = gs * 8 + i2;
                const int r1 = __hip_atomic_fetch_add((LAS int*)(F.lds + MISC_CNT) + e1, 1, __ATOMIC_RELAXED, __HIP_MEMORY_SCOPE_WORKGROUP);
                const int r2 = __hip_atomic_fetch_add((LAS int*)(F.lds + MISC_CNT) + e2, 1, __ATOMIC_RELAXED, __HIP_MEMORY_SCOPE_WORKGROUP);
                toke[2 * t] = e1; toke[2 * t + 1] = e2; tokr[2 * t] = r1; tokr[2 * t + 1] = r2; tokw[2 * t] = w1; tokw[2 * t + 1] = w2;
            }
            LDS_WAIT();
        }
    }
    __syncthreads();
    if (F.tid < 32) ((int*)(ws + WS_BLKCNT))[((size_t)l * 256 + F.bk) * 32 + F.tid] = cntl[F.tid];
}

__device__ __forceinline__ void moe_tables(const Ctx& F, KP kp, int l, bool publish) {
    const Args a = ldargs(kp);
    const int* blkcnt = (const int*)(a.ws + WS_BLKCNT) + (size_t)l * 256 * 32;
    volatile LAS int* pa = (volatile LAS int*)(F.lds + MISC_PA); volatile LAS int* pb = (volatile LAS int*)(F.lds + MISC_PB);
    volatile LAS int* tot = (volatile LAS int*)(F.lds + MISC_TOT); volatile LAS int* base = (volatile LAS int*)(F.lds + MISC_BASE); volatile LAS int* poff = (volatile LAS int*)(F.lds + MISC_POFF);
    __syncthreads();
    {
        const int e = F.tid & 31, part = F.tid >> 5; int sa = 0, sb = 0;
        for (int j = 0; j < 16; ++j) { const int b2 = part * 16 + j; const int c = blkcnt[b2 * 32 + e]; sa += c; sb += (b2 < F.bk) ? c : 0; }
        pa[part * 32 + e] = sa; pb[part * 32 + e] = sb;
    }
    __syncthreads();
    if (F.tid < 32) { int sa = 0, sb = 0; for (int p = 0; p < 16; ++p) { sa += pa[p * 32 + F.tid]; sb += pb[p * 32 + F.tid]; } tot[F.tid] = sa; base[F.tid] = sb; }
    __syncthreads();
    if (F.tid == 0) { int o = 0; for (int e = 0; e < 32; ++e) { poff[e] = o; o += (tot[e] + 255) & ~255; } poff[32] = o; }
    __syncthreads();
    if (publish && F.bk == 0 && F.tid < 33) ((int*)(a.ws + WS_MOETAB))[l * 128 + F.tid] = poff[F.tid];
}

__device__ __forceinline__ void phase_dispatch(const Ctx& F, KP kp, int l, int ntok) {
    const Args a = ldargs(kp);
    unsigned char* ws = a.ws;
    if (l > 0) conv_experts(F, a, l, -1);
    moe_tables(F, kp, l, true);
    volatile LAS int* base = (volatile LAS int*)(F.lds + MISC_BASE); volatile LAS int* poff = (volatile LAS int*)(F.lds + MISC_POFF); volatile LAS int* tot = (volatile LAS int*)(F.lds + MISC_TOT);
    const int* toke = (const int*)(ws + WS_TOKE); const int* tokr = (const int*)(ws + WS_TOKR); int* tokp = (int*)(ws + WS_TOKP); int* postok = (int*)(ws + WS_POSTOK);
    const int tpb = ntok / GRID;
    if (F.tid < tpb) {
        const int t = F.bk * tpb + F.tid;
        const int2 e = *(const int2*)(toke + 2 * t), r = *(const int2*)(tokr + 2 * t);
        const int p1 = poff[e.x] + base[e.x] + r.x, p2 = poff[e.y] + base[e.y] + r.y;
        *(int2*)(tokp + 2 * t) = (int2){p1, p2};
        postok[p1] = t; postok[p2] = t;
    }
    { const int idx = F.bk * NTHREADS + F.tid;
      if (idx < poff[32]) { int e = 0;
#pragma unroll
          for (int j = 1; j < 32; ++j) e += (poff[j] <= idx) ? 1 : 0;
          if (idx >= poff[e] + tot[e]) postok[idx] = 0; } }
}

__device__ __forceinline__ void phase_ln2(const Ctx& F, KP kp, int l, int ntok, bool dry = false) {
    const Args a = ldargs(kp);
    unsigned char* ws = a.ws;
    const bf16_t* Ys = (const bf16_t*)(ws + WS_XS); float* XC = (float*)(ws + WS_XC); bf16_t* H = (bf16_t*)(ws + WS_H);
    const float* mod = (const float*)(ws + WS_MOD) + (size_t)l * 17 * 6144;
    const float* modn = (const float*)(ws + WS_MOD) + (size_t)(l + 1 < NL ? l + 1 : l) * 17 * 6144;
    const int* tokp = (const int*)(ws + WS_TOKP); const float* tokw = (const float*)(ws + WS_TOKW);
    const int gw = F.vcu * NWAVES + F.wave, NGW = GRID * NWAVES, lane = F.lane;
    const int per = ntok / NGW, t0 = gw * per, t1 = t0 + per;
    f32x4 LG[4], LB[4], GF[4], SH[4], SC[4];
#pragma unroll
    for (int j = 0; j < 4; ++j) { LG[j] = *(const f32x4*)(a.ln2_g + l * D + 4 * lane + 256 * j); LB[j] = *(const f32x4*)(a.ln2_b + l * D + 4 * lane + 256 * j); }
    int bbc = -1;
    int2 pn = {0, 0}; float2 wn = {0.f, 0.f};
    u32x2 xn[4], yan[4], ybn[4]; bf16_t* XB = (bf16_t*)(ws + WS_XB);
#define P10_REC(tt) do { pn = *(const int2*)(tokp + 2 * (tt)); wn = *(const float2*)(tokw + 2 * (tt)); } while (0)
#define P10_ROWS(tt, p_) do { const int t_ = (tt); _Pragma("unroll") for (int j = 0; j < 4; ++j) xn[j] = *(const u32x2*)(XB + (size_t)t_ * D + 4 * lane + 256 * j); \
        _Pragma("unroll") for (int j = 0; j < 4; ++j) { yan[j] = *(const u32x2*)(Ys + (size_t)(p_).x * D + 4 * lane + 256 * j); ybn[j] = *(const u32x2*)(Ys + (size_t)(p_).y * D + 4 * lane + 256 * j); } } while (0)
    float2 wc = {0.f, 0.f};
    P10_REC(t0); wc = wn; P10_ROWS(t0, pn); if (t0 + 1 < t1) P10_REC(t0 + 1);
    for (int t = t0; t < t1; ++t) {
        const int bb = bb_of(t);
        if (bb != bbc) {
            bbc = bb;
#pragma unroll
            for (int j = 0; j < 4; ++j) { const int c = 4 * lane + 256 * j; GF[j] = *(const f32x4*)(mod + (size_t)(bb * 6 + 5) * D + c);
                SH[j] = *(const f32x4*)(modn + (size_t)(bb * 6 + 0) * D + c); SC[j] = *(const f32x4*)(modn + (size_t)(bb * 6 + 1) * D + c); }
        }
        f32x4 v[4]; u32x2 ya[4], yb[4];
#pragma unroll
        for (int j = 0; j < 4; ++j) { v[j] = (f32x4){bflo(xn[j].x), bfhi(xn[j].x), bflo(xn[j].y), bfhi(xn[j].y)}; ya[j] = yan[j]; yb[j] = ybn[j]; }
        const float w1 = wc.x, w2 = wc.y;
        if (t + 1 < t1) { wc = wn; P10_ROWS(t + 1, pn); if (t + 2 < t1) P10_REC(t + 2); }
#pragma unroll
        for (int j = 0; j < 4; ++j) {
            const f32x4 y = (f32x4){bflo(ya[j].x), bfhi(ya[j].x), bflo(ya[j].y), bfhi(ya[j].y)} * w1 + (f32x4){bflo(yb[j].x), bfhi(yb[j].x), bflo(yb[j].y), bfhi(yb[j].y)} * w2;
            v[j] = v[j] * ALPHA + GF[j] * y;
        }
        row_ln_reg(v, LG, LB);
        if (l + 1 < NL) {
#pragma unroll
            for (int j = 0; j < 4; ++j) st_bf4(XB + (size_t)t * D + 4 * lane + 256 * j, v[j]);
        } else {
#pragma unroll
            for (int j = 0; j < 4; ++j) *(f32x4*)(a.out + (size_t)t * D + 4 * lane + 256 * j) = v[j];
        }
        if (l + 1 < NL) { bf16_t* hrow = H + (size_t)t * D;
#pragma unroll
            for (int j = 0; j < 4; ++j) st_bf4(hrow + 4 * lane + 256 * j, v[j] * (SC[j] + 1.0f) + SH[j]); }
    }
#undef P10_REC
#undef P10_ROWS
}

template <int QD>
__device__ __forceinline__ void attn_naive_task(const bf16_t* qp, const bf16_t* kp, int kstride, const bf16_t* vp, int vstride, int nkeys, bf16_t* op) {
    u32x4 qv[QD / 8];
#pragma unroll
    for (int i = 0; i < QD / 8; ++i) qv[i] = *(const u32x4*)(qp + 8 * i);
#pragma unroll 1
    for (int half = 0; half < 2; ++half) {
        float o[32];
#pragma unroll
        for (int i = 0; i < 32; ++i) o[i] = 0.f;
        float m = -1.0e30f, lsum = 0.f;
#pragma unroll 1
        for (int j = 0; j < nkeys; ++j) {
            const u32x4* kr = (const u32x4*)(kp + (size_t)j * kstride);
            float s = 0.f;
#pragma unroll
            for (int i = 0; i < QD / 8; ++i) s = dot8(qv[i], kr[i], s);
            if (s > m) { const float al = __builtin_amdgcn_exp2f(m - s); lsum *= al;
#pragma unroll
                for (int i = 0; i < 32; ++i) o[i] *= al;
                m = s; }
            const float p = __builtin_amdgcn_exp2f(s - m); lsum += p;
            const u32x4* vr = (const u32x4*)(vp + (size_t)j * vstride + 32 * half);
#pragma unroll
            for (int i = 0; i < 4; ++i) { const u32x4 w = vr[i];
                o[8 * i + 0] += p * bflo(w.x); o[8 * i + 1] += p * bfhi(w.x); o[8 * i + 2] += p * bflo(w.y); o[8 * i + 3] += p * bfhi(w.y); o[8 * i + 4] += p * bflo(w.z); o[8 * i + 5] += p * bfhi(w.z); o[8 * i + 6] += p * bflo(w.w); o[8 * i + 7] += p * bfhi(w.w); }
        }
        const float rl = 1.0f / lsum;
#pragma unroll
        for (int i = 0; i < 4; ++i) { u32x4 w; w.x = pk2(o[8 * i] * rl, o[8 * i + 1] * rl); w.y = pk2(o[8 * i + 2] * rl, o[8 * i + 3] * rl); w.z = pk2(o[8 * i + 4] * rl, o[8 * i + 5] * rl); w.w = pk2(o[8 * i + 6] * rl, o[8 * i + 7] * rl); *(u32x4*)(op + 32 * half + 8 * i) = w; }
    }
}
__device__ __forceinline__ void phase_attn_naive(const Ctx& F, KP kp, bool last) {
    const Args a = ldargs(kp);
    unsigned char* ws = a.ws;
    const bf16_t* Qm = (const bf16_t*)(ws + WS_QM); const bf16_t* Km = (const bf16_t*)(ws + WS_KM); const bf16_t* Vm = (const bf16_t*)(ws + WS_VM);
    const bf16_t* Qg = (const bf16_t*)(ws + WS_QG); const bf16_t* Kg = (const bf16_t*)(ws + WS_KG); const bf16_t* Vg = (const bf16_t*)(ws + WS_VG);
    bf16_t* O = (bf16_t*)(ws + WS_O);
    const int gw = F.vcu * NWAVES + F.wave, NGW = GRID * NWAVES;
    const int ntask = 8192 + (last ? 0 : 1024);
    for (int T = gw; T < ntask; T += NGW) {
        int b, h16, r, nkeys;
        if (T < 8192) { const int qw = T & 31; h16 = (T >> 5) & 15; b = T >> 9; r = b * SEQ + 64 * qw + F.lane; nkeys = KPB; }
        else { const int T2 = T - 8192, qw = T2 & 3; h16 = (T2 >> 2) & 15; b = T2 >> 6; r = TL + b * CTX + 64 * qw + F.lane; nkeys = CTX; }
        bf16_t* op = O + (size_t)r * D + h16 * 64;
        if (h16 < 8) attn_naive_task<96>(Qm + (size_t)r * QW + h16 * 96, Km + (size_t)b * KPB * QW + h16 * 96, QW, Vm + (size_t)b * KPB * 512 + h16 * 64, 512, nkeys, op);
        else { const int hh = h16 - 8, kvh = hh >> 2; attn_naive_task<64>(Qg + (size_t)r * 512 + hh * 64, Kg + (size_t)b * KPB * 128 + kvh * 64, 128, Vg + (size_t)b * KPB * 128 + kvh * 64, 128, nkeys, op); }
    }
}

typedef float f32x16 __attribute__((ext_vector_type(16)));
typedef short s16x4 __attribute__((ext_vector_type(4)));
__device__ __forceinline__ s16x4 vtr(const LAS unsigned char* p) { return __builtin_bit_cast(s16x4, __builtin_amdgcn_ds_read_tr16_b64_v4i16((LAS s16x4*)p)); }
__device__ __forceinline__ unsigned cvtpk(float lo, float hi) { typedef __bf16 bf2 __attribute__((ext_vector_type(2))); f32x2 v = {lo, hi}; bf2 b = __builtin_convertvector(v, bf2); return __builtin_bit_cast(unsigned, b); }
constexpr float ATT_THR = 6.0f;
constexpr int ATT_KSLOT = 12288, ATT_VSLOT = 8192, ATT_NKS = 3, ATT_NVS = 4, ATT_V0 = ATT_NKS * ATT_KSLOT;
__device__ __forceinline__ void att_glds16(const void* gsrc, unsigned lds_dst) { unsigned keep;
    asm volatile("s_mov_b32 %0, m0\n\ts_mov_b32 m0, %2\n\ts_nop 0\n\tglobal_load_lds_dwordx4 %1, off\n\ts_mov_b32 m0, %0" : "=&s"(keep) : "v"(gsrc), "s"(lds_dst) : "memory"); }
#define ATT_WAITBAR(N) asm volatile("s_waitcnt vmcnt(" #N ") lgkmcnt(0)\n\ts_barrier" ::: "memory")
template <int QD>
__device__ __forceinline__ void attn_unit(LAS unsigned char* lds, int tid, const bf16_t* Kb, int kstride, const bf16_t* Vb, int vstride, int ntiles, const bf16_t* qrow, bf16_t* orow) {
    constexpr int NC = QD / 8, NS = QD / 16;
    const int lane = tid & 63, r32 = lane & 31, hi = lane >> 5;
    const int w = __builtin_amdgcn_readfirstlane(tid >> 6);
    const bool three = (NC == 12) && (w < 4);
    const int vp = (NC == 12) ? (w < 4 ? w + 4 : w - 4) : w;
    const bf16_t* ksrcA = Kb + (size_t)lane * kstride + w * 8;
    const bf16_t* ksrcB = Kb + (size_t)lane * kstride + (w + 8) * 8;
    const bf16_t* vsrc = Vb + (size_t)(16 * (vp & 3) + (lane >> 2)) * vstride + (vp >> 2) * 32 + (lane & 3) * 8;
    const size_t kstep = (size_t)64 * kstride, vstep = (size_t)64 * vstride;
    const unsigned lds0 = (unsigned)(size_t)lds;
#define ATT_DMA(t_, ks_, vs_) do { \
        att_glds16(ksrcA + (size_t)(t_) * kstep, (unsigned)__builtin_amdgcn_readfirstlane((int)(lds0 + (ks_) * ATT_KSLOT + w * 1024))); \
        if (three) att_glds16(ksrcB + (size_t)(t_) * kstep, (unsigned)__builtin_amdgcn_readfirstlane((int)(lds0 + (ks_) * ATT_KSLOT + (w + 8) * 1024))); \
        att_glds16(vsrc + (size_t)(t_) * vstep, (unsigned)__builtin_amdgcn_readfirstlane((int)(lds0 + ATT_V0 + (vs_) * ATT_VSLOT + vp * 1024))); } while (0)
    ATT_DMA(0, 0, 0);
    if (ntiles > 1) ATT_DMA(1, 1, 1);
    bf16x8 qr[NS];
#pragma unroll
    for (int s = 0; s < NS; ++s) qr[s] = *(const bf16x8*)(qrow + 16 * s + 8 * hi);
    f32x16 o0, o1, negm, p0, p1;
#pragma unroll
    for (int r = 0; r < 16; ++r) { o0[r] = 0.f; o1[r] = 0.f; negm[r] = 0.f; p0[r] = 0.f; p1[r] = 0.f; }
    float lsum = 0.f;
    const int kread = hi * 1024 + r32 * 16;
    const int vread = ATT_V0 + ((lane >> 4) & 1) * 32 + (lane & 3) * 8 + (4 * hi + ((lane & 15) >> 2)) * 64;
#define ATT_QK(ks_) do { const LAS unsigned char* kb_ = lds + (ks_) * ATT_KSLOT + kread; \
        _Pragma("unroll") for (int s = 0; s < NS; ++s) { \
            const bf16x8 a0 = *(const LAS bf16x8*)(kb_ + s * 2048), a1 = *(const LAS bf16x8*)(kb_ + s * 2048 + 512); \
            if (s == 0) { p0 = __builtin_amdgcn_mfma_f32_32x32x16_bf16(a0, qr[0], negm, 0, 0, 0); p1 = __builtin_amdgcn_mfma_f32_32x32x16_bf16(a1, qr[0], negm, 0, 0, 0); } \
            else { p0 = __builtin_amdgcn_mfma_f32_32x32x16_bf16(a0, qr[s], p0, 0, 0, 0); p1 = __builtin_amdgcn_mfma_f32_32x32x16_bf16(a1, qr[s], p1, 0, 0, 0); } } } while (0)
#define ATT_SOFT_PV(first_, vs_) do { \
        float mx = fmaxf(fmaxf(p0[0], p1[0]), p0[1]); \
        _Pragma("unroll") for (int r = 1; r < 16; ++r) mx = (r == 1) ? fmaxf(mx, p1[1]) : fmaxf(fmaxf(mx, p0[r]), p1[r]); \
        { auto rr = __builtin_amdgcn_permlane32_swap(__float_as_uint(mx), __float_as_uint(mx), false, false); mx = fmaxf(__uint_as_float(rr[0]), __uint_as_float(rr[1])); } \
        if ((first_) || __any(mx > ATT_THR)) { \
            const float dl = (first_) ? mx : fmaxf(mx, 0.f); \
            _Pragma("unroll") for (int r = 0; r < 16; ++r) { p0[r] -= dl; p1[r] -= dl; negm[r] -= dl; } \
            if (!(first_)) { const float f = __builtin_amdgcn_exp2f(-dl); lsum *= f; \
                _Pragma("unroll") for (int r = 0; r < 16; ++r) { o0[r] *= f; o1[r] *= f; } } \
        } \
        float rs = 0.f; \
        _Pragma("unroll") for (int r = 0; r < 16; ++r) { p0[r] = __builtin_amdgcn_exp2f(p0[r]); p1[r] = __builtin_amdgcn_exp2f(p1[r]); rs += p0[r] + p1[r]; } \
        lsum += rs; \
        u32x4 w0, w1, w2, w3; \
        w0.x = cvtpk(p0[0], p0[1]); w0.y = cvtpk(p0[2], p0[3]); w0.z = cvtpk(p0[4], p0[5]); w0.w = cvtpk(p0[6], p0[7]); \
        w1.x = cvtpk(p0[8], p0[9]); w1.y = cvtpk(p0[10], p0[11]); w1.z = cvtpk(p0[12], p0[13]); w1.w = cvtpk(p0[14], p0[15]); \
        w2.x = cvtpk(p1[0], p1[1]); w2.y = cvtpk(p1[2], p1[3]); w2.z = cvtpk(p1[4], p1[5]); w2.w = cvtpk(p1[6], p1[7]); \
        w3.x = cvtpk(p1[8], p1[9]); w3.y = cvtpk(p1[10], p1[11]); w3.z = cvtpk(p1[12], p1[13]); w3.w = cvtpk(p1[14], p1[15]); \
        const bf16x8 pa0 = __builtin_bit_cast(bf16x8, w0), pa1 = __builtin_bit_cast(bf16x8, w1), pa2 = __builtin_bit_cast(bf16x8, w2), pa3 = __builtin_bit_cast(bf16x8, w3); \
        const LAS unsigned char* vb_ = lds + (vs_) * ATT_VSLOT + vread; \
        o0 = __builtin_amdgcn_mfma_f32_32x32x16_bf16(ATT_VF(0, 0), pa0, o0, 0, 0, 0); \
        o1 = __builtin_amdgcn_mfma_f32_32x32x16_bf16(ATT_VF(1, 0), pa0, o1, 0, 0, 0); \
        o0 = __builtin_amdgcn_mfma_f32_32x32x16_bf16(ATT_VF(0, 1), pa1, o0, 0, 0, 0); \
        o1 = __builtin_amdgcn_mfma_f32_32x32x16_bf16(ATT_VF(1, 1), pa1, o1, 0, 0, 0); \
        o0 = __builtin_amdgcn_mfma_f32_32x32x16_bf16(ATT_VF(0, 2), pa2, o0, 0, 0, 0); \
        o1 = __builtin_amdgcn_mfma_f32_32x32x16_bf16(ATT_VF(1, 2), pa2, o1, 0, 0, 0); \
        o0 = __builtin_amdgcn_mfma_f32_32x32x16_bf16(ATT_VF(0, 3), pa3, o0, 0, 0, 0); \
        o1 = __builtin_amdgcn_mfma_f32_32x32x16_bf16(ATT_VF(1, 3), pa3, o1, 0, 0, 0); } while (0)
#define ATT_VF(d0, ks) ({ const s16x4 lo_ = vtr(vb_ + (d0) * 4096 + (ks) * 1024), hi_ = vtr(vb_ + (d0) * 4096 + (ks) * 1024 + 512); (bf16x8){lo_[0], lo_[1], lo_[2], lo_[3], hi_[0], hi_[1], hi_[2], hi_[3]}; })
#define ATT_ENDSTEP() do { if (issue) { if (three) ATT_WAITBAR(3); else ATT_WAITBAR(2); } else ATT_WAITBAR(0); \
        ks = (ks == ATT_NKS - 1) ? 0 : ks + 1; vs = (vs + 1) & (ATT_NVS - 1); } while (0)
    if (ntiles > 1) { if (three) ATT_WAITBAR(3); else ATT_WAITBAR(2); } else ATT_WAITBAR(0);
    int ks = 0, vs = 0;
    if (w < 4) {
        for (int t = 0; t < ntiles; ++t) {
            const bool issue = (t + 2 < ntiles);
            if (issue) ATT_DMA(t + 2, (ks >= 1) ? ks - 1 : ATT_NKS - 1, (vs + 2) & (ATT_NVS - 1));
            ATT_QK(ks);
            ATT_SOFT_PV(t == 0, vs);
            ATT_ENDSTEP();
        }
    } else {
        for (int t = 0; t < ntiles; ++t) {
            const bool issue = (t + 2 < ntiles);
            if (issue) ATT_DMA(t + 2, (ks >= 1) ? ks - 1 : ATT_NKS - 1, (vs + 2) & (ATT_NVS - 1));
            if (t > 0) ATT_SOFT_PV(t == 1, (vs + ATT_NVS - 1) & (ATT_NVS - 1));
            ATT_QK(ks);
            ATT_ENDSTEP();
        }
        ATT_SOFT_PV(ntiles == 1, (vs + ATT_NVS - 1) & (ATT_NVS - 1));
    }
#undef ATT_DMA
#undef ATT_QK
#undef ATT_SOFT_PV
#undef ATT_VF
#undef ATT_ENDSTEP
    { auto rr = __builtin_amdgcn_permlane32_swap(__float_as_uint(lsum), __float_as_uint(lsum), false, false); lsum = __uint_as_float(rr[0]) + __uint_as_float(rr[1]); }
    const float rl = 1.0f / lsum;
#pragma unroll
    for (int g = 0; g < 4; ++g) {
        u32x2 a, b2;
        a.x = cvtpk(o0[4 * g] * rl, o0[4 * g + 1] * rl); a.y = cvtpk(o0[4 * g + 2] * rl, o0[4 * g + 3] * rl);
        b2.x = cvtpk(o1[4 * g] * rl, o1[4 * g + 1] * rl); b2.y = cvtpk(o1[4 * g + 2] * rl, o1[4 * g + 3] * rl);
        *(u32x2*)(orow + 8 * g + 4 * hi) = a; *(u32x2*)(orow + 32 + 8 * g + 4 * hi) = b2;
    }
    asm volatile("s_waitcnt lgkmcnt(0)\n\ts_barrier" ::: "memory");
}
__device__ __forceinline__ void phase_attn(const Ctx& F, KP kp, bool last) {
    const Args a = ldargs(kp);
    unsigned char* ws = a.ws;
    const bf16_t* Qm = (const bf16_t*)(ws + WS_QM); const bf16_t* Km = (const bf16_t*)(ws + WS_KM); const bf16_t* Vm = (const bf16_t*)(ws + WS_VM);
    const bf16_t* Qg = (const bf16_t*)(ws + WS_QG); const bf16_t* Kg = (const bf16_t*)(ws + WS_KG); const bf16_t* Vg = (const bf16_t*)(ws + WS_VG);
    bf16_t* O = (bf16_t*)(ws + WS_O);
    const int xcd = F.vcu >> 5, cix = F.vcu & 31, r32 = F.lane & 31, w = F.wave;
    const int nun = last ? 8 : 9;
    for (int i = 0; i < nun; ++i) {
        if (i < 8 && (i & 1) == 0) {
            const int pair = xcd * 16 + (i >> 1) * 4 + (cix >> 3), b = pair >> 3, h = pair & 7, qb = cix & 7;
            const int row = b * SEQ + qb * 256 + w * 32 + r32;
            attn_unit<96>(F.lds, F.tid, Km + (size_t)b * KPB * QW + h * 96, QW, Vm + (size_t)b * KPB * 512 + h * 64, 512, KPB / 64, Qm + (size_t)row * QW + h * 96, O + (size_t)row * D + h * 64);
        } else if (i < 8) {
            const int pair = xcd * 4 + (i >> 1), b = pair >> 1, kvh = pair & 1, hh = kvh * 4 + (w >> 1);
            const int row = b * SEQ + cix * 64 + (w & 1) * 32 + r32;
            attn_unit<64>(F.lds, F.tid, Kg + (size_t)b * KPB * 128 + kvh * 64, 128, Vg + (size_t)b * KPB * 128 + kvh * 64, 128, KPB / 64, Qg + (size_t)row * 512 + hh * 64, O + (size_t)row * D + 512 + hh * 64);
        } else if (F.vcu < 128) {
            const int b = F.vcu >> 3, h = F.vcu & 7, row = TL + b * CTX + w * 32 + r32;
            attn_unit<96>(F.lds, F.tid, Km + (size_t)b * KPB * QW + h * 96, QW, Vm + (size_t)b * KPB * 512 + h * 64, 512, CTX / 64, Qm + (size_t)row * QW + h * 96, O + (size_t)row * D + h * 64);
        } else {
            const int idx = F.vcu - 128, b = idx >> 3, kvh = (idx >> 2) & 1, qb = idx & 3, hh = kvh * 4 + (w >> 1);
            const int row = TL + b * CTX + qb * 64 + (w & 1) * 32 + r32;
            attn_unit<64>(F.lds, F.tid, Kg + (size_t)b * KPB * 128 + kvh * 64, 128, Vg + (size_t)b * KPB * 128 + kvh * 64, 128, CTX / 64, Qg + (size_t)row * 512 + hh * 64, O + (size_t)row * D + 512 + hh * 64);
        }
    }
}
__global__ void __launch_bounds__(NTHREADS, 2) fwd_kernel(Args a_unused) {
    extern __shared__ __attribute__((aligned(16))) unsigned char lds_raw[];
    const KP kp = (KP)__builtin_amdgcn_kernarg_segment_ptr();
    Ctx F;
    F.lds = (LAS unsigned char*)lds_raw;
    F.tid = threadIdx.x; F.lane = F.tid & 63; F.wave = __builtin_amdgcn_readfirstlane(F.tid >> 6);
    F.bk = blockIdx.x; F.vcu = (F.bk & 7) * (GRID / 8) + (F.bk >> 3);
    if (F.tid < 4) ((volatile LAS unsigned*)(F.lds + MISC_BAR))[F.tid] = 0u;
    __syncthreads();
    { const Args a = ldargs(kp); (void)xcd_barrier_post((unsigned*)(a.ws + WS_CTL), (volatile LAS unsigned*)(F.lds + MISC_BAR), F.tid == 0); }
#define FRESH() do { int ln_; asm volatile("v_mbcnt_lo_u32_b32 %0, -1, 0\n\tv_mbcnt_hi_u32_b32 %0, -1, %0" : "=v"(ln_)); F.lane = ln_; F.tid = F.wave * 64 + ln_; F.bk = blockIdx.x; F.vcu = (F.bk & 7) * (GRID / 8) + (F.bk >> 3); } while (0)
#define GRID_BAR() do { XcdBarrier b_; { const Args a_ = ldargs(kp); b_.bar = (unsigned*)(a_.ws + WS_CTL); } b_.x = xb_xcc_id(); b_.st = (volatile LAS unsigned*)(F.lds + MISC_BAR); xcd_barrier(b_, F.tid == 0); } while (0)

    for (int rep_ = 0; rep_ < REP_PRO; ++rep_) prologue1(F, kp);
    GRID_BAR(); FRESH();
    prologue2(F, kp);
    prologue3(F, kp);
    GRID_BAR(); FRESH();

    for (int l = 0; l < NL; ++l) {
        const bool last = (l == NL - 1);
        const int ntok = last ? TL : MT;
        { const Args a = ldargs(kp); unsigned char* ws = a.ws;
          Gemm g{(const bf16_t*)(ws + WS_H), D, (const bf16_t*)(ws + WS_WIN) + (size_t)l * ZW * D, D}; StaticOrder S; S.init(MT, ZW, GRID, F.bk);
#if FUSE_SPLIT
          EpiIn E{ws, a.g_gq + l * 64, a.g_gk + l * 64}; gemm_phase<0>(F, g, S, E); }
#else
          EpiZ E{(bf16_t*)(ws + WS_Z)}; gemm_phase<0>(F, g, S, E); }
#endif
        if (F.bk >= (MT / 256) * (ZW / 256) - 3 * GRID) conv_filler(F, kp, l, FILL_P1);
        GRID_BAR(); FRESH();
#if !FUSE_SPLIT
        for (int rep_ = 0; rep_ < REP_P2; ++rep_) phase_split(F, kp, l);
        GRID_BAR(); FRESH();
#endif
        { const Args a = ldargs(kp); unsigned char* ws = a.ws;
          Gemm g{(const bf16_t*)(ws + WS_Z), ZW, (const bf16_t*)(ws + WS_WQ) + (size_t)l * QW * 384, 384}; StaticOrder S; S.init(MT, QW, GRID, F.bk);
          EpiQ E{ws}; gemm_phase<1>(F, g, S, E); }
        FRESH();
        { const Args a = ldargs(kp); unsigned char* ws = a.ws;
          Gemm g{(const bf16_t*)(ws + WS_Z) + 384, ZW, (const bf16_t*)(ws + WS_WKV) + (size_t)l * KVW * 256, 256}; StaticOrder S; S.init(MT, KVW, GRID, (F.bk + 80) & 255);
          EpiKV E{ws}; gemm_phase<2>(F, g, S, E); }
        GRID_BAR(); FRESH();
#if USE_MFMA_ATTN
        for (int rep_ = 0; rep_ < REP_ATTN; ++rep_) phase_attn(F, kp, last);
#else
        phase_attn_naive(F, kp, last);
#endif
        GRID_BAR(); FRESH();
        { const Args a = ldargs(kp); unsigned char* ws = a.ws;
          Gemm g{(const bf16_t*)(ws + WS_O), D, (const bf16_t*)(ws + WS_WO) + (size_t)l * D * D, D}; StaticOrder S; S.init(ntok, D, GRID, F.bk);
          EpiYo E{(bf16_t*)(ws + WS_U)}; gemm_phase<3>(F, g, S, E); }
        if (!last && F.bk >= (MT / 256) * (D / 256) - 2 * GRID) conv_filler(F, kp, l, FILL_P5);
        GRID_BAR(); FRESH();
        if (l == 0) phase_ln1_route<true>(F, kp, l, ntok); else phase_ln1_route<false>(F, kp, l, ntok);
        GRID_BAR(); FRESH();
        for (int rep_ = 0; rep_ < REP_P7; ++rep_) phase_dispatch(F, kp, l, ntok);
        GRID_BAR(); FRESH();
        { const Args a = ldargs(kp); unsigned char* ws = a.ws;
          Gemm g{(const bf16_t*)(ws + WS_H), D, (const bf16_t*)(ws + WS_WGU) + (size_t)l * NEXP * 1024 * D, D}; GroupedOrder S; S.init((const volatile LAS int*)(F.lds + MISC_POFF), GRID, F.vcu);
          LAS int* gt = (LAS int*)(F.lds + STAGE_BYTES);
          { const int* postok = (const int*)(ws + WS_POSTOK); Unit u; for (int i = 0; i < 16 && S.next(i, u); ++i) if (F.tid < 256) gt[i * 256 + F.tid] = postok[u.pm * 256 + F.tid]; }
          __syncthreads();
          EpiAct E{(bf16_t*)(ws + WS_ACT)}; gemm_phase_gather<4>(F, g, S, E, gt); }
        GRID_BAR(); FRESH();
        { const Args a = ldargs(kp); unsigned char* ws = a.ws;
          Gemm g{(const bf16_t*)(ws + WS_ACT), FF, (const bf16_t*)(ws + WS_WD) + (size_t)l * NEXP * D * FF, FF}; GroupedOrder S; S.init((const volatile LAS int*)(F.lds + MISC_POFF), GRID, F.vcu);
          EpiY E{(bf16_t*)(ws + WS_XS)}; gemm_phase<5>(F, g, S, E); }
        GRID_BAR(); FRESH();
        phase_ln2(F, kp, l, ntok);
        GRID_BAR(); FRESH();
    }
}

extern "C" void kernel_launch(void* const* d_in, const int* in_sizes, int n_in, void* d_out, int out_size, void* d_ws, size_t ws_size, hipStream_t stream) {
    static int grid = 0;
    if (grid == 0) {
        if (n_in != 25 || out_size != TL * D || ws_size < WS_END) { fprintf(stderr, "kernel_launch: unexpected shapes (n_in %d out %d ws %zu need %zu)\n", n_in, out_size, ws_size, (size_t)WS_END); grid = -1; return; }
        int dev = 0, cus = 0, per_cu = 0;
        if (hipGetDevice(&dev) != hipSuccess || hipDeviceGetAttribute(&cus, hipDeviceAttributeMultiprocessorCount, dev) != hipSuccess) { grid = -1; return; }
        if (hipFuncSetAttribute((const void*)fwd_kernel, hipFuncAttributeMaxDynamicSharedMemorySize, LDS_BYTES) != hipSuccess) { fprintf(stderr, "kernel_launch: hipFuncSetAttribute failed\n"); grid = -1; return; }
        if (hipOccupancyMaxActiveBlocksPerMultiprocessor(&per_cu, (const void*)fwd_kernel, NTHREADS, LDS_BYTES) != hipSuccess || per_cu < 1) { fprintf(stderr, "kernel_launch: occupancy query says %d\n", per_cu); }
        (void)hipGetLastError();
        grid = (cus == 256) ? 256 : -1;
        if (grid < 0) { fprintf(stderr, "kernel_launch: need a 256-CU device, got %d\n", cus); return; }
    }
    if (grid < 0) return;
    if (hipMemsetAsync((char*)d_ws + WS_CTL, 0, CTL_BYTES, stream) != hipSuccess) return;
    Args a{};
    a.x = (const float*)d_in[0]; a.c = (const float*)d_in[1]; a.ctx = (const float*)d_in[2]; a.c_ctx = (const float*)d_in[3]; a.w_ada = (const float*)d_in[4]; a.b_ada = (const float*)d_in[5];
    a.w_in = (const float*)d_in[6]; a.g_q_a = (const float*)d_in[7]; a.w_q_b = (const float*)d_in[8]; a.g_kv_a = (const float*)d_in[9]; a.w_kv_b = (const float*)d_in[10];
    a.g_gq = (const float*)d_in[11]; a.g_gk = (const float*)d_in[12]; a.w_o = (const float*)d_in[13]; a.ln1_g = (const float*)d_in[14]; a.ln1_b = (const float*)d_in[15];
    a.w_rg = (const float*)d_in[16]; a.b_rg = (const float*)d_in[17]; a.w_re = (const float*)d_in[18]; a.b_re = (const float*)d_in[19];
    a.w_gate = (const float*)d_in[20]; a.w_up = (const float*)d_in[21]; a.w_down = (const float*)d_in[22]; a.ln2_g = (const float*)d_in[23]; a.ln2_b = (const float*)d_in[24];
    a.out = (float*)d_out; a.ws = (unsigned char*)d_ws;
    hipLaunchKernelGGL(fwd_kernel, dim3(grid), dim3(NTHREADS), LDS_BYTES, stream, a);
}
```

```cpp
#include <hip/hip_runtime.h>
#include <cstdint>
#include <cstdio>

#ifndef REP_ATTN
#define REP_ATTN 1
#endif
#ifndef REP_GEMM
#define REP_GEMM 1
#endif
#ifndef REP_PRO
#define REP_PRO 1
#endif
#ifndef REP_THIN
#define REP_THIN 1
#endif
#ifndef REP_P2
#define REP_P2 1
#endif
#ifndef REP_P7
#define REP_P7 1
#endif
#ifndef REP_P6
#define REP_P6 1
#endif
#ifndef REP_P10
#define REP_P10 0
#endif
#ifndef FILL_P1
#define FILL_P1 3
#endif
#ifndef FILL_P5
#define FILL_P5 3
#endif
#ifndef FUSE_SPLIT
#define FUSE_SPLIT 1
#endif
#ifndef USE_MFMA_GEMM
#define USE_MFMA_GEMM 1
#endif
#ifndef USE_MFMA_ATTN
#define USE_MFMA_ATTN 1
#endif

#define GAS __attribute__((address_space(1)))
#define LAS __attribute__((address_space(3)))
typedef unsigned short bf16_t;
typedef float f32x4 __attribute__((ext_vector_type(4)));
typedef float f32x2 __attribute__((ext_vector_type(2)));
typedef unsigned u32x4 __attribute__((ext_vector_type(4)));
typedef unsigned u32x2 __attribute__((ext_vector_type(2)));
typedef short bf16x8 __attribute__((ext_vector_type(8)));

constexpr int D = 1024, NB = 16, SEQ = 2048, CTX = 256, NL = 4;
constexpr int TL = NB * SEQ, TC = NB * CTX, MT = TL + TC;
constexpr int KPB = CTX + SEQ;
constexpr int ZW = 1536;
constexpr int QW = 768, KVW = 1024;
constexpr int NEXP = 32, FF = 512;
constexpr int XS_ROWS = 81920;
constexpr float ALPHA = 1.6817928305074290f;
constexpr float LOG2E = 1.4426950408889634f;
constexpr float QSCALE_M = 0.10206207261596575f * LOG2E;
constexpr float QSCALE_G = 0.125f * LOG2E;
constexpr float RMS_EPS = 1e-6f, LN_EPS = 1e-5f;
constexpr int NWAVES = 8, NTHREADS = 512, GRID = 256;

constexpr size_t al256(size_t x) { return (x + 255) & ~(size_t)255; }
constexpr size_t WS_CTL = 0, CTL_BYTES = 65536;
constexpr size_t WS_BLKCNT = WS_CTL + CTL_BYTES;
constexpr size_t WS_MOETAB = WS_BLKCNT + (size_t)NL * 256 * 32 * 4;
constexpr size_t WS_MOD = WS_MOETAB + (size_t)NL * 128 * 4;
constexpr size_t WS_MODP = WS_MOD + (size_t)NL * 17 * 6144 * 4;
constexpr size_t WS_TAB64 = WS_MODP + (size_t)4 * NL * 17 * 6144 * 4;
constexpr size_t WS_TAB32 = WS_TAB64 + 64 * 16 * 8;
constexpr size_t WS_RSTDQ = WS_TAB32 + 64 * 8 * 8;
constexpr size_t WS_RSTDKV = WS_RSTDQ + (size_t)MT * 4;
constexpr size_t WS_TOKE = WS_RSTDKV + (size_t)MT * 4;
constexpr size_t WS_TOKR = WS_TOKE + (size_t)MT * 8;
constexpr size_t WS_TOKP = WS_TOKR + (size_t)MT * 8;
constexpr size_t WS_TOKW = WS_TOKP + (size_t)MT * 8;
constexpr size_t WS_WIN = al256(WS_TOKW + (size_t)MT * 8);
constexpr size_t WS_WQ = WS_WIN + (size_t)NL * ZW * D * 2;
constexpr size_t WS_WKV = WS_WQ + (size_t)NL * QW * 384 * 2;
constexpr size_t WS_WO = WS_WKV + (size_t)NL * KVW * 256 * 2;
constexpr size_t WS_WGU = WS_WO + (size_t)NL * D * D * 2;
constexpr size_t WS_WD = WS_WGU + (size_t)NL * NEXP * 1024 * D * 2;
constexpr size_t WS_XC = WS_WD + (size_t)NL * NEXP * D * FF * 2;
constexpr size_t WS_H = WS_XC + (size_t)TC * D * 4;
constexpr size_t WS_B = WS_H + (size_t)MT * D * 2;
constexpr size_t WS_Z = WS_B;
constexpr size_t WS_QM = WS_Z + (size_t)MT * ZW * 2;
constexpr size_t WS_KM = WS_QM + (size_t)MT * QW * 2;
constexpr size_t WS_VM = WS_KM + (size_t)MT * QW * 2;
constexpr size_t WS_QG = WS_VM + (size_t)MT * 512 * 2;
constexpr size_t WS_KG = WS_QG + (size_t)MT * 512 * 2;
constexpr size_t WS_VG = WS_KG + (size_t)MT * 128 * 2;
constexpr size_t WS_O = WS_VG + (size_t)MT * 128 * 2;
constexpr size_t WS_BEND = WS_O + (size_t)MT * D * 2;
constexpr size_t WS_U = WS_B;
constexpr size_t WS_XS = WS_B;
constexpr size_t WS_ACT = WS_XS + (size_t)XS_ROWS * D * 2;
constexpr size_t WS_HLO = WS_BEND;
constexpr size_t WS_WR = WS_HLO + (size_t)MT * D * 2;
constexpr size_t WS_POSTOK = WS_WR + (size_t)NL * 2 * 48 * D * 2;
constexpr size_t WS_SSQP = al256(WS_POSTOK + (size_t)XS_ROWS * 4);
constexpr size_t WS_XB = al256(WS_SSQP + (size_t)MT * 20 * 4);
constexpr size_t WS_END = WS_XB + (size_t)MT * D * 2;
static_assert(WS_U + (size_t)MT * D * 4 <= WS_KM, "U must fit in Z+QM");
static_assert(WS_ACT + (size_t)XS_ROWS * FF * 2 <= WS_BEND, "MoE buffers must fit in region B");
static_assert(WS_END < (size_t)1100 * 1000 * 1000, "workspace map too large");

constexpr int LDS_BYTES = 163840;
constexpr int BIG_BYTES = 147456;
constexpr int MISC_OFF = BIG_BYTES;
constexpr int MISC_BAR = MISC_OFF;
constexpr int MISC_CNT = MISC_OFF + 64;
constexpr int MISC_POFF = MISC_OFF + 256;
constexpr int MISC_TOT = MISC_OFF + 512;
constexpr int MISC_BASE = MISC_OFF + 768;
constexpr int MISC_PA = MISC_OFF + 1024;
constexpr int MISC_PB = MISC_OFF + 1024 + 2048;
constexpr int MISC_LG = MISC_OFF + 8192;

#define LDS_WAIT() asm volatile("s_waitcnt lgkmcnt(0)" ::: "memory")
__device__ __forceinline__ unsigned f2bf(float f) { unsigned u = __builtin_bit_cast(unsigned, f); return (u + 0x7fffu + ((u >> 16) & 1u)) >> 16; }
__device__ __forceinline__ unsigned pk2(float lo, float hi) { typedef __bf16 bf2_t __attribute__((ext_vector_type(2))); f32x2 v = {lo, hi}; bf2_t b = __builtin_convertvector(v, bf2_t); return __builtin_bit_cast(unsigned, b); }
__device__ __forceinline__ float bflo(unsigned w) { return __builtin_bit_cast(float, w << 16); }
__device__ __forceinline__ float bfhi(unsigned w) { return __builtin_bit_cast(float, w & 0xffff0000u); }
template <int K> __device__ __forceinline__ float lane_xor(float v) { return __int_as_float(__builtin_amdgcn_ds_swizzle(__float_as_int(v), (K << 10) | 0x1f)); }
__device__ __forceinline__ float wave_sum(float v) {
    v += lane_xor<1>(v); v += lane_xor<2>(v); v += lane_xor<4>(v); v += lane_xor<8>(v); v += lane_xor<16>(v);
    { auto rr = __builtin_amdgcn_permlane32_swap(__float_as_uint(v), __float_as_uint(v), false, false); v = __uint_as_float(rr[0]) + __uint_as_float(rr[1]); }
    return v;
}
__device__ __forceinline__ int krow_of(int r) { return r < TL ? (r >> 11) * KPB + CTX + (r & 2047) : ((r - TL) >> 8) * KPB + ((r - TL) & 255); }
__device__ __forceinline__ void key_bj(int r, int& b, int& j) { if (r < TL) { b = r >> 11; j = CTX + (r & 2047); } else { b = (r - TL) >> 8; j = (r - TL) & 255; } }
__device__ __forceinline__ size_t ktile_off(int nh, int b, int h, int j, int qd, int chunk) { return ((size_t)(b * nh + h) * KPB + (j & ~63)) * qd + chunk * 512 + (j & 63) * 8; }
__device__ __forceinline__ size_t vtile_off(int nh, int b, int h, int j, int d0) { return ((size_t)(b * nh + h) * KPB + (j & ~63)) * 64 + (d0 >> 5) * 2048 + (j & 63) * 32 + (d0 & 31); }
__device__ __forceinline__ int bb_of(int r) { return r < TL ? (r >> 11) : 16; }

#define XB_TMO      128
#define XB_XCNT(j)  (256  + 64 * (j))
#define XB_XSUB(j)  (1280 + 64 * (j))
#define XB_XGEN(j)  (2304 + 64 * (j))
#define XB_TOP      3328
#define XB_TOPGEN   3392
#define XCD_BAR_WORDS 3456
#define XB_SPIN_CAP (1u << 18)
__device__ __forceinline__ unsigned xb_ld(unsigned* p)              { return __hip_atomic_load(p, __ATOMIC_RELAXED, __HIP_MEMORY_SCOPE_AGENT); }
__device__ __forceinline__ unsigned xb_add(unsigned* p, unsigned v) { return __hip_atomic_fetch_add(p, v, __ATOMIC_RELAXED, __HIP_MEMORY_SCOPE_AGENT); }
__device__ __forceinline__ unsigned xb_xcc_id() { return (unsigned)__builtin_amdgcn_s_getreg((3 << 11) | 20) & 0xFu; }
#define XB_SPIN(cond, bar) do { unsigned _sp = 0; while (cond) { __builtin_amdgcn_s_sleep(1); \
    if ((++_sp & 255u) == 0u) { if (xb_ld(&(bar)[XB_TMO])) break; if (_sp > XB_SPIN_CAP) { atomicAdd(&(bar)[XB_TMO], 1u); break; } } } } while (0)
struct XcdBarrier { unsigned* bar; unsigned x; volatile LAS unsigned* st; };
__device__ __forceinline__ XcdBarrier xcd_barrier_post(unsigned* bar, volatile LAS unsigned* st, const bool leader) {
    XcdBarrier b; b.bar = bar; b.x = xb_xcc_id(); b.st = st;
    if (leader) (void)xb_add(&bar[XB_XCNT(b.x)], 1u);
    return b;
}
__device__ __forceinline__ void xcd_barrier_complete(unsigned* bar, unsigned x, unsigned& nloc, unsigned& nx) {
    const unsigned G = gridDim.x * gridDim.y * gridDim.z;
    unsigned sum, cnt, mine, sp = 0u;
    for (;;) {
        sum = 0u; cnt = 0u; mine = 0u;
#pragma unroll
        for (unsigned j = 0; j < 16; ++j) { const unsigned c = xb_ld(&bar[XB_XCNT(j)]); sum += c; cnt += (c > 0u) ? 1u : 0u; mine = (j == x) ? c : mine; }
        if (sum == G) break;
        __builtin_amdgcn_s_sleep(1);
        if ((++sp & 255u) == 0u) { if (xb_ld(&bar[XB_TMO])) break; if (sp > XB_SPIN_CAP) { atomicAdd(&bar[XB_TMO], 1u); break; } }
    }
    nloc = mine > 0u ? mine : 1u; nx = cnt > 0u ? cnt : 1u;
}
__device__ __forceinline__ void xcd_barrier(const XcdBarrier& b, const bool leader) {
    asm volatile("s_waitcnt vmcnt(0)" ::: "memory");
    __syncthreads();
    if (leader) {
        unsigned* bar = b.bar;
        __builtin_amdgcn_s_waitcnt(0);
        unsigned nloc = b.st[0], nx = b.st[1];
        if (nloc == 0u) { xcd_barrier_complete(bar, b.x, nloc, nx); b.st[0] = nloc; b.st[1] = nx; }
        const unsigned old = xb_add(&bar[XB_XSUB(b.x)], 1u);
        const unsigned gen = old / nloc;
        if (old + 1u == (gen + 1u) * nloc) {
            __builtin_amdgcn_fence(__ATOMIC_RELEASE, "agent");
            asm volatile("s_waitcnt vmcnt(0)" ::: "memory");
            const unsigned og = xb_add(&bar[XB_TOP], 1u);
            const unsigned tg = og / nx;
            if (og + 1u == (tg + 1u) * nx) xb_add(&bar[XB_TOPGEN], 1u);
            else XB_SPIN(xb_ld(&bar[XB_TOPGEN]) == tg, bar);
            __builtin_amdgcn_fence(__ATOMIC_ACQUIRE, "agent");
            xb_add(&bar[XB_XGEN(b.x)], 1u);
            asm volatile("s_waitcnt vmcnt(0)" ::: "memory");
        } else {
            XB_SPIN(xb_ld(&bar[XB_XGEN(b.x)]) == gen, bar);
            __builtin_amdgcn_fence(__ATOMIC_ACQUIRE, "agent");
            asm volatile("s_waitcnt vmcnt(0)" ::: "memory");
        }
    }
    __syncthreads();
}

struct Args {
    const float* x; const float* c; const float* ctx; const float* c_ctx; const float* w_ada; const float* b_ada; const float* w_in;
    const float* g_q_a; const float* w_q_b; const float* g_kv_a; const float* w_kv_b; const float* g_gq; const float* g_gk; const float* w_o;
    const float* ln1_g; const float* ln1_b; const float* w_rg; const float* b_rg; const float* w_re; const float* b_re;
    const float* w_gate; const float* w_up; const float* w_down; const float* ln2_g; const float* ln2_b;
    float* out; unsigned char* ws;
};

typedef const __attribute__((address_space(4))) Args* KP;
__device__ __forceinline__ Args ldargs(KP p) {
#if defined(__HIP_DEVICE_COMPILE__)
    asm volatile("" : "+s"(p)); return *p;
#else
    return Args{};
#endif
}

struct Ctx {
    LAS unsigned char* lds;
    int tid, lane, wave, vcu, bk;
};

struct Unit { int pm, pn; };
constexpr int BM = 256, NXCD = 8, WGM = 8;
struct StaticOrder {
    int nM, nN, nwg, G, c;
    __device__ __forceinline__ void init(int M, int N, int G_, int c_) { nM = M / BM; nN = N / BM; nwg = nM * nN; G = G_; c = c_; }
    __device__ __forceinline__ bool next(int i, Unit& u) const {
        const long L = (long)i * G + c; if (L >= nwg) return false;
        int wgid = (int)L; { const int q = nwg / NXCD, r = nwg % NXCD, xcd = wgid % NXCD, off = wgid / NXCD; wgid = (xcd < r ? xcd * (q + 1) : r * (q + 1) + (xcd - r) * q) + off; }
        const int nig = WGM * nN, gid = wgid / nig, fm = gid * WGM, gsz = (nM - fm) < WGM ? (nM - fm) : WGM;
        u.pm = fm + ((wgid % nig) % gsz); u.pn = (wgid % nig) / gsz; return true;
    }
    __device__ __forceinline__ void a_ready(const Unit&) const {}
    __device__ __forceinline__ void done(const Unit&) const {}
};
struct GroupedOrder {
    const volatile LAS int* poff; int nunits, G, c;
    __device__ __forceinline__ void init(const volatile LAS int* poff_, int G_, int c_) { poff = poff_; nunits = (poff_[32] >> 8) * 4; G = G_; c = c_; }
    __device__ __forceinline__ bool next(int i, Unit& u) const {
        const int L = i * G + c; if (L >= nunits) return false;
        const int rt = L >> 2, r0 = rt << 8; int e = 0;
#pragma unroll
        for (int j = 1; j < 32; ++j) e += (poff[j] <= r0) ? 1 : 0;
        u.pm = rt; u.pn = e * 4 + (L & 3); return true;
    }
    __device__ __forceinline__ void a_ready(const Unit&) const {}
    __device__ __forceinline__ void done(const Unit&) const {}
};

__device__ __forceinline__ void st_bf4(bf16_t* p, f32x4 v) { u32x2 w; w.x = pk2(v[0], v[1]); w.y = pk2(v[2], v[3]); *(u32x2*)p = w; }
__device__ __forceinline__ void st_bf8(bf16_t* p, f32x4 a, f32x4 b) { u32x4 w; w.x = pk2(a[0], a[1]); w.y = pk2(a[2], a[3]); w.z = pk2(b[0], b[1]); w.w = pk2(b[2], b[3]); *(u32x4*)p = w; }
struct EpiZ {
    static constexpr bool PERM = true;
    bf16_t* Z;
    __device__ __forceinline__ void tile32(int row, int col, int fq, f32x4 v0, f32x4 v1) const { st_bf8(Z + (size_t)row * ZW + col + 8 * fq, v0, v1); }
};
__device__ __forceinline__ float xor32(float v, bool lower) { auto rr = __builtin_amdgcn_permlane32_swap(__float_as_uint(v), __float_as_uint(v), false, false); return __uint_as_float(lower ? rr[1] : rr[0]); }
struct EpiIn {
    static constexpr bool PERM = true, PAIR = true;
    unsigned char* wsb; const LAS float* ggq; const LAS float* ggk; const LAS f32x2* t64l; const LAS f32x2* t32l;
    __device__ __forceinline__ float sum4(float s, int fq) const { s += lane_xor<16>(s); s += xor32(s, fq < 2); return s; }
    __device__ __forceinline__ void za(int row, int col, int fq, f32x4 v0, f32x4 v1) const {
        bf16_t* Z = (bf16_t*)(wsb + WS_Z); float* ssqp = (float*)(wsb + WS_SSQP); bf16_t* Km = (bf16_t*)(wsb + WS_KM); const LAS f32x2* t32 = t32l;
        if (col < 640) {
            st_bf8(Z + (size_t)row * ZW + col + 8 * fq, v0, v1);
            float s = (v0[0] * v0[0] + v0[1] * v0[1]) + (v0[2] * v0[2] + v0[3] * v0[3]) + (v1[0] * v1[0] + v1[1] * v1[1]) + (v1[2] * v1[2] + v1[3] * v1[3]);
            s = sum4(s, fq);
            if (fq == 0) ssqp[(size_t)row * 20 + (col >> 5)] = s;
        } else if (col == 640) {
            float v[8] = {v0[0], v0[1], v0[2], v0[3], v1[0], v1[1], v1[2], v1[3]}, o[8];
#pragma unroll
            for (int e = 0; e < 8; ++e) { const float p = lane_xor<16>(v[e]); o[e] = v[e];
                if (row < TL) { const int s2 = row & 2047, pos = (fq >> 1) ? (s2 & 63) : (s2 >> 6); const f32x2 c = t32[pos * 8 + e]; o[e] = (fq & 1) ? (v[e] * c.x + p * c.y) : (v[e] * c.x - p * c.y); } }
            u32x4 w; w.x = pk2(o[0], o[1]); w.y = pk2(o[2], o[3]); w.z = pk2(o[4], o[5]); w.w = pk2(o[6], o[7]);
            int kb, kj; key_bj(row, kb, kj);
#pragma unroll
            for (int h = 0; h < 8; ++h) *(u32x4*)(Km + ktile_off(8, kb, h, kj, 96, 8 + fq)) = w;
        }
    }
    __device__ __forceinline__ void head(int row, int fq, f32x4 a0, f32x4 a1, f32x4 b0, f32x4 b1, const LAS float* g, float scale, bf16_t* dlo, bf16_t* dhi) const {
        const LAS f32x2* t64 = t64l;
        float lo[8] = {a0[0], a0[1], a0[2], a0[3], a1[0], a1[1], a1[2], a1[3]}, hi[8] = {b0[0], b0[1], b0[2], b0[3], b1[0], b1[1], b1[2], b1[3]};
        float ss = 0.f;
#pragma unroll
        for (int e = 0; e < 8; ++e) ss += lo[e] * lo[e] + hi[e] * hi[e];
        ss = sum4(ss, fq);
        const float rn = __builtin_amdgcn_rsqf(ss * (1.0f / 64.0f) + RMS_EPS) * scale;
        const bool lat = row < TL, lower = fq < 2; const int s2 = row & 2047, gr = s2 >> 6, gc = s2 & 63, f0 = 8 * (fq & 1);
        const LAS f32x4* gp = (const LAS f32x4*)(g + 8 * fq); const f32x4 g0 = gp[0], g1 = gp[1], g2 = gp[8], g3 = gp[9];
        const float gl[8] = {g0[0], g0[1], g0[2], g0[3], g1[0], g1[1], g1[2], g1[3]}, gh[8] = {g2[0], g2[1], g2[2], g2[3], g3[0], g3[1], g3[2], g3[3]};
        float ol[8], oh[8];
        if (lat) {
            const LAS f32x4* tl = (const LAS f32x4*)(t64 + gr * 16 + f0); const LAS f32x4* th = (const LAS f32x4*)(t64 + gc * 16 + f0);
            const f32x4 cl0 = tl[0], cl1 = tl[1], cl2 = tl[2], cl3 = tl[3], ch0 = th[0], ch1 = th[1], ch2 = th[2], ch3 = th[3];
            const float cL[8] = {cl0[0], cl0[2], cl1[0], cl1[2], cl2[0], cl2[2], cl3[0], cl3[2]}, sL[8] = {cl0[1], cl0[3], cl1[1], cl1[3], cl2[1], cl2[3], cl3[1], cl3[3]};
            const float cH[8] = {ch0[0], ch0[2], ch1[0], ch1[2], ch2[0], ch2[2], ch3[0], ch3[2]}, sH[8] = {ch0[1], ch0[3], ch1[1], ch1[3], ch2[1], ch2[3], ch3[1], ch3[3]};
#pragma unroll
            for (int e = 0; e < 8; ++e) {
                const float yl = lo[e] * rn * gl[e], yh = hi[e] * rn * gh[e];
                const float pl = xor32(yl, lower), ph = xor32(yh, lower);
                ol[e] = lower ? (yl * cL[e] - pl * sL[e]) : (yl * cL[e] + pl * sL[e]);
                oh[e] = lower ? (yh * cH[e] - ph * sH[e]) : (yh * cH[e] + ph * sH[e]);
            }
        } else {
#pragma unroll
            for (int e = 0; e < 8; ++e) { ol[e] = lo[e] * rn * gl[e]; oh[e] = hi[e] * rn * gh[e]; }
        }
        u32x4 w; w.x = pk2(ol[0], ol[1]); w.y = pk2(ol[2], ol[3]); w.z = pk2(ol[4], ol[5]); w.w = pk2(ol[6], ol[7]); *(u32x4*)dlo = w;
        w.x = pk2(oh[0], oh[1]); w.y = pk2(oh[2], oh[3]); w.z = pk2(oh[4], oh[5]); w.w = pk2(oh[6], oh[7]); *(u32x4*)dhi = w;
    }
    __device__ __forceinline__ void tile64(int row, int pn, int wc, int fq, f32x4 a0, f32x4 a1, f32x4 b0, f32x4 b1) const {
        if (pn < 3) { const int col = pn * 256 + wc * 32; za(row, col, fq, a0, a1); za(row, col + 128, fq, b0, b1); }
        else if (pn < 5) { const int h = 4 * (pn - 3) + wc; bf16_t* q = (bf16_t*)(wsb + WS_QG) + (size_t)row * 512 + 64 * h + 8 * fq; head(row, fq, a0, a1, b0, b1, ggq, QSCALE_G, q, q + 32); }
        else { int kb, kj; key_bj(row, kb, kj);
            if (wc < 2) { bf16_t* Kg = (bf16_t*)(wsb + WS_KG); head(row, fq, a0, a1, b0, b1, ggk, 1.0f, Kg + ktile_off(2, kb, wc, kj, 64, fq), Kg + ktile_off(2, kb, wc, kj, 64, 4 + fq)); }
            else { bf16_t* Vg = (bf16_t*)(wsb + WS_VG); st_bf8(Vg + vtile_off(2, kb, wc - 2, kj, 8 * fq), a0, a1); st_bf8(Vg + vtile_off(2, kb, wc - 2, kj, 32 + 8 * fq), b0, b1); } }
    }
};
struct EpiQ {
    static constexpr bool PERM = true, PREP = true;
    unsigned char* wsb;
    const LAS f32x2* tab32;
    const LAS float* rsl;
    static __device__ __forceinline__ float rowscale(const unsigned char* wsb_, int row) {
        const float* rstd = (const float*)(wsb_ + WS_SSQP);
        const f32x4* sp = (const f32x4*)(rstd + (size_t)row * 20); const f32x4 s0 = sp[0], s1 = sp[1], s2 = sp[2];
        return QSCALE_M / sqrtf(((s0[0] + s0[1]) + (s0[2] + s0[3]) + (s1[0] + s1[1]) + (s1[2] + s1[3]) + (s2[0] + s2[1]) + (s2[2] + s2[3])) * (1.0f / 384.0f) + RMS_EPS);
    }
    __device__ __forceinline__ void tile32u(int row, int col, int fq, f32x4 v0, f32x4 v1, int ui) const {
        const float rs = rsl[ui * 256 + (row & 255)];
        bf16_t* Qm = (bf16_t*)(wsb + WS_QM);
        const int h = col / 96, gi = (col - h * 96) >> 5;
        v0 = v0 * rs; v1 = v1 * rs;
        bf16_t* base = Qm + (size_t)row * QW + h * 96;
        if (gi < 2) { st_bf8(base + gi * 32 + 8 * fq, v0, v1); }
        else {
            const int part = fq >> 1, f0 = (4 * fq) & 7;
            f32x4 o1 = v0, o2 = v1;
            if (row < TL) {
                const int s = row & 2047, pos = part ? (s & 63) : (s >> 6);
#pragma unroll
                for (int j = 0; j < 4; ++j) { const f32x2 cs = tab32[pos * 8 + f0 + j]; o1[j] = v0[j] * cs.x - v1[j] * cs.y; o2[j] = v1[j] * cs.x + v0[j] * cs.y; }
            }
            bf16_t* p = base + 64 + part * 16 + f0; st_bf4(p, o1); st_bf4(p + 8, o2);
        }
    }
};
struct EpiKV {
    static constexpr bool PERM = true, PREP = true;
    unsigned char* wsb;
    const LAS float* rsl;
    static __device__ __forceinline__ float rowscale(const unsigned char* wsb_, int row) {
        const float* rstd = (const float*)(wsb_ + WS_SSQP);
        const f32x4* sp = (const f32x4*)(rstd + (size_t)row * 20 + 12); const f32x4 s0 = sp[0], s1 = sp[1];
        return 1.0f / sqrtf(((s0[0] + s0[1]) + (s0[2] + s0[3]) + (s1[0] + s1[1]) + (s1[2] + s1[3])) * (1.0f / 256.0f) + RMS_EPS);
    }
    __device__ __forceinline__ void tile32u(int row, int col, int fq, f32x4 v0, f32x4 v1, int ui) const {
        const float rs = rsl[ui * 256 + (row & 255)];
        bf16_t* Km = (bf16_t*)(wsb + WS_KM); bf16_t* Vm = (bf16_t*)(wsb + WS_VM);
        const int h = col >> 7, w = (col & 127) + 8 * fq; int kb, kj; key_bj(row, kb, kj);
        bf16_t* p = (w < 64) ? (Km + ktile_off(8, kb, h, kj, 96, w >> 3)) : (Vm + vtile_off(8, kb, h, kj, w - 64));
        st_bf8(p, v0 * rs, v1 * rs);
    }
};
struct EpiU {
    static constexpr bool PERM = false;
    float* U; const float* xl; const float* xc; const float* mod_l;
    int gate;
    __device__ __forceinline__ void tile32(int row, int col, int fq, f32x4 v0, f32x4 v1) const {
        const float* xr = (row < TL) ? (xl + (size_t)row * D) : (xc + (size_t)(row - TL) * D);
        const float* g = mod_l + (size_t)(bb_of(row) * 6 + gate) * D;
        const int c0 = col + 4 * fq;
        const f32x4 x0 = *(const f32x4*)(xr + c0), x1 = *(const f32x4*)(xr + c0 + 16), g0 = *(const f32x4*)(g + c0), g1 = *(const f32x4*)(g + c0 + 16);
        float* u = U + (size_t)row * D + c0;
        *(f32x4*)u = x0 * ALPHA + g0 * v0; *(f32x4*)(u + 16) = x1 * ALPHA + g1 * v1;
    }
};
__device__ __forceinline__ float silu_f(float x) { return x * __builtin_amdgcn_rcpf(1.0f + __builtin_amdgcn_exp2f(-x * LOG2E)); }
struct EpiAct {
    static constexpr bool PERM = true, PAIR = true;
    bf16_t* Act;
    __device__ __forceinline__ void tile64(int row, int pn, int wc, int fq, f32x4 g0, f32x4 g1, f32x4 u0, f32x4 u1) const {
        const int f0 = 128 * (pn & 3) + 32 * wc + 8 * fq; f32x4 a, b;
#pragma unroll
        for (int j = 0; j < 4; ++j) { a[j] = silu_f(g0[j]) * u0[j]; b[j] = silu_f(g1[j]) * u1[j]; }
        st_bf8(Act + (size_t)row * FF + f0, a, b);
    }
};
struct EpiYo {
    static constexpr bool PERM = true;
    bf16_t* Y;
    __device__ __forceinline__ void tile32(int row, int col, int fq, f32x4 v0, f32x4 v1) const { st_bf8(Y + (size_t)row * D + col + 8 * fq, v0, v1); }
};
struct EpiY {
    static constexpr bool PERM = true;
    bf16_t* Y;
    __device__ __forceinline__ void tile32(int row, int col, int fq, f32x4 v0, f32x4 v1) const { st_bf8(Y + (size_t)row * D + (col & 1023) + 8 * fq, v0, v1); }
};

template <class E, class = void> struct epi_pair { static constexpr bool value = false; };
template <class E> struct epi_pair<E, decltype((void)E::PAIR)> { static constexpr bool value = E::PAIR; };
template <class E, class = void> struct epi_prep { static constexpr bool value = false; };
template <class E> struct epi_prep<E, decltype((void)E::PREP)> { static constexpr bool value = E::PREP; };
struct Gemm { const bf16_t* A; int lda; const bf16_t* Bt; int K; };
__device__ __forceinline__ float dot8(u32x4 a, u32x4 b, float acc) {
#pragma unroll
    for (int i = 0; i < 4; ++i) { acc += bflo(a[i]) * bflo(b[i]); acc += bfhi(a[i]) * bfhi(b[i]); }
    return acc;
}
template <class Sched, class Epi>
__device__ __forceinline__ void gemm_naive(const Ctx& F, const Gemm g, const Sched& S, const Epi& E) {
    Unit u;
    for (int i = 0; S.next(i, u); ++i) {
        for (int task = F.tid; task < 8192; task += NTHREADS) {
            const int lane = task & 63, fr = lane & 15, fq = lane >> 4, rest = task >> 6, rg = rest & 15, cg = rest >> 4;
            const int row = u.pm * 256 + rg * 16 + fr, col = u.pn * 256 + cg * 32;
            const bf16_t* ap = g.A + (size_t)row * g.lda;
            const bf16_t* bp0 = g.Bt + (size_t)(col + 4 * fq) * g.K;
            const bf16_t* bp1 = bp0 + (size_t)16 * g.K;
            f32x4 v0 = {0.f, 0.f, 0.f, 0.f}, v1 = {0.f, 0.f, 0.f, 0.f};
            for (int k = 0; k < g.K; k += 8) {
                const u32x4 a = *(const u32x4*)(ap + k);
#pragma unroll
                for (int j = 0; j < 4; ++j) {
                    v0[j] = dot8(a, *(const u32x4*)(bp0 + (size_t)j * g.K + k), v0[j]);
                    v1[j] = dot8(a, *(const u32x4*)(bp1 + (size_t)j * g.K + k), v1[j]);
                }
            }
            E.tile32(row, col, fq, v0, v1);
        }
    }
}
constexpr int BK = 64, HALF = 128, HTB = HALF * BK * 2, STAGE_BYTES = 8 * HTB;
__device__ __forceinline__ int lds_byte(int r, int c) { const int st = (r >> 4) * 2 + (c >> 5), rr = r & 15, cc = c & 31, ob = rr * 64 + cc * 2; return st * 1024 + (ob ^ (((ob >> 9) & 1) << 5)); }
__device__ __forceinline__ int perm32(int rho) { const int n = rho >> 4, i = rho & 15; return 8 * (i >> 2) + 4 * n + (i & 3); }
__device__ __forceinline__ void stage_rc(int b, int& R, int& C) { const int st = b / 1024, sb = b % 1024, swz = sb ^ (((sb >> 9) & 1) << 5); R = (st >> 1) * 16 + swz / 64; C = (st & 1) * 32 + (swz % 64) / 2; }
template <class Epi, class Sched, bool ALIGN_EPI = true, bool SP2 = true, bool GATHER = false>
__device__ __forceinline__ void gemm_mfma(LAS unsigned char* lds, const int tid_in, const Gemm g, const Sched& S, const Epi& E, const LAS int* gtab = nullptr) {
    int tid = tid_in; asm volatile("" : "+v"(tid));
    const int wid = __builtin_amdgcn_readfirstlane(tid >> 6), lane = tid & 63, wr = wid >> 2, wc = wid & 3, fr = lane & 15, fq = lane >> 4;
    const int K = g.K, nt = K / BK;
    unsigned voffB[2]; int RA[2], CA[2];
#pragma unroll
    for (int i = 0; i < 2; ++i) { int R, C; stage_rc(tid * 16 + i * 8192, R, C); const int Rb = Epi::PERM ? ((R & ~31) + perm32(R & 31)) : R;
        RA[i] = R; CA[i] = C; voffB[i] = (unsigned)(Rb * K + C) * 2u; }
    const size_t kstep = (size_t)(BK * 2);
    const size_t hstepA = (size_t)HALF * g.lda * 2, hstepB = (size_t)HALF * K * 2;
    const size_t tstepA = GATHER ? 0 : 2 * hstepA, tstepB = 2 * hstepB;
    unsigned vc0[2], vc1[2], vn0[2], vn1[2];
#define PG8_GOFF(dst0, dst1, ui_) do { _Pragma("unroll") for (int i_ = 0; i_ < 2; ++i_) { \
        if constexpr (GATHER) { dst0[i_] = (unsigned)gtab[(ui_) * 256 + RA[i_]] * (unsigned)(g.lda * 2) + (unsigned)CA[i_] * 2u; dst1[i_] = (unsigned)gtab[(ui_) * 256 + HALF + RA[i_]] * (unsigned)(g.lda * 2) + (unsigned)CA[i_] * 2u; } \
        else { dst0[i_] = (unsigned)(RA[i_] * g.lda + CA[i_]) * 2u; dst1[i_] = dst0[i_] + (unsigned)hstepA; } } } while (0)
    const unsigned ldsw = (unsigned)wid * 1024u;
    const int aoff = lds_byte(wr * 64 + fr, fq * 8), boff = lds_byte(wc * 32 + fr, fq * 8);
#define PG8_SA(b, h) (((b) * 2 + (h)) * HTB)
#define PG8_SB(b, h) ((4 + (b) * 2 + (h)) * HTB)
#define PG8_STAGE(bufoff, gbase, voff) do { _Pragma("unroll") for (int _i = 0; _i < 2; ++_i) \
        __builtin_amdgcn_global_load_lds((const unsigned*)((const char*)(gbase) + (voff)[_i]), (LAS unsigned*)(lds + (bufoff) + ldsw + _i * 8192), 16, 0, 0); } while (0)
#define PG8_LDA(dst, b, h) do { _Pragma("unroll") for (int m = 0; m < 4; ++m) _Pragma("unroll") for (int k = 0; k < 2; ++k) dst[m][k] = *(const LAS bf16x8*)(lds + PG8_SA(b, h) + aoff + m * 2048 + k * 1024); } while (0)
#define PG8_LDB(dst, b, h) do { _Pragma("unroll") for (int n = 0; n < 2; ++n) _Pragma("unroll") for (int k = 0; k < 2; ++k) dst[n][k] = *(const LAS bf16x8*)(lds + PG8_SB(b, h) + boff + n * 2048 + k * 1024); } while (0)
#define PG8_MMA(ai, bj, At, Bt) do { __builtin_amdgcn_s_setprio(1); _Pragma("unroll") for (int m = 0; m < 4; ++m) _Pragma("unroll") for (int n = 0; n < 2; ++n) _Pragma("unroll") for (int k = 0; k < 2; ++k) \
        acc[ai][bj][m][n] = __builtin_amdgcn_mfma_f32_16x16x32_bf16(Bt[n][k], At[m][k], acc[ai][bj][m][n], 0, 0, 0); __builtin_amdgcn_s_setprio(0); } while (0)
#define PG8_WAIT_V(n) asm volatile("s_waitcnt vmcnt(" #n ")" ::: "memory")
#define PG8_WAIT_L(n) asm volatile("s_waitcnt lgkmcnt(" #n ")" ::: "memory")
#define PG8_BAR __builtin_amdgcn_s_barrier()
#define PG8_SCHED __builtin_amdgcn_sched_barrier(0)
    Unit cur, nxt; int ui = 0;
    if (!S.next(0, cur)) return;
    PG8_GOFF(vc0, vc1, 0);
#pragma unroll
    for (int i = 0; i < 2; ++i) { vn0[i] = vc0[i]; vn1[i] = vc1[i]; }
    f32x4 acc[2][2][4][2];
#pragma unroll
    for (int a = 0; a < 2; ++a)
#pragma unroll
        for (int b = 0; b < 2; ++b)
#pragma unroll
            for (int m = 0; m < 4; ++m)
#pragma unroll
                for (int n = 0; n < 2; ++n) acc[a][b][m][n] = (f32x4){0.f, 0.f, 0.f, 0.f};
    bf16x8 At[4][2], B0[2][2], B1[2][2];
    const char* cA = (const char*)g.A + (size_t)cur.pm * tstepA; const char* cB = (const char*)g.Bt + (size_t)cur.pn * tstepB;
    S.a_ready(cur);
    if constexpr (SP2) {
        PG8_STAGE(PG8_SB(0, 0), cB, voffB); PG8_STAGE(PG8_SB(0, 1), cB + hstepB, voffB); PG8_STAGE(PG8_SA(0, 0), cA, vc0); PG8_STAGE(PG8_SA(0, 1), cA, vc1);
        if (wr == 1) PG8_BAR;
        PG8_WAIT_V(2); PG8_BAR;
        PG8_STAGE(PG8_SB(1, 0), cB + kstep, voffB); PG8_STAGE(PG8_SA(1, 0), cA + kstep, vc0); PG8_STAGE(PG8_SB(1, 1), cB + hstepB + kstep, voffB);
        PG8_WAIT_V(6); PG8_BAR;
    } else {
        PG8_STAGE(PG8_SB(0, 0), cB, voffB); PG8_STAGE(PG8_SA(0, 0), cA, vc0); PG8_STAGE(PG8_SB(0, 1), cB + hstepB, voffB); PG8_STAGE(PG8_SA(0, 1), cA, vc1);
        if (wr == 1) PG8_BAR;
        PG8_WAIT_V(4); PG8_BAR;
        PG8_STAGE(PG8_SB(1, 0), cB + kstep, voffB); PG8_STAGE(PG8_SA(1, 0), cA + kstep, vc0); PG8_STAGE(PG8_SB(1, 1), cB + hstepB + kstep, voffB);
        PG8_WAIT_V(6); PG8_BAR;
    }
    for (;;) {
        const bool has_next = S.next(ui + 1, nxt);
        if constexpr (GATHER) { if (has_next) { PG8_GOFF(vn0, vn1, ui + 1); } else {
#pragma unroll
            for (int i = 0; i < 2; ++i) { vn0[i] = vc0[i]; vn1[i] = vc1[i]; } } }
        const char* nA = has_next ? (const char*)g.A + (size_t)nxt.pm * tstepA : cA; const char* nB = has_next ? (const char*)g.Bt + (size_t)nxt.pn * tstepB : cB;
#pragma unroll 1
        for (int t = 0; t < nt; t += 2) {
            const bool last = (t == nt - 2);
            const char* a1 = cA + (size_t)(t + 1) * kstep;
            const char* a2 = last ? nA : cA + (size_t)(t + 2) * kstep; const char* b2 = last ? nB : cB + (size_t)(t + 2) * kstep;
            const char* a3 = a2 + kstep; const char* b3 = b2 + kstep;
            unsigned s0[2], s1[2];
#pragma unroll
            for (int i = 0; i < 2; ++i) { if constexpr (GATHER) { s0[i] = last ? vn0[i] : vc0[i]; s1[i] = last ? vn1[i] : vc1[i]; } else { s0[i] = vc0[i]; s1[i] = vc1[i]; } }
            if (last && has_next) S.a_ready(nxt);
            if constexpr (SP2) {
            PG8_LDB(B0, 0, 0); PG8_LDB(B1, 0, 1); PG8_SCHED; PG8_LDA(At, 0, 0); PG8_STAGE(PG8_SA(1, 1), a1, vc1);
            PG8_WAIT_V(8); PG8_WAIT_L(0); PG8_BAR; PG8_MMA(0, 0, At, B0); PG8_MMA(0, 1, At, B1); PG8_BAR; PG8_SCHED;
            PG8_LDA(At, 0, 1); PG8_STAGE(PG8_SB(0, 0), b2, voffB); PG8_STAGE(PG8_SB(0, 1), b2 + hstepB, voffB); PG8_STAGE(PG8_SA(0, 0), a2, s0);
            PG8_WAIT_V(8); PG8_WAIT_L(0); PG8_BAR; PG8_MMA(1, 0, At, B0); PG8_MMA(1, 1, At, B1); PG8_BAR; PG8_SCHED;
            PG8_LDB(B0, 1, 0); PG8_LDB(B1, 1, 1); PG8_SCHED; PG8_LDA(At, 1, 0); PG8_STAGE(PG8_SA(0, 1), a2, s1);
            PG8_WAIT_V(8); PG8_WAIT_L(0); PG8_BAR; PG8_MMA(0, 0, At, B0); PG8_MMA(0, 1, At, B1); PG8_BAR; PG8_SCHED;
            PG8_LDA(At, 1, 1); PG8_STAGE(PG8_SB(1, 0), b3, voffB); PG8_STAGE(PG8_SB(1, 1), b3 + hstepB, voffB); PG8_STAGE(PG8_SA(1, 0), a3, s0);
            PG8_WAIT_V(8); PG8_WAIT_L(0); PG8_BAR; PG8_MMA(1, 0, At, B0); PG8_MMA(1, 1, At, B1); PG8_BAR; PG8_SCHED;
            } else {
            PG8_LDB(B0, 0, 0); PG8_SCHED; PG8_LDA(At, 0, 0); PG8_STAGE(PG8_SA(1, 1), a1, vc1);
            PG8_WAIT_L(8); PG8_BAR; PG8_WAIT_L(0); PG8_MMA(0, 0, At, B0); PG8_BAR; PG8_SCHED;
            PG8_LDB(B1, 0, 1); PG8_STAGE(PG8_SB(0, 0), b2, voffB);
            PG8_BAR; PG8_WAIT_L(0); PG8_MMA(0, 1, At, B1); PG8_BAR;
            PG8_LDA(At, 0, 1); PG8_STAGE(PG8_SA(0, 0), a2, s0);
            PG8_BAR; PG8_WAIT_L(0); PG8_MMA(1, 0, At, B0); PG8_BAR; PG8_SCHED;
            PG8_STAGE(PG8_SB(0, 1), b2 + hstepB, voffB);
            PG8_WAIT_V(6); PG8_BAR; PG8_MMA(1, 1, At, B1); PG8_BAR;
            PG8_LDB(B0, 1, 0); PG8_SCHED; PG8_LDA(At, 1, 0); PG8_STAGE(PG8_SA(0, 1), a2, s1);
            PG8_WAIT_L(8); PG8_BAR; PG8_WAIT_L(0); PG8_MMA(0, 0, At, B0); PG8_BAR; PG8_SCHED;
            PG8_LDB(B1, 1, 1); PG8_STAGE(PG8_SB(1, 0), b3, voffB);
            PG8_BAR; PG8_WAIT_L(0); PG8_MMA(0, 1, At, B1); PG8_BAR;
            PG8_LDA(At, 1, 1); PG8_STAGE(PG8_SA(1, 0), a3, s0);
            PG8_BAR; PG8_WAIT_L(0); PG8_MMA(1, 0, At, B0); PG8_BAR; PG8_SCHED;
            PG8_STAGE(PG8_SB(1, 1), b3 + hstepB, voffB);
            PG8_WAIT_V(6); PG8_BAR; PG8_MMA(1, 1, At, B1); PG8_BAR;
            }
        }
        if constexpr (ALIGN_EPI) { if (wr == 0) PG8_BAR; }
        {
            int ln_e; asm volatile("v_mbcnt_lo_u32_b32 %0, -1, 0\n\tv_mbcnt_hi_u32_b32 %0, -1, %0" : "=v"(ln_e));
            const int fr_e = ln_e & 15, fq_e = ln_e >> 4;
            int pm_e = __builtin_amdgcn_readfirstlane(cur.pm), pn_e = __builtin_amdgcn_readfirstlane(cur.pn), wr_e = __builtin_amdgcn_readfirstlane(wr), wc_e = __builtin_amdgcn_readfirstlane(wc); asm volatile("" : "+s"(pm_e), "+s"(pn_e), "+s"(wr_e), "+s"(wc_e));
#pragma unroll
            for (int ai = 0; ai < 2; ++ai)
#pragma unroll
                for (int m = 0; m < 4; ++m) {
                    if constexpr (epi_pair<Epi>::value) E.tile64(pm_e * BM + ai * HALF + wr_e * 64 + m * 16 + fr_e, pn_e, wc_e, fq_e, acc[ai][0][m][0], acc[ai][0][m][1], acc[ai][1][m][0], acc[ai][1][m][1]);
                    else {
#pragma unroll
                    for (int bj = 0; bj < 2; ++bj) {
                        if constexpr (epi_prep<Epi>::value) E.tile32u(pm_e * BM + ai * HALF + wr_e * 64 + m * 16 + fr_e, pn_e * BM + bj * HALF + wc_e * 32, fq_e, acc[ai][bj][m][0], acc[ai][bj][m][1], ui);
                        else E.tile32(pm_e * BM + ai * HALF + wr_e * 64 + m * 16 + fr_e, pn_e * BM + bj * HALF + wc_e * 32, fq_e, acc[ai][bj][m][0], acc[ai][bj][m][1]); }
                    }
                    asm volatile("" ::: "memory");
                }
            S.done(cur);
        }
        if (!has_next) break;
#pragma unroll
        for (int a = 0; a < 2; ++a)
#pragma unroll
            for (int b = 0; b < 2; ++b)
#pragma unroll
                for (int m = 0; m < 4; ++m)
#pragma unroll
                    for (int n = 0; n < 2; ++n) acc[a][b][m][n] = (f32x4){0.f, 0.f, 0.f, 0.f};
        cur = nxt; cA = nA; cB = nB; ++ui;
        if constexpr (GATHER) {
#pragma unroll
            for (int i = 0; i < 2; ++i) { vc0[i] = vn0[i]; vc1[i] = vn1[i]; } }
        if constexpr (ALIGN_EPI) { if (wr == 1) PG8_BAR; }
    }
    PG8_WAIT_V(0);
    if constexpr (!ALIGN_EPI) { if (wr == 0) PG8_BAR; }
    PG8_BAR;
#undef PG8_GOFF
#undef PG8_SA
#undef PG8_SB
#undef PG8_STAGE
#undef PG8_LDA
#undef PG8_LDB
#undef PG8_MMA
#undef PG8_WAIT_V
#undef PG8_WAIT_L
#undef PG8_BAR
#undef PG8_SCHED
}

#ifndef REP_GEMM_MASK
#define REP_GEMM_MASK 0
#endif
template <int ID, class Sched, class Epi>
__device__ __forceinline__ void gemm_phase_gather(const Ctx& F, const Gemm g, const Sched& S, const Epi& E, const LAS int* gtab) {
    gemm_mfma<Epi, Sched, true, true, true>(F.lds, F.tid, g, S, E, gtab);
    if constexpr ((REP_GEMM_MASK >> ID) & 1) gemm_mfma<Epi, Sched, true, true, true>(F.lds, F.tid, g, S, E, gtab);
}
template <int ID, class Sched, class Epi>
__device__ __forceinline__ void gemm_phase(const Ctx& F, const Gemm g, const Sched& S, const Epi& E) {
#if USE_MFMA_GEMM
    gemm_mfma<Epi, Sched, true, true>(F.lds, F.tid, g, S, E);
    if constexpr ((REP_GEMM_MASK >> ID) & 1) gemm_mfma<Epi, Sched, true, true>(F.lds, F.tid, g, S, E);
#else
    gemm_naive(F, g, S, E);
#endif
}

template <class ColPtr>
__device__ __forceinline__ void tconv_tile(const ColPtr& cp, int ldw, const float* scale, bf16_t* WT, int K, int k0, int p0, LAS float* scr, int lane) {
    const int pc = (lane & 15) * 4, kq = lane >> 4;
    const float* src = cp(p0 + pc);
#pragma unroll 4
    for (int i = 0; i < 16; ++i) {
        const int kk = 4 * i + kq;
        f32x4 v = {0.f, 0.f, 0.f, 0.f};
        if (src) { v = __builtin_nontemporal_load((const f32x4*)(src + (size_t)(k0 + kk) * ldw)); if (scale) v = v * scale[k0 + kk]; }
        LAS float* d = scr + kk * 65 + pc; d[0] = v[0]; d[1] = v[1]; d[2] = v[2]; d[3] = v[3];
    }
    LDS_WAIT();
    const int c = lane & 7;
#pragma unroll
    for (int j = 0; j < 8; ++j) {
        const int n = (lane >> 3) + 8 * j; const LAS float* s = scr + (8 * c) * 65 + n;
        u32x4 o; o.x = pk2(s[0], s[65]); o.y = pk2(s[2 * 65], s[3 * 65]); o.z = pk2(s[4 * 65], s[5 * 65]); o.w = pk2(s[6 * 65], s[7 * 65]);
        *(u32x4*)(WT + (size_t)(p0 + n) * K + k0 + 8 * c) = o;
    }
    LDS_WAIT();
}
struct CpPlain { const float* W; int ncols; __device__ __forceinline__ const float* operator()(int p) const { return p < ncols ? W + p : nullptr; } };
struct CpIn {
    const float* W;
    __device__ __forceinline__ const float* operator()(int p) const {
        if (p < 672) return W + p;
        if (p < 768) return nullptr;
        const int w = p & 31;
        if (p < 1280) { const int q = p - 768, t = q >> 8, g = (q & 255) >> 5; return W + 672 + 64 * (4 * t + (g & 3)) + 32 * (g >> 2) + w; }
        const int g = (p - 1280) >> 5, half = g >> 2, slot = g & 3;
        return W + ((slot < 2) ? (1184 + 64 * slot) : (1312 + 64 * (slot - 2))) + 32 * half + w;
    }
};
#if FUSE_SPLIT
typedef CpIn CpInSel;
#else
struct CpInSel { const float* W; __device__ __forceinline__ const float* operator()(int p) const { return p < 1440 ? W + p : nullptr; } };
#endif
struct CpQ {
    const float* W;
    __device__ __forceinline__ const float* operator()(int p) const {
        const int h = p / 96, pp = p - h * 96; int lc = pp;
        if (pp >= 64) { const int rp = pp - 64, q = rp >> 3, r = rp & 7, i = 4 * q + (r & 3); lc = 64 + (i >> 3) * 16 + (i & 7) + ((r >> 2) ? 8 : 0); }
        return W + h * 96 + lc;
    }
};
struct CpGU {
    const float* Wg; const float* Wu;
    __device__ __forceinline__ const float* operator()(int p) const { const int g = (p >> 5) & 7, ff = 128 * (p >> 8) + 32 * (g & 3) + (p & 31); return (g < 4) ? (Wg + ff) : (Wu + ff); }
};

constexpr int CONV_ITEMS = NEXP * 256 + NEXP * 128, CONV_CH = 4, CONV_CTR0 = 8192;
struct ConvSrc { const float* p; size_t ld; bf16_t* dst; int K; };
__device__ __forceinline__ ConvSrc conv_decode(const Args& a, int l, int idx, int lane) {
    const int pc = (lane & 15) * 4, kh = lane >> 4; ConvSrc r;
    if (idx < NEXP * 256) { const int e = idx >> 8, q = idx & 255, k0 = (q >> 4) * 64, p = (q & 15) * 64 + pc, g = (p >> 5) & 7, ff = 128 * (p >> 8) + 32 * (g & 3) + (p & 31); const size_t le = (size_t)l * NEXP + e;
        r.p = ((g < 4) ? (a.w_gate + le * D * FF + ff) : (a.w_up + le * D * FF + ff)) + (size_t)(k0 + 16 * kh) * FF; r.ld = FF;
        r.dst = (bf16_t*)(a.ws + WS_WGU) + le * 1024 * D + (size_t)((q & 15) * 64 + pc) * D + k0 + 16 * kh; r.K = D; }
    else { const int i2 = idx - NEXP * 256, e = i2 >> 7, q = i2 & 127, k0 = (q >> 4) * 64, p0 = (q & 15) * 64; const size_t le = (size_t)l * NEXP + e;
        r.p = a.w_down + le * FF * D + (size_t)(k0 + 16 * kh) * D + p0 + pc; r.ld = D;
        r.dst = (bf16_t*)(a.ws + WS_WD) + le * D * FF + (size_t)(p0 + pc) * FF + k0 + 16 * kh; r.K = FF; }
    return r;
}
__device__ __forceinline__ void conv_load(const ConvSrc& c, f32x4 (&v)[16]) {
#pragma unroll
    for (int i = 0; i < 16; ++i) v[i] = __builtin_nontemporal_load((const f32x4*)(c.p + (size_t)i * c.ld));
}
__device__ __forceinline__ void conv_store(const ConvSrc& c, const f32x4 (&v)[16]) {
#pragma unroll
    for (int nn = 0; nn < 4; ++nn) {
        u32x4 o0, o1;
        o0.x = pk2(v[0][nn], v[1][nn]); o0.y = pk2(v[2][nn], v[3][nn]); o0.z = pk2(v[4][nn], v[5][nn]); o0.w = pk2(v[6][nn], v[7][nn]);
        o1.x = pk2(v[8][nn], v[9][nn]); o1.y = pk2(v[10][nn], v[11][nn]); o1.z = pk2(v[12][nn], v[13][nn]); o1.w = pk2(v[14][nn], v[15][nn]);
        *(u32x4*)(c.dst + (size_t)nn * c.K) = o0; *(u32x4*)(c.dst + (size_t)nn * c.K + 8) = o1;
    }
}
__device__ __forceinline__ void conv_experts(const int lane, const int wave, const int vcu, const Args& a, int l) {
    const int base = (vcu * NWAVES + wave) * (CONV_ITEMS / (GRID * NWAVES));
    static_assert(CONV_ITEMS % (GRID * NWAVES) == 0 && CONV_ITEMS / (GRID * NWAVES) == 6, "6 tiles per wave");
    f32x4 va[16], vb[16], vc[16];
    ConvSrc c0 = conv_decode(a, l, base, lane), c1 = conv_decode(a, l, base + 1, lane), c2 = conv_decode(a, l, base + 2, lane);
    ConvSrc c3 = conv_decode(a, l, base + 3, lane), c4 = conv_decode(a, l, base + 4, lane), c5 = conv_decode(a, l, base + 5, lane);
    conv_load(c0, va); conv_load(c1, vb); conv_load(c2, vc);
    conv_store(c0, va); conv_load(c3, va);
    conv_store(c1, vb); conv_load(c4, vb);
    conv_store(c2, vc); conv_load(c5, vc);
    conv_store(c3, va); conv_store(c4, vb); conv_store(c5, vc);
}
__device__ __forceinline__ void prologue1(const Ctx& F, KP kp) {
    const Args a = ldargs(kp);
    unsigned char* ws = a.ws;
    {
        LAS float* sl = (LAS float*)F.lds;
        float* modp = (float*)(ws + WS_MODP);
        for (int it = F.bk; it < NL * 12 * 4; it += GRID) {
            const int kc = it & 3, nc = (it >> 2) % 12, l = it / 48;
            __syncthreads();
            for (int idx = F.tid; idx < 17 * 256; idx += NTHREADS) {
                const int bb = idx >> 8, k = idx & 255; const float v = (bb < 16) ? a.c[bb * D + kc * 256 + k] : a.c_ctx[kc * 256 + k];
                sl[idx] = v / (1.0f + __expf(-v));
            }
            __syncthreads();
            const int n = nc * 512 + F.tid;
            const float* w = a.w_ada + ((size_t)l * D + kc * 256) * 6144 + n;
            float acc[17];
#pragma unroll
            for (int bb = 0; bb < 17; ++bb) acc[bb] = 0.f;
            for (int k = 0; k < 256; ++k) {
                const float wv = __builtin_nontemporal_load(w + (size_t)k * 6144);
#pragma unroll
                for (int bb = 0; bb < 17; ++bb) acc[bb] += sl[bb * 256 + k] * wv;
            }
#pragma unroll
            for (int bb = 0; bb < 17; ++bb) modp[((size_t)(kc * NL + l) * 17 + bb) * 6144 + n] = acc[bb];
        }
        __syncthreads();
    }
    {
        f32x2* t64 = (f32x2*)(ws + WS_TAB64); f32x2* t32 = (f32x2*)(ws + WS_TAB32);
        const int gt = F.bk * NTHREADS + F.tid;
        if (gt < 64 * 16) { const int pos = gt >> 4, f = gt & 15; const float inv = powf(10000.0f, -((float)(2 * f) / 32.0f)); const float ang = (float)pos * inv; t64[gt] = (f32x2){cosf(ang), sinf(ang)}; }
        else if (gt < 64 * 16 + 64 * 8) { const int g2 = gt - 64 * 16, pos = g2 >> 3, f = g2 & 7; const float inv = powf(10000.0f, -((float)(2 * f) / 16.0f)); const float ang = (float)pos * inv; t32[g2] = (f32x2){cosf(ang), sinf(ang)}; }
    }
    {
        bf16_t* wr = (bf16_t*)(ws + WS_WR);
        for (int i = F.bk * NTHREADS + F.tid; i < NL * 48 * D; i += GRID * NTHREADS) {
            const int c = i & 1023, j = (i >> 10) % 48, l = i / (48 * D);
            float wv = 0.f;
            if (j < 4) wv = a.w_rg[((size_t)l * D + c) * 4 + j]; else if (j < 36) wv = a.w_re[((size_t)l * D + c) * 32 + (j - 4)];
            const unsigned h = f2bf(wv); const float rem = wv - __builtin_bit_cast(float, h << 16);
            wr[((size_t)(l * 2 + 0) * 48 + j) * D + c] = (bf16_t)h; wr[((size_t)(l * 2 + 1) * 48 + j) * D + c] = (bf16_t)f2bf(rem);
        }
    }
    {
        LAS float* scr = (LAS float*)(F.lds + F.wave * 18432);
        const int gw = F.vcu * NWAVES + F.wave, NGW = GRID * NWAVES;
        constexpr int I_IN = 16 * 24, I_Q = 6 * 12, I_KV = 4 * 16, I_O = 16 * 16, I_GU = 16 * 16, I_D = 8 * 16;
        constexpr int N_SMALL = NL * (I_IN + I_Q + I_KV + I_O), N_GU = NL * NEXP * I_GU, N_D = NL * NEXP * I_D;
        for (int it = gw; it < N_SMALL; it += NGW) {
            {
                const int l = it / (I_IN + I_Q + I_KV + I_O); int r = it % (I_IN + I_Q + I_KV + I_O);
                if (r < I_IN) { const int kt = r / 24, pt = r % 24; tconv_tile(CpInSel{a.w_in + (size_t)l * D * 1440}, 1440, nullptr, (bf16_t*)(ws + WS_WIN) + (size_t)l * ZW * D, D, kt * 64, pt * 64, scr, F.lane); continue; }
                r -= I_IN;
                if (r < I_Q) { const int kt = r / 12, pt = r % 12; tconv_tile(CpQ{a.w_q_b + (size_t)l * 384 * QW}, QW, a.g_q_a + l * 384, (bf16_t*)(ws + WS_WQ) + (size_t)l * QW * 384, 384, kt * 64, pt * 64, scr, F.lane); continue; }
                r -= I_Q;
                if (r < I_KV) { const int kt = r / 16, pt = r % 16; tconv_tile(CpPlain{a.w_kv_b + (size_t)l * 256 * KVW, KVW}, KVW, a.g_kv_a + l * 256, (bf16_t*)(ws + WS_WKV) + (size_t)l * KVW * 256, 256, kt * 64, pt * 64, scr, F.lane); continue; }
                r -= I_KV;
                { const int kt = r / 16, pt = r % 16; tconv_tile(CpPlain{a.w_o + (size_t)l * D * D, D}, D, nullptr, (bf16_t*)(ws + WS_WO) + (size_t)l * D * D, D, kt * 64, pt * 64, scr, F.lane); }
            }
        }
    }
}

__device__ __forceinline__ void prologue2(const Ctx& F, KP kp) {
    const Args a = ldargs(kp);
    const float* modp = (const float*)(a.ws + WS_MODP); float* mod = (float*)(a.ws + WS_MOD);
    constexpr int NE = NL * 17 * 6144 / 4;
    for (int i = F.bk * NTHREADS + F.tid; i < NE; i += GRID * NTHREADS) {
        const int e = i * 4, l = e / (17 * 6144), n = e % 6144;
        f32x4 s = *(const f32x4*)(a.b_ada + l * 6144 + n);
#pragma unroll
        for (int kc = 0; kc < 4; ++kc) s = s + *(const f32x4*)(modp + (size_t)kc * NL * 17 * 6144 + e);
        *(f32x4*)(mod + e) = s;
    }
}

__device__ __forceinline__ void row_load(const float* p, int lane, f32x4 (&v)[4]) {
#pragma unroll
    for (int j = 0; j < 4; ++j) v[j] = *(const f32x4*)(p + 4 * lane + 256 * j);
}
__device__ __forceinline__ void row_ln(f32x4 (&v)[4], const float* g, const float* b, int lane) {
    float s = 0.f;
#pragma unroll
    for (int j = 0; j < 4; ++j) s += (v[j][0] + v[j][1]) + (v[j][2] + v[j][3]);
    const float mean = wave_sum(s) * (1.0f / D); float q = 0.f;
#pragma unroll
    for (int j = 0; j < 4; ++j) { v[j] = v[j] - mean; q += (v[j][0] * v[j][0] + v[j][1] * v[j][1]) + (v[j][2] * v[j][2] + v[j][3] * v[j][3]); }
    const float rstd = 1.0f / sqrtf(wave_sum(q) * (1.0f / D) + LN_EPS);
#pragma unroll
    for (int j = 0; j < 4; ++j) { const f32x4 gg = *(const f32x4*)(g + 4 * lane + 256 * j), bv = *(const f32x4*)(b + 4 * lane + 256 * j); v[j] = v[j] * rstd * gg + bv; }
}
__device__ __forceinline__ void row_ln_reg(f32x4 (&v)[4], const f32x4 (&g)[4], const f32x4 (&b)[4]) {
    float s = 0.f;
#pragma unroll
    for (int j = 0; j < 4; ++j) s += (v[j][0] + v[j][1]) + (v[j][2] + v[j][3]);
    const float mean = wave_sum(s) * (1.0f / D); float q = 0.f;
#pragma unroll
    for (int j = 0; j < 4; ++j) { v[j] = v[j] - mean; q += (v[j][0] * v[j][0] + v[j][1] * v[j][1]) + (v[j][2] * v[j][2] + v[j][3] * v[j][3]); }
    const float rstd = 1.0f / sqrtf(wave_sum(q) * (1.0f / D) + LN_EPS);
#pragma unroll
    for (int j = 0; j < 4; ++j) v[j] = v[j] * rstd * g[j] + b[j];
}
__device__ __forceinline__ void row_store_mod_bf16(bf16_t* hrow, const f32x4 (&v)[4], const float* sh, const float* sc, int lane) {
#pragma unroll
    for (int j = 0; j < 4; ++j) {
        const f32x4 s1 = *(const f32x4*)(sc + 4 * lane + 256 * j), s0 = *(const f32x4*)(sh + 4 * lane + 256 * j);
        const f32x4 h = v[j] * (s1 + 1.0f) + s0;
        st_bf4(hrow + 4 * lane + 256 * j, h);
    }
}

__device__ __forceinline__ void prologue3(const Ctx& F, KP kp) {
    const Args a = ldargs(kp);
    const float* modp = (const float*)(a.ws + WS_MODP); bf16_t* H = (bf16_t*)(a.ws + WS_H);
    const int gw = F.vcu * NWAVES + F.wave, NGW = GRID * NWAVES;
    for (int r = gw; r < MT; r += NGW) {
        const float* xr = (r < TL) ? (a.x + (size_t)r * D) : (a.ctx + (size_t)(r - TL) * D);
        const int bb = bb_of(r);
        f32x4 v[4]; row_load(xr, F.lane, v);
#pragma unroll
        for (int j = 0; j < 4; ++j) {
            const int c = 4 * F.lane + 256 * j;
            f32x4 sh = *(const f32x4*)(a.b_ada + c), sc = *(const f32x4*)(a.b_ada + 1024 + c);
#pragma unroll
            for (int kc = 0; kc < 4; ++kc) { const float* mp = modp + ((size_t)(kc * NL + 0) * 17 + bb) * 6144; sh = sh + *(const f32x4*)(mp + c); sc = sc + *(const f32x4*)(mp + 1024 + c); }
            st_bf4(H + (size_t)r * D + c, v[j] * (sc + 1.0f) + sh);
        }
    }
}

__device__ __forceinline__ void unpack8(const u32x4 w, float (&v)[8]) { v[0] = bflo(w.x); v[1] = bfhi(w.x); v[2] = bflo(w.y); v[3] = bfhi(w.y); v[4] = bflo(w.z); v[5] = bfhi(w.z); v[6] = bflo(w.w); v[7] = bfhi(w.w); }
__device__ __forceinline__ u32x4 pack8(const float (&v)[8]) { u32x4 w; w.x = pk2(v[0], v[1]); w.y = pk2(v[2], v[3]); w.z = pk2(v[4], v[5]); w.w = pk2(v[6], v[7]); return w; }
__device__ __forceinline__ u32x4 head64_norm_rope(const u32x4 raw, const float (&g)[8], const LAS f32x2* t64, bool lat, int gr, int gc, int w8, float scale) {
    float v[8]; unpack8(raw, v);
    float ss = 0.f;
#pragma unroll
    for (int e = 0; e < 8; ++e) ss += v[e] * v[e];
    ss += lane_xor<1>(ss); ss += lane_xor<2>(ss); ss += lane_xor<4>(ss);
    const float rn = 1.0f / sqrtf(ss * (1.0f / 64.0f) + RMS_EPS);
    float y[8], p[8], o[8];
#pragma unroll
    for (int e = 0; e < 8; ++e) { y[e] = v[e] * rn * g[e]; p[e] = lane_xor<2>(y[e]); o[e] = y[e]; }
    if (lat) {
        const int pos = (w8 >> 2) ? gc : gr; const LAS f32x2* cs = t64 + pos * 16 + 8 * (w8 & 1); const bool x2 = (w8 & 2) != 0;
#pragma unroll
        for (int e = 0; e < 8; ++e) { const f32x2 c = cs[e]; o[e] = x2 ? (y[e] * c.x + p[e] * c.y) : (y[e] * c.x - p[e] * c.y); }
    }
#pragma unroll
    for (int e = 0; e < 8; ++e) o[e] *= scale;
    return pack8(o);
}
__device__ __forceinline__ void phase_split(const Ctx& F, KP kp, int l) {
    const Args a = ldargs(kp);
    unsigned char* ws = a.ws;
    const bf16_t* Z = (const bf16_t*)(ws + WS_Z);
    float* rstdq = (float*)(ws + WS_RSTDQ); float* rstdkv = (float*)(ws + WS_RSTDKV);
    bf16_t* Km = (bf16_t*)(ws + WS_KM); bf16_t* Qg = (bf16_t*)(ws + WS_QG); bf16_t* Kg = (bf16_t*)(ws + WS_KG); bf16_t* Vg = (bf16_t*)(ws + WS_VG);
    LAS f32x2* t64 = (LAS f32x2*)(F.lds + 65536); LAS f32x2* t32 = (LAS f32x2*)(F.lds + 65536 + 8192);
    __syncthreads();
    for (int i = F.tid; i < 64 * 16; i += NTHREADS) t64[i] = ((const f32x2*)(ws + WS_TAB64))[i];
    if (F.tid < 64 * 8) t32[F.tid] = ((const f32x2*)(ws + WS_TAB32))[F.tid];
    __syncthreads();
    const int lane = F.lane, gw = F.vcu * NWAVES + F.wave, NGW = GRID * NWAVES, w8 = lane & 7;
    float ggq[8], ggk[8];
#pragma unroll
    for (int e = 0; e < 8; ++e) { ggq[e] = a.g_gq[l * 64 + 8 * w8 + e]; ggk[e] = a.g_gk[l * 64 + 8 * w8 + e]; }
    const int offA2 = 8 * (64 + (lane & 15)), offB = 672 + 8 * lane;
    const int offC = (lane < 4) ? (640 + 8 * lane) : (lane >= 8 && lane < 24) ? (1184 + 8 * (lane - 8)) : (lane >= 24 && lane < 40) ? (1312 + 8 * (lane - 24)) : 0;
    u32x4 nA1, nA2, nB, nC;
#define P2_LOAD(rr) do { const bf16_t* zr_ = Z + (size_t)(rr) * ZW; nA1 = *(const u32x4*)(zr_ + 8 * lane); nA2 = *(const u32x4*)(zr_ + offA2); nB = *(const u32x4*)(zr_ + offB); nC = *(const u32x4*)(zr_ + offC); } while (0)
    if (gw < MT) P2_LOAD(gw);
    for (int r = gw; r < MT; r += NGW) {
        const u32x4 A1 = nA1, A2 = nA2, B = nB, C = nC;
        if (r + NGW < MT) P2_LOAD(r + NGW);
        const bool lat = r < TL; const int s = r & 2047, gr = s >> 6, gc = s & 63, kr = krow_of(r);
        { float v[8]; unpack8(A1, v); float s1 = 0.f;
#pragma unroll
          for (int e = 0; e < 8; ++e) s1 += v[e] * v[e];
          unpack8(A2, v); float s2 = 0.f;
#pragma unroll
          for (int e = 0; e < 8; ++e) s2 += v[e] * v[e];
          const float sq = wave_sum(lane < 48 ? s1 : 0.f), sk = wave_sum((lane >= 48 ? s1 : 0.f) + (lane < 16 ? s2 : 0.f));
          if (lane == 0) { rstdq[r] = 1.0f / sqrtf(sq * (1.0f / 384.0f) + RMS_EPS); rstdkv[r] = 1.0f / sqrtf(sk * (1.0f / 256.0f) + RMS_EPS); } }
        { const u32x4 o = head64_norm_rope(B, ggq, t64, lat, gr, gc, w8, QSCALE_G); *(u32x4*)(Qg + (size_t)r * 512 + 8 * lane) = o; }
        { const u32x4 o = head64_norm_rope(C, ggk, t64, lat, gr, gc, w8, 1.0f); if (lane >= 8 && lane < 24) *(u32x4*)(Kg + (size_t)kr * 128 + 8 * (lane - 8)) = o; }
        if (lane >= 24 && lane < 40) *(u32x4*)(Vg + (size_t)kr * 128 + 8 * (lane - 24)) = C;
        { float v[8], p[8], o[8]; unpack8(C, v);
#pragma unroll
          for (int e = 0; e < 8; ++e) { p[e] = lane_xor<1>(v[e]); o[e] = v[e]; }
          if (lat) { const int pos = ((lane >> 1) & 1) ? gc : gr; const LAS f32x2* cs = t32 + pos * 8; const bool x2 = (lane & 1) != 0;
#pragma unroll
              for (int e = 0; e < 8; ++e) { const f32x2 c = cs[e]; o[e] = x2 ? (v[e] * c.x + p[e] * c.y) : (v[e] * c.x - p[e] * c.y); } }
          const u32x4 ow = pack8(o);
          if (lane < 4) {
#pragma unroll
              for (int h = 0; h < 8; ++h) *(u32x4*)(Km + (size_t)kr * QW + h * 96 + 64 + 8 * lane) = ow; } }
    }
#undef P2_LOAD
}

typedef float f32x4m __attribute__((ext_vector_type(4)));
template <bool XF32>
__device__ __forceinline__ void phase_ln1_route(const Ctx& F, KP kp, int l, int ntok) {
    const Args a = ldargs(kp);
    unsigned char* ws = a.ws;
    const bf16_t* Yo = (const bf16_t*)(ws + WS_U); float* XC = (float*)(ws + WS_XC); bf16_t* H = (bf16_t*)(ws + WS_H);
    bf16_t* XB = (bf16_t*)(ws + WS_XB); constexpr bool xf32 = XF32;
    const float* mod = (const float*)(ws + WS_MOD) + (size_t)l * 17 * 6144;
    int* toke = (int*)(ws + WS_TOKE); int* tokr = (int*)(ws + WS_TOKR); float* tokw = (float*)(ws + WS_TOKW);
    volatile LAS int* cntl = (volatile LAS int*)(F.lds + MISC_CNT);
    const int lane = F.lane;
    __syncthreads();
    if (F.tid < 32) cntl[F.tid] = 0;
    if (F.tid < 36) ((LAS float*)(F.lds + MISC_LG + 2048))[F.tid] = (F.tid < 4) ? a.b_rg[l * 4 + F.tid] : a.b_re[l * 32 + F.tid - 4];
    const int tpb = ntok / GRID;
    {
        f32x4 nx[4]; u32x2 ny[4]; int i = F.wave;
        f32x4 LG[4], LB[4], GA[4], SH[4], SC[4]; int bbc = -1;
#pragma unroll
        for (int j = 0; j < 4; ++j) { LG[j] = *(const f32x4*)(a.ln1_g + l * D + 4 * lane + 256 * j); LB[j] = *(const f32x4*)(a.ln1_b + l * D + 4 * lane + 256 * j); }
        u32x2 nb[4];
#define P6_LOAD(tt) do { const int t_ = (tt); \
        if (xf32) { const float* xp_ = (t_ < TL) ? (a.x + (size_t)t_ * D) : (a.ctx + (size_t)(t_ - TL) * D); row_load(xp_, lane, nx); } \
        else { _Pragma("unroll") for (int j = 0; j < 4; ++j) nb[j] = __builtin_nontemporal_load((const u32x2*)(XB + (size_t)t_ * D + 4 * lane + 256 * j)); } \
        _Pragma("unroll") for (int j = 0; j < 4; ++j) ny[j] = __builtin_nontemporal_load((const u32x2*)(Yo + (size_t)t_ * D + 4 * lane + 256 * j)); } while (0)
        if (i < tpb) P6_LOAD(F.bk * tpb + i);
        for (; i < tpb; i += NWAVES) {
            const int t = F.bk * tpb + i, bb = bb_of(t);
            if (bb != bbc) {
                bbc = bb;
#pragma unroll
                for (int j = 0; j < 4; ++j) { const int c = 4 * lane + 256 * j; GA[j] = *(const f32x4*)(mod + (size_t)(bb * 6 + 2) * D + c);
                    SH[j] = *(const f32x4*)(mod + (size_t)(bb * 6 + 3) * D + c); SC[j] = *(const f32x4*)(mod + (size_t)(bb * 6 + 4) * D + c); }
            }
            f32x4 v[4];
#pragma unroll
            for (int j = 0; j < 4; ++j) { const f32x4 y = {bflo(ny[j].x), bfhi(ny[j].x), bflo(ny[j].y), bfhi(ny[j].y)};
                const f32x4 xv = xf32 ? nx[j] : (f32x4){bflo(nb[j].x), bfhi(nb[j].x), bflo(nb[j].y), bfhi(nb[j].y)}; v[j] = xv * ALPHA + GA[j] * y; }
            if (i + NWAVES < tpb) P6_LOAD(t + NWAVES);
            row_ln_reg(v, LG, LB);
#pragma unroll
            for (int j = 0; j < 4; ++j) st_bf4(XB + (size_t)t * D + 4 * lane + 256 * j, v[j]);
#pragma unroll
            for (int j = 0; j < 4; ++j) {
                const f32x4 h = v[j] * (SC[j] + 1.0f) + SH[j];
                st_bf4(H + (size_t)t * D + 4 * lane + 256 * j, h);
            }
        }
    }
#undef P6_LOAD
    asm volatile("s_waitcnt vmcnt(0)" ::: "memory");
    __syncthreads();
    {
        const bf16_t* wrh = (const bf16_t*)(ws + WS_WR) + (size_t)(l * 2) * 48 * D; const bf16_t* wrl = wrh + (size_t)48 * D;
        const LAS float* bias = (const LAS float*)(F.lds + MISC_LG + 2048);
        const int fr = lane & 15, fq = lane >> 4, w = F.wave;
        bf16x8 WH[4][3], WL[4][3];
#pragma unroll
        for (int ks = 0; ks < 4; ++ks)
#pragma unroll
            for (int tl = 0; tl < 3; ++tl) { const size_t o = (size_t)(16 * tl + fr) * D + 128 * w + 32 * ks + 8 * fq; WH[ks][tl] = *(const bf16x8*)(wrh + o); WL[ks][tl] = *(const bf16x8*)(wrl + o); }
        LAS float* part = (LAS float*)F.lds;
        LAS float* lgf = (LAS float*)(F.lds + 122880);
        const int ngrp = tpb / 16;
        bf16x8 hb[5][4];
#define RT_LOAD(g0_) do { const int ng_ = (ngrp - (g0_) < 5) ? (ngrp - (g0_)) : 5; \
            _Pragma("unroll") for (int gl = 0; gl < 5; ++gl) if (gl < ng_) { \
                const bf16_t* hh = H + (size_t)(F.bk * tpb + ((g0_) + gl) * 16 + fr) * D + 128 * w + 8 * fq; \
                _Pragma("unroll") for (int ks = 0; ks < 4; ++ks) hb[gl][ks] = *(const bf16x8*)(hh + 32 * ks); } } while (0)
        RT_LOAD(0);
        for (int g0 = 0; g0 < ngrp; g0 += 5) {
            const int ng = (ngrp - g0 < 5) ? (ngrp - g0) : 5;
#pragma unroll
            for (int gl = 0; gl < 5; ++gl) if (gl < ng) {
                f32x4m acc0 = {0.f, 0.f, 0.f, 0.f}, acc1 = acc0, acc2 = acc0;
#pragma unroll
                for (int ks = 0; ks < 4; ++ks) {
                    acc0 = __builtin_amdgcn_mfma_f32_16x16x32_bf16(WH[ks][0], hb[gl][ks], acc0, 0, 0, 0); acc1 = __builtin_amdgcn_mfma_f32_16x16x32_bf16(WH[ks][1], hb[gl][ks], acc1, 0, 0, 0); acc2 = __builtin_amdgcn_mfma_f32_16x16x32_bf16(WH[ks][2], hb[gl][ks], acc2, 0, 0, 0);
                    acc0 = __builtin_amdgcn_mfma_f32_16x16x32_bf16(WL[ks][0], hb[gl][ks], acc0, 0, 0, 0); acc1 = __builtin_amdgcn_mfma_f32_16x16x32_bf16(WL[ks][1], hb[gl][ks], acc1, 0, 0, 0); acc2 = __builtin_amdgcn_mfma_f32_16x16x32_bf16(WL[ks][2], hb[gl][ks], acc2, 0, 0, 0);
                }
                LAS float* pp = part + ((size_t)(w * 5 + gl) * 16 + fr) * 48 + 4 * fq;
                *(LAS f32x4m*)(pp) = acc0; *(LAS f32x4m*)(pp + 16) = acc1; *(LAS f32x4m*)(pp + 32) = acc2;
            }
            if (g0 + 5 < ngrp) RT_LOAD(g0 + 5);
            asm volatile("s_waitcnt lgkmcnt(0)\n\ts_barrier" ::: "memory");
            for (int o = F.tid; o < ng * 576; o += NTHREADS) {
                const int gl = o / 576, rem = o - gl * 576, tk = rem / 36, j = rem - tk * 36; float s = 0.f;
#pragma unroll
                for (int ww = 0; ww < 8; ++ww) s += part[(ww * 5 + gl) * 768 + tk * 48 + j];
                lgf[(g0 * 16 + gl * 16 + tk) * 36 + j] = s;
            }
            asm volatile("s_waitcnt lgkmcnt(0)\n\ts_barrier" ::: "memory");
        }
#undef RT_LOAD
        if (F.tid < tpb) {
            const int t = F.bk * tpb + F.tid; const LAS float* q = lgf + F.tid * 36;
            float l4[4];
#pragma unroll
            for (int o = 0; o < 4; ++o) l4[o] = q[o] + bias[o];
            int gs = 0; float gm = l4[0];
#pragma unroll
            for (int o = 1; o < 4; ++o) if (l4[o] > gm) { gm = l4[o]; gs = o; }
            float den = 0.f;
#pragma unroll
            for (int o = 0; o < 4; ++o) den += expf(l4[o] - gm);
            const float pstar = 1.0f / den;
            float le[8];
#pragma unroll
            for (int o = 0; o < 8; ++o) le[o] = q[4 + gs * 8 + o] + bias[4 + gs * 8 + o];
            int i1 = 0; float v1 = le[0];
#pragma unroll
            for (int o = 1; o < 8; ++o) if (le[o] > v1) { v1 = le[o]; i1 = o; }
            int i2 = -1; float v2 = -3.0e38f;
#pragma unroll
            for (int o = 0; o < 8; ++o) if (o != i1 && le[o] > v2) { v2 = le[o]; i2 = o; }
            const float ex = expf(v2 - v1), w1 = pstar / (1.0f + ex), w2 = pstar * ex / (1.0f + ex);
            const int e1 = gs * 8 + i1, e2 = gs * 8 + i2;
            const int r1 = __hip_atomic_fetch_add((LAS int*)(F.lds + MISC_CNT) + e1, 1, __ATOMIC_RELAXED, __HIP_MEMORY_SCOPE_WORKGROUP);
            const int r2 = __hip_atomic_fetch_add((LAS int*)(F.lds + MISC_CNT) + e2, 1, __ATOMIC_RELAXED, __HIP_MEMORY_SCOPE_WORKGROUP);
            toke[2 * t] = e1; toke[2 * t + 1] = e2; tokr[2 * t] = r1; tokr[2 * t + 1] = r2; tokw[2 * t] = w1; tokw[2 * t + 1] = w2;
        }
    }
    __syncthreads();
    if (F.tid < 32) ((int*)(ws + WS_BLKCNT))[((size_t)l * 256 + F.bk) * 32 + F.tid] = cntl[F.tid];
}

__device__ __forceinline__ void moe_tables(const Ctx& F, KP kp, int l, bool publish) {
    const Args a = ldargs(kp);
    const int* blkcnt = (const int*)(a.ws + WS_BLKCNT) + (size_t)l * 256 * 32;
    volatile LAS int* pa = (volatile LAS int*)(F.lds + MISC_PA); volatile LAS int* pb = (volatile LAS int*)(F.lds + MISC_PB);
    volatile LAS int* tot = (volatile LAS int*)(F.lds + MISC_TOT); volatile LAS int* base = (volatile LAS int*)(F.lds + MISC_BASE); volatile LAS int* poff = (volatile LAS int*)(F.lds + MISC_POFF);
    __syncthreads();
    {
        const int e = F.tid & 31, part = F.tid >> 5; int sa = 0, sb = 0;
        for (int j = 0; j < 16; ++j) { const int b2 = part * 16 + j; const int c = blkcnt[b2 * 32 + e]; sa += c; sb += (b2 < F.bk) ? c : 0; }
        pa[part * 32 + e] = sa; pb[part * 32 + e] = sb;
    }
    __syncthreads();
    if (F.tid < 32) { int sa = 0, sb = 0; for (int p = 0; p < 16; ++p) { sa += pa[p * 32 + F.tid]; sb += pb[p * 32 + F.tid]; } tot[F.tid] = sa; base[F.tid] = sb; }
    __syncthreads();
    if (F.tid == 0) { int o = 0; for (int e = 0; e < 32; ++e) { poff[e] = o; o += (tot[e] + 255) & ~255; } poff[32] = o; }
    __syncthreads();
    if (publish && F.bk == 0 && F.tid < 33) ((int*)(a.ws + WS_MOETAB))[l * 128 + F.tid] = poff[F.tid];
}

__device__ __forceinline__ void phase_dispatch(const Ctx& F, KP kp, int l, int ntok) {
    const Args a = ldargs(kp);
    unsigned char* ws = a.ws;
    moe_tables(F, kp, l, true);
    volatile LAS int* base = (volatile LAS int*)(F.lds + MISC_BASE); volatile LAS int* poff = (volatile LAS int*)(F.lds + MISC_POFF); volatile LAS int* tot = (volatile LAS int*)(F.lds + MISC_TOT);
    const int* toke = (const int*)(ws + WS_TOKE); const int* tokr = (const int*)(ws + WS_TOKR); int* tokp = (int*)(ws + WS_TOKP); int* postok = (int*)(ws + WS_POSTOK);
    const int tpb = ntok / GRID;
    if (F.tid < tpb) {
        const int t = F.bk * tpb + F.tid;
        const int2 e = *(const int2*)(toke + 2 * t), r = *(const int2*)(tokr + 2 * t);
        const int p1 = poff[e.x] + base[e.x] + r.x, p2 = poff[e.y] + base[e.y] + r.y;
        *(int2*)(tokp + 2 * t) = (int2){p1, p2};
        postok[p1] = t; postok[p2] = t;
    }
    { const int idx = F.bk * NTHREADS + F.tid;
      if (idx < poff[32]) { int e = 0;
#pragma unroll
          for (int j = 1; j < 32; ++j) e += (poff[j] <= idx) ? 1 : 0;
          if (idx >= poff[e] + tot[e]) postok[idx] = 0; } }
}

__device__ __forceinline__ void phase_ln2(const Ctx& F, KP kp, int l, int ntok, bool dry = false) {
    const Args a = ldargs(kp);
    unsigned char* ws = a.ws;
    const bf16_t* Ys = (const bf16_t*)(ws + WS_XS); float* XC = (float*)(ws + WS_XC); bf16_t* H = (bf16_t*)(ws + WS_H);
    const float* mod = (const float*)(ws + WS_MOD) + (size_t)l * 17 * 6144;
    const float* modn = (const float*)(ws + WS_MOD) + (size_t)(l + 1 < NL ? l + 1 : l) * 17 * 6144;
    const int* tokp = (const int*)(ws + WS_TOKP); const float* tokw = (const float*)(ws + WS_TOKW);
    const int gw = F.vcu * NWAVES + F.wave, NGW = GRID * NWAVES, lane = F.lane;
    const int per = ntok / NGW, t0 = gw * per, t1 = t0 + per;
    f32x4 LG[4], LB[4], GF[4], SH[4], SC[4];
#pragma unroll
    for (int j = 0; j < 4; ++j) { LG[j] = *(const f32x4*)(a.ln2_g + l * D + 4 * lane + 256 * j); LB[j] = *(const f32x4*)(a.ln2_b + l * D + 4 * lane + 256 * j); }
    int bbc = -1;
    int2 pn = {0, 0}; float2 wn = {0.f, 0.f};
    u32x2 xn[4], yan[4], ybn[4]; bf16_t* XB = (bf16_t*)(ws + WS_XB);
#define P10_REC(tt) do { pn = *(const int2*)(tokp + 2 * (tt)); wn = *(const float2*)(tokw + 2 * (tt)); } while (0)
#define P10_ROWS(tt, p_) do { const int t_ = (tt); _Pragma("unroll") for (int j = 0; j < 4; ++j) xn[j] = __builtin_nontemporal_load((const u32x2*)(XB + (size_t)t_ * D + 4 * lane + 256 * j)); \
        _Pragma("unroll") for (int j = 0; j < 4; ++j) { yan[j] = __builtin_nontemporal_load((const u32x2*)(Ys + (size_t)(p_).x * D + 4 * lane + 256 * j)); ybn[j] = __builtin_nontemporal_load((const u32x2*)(Ys + (size_t)(p_).y * D + 4 * lane + 256 * j)); } } while (0)
    float2 wc = {0.f, 0.f};
    P10_REC(t0); wc = wn; P10_ROWS(t0, pn); if (t0 + 1 < t1) P10_REC(t0 + 1);
    for (int t = t0; t < t1; ++t) {
        const int bb = bb_of(t);
        if (bb != bbc) {
            bbc = bb;
#pragma unroll
            for (int j = 0; j < 4; ++j) { const int c = 4 * lane + 256 * j; GF[j] = *(const f32x4*)(mod + (size_t)(bb * 6 + 5) * D + c);
                SH[j] = *(const f32x4*)(modn + (size_t)(bb * 6 + 0) * D + c); SC[j] = *(const f32x4*)(modn + (size_t)(bb * 6 + 1) * D + c); }
        }
        f32x4 v[4]; u32x2 ya[4], yb[4];
#pragma unroll
        for (int j = 0; j < 4; ++j) { v[j] = (f32x4){bflo(xn[j].x), bfhi(xn[j].x), bflo(xn[j].y), bfhi(xn[j].y)}; ya[j] = yan[j]; yb[j] = ybn[j]; }
        const float w1 = wc.x, w2 = wc.y;
        if (t + 1 < t1) { wc = wn; P10_ROWS(t + 1, pn); if (t + 2 < t1) P10_REC(t + 2); }
#pragma unroll
        for (int j = 0; j < 4; ++j) {
            const f32x4 y = (f32x4){bflo(ya[j].x), bfhi(ya[j].x), bflo(ya[j].y), bfhi(ya[j].y)} * w1 + (f32x4){bflo(yb[j].x), bfhi(yb[j].x), bflo(yb[j].y), bfhi(yb[j].y)} * w2;
            v[j] = v[j] * ALPHA + GF[j] * y;
        }
        row_ln_reg(v, LG, LB);
        if (l + 1 < NL) {
#pragma unroll
            for (int j = 0; j < 4; ++j) st_bf4(XB + (size_t)t * D + 4 * lane + 256 * j, v[j]);
        } else {
#pragma unroll
            for (int j = 0; j < 4; ++j) *(f32x4*)(a.out + (size_t)t * D + 4 * lane + 256 * j) = v[j];
        }
        if (l + 1 < NL) { bf16_t* hrow = H + (size_t)t * D;
#pragma unroll
            for (int j = 0; j < 4; ++j) st_bf4(hrow + 4 * lane + 256 * j, v[j] * (SC[j] + 1.0f) + SH[j]); }
    }
#undef P10_REC
#undef P10_ROWS
}

template <int QD>
__device__ __forceinline__ void attn_naive_task(const bf16_t* qp, const bf16_t* kp, int kstride, const bf16_t* vp, int vstride, int nkeys, bf16_t* op) {
    u32x4 qv[QD / 8];
#pragma unroll
    for (int i = 0; i < QD / 8; ++i) qv[i] = *(const u32x4*)(qp + 8 * i);
#pragma unroll 1
    for (int half = 0; half < 2; ++half) {
        float o[32];
#pragma unroll
        for (int i = 0; i < 32; ++i) o[i] = 0.f;
        float m = -1.0e30f, lsum = 0.f;
#pragma unroll 1
        for (int j = 0; j < nkeys; ++j) {
            const u32x4* kr = (const u32x4*)(kp + (size_t)j * kstride);
            float s = 0.f;
#pragma unroll
            for (int i = 0; i < QD / 8; ++i) s = dot8(qv[i], kr[i], s);
            if (s > m) { const float al = __builtin_amdgcn_exp2f(m - s); lsum *= al;
#pragma unroll
                for (int i = 0; i < 32; ++i) o[i] *= al;
                m = s; }
            const float p = __builtin_amdgcn_exp2f(s - m); lsum += p;
            const u32x4* vr = (const u32x4*)(vp + (size_t)j * vstride + 32 * half);
#pragma unroll
            for (int i = 0; i < 4; ++i) { const u32x4 w = vr[i];
                o[8 * i + 0] += p * bflo(w.x); o[8 * i + 1] += p * bfhi(w.x); o[8 * i + 2] += p * bflo(w.y); o[8 * i + 3] += p * bfhi(w.y); o[8 * i + 4] += p * bflo(w.z); o[8 * i + 5] += p * bfhi(w.z); o[8 * i + 6] += p * bflo(w.w); o[8 * i + 7] += p * bfhi(w.w); }
        }
        const float rl = 1.0f / lsum;
#pragma unroll
        for (int i = 0; i < 4; ++i) { u32x4 w; w.x = pk2(o[8 * i] * rl, o[8 * i + 1] * rl); w.y = pk2(o[8 * i + 2] * rl, o[8 * i + 3] * rl); w.z = pk2(o[8 * i + 4] * rl, o[8 * i + 5] * rl); w.w = pk2(o[8 * i + 6] * rl, o[8 * i + 7] * rl); *(u32x4*)(op + 32 * half + 8 * i) = w; }
    }
}
__device__ __forceinline__ void phase_attn_naive(const Ctx& F, KP kp, bool last) {
    const Args a = ldargs(kp);
    unsigned char* ws = a.ws;
    const bf16_t* Qm = (const bf16_t*)(ws + WS_QM); const bf16_t* Km = (const bf16_t*)(ws + WS_KM); const bf16_t* Vm = (const bf16_t*)(ws + WS_VM);
    const bf16_t* Qg = (const bf16_t*)(ws + WS_QG); const bf16_t* Kg = (const bf16_t*)(ws + WS_KG); const bf16_t* Vg = (const bf16_t*)(ws + WS_VG);
    bf16_t* O = (bf16_t*)(ws + WS_O);
    const int gw = F.vcu * NWAVES + F.wave, NGW = GRID * NWAVES;
    const int ntask = 8192 + (last ? 0 : 1024);
    for (int T = gw; T < ntask; T += NGW) {
        int b, h16, r, nkeys;
        if (T < 8192) { const int qw = T & 31; h16 = (T >> 5) & 15; b = T >> 9; r = b * SEQ + 64 * qw + F.lane; nkeys = KPB; }
        else { const int T2 = T - 8192, qw = T2 & 3; h16 = (T2 >> 2) & 15; b = T2 >> 6; r = TL + b * CTX + 64 * qw + F.lane; nkeys = CTX; }
        bf16_t* op = O + (size_t)r * D + h16 * 64;
        if (h16 < 8) attn_naive_task<96>(Qm + (size_t)r * QW + h16 * 96, Km + (size_t)b * KPB * QW + h16 * 96, QW, Vm + (size_t)b * KPB * 512 + h16 * 64, 512, nkeys, op);
        else { const int hh = h16 - 8, kvh = hh >> 2; attn_naive_task<64>(Qg + (size_t)r * 512 + hh * 64, Kg + (size_t)b * KPB * 128 + kvh * 64, 128, Vg + (size_t)b * KPB * 128 + kvh * 64, 128, nkeys, op); }
    }
}

typedef float f32x16 __attribute__((ext_vector_type(16)));
typedef short s16x4 __attribute__((ext_vector_type(4)));
__device__ __forceinline__ s16x4 vtr(const LAS unsigned char* p) { return __builtin_bit_cast(s16x4, __builtin_amdgcn_ds_read_tr16_b64_v4i16((LAS s16x4*)p)); }
__device__ __forceinline__ unsigned cvtpk(float lo, float hi) { typedef __bf16 bf2 __attribute__((ext_vector_type(2))); f32x2 v = {lo, hi}; bf2 b = __builtin_convertvector(v, bf2); return __builtin_bit_cast(unsigned, b); }
constexpr float ATT_THR = 6.0f;
constexpr int ATT_KSLOT = 12288, ATT_VSLOT = 8192, ATT_NKS = 3, ATT_NVS = 4, ATT_V0 = ATT_NKS * ATT_KSLOT;
__device__ __forceinline__ void att_glds16(const void* gsrc, unsigned lds_dst) { unsigned keep;
    asm volatile("s_mov_b32 %0, m0\n\ts_mov_b32 m0, %2\n\ts_nop 0\n\tglobal_load_lds_dwordx4 %1, off\n\ts_mov_b32 m0, %0" : "=&s"(keep) : "v"(gsrc), "s"(lds_dst) : "memory"); }
#define ATT_WAITBAR(N) asm volatile("s_waitcnt vmcnt(" #N ") lgkmcnt(0)\n\ts_barrier" ::: "memory")
template <int QD>
__device__ __forceinline__ void attn_unit(LAS unsigned char* lds, int tid, const bf16_t* Kb, int kstride, const bf16_t* Vb, int vstride, int ntiles, const bf16_t* qrow, bf16_t* orow) {
    constexpr int NC = QD / 8, NS = QD / 16;
    const int lane = tid & 63, r32 = lane & 31, hi = lane >> 5;
    const int w = __builtin_amdgcn_readfirstlane(tid >> 6);
    const bool three = (NC == 12) && (w < 4);
    const int vp = (NC == 12) ? (w < 4 ? w + 4 : w - 4) : w;
    const bf16_t* ksrcA = Kb + w * 512 + lane * 8;
    const bf16_t* ksrcB = Kb + (w + 8) * 512 + lane * 8;
    const bf16_t* vsrc = Vb + vp * 512 + lane * 8;
    const size_t kstep = (size_t)64 * QD, vstep = (size_t)4096;
    const unsigned lds0 = (unsigned)(size_t)lds;
#define ATT_DMA(t_, ks_, vs_) do { \
        att_glds16(ksrcA + (size_t)(t_) * kstep, (unsigned)__builtin_amdgcn_readfirstlane((int)(lds0 + (ks_) * ATT_KSLOT + w * 1024))); \
        if (three) att_glds16(ksrcB + (size_t)(t_) * kstep, (unsigned)__builtin_amdgcn_readfirstlane((int)(lds0 + (ks_) * ATT_KSLOT + (w + 8) * 1024))); \
        att_glds16(vsrc + (size_t)(t_) * vstep, (unsigned)__builtin_amdgcn_readfirstlane((int)(lds0 + ATT_V0 + (vs_) * ATT_VSLOT + vp * 1024))); } while (0)
    ATT_DMA(0, 0, 0);
    if (ntiles > 1) ATT_DMA(1, 1, 1);
    bf16x8 qr[NS];
#pragma unroll
    for (int s = 0; s < NS; ++s) qr[s] = *(const bf16x8*)(qrow + 16 * s + 8 * hi);
    f32x16 o0, o1, negm, p0, p1;
#pragma unroll
    for (int r = 0; r < 16; ++r) { o0[r] = 0.f; o1[r] = 0.f; negm[r] = 0.f; p0[r] = 0.f; p1[r] = 0.f; }
    float lsum = 0.f;
    const int kread = hi * 1024 + r32 * 16;
    const int vread = ATT_V0 + ((lane >> 4) & 1) * 32 + (lane & 3) * 8 + (4 * hi + ((lane & 15) >> 2)) * 64;
#define ATT_QK(ks_) do { const LAS unsigned char* kb_ = lds + (ks_) * ATT_KSLOT + kread; \
        _Pragma("unroll") for (int s = 0; s < NS; ++s) { \
            const bf16x8 a0 = *(const LAS bf16x8*)(kb_ + s * 2048), a1 = *(const LAS bf16x8*)(kb_ + s * 2048 + 512); \
            if (s == 0) { p0 = __builtin_amdgcn_mfma_f32_32x32x16_bf16(a0, qr[0], negm, 0, 0, 0); p1 = __builtin_amdgcn_mfma_f32_32x32x16_bf16(a1, qr[0], negm, 0, 0, 0); } \
            else { p0 = __builtin_amdgcn_mfma_f32_32x32x16_bf16(a0, qr[s], p0, 0, 0, 0); p1 = __builtin_amdgcn_mfma_f32_32x32x16_bf16(a1, qr[s], p1, 0, 0, 0); } } } while (0)
#define ATT_SOFT_PV(first_, vs_) do { \
        float mx = fmaxf(fmaxf(p0[0], p1[0]), p0[1]); \
        _Pragma("unroll") for (int r = 1; r < 16; ++r) mx = (r == 1) ? fmaxf(mx, p1[1]) : fmaxf(fmaxf(mx, p0[r]), p1[r]); \
        { auto rr = __builtin_amdgcn_permlane32_swap(__float_as_uint(mx), __float_as_uint(mx), false, false); mx = fmaxf(__uint_as_float(rr[0]), __uint_as_float(rr[1])); } \
        if ((first_) || __any(mx > ATT_THR)) { \
            const float dl = (first_) ? mx : fmaxf(mx, 0.f); \
            _Pragma("unroll") for (int r = 0; r < 16; ++r) { p0[r] -= dl; p1[r] -= dl; negm[r] -= dl; } \
            if (!(first_)) { const float f = __builtin_amdgcn_exp2f(-dl); lsum *= f; \
                _Pragma("unroll") for (int r = 0; r < 16; ++r) { o0[r] *= f; o1[r] *= f; } } \
        } \
        float rs = 0.f; \
        _Pragma("unroll") for (int r = 0; r < 16; ++r) { p0[r] = __builtin_amdgcn_exp2f(p0[r]); p1[r] = __builtin_amdgcn_exp2f(p1[r]); rs += p0[r] + p1[r]; } \
        lsum += rs; \
        u32x4 w0, w1, w2, w3; \
        w0.x = cvtpk(p0[0], p0[1]); w0.y = cvtpk(p0[2], p0[3]); w0.z = cvtpk(p0[4], p0[5]); w0.w = cvtpk(p0[6], p0[7]); \
        w1.x = cvtpk(p0[8], p0[9]); w1.y = cvtpk(p0[10], p0[11]); w1.z = cvtpk(p0[12], p0[13]); w1.w = cvtpk(p0[14], p0[15]); \
        w2.x = cvtpk(p1[0], p1[1]); w2.y = cvtpk(p1[2], p1[3]); w2.z = cvtpk(p1[4], p1[5]); w2.w = cvtpk(p1[6], p1[7]); \
        w3.x = cvtpk(p1[8], p1[9]); w3.y = cvtpk(p1[10], p1[11]); w3.z = cvtpk(p1[12], p1[13]); w3.w = cvtpk(p1[14], p1[15]); \
        const bf16x8 pa0 = __builtin_bit_cast(bf16x8, w0), pa1 = __builtin_bit_cast(bf16x8, w1), pa2 = __builtin_bit_cast(bf16x8, w2), pa3 = __builtin_bit_cast(bf16x8, w3); \
        const LAS unsigned char* vb_ = lds + (vs_) * ATT_VSLOT + vread; \
        o0 = __builtin_amdgcn_mfma_f32_32x32x16_bf16(ATT_VF(0, 0), pa0, o0, 0, 0, 0); \
        o1 = __builtin_amdgcn_mfma_f32_32x32x16_bf16(ATT_VF(1, 0), pa0, o1, 0, 0, 0); \
        o0 = __builtin_amdgcn_mfma_f32_32x32x16_bf16(ATT_VF(0, 1), pa1, o0, 0, 0, 0); \
        o1 = __builtin_amdgcn_mfma_f32_32x32x16_bf16(ATT_VF(1, 1), pa1, o1, 0, 0, 0); \
        o0 = __builtin_amdgcn_mfma_f32_32x32x16_bf16(ATT_VF(0, 2), pa2, o0, 0, 0, 0); \
        o1 = __builtin_amdgcn_mfma_f32_32x32x16_bf16(ATT_VF(1, 2), pa2, o1, 0, 0, 0); \
        o0 = __builtin_amdgcn_mfma_f32_32x32x16_bf16(ATT_VF(0, 3), pa3, o0, 0, 0, 0); \
        o1 = __builtin_amdgcn_mfma_f32_32x32x16_bf16(ATT_VF(1, 3), pa3, o1, 0, 0, 0); } while (0)
#define ATT_VF(d0, ks) ({ const s16x4 lo_ = vtr(vb_ + (d0) * 4096 + (ks) * 1024), hi_ = vtr(vb_ + (d0) * 4096 + (ks) * 1024 + 512); (bf16x8){lo_[0], lo_[1], lo_[2], lo_[3], hi_[0], hi_[1], hi_[2], hi_[3]}; })
#define ATT_ENDSTEP() do { if (issue) { if (three) ATT_WAITBAR(3); else ATT_WAITBAR(2); } else ATT_WAITBAR(0); \
        ks = (ks == ATT_NKS - 1) ? 0 : ks + 1; vs = (vs + 1) & (ATT_NVS - 1); } while (0)
    if (ntiles > 1) { if (three) ATT_WAITBAR(3); else ATT_WAITBAR(2); } else ATT_WAITBAR(0);
    int ks = 0, vs = 0;
    if (w < 4) {
        for (int t = 0; t < ntiles; ++t) {
            const bool issue = (t + 2 < ntiles);
            if (issue) ATT_DMA(t + 2, (ks >= 1) ? ks - 1 : ATT_NKS - 1, (vs + 2) & (ATT_NVS - 1));
            ATT_QK(ks);
            ATT_SOFT_PV(t == 0, vs);
            ATT_ENDSTEP();
        }
    } else {
        for (int t = 0; t < ntiles; ++t) {
            const bool issue = (t + 2 < ntiles);
            if (issue) ATT_DMA(t + 2, (ks >= 1) ? ks - 1 : ATT_NKS - 1, (vs + 2) & (ATT_NVS - 1));
            if (t > 0) ATT_SOFT_PV(t == 1, (vs + ATT_NVS - 1) & (ATT_NVS - 1));
            ATT_QK(ks);
            ATT_ENDSTEP();
        }
        ATT_SOFT_PV(ntiles == 1, (vs + ATT_NVS - 1) & (ATT_NVS - 1));
    }
#undef ATT_DMA
#undef ATT_QK
#undef ATT_SOFT_PV
#undef ATT_VF
#undef ATT_ENDSTEP
    { auto rr = __builtin_amdgcn_permlane32_swap(__float_as_uint(lsum), __float_as_uint(lsum), false, false); lsum = __uint_as_float(rr[0]) + __uint_as_float(rr[1]); }
    const float rl = 1.0f / lsum;
#pragma unroll
    for (int g = 0; g < 4; ++g) {
        u32x2 a, b2;
        a.x = cvtpk(o0[4 * g] * rl, o0[4 * g + 1] * rl); a.y = cvtpk(o0[4 * g + 2] * rl, o0[4 * g + 3] * rl);
        b2.x = cvtpk(o1[4 * g] * rl, o1[4 * g + 1] * rl); b2.y = cvtpk(o1[4 * g + 2] * rl, o1[4 * g + 3] * rl);
        *(u32x2*)(orow + 8 * g + 4 * hi) = a; *(u32x2*)(orow + 32 + 8 * g + 4 * hi) = b2;
    }
    asm volatile("s_waitcnt lgkmcnt(0)\n\ts_barrier" ::: "memory");
}

constexpr int AT3_KSLOT = 12288, AT3_VSLOT = 8192, AT3_V0 = 3 * AT3_KSLOT;
constexpr int AT3_FLAG = MISC_OFF + 32;
constexpr float AT3_SUMTHR = 1024.f, AT3_SUMBAD = 1.152921504606846976e18f;
#define AT3_SB() __builtin_amdgcn_sched_barrier(0)
#define AT3_PIN(x) asm volatile("" : "+v"(x))
template <int QD, bool exact>
__device__ __forceinline__ void attn_unit3(LAS unsigned char* lds, int tid, const bf16_t* Kb, const bf16_t* Vb, int ntiles, const bf16_t* qrow, bf16_t* orow) {
    constexpr int NC = QD / 8, NS = QD / 16, NKF = 2 * NS;
    constexpr int KG0 = (NS == 4) ? 2 : 1;
    const int lane = tid & 63, r32 = lane & 31, hi = lane >> 5;
    const int w = __builtin_amdgcn_readfirstlane(tid >> 6);
    const bool three = (NC == 12) && (w < 4);
    const int vp = (NC == 12) ? (w < 4 ? w + 4 : w - 4) : w;
    const bf16_t* ksrcA = Kb + w * 512 + lane * 8;
    const bf16_t* ksrcB = Kb + (w + 8) * 512 + lane * 8;
    const bf16_t* vsrc = Vb + vp * 512 + lane * 8;
    const size_t kstep = (size_t)64 * QD, vstep = (size_t)4096;
    const unsigned lds0 = (unsigned)(size_t)lds;
#define AT3_DMAK(t_, sl_) do { \
        att_glds16(ksrcA + (size_t)(t_) * kstep, (unsigned)__builtin_amdgcn_readfirstlane((int)(lds0 + (sl_) * AT3_KSLOT + w * 1024))); \
        if (three) att_glds16(ksrcB + (size_t)(t_) * kstep, (unsigned)__builtin_amdgcn_readfirstlane((int)(lds0 + (sl_) * AT3_KSLOT + (w + 8) * 1024))); } while (0)
#define AT3_DMAV(t_, sl_) att_glds16(vsrc + (size_t)(t_) * vstep, (unsigned)__builtin_amdgcn_readfirstlane((int)(lds0 + AT3_V0 + (sl_) * AT3_VSLOT + vp * 1024)))
#define AT3_WB(n_) do { const int nn_ = (n_); if (nn_ == 3) ATT_WAITBAR(3); else if (nn_ == 2) ATT_WAITBAR(2); else if (nn_ == 1) ATT_WAITBAR(1); else ATT_WAITBAR(0); } while (0)
    const int nk = three ? 2 : 1;
    AT3_DMAK(0, 0); AT3_DMAV(0, 0); AT3_DMAK(1, 1);
    bf16x8 qr[NS];
#pragma unroll
    for (int s = 0; s < NS; ++s) qr[s] = *(const bf16x8*)(qrow + 16 * s + 8 * hi);
    AT3_DMAK(2, 2);
    f32x16 o0, o1, negm, pA0, pA1, pB0, pB1;
#pragma unroll
    for (int r = 0; r < 16; ++r) { o0[r] = 0.f; o1[r] = 0.f; negm[r] = 0.f; }
    AT3_PIN(negm);
    float lsum = 0.f, fres = 1.f; bool resc = false, bad = false;
    const LAS unsigned char* kp0 = lds + hi * 1024 + r32 * 16;
    const LAS unsigned char* vp0 = lds + AT3_V0 + ((lane >> 4) & 1) * 32 + (lane & 3) * 8 + (4 * hi + ((lane & 15) >> 2)) * 64;
    if (three) ATT_WAITBAR(5); else ATT_WAITBAR(3);
    {
#pragma unroll
        for (int s = 0; s < NS; ++s) {
            const bf16x8 a0 = *(const LAS bf16x8*)(kp0 + s * 2048), a1 = *(const LAS bf16x8*)(kp0 + s * 2048 + 512);
            if (s == 0) { pA0 = __builtin_amdgcn_mfma_f32_32x32x16_bf16(a0, qr[0], negm, 0, 0, 0); pA1 = __builtin_amdgcn_mfma_f32_32x32x16_bf16(a1, qr[0], negm, 0, 0, 0); }
            else { pA0 = __builtin_amdgcn_mfma_f32_32x32x16_bf16(a0, qr[s], pA0, 0, 0, 0); pA1 = __builtin_amdgcn_mfma_f32_32x32x16_bf16(a1, qr[s], pA1, 0, 0, 0); } }
        float mx = fmaxf(fmaxf(pA0[0], pA1[0]), pA0[1]);
#pragma unroll
        for (int r = 1; r < 16; ++r) mx = (r == 1) ? fmaxf(mx, pA1[1]) : fmaxf(fmaxf(mx, pA0[r]), pA1[r]);
        { auto rr = __builtin_amdgcn_permlane32_swap(__float_as_uint(mx), __float_as_uint(mx), false, false); mx = fmaxf(__uint_as_float(rr[0]), __uint_as_float(rr[1])); }
#pragma unroll
        for (int r = 0; r < 16; ++r) { pA0[r] = __builtin_amdgcn_exp2f(pA0[r] - mx); pA1[r] = __builtin_amdgcn_exp2f(pA1[r] - mx); negm[r] = -mx; }
        AT3_PIN(negm);
    }
    ATT_WAITBAR(0);
    AT3_DMAK(3, 0); AT3_DMAV(1, 1);
    int sp = 0, sc = 1, sn = 2;
#define AT3_ROT() do { sp = sc; sc = sn; sn = (sn == 2) ? 0 : sn + 1; } while (0)
    bf16x8 kf[NKF];
    { const LAS unsigned char* kp_ = kp0 + sc * AT3_KSLOT;
#pragma unroll
      for (int j = 0; j < NS; ++j) { kf[2 * j] = *(const LAS bf16x8*)(kp_ + j * 2048); kf[2 * j + 1] = *(const LAS bf16x8*)(kp_ + j * 2048 + 512); } }
    AT3_WB(nk + 1);
    s16x4 vlo[8], vhi[8]; u32x4 pw[4];
#define AT3_PVAL(P0, P1, i) (((i) < 16) ? P0[(i) & 15] : P1[(i) & 15])
#define AT3_VFR(i) (bf16x8){vlo[i][0], vlo[i][1], vlo[i][2], vlo[i][3], vhi[i][0], vhi[i][1], vhi[i][2], vhi[i][3]}
#define AT3_STEP(C0, C1, P0, P1, t_, GK, GV, GL) do { AT3_SB(); \
        const LAS unsigned char* vp_ = vp0 + sp * AT3_VSLOT; \
        float sacc = P0[0] + P0[1]; \
        _Pragma("unroll") for (int g = 0; g < NKF; ++g) { \
            if (g < 8) { const int i_ = (g >> 1) + 4 * (g & 1); \
                vlo[i_] = vtr(vp_ + (i_ >> 2) * 4096 + (i_ & 3) * 1024); vhi[i_] = vtr(vp_ + (i_ >> 2) * 4096 + (i_ & 3) * 1024 + 512); AT3_SB(); } \
            if (g & 1) { if (g < 2) C1 = __builtin_amdgcn_mfma_f32_32x32x16_bf16(kf[g], qr[g >> 1], negm, 0, 0, 0); else C1 = __builtin_amdgcn_mfma_f32_32x32x16_bf16(kf[g], qr[g >> 1], C1, 0, 0, 0); } \
            else { if (g < 2) C0 = __builtin_amdgcn_mfma_f32_32x32x16_bf16(kf[g], qr[g >> 1], negm, 0, 0, 0); else C0 = __builtin_amdgcn_mfma_f32_32x32x16_bf16(kf[g], qr[g >> 1], C0, 0, 0, 0); } \
            { const int wl_ = (g * 16) / NKF, wh_ = ((g + 1) * 16) / NKF;         \
              _Pragma("unroll") for (int k_ = 0; k_ < 16; ++k_) if (k_ >= wl_ && k_ < wh_) { \
                  if (k_ < 15) { sacc += AT3_PVAL(P0, P1, 2 * k_ + 2); sacc += AT3_PVAL(P0, P1, 2 * k_ + 3); } \
                  pw[k_ >> 2][k_ & 3] = cvtpk(AT3_PVAL(P0, P1, 2 * k_), AT3_PVAL(P0, P1, 2 * k_ + 1)); } \
              AT3_PIN(sacc); \
              _Pragma("unroll") for (int k_ = 0; k_ < 4; ++k_) if (4 * k_ + 3 >= wl_ && 4 * k_ < wh_) AT3_PIN(pw[k_]); } \
            AT3_SB(); } \
        lsum += sacc; \
        if (GK) AT3_DMAK((t_) + 3, sc); \
        if (GV) AT3_DMAV((t_) + 1, sn); \
        resc = false; \
        if (exact) { float ma = fmaxf(fmaxf(C0[0], C0[1]), C1[0]), mb = fmaxf(fmaxf(C0[2], C0[3]), C1[1]); ma = fmaxf(fmaxf(ma, C1[2]), C1[3]); \
          _Pragma("unroll") for (int r = 4; r < 16; r += 4) { ma = fmaxf(fmaxf(ma, C0[r]), C0[r + 1]); mb = fmaxf(fmaxf(mb, C0[r + 2]), C0[r + 3]); ma = fmaxf(fmaxf(ma, C1[r]), C1[r + 1]); mb = fmaxf(fmaxf(mb, C1[r + 2]), C1[r + 3]); } \
          float rm = fmaxf(ma, mb); \
          { auto rr = __builtin_amdgcn_permlane32_swap(__float_as_uint(rm), __float_as_uint(rm), false, false); rm = fmaxf(__uint_as_float(rr[0]), __uint_as_float(rr[1])); } \
          if (__builtin_expect(__any(rm > ATT_THR), 0)) { const float dl = fmaxf(rm, 0.f); \
              _Pragma("unroll") for (int r = 0; r < 16; ++r) { C0[r] -= dl; C1[r] -= dl; negm[r] -= dl; } \
              AT3_PIN(negm); \
              fres = __builtin_amdgcn_exp2f(-dl); lsum *= fres; resc = true; } \
        } else if (__builtin_expect(__any(!(sacc <= AT3_SUMTHR)), 0)) {         \
            float sm = sacc; \
            { auto rr = __builtin_amdgcn_permlane32_swap(__float_as_uint(sm), __float_as_uint(sm), false, false); const float s0_ = __uint_as_float(rr[0]), s1_ = __uint_as_float(rr[1]); sm = (s0_ == s0_ && s1_ == s1_) ? fmaxf(s0_, s1_) : s0_ + s1_; } \
            if (__any(!(sm < AT3_SUMBAD))) bad = true; \
            const float dl = (sm > AT3_SUMTHR && sm < AT3_SUMBAD) ? (float)((int)(__float_as_uint(sm) >> 23) - 127) : 0.f;     \
            _Pragma("unroll") for (int r = 0; r < 16; ++r) { C0[r] -= dl; C1[r] -= dl; negm[r] -= dl; } \
            AT3_PIN(negm); \
            fres = __builtin_amdgcn_exp2f(-dl); lsum *= fres; resc = true; } \
        AT3_SB(); \
        const LAS unsigned char* kn_ = kp0 + sn * AT3_KSLOT; \
        _Pragma("unroll") for (int g = 0; g < 8; ++g) { \
            if (g >= KG0 && g < KG0 + NS) { if (GL) { const int j_ = g - KG0; kf[2 * j_] = *(const LAS bf16x8*)(kn_ + j_ * 2048); kf[2 * j_ + 1] = *(const LAS bf16x8*)(kn_ + j_ * 2048 + 512); AT3_SB(); } } \
            { const int i_ = (g >> 1) + 4 * (g & 1); \
              if (g & 1) o1 = __builtin_amdgcn_mfma_f32_32x32x16_bf16(AT3_VFR(i_), __builtin_bit_cast(bf16x8, pw[g >> 1]), o1, 0, 0, 0); \
              else o0 = __builtin_amdgcn_mfma_f32_32x32x16_bf16(AT3_VFR(i_), __builtin_bit_cast(bf16x8, pw[g >> 1]), o0, 0, 0, 0); } \
            if (g < 4) { C0[4 * g] = __builtin_amdgcn_exp2f(C0[4 * g]); C0[4 * g + 1] = __builtin_amdgcn_exp2f(C0[4 * g + 1]); C0[4 * g + 2] = __builtin_amdgcn_exp2f(C0[4 * g + 2]); C0[4 * g + 3] = __builtin_amdgcn_exp2f(C0[4 * g + 3]); AT3_PIN(C0); } \
            else { C1[4 * g - 16] = __builtin_amdgcn_exp2f(C1[4 * g - 16]); C1[4 * g - 15] = __builtin_amdgcn_exp2f(C1[4 * g - 15]); C1[4 * g - 14] = __builtin_amdgcn_exp2f(C1[4 * g - 14]); C1[4 * g - 13] = __builtin_amdgcn_exp2f(C1[4 * g - 13]); AT3_PIN(C1); } \
            AT3_SB(); } \
    } while (0)
#define AT3_RESC() do { if (resc) { _Pragma("unroll") for (int r = 0; r < 16; ++r) { o0[r] *= fres; o1[r] *= fres; } } } while (0)
    for (int t = 1; t + 3 < ntiles; t += 2) {
        AT3_STEP(pB0, pB1, pA0, pA1, t, true, true, true);      if (three) ATT_WAITBAR(3); else ATT_WAITBAR(2);  AT3_RESC(); AT3_ROT();
        AT3_STEP(pA0, pA1, pB0, pB1, t + 1, true, true, true);  if (three) ATT_WAITBAR(3); else ATT_WAITBAR(2);  AT3_RESC(); AT3_ROT();
    }
    AT3_STEP(pB0, pB1, pA0, pA1, ntiles - 3, false, true, true);   ATT_WAITBAR(1); AT3_RESC(); AT3_ROT();
    AT3_STEP(pA0, pA1, pB0, pB1, ntiles - 2, false, true, true);   ATT_WAITBAR(0); AT3_RESC(); AT3_ROT();
    AT3_STEP(pB0, pB1, pA0, pA1, ntiles - 1, false, false, false); AT3_RESC();
    { float sacc = pB0[0] + pB0[1];
#pragma unroll
      for (int r = 2; r < 16; ++r) sacc += pB0[r];
#pragma unroll
      for (int r = 0; r < 16; ++r) sacc += pB1[r];
      lsum += sacc;
#pragma unroll
      for (int k = 0; k < 4; ++k) { pw[k][0] = cvtpk(AT3_PVAL(pB0, pB1, 8 * k), AT3_PVAL(pB0, pB1, 8 * k + 1)); pw[k][1] = cvtpk(AT3_PVAL(pB0, pB1, 8 * k + 2), AT3_PVAL(pB0, pB1, 8 * k + 3));
                                    pw[k][2] = cvtpk(AT3_PVAL(pB0, pB1, 8 * k + 4), AT3_PVAL(pB0, pB1, 8 * k + 5)); pw[k][3] = cvtpk(AT3_PVAL(pB0, pB1, 8 * k + 6), AT3_PVAL(pB0, pB1, 8 * k + 7)); }
      const LAS unsigned char* vp_ = vp0 + sc * AT3_VSLOT;
#pragma unroll
      for (int i = 0; i < 8; ++i) { vlo[i] = vtr(vp_ + (i >> 2) * 4096 + (i & 3) * 1024); vhi[i] = vtr(vp_ + (i >> 2) * 4096 + (i & 3) * 1024 + 512); }
#pragma unroll
      for (int k = 0; k < 4; ++k) { o0 = __builtin_amdgcn_mfma_f32_32x32x16_bf16(AT3_VFR(k), __builtin_bit_cast(bf16x8, pw[k]), o0, 0, 0, 0); o1 = __builtin_amdgcn_mfma_f32_32x32x16_bf16(AT3_VFR(k + 4), __builtin_bit_cast(bf16x8, pw[k]), o1, 0, 0, 0); } }
#undef AT3_DMAK
#undef AT3_DMAV
#undef AT3_WB
#undef AT3_ROT
#undef AT3_PVAL
#undef AT3_VFR
#undef AT3_STEP
#undef AT3_RESC
    { auto rr = __builtin_amdgcn_permlane32_swap(__float_as_uint(lsum), __float_as_uint(lsum), false, false); lsum = __uint_as_float(rr[0]) + __uint_as_float(rr[1]); }
    const float rl = 1.0f / lsum;
#pragma unroll
    for (int g = 0; g < 4; ++g) {
        u32x2 a, b2;
        a.x = cvtpk(o0[4 * g] * rl, o0[4 * g + 1] * rl); a.y = cvtpk(o0[4 * g + 2] * rl, o0[4 * g + 3] * rl);
        b2.x = cvtpk(o1[4 * g] * rl, o1[4 * g + 1] * rl); b2.y = cvtpk(o1[4 * g + 2] * rl, o1[4 * g + 3] * rl);
        *(u32x2*)(orow + 8 * g + 4 * hi) = a; *(u32x2*)(orow + 32 + 8 * g + 4 * hi) = b2;
    }
    if (!exact) { if (__any(!(lsum < 1.2676506e30f))) bad = true;
        if (bad && lane == 0) *(volatile LAS unsigned*)(lds + AT3_FLAG) = 1u; }
    asm volatile("s_waitcnt lgkmcnt(0)\n\ts_barrier" ::: "memory");
}
struct AttDesc { bool qd96; const bf16_t* Kb; const bf16_t* Vb; const bf16_t* Qb; bf16_t* Ob; int row0, nt; };
__device__ __forceinline__ AttDesc att_desc(int i, int vcu, unsigned char* ws) {
    const bf16_t* Qm = (const bf16_t*)(ws + WS_QM); const bf16_t* Km = (const bf16_t*)(ws + WS_KM); const bf16_t* Vm = (const bf16_t*)(ws + WS_VM);
    const bf16_t* Qg = (const bf16_t*)(ws + WS_QG); const bf16_t* Kg = (const bf16_t*)(ws + WS_KG); const bf16_t* Vg = (const bf16_t*)(ws + WS_VG);
    bf16_t* O = (bf16_t*)(ws + WS_O);
    const int xcd = vcu >> 5, cix = vcu & 31;
    AttDesc d;
    if (i < 8 && (i & 1) == 0) {
        const int pair = xcd * 16 + (i >> 1) * 4 + (cix >> 3), b = pair >> 3, h = pair & 7, qb = cix & 7;
        d.qd96 = true; d.Kb = Km + (size_t)(b * 8 + h) * KPB * 96; d.Vb = Vm + (size_t)(b * 8 + h) * KPB * 64; d.Qb = Qm + h * 96; d.Ob = O + h * 64; d.row0 = b * SEQ + qb * 256; d.nt = KPB / 64;
    } else if (i < 8) {
        const int pair = xcd * 4 + (i >> 1), b = pair >> 1, kvh = pair & 1;
        d.qd96 = false; d.Kb = Kg + (size_t)(b * 2 + kvh) * KPB * 64; d.Vb = Vg + (size_t)(b * 2 + kvh) * KPB * 64; d.Qb = Qg + kvh * 256; d.Ob = O + 512 + kvh * 256; d.row0 = b * SEQ + cix * 64; d.nt = KPB / 64;
    } else if (vcu < 128) {
        const int b = vcu >> 3, h = vcu & 7;
        d.qd96 = true; d.Kb = Km + (size_t)(b * 8 + h) * KPB * 96; d.Vb = Vm + (size_t)(b * 8 + h) * KPB * 64; d.Qb = Qm + h * 96; d.Ob = O + h * 64; d.row0 = TL + b * CTX; d.nt = CTX / 64;
    } else {
        const int idx = vcu - 128, b = idx >> 3, kvh = (idx >> 2) & 1, qb = idx & 3;
        d.qd96 = false; d.Kb = Kg + (size_t)(b * 2 + kvh) * KPB * 64; d.Vb = Vg + (size_t)(b * 2 + kvh) * KPB * 64; d.Qb = Qg + kvh * 256; d.Ob = O + 512 + kvh * 256; d.row0 = TL + b * CTX + qb * 64; d.nt = CTX / 64;
    }
    return d;
}
#ifndef ATT_FORCE_EXACT
#define ATT_FORCE_EXACT 0
#endif
__device__ __forceinline__ void phase_attn(const Ctx& F, KP kp, bool last, int l) {
    const Args a = ldargs(kp);
    unsigned char* ws = a.ws;
    const int nun = last ? 8 : 9;
    if (F.tid == 0) *(volatile LAS unsigned*)(F.lds + AT3_FLAG) = ATT_FORCE_EXACT ? 1u : 0u;
    bool exact = false;
#define ATT_RUN(EX) do { \
        int tid_; { int ln_; asm volatile("v_mbcnt_lo_u32_b32 %0, -1, 0\n\tv_mbcnt_hi_u32_b32 %0, -1, %0" : "=v"(ln_)); tid_ = F.wave * 64 + ln_; }       \
        const int r32 = tid_ & 31, w = __builtin_amdgcn_readfirstlane(tid_ >> 6); \
        if (d.qd96) { const int row = d.row0 + w * 32 + r32; \
            attn_unit3<96, EX>(F.lds, tid_, d.Kb, d.Vb, d.nt, d.Qb + (size_t)row * QW, d.Ob + (size_t)row * D); \
        } else { const int row = d.row0 + (w & 1) * 32 + r32; \
            attn_unit3<64, EX>(F.lds, tid_, d.Kb, d.Vb, d.nt, d.Qb + (size_t)row * 512 + (w >> 1) * 64, d.Ob + (size_t)row * D + (w >> 1) * 64); } } while (0)
    for (int i = 0; i < nun; ++i) {
        const AttDesc d = att_desc(i, F.vcu, ws);
        if (!exact) {
            ATT_RUN(false);
            const unsigned fl = __builtin_amdgcn_readfirstlane((int)*(volatile LAS unsigned*)(F.lds + AT3_FLAG));
            if (fl != 0u) exact = true;
        }
        if (exact) ATT_RUN(true);
        if (i == (F.vcu & 7)) {
            int ln_; asm volatile("v_mbcnt_lo_u32_b32 %0, -1, 0\n\tv_mbcnt_hi_u32_b32 %0, -1, %0" : "=v"(ln_));
            conv_experts(ln_, F.wave, F.vcu, a, l);
        }
    }
#undef ATT_RUN
}
__global__ void __launch_bounds__(NTHREADS, 2) fwd_kernel(Args a_unused) {
    extern __shared__ __attribute__((aligned(16))) unsigned char lds_raw[];
    const KP kp = (KP)__builtin_amdgcn_kernarg_segment_ptr();
    Ctx F;
    F.lds = (LAS unsigned char*)lds_raw;
    F.tid = threadIdx.x; F.lane = F.tid & 63; F.wave = __builtin_amdgcn_readfirstlane(F.tid >> 6);
    F.bk = blockIdx.x; F.vcu = (F.bk & 7) * (GRID / 8) + (F.bk >> 3);
    if (F.tid < 4) ((volatile LAS unsigned*)(F.lds + MISC_BAR))[F.tid] = 0u;
    __syncthreads();
    { const Args a = ldargs(kp); (void)xcd_barrier_post((unsigned*)(a.ws + WS_CTL), (volatile LAS unsigned*)(F.lds + MISC_BAR), F.tid == 0); }
#define FRESH() do { int ln_; asm volatile("v_mbcnt_lo_u32_b32 %0, -1, 0\n\tv_mbcnt_hi_u32_b32 %0, -1, %0" : "=v"(ln_)); F.lane = ln_; F.tid = F.wave * 64 + ln_; F.bk = blockIdx.x; F.vcu = (F.bk & 7) * (GRID / 8) + (F.bk >> 3); } while (0)
#define GRID_BAR() do { XcdBarrier b_; { const Args a_ = ldargs(kp); b_.bar = (unsigned*)(a_.ws + WS_CTL); } b_.x = xb_xcc_id(); b_.st = (volatile LAS unsigned*)(F.lds + MISC_BAR); xcd_barrier(b_, F.tid == 0); } while (0)

    for (int rep_ = 0; rep_ < REP_PRO; ++rep_) prologue1(F, kp);
    GRID_BAR(); FRESH();
    prologue2(F, kp);
    prologue3(F, kp);
    GRID_BAR(); FRESH();

    for (int l = 0; l < NL; ++l) {
        const bool last = (l == NL - 1);
        const int ntok = last ? TL : MT;
        { const Args a = ldargs(kp); unsigned char* ws = a.ws;
          Gemm g{(const bf16_t*)(ws + WS_H), D, (const bf16_t*)(ws + WS_WIN) + (size_t)l * ZW * D, D}; StaticOrder S; S.init(MT, ZW, GRID, F.bk);
#if FUSE_SPLIT
          LAS f32x2* t64l = (LAS f32x2*)(F.lds + STAGE_BYTES); LAS f32x2* t32l = t64l + 1024; LAS float* ggl = (LAS float*)(t32l + 512);
          { const f32x2* t64g = (const f32x2*)(ws + WS_TAB64); const f32x2* t32g = (const f32x2*)(ws + WS_TAB32);
            t64l[F.tid] = t64g[F.tid]; t64l[F.tid + 512] = t64g[F.tid + 512]; t32l[F.tid] = t32g[F.tid];
            if (F.tid < 64) ggl[F.tid] = a.g_gq[l * 64 + F.tid]; else if (F.tid < 128) ggl[F.tid] = a.g_gk[l * 64 + F.tid - 64]; }
          __syncthreads();
          EpiIn E{ws, ggl, ggl + 64, t64l, t32l}; gemm_phase<0>(F, g, S, E); }
#else
          EpiZ E{(bf16_t*)(ws + WS_Z)}; gemm_phase<0>(F, g, S, E); }
#endif
        GRID_BAR(); FRESH();
#if !FUSE_SPLIT
        for (int rep_ = 0; rep_ < REP_P2; ++rep_) phase_split(F, kp, l);
        GRID_BAR(); FRESH();
#endif
        { const Args a = ldargs(kp); unsigned char* ws = a.ws;
          Gemm g{(const bf16_t*)(ws + WS_Z), ZW, (const bf16_t*)(ws + WS_WQ) + (size_t)l * QW * 384, 384}; StaticOrder S; S.init(MT, QW, GRID, F.bk);
          LAS f32x2* t32l = (LAS f32x2*)(F.lds + STAGE_BYTES);
          LAS float* rsq = (LAS float*)(F.lds + STAGE_BYTES + 4096);
          { const f32x2* t32g = (const f32x2*)(ws + WS_TAB32); t32l[F.tid] = t32g[F.tid];
            Unit u; for (int i = 0; i < 4 && S.next(i, u); ++i) if (F.tid < 256) rsq[i * 256 + F.tid] = EpiQ::rowscale(ws, u.pm * 256 + F.tid); }
          __syncthreads();
          EpiQ E{ws, t32l, rsq}; gemm_phase<1>(F, g, S, E); }
        FRESH();
        { const Args a = ldargs(kp); unsigned char* ws = a.ws;
          Gemm g{(const bf16_t*)(ws + WS_Z) + 384, ZW, (const bf16_t*)(ws + WS_WKV) + (size_t)l * KVW * 256, 256}; StaticOrder S; S.init(MT, KVW, GRID, (F.bk + 80) & 255);
          LAS float* rskv = (LAS float*)(F.lds + STAGE_BYTES + 8192);
          { Unit u; for (int i = 0; i < 4 && S.next(i, u); ++i) if (F.tid < 256) rskv[i * 256 + F.tid] = EpiKV::rowscale(ws, u.pm * 256 + F.tid); }
          __syncthreads();
          EpiKV E{ws, rskv}; gemm_phase<2>(F, g, S, E); }
        GRID_BAR(); FRESH();
#if USE_MFMA_ATTN
        for (int rep_ = 0; rep_ < REP_ATTN; ++rep_) phase_attn(F, kp, last, l);
        FRESH();
#else
#error the scalar attention body reads the old row-major K/V layout
#endif
        GRID_BAR(); FRESH();
        { const Args a = ldargs(kp); unsigned char* ws = a.ws;
          Gemm g{(const bf16_t*)(ws + WS_O), D, (const bf16_t*)(ws + WS_WO) + (size_t)l * D * D, D}; StaticOrder S; S.init(ntok, D, GRID, F.bk);
          EpiYo E{(bf16_t*)(ws + WS_U)}; gemm_phase<3>(F, g, S, E); }
        GRID_BAR(); FRESH();
        if (l == 0) phase_ln1_route<true>(F, kp, l, ntok); else phase_ln1_route<false>(F, kp, l, ntok);
        GRID_BAR(); FRESH();
        for (int rep_ = 0; rep_ < REP_P7; ++rep_) phase_dispatch(F, kp, l, ntok);
        GRID_BAR(); FRESH();
        { const Args a = ldargs(kp); unsigned char* ws = a.ws;
          Gemm g{(const bf16_t*)(ws + WS_H), D, (const bf16_t*)(ws + WS_WGU) + (size_t)l * NEXP * 1024 * D, D}; GroupedOrder S; S.init((const volatile LAS int*)(F.lds + MISC_POFF), GRID, F.vcu);
          LAS int* gt = (LAS int*)(F.lds + STAGE_BYTES);
          { const int* postok = (const int*)(ws + WS_POSTOK); Unit u; for (int i = 0; i < 16 && S.next(i, u); ++i) if (F.tid < 256) gt[i * 256 + F.tid] = postok[u.pm * 256 + F.tid]; }
          __syncthreads();
          EpiAct E{(bf16_t*)(ws + WS_ACT)}; gemm_phase_gather<4>(F, g, S, E, gt); }
        GRID_BAR(); FRESH();
        { const Args a = ldargs(kp); unsigned char* ws = a.ws;
          Gemm g{(const bf16_t*)(ws + WS_ACT), FF, (const bf16_t*)(ws + WS_WD) + (size_t)l * NEXP * D * FF, FF}; GroupedOrder S; S.init((const volatile LAS int*)(F.lds + MISC_POFF), GRID, F.vcu);
          EpiY E{(bf16_t*)(ws + WS_XS)}; gemm_phase<5>(F, g, S, E); }
        GRID_BAR(); FRESH();
        phase_ln2(F, kp, l, ntok);
        GRID_BAR(); FRESH();
    }
}

extern "C" void kernel_launch(void* const* d_in, const int* in_sizes, int n_in, void* d_out, int out_size, void* d_ws, size_t ws_size, hipStream_t stream) {
    static int grid = 0;
    if (grid == 0) {
        if (n_in != 25 || out_size != TL * D || ws_size < WS_END) { fprintf(stderr, "kernel_launch: unexpected shapes (n_in %d out %d ws %zu need %zu)\n", n_in, out_size, ws_size, (size_t)WS_END); grid = -1; return; }
        int dev = 0, cus = 0, per_cu = 0;
        if (hipGetDevice(&dev) != hipSuccess || hipDeviceGetAttribute(&cus, hipDeviceAttributeMultiprocessorCount, dev) != hipSuccess) { grid = -1; return; }
        if (hipFuncSetAttribute((const void*)fwd_kernel, hipFuncAttributeMaxDynamicSharedMemorySize, LDS_BYTES) != hipSuccess) { fprintf(stderr, "kernel_launch: hipFuncSetAttribute failed\n"); grid = -1; return; }
        if (hipOccupancyMaxActiveBlocksPerMultiprocessor(&per_cu, (const void*)fwd_kernel, NTHREADS, LDS_BYTES) != hipSuccess || per_cu < 1) { fprintf(stderr, "kernel_launch: occupancy query says %d\n", per_cu); }
        (void)hipGetLastError();
        grid = (cus == 256) ? 256 : -1;
        if (grid < 0) { fprintf(stderr, "kernel_launch: need a 256-CU device, got %d\n", cus); return; }
    }
    if (grid < 0) return;
    if (hipMemsetAsync((char*)d_ws + WS_CTL, 0, CTL_BYTES, stream) != hipSuccess) return;
    Args a{};
    a.x = (const float*)d_in[0]; a.c = (const float*)d_in[1]; a.ctx = (const float*)d_in[2]; a.c_ctx = (const float*)d_in[3]; a.w_ada = (const float*)d_in[4]; a.b_ada = (const float*)d_in[5];
    a.w_in = (const float*)d_in[6]; a.g_q_a = (const float*)d_in[7]; a.w_q_b = (const float*)d_in[8]; a.g_kv_a = (const float*)d_in[9]; a.w_kv_b = (const float*)d_in[10];
    a.g_gq = (const float*)d_in[11]; a.g_gk = (const float*)d_in[12]; a.w_o = (const float*)d_in[13]; a.ln1_g = (const float*)d_in[14]; a.ln1_b = (const float*)d_in[15];
    a.w_rg = (const float*)d_in[16]; a.b_rg = (const float*)d_in[17]; a.w_re = (const float*)d_in[18]; a.b_re = (const float*)d_in[19];
    a.w_gate = (const float*)d_in[20]; a.w_up = (const float*)d_in[21]; a.w_down = (const float*)d_in[22]; a.ln2_g = (const float*)d_in[23]; a.ln2_b = (const float*)d_in[24];
    a.out = (float*)d_out; a.ws = (unsigned char*)d_ws;
    hipLaunchKernelGGL(fwd_kernel, dim3(grid), dim3(NTHREADS), LDS_BYTES, stream, a);
}
```

```cpp
#include <hip/hip_runtime.h>
#include <cstdint>
#include <cstdio>

#ifndef REP_ATTN
#define REP_ATTN 1
#endif
#ifndef REP_GEMM
#define REP_GEMM 1
#endif
#ifndef REP_PRO
#define REP_PRO 1
#endif
#ifndef REP_THIN
#define REP_THIN 1
#endif
#ifndef REP_P2
#define REP_P2 1
#endif
#ifndef REP_P7
#define REP_P7 1
#endif
#ifndef REP_P6
#define REP_P6 1
#endif
#ifndef REP_P10
#define REP_P10 0
#endif
#ifndef FILL_P1
#define FILL_P1 3
#endif
#ifndef FILL_P5
#define FILL_P5 3
#endif
#ifndef FUSE_SPLIT
#define FUSE_SPLIT 1
#endif
#ifndef USE_MFMA_GEMM
#define USE_MFMA_GEMM 1
#endif
#ifndef USE_MFMA_ATTN
#define USE_MFMA_ATTN 1
#endif

#define GAS __attribute__((address_space(1)))
#define LAS __attribute__((address_space(3)))
typedef unsigned short bf16_t;
typedef float f32x4 __attribute__((ext_vector_type(4)));
typedef float f32x2 __attribute__((ext_vector_type(2)));
typedef unsigned u32x4 __attribute__((ext_vector_type(4)));
typedef unsigned u32x2 __attribute__((ext_vector_type(2)));
typedef short bf16x8 __attribute__((ext_vector_type(8)));

constexpr int D = 1024, NB = 16, SEQ = 2048, CTX = 256, NL = 4;
constexpr int TL = NB * SEQ, TC = NB * CTX, MT = TL + TC;
constexpr int KPB = CTX + SEQ;
constexpr int ZW = 1536;
constexpr int QW = 768, KVW = 1024;
constexpr int NEXP = 32, FF = 512;
constexpr int XS_ROWS = 81920;
constexpr float ALPHA = 1.6817928305074290f;
constexpr float LOG2E = 1.4426950408889634f;
constexpr float QSCALE_M = 0.10206207261596575f * LOG2E;
constexpr float QSCALE_G = 0.125f * LOG2E;
constexpr float RMS_EPS = 1e-6f, LN_EPS = 1e-5f;
constexpr int NWAVES = 8, NTHREADS = 512, GRID = 256;

constexpr size_t al256(size_t x) { return (x + 255) & ~(size_t)255; }
constexpr size_t WS_CTL = 0, CTL_BYTES = 65536;
constexpr size_t WS_BLKCNT = WS_CTL + CTL_BYTES;
constexpr size_t WS_MOETAB = WS_BLKCNT + (size_t)NL * 256 * 32 * 4;
constexpr size_t WS_MOD = WS_MOETAB + (size_t)NL * 128 * 4;
constexpr size_t WS_MODP = WS_MOD + (size_t)NL * 17 * 6144 * 4;
constexpr size_t WS_TAB64 = WS_MODP + (size_t)4 * NL * 17 * 6144 * 4;
constexpr size_t WS_TAB32 = WS_TAB64 + 64 * 16 * 8;
constexpr size_t WS_RSTDQ = WS_TAB32 + 64 * 8 * 8;
constexpr size_t WS_RSTDKV = WS_RSTDQ + (size_t)MT * 4;
constexpr size_t WS_TOKE = WS_RSTDKV + (size_t)MT * 4;
constexpr size_t WS_TOKR = WS_TOKE + (size_t)MT * 8;
constexpr size_t WS_TOKP = WS_TOKR + (size_t)MT * 8;
constexpr size_t WS_TOKW = WS_TOKP + (size_t)MT * 8;
constexpr size_t WS_WIN = al256(WS_TOKW + (size_t)MT * 8);
constexpr size_t WS_WQ = WS_WIN + (size_t)NL * ZW * D * 2;
constexpr size_t WS_WKV = WS_WQ + (size_t)NL * QW * 384 * 2;
constexpr size_t WS_WO = WS_WKV + (size_t)NL * KVW * 256 * 2;
constexpr size_t WS_WGU = WS_WO + (size_t)NL * D * D * 2;
constexpr size_t WS_WD = WS_WGU + (size_t)NL * NEXP * 1024 * D * 2;
constexpr size_t WS_XC = WS_WD + (size_t)NL * NEXP * D * FF * 2;
constexpr size_t WS_H = WS_XC + (size_t)TC * D * 4;
constexpr size_t WS_B = WS_H + (size_t)MT * D * 2;
constexpr size_t WS_Z = WS_B;
constexpr size_t WS_QM = WS_Z + (size_t)MT * ZW * 2;
constexpr size_t WS_KM = WS_QM + (size_t)MT * QW * 2;
constexpr size_t WS_VM = WS_KM + (size_t)MT * QW * 2;
constexpr size_t WS_QG = WS_VM + (size_t)MT * 512 * 2;
constexpr size_t WS_KG = WS_QG + (size_t)MT * 512 * 2;
constexpr size_t WS_VG = WS_KG + (size_t)MT * 128 * 2;
constexpr size_t WS_O = WS_VG + (size_t)MT * 128 * 2;
constexpr size_t WS_BEND = WS_O + (size_t)MT * D * 2;
constexpr size_t WS_U = WS_B;
constexpr size_t WS_XS = WS_B;
constexpr size_t WS_ACT = WS_XS + (size_t)XS_ROWS * D * 2;
constexpr size_t WS_HLO = WS_BEND;
constexpr size_t WS_WR = WS_HLO + (size_t)MT * D * 2;
constexpr size_t WS_POSTOK = WS_WR + (size_t)NL * 2 * 48 * D * 2;
constexpr size_t WS_SSQP = al256(WS_POSTOK + (size_t)XS_ROWS * 4);
constexpr size_t WS_XB = al256(WS_SSQP + (size_t)MT * 20 * 4);
constexpr size_t WS_END = WS_XB + (size_t)MT * D * 2;
static_assert(WS_U + (size_t)MT * D * 4 <= WS_KM, "U must fit in Z+QM");
static_assert(WS_ACT + (size_t)XS_ROWS * FF * 2 <= WS_BEND, "MoE buffers must fit in region B");
static_assert(WS_END < (size_t)1100 * 1000 * 1000, "workspace map too large");

constexpr int LDS_BYTES = 163840;
constexpr int BIG_BYTES = 147456;
constexpr int MISC_OFF = BIG_BYTES;
constexpr int MISC_BAR = MISC_OFF;
constexpr int MISC_CNT = MISC_OFF + 64;
constexpr int MISC_POFF = MISC_OFF + 256;
constexpr int MISC_TOT = MISC_OFF + 512;
constexpr int MISC_BASE = MISC_OFF + 768;
constexpr int MISC_PA = MISC_OFF + 1024;
constexpr int MISC_PB = MISC_OFF + 1024 + 2048;
constexpr int MISC_LG = MISC_OFF + 8192;

#define LDS_WAIT() asm volatile("s_waitcnt lgkmcnt(0)" ::: "memory")
__device__ __forceinline__ unsigned f2bf(float f) { unsigned u = __builtin_bit_cast(unsigned, f); return (u + 0x7fffu + ((u >> 16) & 1u)) >> 16; }
__device__ __forceinline__ unsigned pk2(float lo, float hi) { typedef __bf16 bf2_t __attribute__((ext_vector_type(2))); f32x2 v = {lo, hi}; bf2_t b = __builtin_convertvector(v, bf2_t); return __builtin_bit_cast(unsigned, b); }
__device__ __forceinline__ float bflo(unsigned w) { return __builtin_bit_cast(float, w << 16); }
__device__ __forceinline__ float bfhi(unsigned w) { return __builtin_bit_cast(float, w & 0xffff0000u); }
template <int K> __device__ __forceinline__ float lane_xor(float v) { return __int_as_float(__builtin_amdgcn_ds_swizzle(__float_as_int(v), (K << 10) | 0x1f)); }
__device__ __forceinline__ float wave_sum(float v) {
    v += lane_xor<1>(v); v += lane_xor<2>(v); v += lane_xor<4>(v); v += lane_xor<8>(v); v += lane_xor<16>(v);
    { auto rr = __builtin_amdgcn_permlane32_swap(__float_as_uint(v), __float_as_uint(v), false, false); v = __uint_as_float(rr[0]) + __uint_as_float(rr[1]); }
    return v;
}
__device__ __forceinline__ int krow_of(int r) { return r < TL ? (r >> 11) * KPB + CTX + (r & 2047) : ((r - TL) >> 8) * KPB + ((r - TL) & 255); }
__device__ __forceinline__ void key_bj(int r, int& b, int& j) { if (r < TL) { b = r >> 11; j = CTX + (r & 2047); } else { b = (r - TL) >> 8; j = (r - TL) & 255; } }
__device__ __forceinline__ size_t ktile_off(int nh, int b, int h, int j, int qd, int chunk) { return ((size_t)(b * nh + h) * KPB + (j & ~63)) * qd + chunk * 512 + (j & 63) * 8; }
__device__ __forceinline__ size_t vtile_off(int nh, int b, int h, int j, int d0) { return ((size_t)(b * nh + h) * KPB + (j & ~63)) * 64 + (d0 >> 5) * 2048 + (j & 63) * 32 + (d0 & 31); }
__device__ __forceinline__ int bb_of(int r) { return r < TL ? (r >> 11) : 16; }

#define XB_TMO      128
#define XB_XCNT(j)  (256  + 64 * (j))
#define XB_XSUB(j)  (1280 + 64 * (j))
#define XB_XGEN(j)  (2304 + 64 * (j))
#define XB_TOP      3328
#define XB_TOPGEN   3392
#define XCD_BAR_WORDS 3456
#define XB_SPIN_CAP (1u << 18)
__device__ __forceinline__ unsigned xb_ld(unsigned* p)              { return __hip_atomic_load(p, __ATOMIC_RELAXED, __HIP_MEMORY_SCOPE_AGENT); }
__device__ __forceinline__ unsigned xb_add(unsigned* p, unsigned v) { return __hip_atomic_fetch_add(p, v, __ATOMIC_RELAXED, __HIP_MEMORY_SCOPE_AGENT); }
__device__ __forceinline__ unsigned xb_xcc_id() { return (unsigned)__builtin_amdgcn_s_getreg((3 << 11) | 20) & 0xFu; }
#define XB_SPIN(cond, bar) do { unsigned _sp = 0; while (cond) { __builtin_amdgcn_s_sleep(1); \
    if ((++_sp & 255u) == 0u) { if (xb_ld(&(bar)[XB_TMO])) break; if (_sp > XB_SPIN_CAP) { atomicAdd(&(bar)[XB_TMO], 1u); break; } } } } while (0)
struct XcdBarrier { unsigned* bar; unsigned x; volatile LAS unsigned* st; };
__device__ __forceinline__ XcdBarrier xcd_barrier_post(unsigned* bar, volatile LAS unsigned* st, const bool leader) {
    XcdBarrier b; b.bar = bar; b.x = xb_xcc_id(); b.st = st;
    if (leader) (void)xb_add(&bar[XB_XCNT(b.x)], 1u);
    return b;
}
__device__ __forceinline__ void xcd_barrier_complete(unsigned* bar, unsigned x, unsigned& nloc, unsigned& nx) {
    const unsigned G = gridDim.x * gridDim.y * gridDim.z;
    unsigned sum, cnt, mine, sp = 0u;
    for (;;) {
        sum = 0u; cnt = 0u; mine = 0u;
#pragma unroll
        for (unsigned j = 0; j < 16; ++j) { const unsigned c = xb_ld(&bar[XB_XCNT(j)]); sum += c; cnt += (c > 0u) ? 1u : 0u; mine = (j == x) ? c : mine; }
        if (sum == G) break;
        __builtin_amdgcn_s_sleep(1);
        if ((++sp & 255u) == 0u) { if (xb_ld(&bar[XB_TMO])) break; if (sp > XB_SPIN_CAP) { atomicAdd(&bar[XB_TMO], 1u); break; } }
    }
    nloc = mine > 0u ? mine : 1u; nx = cnt > 0u ? cnt : 1u;
}
__device__ __forceinline__ void xcd_barrier(const XcdBarrier& b, const bool leader) {
    asm volatile("s_waitcnt vmcnt(0)" ::: "memory");
    __syncthreads();
    if (leader) {
        unsigned* bar = b.bar;
        __builtin_amdgcn_s_waitcnt(0);
        unsigned nloc = b.st[0], nx = b.st[1];
        if (nloc == 0u) { xcd_barrier_complete(bar, b.x, nloc, nx); b.st[0] = nloc; b.st[1] = nx; }
        const unsigned old = xb_add(&bar[XB_XSUB(b.x)], 1u);
        const unsigned gen = old / nloc;
        if (old + 1u == (gen + 1u) * nloc) {
            __builtin_amdgcn_fence(__ATOMIC_RELEASE, "agent");
            asm volatile("s_waitcnt vmcnt(0)" ::: "memory");
            const unsigned og = xb_add(&bar[XB_TOP], 1u);
            const unsigned tg = og / nx;
            if (og + 1u == (tg + 1u) * nx) xb_add(&bar[XB_TOPGEN], 1u);
            else XB_SPIN(xb_ld(&bar[XB_TOPGEN]) == tg, bar);
            __builtin_amdgcn_fence(__ATOMIC_ACQUIRE, "agent");
            xb_add(&bar[XB_XGEN(b.x)], 1u);
            asm volatile("s_waitcnt vmcnt(0)" ::: "memory");
        } else {
            XB_SPIN(xb_ld(&bar[XB_XGEN(b.x)]) == gen, bar);
            __builtin_amdgcn_fence(__ATOMIC_ACQUIRE, "agent");
            asm volatile("s_waitcnt vmcnt(0)" ::: "memory");
        }
    }
    __syncthreads();
}

struct Args {
    const float* x; const float* c; const float* ctx; const float* c_ctx; const float* w_ada; const float* b_ada; const float* w_in;
    const float* g_q_a; const float* w_q_b; const float* g_kv_a; const float* w_kv_b; const float* g_gq; const float* g_gk; const float* w_o;
    const float* ln1_g; const float* ln1_b; const float* w_rg; const float* b_rg; const float* w_re; const float* b_re;
    const float* w_gate; const float* w_up; const float* w_down; const float* ln2_g; const float* ln2_b;
    float* out; unsigned char* ws;
};

typedef const __attribute__((address_space(4))) Args* KP;
__device__ __forceinline__ Args ldargs(KP p) {
#if defined(__HIP_DEVICE_COMPILE__)
    asm volatile("" : "+s"(p)); return *p;
#else
    return Args{};
#endif
}

struct Ctx {
    LAS unsigned char* lds;
    int tid, lane, wave, vcu, bk;
};

struct Unit { int pm, pn; };
constexpr int BM = 256, NXCD = 8, WGM = 8;
struct StaticOrder {
    int nM, nN, nwg, G, c;
    __device__ __forceinline__ void init(int M, int N, int G_, int c_) { nM = M / BM; nN = N / BM; nwg = nM * nN; G = G_; c = c_; }
    __device__ __forceinline__ bool next(int i, Unit& u) const {
        const long L = (long)i * G + c; if (L >= nwg) return false;
        int wgid = (int)L; { const int q = nwg / NXCD, r = nwg % NXCD, xcd = wgid % NXCD, off = wgid / NXCD; wgid = (xcd < r ? xcd * (q + 1) : r * (q + 1) + (xcd - r) * q) + off; }
        const int nig = WGM * nN, gid = wgid / nig, fm = gid * WGM, gsz = (nM - fm) < WGM ? (nM - fm) : WGM;
        u.pm = fm + ((wgid % nig) % gsz); u.pn = (wgid % nig) / gsz; return true;
    }
    __device__ __forceinline__ void a_ready(const Unit&) const {}
    __device__ __forceinline__ void done(const Unit&) const {}
};
struct GroupedOrder {
    const volatile LAS int* poff; int nunits, G, c;
    __device__ __forceinline__ void init(const volatile LAS int* poff_, int G_, int c_) { poff = poff_; nunits = (poff_[32] >> 8) * 4; G = G_; c = c_; }
    __device__ __forceinline__ bool next(int i, Unit& u) const {
        const int L = i * G + c; if (L >= nunits) return false;
        const int rt = L >> 2, r0 = rt << 8; int e = 0;
#pragma unroll
        for (int j = 1; j < 32; ++j) e += (poff[j] <= r0) ? 1 : 0;
        u.pm = rt; u.pn = e * 4 + (L & 3); return true;
    }
    __device__ __forceinline__ void a_ready(const Unit&) const {}
    __device__ __forceinline__ void done(const Unit&) const {}
};

__device__ __forceinline__ void st_bf4(bf16_t* p, f32x4 v) { u32x2 w; w.x = pk2(v[0], v[1]); w.y = pk2(v[2], v[3]); *(u32x2*)p = w; }
__device__ __forceinline__ void st_bf8(bf16_t* p, f32x4 a, f32x4 b) { u32x4 w; w.x = pk2(a[0], a[1]); w.y = pk2(a[2], a[3]); w.z = pk2(b[0], b[1]); w.w = pk2(b[2], b[3]); *(u32x4*)p = w; }
struct EpiZ {
    static constexpr bool PERM = true;
    bf16_t* Z;
    __device__ __forceinline__ void tile32(int row, int col, int fq, f32x4 v0, f32x4 v1) const { st_bf8(Z + (size_t)row * ZW + col + 8 * fq, v0, v1); }
};
__device__ __forceinline__ float xor32(float v, bool lower) { auto rr = __builtin_amdgcn_permlane32_swap(__float_as_uint(v), __float_as_uint(v), false, false); return __uint_as_float(lower ? rr[1] : rr[0]); }
struct EpiIn {
    static constexpr bool PERM = true, PAIR = true;
    unsigned char* wsb; const LAS float* ggq; const LAS float* ggk; const LAS f32x2* t64l; const LAS f32x2* t32l;
    __device__ __forceinline__ float sum4(float s, int fq) const { s += lane_xor<16>(s); s += xor32(s, fq < 2); return s; }
    __device__ __forceinline__ void za(int row, int col, int fq, f32x4 v0, f32x4 v1) const {
        bf16_t* Z = (bf16_t*)(wsb + WS_Z); float* ssqp = (float*)(wsb + WS_SSQP); bf16_t* Km = (bf16_t*)(wsb + WS_KM); const LAS f32x2* t32 = t32l;
        if (col < 640) {
            st_bf8(Z + (size_t)row * ZW + col + 8 * fq, v0, v1);
            float s = (v0[0] * v0[0] + v0[1] * v0[1]) + (v0[2] * v0[2] + v0[3] * v0[3]) + (v1[0] * v1[0] + v1[1] * v1[1]) + (v1[2] * v1[2] + v1[3] * v1[3]);
            s = sum4(s, fq);
            if (fq == 0) ssqp[(size_t)row * 20 + (col >> 5)] = s;
        } else if (col == 640) {
            float v[8] = {v0[0], v0[1], v0[2], v0[3], v1[0], v1[1], v1[2], v1[3]}, o[8];
#pragma unroll
            for (int e = 0; e < 8; ++e) { const float p = lane_xor<16>(v[e]); o[e] = v[e];
                if (row < TL) { const int s2 = row & 2047, pos = (fq >> 1) ? (s2 & 63) : (s2 >> 6); const f32x2 c = t32[pos * 8 + e]; o[e] = (fq & 1) ? (v[e] * c.x + p * c.y) : (v[e] * c.x - p * c.y); } }
            u32x4 w; w.x = pk2(o[0], o[1]); w.y = pk2(o[2], o[3]); w.z = pk2(o[4], o[5]); w.w = pk2(o[6], o[7]);
            int kb, kj; key_bj(row, kb, kj);
#pragma unroll
            for (int h = 0; h < 8; ++h) *(u32x4*)(Km + ktile_off(8, kb, h, kj, 96, 8 + fq)) = w;
        }
    }
    __device__ __forceinline__ void head(int row, int fq, f32x4 a0, f32x4 a1, f32x4 b0, f32x4 b1, const LAS float* g, float scale, bf16_t* dlo, bf16_t* dhi) const {
        const LAS f32x2* t64 = t64l;
        float lo[8] = {a0[0], a0[1], a0[2], a0[3], a1[0], a1[1], a1[2], a1[3]}, hi[8] = {b0[0], b0[1], b0[2], b0[3], b1[0], b1[1], b1[2], b1[3]};
        float ss = 0.f;
#pragma unroll
        for (int e = 0; e < 8; ++e) ss += lo[e] * lo[e] + hi[e] * hi[e];
        ss = sum4(ss, fq);
        const float rn = __builtin_amdgcn_rsqf(ss * (1.0f / 64.0f) + RMS_EPS) * scale;
        const bool lat = row < TL, lower = fq < 2; const int s2 = row & 2047, gr = s2 >> 6, gc = s2 & 63, f0 = 8 * (fq & 1);
        const LAS f32x4* gp = (const LAS f32x4*)(g + 8 * fq); const f32x4 g0 = gp[0], g1 = gp[1], g2 = gp[8], g3 = gp[9];
        const float gl[8] = {g0[0], g0[1], g0[2], g0[3], g1[0], g1[1], g1[2], g1[3]}, gh[8] = {g2[0], g2[1], g2[2], g2[3], g3[0], g3[1], g3[2], g3[3]};
        float ol[8], oh[8];
        if (lat) {
            const LAS f32x4* tl = (const LAS f32x4*)(t64 + gr * 16 + f0); const LAS f32x4* th = (const LAS f32x4*)(t64 + gc * 16 + f0);
            const f32x4 cl0 = tl[0], cl1 = tl[1], cl2 = tl[2], cl3 = tl[3], ch0 = th[0], ch1 = th[1], ch2 = th[2], ch3 = th[3];
            const float cL[8] = {cl0[0], cl0[2], cl1[0], cl1[2], cl2[0], cl2[2], cl3[0], cl3[2]}, sL[8] = {cl0[1], cl0[3], cl1[1], cl1[3], cl2[1], cl2[3], cl3[1], cl3[3]};
            const float cH[8] = {ch0[0], ch0[2], ch1[0], ch1[2], ch2[0], ch2[2], ch3[0], ch3[2]}, sH[8] = {ch0[1], ch0[3], ch1[1], ch1[3], ch2[1], ch2[3], ch3[1], ch3[3]};
#pragma unroll
            for (int e = 0; e < 8; ++e) {
                const float yl = lo[e] * rn * gl[e], yh = hi[e] * rn * gh[e];
                const float pl = xor32(yl, lower), ph = xor32(yh, lower);
                ol[e] = lower ? (yl * cL[e] - pl * sL[e]) : (yl * cL[e] + pl * sL[e]);
                oh[e] = lower ? (yh * cH[e] - ph * sH[e]) : (yh * cH[e] + ph * sH[e]);
            }
        } else {
#pragma unroll
            for (int e = 0; e < 8; ++e) { ol[e] = lo[e] * rn * gl[e]; oh[e] = hi[e] * rn * gh[e]; }
        }
        u32x4 w; w.x = pk2(ol[0], ol[1]); w.y = pk2(ol[2], ol[3]); w.z = pk2(ol[4], ol[5]); w.w = pk2(ol[6], ol[7]); *(u32x4*)dlo = w;
        w.x = pk2(oh[0], oh[1]); w.y = pk2(oh[2], oh[3]); w.z = pk2(oh[4], oh[5]); w.w = pk2(oh[6], oh[7]); *(u32x4*)dhi = w;
    }
    __device__ __forceinline__ void tile64(int row, int pn, int wc, int fq, f32x4 a0, f32x4 a1, f32x4 b0, f32x4 b1) const {
        if (pn < 3) { const int col = pn * 256 + wc * 32; za(row, col, fq, a0, a1); za(row, col + 128, fq, b0, b1); }
        else if (pn < 5) { const int h = 4 * (pn - 3) + wc; bf16_t* q = (bf16_t*)(wsb + WS_QG) + (size_t)row * 512 + 64 * h + 8 * fq; head(row, fq, a0, a1, b0, b1, ggq, QSCALE_G, q, q + 32); }
        else { int kb, kj; key_bj(row, kb, kj);
            if (wc < 2) { bf16_t* Kg = (bf16_t*)(wsb + WS_KG); head(row, fq, a0, a1, b0, b1, ggk, 1.0f, Kg + ktile_off(2, kb, wc, kj, 64, fq), Kg + ktile_off(2, kb, wc, kj, 64, 4 + fq)); }
            else { bf16_t* Vg = (bf16_t*)(wsb + WS_VG); st_bf8(Vg + vtile_off(2, kb, wc - 2, kj, 8 * fq), a0, a1); st_bf8(Vg + vtile_off(2, kb, wc - 2, kj, 32 + 8 * fq), b0, b1); } }
    }
};
struct EpiQ {
    static constexpr bool PERM = true, PREP = true;
    unsigned char* wsb;
    const LAS f32x2* tab32;
    const LAS float* rsl;
    static __device__ __forceinline__ float rowscale(const unsigned char* wsb_, int row) {
        const float* rstd = (const float*)(wsb_ + WS_SSQP);
        const f32x4* sp = (const f32x4*)(rstd + (size_t)row * 20); const f32x4 s0 = sp[0], s1 = sp[1], s2 = sp[2];
        return QSCALE_M / sqrtf(((s0[0] + s0[1]) + (s0[2] + s0[3]) + (s1[0] + s1[1]) + (s1[2] + s1[3]) + (s2[0] + s2[1]) + (s2[2] + s2[3])) * (1.0f / 384.0f) + RMS_EPS);
    }
    __device__ __forceinline__ void tile32u(int row, int col, int fq, f32x4 v0, f32x4 v1, int ui) const {
        const float rs = rsl[ui * 256 + (row & 255)];
        bf16_t* Qm = (bf16_t*)(wsb + WS_QM);
        const int h = col / 96, gi = (col - h * 96) >> 5;
        v0 = v0 * rs; v1 = v1 * rs;
        bf16_t* base = Qm + (size_t)row * QW + h * 96;
        if (gi < 2) { st_bf8(base + gi * 32 + 8 * fq, v0, v1); }
        else {
            const int part = fq >> 1, f0 = (4 * fq) & 7;
            f32x4 o1 = v0, o2 = v1;
            if (row < TL) {
                const int s = row & 2047, pos = part ? (s & 63) : (s >> 6);
#pragma unroll
                for (int j = 0; j < 4; ++j) { const f32x2 cs = tab32[pos * 8 + f0 + j]; o1[j] = v0[j] * cs.x - v1[j] * cs.y; o2[j] = v1[j] * cs.x + v0[j] * cs.y; }
            }
            bf16_t* p = base + 64 + part * 16 + f0; st_bf4(p, o1); st_bf4(p + 8, o2);
        }
    }
};
struct EpiKV {
    static constexpr bool PERM = true, PREP = true;
    unsigned char* wsb;
    const LAS float* rsl;
    static __device__ __forceinline__ float rowscale(const unsigned char* wsb_, int row) {
        const float* rstd = (const float*)(wsb_ + WS_SSQP);
        const f32x4* sp = (const f32x4*)(rstd + (size_t)row * 20 + 12); const f32x4 s0 = sp[0], s1 = sp[1];
        return 1.0f / sqrtf(((s0[0] + s0[1]) + (s0[2] + s0[3]) + (s1[0] + s1[1]) + (s1[2] + s1[3])) * (1.0f / 256.0f) + RMS_EPS);
    }
    __device__ __forceinline__ void tile32u(int row, int col, int fq, f32x4 v0, f32x4 v1, int ui) const {
        const float rs = rsl[ui * 256 + (row & 255)];
        bf16_t* Km = (bf16_t*)(wsb + WS_KM); bf16_t* Vm = (bf16_t*)(wsb + WS_VM);
        const int h = col >> 7, w = (col & 127) + 8 * fq; int kb, kj; key_bj(row, kb, kj);
        bf16_t* p = (w < 64) ? (Km + ktile_off(8, kb, h, kj, 96, w >> 3)) : (Vm + vtile_off(8, kb, h, kj, w - 64));
        st_bf8(p, v0 * rs, v1 * rs);
    }
};
struct EpiU {
    static constexpr bool PERM = false;
    float* U; const float* xl; const float* xc; const float* mod_l;
    int gate;
    __device__ __forceinline__ void tile32(int row, int col, int fq, f32x4 v0, f32x4 v1) const {
        const float* xr = (row < TL) ? (xl + (size_t)row * D) : (xc + (size_t)(row - TL) * D);
        const float* g = mod_l + (size_t)(bb_of(row) * 6 + gate) * D;
        const int c0 = col + 4 * fq;
        const f32x4 x0 = *(const f32x4*)(xr + c0), x1 = *(const f32x4*)(xr + c0 + 16), g0 = *(const f32x4*)(g + c0), g1 = *(const f32x4*)(g + c0 + 16);
        float* u = U + (size_t)row * D + c0;
        *(f32x4*)u = x0 * ALPHA + g0 * v0; *(f32x4*)(u + 16) = x1 * ALPHA + g1 * v1;
    }
};
__device__ __forceinline__ float silu_f(float x) { return x * __builtin_amdgcn_rcpf(1.0f + __builtin_amdgcn_exp2f(-x * LOG2E)); }
struct EpiAct {
    static constexpr bool PERM = true, PAIR = true;
    bf16_t* Act;
    __device__ __forceinline__ void tile64(int row, int pn, int wc, int fq, f32x4 g0, f32x4 g1, f32x4 u0, f32x4 u1) const {
        const int f0 = 128 * (pn & 3) + 32 * wc + 8 * fq; f32x4 a, b;
#pragma unroll
        for (int j = 0; j < 4; ++j) { a[j] = silu_f(g0[j]) * u0[j]; b[j] = silu_f(g1[j]) * u1[j]; }
        st_bf8(Act + (size_t)row * FF + f0, a, b);
    }
};
struct EpiYo {
    static constexpr bool PERM = true;
    bf16_t* Y;
    __device__ __forceinline__ void tile32(int row, int col, int fq, f32x4 v0, f32x4 v1) const { st_bf8(Y + (size_t)row * D + col + 8 * fq, v0, v1); }
};
struct EpiY {
    static constexpr bool PERM = true;
    bf16_t* Y;
    __device__ __forceinline__ void tile32(int row, int col, int fq, f32x4 v0, f32x4 v1) const { st_bf8(Y + (size_t)row * D + (col & 1023) + 8 * fq, v0, v1); }
};

template <class E, class = void> struct epi_pair { static constexpr bool value = false; };
template <class E> struct epi_pair<E, decltype((void)E::PAIR)> { static constexpr bool value = E::PAIR; };
template <class E, class = void> struct epi_prep { static constexpr bool value = false; };
template <class E> struct epi_prep<E, decltype((void)E::PREP)> { static constexpr bool value = E::PREP; };
struct Gemm { const bf16_t* A; int lda; const bf16_t* Bt; int K; };
__device__ __forceinline__ float dot8(u32x4 a, u32x4 b, float acc) {
#pragma unroll
    for (int i = 0; i < 4; ++i) { acc += bflo(a[i]) * bflo(b[i]); acc += bfhi(a[i]) * bfhi(b[i]); }
    return acc;
}
template <class Sched, class Epi>
__device__ __forceinline__ void gemm_naive(const Ctx& F, const Gemm g, const Sched& S, const Epi& E) {
    Unit u;
    for (int i = 0; S.next(i, u); ++i) {
        for (int task = F.tid; task < 8192; task += NTHREADS) {
            const int lane = task & 63, fr = lane & 15, fq = lane >> 4, rest = task >> 6, rg = rest & 15, cg = rest >> 4;
            const int row = u.pm * 256 + rg * 16 + fr, col = u.pn * 256 + cg * 32;
            const bf16_t* ap = g.A + (size_t)row * g.lda;
            const bf16_t* bp0 = g.Bt + (size_t)(col + 4 * fq) * g.K;
            const bf16_t* bp1 = bp0 + (size_t)16 * g.K;
            f32x4 v0 = {0.f, 0.f, 0.f, 0.f}, v1 = {0.f, 0.f, 0.f, 0.f};
            for (int k = 0; k < g.K; k += 8) {
                const u32x4 a = *(const u32x4*)(ap + k);
#pragma unroll
                for (int j = 0; j < 4; ++j) {
                    v0[j] = dot8(a, *(const u32x4*)(bp0 + (size_t)j * g.K + k), v0[j]);
                    v1[j] = dot8(a, *(const u32x4*)(bp1 + (size_t)j * g.K + k), v1[j]);
                }
            }
            E.tile32(row, col, fq, v0, v1);
        }
    }
}
constexpr int BK = 64, HALF = 128, HTB = HALF * BK * 2, STAGE_BYTES = 8 * HTB;
__device__ __forceinline__ int lds_byte(int r, int c) { const int st = (r >> 4) * 2 + (c >> 5), rr = r & 15, cc = c & 31, ob = rr * 64 + cc * 2; return st * 1024 + (ob ^ (((ob >> 9) & 1) << 5)); }
__device__ __forceinline__ int perm32(int rho) { const int n = rho >> 4, i = rho & 15; return 8 * (i >> 2) + 4 * n + (i & 3); }
__device__ __forceinline__ void stage_rc(int b, int& R, int& C) { const int st = b / 1024, sb = b % 1024, swz = sb ^ (((sb >> 9) & 1) << 5); R = (st >> 1) * 16 + swz / 64; C = (st & 1) * 32 + (swz % 64) / 2; }
template <class Epi, class Sched, bool ALIGN_EPI = true, bool SP2 = true, bool GATHER = false>
__device__ __forceinline__ void gemm_mfma(LAS unsigned char* lds, const int tid_in, const Gemm g, const Sched& S, const Epi& E, const LAS int* gtab = nullptr) {
    int tid = tid_in; asm volatile("" : "+v"(tid));
    const int wid = __builtin_amdgcn_readfirstlane(tid >> 6), lane = tid & 63, wr = wid >> 2, wc = wid & 3, fr = lane & 15, fq = lane >> 4;
    const int K = g.K, nt = K / BK;
    unsigned voffB[2]; int RA[2], CA[2];
#pragma unroll
    for (int i = 0; i < 2; ++i) { int R, C; stage_rc(tid * 16 + i * 8192, R, C); const int Rb = Epi::PERM ? ((R & ~31) + perm32(R & 31)) : R;
        RA[i] = R; CA[i] = C; voffB[i] = (unsigned)(Rb * K + C) * 2u; }
    const size_t kstep = (size_t)(BK * 2);
    const size_t hstepA = (size_t)HALF * g.lda * 2, hstepB = (size_t)HALF * K * 2;
    const size_t tstepA = GATHER ? 0 : 2 * hstepA, tstepB = 2 * hstepB;
    unsigned vc0[2], vc1[2], vn0[2], vn1[2];
#define PG8_GOFF(dst0, dst1, ui_) do { _Pragma("unroll") for (int i_ = 0; i_ < 2; ++i_) { \
        if constexpr (GATHER) { dst0[i_] = (unsigned)gtab[(ui_) * 256 + RA[i_]] * (unsigned)(g.lda * 2) + (unsigned)CA[i_] * 2u; dst1[i_] = (unsigned)gtab[(ui_) * 256 + HALF + RA[i_]] * (unsigned)(g.lda * 2) + (unsigned)CA[i_] * 2u; } \
        else { dst0[i_] = (unsigned)(RA[i_] * g.lda + CA[i_]) * 2u; dst1[i_] = dst0[i_] + (unsigned)hstepA; } } } while (0)
    const unsigned ldsw = (unsigned)wid * 1024u;
    const int aoff = lds_byte(wr * 64 + fr, fq * 8), boff = lds_byte(wc * 32 + fr, fq * 8);
#define PG8_SA(b, h) (((b) * 2 + (h)) * HTB)
#define PG8_SB(b, h) ((4 + (b) * 2 + (h)) * HTB)
#define PG8_STAGE(bufoff, gbase, voff) do { _Pragma("unroll") for (int _i = 0; _i < 2; ++_i) \
        __builtin_amdgcn_global_load_lds((const unsigned*)((const char*)(gbase) + (voff)[_i]), (LAS unsigned*)(lds + (bufoff) + ldsw + _i * 8192), 16, 0, 0); } while (0)
#define PG8_LDA(dst, b, h) do { _Pragma("unroll") for (int m = 0; m < 4; ++m) _Pragma("unroll") for (int k = 0; k < 2; ++k) dst[m][k] = *(const LAS bf16x8*)(lds + PG8_SA(b, h) + aoff + m * 2048 + k * 1024); } while (0)
#define PG8_LDB(dst, b, h) do { _Pragma("unroll") for (int n = 0; n < 2; ++n) _Pragma("unroll") for (int k = 0; k < 2; ++k) dst[n][k] = *(const LAS bf16x8*)(lds + PG8_SB(b, h) + boff + n * 2048 + k * 1024); } while (0)
#define PG8_MMA(ai, bj, At, Bt) do { __builtin_amdgcn_s_setprio(1); _Pragma("unroll") for (int m = 0; m < 4; ++m) _Pragma("unroll") for (int n = 0; n < 2; ++n) _Pragma("unroll") for (int k = 0; k < 2; ++k) \
        acc[ai][bj][m][n] = __builtin_amdgcn_mfma_f32_16x16x32_bf16(Bt[n][k], At[m][k], acc[ai][bj][m][n], 0, 0, 0); __builtin_amdgcn_s_setprio(0); } while (0)
#define PG8_WAIT_V(n) asm volatile("s_waitcnt vmcnt(" #n ")" ::: "memory")
#define PG8_WAIT_L(n) asm volatile("s_waitcnt lgkmcnt(" #n ")" ::: "memory")
#define PG8_BAR __builtin_amdgcn_s_barrier()
#define PG8_SCHED __builtin_amdgcn_sched_barrier(0)
    Unit cur, nxt; int ui = 0;
    if (!S.next(0, cur)) return;
    PG8_GOFF(vc0, vc1, 0);
#pragma unroll
    for (int i = 0; i < 2; ++i) { vn0[i] = vc0[i]; vn1[i] = vc1[i]; }
    f32x4 acc[2][2][4][2];
#pragma unroll
    for (int a = 0; a < 2; ++a)
#pragma unroll
        for (int b = 0; b < 2; ++b)
#pragma unroll
            for (int m = 0; m < 4; ++m)
#pragma unroll
                for (int n = 0; n < 2; ++n) acc[a][b][m][n] = (f32x4){0.f, 0.f, 0.f, 0.f};
    bf16x8 At[4][2], B0[2][2], B1[2][2];
    const char* cA = (const char*)g.A + (size_t)cur.pm * tstepA; const char* cB = (const char*)g.Bt + (size_t)cur.pn * tstepB;
    S.a_ready(cur);
    if constexpr (SP2) {
        PG8_STAGE(PG8_SB(0, 0), cB, voffB); PG8_STAGE(PG8_SB(0, 1), cB + hstepB, voffB); PG8_STAGE(PG8_SA(0, 0), cA, vc0); PG8_STAGE(PG8_SA(0, 1), cA, vc1);
        if (wr == 1) PG8_BAR;
        PG8_WAIT_V(2); PG8_BAR;
        PG8_STAGE(PG8_SB(1, 0), cB + kstep, voffB); PG8_STAGE(PG8_SA(1, 0), cA + kstep, vc0); PG8_STAGE(PG8_SB(1, 1), cB + hstepB + kstep, voffB);
        PG8_WAIT_V(6); PG8_BAR;
    } else {
        PG8_STAGE(PG8_SB(0, 0), cB, voffB); PG8_STAGE(PG8_SA(0, 0), cA, vc0); PG8_STAGE(PG8_SB(0, 1), cB + hstepB, voffB); PG8_STAGE(PG8_SA(0, 1), cA, vc1);
        if (wr == 1) PG8_BAR;
        PG8_WAIT_V(4); PG8_BAR;
        PG8_STAGE(PG8_SB(1, 0), cB + kstep, voffB); PG8_STAGE(PG8_SA(1, 0), cA + kstep, vc0); PG8_STAGE(PG8_SB(1, 1), cB + hstepB + kstep, voffB);
        PG8_WAIT_V(6); PG8_BAR;
    }
    for (;;) {
        const bool has_next = S.next(ui + 1, nxt);
        if constexpr (GATHER) { if (has_next) { PG8_GOFF(vn0, vn1, ui + 1); } else {
#pragma unroll
            for (int i = 0; i < 2; ++i) { vn0[i] = vc0[i]; vn1[i] = vc1[i]; } } }
        const char* nA = has_next ? (const char*)g.A + (size_t)nxt.pm * tstepA : cA; const char* nB = has_next ? (const char*)g.Bt + (size_t)nxt.pn * tstepB : cB;
#pragma unroll 1
        for (int t = 0; t < nt; t += 2) {
            const bool last = (t == nt - 2);
            const char* a1 = cA + (size_t)(t + 1) * kstep;
            const char* a2 = last ? nA : cA + (size_t)(t + 2) * kstep; const char* b2 = last ? nB : cB + (size_t)(t + 2) * kstep;
            const char* a3 = a2 + kstep; const char* b3 = b2 + kstep;
            unsigned s0[2], s1[2];
#pragma unroll
            for (int i = 0; i < 2; ++i) { if constexpr (GATHER) { s0[i] = last ? vn0[i] : vc0[i]; s1[i] = last ? vn1[i] : vc1[i]; } else { s0[i] = vc0[i]; s1[i] = vc1[i]; } }
            if (last && has_next) S.a_ready(nxt);
            if constexpr (SP2) {
            PG8_LDB(B0, 0, 0); PG8_LDB(B1, 0, 1); PG8_SCHED; PG8_LDA(At, 0, 0); PG8_STAGE(PG8_SA(1, 1), a1, vc1);
            PG8_WAIT_V(8); PG8_WAIT_L(0); PG8_BAR; PG8_MMA(0, 0, At, B0); PG8_MMA(0, 1, At, B1); PG8_BAR; PG8_SCHED;
            PG8_LDA(At, 0, 1); PG8_STAGE(PG8_SB(0, 0), b2, voffB); PG8_STAGE(PG8_SB(0, 1), b2 + hstepB, voffB); PG8_STAGE(PG8_SA(0, 0), a2, s0);
            PG8_WAIT_V(8); PG8_WAIT_L(0); PG8_BAR; PG8_MMA(1, 0, At, B0); PG8_MMA(1, 1, At, B1); PG8_BAR; PG8_SCHED;
            PG8_LDB(B0, 1, 0); PG8_LDB(B1, 1, 1); PG8_SCHED; PG8_LDA(At, 1, 0); PG8_STAGE(PG8_SA(0, 1), a2, s1);
            PG8_WAIT_V(8); PG8_WAIT_L(0); PG8_BAR; PG8_MMA(0, 0, At, B0); PG8_MMA(0, 1, At, B1); PG8_BAR; PG8_SCHED;
            PG8_LDA(At, 1, 1); PG8_STAGE(PG8_SB(1, 0), b3, voffB); PG8_STAGE(PG8_SB(1, 1), b3 + hstepB, voffB); PG8_STAGE(PG8_SA(1, 0), a3, s0);
            PG8_WAIT_V(8); PG8_WAIT_L(0); PG8_BAR; PG8_MMA(1, 0, At, B0); PG8_MMA(1, 1, At, B1); PG8_BAR; PG8_SCHED;
            } else {
            PG8_LDB(B0, 0, 0); PG8_SCHED; PG8_LDA(At, 0, 0); PG8_STAGE(PG8_SA(1, 1), a1, vc1);
            PG8_WAIT_L(8); PG8_BAR; PG8_WAIT_L(0); PG8_MMA(0, 0, At, B0); PG8_BAR; PG8_SCHED;
            PG8_LDB(B1, 0, 1); PG8_STAGE(PG8_SB(0, 0), b2, voffB);
            PG8_BAR; PG8_WAIT_L(0); PG8_MMA(0, 1, At, B1); PG8_BAR;
            PG8_LDA(At, 0, 1); PG8_STAGE(PG8_SA(0, 0), a2, s0);
            PG8_BAR; PG8_WAIT_L(0); PG8_MMA(1, 0, At, B0); PG8_BAR; PG8_SCHED;
            PG8_STAGE(PG8_SB(0, 1), b2 + hstepB, voffB);
            PG8_WAIT_V(6); PG8_BAR; PG8_MMA(1, 1, At, B1); PG8_BAR;
            PG8_LDB(B0, 1, 0); PG8_SCHED; PG8_LDA(At, 1, 0); PG8_STAGE(PG8_SA(0, 1), a2, s1);
            PG8_WAIT_L(8); PG8_BAR; PG8_WAIT_L(0); PG8_MMA(0, 0, At, B0); PG8_BAR; PG8_SCHED;
            PG8_LDB(B1, 1, 1); PG8_STAGE(PG8_SB(1, 0), b3, voffB);
            PG8_BAR; PG8_WAIT_L(0); PG8_MMA(0, 1, At, B1); PG8_BAR;
            PG8_LDA(At, 1, 1); PG8_STAGE(PG8_SA(1, 0), a3, s0);
            PG8_BAR; PG8_WAIT_L(0); PG8_MMA(1, 0, At, B0); PG8_BAR; PG8_SCHED;
            PG8_STAGE(PG8_SB(1, 1), b3 + hstepB, voffB);
            PG8_WAIT_V(6); PG8_BAR; PG8_MMA(1, 1, At, B1); PG8_BAR;
            }
        }
        if constexpr (ALIGN_EPI) { if (wr == 0) PG8_BAR; }
        {
            int ln_e; asm volatile("v_mbcnt_lo_u32_b32 %0, -1, 0\n\tv_mbcnt_hi_u32_b32 %0, -1, %0" : "=v"(ln_e));
            const int fr_e = ln_e & 15, fq_e = ln_e >> 4;
            int pm_e = __builtin_amdgcn_readfirstlane(cur.pm), pn_e = __builtin_amdgcn_readfirstlane(cur.pn), wr_e = __builtin_amdgcn_readfirstlane(wr), wc_e = __builtin_amdgcn_readfirstlane(wc); asm volatile("" : "+s"(pm_e), "+s"(pn_e), "+s"(wr_e), "+s"(wc_e));
#pragma unroll
            for (int ai = 0; ai < 2; ++ai)
#pragma unroll
                for (int m = 0; m < 4; ++m) {
                    if constexpr (epi_pair<Epi>::value) E.tile64(pm_e * BM + ai * HALF + wr_e * 64 + m * 16 + fr_e, pn_e, wc_e, fq_e, acc[ai][0][m][0], acc[ai][0][m][1], acc[ai][1][m][0], acc[ai][1][m][1]);
                    else {
#pragma unroll
                    for (int bj = 0; bj < 2; ++bj) {
                        if constexpr (epi_prep<Epi>::value) E.tile32u(pm_e * BM + ai * HALF + wr_e * 64 + m * 16 + fr_e, pn_e * BM + bj * HALF + wc_e * 32, fq_e, acc[ai][bj][m][0], acc[ai][bj][m][1], ui);
                        else E.tile32(pm_e * BM + ai * HALF + wr_e * 64 + m * 16 + fr_e, pn_e * BM + bj * HALF + wc_e * 32, fq_e, acc[ai][bj][m][0], acc[ai][bj][m][1]); }
                    }
                    asm volatile("" ::: "memory");
                }
            S.done(cur);
        }
        if (!has_next) break;
#pragma unroll
        for (int a = 0; a < 2; ++a)
#pragma unroll
            for (int b = 0; b < 2; ++b)
#pragma unroll
                for (int m = 0; m < 4; ++m)
#pragma unroll
                    for (int n = 0; n < 2; ++n) acc[a][b][m][n] = (f32x4){0.f, 0.f, 0.f, 0.f};
        cur = nxt; cA = nA; cB = nB; ++ui;
        if constexpr (GATHER) {
#pragma unroll
            for (int i = 0; i < 2; ++i) { vc0[i] = vn0[i]; vc1[i] = vn1[i]; } }
        if constexpr (ALIGN_EPI) { if (wr == 1) PG8_BAR; }
    }
    PG8_WAIT_V(0);
    if constexpr (!ALIGN_EPI) { if (wr == 0) PG8_BAR; }
    PG8_BAR;
#undef PG8_GOFF
#undef PG8_SA
#undef PG8_SB
#undef PG8_STAGE
#undef PG8_LDA
#undef PG8_LDB
#undef PG8_MMA
#undef PG8_WAIT_V
#undef PG8_WAIT_L
#undef PG8_BAR
#undef PG8_SCHED
}

#ifndef REP_GEMM_MASK
#define REP_GEMM_MASK 0
#endif
template <int ID, class Sched, class Epi>
__device__ __forceinline__ void gemm_phase_gather(const Ctx& F, const Gemm g, const Sched& S, const Epi& E, const LAS int* gtab) {
    gemm_mfma<Epi, Sched, true, true, true>(F.lds, F.tid, g, S, E, gtab);
    if constexpr ((REP_GEMM_MASK >> ID) & 1) gemm_mfma<Epi, Sched, true, true, true>(F.lds, F.tid, g, S, E, gtab);
}
template <int ID, class Sched, class Epi>
__device__ __forceinline__ void gemm_phase(const Ctx& F, const Gemm g, const Sched& S, const Epi& E) {
#if USE_MFMA_GEMM
    gemm_mfma<Epi, Sched, true, true>(F.lds, F.tid, g, S, E);
    if constexpr ((REP_GEMM_MASK >> ID) & 1) gemm_mfma<Epi, Sched, true, true>(F.lds, F.tid, g, S, E);
#else
    gemm_naive(F, g, S, E);
#endif
}

template <class ColPtr>
__device__ __forceinline__ void tconv_tile(const ColPtr& cp, int ldw, const float* scale, bf16_t* WT, int K, int k0, int p0, LAS float* scr, int lane) {
    const int pc = (lane & 15) * 4, kq = lane >> 4;
    const float* src = cp(p0 + pc);
#pragma unroll 4
    for (int i = 0; i < 16; ++i) {
        const int kk = 4 * i + kq;
        f32x4 v = {0.f, 0.f, 0.f, 0.f};
        if (src) { v = __builtin_nontemporal_load((const f32x4*)(src + (size_t)(k0 + kk) * ldw)); if (scale) v = v * scale[k0 + kk]; }
        LAS float* d = scr + kk * 65 + pc; d[0] = v[0]; d[1] = v[1]; d[2] = v[2]; d[3] = v[3];
    }
    LDS_WAIT();
    const int c = lane & 7;
#pragma unroll
    for (int j = 0; j < 8; ++j) {
        const int n = (lane >> 3) + 8 * j; const LAS float* s = scr + (8 * c) * 65 + n;
        u32x4 o; o.x = pk2(s[0], s[65]); o.y = pk2(s[2 * 65], s[3 * 65]); o.z = pk2(s[4 * 65], s[5 * 65]); o.w = pk2(s[6 * 65], s[7 * 65]);
        *(u32x4*)(WT + (size_t)(p0 + n) * K + k0 + 8 * c) = o;
    }
    LDS_WAIT();
}
struct CpPlain { const float* W; int ncols; __device__ __forceinline__ const float* operator()(int p) const { return p < ncols ? W + p : nullptr; } };
struct CpIn {
    const float* W;
    __device__ __forceinline__ const float* operator()(int p) const {
        if (p < 672) return W + p;
        if (p < 768) return nullptr;
        const int w = p & 31;
        if (p < 1280) { const int q = p - 768, t = q >> 8, g = (q & 255) >> 5; return W + 672 + 64 * (4 * t + (g & 3)) + 32 * (g >> 2) + w; }
        const int g = (p - 1280) >> 5, half = g >> 2, slot = g & 3;
        return W + ((slot < 2) ? (1184 + 64 * slot) : (1312 + 64 * (slot - 2))) + 32 * half + w;
    }
};
#if FUSE_SPLIT
typedef CpIn CpInSel;
#else
struct CpInSel { const float* W; __device__ __forceinline__ const float* operator()(int p) const { return p < 1440 ? W + p : nullptr; } };
#endif
struct CpQ {
    const float* W;
    __device__ __forceinline__ const float* operator()(int p) const {
        const int h = p / 96, pp = p - h * 96; int lc = pp;
        if (pp >= 64) { const int rp = pp - 64, q = rp >> 3, r = rp & 7, i = 4 * q + (r & 3); lc = 64 + (i >> 3) * 16 + (i & 7) + ((r >> 2) ? 8 : 0); }
        return W + h * 96 + lc;
    }
};
struct CpGU {
    const float* Wg; const float* Wu;
    __device__ __forceinline__ const float* operator()(int p) const { const int g = (p >> 5) & 7, ff = 128 * (p >> 8) + 32 * (g & 3) + (p & 31); return (g < 4) ? (Wg + ff) : (Wu + ff); }
};

constexpr int CONV_ITEMS = NEXP * 256 + NEXP * 128, CONV_CH = 4, CONV_CTR0 = 8192;
struct ConvSrc { const float* p; size_t ld; bf16_t* dst; int K; };
__device__ __forceinline__ ConvSrc conv_decode(const Args& a, int l, int idx, int lane) {
    const int pc = (lane & 15) * 4, kh = lane >> 4; ConvSrc r;
    if (idx < NEXP * 256) { const int e = idx >> 8, q = idx & 255, k0 = (q >> 4) * 64, p = (q & 15) * 64 + pc, g = (p >> 5) & 7, ff = 128 * (p >> 8) + 32 * (g & 3) + (p & 31); const size_t le = (size_t)l * NEXP + e;
        r.p = ((g < 4) ? (a.w_gate + le * D * FF + ff) : (a.w_up + le * D * FF + ff)) + (size_t)(k0 + 16 * kh) * FF; r.ld = FF;
        r.dst = (bf16_t*)(a.ws + WS_WGU) + le * 1024 * D + (size_t)((q & 15) * 64 + pc) * D + k0 + 16 * kh; r.K = D; }
    else { const int i2 = idx - NEXP * 256, e = i2 >> 7, q = i2 & 127, k0 = (q >> 4) * 64, p0 = (q & 15) * 64; const size_t le = (size_t)l * NEXP + e;
        r.p = a.w_down + le * FF * D + (size_t)(k0 + 16 * kh) * D + p0 + pc; r.ld = D;
        r.dst = (bf16_t*)(a.ws + WS_WD) + le * D * FF + (size_t)(p0 + pc) * FF + k0 + 16 * kh; r.K = FF; }
    return r;
}
__device__ __forceinline__ void conv_load(const ConvSrc& c, f32x4 (&v)[16]) {
#pragma unroll
    for (int i = 0; i < 16; ++i) v[i] = __builtin_nontemporal_load((const f32x4*)(c.p + (size_t)i * c.ld));
}
__device__ __forceinline__ void conv_store(const ConvSrc& c, const f32x4 (&v)[16]) {
#pragma unroll
    for (int nn = 0; nn < 4; ++nn) {
        u32x4 o0, o1;
        o0.x = pk2(v[0][nn], v[1][nn]); o0.y = pk2(v[2][nn], v[3][nn]); o0.z = pk2(v[4][nn], v[5][nn]); o0.w = pk2(v[6][nn], v[7][nn]);
        o1.x = pk2(v[8][nn], v[9][nn]); o1.y = pk2(v[10][nn], v[11][nn]); o1.z = pk2(v[12][nn], v[13][nn]); o1.w = pk2(v[14][nn], v[15][nn]);
        *(u32x4*)(c.dst + (size_t)nn * c.K) = o0; *(u32x4*)(c.dst + (size_t)nn * c.K + 8) = o1;
    }
}
__device__ __forceinline__ void conv_experts(const int lane, const int wave, const int vcu, const Args& a, int l) {
    const int base = (vcu * NWAVES + wave) * (CONV_ITEMS / (GRID * NWAVES));
    static_assert(CONV_ITEMS % (GRID * NWAVES) == 0 && CONV_ITEMS / (GRID * NWAVES) == 6, "6 tiles per wave");
    f32x4 va[16], vb[16], vc[16];
    ConvSrc c0 = conv_decode(a, l, base, lane), c1 = conv_decode(a, l, base + 1, lane), c2 = conv_decode(a, l, base + 2, lane);
    ConvSrc c3 = conv_decode(a, l, base + 3, lane), c4 = conv_decode(a, l, base + 4, lane), c5 = conv_decode(a, l, base + 5, lane);
    conv_load(c0, va); conv_load(c1, vb); conv_load(c2, vc);
    conv_store(c0, va); conv_load(c3, va);
    conv_store(c1, vb); conv_load(c4, vb);
    conv_store(c2, vc); conv_load(c5, vc);
    conv_store(c3, va); conv_store(c4, vb); conv_store(c5, vc);
}
__device__ __forceinline__ void prologue1(const Ctx& F, KP kp) {
    const Args a = ldargs(kp);
    unsigned char* ws = a.ws;
    {
        LAS float* sl = (LAS float*)F.lds;
        float* modp = (float*)(ws + WS_MODP);
        for (int it = F.bk; it < NL * 12 * 4; it += GRID) {
            const int kc = it & 3, nc = (it >> 2) % 12, l = it / 48;
            __syncthreads();
            for (int idx = F.tid; idx < 17 * 256; idx += NTHREADS) {
                const int bb = idx >> 8, k = idx & 255; const float v = (bb < 16) ? a.c[bb * D + kc * 256 + k] : a.c_ctx[kc * 256 + k];
                sl[idx] = v / (1.0f + __expf(-v));
            }
            __syncthreads();
            const int n = nc * 512 + F.tid;
            const float* w = a.w_ada + ((size_t)l * D + kc * 256) * 6144 + n;
            float acc[17];
#pragma unroll
            for (int bb = 0; bb < 17; ++bb) acc[bb] = 0.f;
            for (int k = 0; k < 256; ++k) {
                const float wv = __builtin_nontemporal_load(w + (size_t)k * 6144);
#pragma unroll
                for (int bb = 0; bb < 17; ++bb) acc[bb] += sl[bb * 256 + k] * wv;
            }
#pragma unroll
            for (int bb = 0; bb < 17; ++bb) modp[((size_t)(kc * NL + l) * 17 + bb) * 6144 + n] = acc[bb];
        }
        __syncthreads();
    }
    {
        f32x2* t64 = (f32x2*)(ws + WS_TAB64); f32x2* t32 = (f32x2*)(ws + WS_TAB32);
        const int gt = F.bk * NTHREADS + F.tid;
        if (gt < 64 * 16) { const int pos = gt >> 4, f = gt & 15; const float inv = powf(10000.0f, -((float)(2 * f) / 32.0f)); const float ang = (float)pos * inv; t64[gt] = (f32x2){cosf(ang), sinf(ang)}; }
        else if (gt < 64 * 16 + 64 * 8) { const int g2 = gt - 64 * 16, pos = g2 >> 3, f = g2 & 7; const float inv = powf(10000.0f, -((float)(2 * f) / 16.0f)); const float ang = (float)pos * inv; t32[g2] = (f32x2){cosf(ang), sinf(ang)}; }
    }
    {
        bf16_t* wr = (bf16_t*)(ws + WS_WR);
        for (int i = F.bk * NTHREADS + F.tid; i < NL * 48 * D; i += GRID * NTHREADS) {
            const int c = i & 1023, j = (i >> 10) % 48, l = i / (48 * D);
            float wv = 0.f;
            if (j < 4) wv = a.w_rg[((size_t)l * D + c) * 4 + j]; else if (j < 36) wv = a.w_re[((size_t)l * D + c) * 32 + (j - 4)];
            const unsigned h = f2bf(wv); const float rem = wv - __builtin_bit_cast(float, h << 16);
            wr[((size_t)(l * 2 + 0) * 48 + j) * D + c] = (bf16_t)h; wr[((size_t)(l * 2 + 1) * 48 + j) * D + c] = (bf16_t)f2bf(rem);
        }
    }
    {
        LAS float* scr = (LAS float*)(F.lds + F.wave * 18432);
        const int gw = F.vcu * NWAVES + F.wave, NGW = GRID * NWAVES;
        constexpr int I_IN = 16 * 24, I_Q = 6 * 12, I_KV = 4 * 16, I_O = 16 * 16, I_GU = 16 * 16, I_D = 8 * 16;
        constexpr int N_SMALL = NL * (I_IN + I_Q + I_KV + I_O), N_GU = NL * NEXP * I_GU, N_D = NL * NEXP * I_D;
        for (int it = gw; it < N_SMALL; it += NGW) {
            {
                const int l = it / (I_IN + I_Q + I_KV + I_O); int r = it % (I_IN + I_Q + I_KV + I_O);
                if (r < I_IN) { const int kt = r / 24, pt = r % 24; tconv_tile(CpInSel{a.w_in + (size_t)l * D * 1440}, 1440, nullptr, (bf16_t*)(ws + WS_WIN) + (size_t)l * ZW * D, D, kt * 64, pt * 64, scr, F.lane); continue; }
                r -= I_IN;
                if (r < I_Q) { const int kt = r / 12, pt = r % 12; tconv_tile(CpQ{a.w_q_b + (size_t)l * 384 * QW}, QW, a.g_q_a + l * 384, (bf16_t*)(ws + WS_WQ) + (size_t)l * QW * 384, 384, kt * 64, pt * 64, scr, F.lane); continue; }
                r -= I_Q;
                if (r < I_KV) { const int kt = r / 16, pt = r % 16; tconv_tile(CpPlain{a.w_kv_b + (size_t)l * 256 * KVW, KVW}, KVW, a.g_kv_a + l * 256, (bf16_t*)(ws + WS_WKV) + (size_t)l * KVW * 256, 256, kt * 64, pt * 64, scr, F.lane); continue; }
                r -= I_KV;
                { const int kt = r / 16, pt = r % 16; tconv_tile(CpPlain{a.w_o + (size_t)l * D * D, D}, D, nullptr, (bf16_t*)(ws + WS_WO) + (size_t)l * D * D, D, kt * 64, pt * 64, scr, F.lane); }
            }
        }
    }
}

__device__ __forceinline__ void prologue2(const Ctx& F, KP kp) {
    const Args a = ldargs(kp);
    const float* modp = (const float*)(a.ws + WS_MODP); float* mod = (float*)(a.ws + WS_MOD);
    constexpr int NE = NL * 17 * 6144 / 4;
    for (int i = F.bk * NTHREADS + F.tid; i < NE; i += GRID * NTHREADS) {
        const int e = i * 4, l = e / (17 * 6144), n = e % 6144;
        f32x4 s = *(const f32x4*)(a.b_ada + l * 6144 + n);
#pragma unroll
        for (int kc = 0; kc < 4; ++kc) s = s + *(const f32x4*)(modp + (size_t)kc * NL * 17 * 6144 + e);
        *(f32x4*)(mod + e) = s;
    }
}

__device__ __forceinline__ void row_load(const float* p, int lane, f32x4 (&v)[4]) {
#pragma unroll
    for (int j = 0; j < 4; ++j) v[j] = *(const f32x4*)(p + 4 * lane + 256 * j);
}
__device__ __forceinline__ void row_ln(f32x4 (&v)[4], const float* g, const float* b, int lane) {
    float s = 0.f;
#pragma unroll
    for (int j = 0; j < 4; ++j) s += (v[j][0] + v[j][1]) + (v[j][2] + v[j][3]);
    const float mean = wave_sum(s) * (1.0f / D); float q = 0.f;
#pragma unroll
    for (int j = 0; j < 4; ++j) { v[j] = v[j] - mean; q += (v[j][0] * v[j][0] + v[j][1] * v[j][1]) + (v[j][2] * v[j][2] + v[j][3] * v[j][3]); }
    const float rstd = 1.0f / sqrtf(wave_sum(q) * (1.0f / D) + LN_EPS);
#pragma unroll
    for (int j = 0; j < 4; ++j) { const f32x4 gg = *(const f32x4*)(g + 4 * lane + 256 * j), bv = *(const f32x4*)(b + 4 * lane + 256 * j); v[j] = v[j] * rstd * gg + bv; }
}
__device__ __forceinline__ void row_ln_reg(f32x4 (&v)[4], const f32x4 (&g)[4], const f32x4 (&b)[4]) {
    float s = 0.f;
#pragma unroll
    for (int j = 0; j < 4; ++j) s += (v[j][0] + v[j][1]) + (v[j][2] + v[j][3]);
    const float mean = wave_sum(s) * (1.0f / D); float q = 0.f;
#pragma unroll
    for (int j = 0; j < 4; ++j) { v[j] = v[j] - mean; q += (v[j][0] * v[j][0] + v[j][1] * v[j][1]) + (v[j][2] * v[j][2] + v[j][3] * v[j][3]); }
    const float rstd = 1.0f / sqrtf(wave_sum(q) * (1.0f / D) + LN_EPS);
#pragma unroll
    for (int j = 0; j < 4; ++j) v[j] = v[j] * rstd * g[j] + b[j];
}
__device__ __forceinline__ void row_store_mod_bf16(bf16_t* hrow, const f32x4 (&v)[4], const float* sh, const float* sc, int lane) {
#pragma unroll
    for (int j = 0; j < 4; ++j) {
        const f32x4 s1 = *(const f32x4*)(sc + 4 * lane + 256 * j), s0 = *(const f32x4*)(sh + 4 * lane + 256 * j);
        const f32x4 h = v[j] * (s1 + 1.0f) + s0;
        st_bf4(hrow + 4 * lane + 256 * j, h);
    }
}

__device__ __forceinline__ void prologue3(const Ctx& F, KP kp) {
    const Args a = ldargs(kp);
    const float* modp = (const float*)(a.ws + WS_MODP); bf16_t* H = (bf16_t*)(a.ws + WS_H);
    const int gw = F.vcu * NWAVES + F.wave, NGW = GRID * NWAVES;
    for (int r = gw; r < MT; r += NGW) {
        const float* xr = (r < TL) ? (a.x + (size_t)r * D) : (a.ctx + (size_t)(r - TL) * D);
        const int bb = bb_of(r);
        f32x4 v[4]; row_load(xr, F.lane, v);
#pragma unroll
        for (int j = 0; j < 4; ++j) {
            const int c = 4 * F.lane + 256 * j;
            f32x4 sh = *(const f32x4*)(a.b_ada + c), sc = *(const f32x4*)(a.b_ada + 1024 + c);
#pragma unroll
            for (int kc = 0; kc < 4; ++kc) { const float* mp = modp + ((size_t)(kc * NL + 0) * 17 + bb) * 6144; sh = sh + *(const f32x4*)(mp + c); sc = sc + *(const f32x4*)(mp + 1024 + c); }
            st_bf4(H + (size_t)r * D + c, v[j] * (sc + 1.0f) + sh);
        }
    }
}

__device__ __forceinline__ void unpack8(const u32x4 w, float (&v)[8]) { v[0] = bflo(w.x); v[1] = bfhi(w.x); v[2] = bflo(w.y); v[3] = bfhi(w.y); v[4] = bflo(w.z); v[5] = bfhi(w.z); v[6] = bflo(w.w); v[7] = bfhi(w.w); }
__device__ __forceinline__ u32x4 pack8(const float (&v)[8]) { u32x4 w; w.x = pk2(v[0], v[1]); w.y = pk2(v[2], v[3]); w.z = pk2(v[4], v[5]); w.w = pk2(v[6], v[7]); return w; }
__device__ __forceinline__ u32x4 head64_norm_rope(const u32x4 raw, const float (&g)[8], const LAS f32x2* t64, bool lat, int gr, int gc, int w8, float scale) {
    float v[8]; unpack8(raw, v);
    float ss = 0.f;
#pragma unroll
    for (int e = 0; e < 8; ++e) ss += v[e] * v[e];
    ss += lane_xor<1>(ss); ss += lane_xor<2>(ss); ss += lane_xor<4>(ss);
    const float rn = 1.0f / sqrtf(ss * (1.0f / 64.0f) + RMS_EPS);
    float y[8], p[8], o[8];
#pragma unroll
    for (int e = 0; e < 8; ++e) { y[e] = v[e] * rn * g[e]; p[e] = lane_xor<2>(y[e]); o[e] = y[e]; }
    if (lat) {
        const int pos = (w8 >> 2) ? gc : gr; const LAS f32x2* cs = t64 + pos * 16 + 8 * (w8 & 1); const bool x2 = (w8 & 2) != 0;
#pragma unroll
        for (int e = 0; e < 8; ++e) { const f32x2 c = cs[e]; o[e] = x2 ? (y[e] * c.x + p[e] * c.y) : (y[e] * c.x - p[e] * c.y); }
    }
#pragma unroll
    for (int e = 0; e < 8; ++e) o[e] *= scale;
    return pack8(o);
}
__device__ __forceinline__ void phase_split(const Ctx& F, KP kp, int l) {
    const Args a = ldargs(kp);
    unsigned char* ws = a.ws;
    const bf16_t* Z = (const bf16_t*)(ws + WS_Z);
    float* rstdq = (float*)(ws + WS_RSTDQ); float* rstdkv = (float*)(ws + WS_RSTDKV);
    bf16_t* Km = (bf16_t*)(ws + WS_KM); bf16_t* Qg = (bf16_t*)(ws + WS_QG); bf16_t* Kg = (bf16_t*)(ws + WS_KG); bf16_t* Vg = (bf16_t*)(ws + WS_VG);
    LAS f32x2* t64 = (LAS f32x2*)(F.lds + 65536); LAS f32x2* t32 = (LAS f32x2*)(F.lds + 65536 + 8192);
    __syncthreads();
    for (int i = F.tid; i < 64 * 16; i += NTHREADS) t64[i] = ((const f32x2*)(ws + WS_TAB64))[i];
    if (F.tid < 64 * 8) t32[F.tid] = ((const f32x2*)(ws + WS_TAB32))[F.tid];
    __syncthreads();
    const int lane = F.lane, gw = F.vcu * NWAVES + F.wave, NGW = GRID * NWAVES, w8 = lane & 7;
    float ggq[8], ggk[8];
#pragma unroll
    for (int e = 0; e < 8; ++e) { ggq[e] = a.g_gq[l * 64 + 8 * w8 + e]; ggk[e] = a.g_gk[l * 64 + 8 * w8 + e]; }
    const int offA2 = 8 * (64 + (lane & 15)), offB = 672 + 8 * lane;
    const int offC = (lane < 4) ? (640 + 8 * lane) : (lane >= 8 && lane < 24) ? (1184 + 8 * (lane - 8)) : (lane >= 24 && lane < 40) ? (1312 + 8 * (lane - 24)) : 0;
    u32x4 nA1, nA2, nB, nC;
#define P2_LOAD(rr) do { const bf16_t* zr_ = Z + (size_t)(rr) * ZW; nA1 = *(const u32x4*)(zr_ + 8 * lane); nA2 = *(const u32x4*)(zr_ + offA2); nB = *(const u32x4*)(zr_ + offB); nC = *(const u32x4*)(zr_ + offC); } while (0)
    if (gw < MT) P2_LOAD(gw);
    for (int r = gw; r < MT; r += NGW) {
        const u32x4 A1 = nA1, A2 = nA2, B = nB, C = nC;
        if (r + NGW < MT) P2_LOAD(r + NGW);
        const bool lat = r < TL; const int s = r & 2047, gr = s >> 6, gc = s & 63, kr = krow_of(r);
        { float v[8]; unpack8(A1, v); float s1 = 0.f;
#pragma unroll
          for (int e = 0; e < 8; ++e) s1 += v[e] * v[e];
          unpack8(A2, v); float s2 = 0.f;
#pragma unroll
          for (int e = 0; e < 8; ++e) s2 += v[e] * v[e];
          const float sq = wave_sum(lane < 48 ? s1 : 0.f), sk = wave_sum((lane >= 48 ? s1 : 0.f) + (lane < 16 ? s2 : 0.f));
          if (lane == 0) { rstdq[r] = 1.0f / sqrtf(sq * (1.0f / 384.0f) + RMS_EPS); rstdkv[r] = 1.0f / sqrtf(sk * (1.0f / 256.0f) + RMS_EPS); } }
        { const u32x4 o = head64_norm_rope(B, ggq, t64, lat, gr, gc, w8, QSCALE_G); *(u32x4*)(Qg + (size_t)r * 512 + 8 * lane) = o; }
        { const u32x4 o = head64_norm_rope(C, ggk, t64, lat, gr, gc, w8, 1.0f); if (lane >= 8 && lane < 24) *(u32x4*)(Kg + (size_t)kr * 128 + 8 * (lane - 8)) = o; }
        if (lane >= 24 && lane < 40) *(u32x4*)(Vg + (size_t)kr * 128 + 8 * (lane - 24)) = C;
        { float v[8], p[8], o[8]; unpack8(C, v);
#pragma unroll
          for (int e = 0; e < 8; ++e) { p[e] = lane_xor<1>(v[e]); o[e] = v[e]; }
          if (lat) { const int pos = ((lane >> 1) & 1) ? gc : gr; const LAS f32x2* cs = t32 + pos * 8; const bool x2 = (lane & 1) != 0;
#pragma unroll
              for (int e = 0; e < 8; ++e) { const f32x2 c = cs[e]; o[e] = x2 ? (v[e] * c.x + p[e] * c.y) : (v[e] * c.x - p[e] * c.y); } }
          const u32x4 ow = pack8(o);
          if (lane < 4) {
#pragma unroll
              for (int h = 0; h < 8; ++h) *(u32x4*)(Km + (size_t)kr * QW + h * 96 + 64 + 8 * lane) = ow; } }
    }
#undef P2_LOAD
}

typedef float f32x4m __attribute__((ext_vector_type(4)));
template <bool XF32>
__device__ __forceinline__ void phase_ln1_route(const Ctx& F, KP kp, int l, int ntok) {
    const Args a = ldargs(kp);
    unsigned char* ws = a.ws;
    const bf16_t* Yo = (const bf16_t*)(ws + WS_U); float* XC = (float*)(ws + WS_XC); bf16_t* H = (bf16_t*)(ws + WS_H);
    bf16_t* XB = (bf16_t*)(ws + WS_XB); constexpr bool xf32 = XF32;
    const float* mod = (const float*)(ws + WS_MOD) + (size_t)l * 17 * 6144;
    int* toke = (int*)(ws + WS_TOKE); int* tokr = (int*)(ws + WS_TOKR); float* tokw = (float*)(ws + WS_TOKW);
    volatile LAS int* cntl = (volatile LAS int*)(F.lds + MISC_CNT);
    const int lane = F.lane;
    __syncthreads();
    if (F.tid < 32) cntl[F.tid] = 0;
    if (F.tid < 36) ((LAS float*)(F.lds + MISC_LG + 2048))[F.tid] = (F.tid < 4) ? a.b_rg[l * 4 + F.tid] : a.b_re[l * 32 + F.tid - 4];
    const int tpb = ntok / GRID;
    {
        f32x4 nx[4]; u32x2 ny[4]; int i = F.wave;
        f32x4 LG[4], LB[4], GA[4], SH[4], SC[4]; int bbc = -1;
#pragma unroll
        for (int j = 0; j < 4; ++j) { LG[j] = *(const f32x4*)(a.ln1_g + l * D + 4 * lane + 256 * j); LB[j] = *(const f32x4*)(a.ln1_b + l * D + 4 * lane + 256 * j); }
        u32x2 nb[4];
#define P6_LOAD(tt) do { const int t_ = (tt); \
        if (xf32) { const float* xp_ = (t_ < TL) ? (a.x + (size_t)t_ * D) : (a.ctx + (size_t)(t_ - TL) * D); row_load(xp_, lane, nx); } \
        else { _Pragma("unroll") for (int j = 0; j < 4; ++j) nb[j] = __builtin_nontemporal_load((const u32x2*)(XB + (size_t)t_ * D + 4 * lane + 256 * j)); } \
        _Pragma("unroll") for (int j = 0; j < 4; ++j) ny[j] = __builtin_nontemporal_load((const u32x2*)(Yo + (size_t)t_ * D + 4 * lane + 256 * j)); } while (0)
        if (i < tpb) P6_LOAD(F.bk * tpb + i);
        for (; i < tpb; i += NWAVES) {
            const int t = F.bk * tpb + i, bb = bb_of(t);
            if (bb != bbc) {
                bbc = bb;
#pragma unroll
                for (int j = 0; j < 4; ++j) { const int c = 4 * lane + 256 * j; GA[j] = *(const f32x4*)(mod + (size_t)(bb * 6 + 2) * D + c);
                    SH[j] = *(const f32x4*)(mod + (size_t)(bb * 6 + 3) * D + c); SC[j] = *(const f32x4*)(mod + (size_t)(bb * 6 + 4) * D + c); }
            }
            f32x4 v[4];
#pragma unroll
            for (int j = 0; j < 4; ++j) { const f32x4 y = {bflo(ny[j].x), bfhi(ny[j].x), bflo(ny[j].y), bfhi(ny[j].y)};
                const f32x4 xv = xf32 ? nx[j] : (f32x4){bflo(nb[j].x), bfhi(nb[j].x), bflo(nb[j].y), bfhi(nb[j].y)}; v[j] = xv * ALPHA + GA[j] * y; }
            if (i + NWAVES < tpb) P6_LOAD(t + NWAVES);
            row_ln_reg(v, LG, LB);
#pragma unroll
            for (int j = 0; j < 4; ++j) st_bf4(XB + (size_t)t * D + 4 * lane + 256 * j, v[j]);
#pragma unroll
            for (int j = 0; j < 4; ++j) {
                const f32x4 h = v[j] * (SC[j] + 1.0f) + SH[j];
                st_bf4(H + (size_t)t * D + 4 * lane + 256 * j, h);
            }
        }
    }
#undef P6_LOAD
    asm volatile("s_waitcnt vmcnt(0)" ::: "memory");
    __syncthreads();
    {
        const bf16_t* wrh = (const bf16_t*)(ws + WS_WR) + (size_t)(l * 2) * 48 * D; const bf16_t* wrl = wrh + (size_t)48 * D;
        const LAS float* bias = (const LAS float*)(F.lds + MISC_LG + 2048);
        const int fr = lane & 15, fq = lane >> 4, w = F.wave;
        bf16x8 WH[4][3], WL[4][3];
#pragma unroll
        for (int ks = 0; ks < 4; ++ks)
#pragma unroll
            for (int tl = 0; tl < 3; ++tl) { const size_t o = (size_t)(16 * tl + fr) * D + 128 * w + 32 * ks + 8 * fq; WH[ks][tl] = *(const bf16x8*)(wrh + o); WL[ks][tl] = *(const bf16x8*)(wrl + o); }
        LAS float* part = (LAS float*)F.lds;
        LAS float* lgf = (LAS float*)(F.lds + 122880);
        const int ngrp = tpb / 16;
        for (int g0 = 0; g0 < ngrp; g0 += 5) {
            const int ng = (ngrp - g0 < 5) ? (ngrp - g0) : 5;
            bf16x8 hb[5][4];
#pragma unroll
            for (int gl = 0; gl < 5; ++gl) if (gl < ng) {
                const bf16_t* hh = H + (size_t)(F.bk * tpb + (g0 + gl) * 16 + fr) * D + 128 * w + 8 * fq;
#pragma unroll
                for (int ks = 0; ks < 4; ++ks) hb[gl][ks] = *(const bf16x8*)(hh + 32 * ks);
            }
#pragma unroll
            for (int gl = 0; gl < 5; ++gl) if (gl < ng) {
                f32x4m acc0 = {0.f, 0.f, 0.f, 0.f}, acc1 = acc0, acc2 = acc0;
#pragma unroll
                for (int ks = 0; ks < 4; ++ks) {
                    acc0 = __builtin_amdgcn_mfma_f32_16x16x32_bf16(WH[ks][0], hb[gl][ks], acc0, 0, 0, 0); acc1 = __builtin_amdgcn_mfma_f32_16x16x32_bf16(WH[ks][1], hb[gl][ks], acc1, 0, 0, 0); acc2 = __builtin_amdgcn_mfma_f32_16x16x32_bf16(WH[ks][2], hb[gl][ks], acc2, 0, 0, 0);
                    acc0 = __builtin_amdgcn_mfma_f32_16x16x32_bf16(WL[ks][0], hb[gl][ks], acc0, 0, 0, 0); acc1 = __builtin_amdgcn_mfma_f32_16x16x32_bf16(WL[ks][1], hb[gl][ks], acc1, 0, 0, 0); acc2 = __builtin_amdgcn_mfma_f32_16x16x32_bf16(WL[ks][2], hb[gl][ks], acc2, 0, 0, 0);
                }
                LAS float* pp = part + ((size_t)(w * 5 + gl) * 16 + fr) * 48 + 4 * fq;
                *(LAS f32x4m*)(pp) = acc0; *(LAS f32x4m*)(pp + 16) = acc1; *(LAS f32x4m*)(pp + 32) = acc2;
            }
            LDS_WAIT();
            __syncthreads();
            for (int o = F.tid; o < ng * 768; o += NTHREADS) {
                const int gl = o / 768, rem = o - gl * 768; float s = 0.f;
#pragma unroll
                for (int ww = 0; ww < 8; ++ww) s += part[(ww * 5 + gl) * 768 + rem];
                lgf[o] = s;
            }
            __syncthreads();
            if (F.tid < ng * 16) {
                const int t = F.bk * tpb + g0 * 16 + F.tid; const LAS float* q = lgf + F.tid * 48;
                float l4[4];
#pragma unroll
                for (int o = 0; o < 4; ++o) l4[o] = q[o] + bias[o];
                int gs = 0; float gm = l4[0];
#pragma unroll
                for (int o = 1; o < 4; ++o) if (l4[o] > gm) { gm = l4[o]; gs = o; }
                float den = 0.f;
#pragma unroll
                for (int o = 0; o < 4; ++o) den += expf(l4[o] - gm);
                const float pstar = 1.0f / den;
                float le[8];
#pragma unroll
                for (int o = 0; o < 8; ++o) le[o] = q[4 + gs * 8 + o] + bias[4 + gs * 8 + o];
                int i1 = 0; float v1 = le[0];
#pragma unroll
                for (int o = 1; o < 8; ++o) if (le[o] > v1) { v1 = le[o]; i1 = o; }
                int i2 = -1; float v2 = -3.0e38f;
#pragma unroll
                for (int o = 0; o < 8; ++o) if (o != i1 && le[o] > v2) { v2 = le[o]; i2 = o; }
                const float ex = expf(v2 - v1), w1 = pstar / (1.0f + ex), w2 = pstar * ex / (1.0f + ex);
                const int e1 = gs * 8 + i1, e2 = gs * 8 + i2;
                const int r1 = __hip_atomic_fetch_add((LAS int*)(F.lds + MISC_CNT) + e1, 1, __ATOMIC_RELAXED, __HIP_MEMORY_SCOPE_WORKGROUP);
                const int r2 = __hip_atomic_fetch_add((LAS int*)(F.lds + MISC_CNT) + e2, 1, __ATOMIC_RELAXED, __HIP_MEMORY_SCOPE_WORKGROUP);
                toke[2 * t] = e1; toke[2 * t + 1] = e2; tokr[2 * t] = r1; tokr[2 * t + 1] = r2; tokw[2 * t] = w1; tokw[2 * t + 1] = w2;
            }
            __syncthreads();
        }
    }
    __syncthreads();
    if (F.tid < 32) ((int*)(ws + WS_BLKCNT))[((size_t)l * 256 + F.bk) * 32 + F.tid] = cntl[F.tid];
}

__device__ __forceinline__ void moe_tables(const Ctx& F, KP kp, int l, bool publish) {
    const Args a = ldargs(kp);
    const int* blkcnt = (const int*)(a.ws + WS_BLKCNT) + (size_t)l * 256 * 32;
    volatile LAS int* pa = (volatile LAS int*)(F.lds + MISC_PA); volatile LAS int* pb = (volatile LAS int*)(F.lds + MISC_PB);
    volatile LAS int* tot = (volatile LAS int*)(F.lds + MISC_TOT); volatile LAS int* base = (volatile LAS int*)(F.lds + MISC_BASE); volatile LAS int* poff = (volatile LAS int*)(F.lds + MISC_POFF);
    __syncthreads();
    {
        const int e = F.tid & 31, part = F.tid >> 5; int sa = 0, sb = 0;
        for (int j = 0; j < 16; ++j) { const int b2 = part * 16 + j; const int c = blkcnt[b2 * 32 + e]; sa += c; sb += (b2 < F.bk) ? c : 0; }
        pa[part * 32 + e] = sa; pb[part * 32 + e] = sb;
    }
    __syncthreads();
    if (F.tid < 32) { int sa = 0, sb = 0; for (int p = 0; p < 16; ++p) { sa += pa[p * 32 + F.tid]; sb += pb[p * 32 + F.tid]; } tot[F.tid] = sa; base[F.tid] = sb; }
    __syncthreads();
    if (F.tid == 0) { int o = 0; for (int e = 0; e < 32; ++e) { poff[e] = o; o += (tot[e] + 255) & ~255; } poff[32] = o; }
    __syncthreads();
    if (publish && F.bk == 0 && F.tid < 33) ((int*)(a.ws + WS_MOETAB))[l * 128 + F.tid] = poff[F.tid];
}

__device__ __forceinline__ void phase_dispatch(const Ctx& F, KP kp, int l, int ntok) {
    const Args a = ldargs(kp);
    unsigned char* ws = a.ws;
    moe_tables(F, kp, l, true);
    volatile LAS int* base = (volatile LAS int*)(F.lds + MISC_BASE); volatile LAS int* poff = (volatile LAS int*)(F.lds + MISC_POFF); volatile LAS int* tot = (volatile LAS int*)(F.lds + MISC_TOT);
    const int* toke = (const int*)(ws + WS_TOKE); const int* tokr = (const int*)(ws + WS_TOKR); int* tokp = (int*)(ws + WS_TOKP); int* postok = (int*)(ws + WS_POSTOK);
    const int tpb = ntok / GRID;
    if (F.tid < tpb) {
        const int t = F.bk * tpb + F.tid;
        const int2 e = *(const int2*)(toke + 2 * t), r = *(const int2*)(tokr + 2 * t);
        const int p1 = poff[e.x] + base[e.x] + r.x, p2 = poff[e.y] + base[e.y] + r.y;
        *(int2*)(tokp + 2 * t) = (int2){p1, p2};
        postok[p1] = t; postok[p2] = t;
    }
    { const int idx = F.bk * NTHREADS + F.tid;
      if (idx < poff[32]) { int e = 0;
#pragma unroll
          for (int j = 1; j < 32; ++j) e += (poff[j] <= idx) ? 1 : 0;
          if (idx >= poff[e] + tot[e]) postok[idx] = 0; } }
}

__device__ __forceinline__ void phase_ln2(const Ctx& F, KP kp, int l, int ntok, bool dry = false) {
    const Args a = ldargs(kp);
    unsigned char* ws = a.ws;
    const bf16_t* Ys = (const bf16_t*)(ws + WS_XS); float* XC = (float*)(ws + WS_XC); bf16_t* H = (bf16_t*)(ws + WS_H);
    const float* mod = (const float*)(ws + WS_MOD) + (size_t)l * 17 * 6144;
    const float* modn = (const float*)(ws + WS_MOD) + (size_t)(l + 1 < NL ? l + 1 : l) * 17 * 6144;
    const int* tokp = (const int*)(ws + WS_TOKP); const float* tokw = (const float*)(ws + WS_TOKW);
    const int gw = F.vcu * NWAVES + F.wave, NGW = GRID * NWAVES, lane = F.lane;
    const int per = ntok / NGW, t0 = gw * per, t1 = t0 + per;
    f32x4 LG[4], LB[4], GF[4], SH[4], SC[4];
#pragma unroll
    for (int j = 0; j < 4; ++j) { LG[j] = *(const f32x4*)(a.ln2_g + l * D + 4 * lane + 256 * j); LB[j] = *(const f32x4*)(a.ln2_b + l * D + 4 * lane + 256 * j); }
    int bbc = -1;
    int2 pn = {0, 0}; float2 wn = {0.f, 0.f};
    u32x2 xn[4], yan[4], ybn[4]; bf16_t* XB = (bf16_t*)(ws + WS_XB);
#define P10_REC(tt) do { pn = *(const int2*)(tokp + 2 * (tt)); wn = *(const float2*)(tokw + 2 * (tt)); } while (0)
#define P10_ROWS(tt, p_) do { const int t_ = (tt); _Pragma("unroll") for (int j = 0; j < 4; ++j) xn[j] = __builtin_nontemporal_load((const u32x2*)(XB + (size_t)t_ * D + 4 * lane + 256 * j)); \
        _Pragma("unroll") for (int j = 0; j < 4; ++j) { yan[j] = __builtin_nontemporal_load((const u32x2*)(Ys + (size_t)(p_).x * D + 4 * lane + 256 * j)); ybn[j] = __builtin_nontemporal_load((const u32x2*)(Ys + (size_t)(p_).y * D + 4 * lane + 256 * j)); } } while (0)
    float2 wc = {0.f, 0.f};
    P10_REC(t0); wc = wn; P10_ROWS(t0, pn); if (t0 + 1 < t1) P10_REC(t0 + 1);
    for (int t = t0; t < t1; ++t) {
        const int bb = bb_of(t);
        if (bb != bbc) {
            bbc = bb;
#pragma unroll
            for (int j = 0; j < 4; ++j) { const int c = 4 * lane + 256 * j; GF[j] = *(const f32x4*)(mod + (size_t)(bb * 6 + 5) * D + c);
                SH[j] = *(const f32x4*)(modn + (size_t)(bb * 6 + 0) * D + c); SC[j] = *(const f32x4*)(modn + (size_t)(bb * 6 + 1) * D + c); }
        }
        f32x4 v[4]; u32x2 ya[4], yb[4];
#pragma unroll
        for (int j = 0; j < 4; ++j) { v[j] = (f32x4){bflo(xn[j].x), bfhi(xn[j].x), bflo(xn[j].y), bfhi(xn[j].y)}; ya[j] = yan[j]; yb[j] = ybn[j]; }
        const float w1 = wc.x, w2 = wc.y;
        if (t + 1 < t1) { wc = wn; P10_ROWS(t + 1, pn); if (t + 2 < t1) P10_REC(t + 2); }
#pragma unroll
        for (int j = 0; j < 4; ++j) {
            const f32x4 y = (f32x4){bflo(ya[j].x), bfhi(ya[j].x), bflo(ya[j].y), bfhi(ya[j].y)} * w1 + (f32x4){bflo(yb[j].x), bfhi(yb[j].x), bflo(yb[j].y), bfhi(yb[j].y)} * w2;
            v[j] = v[j] * ALPHA + GF[j] * y;
        }
        row_ln_reg(v, LG, LB);
        if (l + 1 < NL) {
#pragma unroll
            for (int j = 0; j < 4; ++j) st_bf4(XB + (size_t)t * D + 4 * lane + 256 * j, v[j]);
        } else {
#pragma unroll
            for (int j = 0; j < 4; ++j) *(f32x4*)(a.out + (size_t)t * D + 4 * lane + 256 * j) = v[j];
        }
        if (l + 1 < NL) { bf16_t* hrow = H + (size_t)t * D;
#pragma unroll
            for (int j = 0; j < 4; ++j) st_bf4(hrow + 4 * lane + 256 * j, v[j] * (SC[j] + 1.0f) + SH[j]); }
    }
#undef P10_REC
#undef P10_ROWS
}

template <int QD>
__device__ __forceinline__ void attn_naive_task(const bf16_t* qp, const bf16_t* kp, int kstride, const bf16_t* vp, int vstride, int nkeys, bf16_t* op) {
    u32x4 qv[QD / 8];
#pragma unroll
    for (int i = 0; i < QD / 8; ++i) qv[i] = *(const u32x4*)(qp + 8 * i);
#pragma unroll 1
    for (int half = 0; half < 2; ++half) {
        float o[32];
#pragma unroll
        for (int i = 0; i < 32; ++i) o[i] = 0.f;
        float m = -1.0e30f, lsum = 0.f;
#pragma unroll 1
        for (int j = 0; j < nkeys; ++j) {
            const u32x4* kr = (const u32x4*)(kp + (size_t)j * kstride);
            float s = 0.f;
#pragma unroll
            for (int i = 0; i < QD / 8; ++i) s = dot8(qv[i], kr[i], s);
            if (s > m) { const float al = __builtin_amdgcn_exp2f(m - s); lsum *= al;
#pragma unroll
                for (int i = 0; i < 32; ++i) o[i] *= al;
                m = s; }
            const float p = __builtin_amdgcn_exp2f(s - m); lsum += p;
            const u32x4* vr = (const u32x4*)(vp + (size_t)j * vstride + 32 * half);
#pragma unroll
            for (int i = 0; i < 4; ++i) { const u32x4 w = vr[i];
                o[8 * i + 0] += p * bflo(w.x); o[8 * i + 1] += p * bfhi(w.x); o[8 * i + 2] += p * bflo(w.y); o[8 * i + 3] += p * bfhi(w.y); o[8 * i + 4] += p * bflo(w.z); o[8 * i + 5] += p * bfhi(w.z); o[8 * i + 6] += p * bflo(w.w); o[8 * i + 7] += p * bfhi(w.w); }
        }
        const float rl = 1.0f / lsum;
#pragma unroll
        for (int i = 0; i < 4; ++i) { u32x4 w; w.x = pk2(o[8 * i] * rl, o[8 * i + 1] * rl); w.y = pk2(o[8 * i + 2] * rl, o[8 * i + 3] * rl); w.z = pk2(o[8 * i + 4] * rl, o[8 * i + 5] * rl); w.w = pk2(o[8 * i + 6] * rl, o[8 * i + 7] * rl); *(u32x4*)(op + 32 * half + 8 * i) = w; }
    }
}
__device__ __forceinline__ void phase_attn_naive(const Ctx& F, KP kp, bool last) {
    const Args a = ldargs(kp);
    unsigned char* ws = a.ws;
    const bf16_t* Qm = (const bf16_t*)(ws + WS_QM); const bf16_t* Km = (const bf16_t*)(ws + WS_KM); const bf16_t* Vm = (const bf16_t*)(ws + WS_VM);
    const bf16_t* Qg = (const bf16_t*)(ws + WS_QG); const bf16_t* Kg = (const bf16_t*)(ws + WS_KG); const bf16_t* Vg = (const bf16_t*)(ws + WS_VG);
    bf16_t* O = (bf16_t*)(ws + WS_O);
    const int gw = F.vcu * NWAVES + F.wave, NGW = GRID * NWAVES;
    const int ntask = 8192 + (last ? 0 : 1024);
    for (int T = gw; T < ntask; T += NGW) {
        int b, h16, r, nkeys;
        if (T < 8192) { const int qw = T & 31; h16 = (T >> 5) & 15; b = T >> 9; r = b * SEQ + 64 * qw + F.lane; nkeys = KPB; }
        else { const int T2 = T - 8192, qw = T2 & 3; h16 = (T2 >> 2) & 15; b = T2 >> 6; r = TL + b * CTX + 64 * qw + F.lane; nkeys = CTX; }
        bf16_t* op = O + (size_t)r * D + h16 * 64;
        if (h16 < 8) attn_naive_task<96>(Qm + (size_t)r * QW + h16 * 96, Km + (size_t)b * KPB * QW + h16 * 96, QW, Vm + (size_t)b * KPB * 512 + h16 * 64, 512, nkeys, op);
        else { const int hh = h16 - 8, kvh = hh >> 2; attn_naive_task<64>(Qg + (size_t)r * 512 + hh * 64, Kg + (size_t)b * KPB * 128 + kvh * 64, 128, Vg + (size_t)b * KPB * 128 + kvh * 64, 128, nkeys, op); }
    }
}

typedef float f32x16 __attribute__((ext_vector_type(16)));
typedef short s16x4 __attribute__((ext_vector_type(4)));
__device__ __forceinline__ s16x4 vtr(const LAS unsigned char* p) { return __builtin_bit_cast(s16x4, __builtin_amdgcn_ds_read_tr16_b64_v4i16((LAS s16x4*)p)); }
__device__ __forceinline__ unsigned cvtpk(float lo, float hi) { typedef __bf16 bf2 __attribute__((ext_vector_type(2))); f32x2 v = {lo, hi}; bf2 b = __builtin_convertvector(v, bf2); return __builtin_bit_cast(unsigned, b); }
constexpr float ATT_THR = 6.0f;
constexpr int ATT_KSLOT = 12288, ATT_VSLOT = 8192, ATT_NKS = 3, ATT_NVS = 4, ATT_V0 = ATT_NKS * ATT_KSLOT;
__device__ __forceinline__ void att_glds16(const void* gsrc, unsigned lds_dst) { unsigned keep;
    asm volatile("s_mov_b32 %0, m0\n\ts_mov_b32 m0, %2\n\ts_nop 0\n\tglobal_load_lds_dwordx4 %1, off\n\ts_mov_b32 m0, %0" : "=&s"(keep) : "v"(gsrc), "s"(lds_dst) : "memory"); }
__device__ __forceinline__ void att_glds16s(const void* sbase, unsigned voff, unsigned lds_dst) { unsigned keep;
    asm volatile("s_mov_b32 %0, m0\n\ts_mov_b32 m0, %3\n\ts_nop 0\n\tglobal_load_lds_dwordx4 %1, %2\n\ts_mov_b32 m0, %0" : "=&s"(keep) : "v"(voff), "s"(sbase), "s"(lds_dst) : "memory"); }
#define ATT_WAITBAR(N) asm volatile("s_waitcnt vmcnt(" #N ") lgkmcnt(0)\n\ts_barrier" ::: "memory")
template <int QD>
__device__ __forceinline__ void attn_unit(LAS unsigned char* lds, int tid, const bf16_t* Kb, int kstride, const bf16_t* Vb, int vstride, int ntiles, const bf16_t* qrow, bf16_t* orow) {
    constexpr int NC = QD / 8, NS = QD / 16;
    const int lane = tid & 63, r32 = lane & 31, hi = lane >> 5;
    const int w = __builtin_amdgcn_readfirstlane(tid >> 6);
    const bool three = (NC == 12) && (w < 4);
    const int vp = (NC == 12) ? (w < 4 ? w + 4 : w - 4) : w;
    const bf16_t* ksrcA = Kb + w * 512 + lane * 8;
    const bf16_t* ksrcB = Kb + (w + 8) * 512 + lane * 8;
    const bf16_t* vsrc = Vb + vp * 512 + lane * 8;
    const size_t kstep = (size_t)64 * QD, vstep = (size_t)4096;
    const unsigned lds0 = (unsigned)(size_t)lds;
#define ATT_DMA(t_, ks_, vs_) do { \
        att_glds16(ksrcA + (size_t)(t_) * kstep, (unsigned)__builtin_amdgcn_readfirstlane((int)(lds0 + (ks_) * ATT_KSLOT + w * 1024))); \
        if (three) att_glds16(ksrcB + (size_t)(t_) * kstep, (unsigned)__builtin_amdgcn_readfirstlane((int)(lds0 + (ks_) * ATT_KSLOT + (w + 8) * 1024))); \
        att_glds16(vsrc + (size_t)(t_) * vstep, (unsigned)__builtin_amdgcn_readfirstlane((int)(lds0 + ATT_V0 + (vs_) * ATT_VSLOT + vp * 1024))); } while (0)
    ATT_DMA(0, 0, 0);
    if (ntiles > 1) ATT_DMA(1, 1, 1);
    bf16x8 qr[NS];
#pragma unroll
    for (int s = 0; s < NS; ++s) qr[s] = *(const bf16x8*)(qrow + 16 * s + 8 * hi);
    f32x16 o0, o1, negm, p0, p1;
#pragma unroll
    for (int r = 0; r < 16; ++r) { o0[r] = 0.f; o1[r] = 0.f; negm[r] = 0.f; p0[r] = 0.f; p1[r] = 0.f; }
    float lsum = 0.f;
    const int kread = hi * 1024 + r32 * 16;
    const int vread = ATT_V0 + ((lane >> 4) & 1) * 32 + (lane & 3) * 8 + (4 * hi + ((lane & 15) >> 2)) * 64;
#define ATT_QK(ks_) do { const LAS unsigned char* kb_ = lds + (ks_) * ATT_KSLOT + kread; \
        _Pragma("unroll") for (int s = 0; s < NS; ++s) { \
            const bf16x8 a0 = *(const LAS bf16x8*)(kb_ + s * 2048), a1 = *(const LAS bf16x8*)(kb_ + s * 2048 + 512); \
            if (s == 0) { p0 = __builtin_amdgcn_mfma_f32_32x32x16_bf16(a0, qr[0], negm, 0, 0, 0); p1 = __builtin_amdgcn_mfma_f32_32x32x16_bf16(a1, qr[0], negm, 0, 0, 0); } \
            else { p0 = __builtin_amdgcn_mfma_f32_32x32x16_bf16(a0, qr[s], p0, 0, 0, 0); p1 = __builtin_amdgcn_mfma_f32_32x32x16_bf16(a1, qr[s], p1, 0, 0, 0); } } } while (0)
#define ATT_SOFT_PV(first_, vs_) do { \
        float mx = fmaxf(fmaxf(p0[0], p1[0]), p0[1]); \
        _Pragma("unroll") for (int r = 1; r < 16; ++r) mx = (r == 1) ? fmaxf(mx, p1[1]) : fmaxf(fmaxf(mx, p0[r]), p1[r]); \
        { auto rr = __builtin_amdgcn_permlane32_swap(__float_as_uint(mx), __float_as_uint(mx), false, false); mx = fmaxf(__uint_as_float(rr[0]), __uint_as_float(rr[1])); } \
        if ((first_) || __any(mx > ATT_THR)) { \
            const float dl = (first_) ? mx : fmaxf(mx, 0.f); \
            _Pragma("unroll") for (int r = 0; r < 16; ++r) { p0[r] -= dl; p1[r] -= dl; negm[r] -= dl; } \
            if (!(first_)) { const float f = __builtin_amdgcn_exp2f(-dl); lsum *= f; \
                _Pragma("unroll") for (int r = 0; r < 16; ++r) { o0[r] *= f; o1[r] *= f; } } \
        } \
        float rs = 0.f; \
        _Pragma("unroll") for (int r = 0; r < 16; ++r) { p0[r] = __builtin_amdgcn_exp2f(p0[r]); p1[r] = __builtin_amdgcn_exp2f(p1[r]); rs += p0[r] + p1[r]; } \
        lsum += rs; \
        u32x4 w0, w1, w2, w3; \
        w0.x = cvtpk(p0[0], p0[1]); w0.y = cvtpk(p0[2], p0[3]); w0.z = cvtpk(p0[4], p0[5]); w0.w = cvtpk(p0[6], p0[7]); \
        w1.x = cvtpk(p0[8], p0[9]); w1.y = cvtpk(p0[10], p0[11]); w1.z = cvtpk(p0[12], p0[13]); w1.w = cvtpk(p0[14], p0[15]); \
        w2.x = cvtpk(p1[0], p1[1]); w2.y = cvtpk(p1[2], p1[3]); w2.z = cvtpk(p1[4], p1[5]); w2.w = cvtpk(p1[6], p1[7]); \
        w3.x = cvtpk(p1[8], p1[9]); w3.y = cvtpk(p1[10], p1[11]); w3.z = cvtpk(p1[12], p1[13]); w3.w = cvtpk(p1[14], p1[15]); \
        const bf16x8 pa0 = __builtin_bit_cast(bf16x8, w0), pa1 = __builtin_bit_cast(bf16x8, w1), pa2 = __builtin_bit_cast(bf16x8, w2), pa3 = __builtin_bit_cast(bf16x8, w3); \
        const LAS unsigned char* vb_ = lds + (vs_) * ATT_VSLOT + vread; \
        o0 = __builtin_amdgcn_mfma_f32_32x32x16_bf16(ATT_VF(0, 0), pa0, o0, 0, 0, 0); \
        o1 = __builtin_amdgcn_mfma_f32_32x32x16_bf16(ATT_VF(1, 0), pa0, o1, 0, 0, 0); \
        o0 = __builtin_amdgcn_mfma_f32_32x32x16_bf16(ATT_VF(0, 1), pa1, o0, 0, 0, 0); \
        o1 = __builtin_amdgcn_mfma_f32_32x32x16_bf16(ATT_VF(1, 1), pa1, o1, 0, 0, 0); \
        o0 = __builtin_amdgcn_mfma_f32_32x32x16_bf16(ATT_VF(0, 2), pa2, o0, 0, 0, 0); \
        o1 = __builtin_amdgcn_mfma_f32_32x32x16_bf16(ATT_VF(1, 2), pa2, o1, 0, 0, 0); \
        o0 = __builtin_amdgcn_mfma_f32_32x32x16_bf16(ATT_VF(0, 3), pa3, o0, 0, 0, 0); \
        o1 = __builtin_amdgcn_mfma_f32_32x32x16_bf16(ATT_VF(1, 3), pa3, o1, 0, 0, 0); } while (0)
#define ATT_VF(d0, ks) ({ const s16x4 lo_ = vtr(vb_ + (d0) * 4096 + (ks) * 1024), hi_ = vtr(vb_ + (d0) * 4096 + (ks) * 1024 + 512); (bf16x8){lo_[0], lo_[1], lo_[2], lo_[3], hi_[0], hi_[1], hi_[2], hi_[3]}; })
#define ATT_ENDSTEP() do { if (issue) { if (three) ATT_WAITBAR(3); else ATT_WAITBAR(2); } else ATT_WAITBAR(0); \
        ks = (ks == ATT_NKS - 1) ? 0 : ks + 1; vs = (vs + 1) & (ATT_NVS - 1); } while (0)
    if (ntiles > 1) { if (three) ATT_WAITBAR(3); else ATT_WAITBAR(2); } else ATT_WAITBAR(0);
    int ks = 0, vs = 0;
    if (w < 4) {
        for (int t = 0; t < ntiles; ++t) {
            const bool issue = (t + 2 < ntiles);
            if (issue) ATT_DMA(t + 2, (ks >= 1) ? ks - 1 : ATT_NKS - 1, (vs + 2) & (ATT_NVS - 1));
            ATT_QK(ks);
            ATT_SOFT_PV(t == 0, vs);
            ATT_ENDSTEP();
        }
    } else {
        for (int t = 0; t < ntiles; ++t) {
            const bool issue = (t + 2 < ntiles);
            if (issue) ATT_DMA(t + 2, (ks >= 1) ? ks - 1 : ATT_NKS - 1, (vs + 2) & (ATT_NVS - 1));
            if (t > 0) ATT_SOFT_PV(t == 1, (vs + ATT_NVS - 1) & (ATT_NVS - 1));
            ATT_QK(ks);
            ATT_ENDSTEP();
        }
        ATT_SOFT_PV(ntiles == 1, (vs + ATT_NVS - 1) & (ATT_NVS - 1));
    }
#undef ATT_DMA
#undef ATT_QK
#undef ATT_SOFT_PV
#undef ATT_VF
#undef ATT_ENDSTEP
    { auto rr = __builtin_amdgcn_permlane32_swap(__float_as_uint(lsum), __float_as_uint(lsum), false, false); lsum = __uint_as_float(rr[0]) + __uint_as_float(rr[1]); }
    const float rl = 1.0f / lsum;
#pragma unroll
    for (int g = 0; g < 4; ++g) {
        u32x2 a, b2;
        a.x = cvtpk(o0[4 * g] * rl, o0[4 * g + 1] * rl); a.y = cvtpk(o0[4 * g + 2] * rl, o0[4 * g + 3] * rl);
        b2.x = cvtpk(o1[4 * g] * rl, o1[4 * g + 1] * rl); b2.y = cvtpk(o1[4 * g + 2] * rl, o1[4 * g + 3] * rl);
        *(u32x2*)(orow + 8 * g + 4 * hi) = a; *(u32x2*)(orow + 32 + 8 * g + 4 * hi) = b2;
    }
    asm volatile("s_waitcnt lgkmcnt(0)\n\ts_barrier" ::: "memory");
}

constexpr int AT3_KSLOT = 12288, AT3_VSLOT = 8192, AT3_V0 = 3 * AT3_KSLOT;
constexpr int AT3_FLAG = MISC_OFF + 32;
constexpr float AT3_SUMTHR = 1024.f, AT3_SUMBAD = 1.152921504606846976e18f;
#define AT3_SB() __builtin_amdgcn_sched_barrier(0)
#define AT3_PIN(x) asm volatile("" : "+v"(x))
template <int QD, bool exact>
__device__ __forceinline__ void attn_unit3(LAS unsigned char* lds, int tid, const bf16_t* Kb, const bf16_t* Vb, int ntiles, const bf16_t* qrow, bf16_t* orow) {
    constexpr int NC = QD / 8, NS = QD / 16, NKF = 2 * NS;
    constexpr int KG0 = (NS == 4) ? 2 : 1;
    const int lane = tid & 63, r32 = lane & 31, hi = lane >> 5;
    const int w = __builtin_amdgcn_readfirstlane(tid >> 6);
    const bool three = (NC == 12) && (w < 4);
    const int vp = (NC == 12) ? (w < 4 ? w + 4 : w - 4) : w;
    const bf16_t* ksrcA = Kb + w * 512;
    const bf16_t* ksrcB = Kb + (w + 8) * 512;
    const bf16_t* vsrc = Vb + vp * 512;
    const unsigned lofs = (unsigned)lane * 16u;
    const size_t kstep = (size_t)64 * QD, vstep = (size_t)4096;
    const unsigned lds0 = (unsigned)(size_t)lds;
#define AT3_DMAK(t_, sl_) do { \
        att_glds16s(ksrcA + (size_t)(t_) * kstep, lofs, (unsigned)__builtin_amdgcn_readfirstlane((int)(lds0 + (sl_) * AT3_KSLOT + w * 1024))); \
        if (three) att_glds16s(ksrcB + (size_t)(t_) * kstep, lofs, (unsigned)__builtin_amdgcn_readfirstlane((int)(lds0 + (sl_) * AT3_KSLOT + (w + 8) * 1024))); } while (0)
#define AT3_DMAV(t_, sl_) att_glds16s(vsrc + (size_t)(t_) * vstep, lofs, (unsigned)__builtin_amdgcn_readfirstlane((int)(lds0 + AT3_V0 + (sl_) * AT3_VSLOT + vp * 1024)))
#define AT3_WB(n_) do { const int nn_ = (n_); if (nn_ == 3) ATT_WAITBAR(3); else if (nn_ == 2) ATT_WAITBAR(2); else if (nn_ == 1) ATT_WAITBAR(1); else ATT_WAITBAR(0); } while (0)
    const int nk = three ? 2 : 1;
    bf16x8 qr[NS];
#pragma unroll
    for (int s = 0; s < NS; ++s) qr[s] = *(const bf16x8*)(qrow + 16 * s + 8 * hi);
    AT3_DMAK(0, 0);
    f32x16 o0, o1, negm, pA0, pA1, pB0, pB1;
#pragma unroll
    for (int r = 0; r < 16; ++r) { o0[r] = 0.f; o1[r] = 0.f; negm[r] = 0.f; }
    AT3_PIN(negm);
    float lsum = 0.f, fres = 1.f; bool resc = false, bad = false;
    const LAS unsigned char* kp0 = lds + hi * 1024 + r32 * 16;
    const LAS unsigned char* vp0 = lds + AT3_V0 + ((lane >> 4) & 1) * 32 + (lane & 3) * 8 + (4 * hi + ((lane & 15) >> 2)) * 64;
    ATT_WAITBAR(0);
    AT3_DMAV(0, 0); AT3_DMAK(1, 1); AT3_DMAK(2, 2);
    {
#pragma unroll
        for (int s = 0; s < NS; ++s) {
            const bf16x8 a0 = *(const LAS bf16x8*)(kp0 + s * 2048), a1 = *(const LAS bf16x8*)(kp0 + s * 2048 + 512);
            if (s == 0) { pA0 = __builtin_amdgcn_mfma_f32_32x32x16_bf16(a0, qr[0], negm, 0, 0, 0); pA1 = __builtin_amdgcn_mfma_f32_32x32x16_bf16(a1, qr[0], negm, 0, 0, 0); }
            else { pA0 = __builtin_amdgcn_mfma_f32_32x32x16_bf16(a0, qr[s], pA0, 0, 0, 0); pA1 = __builtin_amdgcn_mfma_f32_32x32x16_bf16(a1, qr[s], pA1, 0, 0, 0); } }
        float mx = fmaxf(fmaxf(pA0[0], pA1[0]), pA0[1]);
#pragma unroll
        for (int r = 1; r < 16; ++r) mx = (r == 1) ? fmaxf(mx, pA1[1]) : fmaxf(fmaxf(mx, pA0[r]), pA1[r]);
        { auto rr = __builtin_amdgcn_permlane32_swap(__float_as_uint(mx), __float_as_uint(mx), false, false); mx = fmaxf(__uint_as_float(rr[0]), __uint_as_float(rr[1])); }
#pragma unroll
        for (int r = 0; r < 16; ++r) { pA0[r] = __builtin_amdgcn_exp2f(pA0[r] - mx); pA1[r] = __builtin_amdgcn_exp2f(pA1[r] - mx); negm[r] = -mx; }
        AT3_PIN(negm);
    }
    ATT_WAITBAR(0);
    AT3_DMAK(3, 0); AT3_DMAV(1, 1);
    int sp = 0, sc = 1, sn = 2;
#define AT3_ROT() do { sp = sc; sc = sn; sn = (sn == 2) ? 0 : sn + 1; } while (0)
    bf16x8 kf[NKF];
    { const LAS unsigned char* kp_ = kp0 + sc * AT3_KSLOT;
#pragma unroll
      for (int j = 0; j < NS; ++j) { kf[2 * j] = *(const LAS bf16x8*)(kp_ + j * 2048); kf[2 * j + 1] = *(const LAS bf16x8*)(kp_ + j * 2048 + 512); } }
    AT3_WB(nk + 1);
    s16x4 vlo[8], vhi[8]; u32x4 pw[4];
#define AT3_PVAL(P0, P1, i) (((i) < 16) ? P0[(i) & 15] : P1[(i) & 15])
#define AT3_VFR(i) (bf16x8){vlo[i][0], vlo[i][1], vlo[i][2], vlo[i][3], vhi[i][0], vhi[i][1], vhi[i][2], vhi[i][3]}
#define AT3_STEP(C0, C1, P0, P1, t_, GK, GV, GL) do { AT3_SB(); \
        const LAS unsigned char* vp_ = vp0 + sp * AT3_VSLOT; \
        float sacc = P0[0] + P0[1]; \
        _Pragma("unroll") for (int g = 0; g < NKF; ++g) { \
            if (g < 8) { const int i_ = (g >> 1) + 4 * (g & 1); \
                vlo[i_] = vtr(vp_ + (i_ >> 2) * 4096 + (i_ & 3) * 1024); vhi[i_] = vtr(vp_ + (i_ >> 2) * 4096 + (i_ & 3) * 1024 + 512); AT3_SB(); } \
            if (g & 1) { if (g < 2) C1 = __builtin_amdgcn_mfma_f32_32x32x16_bf16(kf[g], qr[g >> 1], negm, 0, 0, 0); else C1 = __builtin_amdgcn_mfma_f32_32x32x16_bf16(kf[g], qr[g >> 1], C1, 0, 0, 0); } \
            else { if (g < 2) C0 = __builtin_amdgcn_mfma_f32_32x32x16_bf16(kf[g], qr[g >> 1], negm, 0, 0, 0); else C0 = __builtin_amdgcn_mfma_f32_32x32x16_bf16(kf[g], qr[g >> 1], C0, 0, 0, 0); } \
            { const int wl_ = (g * 16) / NKF, wh_ = ((g + 1) * 16) / NKF;         \
              _Pragma("unroll") for (int k_ = 0; k_ < 16; ++k_) if (k_ >= wl_ && k_ < wh_) { \
                  if (k_ < 15) { sacc += AT3_PVAL(P0, P1, 2 * k_ + 2); sacc += AT3_PVAL(P0, P1, 2 * k_ + 3); } \
                  pw[k_ >> 2][k_ & 3] = cvtpk(AT3_PVAL(P0, P1, 2 * k_), AT3_PVAL(P0, P1, 2 * k_ + 1)); } \
              AT3_PIN(sacc); \
              _Pragma("unroll") for (int k_ = 0; k_ < 4; ++k_) if (4 * k_ + 3 >= wl_ && 4 * k_ < wh_) AT3_PIN(pw[k_]); } \
            AT3_SB(); } \
        lsum += sacc; \
        if (GK) AT3_DMAK((t_) + 3, sc); \
        if (GV) AT3_DMAV((t_) + 1, sn); \
        resc = false; \
        if (exact) { float ma = fmaxf(fmaxf(C0[0], C0[1]), C1[0]), mb = fmaxf(fmaxf(C0[2], C0[3]), C1[1]); ma = fmaxf(fmaxf(ma, C1[2]), C1[3]); \
          _Pragma("unroll") for (int r = 4; r < 16; r += 4) { ma = fmaxf(fmaxf(ma, C0[r]), C0[r + 1]); mb = fmaxf(fmaxf(mb, C0[r + 2]), C0[r + 3]); ma = fmaxf(fmaxf(ma, C1[r]), C1[r + 1]); mb = fmaxf(fmaxf(mb, C1[r + 2]), C1[r + 3]); } \
          float rm = fmaxf(ma, mb); \
          { auto rr = __builtin_amdgcn_permlane32_swap(__float_as_uint(rm), __float_as_uint(rm), false, false); rm = fmaxf(__uint_as_float(rr[0]), __uint_as_float(rr[1])); } \
          if (__builtin_expect(__any(rm > ATT_THR), 0)) { const float dl = fmaxf(rm, 0.f); \
              _Pragma("unroll") for (int r = 0; r < 16; ++r) { C0[r] -= dl; C1[r] -= dl; negm[r] -= dl; } \
              AT3_PIN(negm); \
              fres = __builtin_amdgcn_exp2f(-dl); lsum *= fres; resc = true; } \
        } else if (__builtin_expect(__any(!(sacc <= AT3_SUMTHR)), 0)) {         \
            float sm = sacc; \
            { auto rr = __builtin_amdgcn_permlane32_swap(__float_as_uint(sm), __float_as_uint(sm), false, false); const float s0_ = __uint_as_float(rr[0]), s1_ = __uint_as_float(rr[1]); sm = (s0_ == s0_ && s1_ == s1_) ? fmaxf(s0_, s1_) : s0_ + s1_; } \
            if (__any(!(sm < AT3_SUMBAD))) bad = true; \
            const float dl = (sm > AT3_SUMTHR && sm < AT3_SUMBAD) ? (float)((int)(__float_as_uint(sm) >> 23) - 127) : 0.f;     \
            _Pragma("unroll") for (int r = 0; r < 16; ++r) { C0[r] -= dl; C1[r] -= dl; negm[r] -= dl; } \
            AT3_PIN(negm); \
            fres = __builtin_amdgcn_exp2f(-dl); lsum *= fres; resc = true; } \
        AT3_SB(); \
        const LAS unsigned char* kn_ = kp0 + sn * AT3_KSLOT; \
        _Pragma("unroll") for (int g = 0; g < 8; ++g) { \
            if (g >= KG0 && g < KG0 + NS) { if (GL) { const int j_ = g - KG0; kf[2 * j_] = *(const LAS bf16x8*)(kn_ + j_ * 2048); kf[2 * j_ + 1] = *(const LAS bf16x8*)(kn_ + j_ * 2048 + 512); AT3_SB(); } } \
            { const int i_ = (g >> 1) + 4 * (g & 1); \
              if (g & 1) o1 = __builtin_amdgcn_mfma_f32_32x32x16_bf16(AT3_VFR(i_), __builtin_bit_cast(bf16x8, pw[g >> 1]), o1, 0, 0, 0); \
              else o0 = __builtin_amdgcn_mfma_f32_32x32x16_bf16(AT3_VFR(i_), __builtin_bit_cast(bf16x8, pw[g >> 1]), o0, 0, 0, 0); } \
            if (g < 4) { C0[4 * g] = __builtin_amdgcn_exp2f(C0[4 * g]); C0[4 * g + 1] = __builtin_amdgcn_exp2f(C0[4 * g + 1]); C0[4 * g + 2] = __builtin_amdgcn_exp2f(C0[4 * g + 2]); C0[4 * g + 3] = __builtin_amdgcn_exp2f(C0[4 * g + 3]); AT3_PIN(C0); } \
            else { C1[4 * g - 16] = __builtin_amdgcn_exp2f(C1[4 * g - 16]); C1[4 * g - 15] = __builtin_amdgcn_exp2f(C1[4 * g - 15]); C1[4 * g - 14] = __builtin_amdgcn_exp2f(C1[4 * g - 14]); C1[4 * g - 13] = __builtin_amdgcn_exp2f(C1[4 * g - 13]); AT3_PIN(C1); } \
            AT3_SB(); } \
    } while (0)
#define AT3_RESC() do { if (resc) { _Pragma("unroll") for (int r = 0; r < 16; ++r) { o0[r] *= fres; o1[r] *= fres; } } } while (0)
    for (int t = 1; t + 3 < ntiles; t += 2) {
        AT3_STEP(pB0, pB1, pA0, pA1, t, true, true, true);      if (three) ATT_WAITBAR(3); else ATT_WAITBAR(2);  AT3_RESC(); AT3_ROT();
        AT3_STEP(pA0, pA1, pB0, pB1, t + 1, true, true, true);  if (three) ATT_WAITBAR(3); else ATT_WAITBAR(2);  AT3_RESC(); AT3_ROT();
    }
    AT3_STEP(pB0, pB1, pA0, pA1, ntiles - 3, false, true, true);   ATT_WAITBAR(1); AT3_RESC(); AT3_ROT();
    AT3_STEP(pA0, pA1, pB0, pB1, ntiles - 2, false, true, true);   ATT_WAITBAR(0); AT3_RESC(); AT3_ROT();
    AT3_STEP(pB0, pB1, pA0, pA1, ntiles - 1, false, false, false); AT3_RESC();
    { float sacc = pB0[0] + pB0[1];
#pragma unroll
      for (int r = 2; r < 16; ++r) sacc += pB0[r];
#pragma unroll
      for (int r = 0; r < 16; ++r) sacc += pB1[r];
      lsum += sacc;
#pragma unroll
      for (int k = 0; k < 4; ++k) { pw[k][0] = cvtpk(AT3_PVAL(pB0, pB1, 8 * k), AT3_PVAL(pB0, pB1, 8 * k + 1)); pw[k][1] = cvtpk(AT3_PVAL(pB0, pB1, 8 * k + 2), AT3_PVAL(pB0, pB1, 8 * k + 3));
                                    pw[k][2] = cvtpk(AT3_PVAL(pB0, pB1, 8 * k + 4), AT3_PVAL(pB0, pB1, 8 * k + 5)); pw[k][3] = cvtpk(AT3_PVAL(pB0, pB1, 8 * k + 6), AT3_PVAL(pB0, pB1, 8 * k + 7)); }
      const LAS unsigned char* vp_ = vp0 + sc * AT3_VSLOT;
#pragma unroll
      for (int i = 0; i < 8; ++i) { vlo[i] = vtr(vp_ + (i >> 2) * 4096 + (i & 3) * 1024); vhi[i] = vtr(vp_ + (i >> 2) * 4096 + (i & 3) * 1024 + 512); }
#pragma unroll
      for (int k = 0; k < 4; ++k) { o0 = __builtin_amdgcn_mfma_f32_32x32x16_bf16(AT3_VFR(k), __builtin_bit_cast(bf16x8, pw[k]), o0, 0, 0, 0); o1 = __builtin_amdgcn_mfma_f32_32x32x16_bf16(AT3_VFR(k + 4), __builtin_bit_cast(bf16x8, pw[k]), o1, 0, 0, 0); } }
#undef AT3_DMAK
#undef AT3_DMAV
#undef AT3_WB
#undef AT3_ROT
#undef AT3_PVAL
#undef AT3_VFR
#undef AT3_STEP
#undef AT3_RESC
    { auto rr = __builtin_amdgcn_permlane32_swap(__float_as_uint(lsum), __float_as_uint(lsum), false, false); lsum = __uint_as_float(rr[0]) + __uint_as_float(rr[1]); }
    const float rl = 1.0f / lsum;
#pragma unroll
    for (int g = 0; g < 4; ++g) {
        u32x2 a, b2;
        a.x = cvtpk(o0[4 * g] * rl, o0[4 * g + 1] * rl); a.y = cvtpk(o0[4 * g + 2] * rl, o0[4 * g + 3] * rl);
        b2.x = cvtpk(o1[4 * g] * rl, o1[4 * g + 1] * rl); b2.y = cvtpk(o1[4 * g + 2] * rl, o1[4 * g + 3] * rl);
        *(u32x2*)(orow + 8 * g + 4 * hi) = a; *(u32x2*)(orow + 32 + 8 * g + 4 * hi) = b2;
    }
    if (!exact) { if (__any(!(lsum < 1.2676506e30f))) bad = true;
        if (bad && lane == 0) *(volatile LAS unsigned*)(lds + AT3_FLAG) = 1u; }
    asm volatile("s_waitcnt lgkmcnt(0)\n\ts_barrier" ::: "memory");
}
struct AttDesc { bool qd96; const bf16_t* Kb; const bf16_t* Vb; const bf16_t* Qb; bf16_t* Ob; int row0, nt; };
__device__ __forceinline__ AttDesc att_desc(int i, int vcu, unsigned char* ws) {
    const bf16_t* Qm = (const bf16_t*)(ws + WS_QM); const bf16_t* Km = (const bf16_t*)(ws + WS_KM); const bf16_t* Vm = (const bf16_t*)(ws + WS_VM);
    const bf16_t* Qg = (const bf16_t*)(ws + WS_QG); const bf16_t* Kg = (const bf16_t*)(ws + WS_KG); const bf16_t* Vg = (const bf16_t*)(ws + WS_VG);
    bf16_t* O = (bf16_t*)(ws + WS_O);
    const int xcd = vcu >> 5, cix = vcu & 31;
    AttDesc d;
    if (i < 8 && (i & 1) == 0) {
        const int pair = xcd * 16 + (i >> 1) * 4 + (cix >> 3), b = pair >> 3, h = pair & 7, qb = cix & 7;
        d.qd96 = true; d.Kb = Km + (size_t)(b * 8 + h) * KPB * 96; d.Vb = Vm + (size_t)(b * 8 + h) * KPB * 64; d.Qb = Qm + h * 96; d.Ob = O + h * 64; d.row0 = b * SEQ + qb * 256; d.nt = KPB / 64;
    } else if (i < 8) {
        const int pair = xcd * 4 + (i >> 1), b = pair >> 1, kvh = pair & 1;
        d.qd96 = false; d.Kb = Kg + (size_t)(b * 2 + kvh) * KPB * 64; d.Vb = Vg + (size_t)(b * 2 + kvh) * KPB * 64; d.Qb = Qg + kvh * 256; d.Ob = O + 512 + kvh * 256; d.row0 = b * SEQ + cix * 64; d.nt = KPB / 64;
    } else if (vcu < 128) {
        const int b = vcu >> 3, h = vcu & 7;
        d.qd96 = true; d.Kb = Km + (size_t)(b * 8 + h) * KPB * 96; d.Vb = Vm + (size_t)(b * 8 + h) * KPB * 64; d.Qb = Qm + h * 96; d.Ob = O + h * 64; d.row0 = TL + b * CTX; d.nt = CTX / 64;
    } else {
        const int idx = vcu - 128, b = idx >> 3, kvh = (idx >> 2) & 1, qb = idx & 3;
        d.qd96 = false; d.Kb = Kg + (size_t)(b * 2 + kvh) * KPB * 64; d.Vb = Vg + (size_t)(b * 2 + kvh) * KPB * 64; d.Qb = Qg + kvh * 256; d.Ob = O + 512 + kvh * 256; d.row0 = TL + b * CTX + qb * 64; d.nt = CTX / 64;
    }
    return d;
}
#ifndef ATT_FORCE_EXACT
#define ATT_FORCE_EXACT 0
#endif
__device__ __forceinline__ void phase_attn(const Ctx& F, KP kp, bool last, int l) {
    const Args a = ldargs(kp);
    unsigned char* ws = a.ws;
    const int nun = last ? 8 : 9;
    if (F.tid == 0) *(volatile LAS unsigned*)(F.lds + AT3_FLAG) = ATT_FORCE_EXACT ? 1u : 0u;
    bool exact = false;
#define ATT_RUN(EX) do { \
        int tid_; { int ln_; asm volatile("v_mbcnt_lo_u32_b32 %0, -1, 0\n\tv_mbcnt_hi_u32_b32 %0, -1, %0" : "=v"(ln_)); tid_ = F.wave * 64 + ln_; }       \
        const int r32 = tid_ & 31, w = __builtin_amdgcn_readfirstlane(tid_ >> 6); \
        if (d.qd96) { const int row = d.row0 + w * 32 + r32; \
            attn_unit3<96, EX>(F.lds, tid_, d.Kb, d.Vb, d.nt, d.Qb + (size_t)row * QW, d.Ob + (size_t)row * D); \
        } else { const int row = d.row0 + (w & 1) * 32 + r32; \
            attn_unit3<64, EX>(F.lds, tid_, d.Kb, d.Vb, d.nt, d.Qb + (size_t)row * 512 + (w >> 1) * 64, d.Ob + (size_t)row * D + (w >> 1) * 64); } } while (0)
    for (int i = 0; i < nun; ++i) {
        const AttDesc d = att_desc(i, F.vcu, ws);
        if (!exact) {
            ATT_RUN(false);
            const unsigned fl = __builtin_amdgcn_readfirstlane((int)*(volatile LAS unsigned*)(F.lds + AT3_FLAG));
            if (fl != 0u) exact = true;
        }
        if (exact) ATT_RUN(true);
        if (i == (F.vcu & 7)) {
            int ln_; asm volatile("v_mbcnt_lo_u32_b32 %0, -1, 0\n\tv_mbcnt_hi_u32_b32 %0, -1, %0" : "=v"(ln_));
            conv_experts(ln_, F.wave, F.vcu, a, l);
        }
    }
#undef ATT_RUN
}
__global__ void __launch_bounds__(NTHREADS, 2) fwd_kernel(Args a_unused) {
    extern __shared__ __attribute__((aligned(16))) unsigned char lds_raw[];
    const KP kp = (KP)__builtin_amdgcn_kernarg_segment_ptr();
    Ctx F;
    F.lds = (LAS unsigned char*)lds_raw;
    F.tid = threadIdx.x; F.lane = F.tid & 63; F.wave = __builtin_amdgcn_readfirstlane(F.tid >> 6);
    F.bk = blockIdx.x; F.vcu = (F.bk & 7) * (GRID / 8) + (F.bk >> 3);
    if (F.tid < 4) ((volatile LAS unsigned*)(F.lds + MISC_BAR))[F.tid] = 0u;
    __syncthreads();
    { const Args a = ldargs(kp); (void)xcd_barrier_post((unsigned*)(a.ws + WS_CTL), (volatile LAS unsigned*)(F.lds + MISC_BAR), F.tid == 0); }
#define FRESH() do { int ln_; asm volatile("v_mbcnt_lo_u32_b32 %0, -1, 0\n\tv_mbcnt_hi_u32_b32 %0, -1, %0" : "=v"(ln_)); F.lane = ln_; F.tid = F.wave * 64 + ln_; F.bk = blockIdx.x; F.vcu = (F.bk & 7) * (GRID / 8) + (F.bk >> 3); } while (0)
#define GRID_BAR() do { XcdBarrier b_; { const Args a_ = ldargs(kp); b_.bar = (unsigned*)(a_.ws + WS_CTL); } b_.x = xb_xcc_id(); b_.st = (volatile LAS unsigned*)(F.lds + MISC_BAR); xcd_barrier(b_, F.tid == 0); } while (0)

    for (int rep_ = 0; rep_ < REP_PRO; ++rep_) prologue1(F, kp);
    GRID_BAR(); FRESH();
    prologue2(F, kp);
    prologue3(F, kp);
    GRID_BAR(); FRESH();

    for (int l = 0; l < NL; ++l) {
        const bool last = (l == NL - 1);
        const int ntok = last ? TL : MT;
        { const Args a = ldargs(kp); unsigned char* ws = a.ws;
          Gemm g{(const bf16_t*)(ws + WS_H), D, (const bf16_t*)(ws + WS_WIN) + (size_t)l * ZW * D, D}; StaticOrder S; S.init(MT, ZW, GRID, F.bk);
#if FUSE_SPLIT
          LAS f32x2* t64l = (LAS f32x2*)(F.lds + STAGE_BYTES); LAS f32x2* t32l = t64l + 1024; LAS float* ggl = (LAS float*)(t32l + 512);
          { const f32x2* t64g = (const f32x2*)(ws + WS_TAB64); const f32x2* t32g = (const f32x2*)(ws + WS_TAB32);
            t64l[F.tid] = t64g[F.tid]; t64l[F.tid + 512] = t64g[F.tid + 512]; t32l[F.tid] = t32g[F.tid];
            if (F.tid < 64) ggl[F.tid] = a.g_gq[l * 64 + F.tid]; else if (F.tid < 128) ggl[F.tid] = a.g_gk[l * 64 + F.tid - 64]; }
          __syncthreads();
          EpiIn E{ws, ggl, ggl + 64, t64l, t32l}; gemm_phase<0>(F, g, S, E); }
#else
          EpiZ E{(bf16_t*)(ws + WS_Z)}; gemm_phase<0>(F, g, S, E); }
#endif
        GRID_BAR(); FRESH();
#if !FUSE_SPLIT
        for (int rep_ = 0; rep_ < REP_P2; ++rep_) phase_split(F, kp, l);
        GRID_BAR(); FRESH();
#endif
        { const Args a = ldargs(kp); unsigned char* ws = a.ws;
          Gemm g{(const bf16_t*)(ws + WS_Z), ZW, (const bf16_t*)(ws + WS_WQ) + (size_t)l * QW * 384, 384}; StaticOrder S; S.init(MT, QW, GRID, F.bk);
          LAS f32x2* t32l = (LAS f32x2*)(F.lds + STAGE_BYTES);
          LAS float* rsq = (LAS float*)(F.lds + STAGE_BYTES + 4096);
          { const f32x2* t32g = (const f32x2*)(ws + WS_TAB32); t32l[F.tid] = t32g[F.tid];
            Unit u; for (int i = 0; i < 4 && S.next(i, u); ++i) if (F.tid < 256) rsq[i * 256 + F.tid] = EpiQ::rowscale(ws, u.pm * 256 + F.tid); }
          __syncthreads();
          EpiQ E{ws, t32l, rsq}; gemm_phase<1>(F, g, S, E); }
        FRESH();
        { const Args a = ldargs(kp); unsigned char* ws = a.ws;
          Gemm g{(const bf16_t*)(ws + WS_Z) + 384, ZW, (const bf16_t*)(ws + WS_WKV) + (size_t)l * KVW * 256, 256}; StaticOrder S; S.init(MT, KVW, GRID, (F.bk + 80) & 255);
          LAS float* rskv = (LAS float*)(F.lds + STAGE_BYTES + 8192);
          { Unit u; for (int i = 0; i < 4 && S.next(i, u); ++i) if (F.tid < 256) rskv[i * 256 + F.tid] = EpiKV::rowscale(ws, u.pm * 256 + F.tid); }
          __syncthreads();
          EpiKV E{ws, rskv}; gemm_phase<2>(F, g, S, E); }
        GRID_BAR(); FRESH();
#if USE_MFMA_ATTN
        for (int rep_ = 0; rep_ < REP_ATTN; ++rep_) phase_attn(F, kp, last, l);
        FRESH();
#else
#error the scalar attention body reads the old row-major K/V layout
#endif
        GRID_BAR(); FRESH();
        { const Args a = ldargs(kp); unsigned char* ws = a.ws;
          Gemm g{(const bf16_t*)(ws + WS_O), D, (const bf16_t*)(ws + WS_WO) + (size_t)l * D * D, D}; StaticOrder S; S.init(ntok, D, GRID, F.bk);
          EpiYo E{(bf16_t*)(ws + WS_U)}; gemm_phase<3>(F, g, S, E); }
        GRID_BAR(); FRESH();
        if (l == 0) phase_ln1_route<true>(F, kp, l, ntok); else phase_ln1_route<false>(F, kp, l, ntok);
        GRID_BAR(); FRESH();
        for (int rep_ = 0; rep_ < REP_P7; ++rep_) phase_dispatch(F, kp, l, ntok);
        GRID_BAR(); FRESH();
        { const Args a = ldargs(kp); unsigned char* ws = a.ws;
          Gemm g{(const bf16_t*)(ws + WS_H), D, (const bf16_t*)(ws + WS_WGU) + (size_t)l * NEXP * 1024 * D, D}; GroupedOrder S; S.init((const volatile LAS int*)(F.lds + MISC_POFF), GRID, F.vcu);
          LAS int* gt = (LAS int*)(F.lds + STAGE_BYTES);
          { const int* postok = (const int*)(ws + WS_POSTOK); Unit u; for (int i = 0; i < 16 && S.next(i, u); ++i) if (F.tid < 256) gt[i * 256 + F.tid] = postok[u.pm * 256 + F.tid]; }
          __syncthreads();
          EpiAct E{(bf16_t*)(ws + WS_ACT)}; gemm_phase_gather<4>(F, g, S, E, gt); }
        GRID_BAR(); FRESH();
        { const Args a = ldargs(kp); unsigned char* ws = a.ws;
          Gemm g{(const bf16_t*)(ws + WS_ACT), FF, (const bf16_t*)(ws + WS_WD) + (size_t)l * NEXP * D * FF, FF}; GroupedOrder S; S.init((const volatile LAS int*)(F.lds + MISC_POFF), GRID, F.vcu);
          EpiY E{(bf16_t*)(ws + WS_XS)}; gemm_phase<5>(F, g, S, E); }
        GRID_BAR(); FRESH();
        phase_ln2(F, kp, l, ntok);
        GRID_BAR(); FRESH();
    }
}

extern "C" void kernel_launch(void* const* d_in, const int* in_sizes, int n_in, void* d_out, int out_size, void* d_ws, size_t ws_size, hipStream_t stream) {
    static int grid = 0;
    if (grid == 0) {
        if (n_in != 25 || out_size != TL * D || ws_size < WS_END) { fprintf(stderr, "kernel_launch: unexpected shapes (n_in %d out %d ws %zu need %zu)\n", n_in, out_size, ws_size, (size_t)WS_END); grid = -1; return; }
        int dev = 0, cus = 0, per_cu = 0;
        if (hipGetDevice(&dev) != hipSuccess || hipDeviceGetAttribute(&cus, hipDeviceAttributeMultiprocessorCount, dev) != hipSuccess) { grid = -1; return; }
        if (hipFuncSetAttribute((const void*)fwd_kernel, hipFuncAttributeMaxDynamicSharedMemorySize, LDS_BYTES) != hipSuccess) { fprintf(stderr, "kernel_launch: hipFuncSetAttribute failed\n"); grid = -1; return; }
        if (hipOccupancyMaxActiveBlocksPerMultiprocessor(&per_cu, (const void*)fwd_kernel, NTHREADS, LDS_BYTES) != hipSuccess || per_cu < 1) { fprintf(stderr, "kernel_launch: occupancy query says %d\n", per_cu); }
        (void)hipGetLastError();
        grid = (cus == 256) ? 256 : -1;
        if (grid < 0) { fprintf(stderr, "kernel_launch: need a 256-CU device, got %d\n", cus); return; }
    }
    if (grid < 0) return;
    if (hipMemsetAsync((char*)d_ws + WS_CTL, 0, CTL_BYTES, stream) != hipSuccess) return;
    Args a{};
    a.x = (const float*)d_in[0]; a.c = (const float*)d_in[1]; a.ctx = (const float*)d_in[2]; a.c_ctx = (const float*)d_in[3]; a.w_ada = (const float*)d_in[4]; a.b_ada = (const float*)d_in[5];
    a.w_in = (const float*)d_in[6]; a.g_q_a = (const float*)d_in[7]; a.w_q_b = (const float*)d_in[8]; a.g_kv_a = (const float*)d_in[9]; a.w_kv_b = (const float*)d_in[10];
    a.g_gq = (const float*)d_in[11]; a.g_gk = (const float*)d_in[12]; a.w_o = (const float*)d_in[13]; a.ln1_g = (const float*)d_in[14]; a.ln1_b = (const float*)d_in[15];
    a.w_rg = (const float*)d_in[16]; a.b_rg = (const float*)d_in[17]; a.w_re = (const float*)d_in[18]; a.b_re = (const float*)d_in[19];
    a.w_gate = (const float*)d_in[20]; a.w_up = (const float*)d_in[21]; a.w_down = (const float*)d_in[22]; a.ln2_g = (const float*)d_in[23]; a.ln2_b = (const float*)d_in[24];
    a.out = (float*)d_out; a.ws = (unsigned char*)d_ws;
    hipLaunchKernelGGL(fwd_kernel, dim3(grid), dim3(NTHREADS), LDS_BYTES, stream, a);
}
```

```cpp
#include <hip/hip_runtime.h>
#include <cstdint>
#include <cstdio>

#ifndef REP_ATTN
#define REP_ATTN 1
#endif
#ifndef REP_GEMM
#define REP_GEMM 1
#endif
#ifndef REP_PRO
#define REP_PRO 1
#endif
#ifndef REP_THIN
#define REP_THIN 1
#endif
#ifndef REP_P2
#define REP_P2 1
#endif
#ifndef REP_P7
#define REP_P7 1
#endif
#ifndef REP_P6
#define REP_P6 1
#endif
#ifndef REP_P10
#define REP_P10 0
#endif
#ifndef FILL_P1
#define FILL_P1 3
#endif
#ifndef FILL_P5
#define FILL_P5 3
#endif
#ifndef FUSE_SPLIT
#define FUSE_SPLIT 1
#endif
#ifndef USE_MFMA_GEMM
#define USE_MFMA_GEMM 1
#endif
#ifndef USE_MFMA_ATTN
#define USE_MFMA_ATTN 1
#endif

#define GAS __attribute__((address_space(1)))
#define LAS __attribute__((address_space(3)))
typedef unsigned short bf16_t;
typedef float f32x4 __attribute__((ext_vector_type(4)));
typedef float f32x2 __attribute__((ext_vector_type(2)));
typedef unsigned u32x4 __attribute__((ext_vector_type(4)));
typedef unsigned u32x2 __attribute__((ext_vector_type(2)));
typedef short bf16x8 __attribute__((ext_vector_type(8)));

constexpr int D = 1024, NB = 16, SEQ = 2048, CTX = 256, NL = 4;
constexpr int TL = NB * SEQ, TC = NB * CTX, MT = TL + TC;
constexpr int KPB = CTX + SEQ;
constexpr int ZW = 1536;
constexpr int QW = 768, KVW = 1024;
constexpr int NEXP = 32, FF = 512;
constexpr int XS_ROWS = 81920;
constexpr float ALPHA = 1.6817928305074290f;
constexpr float LOG2E = 1.4426950408889634f;
constexpr float QSCALE_M = 0.10206207261596575f * LOG2E;
constexpr float QSCALE_G = 0.125f * LOG2E;
constexpr float RMS_EPS = 1e-6f, LN_EPS = 1e-5f;
constexpr int NWAVES = 8, NTHREADS = 512, GRID = 256;

constexpr size_t al256(size_t x) { return (x + 255) & ~(size_t)255; }
constexpr size_t WS_CTL = 0, CTL_BYTES = 65536;
constexpr size_t WS_BLKCNT = WS_CTL + CTL_BYTES;
constexpr size_t WS_MOETAB = WS_BLKCNT + (size_t)NL * 256 * 32 * 4;
constexpr size_t WS_MOD = WS_MOETAB + (size_t)NL * 128 * 4;
constexpr size_t WS_MODP = WS_MOD + (size_t)NL * 17 * 6144 * 4;
constexpr size_t WS_TAB64 = WS_MODP + (size_t)4 * NL * 17 * 6144 * 4;
constexpr size_t WS_TAB32 = WS_TAB64 + 64 * 16 * 8;
constexpr size_t WS_RSTDQ = WS_TAB32 + 64 * 8 * 8;
constexpr size_t WS_RSTDKV = WS_RSTDQ + (size_t)MT * 4;
constexpr size_t WS_TOKE = WS_RSTDKV + (size_t)MT * 4;
constexpr size_t WS_TOKR = WS_TOKE + (size_t)MT * 8;
constexpr size_t WS_TOKP = WS_TOKR + (size_t)MT * 8;
constexpr size_t WS_TOKW = WS_TOKP + (size_t)MT * 8;
constexpr size_t WS_WIN = al256(WS_TOKW + (size_t)MT * 8);
constexpr size_t WS_WQ = WS_WIN + (size_t)NL * ZW * D * 2;
constexpr size_t WS_WKV = WS_WQ + (size_t)NL * QW * 384 * 2;
constexpr size_t WS_WO = WS_WKV + (size_t)NL * KVW * 256 * 2;
constexpr size_t WS_WGU = WS_WO + (size_t)NL * D * D * 2;
constexpr size_t WS_WD = WS_WGU + (size_t)NL * NEXP * 1024 * D * 2;
constexpr size_t WS_XC = WS_WD + (size_t)NL * NEXP * D * FF * 2;
constexpr size_t WS_H = WS_XC + (size_t)TC * D * 4;
constexpr size_t WS_B = WS_H + (size_t)MT * D * 2;
constexpr size_t WS_Z = WS_B;
constexpr size_t WS_QM = WS_Z + (size_t)MT * ZW * 2;
constexpr size_t WS_KM = WS_QM + (size_t)MT * QW * 2;
constexpr size_t WS_VM = WS_KM + (size_t)MT * QW * 2;
constexpr size_t WS_QG = WS_VM + (size_t)MT * 512 * 2;
constexpr size_t WS_KG = WS_QG + (size_t)MT * 512 * 2;
constexpr size_t WS_VG = WS_KG + (size_t)MT * 128 * 2;
constexpr size_t WS_O = WS_VG + (size_t)MT * 128 * 2;
constexpr size_t WS_BEND = WS_O + (size_t)MT * D * 2;
constexpr size_t WS_U = WS_B;
constexpr size_t WS_XS = WS_B;
constexpr size_t WS_ACT = WS_XS + (size_t)XS_ROWS * D * 2;
constexpr size_t WS_HLO = WS_BEND;
constexpr size_t WS_WR = WS_HLO + (size_t)MT * D * 2;
constexpr size_t WS_POSTOK = WS_WR + (size_t)NL * 2 * 48 * D * 2;
constexpr size_t WS_SSQP = al256(WS_POSTOK + (size_t)XS_ROWS * 4);
constexpr size_t WS_XB = al256(WS_SSQP + (size_t)MT * 20 * 4);
constexpr size_t WS_END = WS_XB + (size_t)MT * D * 2;
static_assert(WS_U + (size_t)MT * D * 4 <= WS_KM, "U must fit in Z+QM");
static_assert(WS_ACT + (size_t)XS_ROWS * FF * 2 <= WS_BEND, "MoE buffers must fit in region B");
static_assert(WS_END < (size_t)1100 * 1000 * 1000, "workspace map too large");

constexpr int LDS_BYTES = 163840;
constexpr int BIG_BYTES = 147456;
constexpr int MISC_OFF = BIG_BYTES;
constexpr int MISC_BAR = MISC_OFF;
constexpr int MISC_CNT = MISC_OFF + 64;
constexpr int MISC_POFF = MISC_OFF + 256;
constexpr int MISC_TOT = MISC_OFF + 512;
constexpr int MISC_BASE = MISC_OFF + 768;
constexpr int MISC_PA = MISC_OFF + 1024;
constexpr int MISC_PB = MISC_OFF + 1024 + 2048;
constexpr int MISC_LG = MISC_OFF + 8192;

#define LDS_WAIT() asm volatile("s_waitcnt lgkmcnt(0)" ::: "memory")
__device__ __forceinline__ unsigned f2bf(float f) { unsigned u = __builtin_bit_cast(unsigned, f); return (u + 0x7fffu + ((u >> 16) & 1u)) >> 16; }
__device__ __forceinline__ unsigned pk2(float lo, float hi) { typedef __bf16 bf2_t __attribute__((ext_vector_type(2))); f32x2 v = {lo, hi}; bf2_t b = __builtin_convertvector(v, bf2_t); return __builtin_bit_cast(unsigned, b); }
__device__ __forceinline__ float bflo(unsigned w) { return __builtin_bit_cast(float, w << 16); }
__device__ __forceinline__ float bfhi(unsigned w) { return __builtin_bit_cast(float, w & 0xffff0000u); }
template <int K> __device__ __forceinline__ float lane_xor(float v) { return __int_as_float(__builtin_amdgcn_ds_swizzle(__float_as_int(v), (K << 10) | 0x1f)); }
__device__ __forceinline__ float wave_sum(float v) {
    v += lane_xor<1>(v); v += lane_xor<2>(v); v += lane_xor<4>(v); v += lane_xor<8>(v); v += lane_xor<16>(v);
    { auto rr = __builtin_amdgcn_permlane32_swap(__float_as_uint(v), __float_as_uint(v), false, false); v = __uint_as_float(rr[0]) + __uint_as_float(rr[1]); }
    return v;
}
__device__ __forceinline__ int krow_of(int r) { return r < TL ? (r >> 11) * KPB + CTX + (r & 2047) : ((r - TL) >> 8) * KPB + ((r - TL) & 255); }
__device__ __forceinline__ void key_bj(int r, int& b, int& j) { if (r < TL) { b = r >> 11; j = CTX + (r & 2047); } else { b = (r - TL) >> 8; j = (r - TL) & 255; } }
__device__ __forceinline__ size_t ktile_off(int nh, int b, int h, int j, int qd, int chunk) { return ((size_t)(b * nh + h) * KPB + (j & ~63)) * qd + chunk * 512 + (j & 63) * 8; }
__device__ __forceinline__ size_t vtile_off(int nh, int b, int h, int j, int d0) { return ((size_t)(b * nh + h) * KPB + (j & ~63)) * 64 + (d0 >> 5) * 2048 + (j & 63) * 32 + (d0 & 31); }
__device__ __forceinline__ int bb_of(int r) { return r < TL ? (r >> 11) : 16; }

#define XB_TMO      128
#define XB_XCNT(j)  (256  + 64 * (j))
#define XB_XSUB(j)  (1280 + 64 * (j))
#define XB_XGEN(j)  (2304 + 64 * (j))
#define XB_TOP      3328
#define XB_TOPGEN   3392
#define XCD_BAR_WORDS 3456
#define XB_SPIN_CAP (1u << 18)
__device__ __forceinline__ unsigned xb_ld(unsigned* p)              { return __hip_atomic_load(p, __ATOMIC_RELAXED, __HIP_MEMORY_SCOPE_AGENT); }
__device__ __forceinline__ unsigned xb_add(unsigned* p, unsigned v) { return __hip_atomic_fetch_add(p, v, __ATOMIC_RELAXED, __HIP_MEMORY_SCOPE_AGENT); }
__device__ __forceinline__ unsigned xb_xcc_id() { return (unsigned)__builtin_amdgcn_s_getreg((3 << 11) | 20) & 0xFu; }
#define XB_SPIN(cond, bar) do { unsigned _sp = 0; while (cond) { __builtin_amdgcn_s_sleep(1); \
    if ((++_sp & 255u) == 0u) { if (xb_ld(&(bar)[XB_TMO])) break; if (_sp > XB_SPIN_CAP) { atomicAdd(&(bar)[XB_TMO], 1u); break; } } } } while (0)
struct XcdBarrier { unsigned* bar; unsigned x; volatile LAS unsigned* st; };
__device__ __forceinline__ XcdBarrier xcd_barrier_post(unsigned* bar, volatile LAS unsigned* st, const bool leader) {
    XcdBarrier b; b.bar = bar; b.x = xb_xcc_id(); b.st = st;
    if (leader) (void)xb_add(&bar[XB_XCNT(b.x)], 1u);
    return b;
}
__device__ __forceinline__ void xcd_barrier_complete(unsigned* bar, unsigned x, unsigned& nloc, unsigned& nx) {
    const unsigned G = gridDim.x * gridDim.y * gridDim.z;
    unsigned sum, cnt, mine, sp = 0u;
    for (;;) {
        sum = 0u; cnt = 0u; mine = 0u;
#pragma unroll
        for (unsigned j = 0; j < 16; ++j) { const unsigned c = xb_ld(&bar[XB_XCNT(j)]); sum += c; cnt += (c > 0u) ? 1u : 0u; mine = (j == x) ? c : mine; }
        if (sum == G) break;
        __builtin_amdgcn_s_sleep(1);
        if ((++sp & 255u) == 0u) { if (xb_ld(&bar[XB_TMO])) break; if (sp > XB_SPIN_CAP) { atomicAdd(&bar[XB_TMO], 1u); break; } }
    }
    nloc = mine > 0u ? mine : 1u; nx = cnt > 0u ? cnt : 1u;
}
__device__ __forceinline__ void xcd_barrier(const XcdBarrier& b, const bool leader) {
    asm volatile("s_waitcnt vmcnt(0)" ::: "memory");
    __syncthreads();
    if (leader) {
        unsigned* bar = b.bar;
        __builtin_amdgcn_s_waitcnt(0);
        unsigned nloc = b.st[0], nx = b.st[1];
        if (nloc == 0u) { xcd_barrier_complete(bar, b.x, nloc, nx); b.st[0] = nloc; b.st[1] = nx; }
        const unsigned old = xb_add(&bar[XB_XSUB(b.x)], 1u);
        const unsigned gen = old / nloc;
        if (old + 1u == (gen + 1u) * nloc) {
            __builtin_amdgcn_fence(__ATOMIC_RELEASE, "agent");
            asm volatile("s_waitcnt vmcnt(0)" ::: "memory");
            const unsigned og = xb_add(&bar[XB_TOP], 1u);
            const unsigned tg = og / nx;
            if (og + 1u == (tg + 1u) * nx) xb_add(&bar[XB_TOPGEN], 1u);
            else XB_SPIN(xb_ld(&bar[XB_TOPGEN]) == tg, bar);
            __builtin_amdgcn_fence(__ATOMIC_ACQUIRE, "agent");
            xb_add(&bar[XB_XGEN(b.x)], 1u);
            asm volatile("s_waitcnt vmcnt(0)" ::: "memory");
        } else {
            XB_SPIN(xb_ld(&bar[XB_XGEN(b.x)]) == gen, bar);
            __builtin_amdgcn_fence(__ATOMIC_ACQUIRE, "agent");
            asm volatile("s_waitcnt vmcnt(0)" ::: "memory");
        }
    }
    __syncthreads();
}

struct Args {
    const float* x; const float* c; const float* ctx; const float* c_ctx; const float* w_ada; const float* b_ada; const float* w_in;
    const float* g_q_a; const float* w_q_b; const float* g_kv_a; const float* w_kv_b; const float* g_gq; const float* g_gk; const float* w_o;
    const float* ln1_g; const float* ln1_b; const float* w_rg; const float* b_rg; const float* w_re; const float* b_re;
    const float* w_gate; const float* w_up; const float* w_down; const float* ln2_g; const float* ln2_b;
    float* out; unsigned char* ws;
};

typedef const __attribute__((address_space(4))) Args* KP;
__device__ __forceinline__ Args ldargs(KP p) {
#if defined(__HIP_DEVICE_COMPILE__)
    asm volatile("" : "+s"(p)); return *p;
#else
    return Args{};
#endif
}

struct Ctx {
    LAS unsigned char* lds;
    int tid, lane, wave, vcu, bk;
};

struct Unit { int pm, pn; };
constexpr int BM = 256, NXCD = 8, WGM = 8;
struct StaticOrder {
    int nM, nN, nwg, G, c;
    __device__ __forceinline__ void init(int M, int N, int G_, int c_) { nM = M / BM; nN = N / BM; nwg = nM * nN; G = G_; c = c_; }
    __device__ __forceinline__ bool next(int i, Unit& u) const {
        const long L = (long)i * G + c; if (L >= nwg) return false;
        int wgid = (int)L; { const int q = nwg / NXCD, r = nwg % NXCD, xcd = wgid % NXCD, off = wgid / NXCD; wgid = (xcd < r ? xcd * (q + 1) : r * (q + 1) + (xcd - r) * q) + off; }
        const int nig = WGM * nN, gid = wgid / nig, fm = gid * WGM, gsz = (nM - fm) < WGM ? (nM - fm) : WGM;
        u.pm = fm + ((wgid % nig) % gsz); u.pn = (wgid % nig) / gsz; return true;
    }
    __device__ __forceinline__ void a_ready(const Unit&) const {}
    __device__ __forceinline__ void done(const Unit&) const {}
};
struct GroupedOrder {
    const volatile LAS int* poff; int nunits, G, c;
    __device__ __forceinline__ void init(const volatile LAS int* poff_, int G_, int c_) { poff = poff_; nunits = (poff_[32] >> 8) * 4; G = G_; c = c_; }
    __device__ __forceinline__ bool next(int i, Unit& u) const {
        const int L = i * G + c; if (L >= nunits) return false;
        const int rt = L >> 2, r0 = rt << 8; int e = 0;
#pragma unroll
        for (int j = 1; j < 32; ++j) e += (poff[j] <= r0) ? 1 : 0;
        u.pm = rt; u.pn = e * 4 + (L & 3); return true;
    }
    __device__ __forceinline__ void a_ready(const Unit&) const {}
    __device__ __forceinline__ void done(const Unit&) const {}
};

__device__ __forceinline__ void st_bf4(bf16_t* p, f32x4 v) { u32x2 w; w.x = pk2(v[0], v[1]); w.y = pk2(v[2], v[3]); *(u32x2*)p = w; }
__device__ __forceinline__ void st_bf8(bf16_t* p, f32x4 a, f32x4 b) { u32x4 w; w.x = pk2(a[0], a[1]); w.y = pk2(a[2], a[3]); w.z = pk2(b[0], b[1]); w.w = pk2(b[2], b[3]); *(u32x4*)p = w; }
struct EpiZ {
    static constexpr bool PERM = true;
    bf16_t* Z;
    __device__ __forceinline__ void tile32(int row, int col, int fq, f32x4 v0, f32x4 v1) const { st_bf8(Z + (size_t)row * ZW + col + 8 * fq, v0, v1); }
};
__device__ __forceinline__ float xor32(float v, bool lower) { auto rr = __builtin_amdgcn_permlane32_swap(__float_as_uint(v), __float_as_uint(v), false, false); return __uint_as_float(lower ? rr[1] : rr[0]); }
struct EpiIn {
    static constexpr bool PERM = true, PAIR = true;
    unsigned char* wsb; const LAS float* ggq; const LAS float* ggk; const LAS f32x2* t64l; const LAS f32x2* t32l;
    __device__ __forceinline__ float sum4(float s, int fq) const { s += lane_xor<16>(s); s += xor32(s, fq < 2); return s; }
    __device__ __forceinline__ void za(int row, int col, int fq, f32x4 v0, f32x4 v1) const {
        bf16_t* Z = (bf16_t*)(wsb + WS_Z); float* ssqp = (float*)(wsb + WS_SSQP); bf16_t* Km = (bf16_t*)(wsb + WS_KM); const LAS f32x2* t32 = t32l;
        if (col < 640) {
            st_bf8(Z + (size_t)row * ZW + col + 8 * fq, v0, v1);
            float s = (v0[0] * v0[0] + v0[1] * v0[1]) + (v0[2] * v0[2] + v0[3] * v0[3]) + (v1[0] * v1[0] + v1[1] * v1[1]) + (v1[2] * v1[2] + v1[3] * v1[3]);
            s = sum4(s, fq);
            if (fq == 0) ssqp[(size_t)row * 20 + (col >> 5)] = s;
        } else if (col == 640) {
            float v[8] = {v0[0], v0[1], v0[2], v0[3], v1[0], v1[1], v1[2], v1[3]}, o[8];
#pragma unroll
            for (int e = 0; e < 8; ++e) { const float p = lane_xor<16>(v[e]); o[e] = v[e];
                if (row < TL) { const int s2 = row & 2047, pos = (fq >> 1) ? (s2 & 63) : (s2 >> 6); const f32x2 c = t32[pos * 8 + e]; o[e] = (fq & 1) ? (v[e] * c.x + p * c.y) : (v[e] * c.x - p * c.y); } }
            u32x4 w; w.x = pk2(o[0], o[1]); w.y = pk2(o[2], o[3]); w.z = pk2(o[4], o[5]); w.w = pk2(o[6], o[7]);
            int kb, kj; key_bj(row, kb, kj);
#pragma unroll
            for (int h = 0; h < 8; ++h) *(u32x4*)(Km + ktile_off(8, kb, h, kj, 96, 8 + fq)) = w;
        }
    }
    __device__ __forceinline__ void head(int row, int fq, f32x4 a0, f32x4 a1, f32x4 b0, f32x4 b1, const LAS float* g, float scale, bf16_t* dlo, bf16_t* dhi) const {
        const LAS f32x2* t64 = t64l;
        float lo[8] = {a0[0], a0[1], a0[2], a0[3], a1[0], a1[1], a1[2], a1[3]}, hi[8] = {b0[0], b0[1], b0[2], b0[3], b1[0], b1[1], b1[2], b1[3]};
        float ss = 0.f;
#pragma unroll
        for (int e = 0; e < 8; ++e) ss += lo[e] * lo[e] + hi[e] * hi[e];
        ss = sum4(ss, fq);
        const float rn = __builtin_amdgcn_rsqf(ss * (1.0f / 64.0f) + RMS_EPS) * scale;
        const bool lat = row < TL, lower = fq < 2; const int s2 = row & 2047, gr = s2 >> 6, gc = s2 & 63, f0 = 8 * (fq & 1);
        const LAS f32x4* gp = (const LAS f32x4*)(g + 8 * fq); const f32x4 g0 = gp[0], g1 = gp[1], g2 = gp[8], g3 = gp[9];
        const float gl[8] = {g0[0], g0[1], g0[2], g0[3], g1[0], g1[1], g1[2], g1[3]}, gh[8] = {g2[0], g2[1], g2[2], g2[3], g3[0], g3[1], g3[2], g3[3]};
        float ol[8], oh[8];
        if (lat) {
            const LAS f32x4* tl = (const LAS f32x4*)(t64 + gr * 16 + f0); const LAS f32x4* th = (const LAS f32x4*)(t64 + gc * 16 + f0);
            const f32x4 cl0 = tl[0], cl1 = tl[1], cl2 = tl[2], cl3 = tl[3], ch0 = th[0], ch1 = th[1], ch2 = th[2], ch3 = th[3];
            const float cL[8] = {cl0[0], cl0[2], cl1[0], cl1[2], cl2[0], cl2[2], cl3[0], cl3[2]}, sL[8] = {cl0[1], cl0[3], cl1[1], cl1[3], cl2[1], cl2[3], cl3[1], cl3[3]};
            const float cH[8] = {ch0[0], ch0[2], ch1[0], ch1[2], ch2[0], ch2[2], ch3[0], ch3[2]}, sH[8] = {ch0[1], ch0[3], ch1[1], ch1[3], ch2[1], ch2[3], ch3[1], ch3[3]};
#pragma unroll
            for (int e = 0; e < 8; ++e) {
                const float yl = lo[e] * rn * gl[e], yh = hi[e] * rn * gh[e];
                const float pl = xor32(yl, lower), ph = xor32(yh, lower);
                ol[e] = lower ? (yl * cL[e] - pl * sL[e]) : (yl * cL[e] + pl * sL[e]);
                oh[e] = lower ? (yh * cH[e] - ph * sH[e]) : (yh * cH[e] + ph * sH[e]);
            }
        } else {
#pragma unroll
            for (int e = 0; e < 8; ++e) { ol[e] = lo[e] * rn * gl[e]; oh[e] = hi[e] * rn * gh[e]; }
        }
        u32x4 w; w.x = pk2(ol[0], ol[1]); w.y = pk2(ol[2], ol[3]); w.z = pk2(ol[4], ol[5]); w.w = pk2(ol[6], ol[7]); *(u32x4*)dlo = w;
        w.x = pk2(oh[0], oh[1]); w.y = pk2(oh[2], oh[3]); w.z = pk2(oh[4], oh[5]); w.w = pk2(oh[6], oh[7]); *(u32x4*)dhi = w;
    }
    __device__ __forceinline__ void tile64(int row, int pn, int wc, int fq, f32x4 a0, f32x4 a1, f32x4 b0, f32x4 b1) const {
        if (pn < 3) { const int col = pn * 256 + wc * 32; za(row, col, fq, a0, a1); za(row, col + 128, fq, b0, b1); }
        else if (pn < 5) { const int h = 4 * (pn - 3) + wc; bf16_t* q = (bf16_t*)(wsb + WS_QG) + (size_t)row * 512 + 64 * h + 8 * fq; head(row, fq, a0, a1, b0, b1, ggq, QSCALE_G, q, q + 32); }
        else { int kb, kj; key_bj(row, kb, kj);
            if (wc < 2) { bf16_t* Kg = (bf16_t*)(wsb + WS_KG); head(row, fq, a0, a1, b0, b1, ggk, 1.0f, Kg + ktile_off(2, kb, wc, kj, 64, fq), Kg + ktile_off(2, kb, wc, kj, 64, 4 + fq)); }
            else { bf16_t* Vg = (bf16_t*)(wsb + WS_VG); st_bf8(Vg + vtile_off(2, kb, wc - 2, kj, 8 * fq), a0, a1); st_bf8(Vg + vtile_off(2, kb, wc - 2, kj, 32 + 8 * fq), b0, b1); } }
    }
};
struct EpiQ {
    static constexpr bool PERM = true, PREP = true;
    unsigned char* wsb;
    const LAS f32x2* tab32;
    const LAS float* rsl;
    static __device__ __forceinline__ float rowscale(const unsigned char* wsb_, int row) {
        const float* rstd = (const float*)(wsb_ + WS_SSQP);
        const f32x4* sp = (const f32x4*)(rstd + (size_t)row * 20); const f32x4 s0 = sp[0], s1 = sp[1], s2 = sp[2];
        return QSCALE_M / sqrtf(((s0[0] + s0[1]) + (s0[2] + s0[3]) + (s1[0] + s1[1]) + (s1[2] + s1[3]) + (s2[0] + s2[1]) + (s2[2] + s2[3])) * (1.0f / 384.0f) + RMS_EPS);
    }
    __device__ __forceinline__ void tile32u(int row, int col, int fq, f32x4 v0, f32x4 v1, int ui) const {
        const float rs = rsl[ui * 256 + (row & 255)];
        bf16_t* Qm = (bf16_t*)(wsb + WS_QM);
        const int h = col / 96, gi = (col - h * 96) >> 5;
        v0 = v0 * rs; v1 = v1 * rs;
        bf16_t* base = Qm + (size_t)row * QW + h * 96;
        if (gi < 2) { st_bf8(base + gi * 32 + 8 * fq, v0, v1); }
        else {
            const int part = fq >> 1, f0 = (4 * fq) & 7;
            f32x4 o1 = v0, o2 = v1;
            if (row < TL) {
                const int s = row & 2047, pos = part ? (s & 63) : (s >> 6);
#pragma unroll
                for (int j = 0; j < 4; ++j) { const f32x2 cs = tab32[pos * 8 + f0 + j]; o1[j] = v0[j] * cs.x - v1[j] * cs.y; o2[j] = v1[j] * cs.x + v0[j] * cs.y; }
            }
            bf16_t* p = base + 64 + part * 16 + f0; st_bf4(p, o1); st_bf4(p + 8, o2);
        }
    }
};
struct EpiKV {
    static constexpr bool PERM = true, PREP = true;
    unsigned char* wsb;
    const LAS float* rsl;
    static __device__ __forceinline__ float rowscale(const unsigned char* wsb_, int row) {
        const float* rstd = (const float*)(wsb_ + WS_SSQP);
        const f32x4* sp = (const f32x4*)(rstd + (size_t)row * 20 + 12); const f32x4 s0 = sp[0], s1 = sp[1];
        return 1.0f / sqrtf(((s0[0] + s0[1]) + (s0[2] + s0[3]) + (s1[0] + s1[1]) + (s1[2] + s1[3])) * (1.0f / 256.0f) + RMS_EPS);
    }
    __device__ __forceinline__ void tile32u(int row, int col, int fq, f32x4 v0, f32x4 v1, int ui) const {
        const float rs = rsl[ui * 256 + (row & 255)];
        bf16_t* Km = (bf16_t*)(wsb + WS_KM); bf16_t* Vm = (bf16_t*)(wsb + WS_VM);
        const int h = col >> 7, w = (col & 127) + 8 * fq; int kb, kj; key_bj(row, kb, kj);
        bf16_t* p = (w < 64) ? (Km + ktile_off(8, kb, h, kj, 96, w >> 3)) : (Vm + vtile_off(8, kb, h, kj, w - 64));
        st_bf8(p, v0 * rs, v1 * rs);
    }
};
struct EpiU {
    static constexpr bool PERM = false;
    float* U; const float* xl; const float* xc; const float* mod_l;
    int gate;
    __device__ __forceinline__ void tile32(int row, int col, int fq, f32x4 v0, f32x4 v1) const {
        const float* xr = (row < TL) ? (xl + (size_t)row * D) : (xc + (size_t)(row - TL) * D);
        const float* g = mod_l + (size_t)(bb_of(row) * 6 + gate) * D;
        const int c0 = col + 4 * fq;
        const f32x4 x0 = *(const f32x4*)(xr + c0), x1 = *(const f32x4*)(xr + c0 + 16), g0 = *(const f32x4*)(g + c0), g1 = *(const f32x4*)(g + c0 + 16);
        float* u = U + (size_t)row * D + c0;
        *(f32x4*)u = x0 * ALPHA + g0 * v0; *(f32x4*)(u + 16) = x1 * ALPHA + g1 * v1;
    }
};
__device__ __forceinline__ float silu_f(float x) { return x * __builtin_amdgcn_rcpf(1.0f + __builtin_amdgcn_exp2f(-x * LOG2E)); }
struct EpiAct {
    static constexpr bool PERM = true, PAIR = true;
    bf16_t* Act;
    __device__ __forceinline__ void tile64(int row, int pn, int wc, int fq, f32x4 g0, f32x4 g1, f32x4 u0, f32x4 u1) const {
        const int f0 = 128 * (pn & 3) + 32 * wc + 8 * fq; f32x4 a, b;
#pragma unroll
        for (int j = 0; j < 4; ++j) { a[j] = silu_f(g0[j]) * u0[j]; b[j] = silu_f(g1[j]) * u1[j]; }
        st_bf8(Act + (size_t)row * FF + f0, a, b);
    }
};
struct EpiYo {
    static constexpr bool PERM = true;
    bf16_t* Y;
    __device__ __forceinline__ void tile32(int row, int col, int fq, f32x4 v0, f32x4 v1) const { st_bf8(Y + (size_t)row * D + col + 8 * fq, v0, v1); }
};
struct EpiY {
    static constexpr bool PERM = true;
    bf16_t* Y;
    __device__ __forceinline__ void tile32(int row, int col, int fq, f32x4 v0, f32x4 v1) const { st_bf8(Y + (size_t)row * D + (col & 1023) + 8 * fq, v0, v1); }
};

template <class E, class = void> struct epi_pair { static constexpr bool value = false; };
template <class E> struct epi_pair<E, decltype((void)E::PAIR)> { static constexpr bool value = E::PAIR; };
template <class E, class = void> struct epi_prep { static constexpr bool value = false; };
template <class E> struct epi_prep<E, decltype((void)E::PREP)> { static constexpr bool value = E::PREP; };
struct Gemm { const bf16_t* A; int lda; const bf16_t* Bt; int K; };
__device__ __forceinline__ float dot8(u32x4 a, u32x4 b, float acc) {
#pragma unroll
    for (int i = 0; i < 4; ++i) { acc += bflo(a[i]) * bflo(b[i]); acc += bfhi(a[i]) * bfhi(b[i]); }
    return acc;
}
template <class Sched, class Epi>
__device__ __forceinline__ void gemm_naive(const Ctx& F, const Gemm g, const Sched& S, const Epi& E) {
    Unit u;
    for (int i = 0; S.next(i, u); ++i) {
        for (int task = F.tid; task < 8192; task += NTHREADS) {
            const int lane = task & 63, fr = lane & 15, fq = lane >> 4, rest = task >> 6, rg = rest & 15, cg = rest >> 4;
            const int row = u.pm * 256 + rg * 16 + fr, col = u.pn * 256 + cg * 32;
            const bf16_t* ap = g.A + (size_t)row * g.lda;
            const bf16_t* bp0 = g.Bt + (size_t)(col + 4 * fq) * g.K;
            const bf16_t* bp1 = bp0 + (size_t)16 * g.K;
            f32x4 v0 = {0.f, 0.f, 0.f, 0.f}, v1 = {0.f, 0.f, 0.f, 0.f};
            for (int k = 0; k < g.K; k += 8) {
                const u32x4 a = *(const u32x4*)(ap + k);
#pragma unroll
                for (int j = 0; j < 4; ++j) {
                    v0[j] = dot8(a, *(const u32x4*)(bp0 + (size_t)j * g.K + k), v0[j]);
                    v1[j] = dot8(a, *(const u32x4*)(bp1 + (size_t)j * g.K + k), v1[j]);
                }
            }
            E.tile32(row, col, fq, v0, v1);
        }
    }
}
constexpr int BK = 64, HALF = 128, HTB = HALF * BK * 2, STAGE_BYTES = 8 * HTB;
__device__ __forceinline__ int lds_byte(int r, int c) { const int st = (r >> 4) * 2 + (c >> 5), rr = r & 15, cc = c & 31, ob = rr * 64 + cc * 2; return st * 1024 + (ob ^ (((ob >> 9) & 1) << 5)); }
__device__ __forceinline__ int perm32(int rho) { const int n = rho >> 4, i = rho & 15; return 8 * (i >> 2) + 4 * n + (i & 3); }
__device__ __forceinline__ void stage_rc(int b, int& R, int& C) { const int st = b / 1024, sb = b % 1024, swz = sb ^ (((sb >> 9) & 1) << 5); R = (st >> 1) * 16 + swz / 64; C = (st & 1) * 32 + (swz % 64) / 2; }
template <class Epi, class Sched, bool ALIGN_EPI = true, bool SP2 = true, bool GATHER = false>
__device__ __forceinline__ void gemm_mfma(LAS unsigned char* lds, const int tid_in, const Gemm g, const Sched& S, const Epi& E, const LAS int* gtab = nullptr) {
    int tid = tid_in; asm volatile("" : "+v"(tid));
    const int wid = __builtin_amdgcn_readfirstlane(tid >> 6), lane = tid & 63, wr = wid >> 2, wc = wid & 3, fr = lane & 15, fq = lane >> 4;
    const int K = g.K, nt = K / BK;
    unsigned voffB[2]; int RA[2], CA[2];
#pragma unroll
    for (int i = 0; i < 2; ++i) { int R, C; stage_rc(tid * 16 + i * 8192, R, C); const int Rb = Epi::PERM ? ((R & ~31) + perm32(R & 31)) : R;
        RA[i] = R; CA[i] = C; voffB[i] = (unsigned)(Rb * K + C) * 2u; }
    const size_t kstep = (size_t)(BK * 2);
    const size_t hstepA = (size_t)HALF * g.lda * 2, hstepB = (size_t)HALF * K * 2;
    const size_t tstepA = GATHER ? 0 : 2 * hstepA, tstepB = 2 * hstepB;
    unsigned vc0[2], vc1[2], vn0[2], vn1[2];
#define PG8_GOFF(dst0, dst1, ui_) do { _Pragma("unroll") for (int i_ = 0; i_ < 2; ++i_) { \
        if constexpr (GATHER) { dst0[i_] = (unsigned)gtab[(ui_) * 256 + RA[i_]] * (unsigned)(g.lda * 2) + (unsigned)CA[i_] * 2u; dst1[i_] = (unsigned)gtab[(ui_) * 256 + HALF + RA[i_]] * (unsigned)(g.lda * 2) + (unsigned)CA[i_] * 2u; } \
        else { dst0[i_] = (unsigned)(RA[i_] * g.lda + CA[i_]) * 2u; dst1[i_] = dst0[i_] + (unsigned)hstepA; } } } while (0)
    const unsigned ldsw = (unsigned)wid * 1024u;
    const int aoff = lds_byte(wr * 64 + fr, fq * 8), boff = lds_byte(wc * 32 + fr, fq * 8);
#define PG8_SA(b, h) (((b) * 2 + (h)) * HTB)
#define PG8_SB(b, h) ((4 + (b) * 2 + (h)) * HTB)
#define PG8_STAGE(bufoff, gbase, voff) do { _Pragma("unroll") for (int _i = 0; _i < 2; ++_i) \
        __builtin_amdgcn_global_load_lds((const unsigned*)((const char*)(gbase) + (voff)[_i]), (LAS unsigned*)(lds + (bufoff) + ldsw + _i * 8192), 16, 0, 0); } while (0)
#define PG8_LDA(dst, b, h) do { _Pragma("unroll") for (int m = 0; m < 4; ++m) _Pragma("unroll") for (int k = 0; k < 2; ++k) dst[m][k] = *(const LAS bf16x8*)(lds + PG8_SA(b, h) + aoff + m * 2048 + k * 1024); } while (0)
#define PG8_LDB(dst, b, h) do { _Pragma("unroll") for (int n = 0; n < 2; ++n) _Pragma("unroll") for (int k = 0; k < 2; ++k) dst[n][k] = *(const LAS bf16x8*)(lds + PG8_SB(b, h) + boff + n * 2048 + k * 1024); } while (0)
#define PG8_MMA(ai, bj, At, Bt) do { __builtin_amdgcn_s_setprio(1); _Pragma("unroll") for (int m = 0; m < 4; ++m) _Pragma("unroll") for (int n = 0; n < 2; ++n) _Pragma("unroll") for (int k = 0; k < 2; ++k) \
        acc[ai][bj][m][n] = __builtin_amdgcn_mfma_f32_16x16x32_bf16(Bt[n][k], At[m][k], acc[ai][bj][m][n], 0, 0, 0); __builtin_amdgcn_s_setprio(0); } while (0)
#define PG8_WAIT_V(n) asm volatile("s_waitcnt vmcnt(" #n ")" ::: "memory")
#define PG8_WAIT_L(n) asm volatile("s_waitcnt lgkmcnt(" #n ")" ::: "memory")
#define PG8_BAR __builtin_amdgcn_s_barrier()
#define PG8_SCHED __builtin_amdgcn_sched_barrier(0)
    Unit cur, nxt; int ui = 0;
    if (!S.next(0, cur)) return;
    PG8_GOFF(vc0, vc1, 0);
#pragma unroll
    for (int i = 0; i < 2; ++i) { vn0[i] = vc0[i]; vn1[i] = vc1[i]; }
    f32x4 acc[2][2][4][2];
#pragma unroll
    for (int a = 0; a < 2; ++a)
#pragma unroll
        for (int b = 0; b < 2; ++b)
#pragma unroll
            for (int m = 0; m < 4; ++m)
#pragma unroll
                for (int n = 0; n < 2; ++n) acc[a][b][m][n] = (f32x4){0.f, 0.f, 0.f, 0.f};
    bf16x8 At[4][2], B0[2][2], B1[2][2];
    const char* cA = (const char*)g.A + (size_t)cur.pm * tstepA; const char* cB = (const char*)g.Bt + (size_t)cur.pn * tstepB;
    S.a_ready(cur);
    if constexpr (SP2) {
        PG8_STAGE(PG8_SB(0, 0), cB, voffB); PG8_STAGE(PG8_SB(0, 1), cB + hstepB, voffB); PG8_STAGE(PG8_SA(0, 0), cA, vc0); PG8_STAGE(PG8_SA(0, 1), cA, vc1);
        if (wr == 1) PG8_BAR;
        PG8_WAIT_V(2); PG8_BAR;
        PG8_STAGE(PG8_SB(1, 0), cB + kstep, voffB); PG8_STAGE(PG8_SA(1, 0), cA + kstep, vc0); PG8_STAGE(PG8_SB(1, 1), cB + hstepB + kstep, voffB);
        PG8_WAIT_V(6); PG8_BAR;
    } else {
        PG8_STAGE(PG8_SB(0, 0), cB, voffB); PG8_STAGE(PG8_SA(0, 0), cA, vc0); PG8_STAGE(PG8_SB(0, 1), cB + hstepB, voffB); PG8_STAGE(PG8_SA(0, 1), cA, vc1);
        if (wr == 1) PG8_BAR;
        PG8_WAIT_V(4); PG8_BAR;
        PG8_STAGE(PG8_SB(1, 0), cB + kstep, voffB); PG8_STAGE(PG8_SA(1, 0), cA + kstep, vc0); PG8_STAGE(PG8_SB(1, 1), cB + hstepB + kstep, voffB);
        PG8_WAIT_V(6); PG8_BAR;
    }
    for (;;) {
        const bool has_next = S.next(ui + 1, nxt);
        if constexpr (GATHER) { if (has_next) { PG8_GOFF(vn0, vn1, ui + 1); } else {
#pragma unroll
            for (int i = 0; i < 2; ++i) { vn0[i] = vc0[i]; vn1[i] = vc1[i]; } } }
        const char* nA = has_next ? (const char*)g.A + (size_t)nxt.pm * tstepA : cA; const char* nB = has_next ? (const char*)g.Bt + (size_t)nxt.pn * tstepB : cB;
#pragma unroll 1
        for (int t = 0; t < nt; t += 2) {
            const bool last = (t == nt - 2);
            const char* a1 = cA + (size_t)(t + 1) * kstep;
            const char* a2 = last ? nA : cA + (size_t)(t + 2) * kstep; const char* b2 = last ? nB : cB + (size_t)(t + 2) * kstep;
            const char* a3 = a2 + kstep; const char* b3 = b2 + kstep;
            unsigned s0[2], s1[2];
#pragma unroll
            for (int i = 0; i < 2; ++i) { if constexpr (GATHER) { s0[i] = last ? vn0[i] : vc0[i]; s1[i] = last ? vn1[i] : vc1[i]; } else { s0[i] = vc0[i]; s1[i] = vc1[i]; } }
            if (last && has_next) S.a_ready(nxt);
            if constexpr (SP2) {
            PG8_LDB(B0, 0, 0); PG8_LDB(B1, 0, 1); PG8_SCHED; PG8_LDA(At, 0, 0); PG8_STAGE(PG8_SA(1, 1), a1, vc1);
            PG8_WAIT_V(8); PG8_WAIT_L(0); PG8_BAR; PG8_MMA(0, 0, At, B0); PG8_MMA(0, 1, At, B1); PG8_BAR; PG8_SCHED;
            PG8_LDA(At, 0, 1); PG8_STAGE(PG8_SB(0, 0), b2, voffB); PG8_STAGE(PG8_SB(0, 1), b2 + hstepB, voffB); PG8_STAGE(PG8_SA(0, 0), a2, s0);
            PG8_WAIT_V(8); PG8_WAIT_L(0); PG8_BAR; PG8_MMA(1, 0, At, B0); PG8_MMA(1, 1, At, B1); PG8_BAR; PG8_SCHED;
            PG8_LDB(B0, 1, 0); PG8_LDB(B1, 1, 1); PG8_SCHED; PG8_LDA(At, 1, 0); PG8_STAGE(PG8_SA(0, 1), a2, s1);
            PG8_WAIT_V(8); PG8_WAIT_L(0); PG8_BAR; PG8_MMA(0, 0, At, B0); PG8_MMA(0, 1, At, B1); PG8_BAR; PG8_SCHED;
            PG8_LDA(At, 1, 1); PG8_STAGE(PG8_SB(1, 0), b3, voffB); PG8_STAGE(PG8_SB(1, 1), b3 + hstepB, voffB); PG8_STAGE(PG8_SA(1, 0), a3, s0);
            PG8_WAIT_V(8); PG8_WAIT_L(0); PG8_BAR; PG8_MMA(1, 0, At, B0); PG8_MMA(1, 1, At, B1); PG8_BAR; PG8_SCHED;
            } else {
            PG8_LDB(B0, 0, 0); PG8_SCHED; PG8_LDA(At, 0, 0); PG8_STAGE(PG8_SA(1, 1), a1, vc1);
            PG8_WAIT_L(8); PG8_BAR; PG8_WAIT_L(0); PG8_MMA(0, 0, At, B0); PG8_BAR; PG8_SCHED;
            PG8_LDB(B1, 0, 1); PG8_STAGE(PG8_SB(0, 0), b2, voffB);
            PG8_BAR; PG8_WAIT_L(0); PG8_MMA(0, 1, At, B1); PG8_BAR;
            PG8_LDA(At, 0, 1); PG8_STAGE(PG8_SA(0, 0), a2, s0);
            PG8_BAR; PG8_WAIT_L(0); PG8_MMA(1, 0, At, B0); PG8_BAR; PG8_SCHED;
            PG8_STAGE(PG8_SB(0, 1), b2 + hstepB, voffB);
            PG8_WAIT_V(6); PG8_BAR; PG8_MMA(1, 1, At, B1); PG8_BAR;
            PG8_LDB(B0, 1, 0); PG8_SCHED; PG8_LDA(At, 1, 0); PG8_STAGE(PG8_SA(0, 1), a2, s1);
            PG8_WAIT_L(8); PG8_BAR; PG8_WAIT_L(0); PG8_MMA(0, 0, At, B0); PG8_BAR; PG8_SCHED;
            PG8_LDB(B1, 1, 1); PG8_STAGE(PG8_SB(1, 0), b3, voffB);
            PG8_BAR; PG8_WAIT_L(0); PG8_MMA(0, 1, At, B1); PG8_BAR;
            PG8_LDA(At, 1, 1); PG8_STAGE(PG8_SA(1, 0), a3, s0);
            PG8_BAR; PG8_WAIT_L(0); PG8_MMA(1, 0, At, B0); PG8_BAR; PG8_SCHED;
            PG8_STAGE(PG8_SB(1, 1), b3 + hstepB, voffB);
            PG8_WAIT_V(6); PG8_BAR; PG8_MMA(1, 1, At, B1); PG8_BAR;
            }
        }
        if constexpr (ALIGN_EPI) { if (wr == 0) PG8_BAR; }
        {
            int ln_e; asm volatile("v_mbcnt_lo_u32_b32 %0, -1, 0\n\tv_mbcnt_hi_u32_b32 %0, -1, %0" : "=v"(ln_e));
            const int fr_e = ln_e & 15, fq_e = ln_e >> 4;
            int pm_e = __builtin_amdgcn_readfirstlane(cur.pm), pn_e = __builtin_amdgcn_readfirstlane(cur.pn), wr_e = __builtin_amdgcn_readfirstlane(wr), wc_e = __builtin_amdgcn_readfirstlane(wc); asm volatile("" : "+s"(pm_e), "+s"(pn_e), "+s"(wr_e), "+s"(wc_e));
#pragma unroll
            for (int ai = 0; ai < 2; ++ai)
#pragma unroll
                for (int m = 0; m < 4; ++m) {
                    if constexpr (epi_pair<Epi>::value) E.tile64(pm_e * BM + ai * HALF + wr_e * 64 + m * 16 + fr_e, pn_e, wc_e, fq_e, acc[ai][0][m][0], acc[ai][0][m][1], acc[ai][1][m][0], acc[ai][1][m][1]);
                    else {
#pragma unroll
                    for (int bj = 0; bj < 2; ++bj) {
                        if constexpr (epi_prep<Epi>::value) E.tile32u(pm_e * BM + ai * HALF + wr_e * 64 + m * 16 + fr_e, pn_e * BM + bj * HALF + wc_e * 32, fq_e, acc[ai][bj][m][0], acc[ai][bj][m][1], ui);
                        else E.tile32(pm_e * BM + ai * HALF + wr_e * 64 + m * 16 + fr_e, pn_e * BM + bj * HALF + wc_e * 32, fq_e, acc[ai][bj][m][0], acc[ai][bj][m][1]); }
                    }
                    asm volatile("" ::: "memory");
                }
            S.done(cur);
        }
        if (!has_next) break;
#pragma unroll
        for (int a = 0; a < 2; ++a)
#pragma unroll
            for (int b = 0; b < 2; ++b)
#pragma unroll
                for (int m = 0; m < 4; ++m)
#pragma unroll
                    for (int n = 0; n < 2; ++n) acc[a][b][m][n] = (f32x4){0.f, 0.f, 0.f, 0.f};
        cur = nxt; cA = nA; cB = nB; ++ui;
        if constexpr (GATHER) {
#pragma unroll
            for (int i = 0; i < 2; ++i) { vc0[i] = vn0[i]; vc1[i] = vn1[i]; } }
        if constexpr (ALIGN_EPI) { if (wr == 1) PG8_BAR; }
    }
    PG8_WAIT_V(0);
    if constexpr (!ALIGN_EPI) { if (wr == 0) PG8_BAR; }
    PG8_BAR;
#undef PG8_GOFF
#undef PG8_SA
#undef PG8_SB
#undef PG8_STAGE
#undef PG8_LDA
#undef PG8_LDB
#undef PG8_MMA
#undef PG8_WAIT_V
#undef PG8_WAIT_L
#undef PG8_BAR
#undef PG8_SCHED
}

#ifndef REP_GEMM_MASK
#define REP_GEMM_MASK 0
#endif
template <int ID, class Sched, class Epi>
__device__ __forceinline__ void gemm_phase_gather(const Ctx& F, const Gemm g, const Sched& S, const Epi& E, const LAS int* gtab) {
    gemm_mfma<Epi, Sched, true, true, true>(F.lds, F.tid, g, S, E, gtab);
    if constexpr ((REP_GEMM_MASK >> ID) & 1) gemm_mfma<Epi, Sched, true, true, true>(F.lds, F.tid, g, S, E, gtab);
}
template <int ID, class Sched, class Epi>
__device__ __forceinline__ void gemm_phase(const Ctx& F, const Gemm g, const Sched& S, const Epi& E) {
#if USE_MFMA_GEMM
    gemm_mfma<Epi, Sched, true, true>(F.lds, F.tid, g, S, E);
    if constexpr ((REP_GEMM_MASK >> ID) & 1) gemm_mfma<Epi, Sched, true, true>(F.lds, F.tid, g, S, E);
#else
    gemm_naive(F, g, S, E);
#endif
}

template <class ColPtr>
__device__ __forceinline__ void tconv_tile(const ColPtr& cp, int ldw, const float* scale, bf16_t* WT, int K, int k0, int p0, LAS float* scr, int lane) {
    const int pc = (lane & 15) * 4, kq = lane >> 4;
    const float* src = cp(p0 + pc);
#pragma unroll 4
    for (int i = 0; i < 16; ++i) {
        const int kk = 4 * i + kq;
        f32x4 v = {0.f, 0.f, 0.f, 0.f};
        if (src) { v = __builtin_nontemporal_load((const f32x4*)(src + (size_t)(k0 + kk) * ldw)); if (scale) v = v * scale[k0 + kk]; }
        LAS float* d = scr + kk * 65 + pc; d[0] = v[0]; d[1] = v[1]; d[2] = v[2]; d[3] = v[3];
    }
    LDS_WAIT();
    const int c = lane & 7;
#pragma unroll
    for (int j = 0; j < 8; ++j) {
        const int n = (lane >> 3) + 8 * j; const LAS float* s = scr + (8 * c) * 65 + n;
        u32x4 o; o.x = pk2(s[0], s[65]); o.y = pk2(s[2 * 65], s[3 * 65]); o.z = pk2(s[4 * 65], s[5 * 65]); o.w = pk2(s[6 * 65], s[7 * 65]);
        *(u32x4*)(WT + (size_t)(p0 + n) * K + k0 + 8 * c) = o;
    }
    LDS_WAIT();
}
struct CpPlain { const float* W; int ncols; __device__ __forceinline__ const float* operator()(int p) const { return p < ncols ? W + p : nullptr; } };
struct CpIn {
    const float* W;
    __device__ __forceinline__ const float* operator()(int p) const {
        if (p < 672) return W + p;
        if (p < 768) return nullptr;
        const int w = p & 31;
        if (p < 1280) { const int q = p - 768, t = q >> 8, g = (q & 255) >> 5; return W + 672 + 64 * (4 * t + (g & 3)) + 32 * (g >> 2) + w; }
        const int g = (p - 1280) >> 5, half = g >> 2, slot = g & 3;
        return W + ((slot < 2) ? (1184 + 64 * slot) : (1312 + 64 * (slot - 2))) + 32 * half + w;
    }
};
#if FUSE_SPLIT
typedef CpIn CpInSel;
#else
struct CpInSel { const float* W; __device__ __forceinline__ const float* operator()(int p) const { return p < 1440 ? W + p : nullptr; } };
#endif
struct CpQ {
    const float* W;
    __device__ __forceinline__ const float* operator()(int p) const {
        const int h = p / 96, pp = p - h * 96; int lc = pp;
        if (pp >= 64) { const int rp = pp - 64, q = rp >> 3, r = rp & 7, i = 4 * q + (r & 3); lc = 64 + (i >> 3) * 16 + (i & 7) + ((r >> 2) ? 8 : 0); }
        return W + h * 96 + lc;
    }
};
struct CpGU {
    const float* Wg; const float* Wu;
    __device__ __forceinline__ const float* operator()(int p) const { const int g = (p >> 5) & 7, ff = 128 * (p >> 8) + 32 * (g & 3) + (p & 31); return (g < 4) ? (Wg + ff) : (Wu + ff); }
};

constexpr int CONV_ITEMS = NEXP * 256 + NEXP * 128, CONV_CH = 4, CONV_CTR0 = 8192;
struct ConvSrc { const float* p; size_t ld; bf16_t* dst; int K; };
__device__ __forceinline__ ConvSrc conv_decode(const Args& a, int l, int idx, int lane) {
    const int pc = (lane & 15) * 4, kh = lane >> 4; ConvSrc r;
    if (idx < NEXP * 256) { const int e = idx >> 8, q = idx & 255, k0 = (q >> 4) * 64, p = (q & 15) * 64 + pc, g = (p >> 5) & 7, ff = 128 * (p >> 8) + 32 * (g & 3) + (p & 31); const size_t le = (size_t)l * NEXP + e;
        r.p = ((g < 4) ? (a.w_gate + le * D * FF + ff) : (a.w_up + le * D * FF + ff)) + (size_t)(k0 + 16 * kh) * FF; r.ld = FF;
        r.dst = (bf16_t*)(a.ws + WS_WGU) + le * 1024 * D + (size_t)((q & 15) * 64 + pc) * D + k0 + 16 * kh; r.K = D; }
    else { const int i2 = idx - NEXP * 256, e = i2 >> 7, q = i2 & 127, k0 = (q >> 4) * 64, p0 = (q & 15) * 64; const size_t le = (size_t)l * NEXP + e;
        r.p = a.w_down + le * FF * D + (size_t)(k0 + 16 * kh) * D + p0 + pc; r.ld = D;
        r.dst = (bf16_t*)(a.ws + WS_WD) + le * D * FF + (size_t)(p0 + pc) * FF + k0 + 16 * kh; r.K = FF; }
    return r;
}
__device__ __forceinline__ void conv_load(const ConvSrc& c, f32x4 (&v)[16]) {
#pragma unroll
    for (int i = 0; i < 16; ++i) v[i] = __builtin_nontemporal_load((const f32x4*)(c.p + (size_t)i * c.ld));
}
__device__ __forceinline__ void conv_store(const ConvSrc& c, const f32x4 (&v)[16]) {
#pragma unroll
    for (int nn = 0; nn < 4; ++nn) {
        u32x4 o0, o1;
        o0.x = pk2(v[0][nn], v[1][nn]); o0.y = pk2(v[2][nn], v[3][nn]); o0.z = pk2(v[4][nn], v[5][nn]); o0.w = pk2(v[6][nn], v[7][nn]);
        o1.x = pk2(v[8][nn], v[9][nn]); o1.y = pk2(v[10][nn], v[11][nn]); o1.z = pk2(v[12][nn], v[13][nn]); o1.w = pk2(v[14][nn], v[15][nn]);
        *(u32x4*)(c.dst + (size_t)nn * c.K) = o0; *(u32x4*)(c.dst + (size_t)nn * c.K + 8) = o1;
    }
}
__device__ __forceinline__ void conv_experts(const int lane, const int wave, const int vcu, const Args& a, int l) {
    const int base = (vcu * NWAVES + wave) * (CONV_ITEMS / (GRID * NWAVES));
    static_assert(CONV_ITEMS % (GRID * NWAVES) == 0 && CONV_ITEMS / (GRID * NWAVES) == 6, "6 tiles per wave");
    f32x4 va[16], vb[16], vc[16];
    ConvSrc c0 = conv_decode(a, l, base, lane), c1 = conv_decode(a, l, base + 1, lane), c2 = conv_decode(a, l, base + 2, lane);
    ConvSrc c3 = conv_decode(a, l, base + 3, lane), c4 = conv_decode(a, l, base + 4, lane), c5 = conv_decode(a, l, base + 5, lane);
    conv_load(c0, va); conv_load(c1, vb); conv_load(c2, vc);
    conv_store(c0, va); conv_load(c3, va);
    conv_store(c1, vb); conv_load(c4, vb);
    conv_store(c2, vc); conv_load(c5, vc);
    conv_store(c3, va); conv_store(c4, vb); conv_store(c5, vc);
}
__device__ __forceinline__ void prologue1(const Ctx& F, KP kp) {
    const Args a = ldargs(kp);
    unsigned char* ws = a.ws;
    {
        LAS float* sl = (LAS float*)F.lds;
        float* modp = (float*)(ws + WS_MODP);
        for (int it = F.bk; it < NL * 12 * 4; it += GRID) {
            const int kc = it & 3, nc = (it >> 2) % 12, l = it / 48;
            __syncthreads();
            for (int idx = F.tid; idx < 17 * 256; idx += NTHREADS) {
                const int bb = idx >> 8, k = idx & 255; const float v = (bb < 16) ? a.c[bb * D + kc * 256 + k] : a.c_ctx[kc * 256 + k];
                sl[idx] = v / (1.0f + __expf(-v));
            }
            __syncthreads();
            const int n = nc * 512 + F.tid;
            const float* w = a.w_ada + ((size_t)l * D + kc * 256) * 6144 + n;
            float acc[17];
#pragma unroll
            for (int bb = 0; bb < 17; ++bb) acc[bb] = 0.f;
            for (int k = 0; k < 256; ++k) {
                const float wv = __builtin_nontemporal_load(w + (size_t)k * 6144);
#pragma unroll
                for (int bb = 0; bb < 17; ++bb) acc[bb] += sl[bb * 256 + k] * wv;
            }
#pragma unroll
            for (int bb = 0; bb < 17; ++bb) modp[((size_t)(kc * NL + l) * 17 + bb) * 6144 + n] = acc[bb];
        }
        __syncthreads();
    }
    {
        f32x2* t64 = (f32x2*)(ws + WS_TAB64); f32x2* t32 = (f32x2*)(ws + WS_TAB32);
        const int gt = F.bk * NTHREADS + F.tid;
        if (gt < 64 * 16) { const int pos = gt >> 4, f = gt & 15; const float inv = powf(10000.0f, -((float)(2 * f) / 32.0f)); const float ang = (float)pos * inv; t64[gt] = (f32x2){cosf(ang), sinf(ang)}; }
        else if (gt < 64 * 16 + 64 * 8) { const int g2 = gt - 64 * 16, pos = g2 >> 3, f = g2 & 7; const float inv = powf(10000.0f, -((float)(2 * f) / 16.0f)); const float ang = (float)pos * inv; t32[g2] = (f32x2){cosf(ang), sinf(ang)}; }
    }
    {
        bf16_t* wr = (bf16_t*)(ws + WS_WR);
        for (int i = F.bk * NTHREADS + F.tid; i < NL * 48 * D; i += GRID * NTHREADS) {
            const int c = i & 1023, j = (i >> 10) % 48, l = i / (48 * D);
            float wv = 0.f;
            if (j < 4) wv = a.w_rg[((size_t)l * D + c) * 4 + j]; else if (j < 36) wv = a.w_re[((size_t)l * D + c) * 32 + (j - 4)];
            const unsigned h = f2bf(wv); const float rem = wv - __builtin_bit_cast(float, h << 16);
            wr[((size_t)(l * 2 + 0) * 48 + j) * D + c] = (bf16_t)h; wr[((size_t)(l * 2 + 1) * 48 + j) * D + c] = (bf16_t)f2bf(rem);
        }
    }
    {
        LAS float* scr = (LAS float*)(F.lds + F.wave * 18432);
        const int gw = F.vcu * NWAVES + F.wave, NGW = GRID * NWAVES;
        constexpr int I_IN = 16 * 24, I_Q = 6 * 12, I_KV = 4 * 16, I_O = 16 * 16, I_GU = 16 * 16, I_D = 8 * 16;
        constexpr int N_SMALL = NL * (I_IN + I_Q + I_KV + I_O), N_GU = NL * NEXP * I_GU, N_D = NL * NEXP * I_D;
        for (int it = gw; it < N_SMALL; it += NGW) {
            {
                const int l = it / (I_IN + I_Q + I_KV + I_O); int r = it % (I_IN + I_Q + I_KV + I_O);
                if (r < I_IN) { const int kt = r / 24, pt = r % 24; tconv_tile(CpInSel{a.w_in + (size_t)l * D * 1440}, 1440, nullptr, (bf16_t*)(ws + WS_WIN) + (size_t)l * ZW * D, D, kt * 64, pt * 64, scr, F.lane); continue; }
                r -= I_IN;
                if (r < I_Q) { const int kt = r / 12, pt = r % 12; tconv_tile(CpQ{a.w_q_b + (size_t)l * 384 * QW}, QW, a.g_q_a + l * 384, (bf16_t*)(ws + WS_WQ) + (size_t)l * QW * 384, 384, kt * 64, pt * 64, scr, F.lane); continue; }
                r -= I_Q;
                if (r < I_KV) { const int kt = r / 16, pt = r % 16; tconv_tile(CpPlain{a.w_kv_b + (size_t)l * 256 * KVW, KVW}, KVW, a.g_kv_a + l * 256, (bf16_t*)(ws + WS_WKV) + (size_t)l * KVW * 256, 256, kt * 64, pt * 64, scr, F.lane); continue; }
                r -= I_KV;
                { const int kt = r / 16, pt = r % 16; tconv_tile(CpPlain{a.w_o + (size_t)l * D * D, D}, D, nullptr, (bf16_t*)(ws + WS_WO) + (size_t)l * D * D, D, kt * 64, pt * 64, scr, F.lane); }
            }
        }
    }
}

__device__ __forceinline__ void prologue2(const Ctx& F, KP kp) {
    const Args a = ldargs(kp);
    const float* modp = (const float*)(a.ws + WS_MODP); float* mod = (float*)(a.ws + WS_MOD);
    constexpr int NE = NL * 17 * 6144 / 4;
    for (int i = F.bk * NTHREADS + F.tid; i < NE; i += GRID * NTHREADS) {
        const int e = i * 4, l = e / (17 * 6144), n = e % 6144;
        f32x4 s = *(const f32x4*)(a.b_ada + l * 6144 + n);
#pragma unroll
        for (int kc = 0; kc < 4; ++kc) s = s + *(const f32x4*)(modp + (size_t)kc * NL * 17 * 6144 + e);
        *(f32x4*)(mod + e) = s;
    }
}

__device__ __forceinline__ void row_load(const float* p, int lane, f32x4 (&v)[4]) {
#pragma unroll
    for (int j = 0; j < 4; ++j) v[j] = *(const f32x4*)(p + 4 * lane + 256 * j);
}
__device__ __forceinline__ void row_ln(f32x4 (&v)[4], const float* g, const float* b, int lane) {
    float s = 0.f;
#pragma unroll
    for (int j = 0; j < 4; ++j) s += (v[j][0] + v[j][1]) + (v[j][2] + v[j][3]);
    const float mean = wave_sum(s) * (1.0f / D); float q = 0.f;
#pragma unroll
    for (int j = 0; j < 4; ++j) { v[j] = v[j] - mean; q += (v[j][0] * v[j][0] + v[j][1] * v[j][1]) + (v[j][2] * v[j][2] + v[j][3] * v[j][3]); }
    const float rstd = 1.0f / sqrtf(wave_sum(q) * (1.0f / D) + LN_EPS);
#pragma unroll
    for (int j = 0; j < 4; ++j) { const f32x4 gg = *(const f32x4*)(g + 4 * lane + 256 * j), bv = *(const f32x4*)(b + 4 * lane + 256 * j); v[j] = v[j] * rstd * gg + bv; }
}
__device__ __forceinline__ void row_ln_reg(f32x4 (&v)[4], const f32x4 (&g)[4], const f32x4 (&b)[4]) {
    float s = 0.f;
#pragma unroll
    for (int j = 0; j < 4; ++j) s += (v[j][0] + v[j][1]) + (v[j][2] + v[j][3]);
    const float mean = wave_sum(s) * (1.0f / D); float q = 0.f;
#pragma unroll
    for (int j = 0; j < 4; ++j) { v[j] = v[j] - mean; q += (v[j][0] * v[j][0] + v[j][1] * v[j][1]) + (v[j][2] * v[j][2] + v[j][3] * v[j][3]); }
    const float rstd = 1.0f / sqrtf(wave_sum(q) * (1.0f / D) + LN_EPS);
#pragma unroll
    for (int j = 0; j < 4; ++j) v[j] = v[j] * rstd * g[j] + b[j];
}
__device__ __forceinline__ void row_store_mod_bf16(bf16_t* hrow, const f32x4 (&v)[4], const float* sh, const float* sc, int lane) {
#pragma unroll
    for (int j = 0; j < 4; ++j) {
        const f32x4 s1 = *(const f32x4*)(sc + 4 * lane + 256 * j), s0 = *(const f32x4*)(sh + 4 * lane + 256 * j);
        const f32x4 h = v[j] * (s1 + 1.0f) + s0;
        st_bf4(hrow + 4 * lane + 256 * j, h);
    }
}

__device__ __forceinline__ void prologue3(const Ctx& F, KP kp) {
    const Args a = ldargs(kp);
    const float* modp = (const float*)(a.ws + WS_MODP); bf16_t* H = (bf16_t*)(a.ws + WS_H);
    const int gw = F.vcu * NWAVES + F.wave, NGW = GRID * NWAVES;
    for (int r = gw; r < MT; r += NGW) {
        const float* xr = (r < TL) ? (a.x + (size_t)r * D) : (a.ctx + (size_t)(r - TL) * D);
        const int bb = bb_of(r);
        f32x4 v[4]; row_load(xr, F.lane, v);
#pragma unroll
        for (int j = 0; j < 4; ++j) {
            const int c = 4 * F.lane + 256 * j;
            f32x4 sh = *(const f32x4*)(a.b_ada + c), sc = *(const f32x4*)(a.b_ada + 1024 + c);
#pragma unroll
            for (int kc = 0; kc < 4; ++kc) { const float* mp = modp + ((size_t)(kc * NL + 0) * 17 + bb) * 6144; sh = sh + *(const f32x4*)(mp + c); sc = sc + *(const f32x4*)(mp + 1024 + c); }
            st_bf4(H + (size_t)r * D + c, v[j] * (sc + 1.0f) + sh);
        }
    }
}

__device__ __forceinline__ void unpack8(const u32x4 w, float (&v)[8]) { v[0] = bflo(w.x); v[1] = bfhi(w.x); v[2] = bflo(w.y); v[3] = bfhi(w.y); v[4] = bflo(w.z); v[5] = bfhi(w.z); v[6] = bflo(w.w); v[7] = bfhi(w.w); }
__device__ __forceinline__ u32x4 pack8(const float (&v)[8]) { u32x4 w; w.x = pk2(v[0], v[1]); w.y = pk2(v[2], v[3]); w.z = pk2(v[4], v[5]); w.w = pk2(v[6], v[7]); return w; }
__device__ __forceinline__ u32x4 head64_norm_rope(const u32x4 raw, const float (&g)[8], const LAS f32x2* t64, bool lat, int gr, int gc, int w8, float scale) {
    float v[8]; unpack8(raw, v);
    float ss = 0.f;
#pragma unroll
    for (int e = 0; e < 8; ++e) ss += v[e] * v[e];
    ss += lane_xor<1>(ss); ss += lane_xor<2>(ss); ss += lane_xor<4>(ss);
    const float rn = 1.0f / sqrtf(ss * (1.0f / 64.0f) + RMS_EPS);
    float y[8], p[8], o[8];
#pragma unroll
    for (int e = 0; e < 8; ++e) { y[e] = v[e] * rn * g[e]; p[e] = lane_xor<2>(y[e]); o[e] = y[e]; }
    if (lat) {
        const int pos = (w8 >> 2) ? gc : gr; const LAS f32x2* cs = t64 + pos * 16 + 8 * (w8 & 1); const bool x2 = (w8 & 2) != 0;
#pragma unroll
        for (int e = 0; e < 8; ++e) { const f32x2 c = cs[e]; o[e] = x2 ? (y[e] * c.x + p[e] * c.y) : (y[e] * c.x - p[e] * c.y); }
    }
#pragma unroll
    for (int e = 0; e < 8; ++e) o[e] *= scale;
    return pack8(o);
}
__device__ __forceinline__ void phase_split(const Ctx& F, KP kp, int l) {
    const Args a = ldargs(kp);
    unsigned char* ws = a.ws;
    const bf16_t* Z = (const bf16_t*)(ws + WS_Z);
    float* rstdq = (float*)(ws + WS_RSTDQ); float* rstdkv = (float*)(ws + WS_RSTDKV);
    bf16_t* Km = (bf16_t*)(ws + WS_KM); bf16_t* Qg = (bf16_t*)(ws + WS_QG); bf16_t* Kg = (bf16_t*)(ws + WS_KG); bf16_t* Vg = (bf16_t*)(ws + WS_VG);
    LAS f32x2* t64 = (LAS f32x2*)(F.lds + 65536); LAS f32x2* t32 = (LAS f32x2*)(F.lds + 65536 + 8192);
    __syncthreads();
    for (int i = F.tid; i < 64 * 16; i += NTHREADS) t64[i] = ((const f32x2*)(ws + WS_TAB64))[i];
    if (F.tid < 64 * 8) t32[F.tid] = ((const f32x2*)(ws + WS_TAB32))[F.tid];
    __syncthreads();
    const int lane = F.lane, gw = F.vcu * NWAVES + F.wave, NGW = GRID * NWAVES, w8 = lane & 7;
    float ggq[8], ggk[8];
#pragma unroll
    for (int e = 0; e < 8; ++e) { ggq[e] = a.g_gq[l * 64 + 8 * w8 + e]; ggk[e] = a.g_gk[l * 64 + 8 * w8 + e]; }
    const int offA2 = 8 * (64 + (lane & 15)), offB = 672 + 8 * lane;
    const int offC = (lane < 4) ? (640 + 8 * lane) : (lane >= 8 && lane < 24) ? (1184 + 8 * (lane - 8)) : (lane >= 24 && lane < 40) ? (1312 + 8 * (lane - 24)) : 0;
    u32x4 nA1, nA2, nB, nC;
#define P2_LOAD(rr) do { const bf16_t* zr_ = Z + (size_t)(rr) * ZW; nA1 = *(const u32x4*)(zr_ + 8 * lane); nA2 = *(const u32x4*)(zr_ + offA2); nB = *(const u32x4*)(zr_ + offB); nC = *(const u32x4*)(zr_ + offC); } while (0)
    if (gw < MT) P2_LOAD(gw);
    for (int r = gw; r < MT; r += NGW) {
        const u32x4 A1 = nA1, A2 = nA2, B = nB, C = nC;
        if (r + NGW < MT) P2_LOAD(r + NGW);
        const bool lat = r < TL; const int s = r & 2047, gr = s >> 6, gc = s & 63, kr = krow_of(r);
        { float v[8]; unpack8(A1, v); float s1 = 0.f;
#pragma unroll
          for (int e = 0; e < 8; ++e) s1 += v[e] * v[e];
          unpack8(A2, v); float s2 = 0.f;
#pragma unroll
          for (int e = 0; e < 8; ++e) s2 += v[e] * v[e];
          const float sq = wave_sum(lane < 48 ? s1 : 0.f), sk = wave_sum((lane >= 48 ? s1 : 0.f) + (lane < 16 ? s2 : 0.f));
          if (lane == 0) { rstdq[r] = 1.0f / sqrtf(sq * (1.0f / 384.0f) + RMS_EPS); rstdkv[r] = 1.0f / sqrtf(sk * (1.0f / 256.0f) + RMS_EPS); } }
        { const u32x4 o = head64_norm_rope(B, ggq, t64, lat, gr, gc, w8, QSCALE_G); *(u32x4*)(Qg + (size_t)r * 512 + 8 * lane) = o; }
        { const u32x4 o = head64_norm_rope(C, ggk, t64, lat, gr, gc, w8, 1.0f); if (lane >= 8 && lane < 24) *(u32x4*)(Kg + (size_t)kr * 128 + 8 * (lane - 8)) = o; }
        if (lane >= 24 && lane < 40) *(u32x4*)(Vg + (size_t)kr * 128 + 8 * (lane - 24)) = C;
        { float v[8], p[8], o[8]; unpack8(C, v);
#pragma unroll
          for (int e = 0; e < 8; ++e) { p[e] = lane_xor<1>(v[e]); o[e] = v[e]; }
          if (lat) { const int pos = ((lane >> 1) & 1) ? gc : gr; const LAS f32x2* cs = t32 + pos * 8; const bool x2 = (lane & 1) != 0;
#pragma unroll
              for (int e = 0; e < 8; ++e) { const f32x2 c = cs[e]; o[e] = x2 ? (v[e] * c.x + p[e] * c.y) : (v[e] * c.x - p[e] * c.y); } }
          const u32x4 ow = pack8(o);
          if (lane < 4) {
#pragma unroll
              for (int h = 0; h < 8; ++h) *(u32x4*)(Km + (size_t)kr * QW + h * 96 + 64 + 8 * lane) = ow; } }
    }
#undef P2_LOAD
}

typedef float f32x4m __attribute__((ext_vector_type(4)));
template <bool XF32>
__device__ __forceinline__ void phase_ln1_route(const Ctx& F, KP kp, int l, int ntok) {
    const Args a = ldargs(kp);
    unsigned char* ws = a.ws;
    const bf16_t* Yo = (const bf16_t*)(ws + WS_U); float* XC = (float*)(ws + WS_XC); bf16_t* H = (bf16_t*)(ws + WS_H);
    bf16_t* XB = (bf16_t*)(ws + WS_XB); constexpr bool xf32 = XF32;
    const float* mod = (const float*)(ws + WS_MOD) + (size_t)l * 17 * 6144;
    int* toke = (int*)(ws + WS_TOKE); int* tokr = (int*)(ws + WS_TOKR); float* tokw = (float*)(ws + WS_TOKW);
    volatile LAS int* cntl = (volatile LAS int*)(F.lds + MISC_CNT);
    const int lane = F.lane;
    __syncthreads();
    if (F.tid < 32) cntl[F.tid] = 0;
    if (F.tid < 36) ((LAS float*)(F.lds + MISC_LG + 2048))[F.tid] = (F.tid < 4) ? a.b_rg[l * 4 + F.tid] : a.b_re[l * 32 + F.tid - 4];
    const int tpb = ntok / GRID;
    {
        f32x4 nx[4]; u32x2 ny[4]; int i = F.wave;
        f32x4 LG[4], LB[4], GA[4], SH[4], SC[4]; int bbc = -1;
#pragma unroll
        for (int j = 0; j < 4; ++j) { LG[j] = *(const f32x4*)(a.ln1_g + l * D + 4 * lane + 256 * j); LB[j] = *(const f32x4*)(a.ln1_b + l * D + 4 * lane + 256 * j); }
        u32x2 nb[4];
#define P6_LOAD(tt) do { const int t_ = (tt); \
        if (xf32) { const float* xp_ = (t_ < TL) ? (a.x + (size_t)t_ * D) : (a.ctx + (size_t)(t_ - TL) * D); row_load(xp_, lane, nx); } \
        else { _Pragma("unroll") for (int j = 0; j < 4; ++j) nb[j] = __builtin_nontemporal_load((const u32x2*)(XB + (size_t)t_ * D + 4 * lane + 256 * j)); } \
        _Pragma("unroll") for (int j = 0; j < 4; ++j) ny[j] = __builtin_nontemporal_load((const u32x2*)(Yo + (size_t)t_ * D + 4 * lane + 256 * j)); } while (0)
        if (i < tpb) P6_LOAD(F.bk * tpb + i);
        for (; i < tpb; i += NWAVES) {
            const int t = F.bk * tpb + i, bb = bb_of(t);
            if (bb != bbc) {
                bbc = bb;
#pragma unroll
                for (int j = 0; j < 4; ++j) { const int c = 4 * lane + 256 * j; GA[j] = *(const f32x4*)(mod + (size_t)(bb * 6 + 2) * D + c);
                    SH[j] = *(const f32x4*)(mod + (size_t)(bb * 6 + 3) * D + c); SC[j] = *(const f32x4*)(mod + (size_t)(bb * 6 + 4) * D + c); }
            }
            f32x4 v[4];
#pragma unroll
            for (int j = 0; j < 4; ++j) { const f32x4 y = {bflo(ny[j].x), bfhi(ny[j].x), bflo(ny[j].y), bfhi(ny[j].y)};
                const f32x4 xv = xf32 ? nx[j] : (f32x4){bflo(nb[j].x), bfhi(nb[j].x), bflo(nb[j].y), bfhi(nb[j].y)}; v[j] = xv * ALPHA + GA[j] * y; }
            if (i + NWAVES < tpb) P6_LOAD(t + NWAVES);
            row_ln_reg(v, LG, LB);
#pragma unroll
            for (int j = 0; j < 4; ++j) st_bf4(XB + (size_t)t * D + 4 * lane + 256 * j, v[j]);
#pragma unroll
            for (int j = 0; j < 4; ++j) {
                const f32x4 h = v[j] * (SC[j] + 1.0f) + SH[j];
                st_bf4(H + (size_t)t * D + 4 * lane + 256 * j, h);
            }
        }
    }
#undef P6_LOAD
    asm volatile("s_waitcnt vmcnt(0)" ::: "memory");
    __syncthreads();
    {
        const bf16_t* wrh = (const bf16_t*)(ws + WS_WR) + (size_t)(l * 2) * 48 * D; const bf16_t* wrl = wrh + (size_t)48 * D;
        const LAS float* bias = (const LAS float*)(F.lds + MISC_LG + 2048);
        const int fr = lane & 15, fq = lane >> 4, w = F.wave;
        bf16x8 WH[4][3], WL[4][3];
#pragma unroll
        for (int ks = 0; ks < 4; ++ks)
#pragma unroll
            for (int tl = 0; tl < 3; ++tl) { const size_t o = (size_t)(16 * tl + fr) * D + 128 * w + 32 * ks + 8 * fq; WH[ks][tl] = *(const bf16x8*)(wrh + o); WL[ks][tl] = *(const bf16x8*)(wrl + o); }
        LAS float* part = (LAS float*)F.lds;
        LAS float* lgf = (LAS float*)(F.lds + 122880);
        const int ngrp = tpb / 16;
        for (int g0 = 0; g0 < ngrp; g0 += 5) {
            const int ng = (ngrp - g0 < 5) ? (ngrp - g0) : 5;
            bf16x8 hb[5][4];
#pragma unroll
            for (int gl = 0; gl < 5; ++gl) if (gl < ng) {
                const bf16_t* hh = H + (size_t)(F.bk * tpb + (g0 + gl) * 16 + fr) * D + 128 * w + 8 * fq;
#pragma unroll
                for (int ks = 0; ks < 4; ++ks) hb[gl][ks] = *(const bf16x8*)(hh + 32 * ks);
            }
#pragma unroll
            for (int gl = 0; gl < 5; ++gl) if (gl < ng) {
                f32x4m acc0 = {0.f, 0.f, 0.f, 0.f}, acc1 = acc0, acc2 = acc0;
#pragma unroll
                for (int ks = 0; ks < 4; ++ks) {
                    acc0 = __builtin_amdgcn_mfma_f32_16x16x32_bf16(WH[ks][0], hb[gl][ks], acc0, 0, 0, 0); acc1 = __builtin_amdgcn_mfma_f32_16x16x32_bf16(WH[ks][1], hb[gl][ks], acc1, 0, 0, 0); acc2 = __builtin_amdgcn_mfma_f32_16x16x32_bf16(WH[ks][2], hb[gl][ks], acc2, 0, 0, 0);
                    acc0 = __builtin_amdgcn_mfma_f32_16x16x32_bf16(WL[ks][0], hb[gl][ks], acc0, 0, 0, 0); acc1 = __builtin_amdgcn_mfma_f32_16x16x32_bf16(WL[ks][1], hb[gl][ks], acc1, 0, 0, 0); acc2 = __builtin_amdgcn_mfma_f32_16x16x32_bf16(WL[ks][2], hb[gl][ks], acc2, 0, 0, 0);
                }
                LAS float* pp = part + ((size_t)(w * 5 + gl) * 16 + fr) * 48 + 4 * fq;
                *(LAS f32x4m*)(pp) = acc0; *(LAS f32x4m*)(pp + 16) = acc1; *(LAS f32x4m*)(pp + 32) = acc2;
            }
            LDS_WAIT();
            __syncthreads();
            for (int o = F.tid; o < ng * 768; o += NTHREADS) {
                const int gl = o / 768, rem = o - gl * 768; float s = 0.f;
#pragma unroll
                for (int ww = 0; ww < 8; ++ww) s += part[(ww * 5 + gl) * 768 + rem];
                lgf[o] = s;
            }
            __syncthreads();
            if (F.tid < ng * 16) {
                const int t = F.bk * tpb + g0 * 16 + F.tid; const LAS float* q = lgf + F.tid * 48;
                float l4[4];
#pragma unroll
                for (int o = 0; o < 4; ++o) l4[o] = q[o] + bias[o];
                int gs = 0; float gm = l4[0];
#pragma unroll
                for (int o = 1; o < 4; ++o) if (l4[o] > gm) { gm = l4[o]; gs = o; }
                float den = 0.f;
#pragma unroll
                for (int o = 0; o < 4; ++o) den += expf(l4[o] - gm);
                const float pstar = 1.0f / den;
                float le[8];
#pragma unroll
                for (int o = 0; o < 8; ++o) le[o] = q[4 + gs * 8 + o] + bias[4 + gs * 8 + o];
                int i1 = 0; float v1 = le[0];
#pragma unroll
                for (int o = 1; o < 8; ++o) if (le[o] > v1) { v1 = le[o]; i1 = o; }
                int i2 = -1; float v2 = -3.0e38f;
#pragma unroll
                for (int o = 0; o < 8; ++o) if (o != i1 && le[o] > v2) { v2 = le[o]; i2 = o; }
                const float ex = expf(v2 - v1), w1 = pstar / (1.0f + ex), w2 = pstar * ex / (1.0f + ex);
                const int e1 = gs * 8 + i1, e2 = gs * 8 + i2;
                const int r1 = __hip_atomic_fetch_add((LAS int*)(F.lds + MISC_CNT) + e1, 1, __ATOMIC_RELAXED, __HIP_MEMORY_SCOPE_WORKGROUP);
                const int r2 = __hip_atomic_fetch_add((LAS int*)(F.lds + MISC_CNT) + e2, 1, __ATOMIC_RELAXED, __HIP_MEMORY_SCOPE_WORKGROUP);
                toke[2 * t] = e1; toke[2 * t + 1] = e2; tokr[2 * t] = r1; tokr[2 * t + 1] = r2; tokw[2 * t] = w1; tokw[2 * t + 1] = w2;
            }
            __syncthreads();
        }
    }
    __syncthreads();
    if (F.tid < 32) ((int*)(ws + WS_BLKCNT))[((size_t)l * 256 + F.bk) * 32 + F.tid] = cntl[F.tid];
}

__device__ __forceinline__ void moe_tables(const Ctx& F, KP kp, int l, bool publish) {
    const Args a = ldargs(kp);
    const int* blkcnt = (const int*)(a.ws + WS_BLKCNT) + (size_t)l * 256 * 32;
    volatile LAS int* pa = (volatile LAS int*)(F.lds + MISC_PA); volatile LAS int* pb = (volatile LAS int*)(F.lds + MISC_PB);
    volatile LAS int* tot = (volatile LAS int*)(F.lds + MISC_TOT); volatile LAS int* base = (volatile LAS int*)(F.lds + MISC_BASE); volatile LAS int* poff = (volatile LAS int*)(F.lds + MISC_POFF);
    __syncthreads();
    {
        const int e = F.tid & 31, part = F.tid >> 5; int sa = 0, sb = 0;
        for (int j = 0; j < 16; ++j) { const int b2 = part * 16 + j; const int c = blkcnt[b2 * 32 + e]; sa += c; sb += (b2 < F.bk) ? c : 0; }
        pa[part * 32 + e] = sa; pb[part * 32 + e] = sb;
    }
    __syncthreads();
    if (F.tid < 32) { int sa = 0, sb = 0; for (int p = 0; p < 16; ++p) { sa += pa[p * 32 + F.tid]; sb += pb[p * 32 + F.tid]; } tot[F.tid] = sa; base[F.tid] = sb; }
    __syncthreads();
    if (F.tid == 0) { int o = 0; for (int e = 0; e < 32; ++e) { poff[e] = o; o += (tot[e] + 255) & ~255; } poff[32] = o; }
    __syncthreads();
    if (publish && F.bk == 0 && F.tid < 33) ((int*)(a.ws + WS_MOETAB))[l * 128 + F.tid] = poff[F.tid];
}

__device__ __forceinline__ void phase_dispatch(const Ctx& F, KP kp, int l, int ntok) {
    const Args a = ldargs(kp);
    unsigned char* ws = a.ws;
    moe_tables(F, kp, l, true);
    volatile LAS int* base = (volatile LAS int*)(F.lds + MISC_BASE); volatile LAS int* poff = (volatile LAS int*)(F.lds + MISC_POFF); volatile LAS int* tot = (volatile LAS int*)(F.lds + MISC_TOT);
    const int* toke = (const int*)(ws + WS_TOKE); const int* tokr = (const int*)(ws + WS_TOKR); int* tokp = (int*)(ws + WS_TOKP); int* postok = (int*)(ws + WS_POSTOK);
    const int tpb = ntok / GRID;
    if (F.tid < tpb) {
        const int t = F.bk * tpb + F.tid;
        const int2 e = *(const int2*)(toke + 2 * t), r = *(const int2*)(tokr + 2 * t);
        const int p1 = poff[e.x] + base[e.x] + r.x, p2 = poff[e.y] + base[e.y] + r.y;
        *(int2*)(tokp + 2 * t) = (int2){p1, p2};
        postok[p1] = t; postok[p2] = t;
    }
    { const int idx = F.bk * NTHREADS + F.tid;
      if (idx < poff[32]) { int e = 0;
#pragma unroll
          for (int j = 1; j < 32; ++j) e += (poff[j] <= idx) ? 1 : 0;
          if (idx >= poff[e] + tot[e]) postok[idx] = 0; } }
}

__device__ __forceinline__ void phase_ln2(const Ctx& F, KP kp, int l, int ntok, bool dry = false) {
    const Args a = ldargs(kp);
    unsigned char* ws = a.ws;
    const bf16_t* Ys = (const bf16_t*)(ws + WS_XS); float* XC = (float*)(ws + WS_XC); bf16_t* H = (bf16_t*)(ws + WS_H);
    const float* mod = (const float*)(ws + WS_MOD) + (size_t)l * 17 * 6144;
    const float* modn = (const float*)(ws + WS_MOD) + (size_t)(l + 1 < NL ? l + 1 : l) * 17 * 6144;
    const int* tokp = (const int*)(ws + WS_TOKP); const float* tokw = (const float*)(ws + WS_TOKW);
    const int gw = F.vcu * NWAVES + F.wave, NGW = GRID * NWAVES, lane = F.lane;
    const int per = ntok / NGW, t0 = gw * per, t1 = t0 + per;
    f32x4 LG[4], LB[4], GF[4], SH[4], SC[4];
#pragma unroll
    for (int j = 0; j < 4; ++j) { LG[j] = *(const f32x4*)(a.ln2_g + l * D + 4 * lane + 256 * j); LB[j] = *(const f32x4*)(a.ln2_b + l * D + 4 * lane + 256 * j); }
    int bbc = -1;
    int2 pn = {0, 0}; float2 wn = {0.f, 0.f};
    u32x2 xn[4], yan[4], ybn[4]; bf16_t* XB = (bf16_t*)(ws + WS_XB);
#define P10_REC(tt) do { pn = *(const int2*)(tokp + 2 * (tt)); wn = *(const float2*)(tokw + 2 * (tt)); } while (0)
#define P10_ROWS(tt, p_) do { const int t_ = (tt); _Pragma("unroll") for (int j = 0; j < 4; ++j) xn[j] = __builtin_nontemporal_load((const u32x2*)(XB + (size_t)t_ * D + 4 * lane + 256 * j)); \
        _Pragma("unroll") for (int j = 0; j < 4; ++j) { yan[j] = __builtin_nontemporal_load((const u32x2*)(Ys + (size_t)(p_).x * D + 4 * lane + 256 * j)); ybn[j] = __builtin_nontemporal_load((const u32x2*)(Ys + (size_t)(p_).y * D + 4 * lane + 256 * j)); } } while (0)
    float2 wc = {0.f, 0.f};
    P10_REC(t0); wc = wn; P10_ROWS(t0, pn); if (t0 + 1 < t1) P10_REC(t0 + 1);
    for (int t = t0; t < t1; ++t) {
        const int bb = bb_of(t);
        if (bb != bbc) {
            bbc = bb;
#pragma unroll
            for (int j = 0; j < 4; ++j) { const int c = 4 * lane + 256 * j; GF[j] = *(const f32x4*)(mod + (size_t)(bb * 6 + 5) * D + c);
                SH[j] = *(const f32x4*)(modn + (size_t)(bb * 6 + 0) * D + c); SC[j] = *(const f32x4*)(modn + (size_t)(bb * 6 + 1) * D + c); }
        }
        f32x4 v[4]; u32x2 ya[4], yb[4];
#pragma unroll
        for (int j = 0; j < 4; ++j) { v[j] = (f32x4){bflo(xn[j].x), bfhi(xn[j].x), bflo(xn[j].y), bfhi(xn[j].y)}; ya[j] = yan[j]; yb[j] = ybn[j]; }
        const float w1 = wc.x, w2 = wc.y;
        if (t + 1 < t1) { wc = wn; P10_ROWS(t + 1, pn); if (t + 2 < t1) P10_REC(t + 2); }
#pragma unroll
        for (int j = 0; j < 4; ++j) {
            const f32x4 y = (f32x4){bflo(ya[j].x), bfhi(ya[j].x), bflo(ya[j].y), bfhi(ya[j].y)} * w1 + (f32x4){bflo(yb[j].x), bfhi(yb[j].x), bflo(yb[j].y), bfhi(yb[j].y)} * w2;
            v[j] = v[j] * ALPHA + GF[j] * y;
        }
        row_ln_reg(v, LG, LB);
        if (l + 1 < NL) {
#pragma unroll
            for (int j = 0; j < 4; ++j) st_bf4(XB + (size_t)t * D + 4 * lane + 256 * j, v[j]);
        } else {
#pragma unroll
            for (int j = 0; j < 4; ++j) *(f32x4*)(a.out + (size_t)t * D + 4 * lane + 256 * j) = v[j];
        }
        if (l + 1 < NL) { bf16_t* hrow = H + (size_t)t * D;
#pragma unroll
            for (int j = 0; j < 4; ++j) st_bf4(hrow + 4 * lane + 256 * j, v[j] * (SC[j] + 1.0f) + SH[j]); }
    }
#undef P10_REC
#undef P10_ROWS
}

template <int QD>
__device__ __forceinline__ void attn_naive_task(const bf16_t* qp, const bf16_t* kp, int kstride, const bf16_t* vp, int vstride, int nkeys, bf16_t* op) {
    u32x4 qv[QD / 8];
#pragma unroll
    for (int i = 0; i < QD / 8; ++i) qv[i] = *(const u32x4*)(qp + 8 * i);
#pragma unroll 1
    for (int half = 0; half < 2; ++half) {
        float o[32];
#pragma unroll
        for (int i = 0; i < 32; ++i) o[i] = 0.f;
        float m = -1.0e30f, lsum = 0.f;
#pragma unroll 1
        for (int j = 0; j < nkeys; ++j) {
            const u32x4* kr = (const u32x4*)(kp + (size_t)j * kstride);
            float s = 0.f;
#pragma unroll
            for (int i = 0; i < QD / 8; ++i) s = dot8(qv[i], kr[i], s);
            if (s > m) { const float al = __builtin_amdgcn_exp2f(m - s); lsum *= al;
#pragma unroll
                for (int i = 0; i < 32; ++i) o[i] *= al;
                m = s; }
            const float p = __builtin_amdgcn_exp2f(s - m); lsum += p;
            const u32x4* vr = (const u32x4*)(vp + (size_t)j * vstride + 32 * half);
#pragma unroll
            for (int i = 0; i < 4; ++i) { const u32x4 w = vr[i];
                o[8 * i + 0] += p * bflo(w.x); o[8 * i + 1] += p * bfhi(w.x); o[8 * i + 2] += p * bflo(w.y); o[8 * i + 3] += p * bfhi(w.y); o[8 * i + 4] += p * bflo(w.z); o[8 * i + 5] += p * bfhi(w.z); o[8 * i + 6] += p * bflo(w.w); o[8 * i + 7] += p * bfhi(w.w); }
        }
        const float rl = 1.0f / lsum;
#pragma unroll
        for (int i = 0; i < 4; ++i) { u32x4 w; w.x = pk2(o[8 * i] * rl, o[8 * i + 1] * rl); w.y = pk2(o[8 * i + 2] * rl, o[8 * i + 3] * rl); w.z = pk2(o[8 * i + 4] * rl, o[8 * i + 5] * rl); w.w = pk2(o[8 * i + 6] * rl, o[8 * i + 7] * rl); *(u32x4*)(op + 32 * half + 8 * i) = w; }
    }
}
__device__ __forceinline__ void phase_attn_naive(const Ctx& F, KP kp, bool last) {
    const Args a = ldargs(kp);
    unsigned char* ws = a.ws;
    const bf16_t* Qm = (const bf16_t*)(ws + WS_QM); const bf16_t* Km = (const bf16_t*)(ws + WS_KM); const bf16_t* Vm = (const bf16_t*)(ws + WS_VM);
    const bf16_t* Qg = (const bf16_t*)(ws + WS_QG); const bf16_t* Kg = (const bf16_t*)(ws + WS_KG); const bf16_t* Vg = (const bf16_t*)(ws + WS_VG);
    bf16_t* O = (bf16_t*)(ws + WS_O);
    const int gw = F.vcu * NWAVES + F.wave, NGW = GRID * NWAVES;
    const int ntask = 8192 + (last ? 0 : 1024);
    for (int T = gw; T < ntask; T += NGW) {
        int b, h16, r, nkeys;
        if (T < 8192) { const int qw = T & 31; h16 = (T >> 5) & 15; b = T >> 9; r = b * SEQ + 64 * qw + F.lane; nkeys = KPB; }
        else { const int T2 = T - 8192, qw = T2 & 3; h16 = (T2 >> 2) & 15; b = T2 >> 6; r = TL + b * CTX + 64 * qw + F.lane; nkeys = CTX; }
        bf16_t* op = O + (size_t)r * D + h16 * 64;
        if (h16 < 8) attn_naive_task<96>(Qm + (size_t)r * QW + h16 * 96, Km + (size_t)b * KPB * QW + h16 * 96, QW, Vm + (size_t)b * KPB * 512 + h16 * 64, 512, nkeys, op);
        else { const int hh = h16 - 8, kvh = hh >> 2; attn_naive_task<64>(Qg + (size_t)r * 512 + hh * 64, Kg + (size_t)b * KPB * 128 + kvh * 64, 128, Vg + (size_t)b * KPB * 128 + kvh * 64, 128, nkeys, op); }
    }
}

typedef float f32x16 __attribute__((ext_vector_type(16)));
typedef short s16x4 __attribute__((ext_vector_type(4)));
__device__ __forceinline__ s16x4 vtr(const LAS unsigned char* p) { return __builtin_bit_cast(s16x4, __builtin_amdgcn_ds_read_tr16_b64_v4i16((LAS s16x4*)p)); }
__device__ __forceinline__ unsigned cvtpk(float lo, float hi) { typedef __bf16 bf2 __attribute__((ext_vector_type(2))); f32x2 v = {lo, hi}; bf2 b = __builtin_convertvector(v, bf2); return __builtin_bit_cast(unsigned, b); }
constexpr float ATT_THR = 6.0f;
constexpr int ATT_KSLOT = 12288, ATT_VSLOT = 8192, ATT_NKS = 3, ATT_NVS = 4, ATT_V0 = ATT_NKS * ATT_KSLOT;
__device__ __forceinline__ void att_glds16(const void* gsrc, unsigned lds_dst) { unsigned keep;
    asm volatile("s_mov_b32 %0, m0\n\ts_mov_b32 m0, %2\n\ts_nop 0\n\tglobal_load_lds_dwordx4 %1, off\n\ts_mov_b32 m0, %0" : "=&s"(keep) : "v"(gsrc), "s"(lds_dst) : "memory"); }
__device__ __forceinline__ void att_glds16s(const void* sbase, unsigned voff, unsigned lds_dst) { unsigned keep;
    asm volatile("s_mov_b32 %0, m0\n\ts_mov_b32 m0, %3\n\ts_nop 0\n\tglobal_load_lds_dwordx4 %1, %2\n\ts_mov_b32 m0, %0" : "=&s"(keep) : "v"(voff), "s"(sbase), "s"(lds_dst) : "memory"); }
#define ATT_WAITBAR(N) asm volatile("s_waitcnt vmcnt(" #N ") lgkmcnt(0)\n\ts_barrier" ::: "memory")
template <int QD>
__device__ __forceinline__ void attn_unit(LAS unsigned char* lds, int tid, const bf16_t* Kb, int kstride, const bf16_t* Vb, int vstride, int ntiles, const bf16_t* qrow, bf16_t* orow) {
    constexpr int NC = QD / 8, NS = QD / 16;
    const int lane = tid & 63, r32 = lane & 31, hi = lane >> 5;
    const int w = __builtin_amdgcn_readfirstlane(tid >> 6);
    const bool three = (NC == 12) && (w < 4);
    const int vp = (NC == 12) ? (w < 4 ? w + 4 : w - 4) : w;
    const bf16_t* ksrcA = Kb + w * 512 + lane * 8;
    const bf16_t* ksrcB = Kb + (w + 8) * 512 + lane * 8;
    const bf16_t* vsrc = Vb + vp * 512 + lane * 8;
    const size_t kstep = (size_t)64 * QD, vstep = (size_t)4096;
    const unsigned lds0 = (unsigned)(size_t)lds;
#define ATT_DMA(t_, ks_, vs_) do { \
        att_glds16(ksrcA + (size_t)(t_) * kstep, (unsigned)__builtin_amdgcn_readfirstlane((int)(lds0 + (ks_) * ATT_KSLOT + w * 1024))); \
        if (three) att_glds16(ksrcB + (size_t)(t_) * kstep, (unsigned)__builtin_amdgcn_readfirstlane((int)(lds0 + (ks_) * ATT_KSLOT + (w + 8) * 1024))); \
        att_glds16(vsrc + (size_t)(t_) * vstep, (unsigned)__builtin_amdgcn_readfirstlane((int)(lds0 + ATT_V0 + (vs_) * ATT_VSLOT + vp * 1024))); } while (0)
    ATT_DMA(0, 0, 0);
    if (ntiles > 1) ATT_DMA(1, 1, 1);
    bf16x8 qr[NS];
#pragma unroll
    for (int s = 0; s < NS; ++s) qr[s] = *(const bf16x8*)(qrow + 16 * s + 8 * hi);
    f32x16 o0, o1, negm, p0, p1;
#pragma unroll
    for (int r = 0; r < 16; ++r) { o0[r] = 0.f; o1[r] = 0.f; negm[r] = 0.f; p0[r] = 0.f; p1[r] = 0.f; }
    float lsum = 0.f;
    const int kread = hi * 1024 + r32 * 16;
    const int vread = ATT_V0 + ((lane >> 4) & 1) * 32 + (lane & 3) * 8 + (4 * hi + ((lane & 15) >> 2)) * 64;
#define ATT_QK(ks_) do { const LAS unsigned char* kb_ = lds + (ks_) * ATT_KSLOT + kread; \
        _Pragma("unroll") for (int s = 0; s < NS; ++s) { \
            const bf16x8 a0 = *(const LAS bf16x8*)(kb_ + s * 2048), a1 = *(const LAS bf16x8*)(kb_ + s * 2048 + 512); \
            if (s == 0) { p0 = __builtin_amdgcn_mfma_f32_32x32x16_bf16(a0, qr[0], negm, 0, 0, 0); p1 = __builtin_amdgcn_mfma_f32_32x32x16_bf16(a1, qr[0], negm, 0, 0, 0); } \
            else { p0 = __builtin_amdgcn_mfma_f32_32x32x16_bf16(a0, qr[s], p0, 0, 0, 0); p1 = __builtin_amdgcn_mfma_f32_32x32x16_bf16(a1, qr[s], p1, 0, 0, 0); } } } while (0)
#define ATT_SOFT_PV(first_, vs_) do { \
        float mx = fmaxf(fmaxf(p0[0], p1[0]), p0[1]); \
        _Pragma("unroll") for (int r = 1; r < 16; ++r) mx = (r == 1) ? fmaxf(mx, p1[1]) : fmaxf(fmaxf(mx, p0[r]), p1[r]); \
        { auto rr = __builtin_amdgcn_permlane32_swap(__float_as_uint(mx), __float_as_uint(mx), false, false); mx = fmaxf(__uint_as_float(rr[0]), __uint_as_float(rr[1])); } \
        if ((first_) || __any(mx > ATT_THR)) { \
            const float dl = (first_) ? mx : fmaxf(mx, 0.f); \
            _Pragma("unroll") for (int r = 0; r < 16; ++r) { p0[r] -= dl; p1[r] -= dl; negm[r] -= dl; } \
            if (!(first_)) { const float f = __builtin_amdgcn_exp2f(-dl); lsum *= f; \
                _Pragma("unroll") for (int r = 0; r < 16; ++r) { o0[r] *= f; o1[r] *= f; } } \
        } \
        float rs = 0.f; \
        _Pragma("unroll") for (int r = 0; r < 16; ++r) { p0[r] = __builtin_amdgcn_exp2f(p0[r]); p1[r] = __builtin_amdgcn_exp2f(p1[r]); rs += p0[r] + p1[r]; } \
        lsum += rs; \
        u32x4 w0, w1, w2, w3; \
        w0.x = cvtpk(p0[0], p0[1]); w0.y = cvtpk(p0[2], p0[3]); w0.z = cvtpk(p0[4], p0[5]); w0.w = cvtpk(p0[6], p0[7]); \
        w1.x = cvtpk(p0[8], p0[9]); w1.y = cvtpk(p0[10], p0[11]); w1.z = cvtpk(p0[12], p0[13]); w1.w = cvtpk(p0[14], p0[15]); \
        w2.x = cvtpk(p1[0], p1[1]); w2.y = cvtpk(p1[2], p1[3]); w2.z = cvtpk(p1[4], p1[5]); w2.w = cvtpk(p1[6], p1[7]); \
        w3.x = cvtpk(p1[8], p1[9]); w3.y = cvtpk(p1[10], p1[11]); w3.z = cvtpk(p1[12], p1[13]); w3.w = cvtpk(p1[14], p1[15]); \
        const bf16x8 pa0 = __builtin_bit_cast(bf16x8, w0), pa1 = __builtin_bit_cast(bf16x8, w1), pa2 = __builtin_bit_cast(bf16x8, w2), pa3 = __builtin_bit_cast(bf16x8, w3); \
        const LAS unsigned char* vb_ = lds + (vs_) * ATT_VSLOT + vread; \
        o0 = __builtin_amdgcn_mfma_f32_32x32x16_bf16(ATT_VF(0, 0), pa0, o0, 0, 0, 0); \
        o1 = __builtin_amdgcn_mfma_f32_32x32x16_bf16(ATT_VF(1, 0), pa0, o1, 0, 0, 0); \
        o0 = __builtin_amdgcn_mfma_f32_32x32x16_bf16(ATT_VF(0, 1), pa1, o0, 0, 0, 0); \
        o1 = __builtin_amdgcn_mfma_f32_32x32x16_bf16(ATT_VF(1, 1), pa1, o1, 0, 0, 0); \
        o0 = __builtin_amdgcn_mfma_f32_32x32x16_bf16(ATT_VF(0, 2), pa2, o0, 0, 0, 0); \
        o1 = __builtin_amdgcn_mfma_f32_32x32x16_bf16(ATT_VF(1, 2), pa2, o1, 0, 0, 0); \
        o0 = __builtin_amdgcn_mfma_f32_32x32x16_bf16(ATT_VF(0, 3), pa3, o0, 0, 0, 0); \
        o1 = __builtin_amdgcn_mfma_f32_32x32x16_bf16(ATT_VF(1, 3), pa3, o1, 0, 0, 0); } while (0)
#define ATT_VF(d0, ks) ({ const s16x4 lo_ = vtr(vb_ + (d0) * 4096 + (ks) * 1024), hi_ = vtr(vb_ + (d0) * 4096 + (ks) * 1024 + 512); (bf16x8){lo_[0], lo_[1], lo_[2], lo_[3], hi_[0], hi_[1], hi_[2], hi_[3]}; })
#define ATT_ENDSTEP() do { if (issue) { if (three) ATT_WAITBAR(3); else ATT_WAITBAR(2); } else ATT_WAITBAR(0); \
        ks = (ks == ATT_NKS - 1) ? 0 : ks + 1; vs = (vs + 1) & (ATT_NVS - 1); } while (0)
    if (ntiles > 1) { if (three) ATT_WAITBAR(3); else ATT_WAITBAR(2); } else ATT_WAITBAR(0);
    int ks = 0, vs = 0;
    if (w < 4) {
        for (int t = 0; t < ntiles; ++t) {
            const bool issue = (t + 2 < ntiles);
            if (issue) ATT_DMA(t + 2, (ks >= 1) ? ks - 1 : ATT_NKS - 1, (vs + 2) & (ATT_NVS - 1));
            ATT_QK(ks);
            ATT_SOFT_PV(t == 0, vs);
            ATT_ENDSTEP();
        }
    } else {
        for (int t = 0; t < ntiles; ++t) {
            const bool issue = (t + 2 < ntiles);
            if (issue) ATT_DMA(t + 2, (ks >= 1) ? ks - 1 : ATT_NKS - 1, (vs + 2) & (ATT_NVS - 1));
            if (t > 0) ATT_SOFT_PV(t == 1, (vs + ATT_NVS - 1) & (ATT_NVS - 1));
            ATT_QK(ks);
            ATT_ENDSTEP();
        }
        ATT_SOFT_PV(ntiles == 1, (vs + ATT_NVS - 1) & (ATT_NVS - 1));
    }
#undef ATT_DMA
#undef ATT_QK
#undef ATT_SOFT_PV
#undef ATT_VF
#undef ATT_ENDSTEP
    { auto rr = __builtin_amdgcn_permlane32_swap(__float_as_uint(lsum), __float_as_uint(lsum), false, false); lsum = __uint_as_float(rr[0]) + __uint_as_float(rr[1]); }
    const float rl = 1.0f / lsum;
#pragma unroll
    for (int g = 0; g < 4; ++g) {
        u32x2 a, b2;
        a.x = cvtpk(o0[4 * g] * rl, o0[4 * g + 1] * rl); a.y = cvtpk(o0[4 * g + 2] * rl, o0[4 * g + 3] * rl);
        b2.x = cvtpk(o1[4 * g] * rl, o1[4 * g + 1] * rl); b2.y = cvtpk(o1[4 * g + 2] * rl, o1[4 * g + 3] * rl);
        *(u32x2*)(orow + 8 * g + 4 * hi) = a; *(u32x2*)(orow + 32 + 8 * g + 4 * hi) = b2;
    }
    asm volatile("s_waitcnt lgkmcnt(0)\n\ts_barrier" ::: "memory");
}

constexpr int AT3_KSLOT = 12288, AT3_VSLOT = 8192, AT3_V0 = 3 * AT3_KSLOT;
constexpr int AT3_FLAG = MISC_OFF + 32;
constexpr float AT3_SUMTHR = 1024.f, AT3_SUMBAD = 1.152921504606846976e18f;
#define AT3_SB() __builtin_amdgcn_sched_barrier(0)
#define AT3_PIN(x) asm volatile("" : "+v"(x))
template <int QD, bool exact>
__device__ __forceinline__ void attn_unit3(LAS unsigned char* lds, int tid, const bf16_t* Kb, const bf16_t* Vb, int ntiles, const bf16_t* qrow, bf16_t* orow) {
    constexpr int NC = QD / 8, NS = QD / 16, NKF = 2 * NS;
    constexpr int KG0 = (NS == 4) ? 2 : 1;
    const int lane = tid & 63, r32 = lane & 31, hi = lane >> 5;
    const int w = __builtin_amdgcn_readfirstlane(tid >> 6);
    const bool three = (NC == 12) && (w < 4);
    const int vp = (NC == 12) ? (w < 4 ? w + 4 : w - 4) : w;
    const bf16_t* ksrcA = Kb + w * 512;
    const bf16_t* ksrcB = Kb + (w + 8) * 512;
    const bf16_t* vsrc = Vb + vp * 512;
    const unsigned lofs = (unsigned)lane * 16u;
    const size_t kstep = (size_t)64 * QD, vstep = (size_t)4096;
    const unsigned lds0 = (unsigned)(size_t)lds;
#define AT3_DMAK(t_, sl_) do { \
        att_glds16s(ksrcA + (size_t)(t_) * kstep, lofs, (unsigned)__builtin_amdgcn_readfirstlane((int)(lds0 + (sl_) * AT3_KSLOT + w * 1024))); \
        if (three) att_glds16s(ksrcB + (size_t)(t_) * kstep, lofs, (unsigned)__builtin_amdgcn_readfirstlane((int)(lds0 + (sl_) * AT3_KSLOT + (w + 8) * 1024))); } while (0)
#define AT3_DMAV(t_, sl_) att_glds16s(vsrc + (size_t)(t_) * vstep, lofs, (unsigned)__builtin_amdgcn_readfirstlane((int)(lds0 + AT3_V0 + (sl_) * AT3_VSLOT + vp * 1024)))
#define AT3_WB(n_) do { const int nn_ = (n_); if (nn_ == 3) ATT_WAITBAR(3); else if (nn_ == 2) ATT_WAITBAR(2); else if (nn_ == 1) ATT_WAITBAR(1); else ATT_WAITBAR(0); } while (0)
    const int nk = three ? 2 : 1;
    bf16x8 qr[NS];
#pragma unroll
    for (int s = 0; s < NS; ++s) qr[s] = *(const bf16x8*)(qrow + 16 * s + 8 * hi);
    AT3_DMAK(0, 0);
    f32x16 o0, o1, negm, pA0, pA1, pB0, pB1;
#pragma unroll
    for (int r = 0; r < 16; ++r) { o0[r] = 0.f; o1[r] = 0.f; negm[r] = 0.f; }
    AT3_PIN(negm);
    float lsum = 0.f, fres = 1.f; bool resc = false, bad = false;
    const LAS unsigned char* kp0 = lds + hi * 1024 + r32 * 16;
    const LAS unsigned char* vp0 = lds + AT3_V0 + ((lane >> 4) & 1) * 32 + (lane & 3) * 8 + (4 * hi + ((lane & 15) >> 2)) * 64;
    ATT_WAITBAR(0);
    AT3_DMAV(0, 0); AT3_DMAK(1, 1); AT3_DMAK(2, 2);
    {
#pragma unroll
        for (int s = 0; s < NS; ++s) {
            const bf16x8 a0 = *(const LAS bf16x8*)(kp0 + s * 2048), a1 = *(const LAS bf16x8*)(kp0 + s * 2048 + 512);
            if (s == 0) { pA0 = __builtin_amdgcn_mfma_f32_32x32x16_bf16(a0, qr[0], negm, 0, 0, 0); pA1 = __builtin_amdgcn_mfma_f32_32x32x16_bf16(a1, qr[0], negm, 0, 0, 0); }
            else { pA0 = __builtin_amdgcn_mfma_f32_32x32x16_bf16(a0, qr[s], pA0, 0, 0, 0); pA1 = __builtin_amdgcn_mfma_f32_32x32x16_bf16(a1, qr[s], pA1, 0, 0, 0); } }
        float mx = fmaxf(fmaxf(pA0[0], pA1[0]), pA0[1]);
#pragma unroll
        for (int r = 1; r < 16; ++r) mx = (r == 1) ? fmaxf(mx, pA1[1]) : fmaxf(fmaxf(mx, pA0[r]), pA1[r]);
        { auto rr = __builtin_amdgcn_permlane32_swap(__float_as_uint(mx), __float_as_uint(mx), false, false); mx = fmaxf(__uint_as_float(rr[0]), __uint_as_float(rr[1])); }
#pragma unroll
        for (int r = 0; r < 16; ++r) { pA0[r] = __builtin_amdgcn_exp2f(pA0[r] - mx); pA1[r] = __builtin_amdgcn_exp2f(pA1[r] - mx); negm[r] = -mx; }
        AT3_PIN(negm);
    }
    ATT_WAITBAR(0);
    AT3_DMAK(3, 0); AT3_DMAV(1, 1);
    int sp = 0, sc = 1, sn = 2;
#define AT3_ROT() do { sp = sc; sc = sn; sn = (sn == 2) ? 0 : sn + 1; } while (0)
    bf16x8 kf[NKF];
    { const LAS unsigned char* kp_ = kp0 + sc * AT3_KSLOT;
#pragma unroll
      for (int j = 0; j < NS; ++j) { kf[2 * j] = *(const LAS bf16x8*)(kp_ + j * 2048); kf[2 * j + 1] = *(const LAS bf16x8*)(kp_ + j * 2048 + 512); } }
    AT3_WB(nk + 1);
    s16x4 vlo[8], vhi[8]; u32x4 pw[4];
#define AT3_PVAL(P0, P1, i) (((i) < 16) ? P0[(i) & 15] : P1[(i) & 15])
#define AT3_VFR(i) (bf16x8){vlo[i][0], vlo[i][1], vlo[i][2], vlo[i][3], vhi[i][0], vhi[i][1], vhi[i][2], vhi[i][3]}
#define AT3_STEP(C0, C1, P0, P1, t_, GK, GV, GL) do { AT3_SB(); \
        const LAS unsigned char* vp_ = vp0 + sp * AT3_VSLOT; \
        float sacc = P0[0] + P0[1]; \
        _Pragma("unroll") for (int g = 0; g < NKF; ++g) { \
            if (g < 8) { const int i_ = (g >> 1) + 4 * (g & 1); \
                vlo[i_] = vtr(vp_ + (i_ >> 2) * 4096 + (i_ & 3) * 1024); vhi[i_] = vtr(vp_ + (i_ >> 2) * 4096 + (i_ & 3) * 1024 + 512); AT3_SB(); } \
            if (g & 1) { if (g < 2) C1 = __builtin_amdgcn_mfma_f32_32x32x16_bf16(kf[g], qr[g >> 1], negm, 0, 0, 0); else C1 = __builtin_amdgcn_mfma_f32_32x32x16_bf16(kf[g], qr[g >> 1], C1, 0, 0, 0); } \
            else { if (g < 2) C0 = __builtin_amdgcn_mfma_f32_32x32x16_bf16(kf[g], qr[g >> 1], negm, 0, 0, 0); else C0 = __builtin_amdgcn_mfma_f32_32x32x16_bf16(kf[g], qr[g >> 1], C0, 0, 0, 0); } \
            { const int wl_ = (g * 16) / NKF, wh_ = ((g + 1) * 16) / NKF;         \
              _Pragma("unroll") for (int k_ = 0; k_ < 16; ++k_) if (k_ >= wl_ && k_ < wh_) { \
                  if (k_ < 15) { sacc += AT3_PVAL(P0, P1, 2 * k_ + 2); sacc += AT3_PVAL(P0, P1, 2 * k_ + 3); } \
                  pw[k_ >> 2][k_ & 3] = cvtpk(AT3_PVAL(P0, P1, 2 * k_), AT3_PVAL(P0, P1, 2 * k_ + 1)); } \
              AT3_PIN(sacc); \
              _Pragma("unroll") for (int k_ = 0; k_ < 4; ++k_) if (4 * k_ + 3 >= wl_ && 4 * k_ < wh_) AT3_PIN(pw[k_]); } \
            AT3_SB(); } \
        lsum += sacc; \
        if (GK) AT3_DMAK((t_) + 3, sc); \
        if (GV) AT3_DMAV((t_) + 1, sn); \
        resc = false; \
        if (exact) { float ma = fmaxf(fmaxf(C0[0], C0[1]), C1[0]), mb = fmaxf(fmaxf(C0[2], C0[3]), C1[1]); ma = fmaxf(fmaxf(ma, C1[2]), C1[3]); \
          _Pragma("unroll") for (int r = 4; r < 16; r += 4) { ma = fmaxf(fmaxf(ma, C0[r]), C0[r + 1]); mb = fmaxf(fmaxf(mb, C0[r + 2]), C0[r + 3]); ma = fmaxf(fmaxf(ma, C1[r]), C1[r + 1]); mb = fmaxf(fmaxf(mb, C1[r + 2]), C1[r + 3]); } \
          float rm = fmaxf(ma, mb); \
          { auto rr = __builtin_amdgcn_permlane32_swap(__float_as_uint(rm), __float_as_uint(rm), false, false); rm = fmaxf(__uint_as_float(rr[0]), __uint_as_float(rr[1])); } \
          if (__builtin_expect(__any(rm > ATT_THR), 0)) { const float dl = fmaxf(rm, 0.f); \
              _Pragma("unroll") for (int r = 0; r < 16; ++r) { C0[r] -= dl; C1[r] -= dl; negm[r] -= dl; } \
              AT3_PIN(negm); \
              fres = __builtin_amdgcn_exp2f(-dl); lsum *= fres; resc = true; } \
        } else if (__builtin_expect(__any(!(sacc <= AT3_SUMTHR)), 0)) {         \
            float sm = sacc; \
            { auto rr = __builtin_amdgcn_permlane32_swap(__float_as_uint(sm), __float_as_uint(sm), false, false); const float s0_ = __uint_as_float(rr[0]), s1_ = __uint_as_float(rr[1]); sm = (s0_ == s0_ && s1_ == s1_) ? fmaxf(s0_, s1_) : s0_ + s1_; } \
            if (__any(!(sm < AT3_SUMBAD))) bad = true; \
            const float dl = (sm > AT3_SUMTHR && sm < AT3_SUMBAD) ? (float)((int)(__float_as_uint(sm) >> 23) - 127) : 0.f;     \
            _Pragma("unroll") for (int r = 0; r < 16; ++r) { C0[r] -= dl; C1[r] -= dl; negm[r] -= dl; } \
            AT3_PIN(negm); \
            fres = __builtin_amdgcn_exp2f(-dl); lsum *= fres; resc = true; } \
        AT3_SB(); \
        const LAS unsigned char* kn_ = kp0 + sn * AT3_KSLOT; \
        _Pragma("unroll") for (int g = 0; g < 8; ++g) { \
            if (g >= KG0 && g < KG0 + NS) { if (GL) { const int j_ = g - KG0; kf[2 * j_] = *(const LAS bf16x8*)(kn_ + j_ * 2048); kf[2 * j_ + 1] = *(const LAS bf16x8*)(kn_ + j_ * 2048 + 512); AT3_SB(); } } \
            { const int i_ = (g >> 1) + 4 * (g & 1); \
              if (g & 1) o1 = __builtin_amdgcn_mfma_f32_32x32x16_bf16(AT3_VFR(i_), __builtin_bit_cast(bf16x8, pw[g >> 1]), o1, 0, 0, 0); \
              else o0 = __builtin_amdgcn_mfma_f32_32x32x16_bf16(AT3_VFR(i_), __builtin_bit_cast(bf16x8, pw[g >> 1]), o0, 0, 0, 0); } \
            if (g < 4) { C0[4 * g] = __builtin_amdgcn_exp2f(C0[4 * g]); C0[4 * g + 1] = __builtin_amdgcn_exp2f(C0[4 * g + 1]); C0[4 * g + 2] = __builtin_amdgcn_exp2f(C0[4 * g + 2]); C0[4 * g + 3] = __builtin_amdgcn_exp2f(C0[4 * g + 3]); AT3_PIN(C0); } \
            else { C1[4 * g - 16] = __builtin_amdgcn_exp2f(C1[4 * g - 16]); C1[4 * g - 15] = __builtin_amdgcn_exp2f(C1[4 * g - 15]); C1[4 * g - 14] = __builtin_amdgcn_exp2f(C1[4 * g - 14]); C1[4 * g - 13] = __builtin_amdgcn_exp2f(C1[4 * g - 13]); AT3_PIN(C1); } \
            AT3_SB(); } \
    } while (0)
#define AT3_RESC() do { if (resc) { _Pragma("unroll") for (int r = 0; r < 16; ++r) { o0[r] *= fres; o1[r] *= fres; } } } while (0)
    for (int t = 1; t + 3 < ntiles; t += 2) {
        AT3_STEP(pB0, pB1, pA0, pA1, t, true, true, true);      if (three) ATT_WAITBAR(3); else ATT_WAITBAR(2);  AT3_RESC(); AT3_ROT();
        AT3_STEP(pA0, pA1, pB0, pB1, t + 1, true, true, true);  if (three) ATT_WAITBAR(3); else ATT_WAITBAR(2);  AT3_RESC(); AT3_ROT();
    }
    AT3_STEP(pB0, pB1, pA0, pA1, ntiles - 3, false, true, true);   ATT_WAITBAR(1); AT3_RESC(); AT3_ROT();
    AT3_STEP(pA0, pA1, pB0, pB1, ntiles - 2, false, true, true);   ATT_WAITBAR(0); AT3_RESC(); AT3_ROT();
    AT3_STEP(pB0, pB1, pA0, pA1, ntiles - 1, false, false, false); AT3_RESC();
    { float sacc = pB0[0] + pB0[1];
#pragma unroll
      for (int r = 2; r < 16; ++r) sacc += pB0[r];
#pragma unroll
      for (int r = 0; r < 16; ++r) sacc += pB1[r];
      lsum += sacc;
#pragma unroll
      for (int k = 0; k < 4; ++k) { pw[k][0] = cvtpk(AT3_PVAL(pB0, pB1, 8 * k), AT3_PVAL(pB0, pB1, 8 * k + 1)); pw[k][1] = cvtpk(AT3_PVAL(pB0, pB1, 8 * k + 2), AT3_PVAL(pB0, pB1, 8 * k + 3));
                                    pw[k][2] = cvtpk(AT3_PVAL(pB0, pB1, 8 * k + 4), AT3_PVAL(pB0, pB1, 8 * k + 5)); pw[k][3] = cvtpk(AT3_PVAL(pB0, pB1, 8 * k + 6), AT3_PVAL(pB0, pB1, 8 * k + 7)); }
      const LAS unsigned char* vp_ = vp0 + sc * AT3_VSLOT;
#pragma unroll
      for (int i = 0; i < 8; ++i) { vlo[i] = vtr(vp_ + (i >> 2) * 4096 + (i & 3) * 1024); vhi[i] = vtr(vp_ + (i >> 2) * 4096 + (i & 3) * 1024 + 512); }
#pragma unroll
      for (int k = 0; k < 4; ++k) { o0 = __builtin_amdgcn_mfma_f32_32x32x16_bf16(AT3_VFR(k), __builtin_bit_cast(bf16x8, pw[k]), o0, 0, 0, 0); o1 = __builtin_amdgcn_mfma_f32_32x32x16_bf16(AT3_VFR(k + 4), __builtin_bit_cast(bf16x8, pw[k]), o1, 0, 0, 0); } }
#undef AT3_DMAK
#undef AT3_DMAV
#undef AT3_WB
#undef AT3_ROT
#undef AT3_PVAL
#undef AT3_VFR
#undef AT3_STEP
#undef AT3_RESC
    { auto rr = __builtin_amdgcn_permlane32_swap(__float_as_uint(lsum), __float_as_uint(lsum), false, false); lsum = __uint_as_float(rr[0]) + __uint_as_float(rr[1]); }
    const float rl = 1.0f / lsum;
    LAS unsigned char* stg = lds + (AT3_V0 + 3 * AT3_VSLOT) + w * (32 * 144);
#pragma unroll
    for (int g = 0; g < 4; ++g) {
        u32x2 a, b2;
        a.x = cvtpk(o0[4 * g] * rl, o0[4 * g + 1] * rl); a.y = cvtpk(o0[4 * g + 2] * rl, o0[4 * g + 3] * rl);
        b2.x = cvtpk(o1[4 * g] * rl, o1[4 * g + 1] * rl); b2.y = cvtpk(o1[4 * g + 2] * rl, o1[4 * g + 3] * rl);
        *(LAS u32x2*)(stg + r32 * 144 + (8 * g + 4 * hi) * 2) = a; *(LAS u32x2*)(stg + r32 * 144 + (32 + 8 * g + 4 * hi) * 2) = b2;
    }
    asm volatile("s_waitcnt lgkmcnt(0)" ::: "memory");
    { bf16_t* obase = orow - (size_t)r32 * D;
#pragma unroll
      for (int i = 0; i < 4; ++i) { const int row = i * 8 + (lane >> 3), ch = lane & 7;
          const u32x4 v = *(const LAS u32x4*)(stg + row * 144 + ch * 16);
          *(u32x4*)(obase + (size_t)row * D + ch * 8) = v; } }
    if (!exact) { if (__any(!(lsum < 1.2676506e30f))) bad = true;
        if (bad && lane == 0) *(volatile LAS unsigned*)(lds + AT3_FLAG) = 1u; }
    asm volatile("s_waitcnt lgkmcnt(0)\n\ts_barrier" ::: "memory");
}
struct AttDesc { bool qd96; const bf16_t* Kb; const bf16_t* Vb; const bf16_t* Qb; bf16_t* Ob; int row0, nt; };
__device__ __forceinline__ AttDesc att_desc(int i, int vcu, unsigned char* ws) {
    const bf16_t* Qm = (const bf16_t*)(ws + WS_QM); const bf16_t* Km = (const bf16_t*)(ws + WS_KM); const bf16_t* Vm = (const bf16_t*)(ws + WS_VM);
    const bf16_t* Qg = (const bf16_t*)(ws + WS_QG); const bf16_t* Kg = (const bf16_t*)(ws + WS_KG); const bf16_t* Vg = (const bf16_t*)(ws + WS_VG);
    bf16_t* O = (bf16_t*)(ws + WS_O);
    const int xcd = vcu >> 5, cix = vcu & 31;
    AttDesc d;
    if (i < 8 && (i & 1) == 0) {
        const int pair = xcd * 16 + (i >> 1) * 4 + (cix >> 3), b = pair >> 3, h = pair & 7, qb = cix & 7;
        d.qd96 = true; d.Kb = Km + (size_t)(b * 8 + h) * KPB * 96; d.Vb = Vm + (size_t)(b * 8 + h) * KPB * 64; d.Qb = Qm + h * 96; d.Ob = O + h * 64; d.row0 = b * SEQ + qb * 256; d.nt = KPB / 64;
    } else if (i < 8) {
        const int pair = xcd * 4 + (i >> 1), b = pair >> 1, kvh = pair & 1;
        d.qd96 = false; d.Kb = Kg + (size_t)(b * 2 + kvh) * KPB * 64; d.Vb = Vg + (size_t)(b * 2 + kvh) * KPB * 64; d.Qb = Qg + kvh * 256; d.Ob = O + 512 + kvh * 256; d.row0 = b * SEQ + cix * 64; d.nt = KPB / 64;
    } else if (vcu < 128) {
        const int b = vcu >> 3, h = vcu & 7;
        d.qd96 = true; d.Kb = Km + (size_t)(b * 8 + h) * KPB * 96; d.Vb = Vm + (size_t)(b * 8 + h) * KPB * 64; d.Qb = Qm + h * 96; d.Ob = O + h * 64; d.row0 = TL + b * CTX; d.nt = CTX / 64;
    } else {
        const int idx = vcu - 128, b = idx >> 3, kvh = (idx >> 2) & 1, qb = idx & 3;
        d.qd96 = false; d.Kb = Kg + (size_t)(b * 2 + kvh) * KPB * 64; d.Vb = Vg + (size_t)(b * 2 + kvh) * KPB * 64; d.Qb = Qg + kvh * 256; d.Ob = O + 512 + kvh * 256; d.row0 = TL + b * CTX + qb * 64; d.nt = CTX / 64;
    }
    return d;
}
#ifndef ATT_FORCE_EXACT
#define ATT_FORCE_EXACT 0
#endif
__device__ __forceinline__ void phase_attn(const Ctx& F, KP kp, bool last, int l) {
    const Args a = ldargs(kp);
    unsigned char* ws = a.ws;
    const int nun = last ? 8 : 9;
    if (F.tid == 0) *(volatile LAS unsigned*)(F.lds + AT3_FLAG) = ATT_FORCE_EXACT ? 1u : 0u;
    bool exact = false;
#define ATT_RUN(EX) do { \
        int tid_; { int ln_; asm volatile("v_mbcnt_lo_u32_b32 %0, -1, 0\n\tv_mbcnt_hi_u32_b32 %0, -1, %0" : "=v"(ln_)); tid_ = F.wave * 64 + ln_; }       \
        const int r32 = tid_ & 31, w = __builtin_amdgcn_readfirstlane(tid_ >> 6); \
        if (d.qd96) { const int row = d.row0 + w * 32 + r32; \
            attn_unit3<96, EX>(F.lds, tid_, d.Kb, d.Vb, d.nt, d.Qb + (size_t)row * QW, d.Ob + (size_t)row * D); \
        } else { const int row = d.row0 + (w & 1) * 32 + r32; \
            attn_unit3<64, EX>(F.lds, tid_, d.Kb, d.Vb, d.nt, d.Qb + (size_t)row * 512 + (w >> 1) * 64, d.Ob + (size_t)row * D + (w >> 1) * 64); } } while (0)
    for (int i = 0; i < nun; ++i) {
        const AttDesc d = att_desc(i, F.vcu, ws);
        if (!exact) {
            ATT_RUN(false);
            const unsigned fl = __builtin_amdgcn_readfirstlane((int)*(volatile LAS unsigned*)(F.lds + AT3_FLAG));
            if (fl != 0u) exact = true;
        }
        if (exact) ATT_RUN(true);
        if (i == (F.vcu & 7)) {
            int ln_; asm volatile("v_mbcnt_lo_u32_b32 %0, -1, 0\n\tv_mbcnt_hi_u32_b32 %0, -1, %0" : "=v"(ln_));
            conv_experts(ln_, F.wave, F.vcu, a, l);
        }
    }
#undef ATT_RUN
}
__global__ void __launch_bounds__(NTHREADS, 2) fwd_kernel(Args a_unused) {
    extern __shared__ __attribute__((aligned(16))) unsigned char lds_raw[];
    const KP kp = (KP)__builtin_amdgcn_kernarg_segment_ptr();
    Ctx F;
    F.lds = (LAS unsigned char*)lds_raw;
    F.tid = threadIdx.x; F.lane = F.tid & 63; F.wave = __builtin_amdgcn_readfirstlane(F.tid >> 6);
    F.bk = blockIdx.x; F.vcu = (F.bk & 7) * (GRID / 8) + (F.bk >> 3);
    if (F.tid < 4) ((volatile LAS unsigned*)(F.lds + MISC_BAR))[F.tid] = 0u;
    __syncthreads();
    { const Args a = ldargs(kp); (void)xcd_barrier_post((unsigned*)(a.ws + WS_CTL), (volatile LAS unsigned*)(F.lds + MISC_BAR), F.tid == 0); }
#define FRESH() do { int ln_; asm volatile("v_mbcnt_lo_u32_b32 %0, -1, 0\n\tv_mbcnt_hi_u32_b32 %0, -1, %0" : "=v"(ln_)); F.lane = ln_; F.tid = F.wave * 64 + ln_; F.bk = blockIdx.x; F.vcu = (F.bk & 7) * (GRID / 8) + (F.bk >> 3); } while (0)
#define GRID_BAR() do { XcdBarrier b_; { const Args a_ = ldargs(kp); b_.bar = (unsigned*)(a_.ws + WS_CTL); } b_.x = xb_xcc_id(); b_.st = (volatile LAS unsigned*)(F.lds + MISC_BAR); xcd_barrier(b_, F.tid == 0); } while (0)

    for (int rep_ = 0; rep_ < REP_PRO; ++rep_) prologue1(F, kp);
    GRID_BAR(); FRESH();
    prologue2(F, kp);
    prologue3(F, kp);
    GRID_BAR(); FRESH();

    for (int l = 0; l < NL; ++l) {
        const bool last = (l == NL - 1);
        const int ntok = last ? TL : MT;
        { const Args a = ldargs(kp); unsigned char* ws = a.ws;
          Gemm g{(const bf16_t*)(ws + WS_H), D, (const bf16_t*)(ws + WS_WIN) + (size_t)l * ZW * D, D}; StaticOrder S; S.init(MT, ZW, GRID, F.bk);
#if FUSE_SPLIT
          LAS f32x2* t64l = (LAS f32x2*)(F.lds + STAGE_BYTES); LAS f32x2* t32l = t64l + 1024; LAS float* ggl = (LAS float*)(t32l + 512);
          { const f32x2* t64g = (const f32x2*)(ws + WS_TAB64); const f32x2* t32g = (const f32x2*)(ws + WS_TAB32);
            t64l[F.tid] = t64g[F.tid]; t64l[F.tid + 512] = t64g[F.tid + 512]; t32l[F.tid] = t32g[F.tid];
            if (F.tid < 64) ggl[F.tid] = a.g_gq[l * 64 + F.tid]; else if (F.tid < 128) ggl[F.tid] = a.g_gk[l * 64 + F.tid - 64]; }
          __syncthreads();
          EpiIn E{ws, ggl, ggl + 64, t64l, t32l}; gemm_phase<0>(F, g, S, E); }
#else
          EpiZ E{(bf16_t*)(ws + WS_Z)}; gemm_phase<0>(F, g, S, E); }
#endif
        GRID_BAR(); FRESH();
#if !FUSE_SPLIT
        for (int rep_ = 0; rep_ < REP_P2; ++rep_) phase_split(F, kp, l);
        GRID_BAR(); FRESH();
#endif
        { const Args a = ldargs(kp); unsigned char* ws = a.ws;
          Gemm g{(const bf16_t*)(ws + WS_Z), ZW, (const bf16_t*)(ws + WS_WQ) + (size_t)l * QW * 384, 384}; StaticOrder S; S.init(MT, QW, GRID, F.bk);
          LAS f32x2* t32l = (LAS f32x2*)(F.lds + STAGE_BYTES);
          LAS float* rsq = (LAS float*)(F.lds + STAGE_BYTES + 4096);
          { const f32x2* t32g = (const f32x2*)(ws + WS_TAB32); t32l[F.tid] = t32g[F.tid];
            Unit u; for (int i = 0; i < 4 && S.next(i, u); ++i) if (F.tid < 256) rsq[i * 256 + F.tid] = EpiQ::rowscale(ws, u.pm * 256 + F.tid); }
          __syncthreads();
          EpiQ E{ws, t32l, rsq}; gemm_phase<1>(F, g, S, E); }
        FRESH();
        { const Args a = ldargs(kp); unsigned char* ws = a.ws;
          Gemm g{(const bf16_t*)(ws + WS_Z) + 384, ZW, (const bf16_t*)(ws + WS_WKV) + (size_t)l * KVW * 256, 256}; StaticOrder S; S.init(MT, KVW, GRID, (F.bk + 80) & 255);
          LAS float* rskv = (LAS float*)(F.lds + STAGE_BYTES + 8192);
          { Unit u; for (int i = 0; i < 4 && S.next(i, u); ++i) if (F.tid < 256) rskv[i * 256 + F.tid] = EpiKV::rowscale(ws, u.pm * 256 + F.tid); }
          __syncthreads();
          EpiKV E{ws, rskv}; gemm_phase<2>(F, g, S, E); }
        GRID_BAR(); FRESH();
#if USE_MFMA_ATTN
        for (int rep_ = 0; rep_ < REP_ATTN; ++rep_) phase_attn(F, kp, last, l);
        FRESH();
#else
#error the scalar attention body reads the old row-major K/V layout
#endif
        GRID_BAR(); FRESH();
        { const Args a = ldargs(kp); unsigned char* ws = a.ws;
          Gemm g{(const bf16_t*)(ws + WS_O), D, (const bf16_t*)(ws + WS_WO) + (size_t)l * D * D, D}; StaticOrder S; S.init(ntok, D, GRID, F.bk);
          EpiYo E{(bf16_t*)(ws + WS_U)}; gemm_phase<3>(F, g, S, E); }
        GRID_BAR(); FRESH();
        if (l == 0) phase_ln1_route<true>(F, kp, l, ntok); else phase_ln1_route<false>(F, kp, l, ntok);
        GRID_BAR(); FRESH();
        for (int rep_ = 0; rep_ < REP_P7; ++rep_) phase_dispatch(F, kp, l, ntok);
        GRID_BAR(); FRESH();
        { const Args a = ldargs(kp); unsigned char* ws = a.ws;
          Gemm g{(const bf16_t*)(ws + WS_H), D, (const bf16_t*)(ws + WS_WGU) + (size_t)l * NEXP * 1024 * D, D}; GroupedOrder S; S.init((const volatile LAS int*)(F.lds + MISC_POFF), GRID, F.vcu);
          LAS int* gt = (LAS int*)(F.lds + STAGE_BYTES);
          { const int* postok = (const int*)(ws + WS_POSTOK); Unit u; for (int i = 0; i < 16 && S.next(i, u); ++i) if (F.tid < 256) gt[i * 256 + F.tid] = postok[u.pm * 256 + F.tid]; }
          __syncthreads();
          EpiAct E{(bf16_t*)(ws + WS_ACT)}; gemm_phase_gather<4>(F, g, S, E, gt); }
        GRID_BAR(); FRESH();
        { const Args a = ldargs(kp); unsigned char* ws = a.ws;
          Gemm g{(const bf16_t*)(ws + WS_ACT), FF, (const bf16_t*)(ws + WS_WD) + (size_t)l * NEXP * D * FF, FF}; GroupedOrder S; S.init((const volatile LAS int*)(F.lds + MISC_POFF), GRID, F.vcu);
          EpiY E{(bf16_t*)(ws + WS_XS)}; gemm_phase<5>(F, g, S, E); }
        GRID_BAR(); FRESH();
        phase_ln2(F, kp, l, ntok);
        GRID_BAR(); FRESH();
    }
}

extern "C" void kernel_launch(void* const* d_in, const int* in_sizes, int n_in, void* d_out, int out_size, void* d_ws, size_t ws_size, hipStream_t stream) {
    static int grid = 0;
    if (grid == 0) {
        if (n_in != 25 || out_size != TL * D || ws_size < WS_END) { fprintf(stderr, "kernel_launch: unexpected shapes (n_in %d out %d ws %zu need %zu)\n", n_in, out_size, ws_size, (size_t)WS_END); grid = -1; return; }
        int dev = 0, cus = 0, per_cu = 0;
        if (hipGetDevice(&dev) != hipSuccess || hipDeviceGetAttribute(&cus, hipDeviceAttributeMultiprocessorCount, dev) != hipSuccess) { grid = -1; return; }
        if (hipFuncSetAttribute((const void*)fwd_kernel, hipFuncAttributeMaxDynamicSharedMemorySize, LDS_BYTES) != hipSuccess) { fprintf(stderr, "kernel_launch: hipFuncSetAttribute failed\n"); grid = -1; return; }
        if (hipOccupancyMaxActiveBlocksPerMultiprocessor(&per_cu, (const void*)fwd_kernel, NTHREADS, LDS_BYTES) != hipSuccess || per_cu < 1) { fprintf(stderr, "kernel_launch: occupancy query says %d\n", per_cu); }
        (void)hipGetLastError();
        grid = (cus == 256) ? 256 : -1;
        if (grid < 0) { fprintf(stderr, "kernel_launch: need a 256-CU device, got %d\n", cus); return; }
    }
    if (grid < 0) return;
    if (hipMemsetAsync((char*)d_ws + WS_CTL, 0, CTL_BYTES, stream) != hipSuccess) return;
    Args a{};
    a.x = (const float*)d_in[0]; a.c = (const float*)d_in[1]; a.ctx = (const float*)d_in[2]; a.c_ctx = (const float*)d_in[3]; a.w_ada = (const float*)d_in[4]; a.b_ada = (const float*)d_in[5];
    a.w_in = (const float*)d_in[6]; a.g_q_a = (const float*)d_in[7]; a.w_q_b = (const float*)d_in[8]; a.g_kv_a = (const float*)d_in[9]; a.w_kv_b = (const float*)d_in[10];
    a.g_gq = (const float*)d_in[11]; a.g_gk = (const float*)d_in[12]; a.w_o = (const float*)d_in[13]; a.ln1_g = (const float*)d_in[14]; a.ln1_b = (const float*)d_in[15];
    a.w_rg = (const float*)d_in[16]; a.b_rg = (const float*)d_in[17]; a.w_re = (const float*)d_in[18]; a.b_re = (const float*)d_in[19];
    a.w_gate = (const float*)d_in[20]; a.w_up = (const float*)d_in[21]; a.w_down = (const float*)d_in[22]; a.ln2_g = (const float*)d_in[23]; a.ln2_b = (const float*)d_in[24];
    a.out = (float*)d_out; a.ws = (unsigned char*)d_ws;
    hipLaunchKernelGGL(fwd_kernel, dim3(grid), dim3(NTHREADS), LDS_BYTES, stream, a);
}
```

```cpp
#include <hip/hip_runtime.h>
#include <cstdint>
#include <cstdio>

#ifndef REP_ATTN
#define REP_ATTN 1
#endif
#ifndef REP_GEMM
#define REP_GEMM 1
#endif
#ifndef REP_PRO
#define REP_PRO 1
#endif
#ifndef REP_THIN
#define REP_THIN 1
#endif
#ifndef REP_P2
#define REP_P2 1
#endif
#ifndef REP_P7
#define REP_P7 1
#endif
#ifndef REP_P6
#define REP_P6 1
#endif
#ifndef REP_P10
#define REP_P10 0
#endif
#ifndef FILL_P1
#define FILL_P1 3
#endif
#ifndef FILL_P5
#define FILL_P5 3
#endif
#ifndef FUSE_SPLIT
#define FUSE_SPLIT 1
#endif
#ifndef USE_MFMA_GEMM
#define USE_MFMA_GEMM 1
#endif
#ifndef USE_MFMA_ATTN
#define USE_MFMA_ATTN 1
#endif

#define GAS __attribute__((address_space(1)))
#define LAS __attribute__((address_space(3)))
typedef unsigned short bf16_t;
typedef float f32x4 __attribute__((ext_vector_type(4)));
typedef float f32x2 __attribute__((ext_vector_type(2)));
typedef unsigned u32x4 __attribute__((ext_vector_type(4)));
typedef unsigned u32x2 __attribute__((ext_vector_type(2)));
typedef short bf16x8 __attribute__((ext_vector_type(8)));

constexpr int D = 1024, NB = 16, SEQ = 2048, CTX = 256, NL = 4;
constexpr int TL = NB * SEQ, TC = NB * CTX, MT = TL + TC;
constexpr int KPB = CTX + SEQ;
constexpr int ZW = 1536;
constexpr int QW = 768, KVW = 1024;
constexpr int NEXP = 32, FF = 512;
constexpr int XS_ROWS = 81920;
constexpr float ALPHA = 1.6817928305074290f;
constexpr float LOG2E = 1.4426950408889634f;
constexpr float QSCALE_M = 0.10206207261596575f * LOG2E;
constexpr float QSCALE_G = 0.125f * LOG2E;
constexpr float RMS_EPS = 1e-6f, LN_EPS = 1e-5f;
constexpr int NWAVES = 8, NTHREADS = 512, GRID = 256;

constexpr size_t al256(size_t x) { return (x + 255) & ~(size_t)255; }
constexpr size_t WS_CTL = 0, CTL_BYTES = 65536;
constexpr size_t WS_BLKCNT = WS_CTL + CTL_BYTES;
constexpr size_t WS_MOETAB = WS_BLKCNT + (size_t)NL * 256 * 32 * 4;
constexpr size_t WS_MOD = WS_MOETAB + (size_t)NL * 128 * 4;
constexpr size_t WS_MODP = WS_MOD + (size_t)NL * 17 * 6144 * 4;
constexpr size_t WS_TAB64 = WS_MODP + (size_t)4 * NL * 17 * 6144 * 4;
constexpr size_t WS_TAB32 = WS_TAB64 + 64 * 16 * 8;
constexpr size_t WS_RSTDQ = WS_TAB32 + 64 * 8 * 8;
constexpr size_t WS_RSTDKV = WS_RSTDQ + (size_t)MT * 4;
constexpr size_t WS_TOKE = WS_RSTDKV + (size_t)MT * 4;
constexpr size_t WS_TOKR = WS_TOKE + (size_t)MT * 8;
constexpr size_t WS_TOKP = WS_TOKR + (size_t)MT * 8;
constexpr size_t WS_TOKW = WS_TOKP + (size_t)MT * 8;
constexpr size_t WS_WIN = al256(WS_TOKW + (size_t)MT * 8);
constexpr size_t WS_WQ = WS_WIN + (size_t)NL * ZW * D * 2;
constexpr size_t WS_WKV = WS_WQ + (size_t)NL * QW * 384 * 2;
constexpr size_t WS_WO = WS_WKV + (size_t)NL * KVW * 256 * 2;
constexpr size_t WS_WGU = WS_WO + (size_t)NL * D * D * 2;
constexpr size_t WS_WD = WS_WGU + (size_t)NL * NEXP * 1024 * D * 2;
constexpr size_t WS_XC = WS_WD + (size_t)NL * NEXP * D * FF * 2;
constexpr size_t WS_H = WS_XC + (size_t)TC * D * 4;
constexpr size_t WS_B = WS_H + (size_t)MT * D * 2;
constexpr size_t WS_Z = WS_B;
constexpr size_t WS_QM = WS_Z + (size_t)MT * ZW * 2;
constexpr size_t WS_KM = WS_QM + (size_t)MT * QW * 2;
constexpr size_t WS_VM = WS_KM + (size_t)MT * QW * 2;
constexpr size_t WS_QG = WS_VM + (size_t)MT * 512 * 2;
constexpr size_t WS_KG = WS_QG + (size_t)MT * 512 * 2;
constexpr size_t WS_VG = WS_KG + (size_t)MT * 128 * 2;
constexpr size_t WS_O = WS_VG + (size_t)MT * 128 * 2;
constexpr size_t WS_BEND = WS_O + (size_t)MT * D * 2;
constexpr size_t WS_U = WS_B;
constexpr size_t WS_XS = WS_B;
constexpr size_t WS_ACT = WS_XS + (size_t)XS_ROWS * D * 2;
constexpr size_t WS_HLO = WS_BEND;
constexpr size_t WS_WR = WS_HLO + (size_t)MT * D * 2;
constexpr size_t WS_POSTOK = WS_WR + (size_t)NL * 2 * 48 * D * 2;
constexpr size_t WS_SSQP = al256(WS_POSTOK + (size_t)XS_ROWS * 4);
constexpr size_t WS_XB = al256(WS_SSQP + (size_t)MT * 20 * 4);
constexpr size_t WS_END = WS_XB + (size_t)MT * D * 2;
static_assert(WS_U + (size_t)MT * D * 4 <= WS_KM, "U must fit in Z+QM");
static_assert(WS_ACT + (size_t)XS_ROWS * FF * 2 <= WS_BEND, "MoE buffers must fit in region B");
static_assert(WS_END < (size_t)1100 * 1000 * 1000, "workspace map too large");

constexpr int LDS_BYTES = 163840;
constexpr int BIG_BYTES = 147456;
constexpr int MISC_OFF = BIG_BYTES;
constexpr int MISC_BAR = MISC_OFF;
constexpr int MISC_CNT = MISC_OFF + 64;
constexpr int MISC_POFF = MISC_OFF + 256;
constexpr int MISC_TOT = MISC_OFF + 512;
constexpr int MISC_BASE = MISC_OFF + 768;
constexpr int MISC_PA = MISC_OFF + 1024;
constexpr int MISC_PB = MISC_OFF + 1024 + 2048;
constexpr int MISC_LG = MISC_OFF + 8192;

#define LDS_WAIT() asm volatile("s_waitcnt lgkmcnt(0)" ::: "memory")
__device__ __forceinline__ unsigned f2bf(float f) { unsigned u = __builtin_bit_cast(unsigned, f); return (u + 0x7fffu + ((u >> 16) & 1u)) >> 16; }
__device__ __forceinline__ unsigned pk2(float lo, float hi) { typedef __bf16 bf2_t __attribute__((ext_vector_type(2))); f32x2 v = {lo, hi}; bf2_t b = __builtin_convertvector(v, bf2_t); return __builtin_bit_cast(unsigned, b); }
__device__ __forceinline__ float bflo(unsigned w) { return __builtin_bit_cast(float, w << 16); }
__device__ __forceinline__ float bfhi(unsigned w) { return __builtin_bit_cast(float, w & 0xffff0000u); }
template <int K> __device__ __forceinline__ float lane_xor(float v) { return __int_as_float(__builtin_amdgcn_ds_swizzle(__float_as_int(v), (K << 10) | 0x1f)); }
__device__ __forceinline__ float wave_sum(float v) {
    v += lane_xor<1>(v); v += lane_xor<2>(v); v += lane_xor<4>(v); v += lane_xor<8>(v); v += lane_xor<16>(v);
    { auto rr = __builtin_amdgcn_permlane32_swap(__float_as_uint(v), __float_as_uint(v), false, false); v = __uint_as_float(rr[0]) + __uint_as_float(rr[1]); }
    return v;
}
__device__ __forceinline__ int krow_of(int r) { return r < TL ? (r >> 11) * KPB + CTX + (r & 2047) : ((r - TL) >> 8) * KPB + ((r - TL) & 255); }
__device__ __forceinline__ void key_bj(int r, int& b, int& j) { if (r < TL) { b = r >> 11; j = CTX + (r & 2047); } else { b = (r - TL) >> 8; j = (r - TL) & 255; } }
__device__ __forceinline__ size_t ktile_off(int nh, int b, int h, int j, int qd, int chunk) { return ((size_t)(b * nh + h) * KPB + (j & ~63)) * qd + chunk * 512 + (j & 63) * 8; }
__device__ __forceinline__ size_t vtile_off(int nh, int b, int h, int j, int d0) { return ((size_t)(b * nh + h) * KPB + (j & ~63)) * 64 + (d0 >> 5) * 2048 + (j & 63) * 32 + (d0 & 31); }
__device__ __forceinline__ int bb_of(int r) { return r < TL ? (r >> 11) : 16; }

#define XB_TMO      128
#define XB_XCNT(j)  (256  + 64 * (j))
#define XB_XSUB(j)  (1280 + 64 * (j))
#define XB_XGEN(j)  (2304 + 64 * (j))
#define XB_TOP      3328
#define XB_TOPGEN   3392
#define XCD_BAR_WORDS 3456
#define XB_SPIN_CAP (1u << 18)
__device__ __forceinline__ unsigned xb_ld(unsigned* p)              { return __hip_atomic_load(p, __ATOMIC_RELAXED, __HIP_MEMORY_SCOPE_AGENT); }
__device__ __forceinline__ unsigned xb_add(unsigned* p, unsigned v) { return __hip_atomic_fetch_add(p, v, __ATOMIC_RELAXED, __HIP_MEMORY_SCOPE_AGENT); }
__device__ __forceinline__ unsigned xb_xcc_id() { return (unsigned)__builtin_amdgcn_s_getreg((3 << 11) | 20) & 0xFu; }
#define XB_SPIN(cond, bar) do { unsigned _sp = 0; while (cond) { __builtin_amdgcn_s_sleep(1); \
    if ((++_sp & 255u) == 0u) { if (xb_ld(&(bar)[XB_TMO])) break; if (_sp > XB_SPIN_CAP) { atomicAdd(&(bar)[XB_TMO], 1u); break; } } } } while (0)
struct XcdBarrier { unsigned* bar; unsigned x; volatile LAS unsigned* st; };
__device__ __forceinline__ XcdBarrier xcd_barrier_post(unsigned* bar, volatile LAS unsigned* st, const bool leader) {
    XcdBarrier b; b.bar = bar; b.x = xb_xcc_id(); b.st = st;
    if (leader) (void)xb_add(&bar[XB_XCNT(b.x)], 1u);
    return b;
}
__device__ __forceinline__ void xcd_barrier_complete(unsigned* bar, unsigned x, unsigned& nloc, unsigned& nx) {
    const unsigned G = gridDim.x * gridDim.y * gridDim.z;
    unsigned sum, cnt, mine, sp = 0u;
    for (;;) {
        sum = 0u; cnt = 0u; mine = 0u;
#pragma unroll
        for (unsigned j = 0; j < 16; ++j) { const unsigned c = xb_ld(&bar[XB_XCNT(j)]); sum += c; cnt += (c > 0u) ? 1u : 0u; mine = (j == x) ? c : mine; }
        if (sum == G) break;
        __builtin_amdgcn_s_sleep(1);
        if ((++sp & 255u) == 0u) { if (xb_ld(&bar[XB_TMO])) break; if (sp > XB_SPIN_CAP) { atomicAdd(&bar[XB_TMO], 1u); break; } }
    }
    nloc = mine > 0u ? mine : 1u; nx = cnt > 0u ? cnt : 1u;
}
__device__ __forceinline__ void xcd_barrier(const XcdBarrier& b, const bool leader) {
    asm volatile("s_waitcnt vmcnt(0)" ::: "memory");
    __syncthreads();
    if (leader) {
        unsigned* bar = b.bar;
        __builtin_amdgcn_s_waitcnt(0);
        unsigned nloc = b.st[0], nx = b.st[1];
        if (nloc == 0u) { xcd_barrier_complete(bar, b.x, nloc, nx); b.st[0] = nloc; b.st[1] = nx; }
        const unsigned old = xb_add(&bar[XB_XSUB(b.x)], 1u);
        const unsigned gen = old / nloc;
        if (old + 1u == (gen + 1u) * nloc) {
            __builtin_amdgcn_fence(__ATOMIC_RELEASE, "agent");
            asm volatile("s_waitcnt vmcnt(0)" ::: "memory");
            const unsigned og = xb_add(&bar[XB_TOP], 1u);
            const unsigned tg = og / nx;
            if (og + 1u == (tg + 1u) * nx) xb_add(&bar[XB_TOPGEN], 1u);
            else XB_SPIN(xb_ld(&bar[XB_TOPGEN]) == tg, bar);
            __builtin_amdgcn_fence(__ATOMIC_ACQUIRE, "agent");
            xb_add(&bar[XB_XGEN(b.x)], 1u);
            asm volatile("s_waitcnt vmcnt(0)" ::: "memory");
        } else {
            XB_SPIN(xb_ld(&bar[XB_XGEN(b.x)]) == gen, bar);
            __builtin_amdgcn_fence(__ATOMIC_ACQUIRE, "agent");
            asm volatile("s_waitcnt vmcnt(0)" ::: "memory");
        }
    }
    __syncthreads();
}

struct Args {
    const float* x; const float* c; const float* ctx; const float* c_ctx; const float* w_ada; const float* b_ada; const float* w_in;
    const float* g_q_a; const float* w_q_b; const float* g_kv_a; const float* w_kv_b; const float* g_gq; const float* g_gk; const float* w_o;
    const float* ln1_g; const float* ln1_b; const float* w_rg; const float* b_rg; const float* w_re; const float* b_re;
    const float* w_gate; const float* w_up; const float* w_down; const float* ln2_g; const float* ln2_b;
    float* out; unsigned char* ws;
};

typedef const __attribute__((address_space(4))) Args* KP;
__device__ __forceinline__ Args ldargs(KP p) {
#if defined(__HIP_DEVICE_COMPILE__)
    asm volatile("" : "+s"(p)); return *p;
#else
    return Args{};
#endif
}

struct Ctx {
    LAS unsigned char* lds;
    int tid, lane, wave, vcu, bk;
};

struct Unit { int pm, pn; };
constexpr int BM = 256, NXCD = 8, WGM = 8;
struct StaticOrder {
    int nM, nN, nwg, G, c;
    __device__ __forceinline__ void init(int M, int N, int G_, int c_) { nM = M / BM; nN = N / BM; nwg = nM * nN; G = G_; c = c_; }
    __device__ __forceinline__ bool next(int i, Unit& u) const {
        const long L = (long)i * G + c; if (L >= nwg) return false;
        int wgid = (int)L; { const int q = nwg / NXCD, r = nwg % NXCD, xcd = wgid % NXCD, off = wgid / NXCD; wgid = (xcd < r ? xcd * (q + 1) : r * (q + 1) + (xcd - r) * q) + off; }
        const int nig = WGM * nN, gid = wgid / nig, fm = gid * WGM, gsz = (nM - fm) < WGM ? (nM - fm) : WGM;
        u.pm = fm + ((wgid % nig) % gsz); u.pn = (wgid % nig) / gsz; return true;
    }
    __device__ __forceinline__ void a_ready(const Unit&) const {}
    __device__ __forceinline__ void done(const Unit&) const {}
};
struct GroupedOrder {
    const volatile LAS int* poff; int nunits, G, c;
    __device__ __forceinline__ void init(const volatile LAS int* poff_, int G_, int c_) { poff = poff_; nunits = (poff_[32] >> 8) * 4; G = G_; c = c_; }
    __device__ __forceinline__ bool next(int i, Unit& u) const {
        const int L = i * G + c; if (L >= nunits) return false;
        const int rt = L >> 2, r0 = rt << 8; int e = 0;
#pragma unroll
        for (int j = 1; j < 32; ++j) e += (poff[j] <= r0) ? 1 : 0;
        u.pm = rt; u.pn = e * 4 + (L & 3); return true;
    }
    __device__ __forceinline__ void a_ready(const Unit&) const {}
    __device__ __forceinline__ void done(const Unit&) const {}
};

__device__ __forceinline__ void st_bf4(bf16_t* p, f32x4 v) { u32x2 w; w.x = pk2(v[0], v[1]); w.y = pk2(v[2], v[3]); *(u32x2*)p = w; }
__device__ __forceinline__ void st_bf8(bf16_t* p, f32x4 a, f32x4 b) { u32x4 w; w.x = pk2(a[0], a[1]); w.y = pk2(a[2], a[3]); w.z = pk2(b[0], b[1]); w.w = pk2(b[2], b[3]); *(u32x4*)p = w; }
struct EpiZ {
    static constexpr bool PERM = true;
    bf16_t* Z;
    __device__ __forceinline__ void tile32(int row, int col, int fq, f32x4 v0, f32x4 v1) const { st_bf8(Z + (size_t)row * ZW + col + 8 * fq, v0, v1); }
};
__device__ __forceinline__ float xor32(float v, bool lower) { auto rr = __builtin_amdgcn_permlane32_swap(__float_as_uint(v), __float_as_uint(v), false, false); return __uint_as_float(lower ? rr[1] : rr[0]); }
struct EpiIn {
    static constexpr bool PERM = true, PAIR = true;
    unsigned char* wsb; const LAS float* ggq; const LAS float* ggk; const LAS f32x2* t64l; const LAS f32x2* t32l;
    __device__ __forceinline__ float sum4(float s, int fq) const { s += lane_xor<16>(s); s += xor32(s, fq < 2); return s; }
    __device__ __forceinline__ void za(int row, int col, int fq, f32x4 v0, f32x4 v1) const {
        bf16_t* Z = (bf16_t*)(wsb + WS_Z); float* ssqp = (float*)(wsb + WS_SSQP); bf16_t* Km = (bf16_t*)(wsb + WS_KM); const LAS f32x2* t32 = t32l;
        if (col < 640) {
            st_bf8(Z + (size_t)row * ZW + col + 8 * fq, v0, v1);
            float s = (v0[0] * v0[0] + v0[1] * v0[1]) + (v0[2] * v0[2] + v0[3] * v0[3]) + (v1[0] * v1[0] + v1[1] * v1[1]) + (v1[2] * v1[2] + v1[3] * v1[3]);
            s = sum4(s, fq);
            if (fq == 0) ssqp[(size_t)row * 20 + (col >> 5)] = s;
        } else if (col == 640) {
            float v[8] = {v0[0], v0[1], v0[2], v0[3], v1[0], v1[1], v1[2], v1[3]}, o[8];
#pragma unroll
            for (int e = 0; e < 8; ++e) { const float p = lane_xor<16>(v[e]); o[e] = v[e];
                if (row < TL) { const int s2 = row & 2047, pos = (fq >> 1) ? (s2 & 63) : (s2 >> 6); const f32x2 c = t32[pos * 8 + e]; o[e] = (fq & 1) ? (v[e] * c.x + p * c.y) : (v[e] * c.x - p * c.y); } }
            u32x4 w; w.x = pk2(o[0], o[1]); w.y = pk2(o[2], o[3]); w.z = pk2(o[4], o[5]); w.w = pk2(o[6], o[7]);
            int kb, kj; key_bj(row, kb, kj);
#pragma unroll
            for (int h = 0; h < 8; ++h) *(u32x4*)(Km + ktile_off(8, kb, h, kj, 96, 8 + fq)) = w;
        }
    }
    __device__ __forceinline__ void head(int row, int fq, f32x4 a0, f32x4 a1, f32x4 b0, f32x4 b1, const LAS float* g, float scale, bf16_t* dlo, bf16_t* dhi) const {
        const LAS f32x2* t64 = t64l;
        float lo[8] = {a0[0], a0[1], a0[2], a0[3], a1[0], a1[1], a1[2], a1[3]}, hi[8] = {b0[0], b0[1], b0[2], b0[3], b1[0], b1[1], b1[2], b1[3]};
        float ss = 0.f;
#pragma unroll
        for (int e = 0; e < 8; ++e) ss += lo[e] * lo[e] + hi[e] * hi[e];
        ss = sum4(ss, fq);
        const float rn = __builtin_amdgcn_rsqf(ss * (1.0f / 64.0f) + RMS_EPS) * scale;
        const bool lat = row < TL, lower = fq < 2; const int s2 = row & 2047, gr = s2 >> 6, gc = s2 & 63, f0 = 8 * (fq & 1);
        const LAS f32x4* gp = (const LAS f32x4*)(g + 8 * fq); const f32x4 g0 = gp[0], g1 = gp[1], g2 = gp[8], g3 = gp[9];
        const float gl[8] = {g0[0], g0[1], g0[2], g0[3], g1[0], g1[1], g1[2], g1[3]}, gh[8] = {g2[0], g2[1], g2[2], g2[3], g3[0], g3[1], g3[2], g3[3]};
        float ol[8], oh[8];
        if (lat) {
            const LAS f32x4* tl = (const LAS f32x4*)(t64 + gr * 16 + f0); const LAS f32x4* th = (const LAS f32x4*)(t64 + gc * 16 + f0);
            const f32x4 cl0 = tl[0], cl1 = tl[1], cl2 = tl[2], cl3 = tl[3], ch0 = th[0], ch1 = th[1], ch2 = th[2], ch3 = th[3];
            const float cL[8] = {cl0[0], cl0[2], cl1[0], cl1[2], cl2[0], cl2[2], cl3[0], cl3[2]}, sL[8] = {cl0[1], cl0[3], cl1[1], cl1[3], cl2[1], cl2[3], cl3[1], cl3[3]};
            const float cH[8] = {ch0[0], ch0[2], ch1[0], ch1[2], ch2[0], ch2[2], ch3[0], ch3[2]}, sH[8] = {ch0[1], ch0[3], ch1[1], ch1[3], ch2[1], ch2[3], ch3[1], ch3[3]};
#pragma unroll
            for (int e = 0; e < 8; ++e) {
                const float yl = lo[e] * rn * gl[e], yh = hi[e] * rn * gh[e];
                const float pl = xor32(yl, lower), ph = xor32(yh, lower);
                ol[e] = lower ? (yl * cL[e] - pl * sL[e]) : (yl * cL[e] + pl * sL[e]);
                oh[e] = lower ? (yh * cH[e] - ph * sH[e]) : (yh * cH[e] + ph * sH[e]);
            }
        } else {
#pragma unroll
            for (int e = 0; e < 8; ++e) { ol[e] = lo[e] * rn * gl[e]; oh[e] = hi[e] * rn * gh[e]; }
        }
        u32x4 w; w.x = pk2(ol[0], ol[1]); w.y = pk2(ol[2], ol[3]); w.z = pk2(ol[4], ol[5]); w.w = pk2(ol[6], ol[7]); *(u32x4*)dlo = w;
        w.x = pk2(oh[0], oh[1]); w.y = pk2(oh[2], oh[3]); w.z = pk2(oh[4], oh[5]); w.w = pk2(oh[6], oh[7]); *(u32x4*)dhi = w;
    }
    __device__ __forceinline__ void tile64(int row, int pn, int wc, int fq, f32x4 a0, f32x4 a1, f32x4 b0, f32x4 b1) const {
        if (pn < 3) { const int col = pn * 256 + wc * 32; za(row, col, fq, a0, a1); za(row, col + 128, fq, b0, b1); }
        else if (pn < 5) { const int h = 4 * (pn - 3) + wc; bf16_t* q = (bf16_t*)(wsb + WS_QG) + (size_t)row * 512 + 64 * h + 8 * fq; head(row, fq, a0, a1, b0, b1, ggq, QSCALE_G, q, q + 32); }
        else { int kb, kj; key_bj(row, kb, kj);
            if (wc < 2) { bf16_t* Kg = (bf16_t*)(wsb + WS_KG); head(row, fq, a0, a1, b0, b1, ggk, 1.0f, Kg + ktile_off(2, kb, wc, kj, 64, fq), Kg + ktile_off(2, kb, wc, kj, 64, 4 + fq)); }
            else { bf16_t* Vg = (bf16_t*)(wsb + WS_VG); st_bf8(Vg + vtile_off(2, kb, wc - 2, kj, 8 * fq), a0, a1); st_bf8(Vg + vtile_off(2, kb, wc - 2, kj, 32 + 8 * fq), b0, b1); } }
    }
};
struct EpiQ {
    static constexpr bool PERM = true, PREP = true;
    unsigned char* wsb;
    const LAS f32x2* tab32;
    const LAS float* rsl;
    static __device__ __forceinline__ float rowscale(const unsigned char* wsb_, int row) {
        const float* rstd = (const float*)(wsb_ + WS_SSQP);
        const f32x4* sp = (const f32x4*)(rstd + (size_t)row * 20); const f32x4 s0 = sp[0], s1 = sp[1], s2 = sp[2];
        return QSCALE_M / sqrtf(((s0[0] + s0[1]) + (s0[2] + s0[3]) + (s1[0] + s1[1]) + (s1[2] + s1[3]) + (s2[0] + s2[1]) + (s2[2] + s2[3])) * (1.0f / 384.0f) + RMS_EPS);
    }
    __device__ __forceinline__ void tile32u(int row, int col, int fq, f32x4 v0, f32x4 v1, int ui) const {
        const float rs = rsl[ui * 256 + (row & 255)];
        bf16_t* Qm = (bf16_t*)(wsb + WS_QM);
        const int h = col / 96, gi = (col - h * 96) >> 5;
        v0 = v0 * rs; v1 = v1 * rs;
        bf16_t* base = Qm + (size_t)row * QW + h * 96;
        if (gi < 2) { st_bf8(base + gi * 32 + 8 * fq, v0, v1); }
        else {
            const int part = fq >> 1, f0 = (4 * fq) & 7;
            f32x4 o1 = v0, o2 = v1;
            if (row < TL) {
                const int s = row & 2047, pos = part ? (s & 63) : (s >> 6);
#pragma unroll
                for (int j = 0; j < 4; ++j) { const f32x2 cs = tab32[pos * 8 + f0 + j]; o1[j] = v0[j] * cs.x - v1[j] * cs.y; o2[j] = v1[j] * cs.x + v0[j] * cs.y; }
            }
            bf16_t* p = base + 64 + part * 16 + f0; st_bf4(p, o1); st_bf4(p + 8, o2);
        }
    }
};
struct EpiKV {
    static constexpr bool PERM = true, PREP = true;
    unsigned char* wsb;
    const LAS float* rsl;
    static __device__ __forceinline__ float rowscale(const unsigned char* wsb_, int row) {
        const float* rstd = (const float*)(wsb_ + WS_SSQP);
        const f32x4* sp = (const f32x4*)(rstd + (size_t)row * 20 + 12); const f32x4 s0 = sp[0], s1 = sp[1];
        return 1.0f / sqrtf(((s0[0] + s0[1]) + (s0[2] + s0[3]) + (s1[0] + s1[1]) + (s1[2] + s1[3])) * (1.0f / 256.0f) + RMS_EPS);
    }
    __device__ __forceinline__ void tile32u(int row, int col, int fq, f32x4 v0, f32x4 v1, int ui) const {
        const float rs = rsl[ui * 256 + (row & 255)];
        bf16_t* Km = (bf16_t*)(wsb + WS_KM); bf16_t* Vm = (bf16_t*)(wsb + WS_VM);
        const int h = col >> 7, w = (col & 127) + 8 * fq; int kb, kj; key_bj(row, kb, kj);
        bf16_t* p = (w < 64) ? (Km + ktile_off(8, kb, h, kj, 96, w >> 3)) : (Vm + vtile_off(8, kb, h, kj, w - 64));
        st_bf8(p, v0 * rs, v1 * rs);
    }
};
struct EpiU {
    static constexpr bool PERM = false;
    float* U; const float* xl; const float* xc; const float* mod_l;
    int gate;
    __device__ __forceinline__ void tile32(int row, int col, int fq, f32x4 v0, f32x4 v1) const {
        const float* xr = (row < TL) ? (xl + (size_t)row * D) : (xc + (size_t)(row - TL) * D);
        const float* g = mod_l + (size_t)(bb_of(row) * 6 + gate) * D;
        const int c0 = col + 4 * fq;
        const f32x4 x0 = *(const f32x4*)(xr + c0), x1 = *(const f32x4*)(xr + c0 + 16), g0 = *(const f32x4*)(g + c0), g1 = *(const f32x4*)(g + c0 + 16);
        float* u = U + (size_t)row * D + c0;
        *(f32x4*)u = x0 * ALPHA + g0 * v0; *(f32x4*)(u + 16) = x1 * ALPHA + g1 * v1;
    }
};
__device__ __forceinline__ float silu_f(float x) { return x * __builtin_amdgcn_rcpf(1.0f + __builtin_amdgcn_exp2f(-x * LOG2E)); }
struct EpiAct {
    static constexpr bool PERM = true, PAIR = true;
    bf16_t* Act;
    __device__ __forceinline__ void tile64(int row, int pn, int wc, int fq, f32x4 g0, f32x4 g1, f32x4 u0, f32x4 u1) const {
        const int f0 = 128 * (pn & 3) + 32 * wc + 8 * fq; f32x4 a, b;
#pragma unroll
        for (int j = 0; j < 4; ++j) { a[j] = silu_f(g0[j]) * u0[j]; b[j] = silu_f(g1[j]) * u1[j]; }
        st_bf8(Act + (size_t)row * FF + f0, a, b);
    }
};
struct EpiYo {
    static constexpr bool PERM = true;
    bf16_t* Y;
    __device__ __forceinline__ void tile32(int row, int col, int fq, f32x4 v0, f32x4 v1) const { st_bf8(Y + (size_t)row * D + col + 8 * fq, v0, v1); }
};
struct EpiY {
    static constexpr bool PERM = true;
    bf16_t* Y;
    __device__ __forceinline__ void tile32(int row, int col, int fq, f32x4 v0, f32x4 v1) const { st_bf8(Y + (size_t)row * D + (col & 1023) + 8 * fq, v0, v1); }
};

template <class E, class = void> struct epi_pair { static constexpr bool value = false; };
template <class E> struct epi_pair<E, decltype((void)E::PAIR)> { static constexpr bool value = E::PAIR; };
template <class E, class = void> struct epi_prep { static constexpr bool value = false; };
template <class E> struct epi_prep<E, decltype((void)E::PREP)> { static constexpr bool value = E::PREP; };
struct Gemm { const bf16_t* A; int lda; const bf16_t* Bt; int K; };
__device__ __forceinline__ float dot8(u32x4 a, u32x4 b, float acc) {
#pragma unroll
    for (int i = 0; i < 4; ++i) { acc += bflo(a[i]) * bflo(b[i]); acc += bfhi(a[i]) * bfhi(b[i]); }
    return acc;
}
template <class Sched, class Epi>
__device__ __forceinline__ void gemm_naive(const Ctx& F, const Gemm g, const Sched& S, const Epi& E) {
    Unit u;
    for (int i = 0; S.next(i, u); ++i) {
        for (int task = F.tid; task < 8192; task += NTHREADS) {
            const int lane = task & 63, fr = lane & 15, fq = lane >> 4, rest = task >> 6, rg = rest & 15, cg = rest >> 4;
            const int row = u.pm * 256 + rg * 16 + fr, col = u.pn * 256 + cg * 32;
            const bf16_t* ap = g.A + (size_t)row * g.lda;
            const bf16_t* bp0 = g.Bt + (size_t)(col + 4 * fq) * g.K;
            const bf16_t* bp1 = bp0 + (size_t)16 * g.K;
            f32x4 v0 = {0.f, 0.f, 0.f, 0.f}, v1 = {0.f, 0.f, 0.f, 0.f};
            for (int k = 0; k < g.K; k += 8) {
                const u32x4 a = *(const u32x4*)(ap + k);
#pragma unroll
                for (int j = 0; j < 4; ++j) {
                    v0[j] = dot8(a, *(const u32x4*)(bp0 + (size_t)j * g.K + k), v0[j]);
                    v1[j] = dot8(a, *(const u32x4*)(bp1 + (size_t)j * g.K + k), v1[j]);
                }
            }
            E.tile32(row, col, fq, v0, v1);
        }
    }
}
constexpr int BK = 64, HALF = 128, HTB = HALF * BK * 2, STAGE_BYTES = 8 * HTB;
__device__ __forceinline__ int lds_byte(int r, int c) { const int st = (r >> 4) * 2 + (c >> 5), rr = r & 15, cc = c & 31, ob = rr * 64 + cc * 2; return st * 1024 + (ob ^ (((ob >> 9) & 1) << 5)); }
__device__ __forceinline__ int perm32(int rho) { const int n = rho >> 4, i = rho & 15; return 8 * (i >> 2) + 4 * n + (i & 3); }
__device__ __forceinline__ void stage_rc(int b, int& R, int& C) { const int st = b / 1024, sb = b % 1024, swz = sb ^ (((sb >> 9) & 1) << 5); R = (st >> 1) * 16 + swz / 64; C = (st & 1) * 32 + (swz % 64) / 2; }
template <class Epi, class Sched, bool ALIGN_EPI = true, bool SP2 = true, bool GATHER = false>
__device__ __forceinline__ void gemm_mfma(LAS unsigned char* lds, const int tid_in, const Gemm g, const Sched& S, const Epi& E, const LAS int* gtab = nullptr) {
    int tid = tid_in; asm volatile("" : "+v"(tid));
    const int wid = __builtin_amdgcn_readfirstlane(tid >> 6), lane = tid & 63, wr = wid >> 2, wc = wid & 3, fr = lane & 15, fq = lane >> 4;
    const int K = g.K, nt = K / BK;
    unsigned voffB[2]; int RA[2], CA[2];
#pragma unroll
    for (int i = 0; i < 2; ++i) { int R, C; stage_rc(tid * 16 + i * 8192, R, C); const int Rb = Epi::PERM ? ((R & ~31) + perm32(R & 31)) : R;
        RA[i] = R; CA[i] = C; voffB[i] = (unsigned)(Rb * K + C) * 2u; }
    const size_t kstep = (size_t)(BK * 2);
    const size_t hstepA = (size_t)HALF * g.lda * 2, hstepB = (size_t)HALF * K * 2;
    const size_t tstepA = GATHER ? 0 : 2 * hstepA, tstepB = 2 * hstepB;
    unsigned vc0[2], vc1[2], vn0[2], vn1[2];
#define PG8_GOFF(dst0, dst1, ui_) do { _Pragma("unroll") for (int i_ = 0; i_ < 2; ++i_) { \
        if constexpr (GATHER) { dst0[i_] = (unsigned)gtab[(ui_) * 256 + RA[i_]] * (unsigned)(g.lda * 2) + (unsigned)CA[i_] * 2u; dst1[i_] = (unsigned)gtab[(ui_) * 256 + HALF + RA[i_]] * (unsigned)(g.lda * 2) + (unsigned)CA[i_] * 2u; } \
        else { dst0[i_] = (unsigned)(RA[i_] * g.lda + CA[i_]) * 2u; dst1[i_] = dst0[i_] + (unsigned)hstepA; } } } while (0)
    const unsigned ldsw = (unsigned)wid * 1024u;
    const int aoff = lds_byte(wr * 64 + fr, fq * 8), boff = lds_byte(wc * 32 + fr, fq * 8);
#define PG8_SA(b, h) (((b) * 2 + (h)) * HTB)
#define PG8_SB(b, h) ((4 + (b) * 2 + (h)) * HTB)
#define PG8_STAGE(bufoff, gbase, voff) do { _Pragma("unroll") for (int _i = 0; _i < 2; ++_i) \
        __builtin_amdgcn_global_load_lds((const unsigned*)((const char*)(gbase) + (voff)[_i]), (LAS unsigned*)(lds + (bufoff) + ldsw + _i * 8192), 16, 0, 0); } while (0)
#define PG8_LDA(dst, b, h) do { _Pragma("unroll") for (int m = 0; m < 4; ++m) _Pragma("unroll") for (int k = 0; k < 2; ++k) dst[m][k] = *(const LAS bf16x8*)(lds + PG8_SA(b, h) + aoff + m * 2048 + k * 1024); } while (0)
#define PG8_LDB(dst, b, h) do { _Pragma("unroll") for (int n = 0; n < 2; ++n) _Pragma("unroll") for (int k = 0; k < 2; ++k) dst[n][k] = *(const LAS bf16x8*)(lds + PG8_SB(b, h) + boff + n * 2048 + k * 1024); } while (0)
#define PG8_MMA(ai, bj, At, Bt) do { __builtin_amdgcn_s_setprio(1); _Pragma("unroll") for (int m = 0; m < 4; ++m) _Pragma("unroll") for (int n = 0; n < 2; ++n) _Pragma("unroll") for (int k = 0; k < 2; ++k) \
        acc[ai][bj][m][n] = __builtin_amdgcn_mfma_f32_16x16x32_bf16(Bt[n][k], At[m][k], acc[ai][bj][m][n], 0, 0, 0); __builtin_amdgcn_s_setprio(0); } while (0)
#define PG8_WAIT_V(n) asm volatile("s_waitcnt vmcnt(" #n ")" ::: "memory")
#define PG8_WAIT_L(n) asm volatile("s_waitcnt lgkmcnt(" #n ")" ::: "memory")
#define PG8_BAR __builtin_amdgcn_s_barrier()
#define PG8_SCHED __builtin_amdgcn_sched_barrier(0)
    Unit cur, nxt; int ui = 0;
    if (!S.next(0, cur)) return;
    PG8_GOFF(vc0, vc1, 0);
#pragma unroll
    for (int i = 0; i < 2; ++i) { vn0[i] = vc0[i]; vn1[i] = vc1[i]; }
    f32x4 acc[2][2][4][2];
#pragma unroll
    for (int a = 0; a < 2; ++a)
#pragma unroll
        for (int b = 0; b < 2; ++b)
#pragma unroll
            for (int m = 0; m < 4; ++m)
#pragma unroll
                for (int n = 0; n < 2; ++n) acc[a][b][m][n] = (f32x4){0.f, 0.f, 0.f, 0.f};
    bf16x8 At[4][2], B0[2][2], B1[2][2];
    const char* cA = (const char*)g.A + (size_t)cur.pm * tstepA; const char* cB = (const char*)g.Bt + (size_t)cur.pn * tstepB;
    S.a_ready(cur);
    if constexpr (SP2) {
        PG8_STAGE(PG8_SB(0, 0), cB, voffB); PG8_STAGE(PG8_SB(0, 1), cB + hstepB, voffB); PG8_STAGE(PG8_SA(0, 0), cA, vc0); PG8_STAGE(PG8_SA(0, 1), cA, vc1);
        if (wr == 1) PG8_BAR;
        PG8_WAIT_V(2); PG8_BAR;
        PG8_STAGE(PG8_SB(1, 0), cB + kstep, voffB); PG8_STAGE(PG8_SA(1, 0), cA + kstep, vc0); PG8_STAGE(PG8_SB(1, 1), cB + hstepB + kstep, voffB);
        PG8_WAIT_V(6); PG8_BAR;
    } else {
        PG8_STAGE(PG8_SB(0, 0), cB, voffB); PG8_STAGE(PG8_SA(0, 0), cA, vc0); PG8_STAGE(PG8_SB(0, 1), cB + hstepB, voffB); PG8_STAGE(PG8_SA(0, 1), cA, vc1);
        if (wr == 1) PG8_BAR;
        PG8_WAIT_V(4); PG8_BAR;
        PG8_STAGE(PG8_SB(1, 0), cB + kstep, voffB); PG8_STAGE(PG8_SA(1, 0), cA + kstep, vc0); PG8_STAGE(PG8_SB(1, 1), cB + hstepB + kstep, voffB);
        PG8_WAIT_V(6); PG8_BAR;
    }
    for (;;) {
        const bool has_next = S.next(ui + 1, nxt);
        if constexpr (GATHER) { if (has_next) { PG8_GOFF(vn0, vn1, ui + 1); } else {
#pragma unroll
            for (int i = 0; i < 2; ++i) { vn0[i] = vc0[i]; vn1[i] = vc1[i]; } } }
        const char* nA = has_next ? (const char*)g.A + (size_t)nxt.pm * tstepA : cA; const char* nB = has_next ? (const char*)g.Bt + (size_t)nxt.pn * tstepB : cB;
#pragma unroll 1
        for (int t = 0; t < nt; t += 2) {
            const bool last = (t == nt - 2);
            const char* a1 = cA + (size_t)(t + 1) * kstep;
            const char* a2 = last ? nA : cA + (size_t)(t + 2) * kstep; const char* b2 = last ? nB : cB + (size_t)(t + 2) * kstep;
            const char* a3 = a2 + kstep; const char* b3 = b2 + kstep;
            unsigned s0[2], s1[2];
#pragma unroll
            for (int i = 0; i < 2; ++i) { if constexpr (GATHER) { s0[i] = last ? vn0[i] : vc0[i]; s1[i] = last ? vn1[i] : vc1[i]; } else { s0[i] = vc0[i]; s1[i] = vc1[i]; } }
            if (last && has_next) S.a_ready(nxt);
            if constexpr (SP2) {
            PG8_LDB(B0, 0, 0); PG8_LDB(B1, 0, 1); PG8_SCHED; PG8_LDA(At, 0, 0); PG8_STAGE(PG8_SA(1, 1), a1, vc1);
            PG8_WAIT_V(8); PG8_WAIT_L(0); PG8_BAR; PG8_MMA(0, 0, At, B0); PG8_MMA(0, 1, At, B1); PG8_BAR; PG8_SCHED;
            PG8_LDA(At, 0, 1); PG8_STAGE(PG8_SB(0, 0), b2, voffB); PG8_STAGE(PG8_SB(0, 1), b2 + hstepB, voffB); PG8_STAGE(PG8_SA(0, 0), a2, s0);
            PG8_WAIT_V(8); PG8_WAIT_L(0); PG8_BAR; PG8_MMA(1, 0, At, B0); PG8_MMA(1, 1, At, B1); PG8_BAR; PG8_SCHED;
            PG8_LDB(B0, 1, 0); PG8_LDB(B1, 1, 1); PG8_SCHED; PG8_LDA(At, 1, 0); PG8_STAGE(PG8_SA(0, 1), a2, s1);
            PG8_WAIT_V(8); PG8_WAIT_L(0); PG8_BAR; PG8_MMA(0, 0, At, B0); PG8_MMA(0, 1, At, B1); PG8_BAR; PG8_SCHED;
            PG8_LDA(At, 1, 1); PG8_STAGE(PG8_SB(1, 0), b3, voffB); PG8_STAGE(PG8_SB(1, 1), b3 + hstepB, voffB); PG8_STAGE(PG8_SA(1, 0), a3, s0);
            PG8_WAIT_V(8); PG8_WAIT_L(0); PG8_BAR; PG8_MMA(1, 0, At, B0); PG8_MMA(1, 1, At, B1); PG8_BAR; PG8_SCHED;
            } else {
            PG8_LDB(B0, 0, 0); PG8_SCHED; PG8_LDA(At, 0, 0); PG8_STAGE(PG8_SA(1, 1), a1, vc1);
            PG8_WAIT_L(8); PG8_BAR; PG8_WAIT_L(0); PG8_MMA(0, 0, At, B0); PG8_BAR; PG8_SCHED;
            PG8_LDB(B1, 0, 1); PG8_STAGE(PG8_SB(0, 0), b2, voffB);
            PG8_BAR; PG8_WAIT_L(0); PG8_MMA(0, 1, At, B1); PG8_BAR;
            PG8_LDA(At, 0, 1); PG8_STAGE(PG8_SA(0, 0), a2, s0);
            PG8_BAR; PG8_WAIT_L(0); PG8_MMA(1, 0, At, B0); PG8_BAR; PG8_SCHED;
            PG8_STAGE(PG8_SB(0, 1), b2 + hstepB, voffB);
            PG8_WAIT_V(6); PG8_BAR; PG8_MMA(1, 1, At, B1); PG8_BAR;
            PG8_LDB(B0, 1, 0); PG8_SCHED; PG8_LDA(At, 1, 0); PG8_STAGE(PG8_SA(0, 1), a2, s1);
            PG8_WAIT_L(8); PG8_BAR; PG8_WAIT_L(0); PG8_MMA(0, 0, At, B0); PG8_BAR; PG8_SCHED;
            PG8_LDB(B1, 1, 1); PG8_STAGE(PG8_SB(1, 0), b3, voffB);
            PG8_BAR; PG8_WAIT_L(0); PG8_MMA(0, 1, At, B1); PG8_BAR;
            PG8_LDA(At, 1, 1); PG8_STAGE(PG8_SA(1, 0), a3, s0);
            PG8_BAR; PG8_WAIT_L(0); PG8_MMA(1, 0, At, B0); PG8_BAR; PG8_SCHED;
            PG8_STAGE(PG8_SB(1, 1), b3 + hstepB, voffB);
            PG8_WAIT_V(6); PG8_BAR; PG8_MMA(1, 1, At, B1); PG8_BAR;
            }
        }
        if constexpr (ALIGN_EPI) { if (wr == 0) PG8_BAR; }
        {
            int ln_e; asm volatile("v_mbcnt_lo_u32_b32 %0, -1, 0\n\tv_mbcnt_hi_u32_b32 %0, -1, %0" : "=v"(ln_e));
            const int fr_e = ln_e & 15, fq_e = ln_e >> 4;
            int pm_e = __builtin_amdgcn_readfirstlane(cur.pm), pn_e = __builtin_amdgcn_readfirstlane(cur.pn), wr_e = __builtin_amdgcn_readfirstlane(wr), wc_e = __builtin_amdgcn_readfirstlane(wc); asm volatile("" : "+s"(pm_e), "+s"(pn_e), "+s"(wr_e), "+s"(wc_e));
#pragma unroll
            for (int ai = 0; ai < 2; ++ai)
#pragma unroll
                for (int m = 0; m < 4; ++m) {
                    if constexpr (epi_pair<Epi>::value) E.tile64(pm_e * BM + ai * HALF + wr_e * 64 + m * 16 + fr_e, pn_e, wc_e, fq_e, acc[ai][0][m][0], acc[ai][0][m][1], acc[ai][1][m][0], acc[ai][1][m][1]);
                    else {
#pragma unroll
                    for (int bj = 0; bj < 2; ++bj) {
                        if constexpr (epi_prep<Epi>::value) E.tile32u(pm_e * BM + ai * HALF + wr_e * 64 + m * 16 + fr_e, pn_e * BM + bj * HALF + wc_e * 32, fq_e, acc[ai][bj][m][0], acc[ai][bj][m][1], ui);
                        else E.tile32(pm_e * BM + ai * HALF + wr_e * 64 + m * 16 + fr_e, pn_e * BM + bj * HALF + wc_e * 32, fq_e, acc[ai][bj][m][0], acc[ai][bj][m][1]); }
                    }
                    asm volatile("" ::: "memory");
                }
            S.done(cur);
        }
        if (!has_next) break;
#pragma unroll
        for (int a = 0; a < 2; ++a)
#pragma unroll
            for (int b = 0; b < 2; ++b)
#pragma unroll
                for (int m = 0; m < 4; ++m)
#pragma unroll
                    for (int n = 0; n < 2; ++n) acc[a][b][m][n] = (f32x4){0.f, 0.f, 0.f, 0.f};
        cur = nxt; cA = nA; cB = nB; ++ui;
        if constexpr (GATHER) {
#pragma unroll
            for (int i = 0; i < 2; ++i) { vc0[i] = vn0[i]; vc1[i] = vn1[i]; } }
        if constexpr (ALIGN_EPI) { if (wr == 1) PG8_BAR; }
    }
    PG8_WAIT_V(0);
    if constexpr (!ALIGN_EPI) { if (wr == 0) PG8_BAR; }
    PG8_BAR;
#undef PG8_GOFF
#undef PG8_SA
#undef PG8_SB
#undef PG8_STAGE
#undef PG8_LDA
#undef PG8_LDB
#undef PG8_MMA
#undef PG8_WAIT_V
#undef PG8_WAIT_L
#undef PG8_BAR
#undef PG8_SCHED
}

#ifndef REP_GEMM_MASK
#define REP_GEMM_MASK 0
#endif
template <int ID, class Sched, class Epi>
__device__ __forceinline__ void gemm_phase_gather(const Ctx& F, const Gemm g, const Sched& S, const Epi& E, const LAS int* gtab) {
    gemm_mfma<Epi, Sched, true, true, true>(F.lds, F.tid, g, S, E, gtab);
    if constexpr ((REP_GEMM_MASK >> ID) & 1) gemm_mfma<Epi, Sched, true, true, true>(F.lds, F.tid, g, S, E, gtab);
}
template <int ID, class Sched, class Epi>
__device__ __forceinline__ void gemm_phase(const Ctx& F, const Gemm g, const Sched& S, const Epi& E) {
#if USE_MFMA_GEMM
    gemm_mfma<Epi, Sched, true, true>(F.lds, F.tid, g, S, E);
    if constexpr ((REP_GEMM_MASK >> ID) & 1) gemm_mfma<Epi, Sched, true, true>(F.lds, F.tid, g, S, E);
#else
    gemm_naive(F, g, S, E);
#endif
}

template <class ColPtr>
__device__ __forceinline__ void tconv_tile(const ColPtr& cp, int ldw, const float* scale, bf16_t* WT, int K, int k0, int p0, LAS float* scr, int lane) {
    const int pc = (lane & 15) * 4, kq = lane >> 4;
    const float* src = cp(p0 + pc);
#pragma unroll 4
    for (int i = 0; i < 16; ++i) {
        const int kk = 4 * i + kq;
        f32x4 v = {0.f, 0.f, 0.f, 0.f};
        if (src) { v = __builtin_nontemporal_load((const f32x4*)(src + (size_t)(k0 + kk) * ldw)); if (scale) v = v * scale[k0 + kk]; }
        LAS float* d = scr + kk * 65 + pc; d[0] = v[0]; d[1] = v[1]; d[2] = v[2]; d[3] = v[3];
    }
    LDS_WAIT();
    const int c = lane & 7;
#pragma unroll
    for (int j = 0; j < 8; ++j) {
        const int n = (lane >> 3) + 8 * j; const LAS float* s = scr + (8 * c) * 65 + n;
        u32x4 o; o.x = pk2(s[0], s[65]); o.y = pk2(s[2 * 65], s[3 * 65]); o.z = pk2(s[4 * 65], s[5 * 65]); o.w = pk2(s[6 * 65], s[7 * 65]);
        *(u32x4*)(WT + (size_t)(p0 + n) * K + k0 + 8 * c) = o;
    }
    LDS_WAIT();
}
struct CpPlain { const float* W; int ncols; __device__ __forceinline__ const float* operator()(int p) const { return p < ncols ? W + p : nullptr; } };
struct CpIn {
    const float* W;
    __device__ __forceinline__ const float* operator()(int p) const {
        if (p < 672) return W + p;
        if (p < 768) return nullptr;
        const int w = p & 31;
        if (p < 1280) { const int q = p - 768, t = q >> 8, g = (q & 255) >> 5; return W + 672 + 64 * (4 * t + (g & 3)) + 32 * (g >> 2) + w; }
        const int g = (p - 1280) >> 5, half = g >> 2, slot = g & 3;
        return W + ((slot < 2) ? (1184 + 64 * slot) : (1312 + 64 * (slot - 2))) + 32 * half + w;
    }
};
#if FUSE_SPLIT
typedef CpIn CpInSel;
#else
struct CpInSel { const float* W; __device__ __forceinline__ const float* operator()(int p) const { return p < 1440 ? W + p : nullptr; } };
#endif
struct CpQ {
    const float* W;
    __device__ __forceinline__ const float* operator()(int p) const {
        const int h = p / 96, pp = p - h * 96; int lc = pp;
        if (pp >= 64) { const int rp = pp - 64, q = rp >> 3, r = rp & 7, i = 4 * q + (r & 3); lc = 64 + (i >> 3) * 16 + (i & 7) + ((r >> 2) ? 8 : 0); }
        return W + h * 96 + lc;
    }
};
struct CpGU {
    const float* Wg; const float* Wu;
    __device__ __forceinline__ const float* operator()(int p) const { const int g = (p >> 5) & 7, ff = 128 * (p >> 8) + 32 * (g & 3) + (p & 31); return (g < 4) ? (Wg + ff) : (Wu + ff); }
};

constexpr int CONV_ITEMS = NEXP * 256 + NEXP * 128, CONV_CH = 4, CONV_CTR0 = 8192;
struct ConvSrc { const float* p; size_t ld; bf16_t* dst; int K; };
__device__ __forceinline__ ConvSrc conv_decode(const Args& a, int l, int idx, int lane) {
    const int pc = (lane & 15) * 4, kh = lane >> 4; ConvSrc r;
    if (idx < NEXP * 256) { const int e = idx >> 8, q = idx & 255, k0 = (q >> 4) * 64, p = (q & 15) * 64 + pc, g = (p >> 5) & 7, ff = 128 * (p >> 8) + 32 * (g & 3) + (p & 31); const size_t le = (size_t)l * NEXP + e;
        r.p = ((g < 4) ? (a.w_gate + le * D * FF + ff) : (a.w_up + le * D * FF + ff)) + (size_t)(k0 + 16 * kh) * FF; r.ld = FF;
        r.dst = (bf16_t*)(a.ws + WS_WGU) + le * 1024 * D + (size_t)((q & 15) * 64 + pc) * D + k0 + 16 * kh; r.K = D; }
    else { const int i2 = idx - NEXP * 256, e = i2 >> 7, q = i2 & 127, k0 = (q >> 4) * 64, p0 = (q & 15) * 64; const size_t le = (size_t)l * NEXP + e;
        r.p = a.w_down + le * FF * D + (size_t)(k0 + 16 * kh) * D + p0 + pc; r.ld = D;
        r.dst = (bf16_t*)(a.ws + WS_WD) + le * D * FF + (size_t)(p0 + pc) * FF + k0 + 16 * kh; r.K = FF; }
    return r;
}
__device__ __forceinline__ void conv_load(const ConvSrc& c, f32x4 (&v)[16]) {
#pragma unroll
    for (int i = 0; i < 16; ++i) v[i] = __builtin_nontemporal_load((const f32x4*)(c.p + (size_t)i * c.ld));
}
__device__ __forceinline__ void conv_store(const ConvSrc& c, const f32x4 (&v)[16]) {
#pragma unroll
    for (int nn = 0; nn < 4; ++nn) {
        u32x4 o0, o1;
        o0.x = pk2(v[0][nn], v[1][nn]); o0.y = pk2(v[2][nn], v[3][nn]); o0.z = pk2(v[4][nn], v[5][nn]); o0.w = pk2(v[6][nn], v[7][nn]);
        o1.x = pk2(v[8][nn], v[9][nn]); o1.y = pk2(v[10][nn], v[11][nn]); o1.z = pk2(v[12][nn], v[13][nn]); o1.w = pk2(v[14][nn], v[15][nn]);
        *(u32x4*)(c.dst + (size_t)nn * c.K) = o0; *(u32x4*)(c.dst + (size_t)nn * c.K + 8) = o1;
    }
}
__device__ __forceinline__ void conv_experts(const int lane, const int wave, const int vcu, const Args& a, int l) {
    const int base = (vcu * NWAVES + wave) * (CONV_ITEMS / (GRID * NWAVES));
    static_assert(CONV_ITEMS % (GRID * NWAVES) == 0 && CONV_ITEMS / (GRID * NWAVES) == 6, "6 tiles per wave");
    f32x4 va[16], vb[16], vc[16];
    ConvSrc c0 = conv_decode(a, l, base, lane), c1 = conv_decode(a, l, base + 1, lane), c2 = conv_decode(a, l, base + 2, lane);
    ConvSrc c3 = conv_decode(a, l, base + 3, lane), c4 = conv_decode(a, l, base + 4, lane), c5 = conv_decode(a, l, base + 5, lane);
    conv_load(c0, va); conv_load(c1, vb); conv_load(c2, vc);
    conv_store(c0, va); conv_load(c3, va);
    conv_store(c1, vb); conv_load(c4, vb);
    conv_store(c2, vc); conv_load(c5, vc);
    conv_store(c3, va); conv_store(c4, vb); conv_store(c5, vc);
}
__device__ __forceinline__ void prologue1(const Ctx& F, KP kp) {
    const Args a = ldargs(kp);
    unsigned char* ws = a.ws;
    {
        LAS float* sl = (LAS float*)F.lds;
        float* modp = (float*)(ws + WS_MODP);
        for (int it = F.bk; it < NL * 12 * 4; it += GRID) {
            const int kc = it & 3, nc = (it >> 2) % 12, l = it / 48;
            __syncthreads();
            for (int idx = F.tid; idx < 17 * 256; idx += NTHREADS) {
                const int bb = idx >> 8, k = idx & 255; const float v = (bb < 16) ? a.c[bb * D + kc * 256 + k] : a.c_ctx[kc * 256 + k];
                sl[idx] = v / (1.0f + __expf(-v));
            }
            __syncthreads();
            const int n = nc * 512 + F.tid;
            const float* w = a.w_ada + ((size_t)l * D + kc * 256) * 6144 + n;
            float acc[17];
#pragma unroll
            for (int bb = 0; bb < 17; ++bb) acc[bb] = 0.f;
            for (int k = 0; k < 256; ++k) {
                const float wv = __builtin_nontemporal_load(w + (size_t)k * 6144);
#pragma unroll
                for (int bb = 0; bb < 17; ++bb) acc[bb] += sl[bb * 256 + k] * wv;
            }
#pragma unroll
            for (int bb = 0; bb < 17; ++bb) modp[((size_t)(kc * NL + l) * 17 + bb) * 6144 + n] = acc[bb];
        }
        __syncthreads();
    }
    {
        f32x2* t64 = (f32x2*)(ws + WS_TAB64); f32x2* t32 = (f32x2*)(ws + WS_TAB32);
        const int gt = F.bk * NTHREADS + F.tid;
        if (gt < 64 * 16) { const int pos = gt >> 4, f = gt & 15; const float inv = powf(10000.0f, -((float)(2 * f) / 32.0f)); const float ang = (float)pos * inv; t64[gt] = (f32x2){cosf(ang), sinf(ang)}; }
        else if (gt < 64 * 16 + 64 * 8) { const int g2 = gt - 64 * 16, pos = g2 >> 3, f = g2 & 7; const float inv = powf(10000.0f, -((float)(2 * f) / 16.0f)); const float ang = (float)pos * inv; t32[g2] = (f32x2){cosf(ang), sinf(ang)}; }
    }
    {
        bf16_t* wr = (bf16_t*)(ws + WS_WR);
        for (int i = F.bk * NTHREADS + F.tid; i < NL * 48 * D; i += GRID * NTHREADS) {
            const int c = i & 1023, j = (i >> 10) % 48, l = i / (48 * D);
            float wv = 0.f;
            if (j < 4) wv = a.w_rg[((size_t)l * D + c) * 4 + j]; else if (j < 36) wv = a.w_re[((size_t)l * D + c) * 32 + (j - 4)];
            const unsigned h = f2bf(wv); const float rem = wv - __builtin_bit_cast(float, h << 16);
            wr[((size_t)(l * 2 + 0) * 48 + j) * D + c] = (bf16_t)h; wr[((size_t)(l * 2 + 1) * 48 + j) * D + c] = (bf16_t)f2bf(rem);
        }
    }
    {
        LAS float* scr = (LAS float*)(F.lds + F.wave * 18432);
        const int gw = F.vcu * NWAVES + F.wave, NGW = GRID * NWAVES;
        constexpr int I_IN = 16 * 24, I_Q = 6 * 12, I_KV = 4 * 16, I_O = 16 * 16, I_GU = 16 * 16, I_D = 8 * 16;
        constexpr int N_SMALL = NL * (I_IN + I_Q + I_KV + I_O), N_GU = NL * NEXP * I_GU, N_D = NL * NEXP * I_D;
        for (int it = gw; it < N_SMALL; it += NGW) {
            {
                const int l = it / (I_IN + I_Q + I_KV + I_O); int r = it % (I_IN + I_Q + I_KV + I_O);
                if (r < I_IN) { const int kt = r / 24, pt = r % 24; tconv_tile(CpInSel{a.w_in + (size_t)l * D * 1440}, 1440, nullptr, (bf16_t*)(ws + WS_WIN) + (size_t)l * ZW * D, D, kt * 64, pt * 64, scr, F.lane); continue; }
                r -= I_IN;
                if (r < I_Q) { const int kt = r / 12, pt = r % 12; tconv_tile(CpQ{a.w_q_b + (size_t)l * 384 * QW}, QW, a.g_q_a + l * 384, (bf16_t*)(ws + WS_WQ) + (size_t)l * QW * 384, 384, kt * 64, pt * 64, scr, F.lane); continue; }
                r -= I_Q;
                if (r < I_KV) { const int kt = r / 16, pt = r % 16; tconv_tile(CpPlain{a.w_kv_b + (size_t)l * 256 * KVW, KVW}, KVW, a.g_kv_a + l * 256, (bf16_t*)(ws + WS_WKV) + (size_t)l * KVW * 256, 256, kt * 64, pt * 64, scr, F.lane); continue; }
                r -= I_KV;
                { const int kt = r / 16, pt = r % 16; tconv_tile(CpPlain{a.w_o + (size_t)l * D * D, D}, D, nullptr, (bf16_t*)(ws + WS_WO) + (size_t)l * D * D, D, kt * 64, pt * 64, scr, F.lane); }
            }
        }
    }
}

__device__ __forceinline__ void prologue2(const Ctx& F, KP kp) {
    const Args a = ldargs(kp);
    const float* modp = (const float*)(a.ws + WS_MODP); float* mod = (float*)(a.ws + WS_MOD);
    constexpr int NE = NL * 17 * 6144 / 4;
    for (int i = F.bk * NTHREADS + F.tid; i < NE; i += GRID * NTHREADS) {
        const int e = i * 4, l = e / (17 * 6144), n = e % 6144;
        f32x4 s = *(const f32x4*)(a.b_ada + l * 6144 + n);
#pragma unroll
        for (int kc = 0; kc < 4; ++kc) s = s + *(const f32x4*)(modp + (size_t)kc * NL * 17 * 6144 + e);
        *(f32x4*)(mod + e) = s;
    }
}

__device__ __forceinline__ void row_load(const float* p, int lane, f32x4 (&v)[4]) {
#pragma unroll
    for (int j = 0; j < 4; ++j) v[j] = *(const f32x4*)(p + 4 * lane + 256 * j);
}
__device__ __forceinline__ void row_ln(f32x4 (&v)[4], const float* g, const float* b, int lane) {
    float s = 0.f;
#pragma unroll
    for (int j = 0; j < 4; ++j) s += (v[j][0] + v[j][1]) + (v[j][2] + v[j][3]);
    const float mean = wave_sum(s) * (1.0f / D); float q = 0.f;
#pragma unroll
    for (int j = 0; j < 4; ++j) { v[j] = v[j] - mean; q += (v[j][0] * v[j][0] + v[j][1] * v[j][1]) + (v[j][2] * v[j][2] + v[j][3] * v[j][3]); }
    const float rstd = 1.0f / sqrtf(wave_sum(q) * (1.0f / D) + LN_EPS);
#pragma unroll
    for (int j = 0; j < 4; ++j) { const f32x4 gg = *(const f32x4*)(g + 4 * lane + 256 * j), bv = *(const f32x4*)(b + 4 * lane + 256 * j); v[j] = v[j] * rstd * gg + bv; }
}
__device__ __forceinline__ void row_ln_reg(f32x4 (&v)[4], const f32x4 (&g)[4], const f32x4 (&b)[4]) {
    float s = 0.f;
#pragma unroll
    for (int j = 0; j < 4; ++j) s += (v[j][0] + v[j][1]) + (v[j][2] + v[j][3]);
    const float mean = wave_sum(s) * (1.0f / D); float q = 0.f;
#pragma unroll
    for (int j = 0; j < 4; ++j) { v[j] = v[j] - mean; q += (v[j][0] * v[j][0] + v[j][1] * v[j][1]) + (v[j][2] * v[j][2] + v[j][3] * v[j][3]); }
    const float rstd = 1.0f / sqrtf(wave_sum(q) * (1.0f / D) + LN_EPS);
#pragma unroll
    for (int j = 0; j < 4; ++j) v[j] = v[j] * rstd * g[j] + b[j];
}
__device__ __forceinline__ void row_store_mod_bf16(bf16_t* hrow, const f32x4 (&v)[4], const float* sh, const float* sc, int lane) {
#pragma unroll
    for (int j = 0; j < 4; ++j) {
        const f32x4 s1 = *(const f32x4*)(sc + 4 * lane + 256 * j), s0 = *(const f32x4*)(sh + 4 * lane + 256 * j);
        const f32x4 h = v[j] * (s1 + 1.0f) + s0;
        st_bf4(hrow + 4 * lane + 256 * j, h);
    }
}

__device__ __forceinline__ void prologue3(const Ctx& F, KP kp) {
    const Args a = ldargs(kp);
    const float* modp = (const float*)(a.ws + WS_MODP); bf16_t* H = (bf16_t*)(a.ws + WS_H);
    const int gw = F.vcu * NWAVES + F.wave, NGW = GRID * NWAVES;
    for (int r = gw; r < MT; r += NGW) {
        const float* xr = (r < TL) ? (a.x + (size_t)r * D) : (a.ctx + (size_t)(r - TL) * D);
        const int bb = bb_of(r);
        f32x4 v[4]; row_load(xr, F.lane, v);
#pragma unroll
        for (int j = 0; j < 4; ++j) {
            const int c = 4 * F.lane + 256 * j;
            f32x4 sh = *(const f32x4*)(a.b_ada + c), sc = *(const f32x4*)(a.b_ada + 1024 + c);
#pragma unroll
            for (int kc = 0; kc < 4; ++kc) { const float* mp = modp + ((size_t)(kc * NL + 0) * 17 + bb) * 6144; sh = sh + *(const f32x4*)(mp + c); sc = sc + *(const f32x4*)(mp + 1024 + c); }
            st_bf4(H + (size_t)r * D + c, v[j] * (sc + 1.0f) + sh);
        }
    }
}

__device__ __forceinline__ void unpack8(const u32x4 w, float (&v)[8]) { v[0] = bflo(w.x); v[1] = bfhi(w.x); v[2] = bflo(w.y); v[3] = bfhi(w.y); v[4] = bflo(w.z); v[5] = bfhi(w.z); v[6] = bflo(w.w); v[7] = bfhi(w.w); }
__device__ __forceinline__ u32x4 pack8(const float (&v)[8]) { u32x4 w; w.x = pk2(v[0], v[1]); w.y = pk2(v[2], v[3]); w.z = pk2(v[4], v[5]); w.w = pk2(v[6], v[7]); return w; }
__device__ __forceinline__ u32x4 head64_norm_rope(const u32x4 raw, const float (&g)[8], const LAS f32x2* t64, bool lat, int gr, int gc, int w8, float scale) {
    float v[8]; unpack8(raw, v);
    float ss = 0.f;
#pragma unroll
    for (int e = 0; e < 8; ++e) ss += v[e] * v[e];
    ss += lane_xor<1>(ss); ss += lane_xor<2>(ss); ss += lane_xor<4>(ss);
    const float rn = 1.0f / sqrtf(ss * (1.0f / 64.0f) + RMS_EPS);
    float y[8], p[8], o[8];
#pragma unroll
    for (int e = 0; e < 8; ++e) { y[e] = v[e] * rn * g[e]; p[e] = lane_xor<2>(y[e]); o[e] = y[e]; }
    if (lat) {
        const int pos = (w8 >> 2) ? gc : gr; const LAS f32x2* cs = t64 + pos * 16 + 8 * (w8 & 1); const bool x2 = (w8 & 2) != 0;
#pragma unroll
        for (int e = 0; e < 8; ++e) { const f32x2 c = cs[e]; o[e] = x2 ? (y[e] * c.x + p[e] * c.y) : (y[e] * c.x - p[e] * c.y); }
    }
#pragma unroll
    for (int e = 0; e < 8; ++e) o[e] *= scale;
    return pack8(o);
}
__device__ __forceinline__ void phase_split(const Ctx& F, KP kp, int l) {
    const Args a = ldargs(kp);
    unsigned char* ws = a.ws;
    const bf16_t* Z = (const bf16_t*)(ws + WS_Z);
    float* rstdq = (float*)(ws + WS_RSTDQ); float* rstdkv = (float*)(ws + WS_RSTDKV);
    bf16_t* Km = (bf16_t*)(ws + WS_KM); bf16_t* Qg = (bf16_t*)(ws + WS_QG); bf16_t* Kg = (bf16_t*)(ws + WS_KG); bf16_t* Vg = (bf16_t*)(ws + WS_VG);
    LAS f32x2* t64 = (LAS f32x2*)(F.lds + 65536); LAS f32x2* t32 = (LAS f32x2*)(F.lds + 65536 + 8192);
    __syncthreads();
    for (int i = F.tid; i < 64 * 16; i += NTHREADS) t64[i] = ((const f32x2*)(ws + WS_TAB64))[i];
    if (F.tid < 64 * 8) t32[F.tid] = ((const f32x2*)(ws + WS_TAB32))[F.tid];
    __syncthreads();
    const int lane = F.lane, gw = F.vcu * NWAVES + F.wave, NGW = GRID * NWAVES, w8 = lane & 7;
    float ggq[8], ggk[8];
#pragma unroll
    for (int e = 0; e < 8; ++e) { ggq[e] = a.g_gq[l * 64 + 8 * w8 + e]; ggk[e] = a.g_gk[l * 64 + 8 * w8 + e]; }
    const int offA2 = 8 * (64 + (lane & 15)), offB = 672 + 8 * lane;
    const int offC = (lane < 4) ? (640 + 8 * lane) : (lane >= 8 && lane < 24) ? (1184 + 8 * (lane - 8)) : (lane >= 24 && lane < 40) ? (1312 + 8 * (lane - 24)) : 0;
    u32x4 nA1, nA2, nB, nC;
#define P2_LOAD(rr) do { const bf16_t* zr_ = Z + (size_t)(rr) * ZW; nA1 = *(const u32x4*)(zr_ + 8 * lane); nA2 = *(const u32x4*)(zr_ + offA2); nB = *(const u32x4*)(zr_ + offB); nC = *(const u32x4*)(zr_ + offC); } while (0)
    if (gw < MT) P2_LOAD(gw);
    for (int r = gw; r < MT; r += NGW) {
        const u32x4 A1 = nA1, A2 = nA2, B = nB, C = nC;
        if (r + NGW < MT) P2_LOAD(r + NGW);
        const bool lat = r < TL; const int s = r & 2047, gr = s >> 6, gc = s & 63, kr = krow_of(r);
        { float v[8]; unpack8(A1, v); float s1 = 0.f;
#pragma unroll
          for (int e = 0; e < 8; ++e) s1 += v[e] * v[e];
          unpack8(A2, v); float s2 = 0.f;
#pragma unroll
          for (int e = 0; e < 8; ++e) s2 += v[e] * v[e];
          const float sq = wave_sum(lane < 48 ? s1 : 0.f), sk = wave_sum((lane >= 48 ? s1 : 0.f) + (lane < 16 ? s2 : 0.f));
          if (lane == 0) { rstdq[r] = 1.0f / sqrtf(sq * (1.0f / 384.0f) + RMS_EPS); rstdkv[r] = 1.0f / sqrtf(sk * (1.0f / 256.0f) + RMS_EPS); } }
        { const u32x4 o = head64_norm_rope(B, ggq, t64, lat, gr, gc, w8, QSCALE_G); *(u32x4*)(Qg + (size_t)r * 512 + 8 * lane) = o; }
        { const u32x4 o = head64_norm_rope(C, ggk, t64, lat, gr, gc, w8, 1.0f); if (lane >= 8 && lane < 24) *(u32x4*)(Kg + (size_t)kr * 128 + 8 * (lane - 8)) = o; }
        if (lane >= 24 && lane < 40) *(u32x4*)(Vg + (size_t)kr * 128 + 8 * (lane - 24)) = C;
        { float v[8], p[8], o[8]; unpack8(C, v);
#pragma unroll
          for (int e = 0; e < 8; ++e) { p[e] = lane_xor<1>(v[e]); o[e] = v[e]; }
          if (lat) { const int pos = ((lane >> 1) & 1) ? gc : gr; const LAS f32x2* cs = t32 + pos * 8; const bool x2 = (lane & 1) != 0;
#pragma unroll
              for (int e = 0; e < 8; ++e) { const f32x2 c = cs[e]; o[e] = x2 ? (v[e] * c.x + p[e] * c.y) : (v[e] * c.x - p[e] * c.y); } }
          const u32x4 ow = pack8(o);
          if (lane < 4) {
#pragma unroll
              for (int h = 0; h < 8; ++h) *(u32x4*)(Km + (size_t)kr * QW + h * 96 + 64 + 8 * lane) = ow; } }
    }
#undef P2_LOAD
}

typedef float f32x4m __attribute__((ext_vector_type(4)));
template <bool XF32>
__device__ __forceinline__ void phase_ln1_route(const Ctx& F, KP kp, int l, int ntok) {
    const Args a = ldargs(kp);
    unsigned char* ws = a.ws;
    const bf16_t* Yo = (const bf16_t*)(ws + WS_U); float* XC = (float*)(ws + WS_XC); bf16_t* H = (bf16_t*)(ws + WS_H);
    bf16_t* XB = (bf16_t*)(ws + WS_XB); constexpr bool xf32 = XF32;
    const float* mod = (const float*)(ws + WS_MOD) + (size_t)l * 17 * 6144;
    int* toke = (int*)(ws + WS_TOKE); int* tokr = (int*)(ws + WS_TOKR); float* tokw = (float*)(ws + WS_TOKW);
    volatile LAS int* cntl = (volatile LAS int*)(F.lds + MISC_CNT);
    const int lane = F.lane;
    __syncthreads();
    if (F.tid < 32) cntl[F.tid] = 0;
    if (F.tid < 36) ((LAS float*)(F.lds + MISC_LG + 2048))[F.tid] = (F.tid < 4) ? a.b_rg[l * 4 + F.tid] : a.b_re[l * 32 + F.tid - 4];
    const int tpb = ntok / GRID;
    {
        f32x4 nx[4]; u32x2 ny[4]; int i = F.wave;
        f32x4 LG[4], LB[4], GA[4], SH[4], SC[4]; int bbc = -1;
#pragma unroll
        for (int j = 0; j < 4; ++j) { LG[j] = *(const f32x4*)(a.ln1_g + l * D + 4 * lane + 256 * j); LB[j] = *(const f32x4*)(a.ln1_b + l * D + 4 * lane + 256 * j); }
        u32x2 nb[4];
#define P6_LOAD(tt) do { const int t_ = (tt); \
        if (xf32) { const float* xp_ = (t_ < TL) ? (a.x + (size_t)t_ * D) : (a.ctx + (size_t)(t_ - TL) * D); row_load(xp_, lane, nx); } \
        else { _Pragma("unroll") for (int j = 0; j < 4; ++j) nb[j] = __builtin_nontemporal_load((const u32x2*)(XB + (size_t)t_ * D + 4 * lane + 256 * j)); } \
        _Pragma("unroll") for (int j = 0; j < 4; ++j) ny[j] = __builtin_nontemporal_load((const u32x2*)(Yo + (size_t)t_ * D + 4 * lane + 256 * j)); } while (0)
        if (i < tpb) P6_LOAD(F.bk * tpb + i);
        for (; i < tpb; i += NWAVES) {
            const int t = F.bk * tpb + i, bb = bb_of(t);
            if (bb != bbc) {
                bbc = bb;
#pragma unroll
                for (int j = 0; j < 4; ++j) { const int c = 4 * lane + 256 * j; GA[j] = *(const f32x4*)(mod + (size_t)(bb * 6 + 2) * D + c);
                    SH[j] = *(const f32x4*)(mod + (size_t)(bb * 6 + 3) * D + c); SC[j] = *(const f32x4*)(mod + (size_t)(bb * 6 + 4) * D + c); }
            }
            f32x4 v[4];
#pragma unroll
            for (int j = 0; j < 4; ++j) { const f32x4 y = {bflo(ny[j].x), bfhi(ny[j].x), bflo(ny[j].y), bfhi(ny[j].y)};
                const f32x4 xv = xf32 ? nx[j] : (f32x4){bflo(nb[j].x), bfhi(nb[j].x), bflo(nb[j].y), bfhi(nb[j].y)}; v[j] = xv * ALPHA + GA[j] * y; }
            if (i + NWAVES < tpb) P6_LOAD(t + NWAVES);
            row_ln_reg(v, LG, LB);
#pragma unroll
            for (int j = 0; j < 4; ++j) st_bf4(XB + (size_t)t * D + 4 * lane + 256 * j, v[j]);
#pragma unroll
            for (int j = 0; j < 4; ++j) {
                const f32x4 h = v[j] * (SC[j] + 1.0f) + SH[j];
                st_bf4(H + (size_t)t * D + 4 * lane + 256 * j, h);
            }
        }
    }
#undef P6_LOAD
    asm volatile("s_waitcnt vmcnt(0)" ::: "memory");
    __syncthreads();
    {
        const bf16_t* wrh = (const bf16_t*)(ws + WS_WR) + (size_t)(l * 2) * 48 * D; const bf16_t* wrl = wrh + (size_t)48 * D;
        const LAS float* bias = (const LAS float*)(F.lds + MISC_LG + 2048);
        const int fr = lane & 15, fq = lane >> 4, w = F.wave;
        bf16x8 WH[4][3], WL[4][3];
#pragma unroll
        for (int ks = 0; ks < 4; ++ks)
#pragma unroll
            for (int tl = 0; tl < 3; ++tl) { const size_t o = (size_t)(16 * tl + fr) * D + 128 * w + 32 * ks + 8 * fq; WH[ks][tl] = *(const bf16x8*)(wrh + o); WL[ks][tl] = *(const bf16x8*)(wrl + o); }
        LAS float* part = (LAS float*)F.lds;
        LAS float* lgf = (LAS float*)(F.lds + 122880);
        const int ngrp = tpb / 16;
        for (int g0 = 0; g0 < ngrp; g0 += 5) {
            const int ng = (ngrp - g0 < 5) ? (ngrp - g0) : 5;
            bf16x8 hb[5][4];
#pragma unroll
            for (int gl = 0; gl < 5; ++gl) if (gl < ng) {
                const bf16_t* hh = H + (size_t)(F.bk * tpb + (g0 + gl) * 16 + fr) * D + 128 * w + 8 * fq;
#pragma unroll
                for (int ks = 0; ks < 4; ++ks) hb[gl][ks] = *(const bf16x8*)(hh + 32 * ks);
            }
#pragma unroll
            for (int gl = 0; gl < 5; ++gl) if (gl < ng) {
                f32x4m acc0 = {0.f, 0.f, 0.f, 0.f}, acc1 = acc0, acc2 = acc0;
#pragma unroll
                for (int ks = 0; ks < 4; ++ks) {
                    acc0 = __builtin_amdgcn_mfma_f32_16x16x32_bf16(WH[ks][0], hb[gl][ks], acc0, 0, 0, 0); acc1 = __builtin_amdgcn_mfma_f32_16x16x32_bf16(WH[ks][1], hb[gl][ks], acc1, 0, 0, 0); acc2 = __builtin_amdgcn_mfma_f32_16x16x32_bf16(WH[ks][2], hb[gl][ks], acc2, 0, 0, 0);
                    acc0 = __builtin_amdgcn_mfma_f32_16x16x32_bf16(WL[ks][0], hb[gl][ks], acc0, 0, 0, 0); acc1 = __builtin_amdgcn_mfma_f32_16x16x32_bf16(WL[ks][1], hb[gl][ks], acc1, 0, 0, 0); acc2 = __builtin_amdgcn_mfma_f32_16x16x32_bf16(WL[ks][2], hb[gl][ks], acc2, 0, 0, 0);
                }
                LAS float* pp = part + ((size_t)(w * 5 + gl) * 16 + fr) * 48 + 4 * fq;
                *(LAS f32x4m*)(pp) = acc0; *(LAS f32x4m*)(pp + 16) = acc1; *(LAS f32x4m*)(pp + 32) = acc2;
            }
            LDS_WAIT();
            __syncthreads();
            for (int o = F.tid; o < ng * 768; o += NTHREADS) {
                const int gl = o / 768, rem = o - gl * 768; float s = 0.f;
#pragma unroll
                for (int ww = 0; ww < 8; ++ww) s += part[(ww * 5 + gl) * 768 + rem];
                lgf[o] = s;
            }
            __syncthreads();
            if (F.tid < ng * 16) {
                const int t = F.bk * tpb + g0 * 16 + F.tid; const LAS float* q = lgf + F.tid * 48;
                float l4[4];
#pragma unroll
                for (int o = 0; o < 4; ++o) l4[o] = q[o] + bias[o];
                int gs = 0; float gm = l4[0];
#pragma unroll
                for (int o = 1; o < 4; ++o) if (l4[o] > gm) { gm = l4[o]; gs = o; }
                float den = 0.f;
#pragma unroll
                for (int o = 0; o < 4; ++o) den += expf(l4[o] - gm);
                const float pstar = 1.0f / den;
                float le[8];
#pragma unroll
                for (int o = 0; o < 8; ++o) le[o] = q[4 + gs * 8 + o] + bias[4 + gs * 8 + o];
                int i1 = 0; float v1 = le[0];
#pragma unroll
                for (int o = 1; o < 8; ++o) if (le[o] > v1) { v1 = le[o]; i1 = o; }
                int i2 = -1; float v2 = -3.0e38f;
#pragma unroll
                for (int o = 0; o < 8; ++o) if (o != i1 && le[o] > v2) { v2 = le[o]; i2 = o; }
                const float ex = expf(v2 - v1), w1 = pstar / (1.0f + ex), w2 = pstar * ex / (1.0f + ex);
                const int e1 = gs * 8 + i1, e2 = gs * 8 + i2;
                const int r1 = __hip_atomic_fetch_add((LAS int*)(F.lds + MISC_CNT) + e1, 1, __ATOMIC_RELAXED, __HIP_MEMORY_SCOPE_WORKGROUP);
                const int r2 = __hip_atomic_fetch_add((LAS int*)(F.lds + MISC_CNT) + e2, 1, __ATOMIC_RELAXED, __HIP_MEMORY_SCOPE_WORKGROUP);
                toke[2 * t] = e1; toke[2 * t + 1] = e2; tokr[2 * t] = r1; tokr[2 * t + 1] = r2; tokw[2 * t] = w1; tokw[2 * t + 1] = w2;
            }
            __syncthreads();
        }
    }
    __syncthreads();
    if (F.tid < 32) ((int*)(ws + WS_BLKCNT))[((size_t)l * 256 + F.bk) * 32 + F.tid] = cntl[F.tid];
}

__device__ __forceinline__ void moe_tables(const Ctx& F, KP kp, int l, bool publish) {
    const Args a = ldargs(kp);
    const int* blkcnt = (const int*)(a.ws + WS_BLKCNT) + (size_t)l * 256 * 32;
    volatile LAS int* pa = (volatile LAS int*)(F.lds + MISC_PA); volatile LAS int* pb = (volatile LAS int*)(F.lds + MISC_PB);
    volatile LAS int* tot = (volatile LAS int*)(F.lds + MISC_TOT); volatile LAS int* base = (volatile LAS int*)(F.lds + MISC_BASE); volatile LAS int* poff = (volatile LAS int*)(F.lds + MISC_POFF);
    __syncthreads();
    {
        const int e = F.tid & 31, part = F.tid >> 5; int sa = 0, sb = 0;
        for (int j = 0; j < 16; ++j) { const int b2 = part * 16 + j; const int c = blkcnt[b2 * 32 + e]; sa += c; sb += (b2 < F.bk) ? c : 0; }
        pa[part * 32 + e] = sa; pb[part * 32 + e] = sb;
    }
    __syncthreads();
    if (F.tid < 32) { int sa = 0, sb = 0; for (int p = 0; p < 16; ++p) { sa += pa[p * 32 + F.tid]; sb += pb[p * 32 + F.tid]; } tot[F.tid] = sa; base[F.tid] = sb; }
    __syncthreads();
    if (F.tid == 0) { int o = 0; for (int e = 0; e < 32; ++e) { poff[e] = o; o += (tot[e] + 255) & ~255; } poff[32] = o; }
    __syncthreads();
    if (publish && F.bk == 0 && F.tid < 33) ((int*)(a.ws + WS_MOETAB))[l * 128 + F.tid] = poff[F.tid];
}

__device__ __forceinline__ void phase_dispatch(const Ctx& F, KP kp, int l, int ntok) {
    const Args a = ldargs(kp);
    unsigned char* ws = a.ws;
    moe_tables(F, kp, l, true);
    volatile LAS int* base = (volatile LAS int*)(F.lds + MISC_BASE); volatile LAS int* poff = (volatile LAS int*)(F.lds + MISC_POFF); volatile LAS int* tot = (volatile LAS int*)(F.lds + MISC_TOT);
    const int* toke = (const int*)(ws + WS_TOKE); const int* tokr = (const int*)(ws + WS_TOKR); int* tokp = (int*)(ws + WS_TOKP); int* postok = (int*)(ws + WS_POSTOK);
    const int tpb = ntok / GRID;
    if (F.tid < tpb) {
        const int t = F.bk * tpb + F.tid;
        const int2 e = *(const int2*)(toke + 2 * t), r = *(const int2*)(tokr + 2 * t);
        const int p1 = poff[e.x] + base[e.x] + r.x, p2 = poff[e.y] + base[e.y] + r.y;
        *(int2*)(tokp + 2 * t) = (int2){p1, p2};
        postok[p1] = t; postok[p2] = t;
    }
    { const int idx = F.bk * NTHREADS + F.tid;
      if (idx < poff[32]) { int e = 0;
#pragma unroll
          for (int j = 1; j < 32; ++j) e += (poff[j] <= idx) ? 1 : 0;
          if (idx >= poff[e] + tot[e]) postok[idx] = 0; } }
}

__device__ __forceinline__ void phase_ln2(const Ctx& F, KP kp, int l, int ntok, bool dry = false) {
    const Args a = ldargs(kp);
    unsigned char* ws = a.ws;
    const bf16_t* Ys = (const bf16_t*)(ws + WS_XS); float* XC = (float*)(ws + WS_XC); bf16_t* H = (bf16_t*)(ws + WS_H);
    const float* mod = (const float*)(ws + WS_MOD) + (size_t)l * 17 * 6144;
    const float* modn = (const float*)(ws + WS_MOD) + (size_t)(l + 1 < NL ? l + 1 : l) * 17 * 6144;
    const int* tokp = (const int*)(ws + WS_TOKP); const float* tokw = (const float*)(ws + WS_TOKW);
    const int gw = F.vcu * NWAVES + F.wave, NGW = GRID * NWAVES, lane = F.lane;
    const int per = ntok / NGW, t0 = gw * per, t1 = t0 + per;
    f32x4 LG[4], LB[4], GF[4], SH[4], SC[4];
#pragma unroll
    for (int j = 0; j < 4; ++j) { LG[j] = *(const f32x4*)(a.ln2_g + l * D + 4 * lane + 256 * j); LB[j] = *(const f32x4*)(a.ln2_b + l * D + 4 * lane + 256 * j); }
    int bbc = -1;
    int2 pn = {0, 0}; float2 wn = {0.f, 0.f};
    u32x2 xn[4], yan[4], ybn[4]; bf16_t* XB = (bf16_t*)(ws + WS_XB);
#define P10_REC(tt) do { pn = *(const int2*)(tokp + 2 * (tt)); wn = *(const float2*)(tokw + 2 * (tt)); } while (0)
#define P10_ROWS(tt, p_) do { const int t_ = (tt); _Pragma("unroll") for (int j = 0; j < 4; ++j) xn[j] = __builtin_nontemporal_load((const u32x2*)(XB + (size_t)t_ * D + 4 * lane + 256 * j)); \
        _Pragma("unroll") for (int j = 0; j < 4; ++j) { yan[j] = __builtin_nontemporal_load((const u32x2*)(Ys + (size_t)(p_).x * D + 4 * lane + 256 * j)); ybn[j] = __builtin_nontemporal_load((const u32x2*)(Ys + (size_t)(p_).y * D + 4 * lane + 256 * j)); } } while (0)
    float2 wc = {0.f, 0.f};
    P10_REC(t0); wc = wn; P10_ROWS(t0, pn); if (t0 + 1 < t1) P10_REC(t0 + 1);
    for (int t = t0; t < t1; ++t) {
        const int bb = bb_of(t);
        if (bb != bbc) {
            bbc = bb;
#pragma unroll
            for (int j = 0; j < 4; ++j) { const int c = 4 * lane + 256 * j; GF[j] = *(const f32x4*)(mod + (size_t)(bb * 6 + 5) * D + c);
                SH[j] = *(const f32x4*)(modn + (size_t)(bb * 6 + 0) * D + c); SC[j] = *(const f32x4*)(modn + (size_t)(bb * 6 + 1) * D + c); }
        }
        f32x4 v[4]; u32x2 ya[4], yb[4];
#pragma unroll
        for (int j = 0; j < 4; ++j) { v[j] = (f32x4){bflo(xn[j].x), bfhi(xn[j].x), bflo(xn[j].y), bfhi(xn[j].y)}; ya[j] = yan[j]; yb[j] = ybn[j]; }
        const float w1 = wc.x, w2 = wc.y;
        if (t + 1 < t1) { wc = wn; P10_ROWS(t + 1, pn); if (t + 2 < t1) P10_REC(t + 2); }
#pragma unroll
        for (int j = 0; j < 4; ++j) {
            const f32x4 y = (f32x4){bflo(ya[j].x), bfhi(ya[j].x), bflo(ya[j].y), bfhi(ya[j].y)} * w1 + (f32x4){bflo(yb[j].x), bfhi(yb[j].x), bflo(yb[j].y), bfhi(yb[j].y)} * w2;
            v[j] = v[j] * ALPHA + GF[j] * y;
        }
        row_ln_reg(v, LG, LB);
        if (l + 1 < NL) {
#pragma unroll
            for (int j = 0; j < 4; ++j) st_bf4(XB + (size_t)t * D + 4 * lane + 256 * j, v[j]);
        } else {
#pragma unroll
            for (int j = 0; j < 4; ++j) *(f32x4*)(a.out + (size_t)t * D + 4 * lane + 256 * j) = v[j];
        }
        if (l + 1 < NL) { bf16_t* hrow = H + (size_t)t * D;
#pragma unroll
            for (int j = 0; j < 4; ++j) st_bf4(hrow + 4 * lane + 256 * j, v[j] * (SC[j] + 1.0f) + SH[j]); }
    }
#undef P10_REC
#undef P10_ROWS
}

template <int QD>
__device__ __forceinline__ void attn_naive_task(const bf16_t* qp, const bf16_t* kp, int kstride, const bf16_t* vp, int vstride, int nkeys, bf16_t* op) {
    u32x4 qv[QD / 8];
#pragma unroll
    for (int i = 0; i < QD / 8; ++i) qv[i] = *(const u32x4*)(qp + 8 * i);
#pragma unroll 1
    for (int half = 0; half < 2; ++half) {
        float o[32];
#pragma unroll
        for (int i = 0; i < 32; ++i) o[i] = 0.f;
        float m = -1.0e30f, lsum = 0.f;
#pragma unroll 1
        for (int j = 0; j < nkeys; ++j) {
            const u32x4* kr = (const u32x4*)(kp + (size_t)j * kstride);
            float s = 0.f;
#pragma unroll
            for (int i = 0; i < QD / 8; ++i) s = dot8(qv[i], kr[i], s);
            if (s > m) { const float al = __builtin_amdgcn_exp2f(m - s); lsum *= al;
#pragma unroll
                for (int i = 0; i < 32; ++i) o[i] *= al;
                m = s; }
            const float p = __builtin_amdgcn_exp2f(s - m); lsum += p;
            const u32x4* vr = (const u32x4*)(vp + (size_t)j * vstride + 32 * half);
#pragma unroll
            for (int i = 0; i < 4; ++i) { const u32x4 w = vr[i];
                o[8 * i + 0] += p * bflo(w.x); o[8 * i + 1] += p * bfhi(w.x); o[8 * i + 2] += p * bflo(w.y); o[8 * i + 3] += p * bfhi(w.y); o[8 * i + 4] += p * bflo(w.z); o[8 * i + 5] += p * bfhi(w.z); o[8 * i + 6] += p * bflo(w.w); o[8 * i + 7] += p * bfhi(w.w); }
        }
        const float rl = 1.0f / lsum;
#pragma unroll
        for (int i = 0; i < 4; ++i) { u32x4 w; w.x = pk2(o[8 * i] * rl, o[8 * i + 1] * rl); w.y = pk2(o[8 * i + 2] * rl, o[8 * i + 3] * rl); w.z = pk2(o[8 * i + 4] * rl, o[8 * i + 5] * rl); w.w = pk2(o[8 * i + 6] * rl, o[8 * i + 7] * rl); *(u32x4*)(op + 32 * half + 8 * i) = w; }
    }
}
__device__ __forceinline__ void phase_attn_naive(const Ctx& F, KP kp, bool last) {
    const Args a = ldargs(kp);
    unsigned char* ws = a.ws;
    const bf16_t* Qm = (const bf16_t*)(ws + WS_QM); const bf16_t* Km = (const bf16_t*)(ws + WS_KM); const bf16_t* Vm = (const bf16_t*)(ws + WS_VM);
    const bf16_t* Qg = (const bf16_t*)(ws + WS_QG); const bf16_t* Kg = (const bf16_t*)(ws + WS_KG); const bf16_t* Vg = (const bf16_t*)(ws + WS_VG);
    bf16_t* O = (bf16_t*)(ws + WS_O);
    const int gw = F.vcu * NWAVES + F.wave, NGW = GRID * NWAVES;
    const int ntask = 8192 + (last ? 0 : 1024);
    for (int T = gw; T < ntask; T += NGW) {
        int b, h16, r, nkeys;
        if (T < 8192) { const int qw = T & 31; h16 = (T >> 5) & 15; b = T >> 9; r = b * SEQ + 64 * qw + F.lane; nkeys = KPB; }
        else { const int T2 = T - 8192, qw = T2 & 3; h16 = (T2 >> 2) & 15; b = T2 >> 6; r = TL + b * CTX + 64 * qw + F.lane; nkeys = CTX; }
        bf16_t* op = O + (size_t)r * D + h16 * 64;
        if (h16 < 8) attn_naive_task<96>(Qm + (size_t)r * QW + h16 * 96, Km + (size_t)b * KPB * QW + h16 * 96, QW, Vm + (size_t)b * KPB * 512 + h16 * 64, 512, nkeys, op);
        else { const int hh = h16 - 8, kvh = hh >> 2; attn_naive_task<64>(Qg + (size_t)r * 512 + hh * 64, Kg + (size_t)b * KPB * 128 + kvh * 64, 128, Vg + (size_t)b * KPB * 128 + kvh * 64, 128, nkeys, op); }
    }
}

typedef float f32x16 __attribute__((ext_vector_type(16)));
typedef short s16x4 __attribute__((ext_vector_type(4)));
__device__ __forceinline__ s16x4 vtr(const LAS unsigned char* p) { return __builtin_bit_cast(s16x4, __builtin_amdgcn_ds_read_tr16_b64_v4i16((LAS s16x4*)p)); }
__device__ __forceinline__ unsigned cvtpk(float lo, float hi) { typedef __bf16 bf2 __attribute__((ext_vector_type(2))); f32x2 v = {lo, hi}; bf2 b = __builtin_convertvector(v, bf2); return __builtin_bit_cast(unsigned, b); }
constexpr float ATT_THR = 6.0f;
constexpr int ATT_KSLOT = 12288, ATT_VSLOT = 8192, ATT_NKS = 3, ATT_NVS = 4, ATT_V0 = ATT_NKS * ATT_KSLOT;
__device__ __forceinline__ void att_glds16(const void* gsrc, unsigned lds_dst) { unsigned keep;
    asm volatile("s_mov_b32 %0, m0\n\ts_mov_b32 m0, %2\n\ts_nop 0\n\tglobal_load_lds_dwordx4 %1, off\n\ts_mov_b32 m0, %0" : "=&s"(keep) : "v"(gsrc), "s"(lds_dst) : "memory"); }
__device__ __forceinline__ void att_glds16s(const void* sbase, unsigned voff, unsigned lds_dst) { unsigned keep;
    asm volatile("s_mov_b32 %0, m0\n\ts_mov_b32 m0, %3\n\ts_nop 0\n\tglobal_load_lds_dwordx4 %1, %2\n\ts_mov_b32 m0, %0" : "=&s"(keep) : "v"(voff), "s"(sbase), "s"(lds_dst) : "memory"); }
#define ATT_WAITBAR(N) asm volatile("s_waitcnt vmcnt(" #N ") lgkmcnt(0)\n\ts_barrier" ::: "memory")
template <int QD>
__device__ __forceinline__ void attn_unit(LAS unsigned char* lds, int tid, const bf16_t* Kb, int kstride, const bf16_t* Vb, int vstride, int ntiles, const bf16_t* qrow, bf16_t* orow) {
    constexpr int NC = QD / 8, NS = QD / 16;
    const int lane = tid & 63, r32 = lane & 31, hi = lane >> 5;
    const int w = __builtin_amdgcn_readfirstlane(tid >> 6);
    const bool three = (NC == 12) && (w < 4);
    const int vp = (NC == 12) ? (w < 4 ? w + 4 : w - 4) : w;
    const bf16_t* ksrcA = Kb + w * 512 + lane * 8;
    const bf16_t* ksrcB = Kb + (w + 8) * 512 + lane * 8;
    const bf16_t* vsrc = Vb + vp * 512 + lane * 8;
    const size_t kstep = (size_t)64 * QD, vstep = (size_t)4096;
    const unsigned lds0 = (unsigned)(size_t)lds;
#define ATT_DMA(t_, ks_, vs_) do { \
        att_glds16(ksrcA + (size_t)(t_) * kstep, (unsigned)__builtin_amdgcn_readfirstlane((int)(lds0 + (ks_) * ATT_KSLOT + w * 1024))); \
        if (three) att_glds16(ksrcB + (size_t)(t_) * kstep, (unsigned)__builtin_amdgcn_readfirstlane((int)(lds0 + (ks_) * ATT_KSLOT + (w + 8) * 1024))); \
        att_glds16(vsrc + (size_t)(t_) * vstep, (unsigned)__builtin_amdgcn_readfirstlane((int)(lds0 + ATT_V0 + (vs_) * ATT_VSLOT + vp * 1024))); } while (0)
    ATT_DMA(0, 0, 0);
    if (ntiles > 1) ATT_DMA(1, 1, 1);
    bf16x8 qr[NS];
#pragma unroll
    for (int s = 0; s < NS; ++s) qr[s] = *(const bf16x8*)(qrow + 16 * s + 8 * hi);
    f32x16 o0, o1, negm, p0, p1;
#pragma unroll
    for (int r = 0; r < 16; ++r) { o0[r] = 0.f; o1[r] = 0.f; negm[r] = 0.f; p0[r] = 0.f; p1[r] = 0.f; }
    float lsum = 0.f;
    const int kread = hi * 1024 + r32 * 16;
    const int vread = ATT_V0 + ((lane >> 4) & 1) * 32 + (lane & 3) * 8 + (4 * hi + ((lane & 15) >> 2)) * 64;
#define ATT_QK(ks_) do { const LAS unsigned char* kb_ = lds + (ks_) * ATT_KSLOT + kread; \
        _Pragma("unroll") for (int s = 0; s < NS; ++s) { \
            const bf16x8 a0 = *(const LAS bf16x8*)(kb_ + s * 2048), a1 = *(const LAS bf16x8*)(kb_ + s * 2048 + 512); \
            if (s == 0) { p0 = __builtin_amdgcn_mfma_f32_32x32x16_bf16(a0, qr[0], negm, 0, 0, 0); p1 = __builtin_amdgcn_mfma_f32_32x32x16_bf16(a1, qr[0], negm, 0, 0, 0); } \
            else { p0 = __builtin_amdgcn_mfma_f32_32x32x16_bf16(a0, qr[s], p0, 0, 0, 0); p1 = __builtin_amdgcn_mfma_f32_32x32x16_bf16(a1, qr[s], p1, 0, 0, 0); } } } while (0)
#define ATT_SOFT_PV(first_, vs_) do { \
        float mx = fmaxf(fmaxf(p0[0], p1[0]), p0[1]); \
        _Pragma("unroll") for (int r = 1; r < 16; ++r) mx = (r == 1) ? fmaxf(mx, p1[1]) : fmaxf(fmaxf(mx, p0[r]), p1[r]); \
        { auto rr = __builtin_amdgcn_permlane32_swap(__float_as_uint(mx), __float_as_uint(mx), false, false); mx = fmaxf(__uint_as_float(rr[0]), __uint_as_float(rr[1])); } \
        if ((first_) || __any(mx > ATT_THR)) { \
            const float dl = (first_) ? mx : fmaxf(mx, 0.f); \
            _Pragma("unroll") for (int r = 0; r < 16; ++r) { p0[r] -= dl; p1[r] -= dl; negm[r] -= dl; } \
            if (!(first_)) { const float f = __builtin_amdgcn_exp2f(-dl); lsum *= f; \
                _Pragma("unroll") for (int r = 0; r < 16; ++r) { o0[r] *= f; o1[r] *= f; } } \
        } \
        float rs = 0.f; \
        _Pragma("unroll") for (int r = 0; r < 16; ++r) { p0[r] = __builtin_amdgcn_exp2f(p0[r]); p1[r] = __builtin_amdgcn_exp2f(p1[r]); rs += p0[r] + p1[r]; } \
        lsum += rs; \
        u32x4 w0, w1, w2, w3; \
        w0.x = cvtpk(p0[0], p0[1]); w0.y = cvtpk(p0[2], p0[3]); w0.z = cvtpk(p0[4], p0[5]); w0.w = cvtpk(p0[6], p0[7]); \
        w1.x = cvtpk(p0[8], p0[9]); w1.y = cvtpk(p0[10], p0[11]); w1.z = cvtpk(p0[12], p0[13]); w1.w = cvtpk(p0[14], p0[15]); \
        w2.x = cvtpk(p1[0], p1[1]); w2.y = cvtpk(p1[2], p1[3]); w2.z = cvtpk(p1[4], p1[5]); w2.w = cvtpk(p1[6], p1[7]); \
        w3.x = cvtpk(p1[8], p1[9]); w3.y = cvtpk(p1[10], p1[11]); w3.z = cvtpk(p1[12], p1[13]); w3.w = cvtpk(p1[14], p1[15]); \
        const bf16x8 pa0 = __builtin_bit_cast(bf16x8, w0), pa1 = __builtin_bit_cast(bf16x8, w1), pa2 = __builtin_bit_cast(bf16x8, w2), pa3 = __builtin_bit_cast(bf16x8, w3); \
        const LAS unsigned char* vb_ = lds + (vs_) * ATT_VSLOT + vread; \
        o0 = __builtin_amdgcn_mfma_f32_32x32x16_bf16(ATT_VF(0, 0), pa0, o0, 0, 0, 0); \
        o1 = __builtin_amdgcn_mfma_f32_32x32x16_bf16(ATT_VF(1, 0), pa0, o1, 0, 0, 0); \
        o0 = __builtin_amdgcn_mfma_f32_32x32x16_bf16(ATT_VF(0, 1), pa1, o0, 0, 0, 0); \
        o1 = __builtin_amdgcn_mfma_f32_32x32x16_bf16(ATT_VF(1, 1), pa1, o1, 0, 0, 0); \
        o0 = __builtin_amdgcn_mfma_f32_32x32x16_bf16(ATT_VF(0, 2), pa2, o0, 0, 0, 0); \
        o1 = __builtin_amdgcn_mfma_f32_32x32x16_bf16(ATT_VF(1, 2), pa2, o1, 0, 0, 0); \
        o0 = __builtin_amdgcn_mfma_f32_32x32x16_bf16(ATT_VF(0, 3), pa3, o0, 0, 0, 0); \
        o1 = __builtin_amdgcn_mfma_f32_32x32x16_bf16(ATT_VF(1, 3), pa3, o1, 0, 0, 0); } while (0)
#define ATT_VF(d0, ks) ({ const s16x4 lo_ = vtr(vb_ + (d0) * 4096 + (ks) * 1024), hi_ = vtr(vb_ + (d0) * 4096 + (ks) * 1024 + 512); (bf16x8){lo_[0], lo_[1], lo_[2], lo_[3], hi_[0], hi_[1], hi_[2], hi_[3]}; })
#define ATT_ENDSTEP() do { if (issue) { if (three) ATT_WAITBAR(3); else ATT_WAITBAR(2); } else ATT_WAITBAR(0); \
        ks = (ks == ATT_NKS - 1) ? 0 : ks + 1; vs = (vs + 1) & (ATT_NVS - 1); } while (0)
    if (ntiles > 1) { if (three) ATT_WAITBAR(3); else ATT_WAITBAR(2); } else ATT_WAITBAR(0);
    int ks = 0, vs = 0;
    if (w < 4) {
        for (int t = 0; t < ntiles; ++t) {
            const bool issue = (t + 2 < ntiles);
            if (issue) ATT_DMA(t + 2, (ks >= 1) ? ks - 1 : ATT_NKS - 1, (vs + 2) & (ATT_NVS - 1));
            ATT_QK(ks);
            ATT_SOFT_PV(t == 0, vs);
            ATT_ENDSTEP();
        }
    } else {
        for (int t = 0; t < ntiles; ++t) {
            const bool issue = (t + 2 < ntiles);
            if (issue) ATT_DMA(t + 2, (ks >= 1) ? ks - 1 : ATT_NKS - 1, (vs + 2) & (ATT_NVS - 1));
            if (t > 0) ATT_SOFT_PV(t == 1, (vs + ATT_NVS - 1) & (ATT_NVS - 1));
            ATT_QK(ks);
            ATT_ENDSTEP();
        }
        ATT_SOFT_PV(ntiles == 1, (vs + ATT_NVS - 1) & (ATT_NVS - 1));
    }
#undef ATT_DMA
#undef ATT_QK
#undef ATT_SOFT_PV
#undef ATT_VF
#undef ATT_ENDSTEP
    { auto rr = __builtin_amdgcn_permlane32_swap(__float_as_uint(lsum), __float_as_uint(lsum), false, false); lsum = __uint_as_float(rr[0]) + __uint_as_float(rr[1]); }
    const float rl = 1.0f / lsum;
#pragma unroll
    for (int g = 0; g < 4; ++g) {
        u32x2 a, b2;
        a.x = cvtpk(o0[4 * g] * rl, o0[4 * g + 1] * rl); a.y = cvtpk(o0[4 * g + 2] * rl, o0[4 * g + 3] * rl);
        b2.x = cvtpk(o1[4 * g] * rl, o1[4 * g + 1] * rl); b2.y = cvtpk(o1[4 * g + 2] * rl, o1[4 * g + 3] * rl);
        *(u32x2*)(orow + 8 * g + 4 * hi) = a; *(u32x2*)(orow + 32 + 8 * g + 4 * hi) = b2;
    }
    asm volatile("s_waitcnt lgkmcnt(0)\n\ts_barrier" ::: "memory");
}

constexpr int AT3_KSLOT = 12288, AT3_VSLOT = 8192, AT3_V0 = 3 * AT3_KSLOT;
constexpr int AT3_FLAG = MISC_OFF + 32;
constexpr float AT3_SUMTHR = 1024.f, AT3_SUMBAD = 1.152921504606846976e18f;
#define AT3_SB() __builtin_amdgcn_sched_barrier(0)
#define AT3_PIN(x) asm volatile("" : "+v"(x))
struct AttNext { bool has, qd96; const bf16_t* Kb; const bf16_t* Qb; int row0; };
template <int QD, bool exact>
__device__ __forceinline__ void attn_unit3(LAS unsigned char* lds, int tid, const bf16_t* Kb, const bf16_t* Vb, int ntiles, const bf16_t* qrow, bf16_t* orow, const bool warm, const AttNext nx, bf16x8 (&qpre)[6]) {
    constexpr int NC = QD / 8, NS = QD / 16, NKF = 2 * NS;
    constexpr int KG0 = (NS == 4) ? 2 : 1;
    const int lane = tid & 63, r32 = lane & 31, hi = lane >> 5;
    const int w = __builtin_amdgcn_readfirstlane(tid >> 6);
    const bool three = (NC == 12) && (w < 4);
    const int vp = (NC == 12) ? (w < 4 ? w + 4 : w - 4) : w;
    const bf16_t* ksrcA = Kb + w * 512;
    const bf16_t* ksrcB = Kb + (w + 8) * 512;
    const bf16_t* vsrc = Vb + vp * 512;
    const unsigned lofs = (unsigned)lane * 16u;
    const size_t kstep = (size_t)64 * QD, vstep = (size_t)4096;
    const unsigned lds0 = (unsigned)(size_t)lds;
#define AT3_DMAK(t_, sl_) do { \
        att_glds16s(ksrcA + (size_t)(t_) * kstep, lofs, (unsigned)__builtin_amdgcn_readfirstlane((int)(lds0 + (sl_) * AT3_KSLOT + w * 1024))); \
        if (three) att_glds16s(ksrcB + (size_t)(t_) * kstep, lofs, (unsigned)__builtin_amdgcn_readfirstlane((int)(lds0 + (sl_) * AT3_KSLOT + (w + 8) * 1024))); } while (0)
#define AT3_DMAV(t_, sl_) att_glds16s(vsrc + (size_t)(t_) * vstep, lofs, (unsigned)__builtin_amdgcn_readfirstlane((int)(lds0 + AT3_V0 + (sl_) * AT3_VSLOT + vp * 1024)))
#define AT3_WB(n_) do { const int nn_ = (n_); if (nn_ == 3) ATT_WAITBAR(3); else if (nn_ == 2) ATT_WAITBAR(2); else if (nn_ == 1) ATT_WAITBAR(1); else ATT_WAITBAR(0); } while (0)
    const int nk = three ? 2 : 1;
    bf16x8 qr[NS];
    if (!warm) {
#pragma unroll
        for (int s = 0; s < NS; ++s) qr[s] = *(const bf16x8*)(qrow + 16 * s + 8 * hi);
        AT3_DMAK(0, 0);
    } else {
#pragma unroll
        for (int s = 0; s < NS; ++s) qr[s] = qpre[s];
    }
    f32x16 o0, o1, negm, pA0, pA1, pB0, pB1;
#pragma unroll
    for (int r = 0; r < 16; ++r) { o0[r] = 0.f; o1[r] = 0.f; negm[r] = 0.f; }
    AT3_PIN(negm);
    float lsum = 0.f, fres = 1.f; bool resc = false, bad = false;
    const LAS unsigned char* kp0 = lds + hi * 1024 + r32 * 16;
    const LAS unsigned char* vp0 = lds + AT3_V0 + ((lane >> 4) & 1) * 32 + (lane & 3) * 8 + (4 * hi + ((lane & 15) >> 2)) * 64;
    if (warm) ATT_WAITBAR(4); else ATT_WAITBAR(0);
    AT3_DMAV(0, 0); AT3_DMAK(1, 1); AT3_DMAK(2, 2);
    {
#pragma unroll
        for (int s = 0; s < NS; ++s) {
            const bf16x8 a0 = *(const LAS bf16x8*)(kp0 + s * 2048), a1 = *(const LAS bf16x8*)(kp0 + s * 2048 + 512);
            if (s == 0) { pA0 = __builtin_amdgcn_mfma_f32_32x32x16_bf16(a0, qr[0], negm, 0, 0, 0); pA1 = __builtin_amdgcn_mfma_f32_32x32x16_bf16(a1, qr[0], negm, 0, 0, 0); }
            else { pA0 = __builtin_amdgcn_mfma_f32_32x32x16_bf16(a0, qr[s], pA0, 0, 0, 0); pA1 = __builtin_amdgcn_mfma_f32_32x32x16_bf16(a1, qr[s], pA1, 0, 0, 0); } }
        float mx = fmaxf(fmaxf(pA0[0], pA1[0]), pA0[1]);
#pragma unroll
        for (int r = 1; r < 16; ++r) mx = (r == 1) ? fmaxf(mx, pA1[1]) : fmaxf(fmaxf(mx, pA0[r]), pA1[r]);
        { auto rr = __builtin_amdgcn_permlane32_swap(__float_as_uint(mx), __float_as_uint(mx), false, false); mx = fmaxf(__uint_as_float(rr[0]), __uint_as_float(rr[1])); }
#pragma unroll
        for (int r = 0; r < 16; ++r) { pA0[r] = __builtin_amdgcn_exp2f(pA0[r] - mx); pA1[r] = __builtin_amdgcn_exp2f(pA1[r] - mx); negm[r] = -mx; }
        AT3_PIN(negm);
    }
    ATT_WAITBAR(0);
    AT3_DMAK(3, 0); AT3_DMAV(1, 1);
    int sp = 0, sc = 1, sn = 2;
#define AT3_ROT() do { sp = sc; sc = sn; sn = (sn == 2) ? 0 : sn + 1; } while (0)
    bf16x8 kf[NKF];
    { const LAS unsigned char* kp_ = kp0 + sc * AT3_KSLOT;
#pragma unroll
      for (int j = 0; j < NS; ++j) { kf[2 * j] = *(const LAS bf16x8*)(kp_ + j * 2048); kf[2 * j + 1] = *(const LAS bf16x8*)(kp_ + j * 2048 + 512); } }
    AT3_WB(nk + 1);
    s16x4 vlo[8], vhi[8]; u32x4 pw[4];
#define AT3_PVAL(P0, P1, i) (((i) < 16) ? P0[(i) & 15] : P1[(i) & 15])
#define AT3_VFR(i) (bf16x8){vlo[i][0], vlo[i][1], vlo[i][2], vlo[i][3], vhi[i][0], vhi[i][1], vhi[i][2], vhi[i][3]}
#define AT3_STEP(C0, C1, P0, P1, t_, GK, GV, GL, HOOK) do { AT3_SB(); \
        const LAS unsigned char* vp_ = vp0 + sp * AT3_VSLOT; \
        float sacc = P0[0] + P0[1]; \
        _Pragma("unroll") for (int g = 0; g < NKF; ++g) { \
            if (g < 8) { const int i_ = (g >> 1) + 4 * (g & 1); \
                vlo[i_] = vtr(vp_ + (i_ >> 2) * 4096 + (i_ & 3) * 1024); vhi[i_] = vtr(vp_ + (i_ >> 2) * 4096 + (i_ & 3) * 1024 + 512); AT3_SB(); } \
            if (g & 1) { if (g < 2) C1 = __builtin_amdgcn_mfma_f32_32x32x16_bf16(kf[g], qr[g >> 1], negm, 0, 0, 0); else C1 = __builtin_amdgcn_mfma_f32_32x32x16_bf16(kf[g], qr[g >> 1], C1, 0, 0, 0); } \
            else { if (g < 2) C0 = __builtin_amdgcn_mfma_f32_32x32x16_bf16(kf[g], qr[g >> 1], negm, 0, 0, 0); else C0 = __builtin_amdgcn_mfma_f32_32x32x16_bf16(kf[g], qr[g >> 1], C0, 0, 0, 0); } \
            { const int wl_ = (g * 16) / NKF, wh_ = ((g + 1) * 16) / NKF;         \
              _Pragma("unroll") for (int k_ = 0; k_ < 16; ++k_) if (k_ >= wl_ && k_ < wh_) { \
                  if (k_ < 15) { sacc += AT3_PVAL(P0, P1, 2 * k_ + 2); sacc += AT3_PVAL(P0, P1, 2 * k_ + 3); } \
                  pw[k_ >> 2][k_ & 3] = cvtpk(AT3_PVAL(P0, P1, 2 * k_), AT3_PVAL(P0, P1, 2 * k_ + 1)); } \
              AT3_PIN(sacc); \
              _Pragma("unroll") for (int k_ = 0; k_ < 4; ++k_) if (4 * k_ + 3 >= wl_ && 4 * k_ < wh_) AT3_PIN(pw[k_]); } \
            AT3_SB(); } \
        lsum += sacc; \
        if (GK) AT3_DMAK((t_) + 3, sc); \
        if (GV) AT3_DMAV((t_) + 1, sn); \
        HOOK; \
        resc = false; \
        if (exact) { float ma = fmaxf(fmaxf(C0[0], C0[1]), C1[0]), mb = fmaxf(fmaxf(C0[2], C0[3]), C1[1]); ma = fmaxf(fmaxf(ma, C1[2]), C1[3]); \
          _Pragma("unroll") for (int r = 4; r < 16; r += 4) { ma = fmaxf(fmaxf(ma, C0[r]), C0[r + 1]); mb = fmaxf(fmaxf(mb, C0[r + 2]), C0[r + 3]); ma = fmaxf(fmaxf(ma, C1[r]), C1[r + 1]); mb = fmaxf(fmaxf(mb, C1[r + 2]), C1[r + 3]); } \
          float rm = fmaxf(ma, mb); \
          { auto rr = __builtin_amdgcn_permlane32_swap(__float_as_uint(rm), __float_as_uint(rm), false, false); rm = fmaxf(__uint_as_float(rr[0]), __uint_as_float(rr[1])); } \
          if (__builtin_expect(__any(rm > ATT_THR), 0)) { const float dl = fmaxf(rm, 0.f); \
              _Pragma("unroll") for (int r = 0; r < 16; ++r) { C0[r] -= dl; C1[r] -= dl; negm[r] -= dl; } \
              AT3_PIN(negm); \
              fres = __builtin_amdgcn_exp2f(-dl); lsum *= fres; resc = true; } \
        } else if (__builtin_expect(__any(!(sacc <= AT3_SUMTHR)), 0)) {         \
            float sm = sacc; \
            { auto rr = __builtin_amdgcn_permlane32_swap(__float_as_uint(sm), __float_as_uint(sm), false, false); const float s0_ = __uint_as_float(rr[0]), s1_ = __uint_as_float(rr[1]); sm = (s0_ == s0_ && s1_ == s1_) ? fmaxf(s0_, s1_) : s0_ + s1_; } \
            if (__any(!(sm < AT3_SUMBAD))) bad = true; \
            const float dl = (sm > AT3_SUMTHR && sm < AT3_SUMBAD) ? (float)((int)(__float_as_uint(sm) >> 23) - 127) : 0.f;     \
            _Pragma("unroll") for (int r = 0; r < 16; ++r) { C0[r] -= dl; C1[r] -= dl; negm[r] -= dl; } \
            AT3_PIN(negm); \
            fres = __builtin_amdgcn_exp2f(-dl); lsum *= fres; resc = true; } \
        AT3_SB(); \
        const LAS unsigned char* kn_ = kp0 + sn * AT3_KSLOT; \
        _Pragma("unroll") for (int g = 0; g < 8; ++g) { \
            if (g >= KG0 && g < KG0 + NS) { if (GL) { const int j_ = g - KG0; kf[2 * j_] = *(const LAS bf16x8*)(kn_ + j_ * 2048); kf[2 * j_ + 1] = *(const LAS bf16x8*)(kn_ + j_ * 2048 + 512); AT3_SB(); } } \
            { const int i_ = (g >> 1) + 4 * (g & 1); \
              if (g & 1) o1 = __builtin_amdgcn_mfma_f32_32x32x16_bf16(AT3_VFR(i_), __builtin_bit_cast(bf16x8, pw[g >> 1]), o1, 0, 0, 0); \
              else o0 = __builtin_amdgcn_mfma_f32_32x32x16_bf16(AT3_VFR(i_), __builtin_bit_cast(bf16x8, pw[g >> 1]), o0, 0, 0, 0); } \
            if (g < 4) { C0[4 * g] = __builtin_amdgcn_exp2f(C0[4 * g]); C0[4 * g + 1] = __builtin_amdgcn_exp2f(C0[4 * g + 1]); C0[4 * g + 2] = __builtin_amdgcn_exp2f(C0[4 * g + 2]); C0[4 * g + 3] = __builtin_amdgcn_exp2f(C0[4 * g + 3]); AT3_PIN(C0); } \
            else { C1[4 * g - 16] = __builtin_amdgcn_exp2f(C1[4 * g - 16]); C1[4 * g - 15] = __builtin_amdgcn_exp2f(C1[4 * g - 15]); C1[4 * g - 14] = __builtin_amdgcn_exp2f(C1[4 * g - 14]); C1[4 * g - 13] = __builtin_amdgcn_exp2f(C1[4 * g - 13]); AT3_PIN(C1); } \
            AT3_SB(); } \
    } while (0)
#define AT3_RESC() do { if (resc) { _Pragma("unroll") for (int r = 0; r < 16; ++r) { o0[r] *= fres; o1[r] *= fres; } } } while (0)
    for (int t = 1; t + 3 < ntiles; t += 2) {
        AT3_STEP(pB0, pB1, pA0, pA1, t, true, true, true, (void)0);      if (three) ATT_WAITBAR(3); else ATT_WAITBAR(2);  AT3_RESC(); AT3_ROT();
        AT3_STEP(pA0, pA1, pB0, pB1, t + 1, true, true, true, (void)0);  if (three) ATT_WAITBAR(3); else ATT_WAITBAR(2);  AT3_RESC(); AT3_ROT();
    }
    AT3_STEP(pB0, pB1, pA0, pA1, ntiles - 3, false, true, true, (void)0);   ATT_WAITBAR(1); AT3_RESC(); AT3_ROT();
    AT3_STEP(pA0, pA1, pB0, pB1, ntiles - 2, false, true, true, (void)0);   ATT_WAITBAR(0); AT3_RESC(); AT3_ROT();
#define AT3_NEXT() do { if (nx.has) { \
            const bool threen_ = nx.qd96 && (w < 4); const size_t kw_ = (size_t)w * 512; \
            att_glds16s(nx.Kb + kw_, lofs, (unsigned)__builtin_amdgcn_readfirstlane((int)(lds0 + w * 1024))); \
            if (threen_) att_glds16s(nx.Kb + kw_ + 8 * 512, lofs, (unsigned)__builtin_amdgcn_readfirstlane((int)(lds0 + (w + 8) * 1024))); \
            const bf16_t* qn_ = nx.qd96 ? nx.Qb + (size_t)(nx.row0 + w * 32 + r32) * QW : nx.Qb + (size_t)(nx.row0 + (w & 1) * 32 + r32) * 512 + (w >> 1) * 64; \
            _Pragma("unroll") for (int s = 0; s < 4; ++s) qpre[s] = *(const bf16x8*)(qn_ + 16 * s + 8 * hi); \
            if (nx.qd96) { qpre[4] = *(const bf16x8*)(qn_ + 64 + 8 * hi); qpre[5] = *(const bf16x8*)(qn_ + 80 + 8 * hi); } else { qpre[4] = (bf16x8){0, 0, 0, 0, 0, 0, 0, 0}; qpre[5] = qpre[4]; } \
        } else { _Pragma("unroll") for (int s = 0; s < 6; ++s) qpre[s] = (bf16x8){0, 0, 0, 0, 0, 0, 0, 0}; } } while (0)
    AT3_STEP(pB0, pB1, pA0, pA1, ntiles - 1, false, false, false, AT3_NEXT()); AT3_RESC();
#undef AT3_NEXT
    { float sacc = pB0[0] + pB0[1];
#pragma unroll
      for (int r = 2; r < 16; ++r) sacc += pB0[r];
#pragma unroll
      for (int r = 0; r < 16; ++r) sacc += pB1[r];
      lsum += sacc;
#pragma unroll
      for (int k = 0; k < 4; ++k) { pw[k][0] = cvtpk(AT3_PVAL(pB0, pB1, 8 * k), AT3_PVAL(pB0, pB1, 8 * k + 1)); pw[k][1] = cvtpk(AT3_PVAL(pB0, pB1, 8 * k + 2), AT3_PVAL(pB0, pB1, 8 * k + 3));
                                    pw[k][2] = cvtpk(AT3_PVAL(pB0, pB1, 8 * k + 4), AT3_PVAL(pB0, pB1, 8 * k + 5)); pw[k][3] = cvtpk(AT3_PVAL(pB0, pB1, 8 * k + 6), AT3_PVAL(pB0, pB1, 8 * k + 7)); }
      const LAS unsigned char* vp_ = vp0 + sc * AT3_VSLOT;
#pragma unroll
      for (int i = 0; i < 8; ++i) { vlo[i] = vtr(vp_ + (i >> 2) * 4096 + (i & 3) * 1024); vhi[i] = vtr(vp_ + (i >> 2) * 4096 + (i & 3) * 1024 + 512); }
#pragma unroll
      for (int k = 0; k < 4; ++k) { o0 = __builtin_amdgcn_mfma_f32_32x32x16_bf16(AT3_VFR(k), __builtin_bit_cast(bf16x8, pw[k]), o0, 0, 0, 0); o1 = __builtin_amdgcn_mfma_f32_32x32x16_bf16(AT3_VFR(k + 4), __builtin_bit_cast(bf16x8, pw[k]), o1, 0, 0, 0); } }
#undef AT3_DMAK
#undef AT3_DMAV
#undef AT3_WB
#undef AT3_ROT
#undef AT3_PVAL
#undef AT3_VFR
#undef AT3_STEP
#undef AT3_RESC
    { auto rr = __builtin_amdgcn_permlane32_swap(__float_as_uint(lsum), __float_as_uint(lsum), false, false); lsum = __uint_as_float(rr[0]) + __uint_as_float(rr[1]); }
    const float rl = 1.0f / lsum;
    LAS unsigned char* stg = lds + (AT3_V0 + 3 * AT3_VSLOT) + w * (32 * 144);
#pragma unroll
    for (int g = 0; g < 4; ++g) {
        u32x2 a, b2;
        a.x = cvtpk(o0[4 * g] * rl, o0[4 * g + 1] * rl); a.y = cvtpk(o0[4 * g + 2] * rl, o0[4 * g + 3] * rl);
        b2.x = cvtpk(o1[4 * g] * rl, o1[4 * g + 1] * rl); b2.y = cvtpk(o1[4 * g + 2] * rl, o1[4 * g + 3] * rl);
        *(LAS u32x2*)(stg + r32 * 144 + (8 * g + 4 * hi) * 2) = a; *(LAS u32x2*)(stg + r32 * 144 + (32 + 8 * g + 4 * hi) * 2) = b2;
    }
    asm volatile("s_waitcnt lgkmcnt(0)" ::: "memory");
    { bf16_t* obase = orow - (size_t)r32 * D;
#pragma unroll
      for (int i = 0; i < 4; ++i) { const int row = i * 8 + (lane >> 3), ch = lane & 7;
          const u32x4 v = *(const LAS u32x4*)(stg + row * 144 + ch * 16);
          *(u32x4*)(obase + (size_t)row * D + ch * 8) = v; } }
    if (!exact) { if (__any(!(lsum < 1.2676506e30f))) bad = true;
        if (bad && lane == 0) *(volatile LAS unsigned*)(lds + AT3_FLAG) = 1u; }
    asm volatile("s_waitcnt lgkmcnt(0)\n\ts_barrier" ::: "memory");
}
struct AttDesc { bool qd96; const bf16_t* Kb; const bf16_t* Vb; const bf16_t* Qb; bf16_t* Ob; int row0, nt; };
__device__ __forceinline__ AttDesc att_desc(int i, int vcu, unsigned char* ws) {
    const bf16_t* Qm = (const bf16_t*)(ws + WS_QM); const bf16_t* Km = (const bf16_t*)(ws + WS_KM); const bf16_t* Vm = (const bf16_t*)(ws + WS_VM);
    const bf16_t* Qg = (const bf16_t*)(ws + WS_QG); const bf16_t* Kg = (const bf16_t*)(ws + WS_KG); const bf16_t* Vg = (const bf16_t*)(ws + WS_VG);
    bf16_t* O = (bf16_t*)(ws + WS_O);
    const int xcd = vcu >> 5, cix = vcu & 31;
    AttDesc d;
    if (i < 8 && (i & 1) == 0) {
        const int pair = xcd * 16 + (i >> 1) * 4 + (cix >> 3), b = pair >> 3, h = pair & 7, qb = cix & 7;
        d.qd96 = true; d.Kb = Km + (size_t)(b * 8 + h) * KPB * 96; d.Vb = Vm + (size_t)(b * 8 + h) * KPB * 64; d.Qb = Qm + h * 96; d.Ob = O + h * 64; d.row0 = b * SEQ + qb * 256; d.nt = KPB / 64;
    } else if (i < 8) {
        const int pair = xcd * 4 + (i >> 1), b = pair >> 1, kvh = pair & 1;
        d.qd96 = false; d.Kb = Kg + (size_t)(b * 2 + kvh) * KPB * 64; d.Vb = Vg + (size_t)(b * 2 + kvh) * KPB * 64; d.Qb = Qg + kvh * 256; d.Ob = O + 512 + kvh * 256; d.row0 = b * SEQ + cix * 64; d.nt = KPB / 64;
    } else if (vcu < 128) {
        const int b = vcu >> 3, h = vcu & 7;
        d.qd96 = true; d.Kb = Km + (size_t)(b * 8 + h) * KPB * 96; d.Vb = Vm + (size_t)(b * 8 + h) * KPB * 64; d.Qb = Qm + h * 96; d.Ob = O + h * 64; d.row0 = TL + b * CTX; d.nt = CTX / 64;
    } else {
        const int idx = vcu - 128, b = idx >> 3, kvh = (idx >> 2) & 1, qb = idx & 3;
        d.qd96 = false; d.Kb = Kg + (size_t)(b * 2 + kvh) * KPB * 64; d.Vb = Vg + (size_t)(b * 2 + kvh) * KPB * 64; d.Qb = Qg + kvh * 256; d.Ob = O + 512 + kvh * 256; d.row0 = TL + b * CTX + qb * 64; d.nt = CTX / 64;
    }
    return d;
}
#ifndef ATT_FORCE_EXACT
#define ATT_FORCE_EXACT 0
#endif
__device__ __forceinline__ void phase_attn(const Ctx& F, KP kp, bool last, int l) {
    const Args a = ldargs(kp);
    unsigned char* ws = a.ws;
    const int nun = last ? 8 : 9;
    if (F.tid == 0) *(volatile LAS unsigned*)(F.lds + AT3_FLAG) = ATT_FORCE_EXACT ? 1u : 0u;
    bool exact = false, warm = false;
    bf16x8 qpre[6];
#pragma unroll
    for (int s = 0; s < 6; ++s) qpre[s] = (bf16x8){0, 0, 0, 0, 0, 0, 0, 0};
#define ATT_RUN(EX, WARM) do { \
        int tid_; { int ln_; asm volatile("v_mbcnt_lo_u32_b32 %0, -1, 0\n\tv_mbcnt_hi_u32_b32 %0, -1, %0" : "=v"(ln_)); tid_ = F.wave * 64 + ln_; }       \
        const int r32 = tid_ & 31, w = __builtin_amdgcn_readfirstlane(tid_ >> 6); \
        if (d.qd96) { const int row = d.row0 + w * 32 + r32; \
            attn_unit3<96, EX>(F.lds, tid_, d.Kb, d.Vb, d.nt, d.Qb + (size_t)row * QW, d.Ob + (size_t)row * D, WARM, nx, qpre); \
        } else { const int row = d.row0 + (w & 1) * 32 + r32; \
            attn_unit3<64, EX>(F.lds, tid_, d.Kb, d.Vb, d.nt, d.Qb + (size_t)row * 512 + (w >> 1) * 64, d.Ob + (size_t)row * D + (w >> 1) * 64, WARM, nx, qpre); } } while (0)
    for (int i = 0; i < nun; ++i) {
        const AttDesc d = att_desc(i, F.vcu, ws);
        const bool convs = (i == (F.vcu & 7));
        AttNext nx; nx.has = (i + 1 < nun) && (d.nt % 3 == 0) && !convs;
        { const AttDesc dn = att_desc((i + 1 < nun) ? i + 1 : i, F.vcu, ws); nx.qd96 = dn.qd96; nx.Kb = dn.Kb; nx.Qb = dn.Qb; nx.row0 = dn.row0; }
        if (!exact) {
            ATT_RUN(false, warm);
            const unsigned fl = __builtin_amdgcn_readfirstlane((int)*(volatile LAS unsigned*)(F.lds + AT3_FLAG));
            if (fl != 0u) { exact = true; warm = false; }
        }
        if (exact) ATT_RUN(true, warm);
        warm = nx.has;
        if (convs) {
            int ln_; asm volatile("v_mbcnt_lo_u32_b32 %0, -1, 0\n\tv_mbcnt_hi_u32_b32 %0, -1, %0" : "=v"(ln_));
            conv_experts(ln_, F.wave, F.vcu, a, l);
        }
    }
#undef ATT_RUN
}
__global__ void __launch_bounds__(NTHREADS, 2) fwd_kernel(Args a_unused) {
    extern __shared__ __attribute__((aligned(16))) unsigned char lds_raw[];
    const KP kp = (KP)__builtin_amdgcn_kernarg_segment_ptr();
    Ctx F;
    F.lds = (LAS unsigned char*)lds_raw;
    F.tid = threadIdx.x; F.lane = F.tid & 63; F.wave = __builtin_amdgcn_readfirstlane(F.tid >> 6);
    F.bk = blockIdx.x; F.vcu = (F.bk & 7) * (GRID / 8) + (F.bk >> 3);
    if (F.tid < 4) ((volatile LAS unsigned*)(F.lds + MISC_BAR))[F.tid] = 0u;
    __syncthreads();
    { const Args a = ldargs(kp); (void)xcd_barrier_post((unsigned*)(a.ws + WS_CTL), (volatile LAS unsigned*)(F.lds + MISC_BAR), F.tid == 0); }
#define FRESH() do { int ln_; asm volatile("v_mbcnt_lo_u32_b32 %0, -1, 0\n\tv_mbcnt_hi_u32_b32 %0, -1, %0" : "=v"(ln_)); F.lane = ln_; F.tid = F.wave * 64 + ln_; F.bk = blockIdx.x; F.vcu = (F.bk & 7) * (GRID / 8) + (F.bk >> 3); } while (0)
#define GRID_BAR() do { XcdBarrier b_; { const Args a_ = ldargs(kp); b_.bar = (unsigned*)(a_.ws + WS_CTL); } b_.x = xb_xcc_id(); b_.st = (volatile LAS unsigned*)(F.lds + MISC_BAR); xcd_barrier(b_, F.tid == 0); } while (0)

    for (int rep_ = 0; rep_ < REP_PRO; ++rep_) prologue1(F, kp);
    GRID_BAR(); FRESH();
    prologue2(F, kp);
    prologue3(F, kp);
    GRID_BAR(); FRESH();

    for (int l = 0; l < NL; ++l) {
        const bool last = (l == NL - 1);
        const int ntok = last ? TL : MT;
        { const Args a = ldargs(kp); unsigned char* ws = a.ws;
          Gemm g{(const bf16_t*)(ws + WS_H), D, (const bf16_t*)(ws + WS_WIN) + (size_t)l * ZW * D, D}; StaticOrder S; S.init(MT, ZW, GRID, F.bk);
#if FUSE_SPLIT
          LAS f32x2* t64l = (LAS f32x2*)(F.lds + STAGE_BYTES); LAS f32x2* t32l = t64l + 1024; LAS float* ggl = (LAS float*)(t32l + 512);
          { const f32x2* t64g = (const f32x2*)(ws + WS_TAB64); const f32x2* t32g = (const f32x2*)(ws + WS_TAB32);
            t64l[F.tid] = t64g[F.tid]; t64l[F.tid + 512] = t64g[F.tid + 512]; t32l[F.tid] = t32g[F.tid];
            if (F.tid < 64) ggl[F.tid] = a.g_gq[l * 64 + F.tid]; else if (F.tid < 128) ggl[F.tid] = a.g_gk[l * 64 + F.tid - 64]; }
          __syncthreads();
          EpiIn E{ws, ggl, ggl + 64, t64l, t32l}; gemm_phase<0>(F, g, S, E); }
#else
          EpiZ E{(bf16_t*)(ws + WS_Z)}; gemm_phase<0>(F, g, S, E); }
#endif
        GRID_BAR(); FRESH();
#if !FUSE_SPLIT
        for (int rep_ = 0; rep_ < REP_P2; ++rep_) phase_split(F, kp, l);
        GRID_BAR(); FRESH();
#endif
        { const Args a = ldargs(kp); unsigned char* ws = a.ws;
          Gemm g{(const bf16_t*)(ws + WS_Z), ZW, (const bf16_t*)(ws + WS_WQ) + (size_t)l * QW * 384, 384}; StaticOrder S; S.init(MT, QW, GRID, F.bk);
          LAS f32x2* t32l = (LAS f32x2*)(F.lds + STAGE_BYTES);
          LAS float* rsq = (LAS float*)(F.lds + STAGE_BYTES + 4096);
          { const f32x2* t32g = (const f32x2*)(ws + WS_TAB32); t32l[F.tid] = t32g[F.tid];
            Unit u; for (int i = 0; i < 4 && S.next(i, u); ++i) if (F.tid < 256) rsq[i * 256 + F.tid] = EpiQ::rowscale(ws, u.pm * 256 + F.tid); }
          __syncthreads();
          EpiQ E{ws, t32l, rsq}; gemm_phase<1>(F, g, S, E); }
        FRESH();
        { const Args a = ldargs(kp); unsigned char* ws = a.ws;
          Gemm g{(const bf16_t*)(ws + WS_Z) + 384, ZW, (const bf16_t*)(ws + WS_WKV) + (size_t)l * KVW * 256, 256}; StaticOrder S; S.init(MT, KVW, GRID, (F.bk + 80) & 255);
          LAS float* rskv = (LAS float*)(F.lds + STAGE_BYTES + 8192);
          { Unit u; for (int i = 0; i < 4 && S.next(i, u); ++i) if (F.tid < 256) rskv[i * 256 + F.tid] = EpiKV::rowscale(ws, u.pm * 256 + F.tid); }
          __syncthreads();
          EpiKV E{ws, rskv}; gemm_phase<2>(F, g, S, E); }
        GRID_BAR(); FRESH();
#if USE_MFMA_ATTN
        for (int rep_ = 0; rep_ < REP_ATTN; ++rep_) phase_attn(F, kp, last, l);
        FRESH();
#else
#error the scalar attention body reads the old row-major K/V layout
#endif
        GRID_BAR(); FRESH();
        { const Args a = ldargs(kp); unsigned char* ws = a.ws;
          Gemm g{(const bf16_t*)(ws + WS_O), D, (const bf16_t*)(ws + WS_WO) + (size_t)l * D * D, D}; StaticOrder S; S.init(ntok, D, GRID, F.bk);
          EpiYo E{(bf16_t*)(ws + WS_U)}; gemm_phase<3>(F, g, S, E); }
        GRID_BAR(); FRESH();
        if (l == 0) phase_ln1_route<true>(F, kp, l, ntok); else phase_ln1_route<false>(F, kp, l, ntok);
        GRID_BAR(); FRESH();
        for (int rep_ = 0; rep_ < REP_P7; ++rep_) phase_dispatch(F, kp, l, ntok);
        GRID_BAR(); FRESH();
        { const Args a = ldargs(kp); unsigned char* ws = a.ws;
          Gemm g{(const bf16_t*)(ws + WS_H), D, (const bf16_t*)(ws + WS_WGU) + (size_t)l * NEXP * 1024 * D, D}; GroupedOrder S; S.init((const volatile LAS int*)(F.lds + MISC_POFF), GRID, F.vcu);
          LAS int* gt = (LAS int*)(F.lds + STAGE_BYTES);
          { const int* postok = (const int*)(ws + WS_POSTOK); Unit u; for (int i = 0; i < 16 && S.next(i, u); ++i) if (F.tid < 256) gt[i * 256 + F.tid] = postok[u.pm * 256 + F.tid]; }
          __syncthreads();
          EpiAct E{(bf16_t*)(ws + WS_ACT)}; gemm_phase_gather<4>(F, g, S, E, gt); }
        GRID_BAR(); FRESH();
        { const Args a = ldargs(kp); unsigned char* ws = a.ws;
          Gemm g{(const bf16_t*)(ws + WS_ACT), FF, (const bf16_t*)(ws + WS_WD) + (size_t)l * NEXP * D * FF, FF}; GroupedOrder S; S.init((const volatile LAS int*)(F.lds + MISC_POFF), GRID, F.vcu);
          EpiY E{(bf16_t*)(ws + WS_XS)}; gemm_phase<5>(F, g, S, E); }
        GRID_BAR(); FRESH();
        phase_ln2(F, kp, l, ntok);
        GRID_BAR(); FRESH();
    }
}

extern "C" void kernel_launch(void* const* d_in, const int* in_sizes, int n_in, void* d_out, int out_size, void* d_ws, size_t ws_size, hipStream_t stream) {
    static int grid = 0;
    if (grid == 0) {
        if (n_in != 25 || out_size != TL * D || ws_size < WS_END) { fprintf(stderr, "kernel_launch: unexpected shapes (n_in %d out %d ws %zu need %zu)\n", n_in, out_size, ws_size, (size_t)WS_END); grid = -1; return; }
        int dev = 0, cus = 0, per_cu = 0;
        if (hipGetDevice(&dev) != hipSuccess || hipDeviceGetAttribute(&cus, hipDeviceAttributeMultiprocessorCount, dev) != hipSuccess) { grid = -1; return; }
        if (hipFuncSetAttribute((const void*)fwd_kernel, hipFuncAttributeMaxDynamicSharedMemorySize, LDS_BYTES) != hipSuccess) { fprintf(stderr, "kernel_launch: hipFuncSetAttribute failed\n"); grid = -1; return; }
        if (hipOccupancyMaxActiveBlocksPerMultiprocessor(&per_cu, (const void*)fwd_kernel, NTHREADS, LDS_BYTES) != hipSuccess || per_cu < 1) { fprintf(stderr, "kernel_launch: occupancy query says %d\n", per_cu); }
        (void)hipGetLastError();
        grid = (cus == 256) ? 256 : -1;
        if (grid < 0) { fprintf(stderr, "kernel_launch: need a 256-CU device, got %d\n", cus); return; }
    }
    if (grid < 0) return;
    if (hipMemsetAsync((char*)d_ws + WS_CTL, 0, CTL_BYTES, stream) != hipSuccess) return;
    Args a{};
    a.x = (const float*)d_in[0]; a.c = (const float*)d_in[1]; a.ctx = (const float*)d_in[2]; a.c_ctx = (const float*)d_in[3]; a.w_ada = (const float*)d_in[4]; a.b_ada = (const float*)d_in[5];
    a.w_in = (const float*)d_in[6]; a.g_q_a = (const float*)d_in[7]; a.w_q_b = (const float*)d_in[8]; a.g_kv_a = (const float*)d_in[9]; a.w_kv_b = (const float*)d_in[10];
    a.g_gq = (const float*)d_in[11]; a.g_gk = (const float*)d_in[12]; a.w_o = (const float*)d_in[13]; a.ln1_g = (const float*)d_in[14]; a.ln1_b = (const float*)d_in[15];
    a.w_rg = (const float*)d_in[16]; a.b_rg = (const float*)d_in[17]; a.w_re = (const float*)d_in[18]; a.b_re = (const float*)d_in[19];
    a.w_gate = (const float*)d_in[20]; a.w_up = (const float*)d_in[21]; a.w_down = (const float*)d_in[22]; a.ln2_g = (const float*)d_in[23]; a.ln2_b = (const float*)d_in[24];
    a.out = (float*)d_out; a.ws = (unsigned char*)d_ws;
    hipLaunchKernelGGL(fwd_kernel, dim3(grid), dim3(NTHREADS), LDS_BYTES, stream, a);
}
```
